# Optimizing an MI355X kernel written in HIP

```python
import numpy as np
import jax
import jax.numpy as jnp
from jax import lax

D_MODEL = 1024
BATCH = 4
SEQ = 8192
DEPTH = 2

GRID_W = 64
CTX_LEN = 256
D_MIX = D_MODEL
GROUP_W = D_MIX // 4
GLA_HEADS = 4
GLA_DV = GROUP_W // GLA_HEADS
GLA_DK = GLA_DV // 2
GLA_QK_W = GLA_HEADS * GLA_DK
GLA_GATE_RANK = 16
GLA_GATE_NORM = 16.0
GLA_CHUNK = 64
CONF_WIDTH = 31
SC_WIDTH = 3
POOL_WINDOWS = (2, 4, 8, 16)
POOL_GROUPS = 4
POOL_GW = GROUP_W // POOL_GROUPS
N_GROUPS = 4
EXPERTS_PER_GROUP = 8
N_EXPERTS = N_GROUPS * EXPERTS_PER_GROUP
TOP_K_INNER = 2
D_EXPERT = D_MODEL // 2
MOE_BLOCK = 256
NORM_EPS = 1e-6
IN_SPLITS = (GLA_QK_W, GLA_QK_W, GROUP_W, GROUP_W, GLA_GATE_RANK, GLA_GATE_RANK,
             2 * GROUP_W, GROUP_W, GROUP_W, GROUP_W, GROUP_W)
N_IN = 2 * GLA_QK_W + 2 * GLA_GATE_RANK + 8 * GROUP_W

kernel_name = 'hybrid_parallel_group_flow_block'


def rms_norm(x, g):
    xf = x.astype(jnp.float32)
    y = xf * lax.rsqrt(jnp.mean(xf * xf, axis=-1, keepdims=True) + NORM_EPS)
    return (y * g.astype(jnp.float32)).astype(x.dtype)


def layer_norm(x, g, b):
    xf = x.astype(jnp.float32)
    xc = xf - jnp.mean(xf, axis=-1, keepdims=True)
    y = xc * lax.rsqrt(jnp.mean(xc * xc, axis=-1, keepdims=True) + NORM_EPS)
    return (y * g.astype(jnp.float32) + b.astype(jnp.float32)).astype(x.dtype)


def adaln(cvec, w, b):
    m = jax.nn.silu(cvec) @ w + b
    m = m.reshape(m.shape[:-1] + (6, D_MODEL))
    return [m[..., None, i, :] for i in range(6)]


def modulate(x, shift, scale):
    return x * (1 + scale) + shift


def split_columns(h):
    idx = np.cumsum(IN_SPLITS)[:-1].tolist()
    return jnp.split(h, idx, axis=-1)


def dwconv(x, w):
    k = w.shape[0]
    return lax.conv_general_dilated(
        x, w[:, None, :].astype(x.dtype), window_strides=(1,), padding=[(k // 2, k // 2)],
        dimension_numbers=('NWC', 'WIO', 'NWC'), feature_group_count=x.shape[-1])


def axial_dwconv(x, w):
    bsz, length, ch = x.shape
    rows = length // GRID_W
    half = ch // 2
    g = x.reshape(bsz, rows, GRID_W, ch)
    horiz = dwconv(g[..., :half].reshape(bsz * rows, GRID_W, half), w[:, :half])
    horiz = horiz.reshape(bsz, rows, GRID_W, half)
    vert = g[..., half:].transpose(0, 2, 1, 3).reshape(bsz * GRID_W, rows, ch - half)
    vert = dwconv(vert, w[:, half:]).reshape(bsz, GRID_W, rows, ch - half).transpose(0, 2, 1, 3)
    return jnp.concatenate([horiz, vert], axis=-1).reshape(bsz, length, ch)


def centred_mean(x, win):
    length = x.shape[1]
    cs = jnp.pad(jnp.cumsum(x.astype(jnp.float32), axis=1), ((0, 0), (1, 0), (0, 0)))
    t = np.arange(length)
    lo = np.clip(t - win // 2, 0, length)
    hi = np.clip(t + win // 2, 0, length)
    cnt = jnp.asarray((hi - lo)[None, :, None], jnp.float32)
    return ((cs[:, hi] - cs[:, lo]) / cnt).astype(x.dtype)


def row_mean(x, win):
    bsz, length, ch = x.shape
    rows = length // GRID_W
    return centred_mean(x.reshape(bsz * rows, GRID_W, ch), win).reshape(bsz, length, ch)


def to_heads(t, n_heads):
    bsz, length, width = t.shape
    return t.reshape(bsz, length, n_heads, width // n_heads).transpose(0, 2, 1, 3).astype(jnp.float32)


def gla_chunked(q, k, v, log_a, s0):
    bsz, nh, length, dk = q.shape
    dv = v.shape[-1]
    nc = length // GLA_CHUNK
    shp = (bsz, nh, nc, GLA_CHUNK)
    q, k, log_a = (t.reshape(shp + (dk,)) for t in (q, k, log_a))
    v = v.reshape(shp + (dv,))
    b = jnp.cumsum(log_a, axis=3)
    b_last = b[:, :, :, -1:, :]
    q_dec = q * jnp.exp(b)
    k_inv = k * jnp.exp(-b)
    mask = np.tril(np.ones((GLA_CHUNK, GLA_CHUNK), dtype=bool))
    scores = jnp.where(mask, jnp.einsum('bhnid,bhnjd->bhnij', q_dec, k_inv), 0.0)
    o_intra = jnp.einsum('bhnij,bhnjv->bhniv', scores, v)
    chunk_kv = jnp.einsum('bhnjd,bhnjv->bhndv', k * jnp.exp(b_last - b), v)
    chunk_decay = jnp.exp(b_last[:, :, :, 0, :])

    def step(state, inp):
        dec, kv = inp
        return dec[..., None] * state + kv, state

    s_final, s_in = lax.scan(step, s0, (jnp.moveaxis(chunk_decay, 2, 0), jnp.moveaxis(chunk_kv, 2, 0)))
    o_inter = jnp.einsum('bhnid,nbhdv->bhniv', q_dec, s_in)
    return (o_intra + o_inter).reshape(bsz, nh, length, dv), s_final


def gla_bidir(q, k, v, la_f, la_b, s0_f, s0_b):
    o_f, s_f = gla_chunked(q, k, v, la_f, s0_f)
    rev = lambda t: jnp.flip(t, axis=2)
    o_b, s_b = gla_chunked(rev(q), rev(k), rev(v), rev(la_b), s0_b)
    return o_f + rev(o_b), s_f, s_b


def gla_branch(cols, w_gf, b_gf, w_gb, b_gb, g_out, s0_f, s0_b):
    q, k, v, g, z_f, z_b = cols[:6]

    def decay(z, w, b):
        return to_heads(jax.nn.log_sigmoid((z @ w + b).astype(jnp.float32)) / GLA_GATE_NORM, GLA_HEADS)

    o, s_f, s_b = gla_bidir(to_heads(q, GLA_HEADS) * GLA_DK ** -0.5, to_heads(k, GLA_HEADS),
                            to_heads(v, GLA_HEADS), decay(z_f, w_gf, b_gf), decay(z_b, w_gb, b_gb),
                            s0_f, s0_b)
    o = o * lax.rsqrt(jnp.mean(o * o, axis=-1, keepdims=True) + NORM_EPS)
    bsz, nh, length, dv = o.shape
    o = o.transpose(0, 2, 1, 3).reshape(bsz, length, nh * dv) * g_out.astype(jnp.float32)
    return (o * jax.nn.silu(g.astype(jnp.float32))).astype(g.dtype), s_f, s_b


def local_branches(cols, conf_w, conf_b, conf_g, conf_beta, sc_w, pool_w, pool_scale, conv_fn, mean_fn):
    conf_in, sc_b, sc_c, sc_x, pool_in = cols[6:]
    a, gate = jnp.split(conf_in, 2, axis=-1)
    u = conv_fn(a * jax.nn.sigmoid(gate), conf_w) + conf_b
    y_conf = jax.nn.silu(layer_norm(u, conf_g, conf_beta))
    y_sc = sc_b * conv_fn(sc_c * sc_x, sc_w)
    diffs = []
    for i, win in enumerate(POOL_WINDOWS):
        hg = pool_in[..., i * POOL_GW:(i + 1) * POOL_GW]
        diffs.append(mean_fn(hg, win) - hg)
    y_pool = jnp.einsum('blgc,gcd->blgd', jnp.stack(diffs, axis=-2), pool_w).reshape(pool_in.shape) * pool_scale
    return jnp.concatenate([y_conf, y_sc, y_pool], axis=-1)


def grouped_experts(h, eid, gate, w_in, w_out):
    n, d = h.shape
    a = eid.shape[0]
    tok = jnp.arange(a) // TOP_K_INNER
    order = jnp.argsort(eid)
    e_s, tok_s, g_s = eid[order], tok[order], gate[order]
    counts = jnp.zeros((N_EXPERTS,), jnp.int32).at[eid].add(1)
    starts = jnp.cumsum(counts) - counts
    padded = (counts + MOE_BLOCK - 1) // MOE_BLOCK * MOE_BLOCK
    pad_end = jnp.cumsum(padded)
    pad_start = pad_end - padded
    dest = pad_start[e_s] + jnp.arange(a) - starts[e_s]
    n_blocks = -(-a // MOE_BLOCK) + N_EXPERTS
    slots = n_blocks * MOE_BLOCK
    slot_tok = jnp.zeros((slots,), jnp.int32).at[dest].set(tok_s)
    slot_gate = jnp.zeros((slots,), gate.dtype).at[dest].set(g_s)
    blk_expert = jnp.minimum(jnp.searchsorted(pad_end, jnp.arange(n_blocks) * MOE_BLOCK, side='right'),
                             N_EXPERTS - 1)

    def run_block(args):
        e, toks = args
        xb = h[toks]
        gt, up = jnp.split(xb @ w_in[e], 2, axis=-1)
        return (jax.nn.silu(gt) * up) @ w_out[e]

    y = lax.map(run_block, (blk_expert, slot_tok.reshape(n_blocks, MOE_BLOCK)))
    y = y.reshape(slots, d) * slot_gate[:, None].astype(y.dtype)
    return jax.ops.segment_sum(y, slot_tok, num_segments=n)


def hier_moe(h, w_rg, b_rg, w_re, b_re, w_e_in, w_e_out):
    n = h.shape[0]
    rows = jnp.arange(n)
    lg = (h @ w_rg + b_rg).astype(jnp.float32)
    grp = jnp.argmax(lg, axis=-1)
    p_grp = jax.nn.softmax(lg, axis=-1)[rows, grp][:, None]
    le = (h @ w_re + b_re).astype(jnp.float32).reshape(n, N_GROUPS, EXPERTS_PER_GROUP)
    top_v, top_i = lax.top_k(le[rows, grp], TOP_K_INNER)
    w = jax.nn.softmax(top_v, axis=-1) * p_grp
    eid = grp[:, None] * EXPERTS_PER_GROUP + top_i
    return grouped_experts(h, eid.reshape(-1), w.reshape(-1), w_e_in, w_e_out)


def setup_inputs(seed: int = 0) -> dict:
    key = jax.random.key(seed)
    keys = iter(jax.random.split(key, 32))

    def rnd(shape, scale):
        return jax.random.normal(next(keys), shape, jnp.float32) * scale

    L, D = DEPTH, D_MODEL
    return {
        'x': rnd((BATCH, SEQ, D), 1.0),
        'c': rnd((BATCH, D), 1.0),
        'ctx': rnd((BATCH, CTX_LEN, D), 1.0),
        'c_ctx': rnd((D,), 1.0),
        'w_mod': rnd((L, D, 6 * D), 0.5 * D ** -0.5),
        'b_mod': rnd((L, 6 * D), 0.02),
        'g_norm1': 1.0 + rnd((L, D), 0.05),
        'g_norm2': 1.0 + rnd((L, D), 0.05),
        'w_in': rnd((L, D, N_IN), D ** -0.5),
        'gla_w_gate_f': rnd((L, GLA_GATE_RANK, GLA_QK_W), GLA_GATE_RANK ** -0.5),
        'gla_b_gate_f': rnd((L, GLA_QK_W), 0.1),
        'gla_w_gate_b': rnd((L, GLA_GATE_RANK, GLA_QK_W), GLA_GATE_RANK ** -0.5),
        'gla_b_gate_b': rnd((L, GLA_QK_W), 0.1),
        'gla_g_out': 1.0 + rnd((L, GROUP_W), 0.05),
        'conf_w_dw': rnd((L, CONF_WIDTH, GROUP_W), CONF_WIDTH ** -0.5),
        'conf_b_dw': rnd((L, GROUP_W), 0.02),
        'conf_ln_g': 1.0 + rnd((L, GROUP_W), 0.05),
        'conf_ln_b': rnd((L, GROUP_W), 0.02),
        'sc_w_dw': rnd((L, SC_WIDTH, GROUP_W), SC_WIDTH ** -0.5),
        'pool_w': rnd((L, POOL_GROUPS, POOL_GW, POOL_GW), POOL_GW ** -0.5),
        'pool_scale': 1.0 + rnd((L, GROUP_W), 0.1),
        'w_out': rnd((L, D_MIX, D), D_MIX ** -0.5),
        'router_w_group': rnd((L, D, N_GROUPS), D ** -0.5),
        'router_b_group': rnd((L, N_GROUPS), 0.01),
        'router_w_expert': rnd((L, D, N_EXPERTS), D ** -0.5),
        'router_b_expert': rnd((L, N_EXPERTS), 0.01),
        'expert_w_in': rnd((L, N_EXPERTS, D, 2 * D_EXPERT), D ** -0.5),
        'expert_w_out': rnd((L, N_EXPERTS, D_EXPERT, D), D_EXPERT ** -0.5),
        'g_final': 1.0 + rnd((D,), 0.05),
    }


def reference(x, c, ctx, c_ctx, w_mod, b_mod, g_norm1, g_norm2, w_in, gla_w_gate_f, gla_b_gate_f,
              gla_w_gate_b, gla_b_gate_b, gla_g_out, conf_w_dw, conf_b_dw, conf_ln_g, conf_ln_b,
              sc_w_dw, pool_w, pool_scale, w_out, router_w_group, router_b_group, router_w_expert,
              router_b_expert, expert_w_in, expert_w_out, g_final):
    bsz, seq, d = x.shape
    n_lat = bsz * seq
    s0 = jnp.zeros((bsz, GLA_HEADS, GLA_DK, GLA_DV), jnp.float32)
    for l in range(DEPTH):
        last = l == DEPTH - 1
        sh1, sc1, ga1, sh2, sc2, ga2 = adaln(c, w_mod[l], b_mod[l])
        csh1, csc1, cga1, csh2, csc2, cga2 = adaln(c_ctx, w_mod[l], b_mod[l])
        gla_p = (gla_w_gate_f[l], gla_b_gate_f[l], gla_w_gate_b[l], gla_b_gate_b[l], gla_g_out[l])
        loc_p = (conf_w_dw[l], conf_b_dw[l], conf_ln_g[l], conf_ln_b[l], sc_w_dw[l], pool_w[l], pool_scale[l])
        moe_p = (router_w_group[l], router_b_group[l], router_w_expert[l], router_b_expert[l],
                 expert_w_in[l], expert_w_out[l])

        cols_c = split_columns(modulate(rms_norm(ctx, g_norm1[l]), csh1, csc1) @ w_in[l])
        cols_x = split_columns(modulate(rms_norm(x, g_norm1[l]), sh1, sc1) @ w_in[l])
        y_gla_c, s_f, s_b = gla_branch(cols_c, *gla_p, s0, s0)
        y_gla_x, _, _ = gla_branch(cols_x, *gla_p, s_f, s_b)
        y_loc_x = local_branches(cols_x, *loc_p, axial_dwconv, row_mean)
        x = x + ga1 * (jnp.concatenate([y_gla_x, y_loc_x], axis=-1) @ w_out[l])
        if not last:
            y_loc_c = local_branches(cols_c, *loc_p, dwconv, centred_mean)
            ctx = ctx + cga1 * (jnp.concatenate([y_gla_c, y_loc_c], axis=-1) @ w_out[l])

        m_x = modulate(rms_norm(x, g_norm2[l]), sh2, sc2).reshape(n_lat, d)
        if last:
            x = x + ga2 * hier_moe(m_x, *moe_p).reshape(bsz, seq, d)
        else:
            m_c = modulate(rms_norm(ctx, g_norm2[l]), csh2, csc2).reshape(-1, d)
            y = hier_moe(jnp.concatenate([m_x, m_c], axis=0), *moe_p)
            x = x + ga2 * y[:n_lat].reshape(bsz, seq, d)
            ctx = ctx + cga2 * y[n_lat:].reshape(ctx.shape)
    return rms_norm(x, g_final)
```

```cpp
#include <hip/hip_runtime.h>
#include <hip/hip_cooperative_groups.h>
#include <cstdio>
namespace cg = cooperative_groups;

#ifndef MK_MULTI
#define MK_MULTI 0
#endif

#define LAS __attribute__((address_space(3)))
typedef unsigned short bf16_t;
typedef short bf16x8 __attribute__((ext_vector_type(8)));
typedef float f32x4 __attribute__((ext_vector_type(4)));
typedef float f32x2 __attribute__((ext_vector_type(2)));
typedef unsigned u32x4 __attribute__((ext_vector_type(4)));
typedef unsigned u32x2 __attribute__((ext_vector_type(2)));
typedef int i32x4 __attribute__((ext_vector_type(4)));

constexpr int D = 1024, NLAT = 32768, SEQ = 8192, NCTXT = 1024, CTXL = 256, MTOT = NLAT + NCTXT;
constexpr int NIN = 2336, NINP = 2560;
constexpr int NCHUNK = MTOT / 64, NSEQ = 132;
constexpr int NEXP = 32, DEXP = 512, SLOTS = 75776;
constexpr float EPS = 1e-6f;
constexpr int C_Q = 0, C_K = 128, C_V = 256, C_G = 512, C_ZF = 768, C_ZB = 784, C_CA = 800, C_CG = 1056, C_SB = 1312, C_SC = 1568, C_SX = 1824, C_PL = 2080;

constexpr size_t MiB = 1u << 20;
constexpr size_t WS_CTL = 0, CTL_BYTES = 1 * MiB;
constexpr size_t WS_MOD = 1 * MiB;
constexpr size_t WS_WIN = 2 * MiB;
constexpr size_t WS_WOUT = 12 * MiB;
constexpr size_t WS_WEIN = 16 * MiB;
constexpr size_t WS_WEOUT = 144 * MiB;
constexpr size_t WS_XCTX = 208 * MiB;
constexpr size_t WS_H = 212 * MiB;
constexpr size_t WS_COLS = 278 * MiB;
constexpr size_t WS_MIX = 443 * MiB;
constexpr size_t WS_KV = 509 * MiB;
constexpr size_t WS_DEC = 542 * MiB;
constexpr size_t WS_AGV = 543 * MiB;
constexpr size_t WS_CXV = 559 * MiB;
constexpr size_t WS_UV = 575 * MiB;
constexpr size_t WS_SCV = 591 * MiB;
constexpr size_t WS_TOKINFO = 607 * MiB;
constexpr size_t WS_TOKLIST = 608 * MiB;
constexpr size_t WS_ACT = 613 * MiB;
constexpr size_t WS_Y = 687 * MiB;
constexpr size_t WS_END = 835 * MiB;
constexpr int CW_CNT = 1024;
constexpr int CW_BAR = 8192;

constexpr int LDS_BYTES = 147456;
constexpr int MISC_OFF = 131072;

__device__ __forceinline__ unsigned pk2(float lo, float hi) { unsigned r; asm("v_cvt_pk_bf16_f32 %0, %1, %2" : "=v"(r) : "v"(lo), "v"(hi)); return r; }
__device__ __forceinline__ float bflo(unsigned w) { return __uint_as_float(w << 16); }
__device__ __forceinline__ float bfhi(unsigned w) { return __uint_as_float(w & 0xffff0000u); }
__device__ __forceinline__ void unpack8(const u32x4 w, float (&f)[8]) { f[0] = bflo(w.x); f[1] = bfhi(w.x); f[2] = bflo(w.y); f[3] = bfhi(w.y); f[4] = bflo(w.z); f[5] = bfhi(w.z); f[6] = bflo(w.w); f[7] = bfhi(w.w); }
__device__ __forceinline__ float sigmoidf_(float x) { return 1.0f / (1.0f + __expf(-x)); }
__device__ __forceinline__ float siluf_(float x) { return x / (1.0f + __expf(-x)); }
__device__ __forceinline__ float logsigf_(float x) { return fminf(x, 0.0f) - log1pf(__expf(-fabsf(x))); }
__device__ __forceinline__ float wave_sum(float v) {
#pragma unroll
    for (int o = 1; o < 64; o <<= 1) v += __shfl_xor(v, o);
    return v;
}
#define LDS_WAIT() asm volatile("s_waitcnt lgkmcnt(0)" ::: "memory")
__device__ __forceinline__ int tid_now() { int t = threadIdx.x; asm volatile("" : "+v"(t)); return t; }

namespace g8 {
constexpr int BM = 256, BK = 64, HALF = 128, HTB = HALF * BK * 2, NXCD = 8, WGM = 8;
__device__ __forceinline__ int lds_byte(int r, int c) { const int st = (r >> 4) * 2 + (c >> 5), rr = r & 15, cc = c & 31, ob = rr * 64 + cc * 2; return st * 1024 + (ob ^ (((ob >> 9) & 1) << 5)); }
__device__ __forceinline__ void stage_rc(int b, int& R, int& C) { const int st = b / 1024, sb = b % 1024, swz = sb ^ (((sb >> 9) & 1) << 5); R = (st >> 1) * 16 + swz / 64; C = (st & 1) * 32 + (swz % 64) / 2; }
__device__ __forceinline__ int perm32(int rho) { const int n = rho >> 4, i = rho & 15; return 8 * (i >> 2) + 4 * n + (i & 3); }

struct Unit { int pm, pn, e, mt; };

struct DenseSched {
    const char* A; const char* Bt; int K, nM, nN, nwg, G, c;
    __device__ __forceinline__ void init(const void* A_, const void* Bt_, int M, int N, int K_, int G_, int c_) { A = (const char*)A_; Bt = (const char*)Bt_; K = K_; nM = M / BM; nN = N / BM; nwg = nM * nN; G = G_; c = c_; }
    __device__ __forceinline__ bool next(int i, Unit& u) const {
        const long L = (long)i * G + c; if (L >= nwg) return false;
        int wgid = (int)L; { const int q = nwg / NXCD, r = nwg % NXCD, xcd = wgid % NXCD, off = wgid / NXCD; wgid = (xcd < r ? xcd * (q + 1) : r * (q + 1) + (xcd - r) * q) + off; }
        const int nig = WGM * nN, gid = wgid / nig, fm = gid * WGM, gsz = (nM - fm) < WGM ? (nM - fm) : WGM;
        u.pm = fm + ((wgid % nig) % gsz); u.pn = (wgid % nig) / gsz; u.e = 0; u.mt = 0; return true;
    }
    __device__ __forceinline__ unsigned a_off(const Unit& u, int h, int R, int C) const { return (unsigned)(((u.pm * BM + h * HALF + R) * K + C) * 2); }
    __device__ __forceinline__ const char* b_ptr(const Unit& u) const { return Bt + (size_t)u.pn * BM * K * 2; }
};
template <bool GATHER> struct MoeSched {
    const char* A; const char* Bw; size_t wstride; int K, T, G, c; const LAS int* tile_e; const LAS int* tile_mt; const LAS int* cnt; const int* toklist;
    __device__ __forceinline__ bool next(int i, Unit& u) const {
        const int L = i * G + c; if (L >= 4 * T) return false;
        u.pm = L >> 2; u.pn = L & 3; u.e = __builtin_amdgcn_readfirstlane(tile_e[u.pm]); u.mt = __builtin_amdgcn_readfirstlane(tile_mt[u.pm]); return true;
    }
    __device__ __forceinline__ unsigned a_off(const Unit& u, int h, int R, int C) const {
        if (GATHER) { const int pos = u.mt * BM + h * HALF + R; int tok = 0; if (pos < cnt[u.e]) tok = toklist[u.e * MTOT + pos]; return (unsigned)((tok * K + C) * 2); }
        return (unsigned)(((u.pm * BM + h * HALF + R) * K + C) * 2);
    }
    __device__ __forceinline__ const char* b_ptr(const Unit& u) const { return Bw + (size_t)u.e * wstride + (size_t)u.pn * BM * K * 2; }
};

struct EpiBf16 {
    static constexpr bool PERM = true;
    bf16_t* O; int ldc;
    __device__ __forceinline__ void operator()(const f32x4 (&acc)[2][2][4][2], const Unit& u, int wr, int wc, int fr, int fq) const {
        const int row0 = u.pm * BM + wr * 64 + fr, col0 = u.pn * BM + wc * 32 + 8 * fq;
#pragma unroll
        for (int ai = 0; ai < 2; ++ai)
#pragma unroll
            for (int m = 0; m < 4; ++m) { bf16_t* rowp = O + (size_t)(row0 + ai * HALF + m * 16) * ldc + col0;
#pragma unroll
                for (int bj = 0; bj < 2; ++bj) { const f32x4 v0 = acc[ai][bj][m][0], v1 = acc[ai][bj][m][1];
                    u32x4 w; w.x = pk2(v0[0], v0[1]); w.y = pk2(v0[2], v0[3]); w.z = pk2(v1[0], v1[1]); w.w = pk2(v1[2], v1[3]);
                    *(u32x4*)(rowp + bj * HALF) = w; } }
    }
};
struct EpiSwiGLU {
    static constexpr bool PERM = true;
    bf16_t* O;
    __device__ __forceinline__ void operator()(const f32x4 (&acc)[2][2][4][2], const Unit& u, int wr, int wc, int fr, int fq) const {
        const int row0 = u.pm * BM + wr * 64 + fr, col0 = u.pn * HALF + wc * 32 + 8 * fq;
#pragma unroll
        for (int ai = 0; ai < 2; ++ai)
#pragma unroll
            for (int m = 0; m < 4; ++m) { bf16_t* rowp = O + (size_t)(row0 + ai * HALF + m * 16) * DEXP + col0;
                const f32x4 g0 = acc[ai][0][m][0], g1 = acc[ai][0][m][1], u0 = acc[ai][1][m][0], u1 = acc[ai][1][m][1];
                u32x4 w; w.x = pk2(siluf_(g0[0]) * u0[0], siluf_(g0[1]) * u0[1]); w.y = pk2(siluf_(g0[2]) * u0[2], siluf_(g0[3]) * u0[3]);
                w.z = pk2(siluf_(g1[0]) * u1[0], siluf_(g1[1]) * u1[1]); w.w = pk2(siluf_(g1[2]) * u1[2], siluf_(g1[3]) * u1[3]);
                *(u32x4*)rowp = w; }
    }
};
struct EpiRes {
    static constexpr bool PERM = false;
    const float* src_lat; const float* src_ctx; float* dst_lat; float* dst_ctx; const float* ga;
    __device__ __forceinline__ void operator()(const f32x4 (&acc)[2][2][4][2], const Unit& u, int wr, int wc, int fr, int fq) const {
        const bool lat = u.pm < (NLAT / BM);
        const int b = lat ? (u.pm >> 5) : 4;
        const int lrow0 = (lat ? u.pm * BM : (u.pm * BM - NLAT)) + wr * 64 + fr, col0 = u.pn * BM + wc * 32 + 4 * fq;
        const float* src = lat ? src_lat : src_ctx; float* dst = lat ? dst_lat : dst_ctx;
        const float* gp = ga + b * 6144 + col0;
        f32x4 gv[2][2];
#pragma unroll
        for (int bj = 0; bj < 2; ++bj)
#pragma unroll
            for (int n = 0; n < 2; ++n) gv[bj][n] = *(const f32x4*)(gp + bj * HALF + n * 16);
#pragma unroll
        for (int ai = 0; ai < 2; ++ai)
#pragma unroll
            for (int m = 0; m < 4; ++m) { const size_t off = (size_t)(lrow0 + ai * HALF + m * 16) * D + col0;
#pragma unroll
                for (int bj = 0; bj < 2; ++bj)
#pragma unroll
                    for (int n = 0; n < 2; ++n) { const f32x4 s = *(const f32x4*)(src + off + bj * HALF + n * 16);
                        *(f32x4*)(dst + off + bj * HALF + n * 16) = s + gv[bj][n] * acc[ai][bj][m][n]; }
                asm volatile("" ::: "memory"); }
    }
};

template <class Epi, class Sched>
__device__ __forceinline__ void gemm_phase(LAS unsigned char* lds, const Sched& S, const Epi& E) {
    const int tid = tid_now(), wid = __builtin_amdgcn_readfirstlane(tid >> 6), lane = tid & 63, wr = wid >> 2, wc = wid & 3, fr = lane & 15, fq = lane >> 4;
    const int K = S.K, nt = K / BK;
    unsigned voffB[2];
#pragma unroll
    for (int i = 0; i < 2; ++i) { int R, C; stage_rc(tid * 16 + i * 8192, R, C); const int Rb = Epi::PERM ? ((R & ~31) + perm32(R & 31)) : R; voffB[i] = (unsigned)(Rb * K + C) * 2u; }
    const size_t kstep = (size_t)(BK * 2);
    const size_t hstep = (size_t)HALF * K * 2;
    const unsigned ldsw = (unsigned)wid * 1024u;
    const int aoff = lds_byte(wr * 64 + fr, fq * 8), boff = lds_byte(wc * 32 + fr, fq * 8);
#define G8_SA(b, h) (((b) * 2 + (h)) * HTB)
#define G8_SB(b, h) ((4 + (b) * 2 + (h)) * HTB)
#define G8_STAGE(bufoff, gbase, voff) do { const unsigned long long _g = (unsigned long long)(gbase); \
        const char* _gb = (const char*)(((unsigned long long)(unsigned)__builtin_amdgcn_readfirstlane((int)(unsigned)(_g >> 32)) << 32) | (unsigned long long)(unsigned)__builtin_amdgcn_readfirstlane((int)(unsigned)_g)); \
        _Pragma("unroll") for (int _i = 0; _i < 2; ++_i) \
        __builtin_amdgcn_global_load_lds((const unsigned*)(_gb + (voff)[_i]), (LAS unsigned*)(lds + (bufoff) + ldsw + _i * 8192), 16, 0, 0); } while (0)
#define G8_LDA(dst, b, h) do { _Pragma("unroll") for (int m = 0; m < 4; ++m) _Pragma("unroll") for (int k = 0; k < 2; ++k) dst[m][k] = *(const LAS bf16x8*)(lds + G8_SA(b, h) + aoff + m * 2048 + k * 1024); } while (0)
#define G8_LDB(dst, b, h) do { _Pragma("unroll") for (int n = 0; n < 2; ++n) _Pragma("unroll") for (int k = 0; k < 2; ++k) dst[n][k] = *(const LAS bf16x8*)(lds + G8_SB(b, h) + boff + n * 2048 + k * 1024); } while (0)
#define G8_MMA(ai, bj, At, Bt) do { __builtin_amdgcn_s_setprio(1); _Pragma("unroll") for (int m = 0; m < 4; ++m) _Pragma("unroll") for (int n = 0; n < 2; ++n) _Pragma("unroll") for (int k = 0; k < 2; ++k) \
        acc[ai][bj][m][n] = __builtin_amdgcn_mfma_f32_16x16x32_bf16(Bt[n][k], At[m][k], acc[ai][bj][m][n], 0, 0, 0); __builtin_amdgcn_s_setprio(0); } while (0)
#define G8_WAIT_V(n) asm volatile("s_waitcnt vmcnt(" #n ")" ::: "memory")
#define G8_WAIT_L(n) asm volatile("s_waitcnt lgkmcnt(" #n ")" ::: "memory")
#define G8_BAR __builtin_amdgcn_s_barrier()
#define G8_SCHED __builtin_amdgcn_sched_barrier(0)
    Unit cur, nxt; int ui = 0;
    if (!S.next(0, cur)) return;
    f32x4 acc[2][2][4][2];
#pragma unroll
    for (int a = 0; a < 2; ++a)
#pragma unroll
        for (int b = 0; b < 2; ++b)
#pragma unroll
            for (int m = 0; m < 4; ++m)
#pragma unroll
                for (int n = 0; n < 2; ++n) acc[a][b][m][n] = (f32x4){0.f, 0.f, 0.f, 0.f};
    bf16x8 At[4][2], B0[2][2], B1[2][2];
    unsigned vA0[2], vA1[2];
#pragma unroll
    for (int i = 0; i < 2; ++i) { int R, C; stage_rc(tid * 16 + i * 8192, R, C); vA0[i] = S.a_off(cur, 0, R, C); vA1[i] = S.a_off(cur, 1, R, C); }
    const char* const Ab = S.A;
    const char* cB = S.b_ptr(cur);
    G8_STAGE(G8_SB(0, 0), cB, voffB); G8_STAGE(G8_SA(0, 0), Ab, vA0); G8_STAGE(G8_SB(0, 1), cB + hstep, voffB); G8_STAGE(G8_SA(0, 1), Ab, vA1);
    if (wr == 1) G8_BAR;
    G8_WAIT_V(4); G8_BAR;
    G8_STAGE(G8_SB(1, 0), cB + kstep, voffB); G8_STAGE(G8_SA(1, 0), Ab + kstep, vA0); G8_STAGE(G8_SB(1, 1), cB + hstep + kstep, voffB);
    G8_WAIT_V(6); G8_BAR;
    for (;;) {
        const bool has_next = S.next(ui + 1, nxt);
        const char* nB = has_next ? S.b_ptr(nxt) : cB;
        for (int t = 0; t < nt; t += 2) {
            const bool last = (t == nt - 2);
            const char* a1 = Ab + (size_t)(t + 1) * kstep;
            const char* a2 = last ? Ab : Ab + (size_t)(t + 2) * kstep; const char* b2 = last ? nB : cB + (size_t)(t + 2) * kstep;
            const char* a3 = a2 + kstep; const char* b3 = b2 + kstep;
            G8_LDB(B0, 0, 0); G8_SCHED; G8_LDA(At, 0, 0); G8_STAGE(G8_SA(1, 1), a1, vA1);
            G8_WAIT_L(8); G8_BAR; G8_WAIT_L(0); G8_MMA(0, 0, At, B0); G8_BAR; G8_SCHED;
            if (last && has_next) {
#pragma unroll
                for (int i = 0; i < 2; ++i) { int R, C; stage_rc(tid * 16 + i * 8192, R, C); vA0[i] = S.a_off(nxt, 0, R, C); vA1[i] = S.a_off(nxt, 1, R, C); }
            }
            G8_LDB(B1, 0, 1); G8_STAGE(G8_SB(0, 0), b2, voffB);
            G8_BAR; G8_WAIT_L(0); G8_MMA(0, 1, At, B1); G8_BAR;
            G8_LDA(At, 0, 1); G8_STAGE(G8_SA(0, 0), a2, vA0);
            G8_BAR; G8_WAIT_L(0); G8_MMA(1, 0, At, B0); G8_BAR; G8_SCHED;
            G8_STAGE(G8_SB(0, 1), b2 + hstep, voffB);
            G8_WAIT_V(6); G8_BAR; G8_MMA(1, 1, At, B1); G8_BAR;
            G8_LDB(B0, 1, 0); G8_SCHED; G8_LDA(At, 1, 0); G8_STAGE(G8_SA(0, 1), a2, vA1);
            G8_WAIT_L(8); G8_BAR; G8_WAIT_L(0); G8_MMA(0, 0, At, B0); G8_BAR; G8_SCHED;
            G8_LDB(B1, 1, 1); G8_STAGE(G8_SB(1, 0), b3, voffB);
            G8_BAR; G8_WAIT_L(0); G8_MMA(0, 1, At, B1); G8_BAR;
            G8_LDA(At, 1, 1); G8_STAGE(G8_SA(1, 0), a3, vA0);
            G8_BAR; G8_WAIT_L(0); G8_MMA(1, 0, At, B0); G8_BAR; G8_SCHED;
            G8_STAGE(G8_SB(1, 1), b3 + hstep, voffB);
            G8_WAIT_V(6); G8_BAR; G8_MMA(1, 1, At, B1); G8_BAR;
        }
        E(acc, cur, wr, wc, fr, fq);
        if (!has_next) break;
#pragma unroll
        for (int a = 0; a < 2; ++a)
#pragma unroll
            for (int b = 0; b < 2; ++b)
#pragma unroll
                for (int m = 0; m < 4; ++m)
#pragma unroll
                    for (int n = 0; n < 2; ++n) acc[a][b][m][n] = (f32x4){0.f, 0.f, 0.f, 0.f};
        cur = nxt; cB = nB; ++ui;
    }
    G8_WAIT_V(0);
    if (wr == 0) G8_BAR;
    G8_BAR;
#undef G8_SA
#undef G8_SB
#undef G8_STAGE
#undef G8_LDA
#undef G8_LDB
#undef G8_MMA
#undef G8_WAIT_V
#undef G8_WAIT_L
#undef G8_BAR
#undef G8_SCHED
}
}

struct Args { const float* in[29]; float* out; unsigned char* ws; int ph_lo, ph_hi; };
enum { I_X = 0, I_C, I_CTX, I_CCTX, I_WMOD, I_BMOD, I_G1, I_G2, I_WIN, I_GWF, I_GBF, I_GWB, I_GBB, I_GOUT, I_CONFW, I_CONFB, I_CONFG, I_CONFBETA, I_SCW, I_POOLW, I_POOLS, I_WOUT, I_RWG, I_RBG, I_RWE, I_RBE, I_EIN, I_EOUT, I_GFINAL };

__device__ __forceinline__ void transpose_item(const float* W, int K, int N, bf16_t* WT, int kb, int n0, int dst_row0, LAS float* scr, int lane) {
    const int k0 = 64 * kb;
#pragma unroll 8
    for (int i = 0; i < 32; ++i) { const int kk = 2 * i + (lane >> 5); scr[kk * 33 + (lane & 31)] = W[(size_t)(k0 + kk) * N + n0 + (lane & 31)]; }
    LDS_WAIT(); asm volatile("" ::: "memory");
    const int c = lane & 7;
#pragma unroll
    for (int j = 0; j < 4; ++j) { const int n = (lane >> 3) + 8 * j; const LAS float* s = scr + (8 * c) * 33 + n;
        u32x4 o; o.x = pk2(s[0 * 33], s[1 * 33]); o.y = pk2(s[2 * 33], s[3 * 33]); o.z = pk2(s[4 * 33], s[5 * 33]); o.w = pk2(s[6 * 33], s[7 * 33]);
        *(u32x4*)(WT + (size_t)(dst_row0 + n) * K + k0 + 8 * c) = o; }
    LDS_WAIT(); asm volatile("" ::: "memory");
}

__device__ __forceinline__ void phase_p0(const Args& a, LAS unsigned char* lds) {
    const int tid = tid_now(), lane = tid & 63, wid = __builtin_amdgcn_readfirstlane(tid >> 6);
    unsigned char* ws = a.ws;
    for (int job = blockIdx.x; job < 192; job += gridDim.x) {
        const int l = job / 96, n0 = (job % 96) * 64;
        LAS float* sv = (LAS float*)lds;
        LAS float* red = (LAS float*)(lds + 5 * 1024 * 4);
        for (int i = tid; i < 5 * 1024; i += 512) { const int r = i >> 10, k = i & 1023; const float v = r < 4 ? a.in[I_C][r * 1024 + k] : a.in[I_CCTX][k]; sv[i] = siluf_(v); }
        __syncthreads();
        const int ks = tid >> 6, col = tid & 63;
        const float* w = a.in[I_WMOD] + (size_t)l * 1024 * 6144 + (size_t)(ks * 128) * 6144 + n0 + col;
        float acc[5] = {0.f, 0.f, 0.f, 0.f, 0.f};
#pragma unroll 8
        for (int k = 0; k < 128; ++k) { const float wv = w[(size_t)k * 6144];
#pragma unroll
            for (int r = 0; r < 5; ++r) acc[r] += sv[r * 1024 + ks * 128 + k] * wv; }
#pragma unroll
        for (int r = 0; r < 5; ++r) red[(ks * 5 + r) * 64 + col] = acc[r];
        __syncthreads();
        if (tid < 320) { const int r = tid >> 6; float s = 0.f;
#pragma unroll
            for (int q = 0; q < 8; ++q) s += red[(q * 5 + r) * 64 + col];
            ((float*)(ws + WS_MOD))[(size_t)(l * 5 + r) * 6144 + n0 + col] = s + a.in[I_BMOD][l * 6144 + n0 + col]; }
        __syncthreads();
    }
    LAS float* scr = (LAS float*)(lds + wid * 16384);
    const int gw = blockIdx.x * 8 + wid, NGW = gridDim.x * 8;
    constexpr int I_IN = 16 * 73, I_OUT = 16 * 32, I_EI = 16 * 32, I_EO = 8 * 32;
    constexpr int N_IN = 2 * I_IN, N_OUT = 2 * I_OUT, N_EI = 64 * I_EI, N_EO = 64 * I_EO, NITEMS = N_IN + N_OUT + N_EI + N_EO;
    for (int it = gw; it < NITEMS; it += NGW) {
        int r = it;
        if (r < N_IN) { const int l = r / I_IN, q = r % I_IN, kb = q / 73, nb = q % 73;
            transpose_item(a.in[I_WIN] + (size_t)l * 1024 * NIN, 1024, NIN, (bf16_t*)(ws + WS_WIN) + (size_t)l * NINP * 1024, kb, nb * 32, nb * 32, scr, lane); continue; }
        r -= N_IN;
        if (r < N_OUT) { const int l = r / I_OUT, q = r % I_OUT, kb = q / 32, nb = q % 32;
            transpose_item(a.in[I_WOUT] + (size_t)l * 1024 * 1024, 1024, 1024, (bf16_t*)(ws + WS_WOUT) + (size_t)l * 1024 * 1024, kb, nb * 32, nb * 32, scr, lane); continue; }
        r -= N_OUT;
        if (r < N_EI) { const int le = r / I_EI, q = r % I_EI, kb = q / 32, nb = q % 32, n0 = nb * 32;
            const int dst = n0 < 512 ? (256 * (n0 >> 7) + (n0 & 127)) : (256 * ((n0 - 512) >> 7) + 128 + ((n0 - 512) & 127));
            transpose_item(a.in[I_EIN] + (size_t)le * 1024 * 1024, 1024, 1024, (bf16_t*)(ws + WS_WEIN) + (size_t)le * 1024 * 1024, kb, n0, dst, scr, lane); continue; }
        r -= N_EI;
        { const int le = r / I_EO, q = r % I_EO, kb = q / 32, nb = q % 32;
            transpose_item(a.in[I_EOUT] + (size_t)le * 512 * 1024, 512, 1024, (bf16_t*)(ws + WS_WEOUT) + (size_t)le * 1024 * 512, kb, nb * 32, nb * 32, scr, lane); }
    }
    for (int i = blockIdx.x * 512 + tid; i < 2 * 224 * 1024 / 8; i += gridDim.x * 512) { const int l = i / (224 * 128), q = i % (224 * 128);
        *(u32x4*)((bf16_t*)(ws + WS_WIN) + (size_t)l * NINP * 1024 + (size_t)NIN * 1024 + (size_t)q * 8) = (u32x4){0u, 0u, 0u, 0u}; }
}

__device__ __forceinline__ void load_row(const float* xrow, int lane, f32x4 (&v)[4]) {
    const f32x4* xr = (const f32x4*)xrow + lane;
#pragma unroll
    for (int j = 0; j < 4; ++j) v[j] = xr[64 * j];
}
__device__ __forceinline__ float row_rstd(const f32x4 (&v)[4]) {
    float s = 0.f;
#pragma unroll
    for (int j = 0; j < 4; ++j) s += (v[j].x * v[j].x + v[j].y * v[j].y) + (v[j].z * v[j].z + v[j].w * v[j].w);
    return rsqrtf(wave_sum(s) * (1.0f / D) + EPS);
}
__device__ __forceinline__ void norm_mod_store(f32x4 (&v)[4], float rstd, const float* g, const float* sc, const float* sh, bf16_t* hrow, int lane) {
#pragma unroll
    for (int j = 0; j < 4; ++j) { const f32x4 gv = *((const f32x4*)g + lane + 64 * j), scv = *((const f32x4*)sc + lane + 64 * j), shv = *((const f32x4*)sh + lane + 64 * j);
        v[j] = (v[j] * rstd * gv) * (1.0f + scv) + shv;
        u32x2 w; w.x = pk2(v[j].x, v[j].y); w.y = pk2(v[j].z, v[j].w);
        *((u32x2*)hrow + lane + 64 * j) = w; }
}

__device__ __forceinline__ void phase_norm1_l0(const Args& a) {
    const int lane = tid_now() & 63, wid = tid_now() >> 6, gw = blockIdx.x * 8 + wid, NGW = gridDim.x * 8;
    const float* MOD = (const float*)(a.ws + WS_MOD); bf16_t* H = (bf16_t*)(a.ws + WS_H);
    for (int m = gw; m < MTOT; m += NGW) {
        const float* src = m < NLAT ? a.in[I_X] + (size_t)m * D : a.in[I_CTX] + (size_t)(m - NLAT) * D;
        const int b = m < NLAT ? (m >> 13) : 4;
        f32x4 v[4]; load_row(src, lane, v); const float rstd = row_rstd(v);
        const float* mod = MOD + (size_t)b * 6144;
        norm_mod_store(v, rstd, a.in[I_G1], mod + 1024, mod, H + (size_t)m * D, lane);
    }
}

struct ChunkPos { int b, sf, sb; };
__device__ __forceinline__ ChunkPos chunk_pos(int chunk) {
    ChunkPos p;
    if (chunk < 512) { p.b = chunk >> 7; const int n = chunk & 127; p.sf = 4 + n; p.sb = 4 + 127 - n; }
    else { const int cc = chunk - 512; p.b = cc >> 2; const int n = cc & 3; p.sf = n; p.sb = 3 - n; }
    return p;
}

__device__ __forceinline__ void gla_gates(const Args& a, int l, int h, const bf16_t* cols0, LAS float* Z, LAS float* WG, LAS float* LA) {
    const int tid = tid_now();
    if (tid < 256) { const int t = tid >> 2, seg = tid & 3; const u32x4 w = *(const u32x4*)(cols0 + (size_t)t * NINP + C_ZF + seg * 8); float f[8]; unpack8(w, f);
#pragma unroll
        for (int i = 0; i < 8; ++i) Z[t * 32 + seg * 8 + i] = f[i]; }
    else { const int q = tid - 256;
        const int dir = q >> 7, rr = (q >> 3) & 15, d4 = (q & 7) * 4; const float* wsrc = a.in[dir ? I_GWB : I_GWF] + (size_t)l * 16 * 128 + rr * 128 + 32 * h + d4;
#pragma unroll
        for (int i = 0; i < 4; ++i) WG[(dir * 16 + rr) * 32 + d4 + i] = wsrc[i];
        if (q < 64) { const int dd = q >> 5, d = q & 31; WG[1024 + dd * 32 + d] = a.in[dd ? I_GBB : I_GBF][l * 128 + 32 * h + d]; } }
    __syncthreads();
    { const int dir = tid >> 8, t = (tid >> 2) & 63, d0 = (tid & 3) * 8;
        float s[8];
#pragma unroll
        for (int i = 0; i < 8; ++i) s[i] = WG[1024 + dir * 32 + d0 + i];
#pragma unroll
        for (int r = 0; r < 16; ++r) { const float zv = Z[t * 32 + dir * 16 + r];
#pragma unroll
            for (int i = 0; i < 8; ++i) s[i] += zv * WG[(dir * 16 + r) * 32 + d0 + i]; }
#pragma unroll
        for (int i = 0; i < 8; ++i) LA[(dir * 64 + t) * 32 + d0 + i] = logsigf_(s[i]) * (1.0f / 16.0f); }
    __syncthreads();
}

__device__ __forceinline__ void phase_chunk(const Args& a, int l, LAS unsigned char* lds) {
    const int tid = tid_now();
    const bf16_t* COLS = (const bf16_t*)(a.ws + WS_COLS);
    float* KV = (float*)(a.ws + WS_KV); float* DEC = (float*)(a.ws + WS_DEC);
    LAS float* Kt = (LAS float*)lds;
    LAS float* Vt = Kt + 2048;
    LAS float* Z = Vt + 4096;
    LAS float* WG = Z + 2048;
    LAS float* LA = WG + 1088;
    for (int it = blockIdx.x; it < NCHUNK * 5; it += gridDim.x) {
        const int chunk = it / 5, part = it % 5; const int row0 = chunk * 64;
        if (part == 4) {
            if (chunk < 512) {
                float* AGV = (float*)(a.ws + WS_AGV); float* CXV = (float*)(a.ws + WS_CXV);
#pragma unroll
                for (int rep = 0; rep < 2; ++rep) { const int idx = tid + rep * 512, t = idx >> 4, c8 = (idx & 15) * 8; const bf16_t* rp = COLS + (size_t)(row0 + t) * NINP;
                    float fa[8], fg[8], fc[8], fx[8];
                    unpack8(*(const u32x4*)(rp + C_CA + 128 + c8), fa); unpack8(*(const u32x4*)(rp + C_CG + 128 + c8), fg);
                    unpack8(*(const u32x4*)(rp + C_SC + 128 + c8), fc); unpack8(*(const u32x4*)(rp + C_SX + 128 + c8), fx);
                    f32x4 o0, o1, p0, p1;
#pragma unroll
                    for (int i = 0; i < 4; ++i) { o0[i] = fa[i] * sigmoidf_(fg[i]); o1[i] = fa[4 + i] * sigmoidf_(fg[4 + i]); p0[i] = fc[i] * fx[i]; p1[i] = fc[4 + i] * fx[4 + i]; }
                    float* ao = AGV + (size_t)(row0 + t) * 128 + c8; float* co = CXV + (size_t)(row0 + t) * 128 + c8;
                    *(f32x4*)ao = o0; *(f32x4*)(ao + 4) = o1; *(f32x4*)co = p0; *(f32x4*)(co + 4) = p1; }
            }
            continue;
        }
        const int h = part; const ChunkPos cp = chunk_pos(chunk);
        const bf16_t* cols0 = COLS + (size_t)row0 * NINP;
        if (tid < 256) { const int t = tid >> 2, seg = tid & 3; float f[8]; unpack8(*(const u32x4*)(cols0 + (size_t)t * NINP + C_K + 32 * h + seg * 8), f);
#pragma unroll
            for (int i = 0; i < 8; ++i) Kt[t * 32 + seg * 8 + i] = f[i]; }
        { const int t = tid >> 3, seg = tid & 7; float f[8]; unpack8(*(const u32x4*)(cols0 + (size_t)t * NINP + C_V + 64 * h + seg * 8), f);
#pragma unroll
            for (int i = 0; i < 8; ++i) Vt[t * 64 + seg * 8 + i] = f[i]; }
        gla_gates(a, l, h, cols0, Z, WG, LA);
        if (tid < 64) { const int dir = tid >> 5, d = tid & 31; LAS float* p = LA + dir * 2048 + d;
            if (dir == 0) { float tot = 0.f; for (int t = 0; t < 64; ++t) tot += p[t * 32];
                float run = 0.f; for (int t = 0; t < 64; ++t) { run += p[t * 32]; p[t * 32] = __expf(tot - run); }
                DEC[((size_t)((0 * 4 + cp.b) * 4 + h) * NSEQ + cp.sf) * 32 + d] = __expf(tot); }
            else { float run = 0.f; for (int t = 0; t < 64; ++t) { const float la = p[t * 32]; p[t * 32] = __expf(run); run += la; }
                DEC[((size_t)((1 * 4 + cp.b) * 4 + h) * NSEQ + cp.sb) * 32 + d] = __expf(run); } }
        __syncthreads();
        { const int dir = tid >> 8, d = (tid >> 3) & 31, cg8 = (tid & 7) * 8;
            float o[8] = {0.f, 0.f, 0.f, 0.f, 0.f, 0.f, 0.f, 0.f};
            for (int t = 0; t < 64; ++t) { const float kd = Kt[t * 32 + d] * LA[(dir * 64 + t) * 32 + d]; const f32x4 v0 = *(const LAS f32x4*)(Vt + t * 64 + cg8), v1 = *(const LAS f32x4*)(Vt + t * 64 + cg8 + 4);
#pragma unroll
                for (int i = 0; i < 4; ++i) { o[i] += kd * v0[i]; o[4 + i] += kd * v1[i]; } }
            float* dst = KV + ((size_t)((dir * 4 + cp.b) * 4 + h) * NSEQ + (dir ? cp.sb : cp.sf)) * 2048 + d * 64 + cg8;
            *(f32x4*)dst = (f32x4){o[0], o[1], o[2], o[3]}; *(f32x4*)(dst + 4) = (f32x4){o[4], o[5], o[6], o[7]}; }
        __syncthreads();
    }
}

template <int TAPS>
__device__ __forceinline__ void vconv_item(const float* SRC, float* DST, const float* w  , int b, int col, int chg, LAS float* buf, int lane) {
    const int ch = lane & 31, rh = lane >> 5;
    const size_t base = ((size_t)b * SEQ + col) * 128 + chg * 32 + ch;
#pragma unroll 8
    for (int r = 0; r < 128; r += 2) buf[(r + rh) * 32 + ch] = SRC[base + (size_t)(r + rh) * 64 * 128];
    float wt[TAPS];
#pragma unroll
    for (int j = 0; j < TAPS; ++j) wt[j] = w[j * 256 + chg * 32 + ch];
    LDS_WAIT(); asm volatile("" ::: "memory");
    constexpr int HW = TAPS / 2;
#pragma unroll 1
    for (int r0 = 0; r0 < 64; r0 += 8) {
        const int rb = rh * 64 + r0;
        float o[8] = {0.f, 0.f, 0.f, 0.f, 0.f, 0.f, 0.f, 0.f};
#pragma unroll
        for (int j = 0; j < TAPS + 7; ++j) { const int rin = rb - HW + j; const float x = (rin >= 0 && rin < 128) ? buf[rin * 32 + ch] : 0.f;
#pragma unroll
            for (int q = 0; q < 8; ++q) { if (j - q >= 0 && j - q < TAPS) o[q] += x * wt[j - q]; } }
#pragma unroll
        for (int q = 0; q < 8; ++q) DST[base + (size_t)(rb + q) * 64 * 128] = o[q];
    }
    LDS_WAIT(); asm volatile("" ::: "memory");
}
__device__ __forceinline__ void phase_scan(const Args& a, int l, LAS unsigned char* lds) {
    const int tid = tid_now(), lane = tid & 63, wid = __builtin_amdgcn_readfirstlane(tid >> 6);
    float* KV = (float*)(a.ws + WS_KV); const float* DEC = (const float*)(a.ws + WS_DEC);
    if (tid < 256) {
        for (int gid = blockIdx.x * 256 + tid; gid < 65536; gid += gridDim.x * 256) {
            const int e = gid >> 11, dc = gid & 2047;
            float* p = KV + (size_t)e * NSEQ * 2048 + dc; const float* dp = DEC + (size_t)e * NSEQ * 32 + (dc >> 6);
            float st = 0.f;
            for (int s = 0; s < NSEQ; s += 4) {
                float kv[4], dd[4];
#pragma unroll
                for (int q = 0; q < 4; ++q) { kv[q] = p[(size_t)(s + q) * 2048]; dd[q] = dp[(s + q) * 32]; }
#pragma unroll
                for (int q = 0; q < 4; ++q) { p[(size_t)(s + q) * 2048] = st; st = dd[q] * st + kv[q]; }
            }
        }
    }
    LAS float* buf = (LAS float*)(lds + wid * 16384);
    const int gw = blockIdx.x * 8 + wid, NGW = gridDim.x * 8;
    for (int it = gw; it < 2048; it += NGW) {
        const int kind = it >> 10, q = it & 1023, b = q >> 8, col = (q >> 2) & 63, chg = q & 3;
        if (kind == 0) vconv_item<31>((const float*)(a.ws + WS_AGV), (float*)(a.ws + WS_UV), a.in[I_CONFW] + (size_t)l * 31 * 256 + 128, b, col, chg, buf, lane);
        else vconv_item<3>((const float*)(a.ws + WS_CXV), (float*)(a.ws + WS_SCV), a.in[I_SCW] + (size_t)l * 3 * 256 + 128, b, col, chg, buf, lane);
    }
}

__device__ __forceinline__ void mixer_gla(const Args& a, int l, int tile, int h, LAS unsigned char* lds) {
    const int tid = tid_now();
    const bf16_t* COLS = (const bf16_t*)(a.ws + WS_COLS); const float* KV = (const float*)(a.ws + WS_KV); bf16_t* MIX = (bf16_t*)(a.ws + WS_MIX);
    LAS float* Q = (LAS float*)lds; LAS float* Kt = Q + 2048; LAS float* Z = Q + 4096; LAS float* V = Q + 6144; LAS float* WG = Q + 10240; LAS float* LA = Q + 11328;
    LAS float* QF = Q + 15424; LAS float* KF = Q + 17728; LAS float* QB = Q + 20032; LAS float* KB = Q + 22336; LAS float* SF = Q + 24640; LAS float* SB = Q + 26688; LAS float* P = Q;
    const int row0 = tile * 64; const ChunkPos cp = chunk_pos(tile);
    const bf16_t* cols0 = COLS + (size_t)row0 * NINP;
    { const int t = (tid & 255) >> 2, seg = tid & 3; float f[8];
        if (tid < 256) { unpack8(*(const u32x4*)(cols0 + (size_t)t * NINP + C_Q + 32 * h + seg * 8), f);
#pragma unroll
            for (int i = 0; i < 8; ++i) Q[t * 32 + seg * 8 + i] = f[i] * 0.17677669529663687f; }
        else { unpack8(*(const u32x4*)(cols0 + (size_t)t * NINP + C_K + 32 * h + seg * 8), f);
#pragma unroll
            for (int i = 0; i < 8; ++i) Kt[t * 32 + seg * 8 + i] = f[i]; } }
    { const int t = tid >> 3, seg = tid & 7; float f[8]; unpack8(*(const u32x4*)(cols0 + (size_t)t * NINP + C_V + 64 * h + seg * 8), f);
#pragma unroll
        for (int i = 0; i < 8; ++i) V[t * 64 + seg * 8 + i] = f[i]; }
    { const float* sf = KV + ((size_t)((0 * 4 + cp.b) * 4 + h) * NSEQ + cp.sf) * 2048; const float* sb = KV + ((size_t)((1 * 4 + cp.b) * 4 + h) * NSEQ + cp.sb) * 2048;
        *(LAS f32x4*)(SF + tid * 4) = *(const f32x4*)(sf + tid * 4); *(LAS f32x4*)(SB + tid * 4) = *(const f32x4*)(sb + tid * 4); }
    gla_gates(a, l, h, cols0, Z, WG, LA);
    if (tid < 64) { const int dir = tid >> 5, d = tid & 31; LAS float* p = LA + dir * 2048 + d;
        if (dir == 0) { float run = 0.f; for (int t = 0; t < 64; ++t) { run += p[t * 32]; p[t * 32] = run; } }
        else { float run = 0.f; for (int t = 63; t >= 0; --t) { run += p[t * 32]; p[t * 32] = run; } } }
    __syncthreads();
    { const int t = tid >> 3, d0 = (tid & 7) * 4;
#pragma unroll
        for (int i = 0; i < 4; ++i) { const int d = d0 + i; const float bf_ = LA[t * 32 + d], bb_ = LA[(64 + t) * 32 + d], q = Q[t * 32 + d], k = Kt[t * 32 + d];
            QF[t * 36 + d] = q * __expf(bf_); KF[t * 36 + d] = k * __expf(-bf_); QB[t * 36 + d] = q * __expf(bb_); KB[t * 36 + d] = k * __expf(-bb_); } }
    __syncthreads();
    { const int ib = tid >> 4, jb = tid & 15; const int i0 = 2 * ib, j0 = 4 * jb;
        float sfv[2][4], sbv[2][4];
#pragma unroll
        for (int x = 0; x < 2; ++x)
#pragma unroll
            for (int y = 0; y < 4; ++y) { sfv[x][y] = 0.f; sbv[x][y] = 0.f; }
#pragma unroll 1
        for (int d4 = 0; d4 < 32; d4 += 4) {
            f32x4 qf[2], qb[2], kf[4], kb[4];
#pragma unroll
            for (int x = 0; x < 2; ++x) { qf[x] = *(const LAS f32x4*)(QF + (i0 + x) * 36 + d4); qb[x] = *(const LAS f32x4*)(QB + (i0 + x) * 36 + d4); }
#pragma unroll
            for (int y = 0; y < 4; ++y) { kf[y] = *(const LAS f32x4*)(KF + (j0 + y) * 36 + d4); kb[y] = *(const LAS f32x4*)(KB + (j0 + y) * 36 + d4); }
#pragma unroll
            for (int x = 0; x < 2; ++x)
#pragma unroll
                for (int y = 0; y < 4; ++y) { sfv[x][y] += qf[x][0] * kf[y][0] + qf[x][1] * kf[y][1] + qf[x][2] * kf[y][2] + qf[x][3] * kf[y][3];
                    sbv[x][y] += qb[x][0] * kb[y][0] + qb[x][1] * kb[y][1] + qb[x][2] * kb[y][2] + qb[x][3] * kb[y][3]; }
        }
#pragma unroll
        for (int x = 0; x < 2; ++x) { f32x4 o;
#pragma unroll
            for (int y = 0; y < 4; ++y) { const int i = i0 + x, j = j0 + y; o[y] = (j <= i ? sfv[x][y] : 0.f) + (j >= i ? sbv[x][y] : 0.f); }
            *(LAS f32x4*)(P + (i0 + x) * 68 + j0) = o; }
    }
    __syncthreads();
    { const int ib = tid >> 4, cb = tid & 15; const int i0 = 2 * ib, c0 = 4 * cb;
        f32x4 o[2] = {(f32x4){0.f, 0.f, 0.f, 0.f}, (f32x4){0.f, 0.f, 0.f, 0.f}};
#pragma unroll 2
        for (int k4 = 0; k4 < 64; k4 += 4) { const f32x4 p0 = *(const LAS f32x4*)(P + i0 * 68 + k4), p1 = *(const LAS f32x4*)(P + (i0 + 1) * 68 + k4);
#pragma unroll
            for (int q = 0; q < 4; ++q) { const f32x4 vv = *(const LAS f32x4*)(V + (k4 + q) * 64 + c0); o[0] += p0[q] * vv; o[1] += p1[q] * vv; } }
#pragma unroll 2
        for (int k4 = 0; k4 < 32; k4 += 4) { const f32x4 p0 = *(const LAS f32x4*)(QF + i0 * 36 + k4), p1 = *(const LAS f32x4*)(QF + (i0 + 1) * 36 + k4), r0 = *(const LAS f32x4*)(QB + i0 * 36 + k4), r1 = *(const LAS f32x4*)(QB + (i0 + 1) * 36 + k4);
#pragma unroll
            for (int q = 0; q < 4; ++q) { const f32x4 s1 = *(const LAS f32x4*)(SF + (k4 + q) * 64 + c0), s2 = *(const LAS f32x4*)(SB + (k4 + q) * 64 + c0); o[0] += p0[q] * s1 + r0[q] * s2; o[1] += p1[q] * s1 + r1[q] * s2; } }
        const f32x4 gout = *(const f32x4*)(a.in[I_GOUT] + l * 256 + 64 * h + c0);
#pragma unroll
        for (int x = 0; x < 2; ++x) {
            float ss = (o[x][0] * o[x][0] + o[x][1] * o[x][1]) + (o[x][2] * o[x][2] + o[x][3] * o[x][3]);
            ss += __shfl_xor(ss, 1); ss += __shfl_xor(ss, 2); ss += __shfl_xor(ss, 4); ss += __shfl_xor(ss, 8);
            const float rs = rsqrtf(ss * (1.0f / 64.0f) + EPS);
            const u32x2 gw_ = *(const u32x2*)(cols0 + (size_t)(i0 + x) * NINP + C_G + 64 * h + c0);
            const float g0 = bflo(gw_.x), g1 = bfhi(gw_.x), g2 = bflo(gw_.y), g3 = bfhi(gw_.y);
            u32x2 w; w.x = pk2(o[x][0] * rs * gout[0] * siluf_(g0), o[x][1] * rs * gout[1] * siluf_(g1)); w.y = pk2(o[x][2] * rs * gout[2] * siluf_(g2), o[x][3] * rs * gout[3] * siluf_(g3));
            *(u32x2*)(MIX + (size_t)(row0 + i0 + x) * D + 64 * h + c0) = w; }
    }
    __syncthreads();
}

__device__ __forceinline__ void mixer_local(const Args& a, int l, int tile, int half, LAS unsigned char* lds) {
    const int tid = tid_now();
    const bf16_t* COLS = (const bf16_t*)(a.ws + WS_COLS); bf16_t* MIX = (bf16_t*)(a.ws + WS_MIX);
    LAS float* AG = (LAS float*)lds;
    LAS float* U = AG + 7936;
    LAS float* CX = U + 8192;
    const bool lat = tile < 512; const int r0 = tile * 64 + half * 32;
    const int seq_lo = lat ? tile * 64 : (NLAT + ((tile - 512) >> 2) * CTXL), seq_hi = lat ? tile * 64 + 64 : seq_lo + CTXL;
    const float* confw = a.in[I_CONFW] + (size_t)l * 31 * 256; const float* scw = a.in[I_SCW] + (size_t)l * 3 * 256;
    const int npass = lat ? 1 : 2;
    for (int ps = 0; ps < npass; ++ps) {
        const int chb = ps * 128;
        for (int idx = tid; idx < 62 * 16; idx += 512) { const int tt = idx >> 4, c8 = (idx & 15) * 8, r = r0 - 15 + tt;
            float o[8] = {0.f, 0.f, 0.f, 0.f, 0.f, 0.f, 0.f, 0.f};
            if (r >= seq_lo && r < seq_hi) { const bf16_t* rp = COLS + (size_t)r * NINP; float fa[8], fg[8]; unpack8(*(const u32x4*)(rp + C_CA + chb + c8), fa); unpack8(*(const u32x4*)(rp + C_CG + chb + c8), fg);
#pragma unroll
                for (int i = 0; i < 8; ++i) o[i] = fa[i] * sigmoidf_(fg[i]); }
            *(LAS f32x4*)(AG + tt * 128 + c8) = (f32x4){o[0], o[1], o[2], o[3]}; *(LAS f32x4*)(AG + tt * 128 + c8 + 4) = (f32x4){o[4], o[5], o[6], o[7]}; }
        for (int idx = tid; idx < 34 * 16; idx += 512) { const int tt = idx >> 4, c8 = (idx & 15) * 8, r = r0 - 1 + tt;
            float o[8] = {0.f, 0.f, 0.f, 0.f, 0.f, 0.f, 0.f, 0.f};
            if (r >= seq_lo && r < seq_hi) { const bf16_t* rp = COLS + (size_t)r * NINP; float fc[8], fx[8]; unpack8(*(const u32x4*)(rp + C_SC + chb + c8), fc); unpack8(*(const u32x4*)(rp + C_SX + chb + c8), fx);
#pragma unroll
                for (int i = 0; i < 8; ++i) o[i] = fc[i] * fx[i]; }
            *(LAS f32x4*)(CX + tt * 128 + c8) = (f32x4){o[0], o[1], o[2], o[3]}; *(LAS f32x4*)(CX + tt * 128 + c8 + 4) = (f32x4){o[4], o[5], o[6], o[7]}; }
        __syncthreads();
        { const int c = tid & 127, t0 = (tid >> 7) * 8;
            float wv[31];
#pragma unroll
            for (int j = 0; j < 31; ++j) wv[j] = confw[j * 256 + chb + c];
            const float bias = a.in[I_CONFB][l * 256 + chb + c];
            const float w0 = scw[chb + c], w1 = scw[256 + chb + c], w2 = scw[512 + chb + c];
            float o[8];
#pragma unroll
            for (int q = 0; q < 8; ++q) o[q] = bias;
#pragma unroll
            for (int j = 0; j < 38; ++j) { const float x = AG[(t0 + j) * 128 + c];
#pragma unroll
                for (int q = 0; q < 8; ++q) { if (j - q >= 0 && j - q < 31) o[q] += x * wv[j - q]; } }
#pragma unroll
            for (int q = 0; q < 8; ++q) U[(t0 + q) * 256 + chb + c] = o[q];
#pragma unroll
            for (int q = 0; q < 8; ++q) { const int t = t0 + q; const float cv = CX[t * 128 + c] * w0 + CX[(t + 1) * 128 + c] * w1 + CX[(t + 2) * 128 + c] * w2;
                const float sb = __uint_as_float(((unsigned)COLS[(size_t)(r0 + t) * NINP + C_SB + chb + c]) << 16);
                MIX[(size_t)(r0 + t) * D + 512 + chb + c] = (bf16_t)(pk2(sb * cv, 0.f) & 0xffffu); }
        }
        __syncthreads();
    }
    if (lat) {
        const float* UV = (const float*)(a.ws + WS_UV); const float* SCV = (const float*)(a.ws + WS_SCV);
        for (int idx = tid; idx < 32 * 32; idx += 512) { const int t = idx >> 5, c4 = (idx & 31) * 4;
            const f32x4 u = *(const f32x4*)(UV + (size_t)(r0 + t) * 128 + c4), bz = *(const f32x4*)(a.in[I_CONFB] + l * 256 + 128 + c4);
            *(LAS f32x4*)(U + t * 256 + 128 + c4) = u + bz;
            const f32x4 sv = *(const f32x4*)(SCV + (size_t)(r0 + t) * 128 + c4);
            const u32x2 sbw = *(const u32x2*)(COLS + (size_t)(r0 + t) * NINP + C_SB + 128 + c4);
            u32x2 w; w.x = pk2(bflo(sbw.x) * sv[0], bfhi(sbw.x) * sv[1]); w.y = pk2(bflo(sbw.y) * sv[2], bfhi(sbw.y) * sv[3]);
            *(u32x2*)(MIX + (size_t)(r0 + t) * D + 512 + 128 + c4) = w; }
        __syncthreads();
    }
    { const int t = tid >> 4, c0 = (tid & 15) * 16;
        float s = 0.f;
#pragma unroll
        for (int i = 0; i < 16; i += 4) { const f32x4 v = *(const LAS f32x4*)(U + t * 256 + c0 + i); s += (v[0] + v[1]) + (v[2] + v[3]); }
        s += __shfl_xor(s, 1); s += __shfl_xor(s, 2); s += __shfl_xor(s, 4); s += __shfl_xor(s, 8);
        const float mean = s * (1.0f / 256.0f); float q = 0.f;
#pragma unroll
        for (int i = 0; i < 16; i += 4) { const f32x4 v = *(const LAS f32x4*)(U + t * 256 + c0 + i) - mean; q += (v[0] * v[0] + v[1] * v[1]) + (v[2] * v[2] + v[3] * v[3]); }
        q += __shfl_xor(q, 1); q += __shfl_xor(q, 2); q += __shfl_xor(q, 4); q += __shfl_xor(q, 8);
        const float rstd = rsqrtf(q * (1.0f / 256.0f) + EPS);
        const float* lg = a.in[I_CONFG] + l * 256 + c0; const float* lb = a.in[I_CONFBETA] + l * 256 + c0;
#pragma unroll
        for (int i = 0; i < 16; i += 8) { float y[8];
#pragma unroll
            for (int k = 0; k < 8; ++k) y[k] = siluf_((U[t * 256 + c0 + i + k] - mean) * rstd * lg[i + k] + lb[i + k]);
            u32x4 w; w.x = pk2(y[0], y[1]); w.y = pk2(y[2], y[3]); w.z = pk2(y[4], y[5]); w.w = pk2(y[6], y[7]);
            *(u32x4*)(MIX + (size_t)(r0 + t) * D + 256 + c0 + i) = w; }
    }
    __syncthreads();
    for (int hf = 0; hf < 2; ++hf) {
        LAS float* PI = (LAS float*)lds;
        LAS float* DF = PI + 6144;
        LAS float* PW = DF + 4224;
        for (int idx = tid; idx < 48 * 16; idx += 512) { const int tt = idx >> 4, c8 = (idx & 15) * 8, r = r0 - 8 + tt;
            float o[8] = {0.f, 0.f, 0.f, 0.f, 0.f, 0.f, 0.f, 0.f};
            if (r >= seq_lo && r < seq_hi) unpack8(*(const u32x4*)(COLS + (size_t)r * NINP + C_PL + hf * 128 + c8), o);
            *(LAS f32x4*)(PI + tt * 128 + c8) = (f32x4){o[0], o[1], o[2], o[3]}; *(LAS f32x4*)(PI + tt * 128 + c8 + 4) = (f32x4){o[4], o[5], o[6], o[7]}; }
        for (int idx = tid; idx < 2 * 64 * 64 / 4; idx += 512) *(LAS f32x4*)(PW + idx * 4) = *(const f32x4*)(a.in[I_POOLW] + (size_t)l * 4 * 4096 + (size_t)hf * 2 * 4096 + idx * 4);
        __syncthreads();
        for (int idx = tid; idx < 32 * 128; idx += 512) { const int t = idx >> 7, c = idx & 127, g = hf * 2 + (c >> 6); const int hw = 1 << g;
            const int r = r0 + t; int lo = r - hw, hi = r + hw; lo = lo < seq_lo ? seq_lo : lo; hi = hi > seq_hi ? seq_hi : hi;
            float sm = 0.f; for (int rr = lo; rr < hi; ++rr) sm += PI[(rr - r0 + 8) * 128 + c];
            DF[t * 132 + c] = sm / (float)(hi - lo) - PI[(t + 8) * 128 + c]; }
        __syncthreads();
        { const int gl = tid >> 8, tp = (tid >> 4) & 15, dq = tid & 15; const int dd0 = dq * 4;
            f32x4 o[2] = {(f32x4){0.f, 0.f, 0.f, 0.f}, (f32x4){0.f, 0.f, 0.f, 0.f}};
#pragma unroll 2
            for (int c4 = 0; c4 < 64; c4 += 4) { f32x4 dv[2];
#pragma unroll
                for (int x = 0; x < 2; ++x) dv[x] = *(const LAS f32x4*)(DF + (tp * 2 + x) * 132 + gl * 64 + c4);
#pragma unroll
                for (int q = 0; q < 4; ++q) { const f32x4 wv = *(const LAS f32x4*)(PW + (gl * 64 + c4 + q) * 64 + dd0);
#pragma unroll
                    for (int x = 0; x < 2; ++x) o[x] += dv[x][q] * wv; } }
            const int ch = (hf * 2 + gl) * 64 + dd0; const f32x4 ps = *(const f32x4*)(a.in[I_POOLS] + l * 256 + ch);
#pragma unroll
            for (int x = 0; x < 2; ++x) { u32x2 w; w.x = pk2(o[x][0] * ps[0], o[x][1] * ps[1]); w.y = pk2(o[x][2] * ps[2], o[x][3] * ps[3]);
                *(u32x2*)(MIX + (size_t)(r0 + tp * 2 + x) * D + 768 + ch) = w; } }
        __syncthreads();
    }
}

__device__ __forceinline__ void phase_mixer(const Args& a, int l, LAS unsigned char* lds) {
    const int ntile = (l == 1) ? 512 : NCHUNK;
    for (int it = blockIdx.x; it < ntile * 6; it += gridDim.x) { const int tile = it / 6, part = it % 6;
        if (part < 4) mixer_gla(a, l, tile, part, lds); else mixer_local(a, l, tile, part - 4, lds); }
}

__device__ __forceinline__ void phase_router(const Args& a, int l, LAS unsigned char* lds) {
    const int tid = tid_now(), lane = tid & 63, wid = tid >> 6;
    const int M = (l == 1) ? NLAT : MTOT;
    const float* MOD = (const float*)(a.ws + WS_MOD) + (size_t)l * 5 * 6144; bf16_t* H = (bf16_t*)(a.ws + WS_H);
    const float* Xlat = a.out; const float* Xctx = (const float*)(a.ws + WS_XCTX);
    LAS float* WRE = (LAS float*)lds;
    LAS int* INFO = (LAS int*)(lds + MISC_OFF + 4096);
    LAS int* HIST = (LAS int*)(lds + MISC_OFF + 2048);
    const float* wre = a.in[I_RWE] + (size_t)l * 1024 * 32; const float* wrg = a.in[I_RWG] + (size_t)l * 1024 * 4;
    for (int i = tid; i < 1024 * 8; i += 512) { const int k = i >> 3, q = i & 7; *(LAS f32x4*)(WRE + k * 32 + ((q ^ ((k >> 2) & 7)) << 2)) = *(const f32x4*)(wre + k * 32 + q * 4); }
    if (tid < 64) HIST[tid] = 0;
    __syncthreads();
    const int per = (M + gridDim.x - 1) / gridDim.x; const int r_lo = blockIdx.x * per; int r_hi = r_lo + per; if (r_hi > M) r_hi = M;
    const float rbg0 = a.in[I_RBG][l * 4 + 0], rbg1 = a.in[I_RBG][l * 4 + 1], rbg2 = a.in[I_RBG][l * 4 + 2], rbg3 = a.in[I_RBG][l * 4 + 3];
    for (int m = r_lo + wid; m < r_hi; m += 8) {
        const float* src = m < NLAT ? Xlat + (size_t)m * D : Xctx + (size_t)(m - NLAT) * D;
        const int b = m < NLAT ? (m >> 13) : 4;
        f32x4 v[4]; load_row(src, lane, v); const float rstd = row_rstd(v);
        const float* mod = MOD + (size_t)b * 6144;
        norm_mod_store(v, rstd, a.in[I_G2] + l * 1024, mod + 4 * 1024, mod + 3 * 1024, H + (size_t)m * D, lane);
        f32x4 lgv = (f32x4){0.f, 0.f, 0.f, 0.f};
#pragma unroll
        for (int j = 0; j < 4; ++j)
#pragma unroll
            for (int i = 0; i < 4; ++i) { const int k = 256 * j + 4 * lane + i; lgv += v[j][i] * *(const f32x4*)(wrg + k * 4); }
        float lg0 = wave_sum(lgv[0]) + rbg0, lg1 = wave_sum(lgv[1]) + rbg1, lg2 = wave_sum(lgv[2]) + rbg2, lg3 = wave_sum(lgv[3]) + rbg3;
        int grp = 0; float best = lg0; if (lg1 > best) { best = lg1; grp = 1; } if (lg2 > best) { best = lg2; grp = 2; } if (lg3 > best) { best = lg3; grp = 3; }
        const float pg = 1.0f / (__expf(lg0 - best) + __expf(lg1 - best) + __expf(lg2 - best) + __expf(lg3 - best));
        grp = __builtin_amdgcn_readfirstlane(grp);
        f32x4 e0 = (f32x4){0.f, 0.f, 0.f, 0.f}, e1 = (f32x4){0.f, 0.f, 0.f, 0.f};
#pragma unroll
        for (int j = 0; j < 4; ++j)
#pragma unroll
            for (int i = 0; i < 4; ++i) { const int k = 256 * j + 4 * lane + i; const int sw = (k >> 2) & 7;
                e0 += v[j][i] * *(const LAS f32x4*)(WRE + k * 32 + (((2 * grp) ^ sw) << 2)); e1 += v[j][i] * *(const LAS f32x4*)(WRE + k * 32 + (((2 * grp + 1) ^ sw) << 2)); }
        float le[8];
#pragma unroll
        for (int i = 0; i < 4; ++i) { le[i] = wave_sum(e0[i]) + a.in[I_RBE][l * 32 + grp * 8 + i]; le[4 + i] = wave_sum(e1[i]) + a.in[I_RBE][l * 32 + grp * 8 + 4 + i]; }
        int i0 = 0; float v0 = le[0];
#pragma unroll
        for (int i = 1; i < 8; ++i) if (le[i] > v0) { v0 = le[i]; i0 = i; }
        int i1 = -1; float v1 = -3.0e38f;
#pragma unroll
        for (int i = 0; i < 8; ++i) if (i != i0 && le[i] > v1) { v1 = le[i]; i1 = i; }
        const float w0 = 1.0f / (1.0f + __expf(v1 - v0)); const float w1 = 1.0f - w0;
        if (lane == 0) { const int lr = m - r_lo; INFO[lr * 4 + 0] = grp * 8 + i0; INFO[lr * 4 + 1] = grp * 8 + i1; INFO[lr * 4 + 2] = __float_as_int(w0 * pg); INFO[lr * 4 + 3] = __float_as_int(w1 * pg); }
    }
    __syncthreads();
    const int nr = r_hi - r_lo; int lp0 = 0, lp1 = 0, ee0 = 0, ee1 = 0;
    if (tid < nr) { ee0 = INFO[tid * 4 + 0]; ee1 = INFO[tid * 4 + 1]; lp0 = atomicAdd((int*)(HIST + ee0), 1); lp1 = atomicAdd((int*)(HIST + ee1), 1); }
    __syncthreads();
    unsigned* cnt = (unsigned*)(a.ws + WS_CTL) + CW_CNT + l * 32 * 64;
    if (tid < 32) { const int c = HIST[tid]; HIST[32 + tid] = c ? (int)atomicAdd(cnt + tid * 64, (unsigned)c) : 0; }
    __syncthreads();
    if (tid < nr) { const int m = r_lo + tid; const int p0 = HIST[32 + ee0] + lp0, p1 = HIST[32 + ee1] + lp1;
        int* TL = (int*)(a.ws + WS_TOKLIST); TL[ee0 * MTOT + p0] = m; TL[ee1 * MTOT + p1] = m;
        *((i32x4*)(a.ws + WS_TOKINFO) + m) = (i32x4){(ee0 << 20) | p0, (ee1 << 20) | p1, INFO[tid * 4 + 2], INFO[tid * 4 + 3]}; }
    __syncthreads();
}

__device__ __forceinline__ int moe_tables(const Args& a, int l, LAS unsigned char* lds) {
    LAS int* TB = (LAS int*)(lds + MISC_OFF + 256); LAS int* CN = TB + 64; LAS int* TE = (LAS int*)(lds + MISC_OFF + 1024); LAS int* TM = TE + 320;
    const unsigned* cnt = (const unsigned*)(a.ws + WS_CTL) + CW_CNT + l * 32 * 64;
    { const int tq_ = tid_now(); if (tq_ < 32) CN[tq_] = (int)__hip_atomic_load(cnt + tq_ * 64, __ATOMIC_RELAXED, __HIP_MEMORY_SCOPE_AGENT); }
    __syncthreads();
    if (tid_now() == 0) { int t = 0;
#pragma unroll 1
        for (int e = 0; e < 32; ++e) { TB[e] = t; const int nt = (CN[e] + 255) >> 8;
#pragma unroll 1
            for (int q = 0; q < nt; ++q) { TE[t + q] = e; TM[t + q] = q; } t += nt; } TB[32] = t; }
    __syncthreads();
    return __builtin_amdgcn_readfirstlane(TB[32]);
}

__device__ __forceinline__ void phase_combine(const Args& a, int l, LAS unsigned char* lds) {
    const int lane = tid_now() & 63, wid = tid_now() >> 6, gw = blockIdx.x * 8 + wid, NGW = gridDim.x * 8;
    const int M = (l == 1) ? NLAT : MTOT;
    (void)moe_tables(a, l, lds);
    const LAS int* TB = (const LAS int*)(lds + MISC_OFF + 256);
    const float* MOD = (const float*)(a.ws + WS_MOD); const bf16_t* Y = (const bf16_t*)(a.ws + WS_Y); bf16_t* H = (bf16_t*)(a.ws + WS_H);
    float* Xlat = a.out; float* Xctx = (float*)(a.ws + WS_XCTX);
    for (int m = gw; m < M; m += NGW) {
        float* xr = m < NLAT ? Xlat + (size_t)m * D : Xctx + (size_t)(m - NLAT) * D;
        const int b = m < NLAT ? (m >> 13) : 4;
        const i32x4 inf = *((const i32x4*)(a.ws + WS_TOKINFO) + m);
        const int e0 = inf.x >> 20, p0 = inf.x & 0xfffff, e1 = inf.y >> 20, p1 = inf.y & 0xfffff; const float w0 = __int_as_float(inf.z), w1 = __int_as_float(inf.w);
        const bf16_t* y0 = Y + (size_t)(TB[e0] * 256 + p0) * D; const bf16_t* y1 = Y + (size_t)(TB[e1] * 256 + p1) * D;
        const float* ga2 = MOD + (size_t)(l * 5 + b) * 6144 + 5 * 1024;
        f32x4 v[4]; load_row(xr, lane, v);
#pragma unroll
        for (int j = 0; j < 4; ++j) { const u32x2 a0 = *((const u32x2*)y0 + lane + 64 * j), a1 = *((const u32x2*)y1 + lane + 64 * j); const f32x4 g = *((const f32x4*)ga2 + lane + 64 * j);
            f32x4 y; y[0] = w0 * bflo(a0.x) + w1 * bflo(a1.x); y[1] = w0 * bfhi(a0.x) + w1 * bfhi(a1.x); y[2] = w0 * bflo(a0.y) + w1 * bflo(a1.y); y[3] = w0 * bfhi(a0.y) + w1 * bfhi(a1.y);
            v[j] = v[j] + g * y; }
        const float rstd = row_rstd(v);
        if (l == 0) {
#pragma unroll
            for (int j = 0; j < 4; ++j) *((f32x4*)xr + lane + 64 * j) = v[j];
            const float* mod = MOD + (size_t)(5 + b) * 6144;
            norm_mod_store(v, rstd, a.in[I_G1] + 1024, mod + 1024, mod, H + (size_t)m * D, lane);
        } else {
#pragma unroll
            for (int j = 0; j < 4; ++j) { const f32x4 g = *((const f32x4*)a.in[I_GFINAL] + lane + 64 * j); *((f32x4*)xr + lane + 64 * j) = v[j] * rstd * g; }
        }
    }
}

constexpr int NPHASE = 20;
#ifndef DIAG_PH
#define DIAG_PH -1
#endif
#define PH_ON(x) (DIAG_PH < 0 || DIAG_PH == (x))
__global__ void __launch_bounds__(512, 2) mega(Args a) {
    extern __shared__ __attribute__((aligned(16))) unsigned char lds_raw[];
    LAS unsigned char* lds = (LAS unsigned char*)lds_raw;
    unsigned char* ws = a.ws;
    for (int ph = a.ph_lo; ph < a.ph_hi; ++ph) {
        if (PH_ON(0) && ph == 0) phase_p0(a, lds);
        else if (PH_ON(1) && ph == 1) phase_norm1_l0(a);
        else {
            const int l = (ph - 2) / 9, sp = (ph - 2) % 9;
            if (PH_ON(2) && sp == 0) {
                g8::DenseSched S; S.init(ws + WS_H, ws + WS_WIN + (size_t)l * NINP * 1024 * 2, MTOT, NINP, 1024, gridDim.x, blockIdx.x);
                g8::EpiBf16 E{(bf16_t*)(ws + WS_COLS), NINP};
                g8::gemm_phase(lds, S, E);
            } else if (PH_ON(3) && sp == 1) phase_chunk(a, l, lds);
            else if (PH_ON(4) && sp == 2) phase_scan(a, l, lds);
            else if (PH_ON(5) && sp == 3) phase_mixer(a, l, lds);
            else if (PH_ON(6) && sp == 4) {
                g8::DenseSched S; S.init(ws + WS_MIX, ws + WS_WOUT + (size_t)l * 1024 * 1024 * 2, l == 1 ? NLAT : MTOT, 1024, 1024, gridDim.x, blockIdx.x);
                g8::EpiRes E{l == 0 ? a.in[I_X] : a.out, l == 0 ? a.in[I_CTX] : (const float*)(ws + WS_XCTX), a.out, (float*)(ws + WS_XCTX), (const float*)(ws + WS_MOD) + (size_t)l * 5 * 6144 + 2 * 1024};
                g8::gemm_phase(lds, S, E);
            } else if (PH_ON(7) && sp == 5) phase_router(a, l, lds);
            else if ((PH_ON(8) || PH_ON(9)) && (sp == 6 || sp == 7)) {
                const int T = moe_tables(a, l, lds);
                const int G = gridDim.x, bx = blockIdx.x, vcu = (G % 8 == 0) ? (bx % 8) * (G / 8) + bx / 8 : bx;
                const LAS int* TBp = (const LAS int*)(lds + MISC_OFF + 256);
                if (PH_ON(8) && sp == 6) {
                    g8::MoeSched<true> S; S.A = (const char*)(ws + WS_H); S.Bw = (const char*)(ws + WS_WEIN) + (size_t)l * 32 * 1024 * 1024 * 2; S.wstride = (size_t)1024 * 1024 * 2; S.K = 1024; S.T = T; S.G = G; S.c = vcu;
                    S.tile_e = (const LAS int*)(lds + MISC_OFF + 1024); S.tile_mt = S.tile_e + 320; S.cnt = TBp + 64; S.toklist = (const int*)(ws + WS_TOKLIST);
                    g8::EpiSwiGLU E{(bf16_t*)(ws + WS_ACT)};
                    g8::gemm_phase(lds, S, E);
                } else if (PH_ON(9) && sp == 7) {
                    g8::MoeSched<false> S; S.A = (const char*)(ws + WS_ACT); S.Bw = (const char*)(ws + WS_WEOUT) + (size_t)l * 32 * 1024 * 512 * 2; S.wstride = (size_t)1024 * 512 * 2; S.K = 512; S.T = T; S.G = G; S.c = vcu;
                    S.tile_e = (const LAS int*)(lds + MISC_OFF + 1024); S.tile_mt = S.tile_e + 320; S.cnt = TBp + 64; S.toklist = (const int*)(ws + WS_TOKLIST);
                    g8::EpiBf16 E{(bf16_t*)(ws + WS_Y), 1024};
                    g8::gemm_phase(lds, S, E);
                }
            } else if (PH_ON(10) && sp == 8) phase_combine(a, l, lds);
        }
        if (ph + 1 < a.ph_hi) { cg::this_grid().sync(); }
    }
}

extern "C" void kernel_launch(void* const* d_in, const int* in_sizes, int n_in, void* d_out, int out_size, void* d_ws, size_t ws_size, hipStream_t stream) {
    static int grid = 0;
    if (grid == 0) {
        if (n_in != 29 || out_size != NLAT * D || ws_size < WS_END) { fprintf(stderr, "kernel_launch: unexpected shapes (n_in %d out %d ws %zu)\n", n_in, out_size, ws_size); grid = -1; return; }
        int dev = 0, cus = 0, per_cu = 0;
        hipGetDevice(&dev); hipDeviceGetAttribute(&cus, hipDeviceAttributeMultiprocessorCount, dev);
        if (hipFuncSetAttribute((const void*)mega, hipFuncAttributeMaxDynamicSharedMemorySize, LDS_BYTES) != hipSuccess) { fprintf(stderr, "kernel_launch: hipFuncSetAttribute failed\n"); grid = -1; return; }
        if (hipOccupancyMaxActiveBlocksPerMultiprocessor(&per_cu, (const void*)mega, 512, LDS_BYTES) != hipSuccess || per_cu < 1) { fprintf(stderr, "kernel_launch: occupancy query says %d\n", per_cu); per_cu = 1; }
        (void)hipGetLastError();
        grid = cus;
    }
    if (grid < 0) return;
    hipMemsetAsync((char*)d_ws + WS_CTL, 0, CTL_BYTES, stream);
    Args a{};
    for (int i = 0; i < 29; ++i) a.in[i] = (const float*)d_in[i];
    a.out = (float*)d_out; a.ws = (unsigned char*)d_ws;
#if MK_MULTI
    for (int ph = 0; ph < NPHASE; ++ph) { a.ph_lo = ph; a.ph_hi = ph + 1; hipLaunchKernelGGL(mega, dim3(grid), dim3(512), LDS_BYTES, stream, a); }
#else
    a.ph_lo = 0; a.ph_hi = NPHASE;
    void* args[] = {&a};
    hipError_t e = hipLaunchCooperativeKernel((const void*)mega, dim3(grid), dim3(512), args, LDS_BYTES, stream);
    if (e != hipSuccess) fprintf(stderr, "cooperative launch failed: %s (grid %d)\n", hipGetErrorString(e), grid);
#endif
}
```

```cpp
#include <hip/hip_runtime.h>
#include <hip/hip_cooperative_groups.h>
#include <cstdio>
namespace cg = cooperative_groups;

#ifndef MK_MULTI
#define MK_MULTI 0
#endif

#define LAS __attribute__((address_space(3)))
typedef unsigned short bf16_t;
typedef short bf16x8 __attribute__((ext_vector_type(8)));
typedef float f32x4 __attribute__((ext_vector_type(4)));
typedef float f32x2 __attribute__((ext_vector_type(2)));
typedef unsigned u32x4 __attribute__((ext_vector_type(4)));
typedef unsigned u32x2 __attribute__((ext_vector_type(2)));
typedef int i32x4 __attribute__((ext_vector_type(4)));

constexpr int D = 1024, NLAT = 32768, SEQ = 8192, NCTXT = 1024, CTXL = 256, MTOT = NLAT + NCTXT;
constexpr int NIN = 2336, NINP = 2560;
constexpr int NCHUNK = MTOT / 64, NSEQ = 132;
constexpr int NEXP = 32, DEXP = 512, SLOTS = 75776;
constexpr float EPS = 1e-6f;
constexpr int C_Q = 0, C_K = 128, C_V = 256, C_G = 512, C_ZF = 768, C_ZB = 784, C_CA = 800, C_CG = 1056, C_SB = 1312, C_SC = 1568, C_SX = 1824, C_PL = 2080;

constexpr size_t MiB = 1u << 20;
constexpr size_t WS_CTL = 0, CTL_BYTES = 1 * MiB;
constexpr size_t WS_MOD = 1 * MiB;
constexpr size_t WS_WIN = 2 * MiB;
constexpr size_t WS_WOUT = 12 * MiB;
constexpr size_t WS_WEIN = 16 * MiB;
constexpr size_t WS_WEOUT = 144 * MiB;
constexpr size_t WS_XCTX = 208 * MiB;
constexpr size_t WS_H = 212 * MiB;
constexpr size_t WS_COLS = 278 * MiB;
constexpr size_t WS_MIX = 443 * MiB;
constexpr size_t WS_KV = 509 * MiB;
constexpr size_t WS_DEC = 542 * MiB;
constexpr size_t WS_AGV = 543 * MiB;
constexpr size_t WS_CXV = 559 * MiB;
constexpr size_t WS_UV = 575 * MiB;
constexpr size_t WS_SCV = 591 * MiB;
constexpr size_t WS_TOKINFO = 607 * MiB;
constexpr size_t WS_TOKLIST = 608 * MiB;
constexpr size_t WS_ACT = 613 * MiB;
constexpr size_t WS_Y = 687 * MiB;
constexpr size_t WS_END = 835 * MiB;
constexpr int CW_CNT = 1024;
constexpr int CW_BAR = 8192;

constexpr int LDS_BYTES = 147456;
constexpr int MISC_OFF = 131072;

__device__ __forceinline__ unsigned pk2(float lo, float hi) { unsigned r; asm("v_cvt_pk_bf16_f32 %0, %1, %2" : "=v"(r) : "v"(lo), "v"(hi)); return r; }
__device__ __forceinline__ float bflo(unsigned w) { return __uint_as_float(w << 16); }
__device__ __forceinline__ float bfhi(unsigned w) { return __uint_as_float(w & 0xffff0000u); }
__device__ __forceinline__ void unpack8(const u32x4 w, float (&f)[8]) { f[0] = bflo(w.x); f[1] = bfhi(w.x); f[2] = bflo(w.y); f[3] = bfhi(w.y); f[4] = bflo(w.z); f[5] = bfhi(w.z); f[6] = bflo(w.w); f[7] = bfhi(w.w); }
__device__ __forceinline__ float sigmoidf_(float x) { return 1.0f / (1.0f + __expf(-x)); }
__device__ __forceinline__ float siluf_(float x) { return x / (1.0f + __expf(-x)); }
__device__ __forceinline__ float logsigf_(float x) { return fminf(x, 0.0f) - log1pf(__expf(-fabsf(x))); }
__device__ __forceinline__ float wave_sum(float v) {
#pragma unroll
    for (int o = 1; o < 64; o <<= 1) v += __shfl_xor(v, o);
    return v;
}
#define LDS_WAIT() asm volatile("s_waitcnt lgkmcnt(0)" ::: "memory")
__device__ __forceinline__ int tid_now() { int t = threadIdx.x; asm volatile("" : "+v"(t)); return t; }

namespace g8 {
constexpr int BM = 256, BK = 64, HALF = 128, HTB = HALF * BK * 2, NXCD = 8, WGM = 8;
__device__ __forceinline__ int lds_byte(int r, int c) { const int st = (r >> 4) * 2 + (c >> 5), rr = r & 15, cc = c & 31, ob = rr * 64 + cc * 2; return st * 1024 + (ob ^ (((ob >> 9) & 1) << 5)); }
__device__ __forceinline__ void stage_rc(int b, int& R, int& C) { const int st = b / 1024, sb = b % 1024, swz = sb ^ (((sb >> 9) & 1) << 5); R = (st >> 1) * 16 + swz / 64; C = (st & 1) * 32 + (swz % 64) / 2; }
__device__ __forceinline__ int perm32(int rho) { const int n = rho >> 4, i = rho & 15; return 8 * (i >> 2) + 4 * n + (i & 3); }

struct Unit { int pm, pn, e, mt; };

struct DenseSched {
    const char* A; const char* Bt; int K, nM, nN, nwg, G, c;
    __device__ __forceinline__ void init(const void* A_, const void* Bt_, int M, int N, int K_, int G_, int c_) { A = (const char*)A_; Bt = (const char*)Bt_; K = K_; nM = M / BM; nN = N / BM; nwg = nM * nN; G = G_; c = c_; }
    __device__ __forceinline__ bool next(int i, Unit& u) const {
        const long L = (long)i * G + c; if (L >= nwg) return false;
        int wgid = (int)L; { const int q = nwg / NXCD, r = nwg % NXCD, xcd = wgid % NXCD, off = wgid / NXCD; wgid = (xcd < r ? xcd * (q + 1) : r * (q + 1) + (xcd - r) * q) + off; }
        const int nig = WGM * nN, gid = wgid / nig, fm = gid * WGM, gsz = (nM - fm) < WGM ? (nM - fm) : WGM;
        u.pm = fm + ((wgid % nig) % gsz); u.pn = (wgid % nig) / gsz; u.e = 0; u.mt = 0; return true;
    }
    __device__ __forceinline__ unsigned a_off(const Unit& u, int h, int R, int C) const { return (unsigned)(((u.pm * BM + h * HALF + R) * K + C) * 2); }
    __device__ __forceinline__ const char* b_ptr(const Unit& u) const { return Bt + (size_t)u.pn * BM * K * 2; }
};
template <bool GATHER> struct MoeSched {
    const char* A; const char* Bw; size_t wstride; int K, T, G, c; const LAS int* tile_e; const LAS int* tile_mt; const LAS int* cnt; const int* toklist;
    __device__ __forceinline__ bool next(int i, Unit& u) const {
        const int L = i * G + c; if (L >= 4 * T) return false;
        u.pm = L >> 2; u.pn = L & 3; u.e = __builtin_amdgcn_readfirstlane(tile_e[u.pm]); u.mt = __builtin_amdgcn_readfirstlane(tile_mt[u.pm]); return true;
    }
    __device__ __forceinline__ unsigned a_off(const Unit& u, int h, int R, int C) const {
        if (GATHER) { const int pos = u.mt * BM + h * HALF + R; int tok = 0; if (pos < cnt[u.e]) tok = toklist[u.e * MTOT + pos]; return (unsigned)((tok * K + C) * 2); }
        return (unsigned)(((u.pm * BM + h * HALF + R) * K + C) * 2);
    }
    __device__ __forceinline__ const char* b_ptr(const Unit& u) const { return Bw + (size_t)u.e * wstride + (size_t)u.pn * BM * K * 2; }
};

struct EpiBf16 {
    static constexpr bool PERM = true;
    bf16_t* O; int ldc;
    __device__ __forceinline__ void operator()(const f32x4 (&acc)[2][2][4][2], const Unit& u, int wr, int wc, int fr, int fq) const {
        const int row0 = u.pm * BM + wr * 64 + fr, col0 = u.pn * BM + wc * 32 + 8 * fq;
#pragma unroll
        for (int ai = 0; ai < 2; ++ai)
#pragma unroll
            for (int m = 0; m < 4; ++m) { bf16_t* rowp = O + (size_t)(row0 + ai * HALF + m * 16) * ldc + col0;
#pragma unroll
                for (int bj = 0; bj < 2; ++bj) { const f32x4 v0 = acc[ai][bj][m][0], v1 = acc[ai][bj][m][1];
                    u32x4 w; w.x = pk2(v0[0], v0[1]); w.y = pk2(v0[2], v0[3]); w.z = pk2(v1[0], v1[1]); w.w = pk2(v1[2], v1[3]);
                    *(u32x4*)(rowp + bj * HALF) = w; } }
    }
};
struct EpiSwiGLU {
    static constexpr bool PERM = true;
    bf16_t* O;
    __device__ __forceinline__ void operator()(const f32x4 (&acc)[2][2][4][2], const Unit& u, int wr, int wc, int fr, int fq) const {
        const int row0 = u.pm * BM + wr * 64 + fr, col0 = u.pn * HALF + wc * 32 + 8 * fq;
#pragma unroll
        for (int ai = 0; ai < 2; ++ai)
#pragma unroll
            for (int m = 0; m < 4; ++m) { bf16_t* rowp = O + (size_t)(row0 + ai * HALF + m * 16) * DEXP + col0;
                const f32x4 g0 = acc[ai][0][m][0], g1 = acc[ai][0][m][1], u0 = acc[ai][1][m][0], u1 = acc[ai][1][m][1];
                u32x4 w; w.x = pk2(siluf_(g0[0]) * u0[0], siluf_(g0[1]) * u0[1]); w.y = pk2(siluf_(g0[2]) * u0[2], siluf_(g0[3]) * u0[3]);
                w.z = pk2(siluf_(g1[0]) * u1[0], siluf_(g1[1]) * u1[1]); w.w = pk2(siluf_(g1[2]) * u1[2], siluf_(g1[3]) * u1[3]);
                *(u32x4*)rowp = w; }
    }
};
template <class Epi, class Sched>
__device__ __forceinline__ void gemm_phase(LAS unsigned char* lds, const Sched& S, const Epi& E) {
    const int tid = tid_now(), wid = __builtin_amdgcn_readfirstlane(tid >> 6), lane = tid & 63, wr = wid >> 2, wc = wid & 3, fr = lane & 15, fq = lane >> 4;
    const int K = S.K, nt = K / BK;
    unsigned voffB[2];
#pragma unroll
    for (int i = 0; i < 2; ++i) { int R, C; stage_rc(tid * 16 + i * 8192, R, C); const int Rb = Epi::PERM ? ((R & ~31) + perm32(R & 31)) : R; voffB[i] = (unsigned)(Rb * K + C) * 2u; }
    const size_t kstep = (size_t)(BK * 2);
    const size_t hstep = (size_t)HALF * K * 2;
    const unsigned ldsw = (unsigned)wid * 1024u;
    const int aoff = lds_byte(wr * 64 + fr, fq * 8), boff = lds_byte(wc * 32 + fr, fq * 8);
#define G8_SA(b, h) (((b) * 2 + (h)) * HTB)
#define G8_SB(b, h) ((4 + (b) * 2 + (h)) * HTB)
#define G8_STAGE(bufoff, gbase, voff) do { const unsigned long long _g = (unsigned long long)(gbase); \
        const char* _gb = (const char*)(((unsigned long long)(unsigned)__builtin_amdgcn_readfirstlane((int)(unsigned)(_g >> 32)) << 32) | (unsigned long long)(unsigned)__builtin_amdgcn_readfirstlane((int)(unsigned)_g)); \
        _Pragma("unroll") for (int _i = 0; _i < 2; ++_i) \
        __builtin_amdgcn_global_load_lds((const unsigned*)(_gb + (voff)[_i]), (LAS unsigned*)(lds + (bufoff) + ldsw + _i * 8192), 16, 0, 0); } while (0)
#define G8_LDA(dst, b, h) do { _Pragma("unroll") for (int m = 0; m < 4; ++m) _Pragma("unroll") for (int k = 0; k < 2; ++k) dst[m][k] = *(const LAS bf16x8*)(lds + G8_SA(b, h) + aoff + m * 2048 + k * 1024); } while (0)
#define G8_LDB(dst, b, h) do { _Pragma("unroll") for (int n = 0; n < 2; ++n) _Pragma("unroll") for (int k = 0; k < 2; ++k) dst[n][k] = *(const LAS bf16x8*)(lds + G8_SB(b, h) + boff + n * 2048 + k * 1024); } while (0)
#define G8_MMA(ai, bj, At, Bt) do { __builtin_amdgcn_s_setprio(1); _Pragma("unroll") for (int m = 0; m < 4; ++m) _Pragma("unroll") for (int n = 0; n < 2; ++n) _Pragma("unroll") for (int k = 0; k < 2; ++k) \
        acc[ai][bj][m][n] = __builtin_amdgcn_mfma_f32_16x16x32_bf16(Bt[n][k], At[m][k], acc[ai][bj][m][n], 0, 0, 0); __builtin_amdgcn_s_setprio(0); } while (0)
#define G8_WAIT_V(n) asm volatile("s_waitcnt vmcnt(" #n ")" ::: "memory")
#define G8_WAIT_L(n) asm volatile("s_waitcnt lgkmcnt(" #n ")" ::: "memory")
#define G8_BAR __builtin_amdgcn_s_barrier()
#define G8_SCHED __builtin_amdgcn_sched_barrier(0)
    Unit cur, nxt; int ui = 0;
    if (!S.next(0, cur)) return;
    f32x4 acc[2][2][4][2];
#pragma unroll
    for (int a = 0; a < 2; ++a)
#pragma unroll
        for (int b = 0; b < 2; ++b)
#pragma unroll
            for (int m = 0; m < 4; ++m)
#pragma unroll
                for (int n = 0; n < 2; ++n) acc[a][b][m][n] = (f32x4){0.f, 0.f, 0.f, 0.f};
    bf16x8 At[4][2], B0[2][2], B1[2][2];
    unsigned vA0[2], vA1[2];
#pragma unroll
    for (int i = 0; i < 2; ++i) { int R, C; stage_rc(tid * 16 + i * 8192, R, C); vA0[i] = S.a_off(cur, 0, R, C); vA1[i] = S.a_off(cur, 1, R, C); }
    const char* const Ab = S.A;
    const char* cB = S.b_ptr(cur);
    G8_STAGE(G8_SB(0, 0), cB, voffB); G8_STAGE(G8_SA(0, 0), Ab, vA0); G8_STAGE(G8_SB(0, 1), cB + hstep, voffB); G8_STAGE(G8_SA(0, 1), Ab, vA1);
    if (wr == 1) G8_BAR;
    G8_WAIT_V(4); G8_BAR;
    G8_STAGE(G8_SB(1, 0), cB + kstep, voffB); G8_STAGE(G8_SA(1, 0), Ab + kstep, vA0); G8_STAGE(G8_SB(1, 1), cB + hstep + kstep, voffB);
    G8_WAIT_V(6); G8_BAR;
    for (;;) {
        const bool has_next = S.next(ui + 1, nxt);
        const char* nB = has_next ? S.b_ptr(nxt) : cB;
        for (int t = 0; t < nt; t += 2) {
            const bool last = (t == nt - 2);
            const char* a1 = Ab + (size_t)(t + 1) * kstep;
            const char* a2 = last ? Ab : Ab + (size_t)(t + 2) * kstep; const char* b2 = last ? nB : cB + (size_t)(t + 2) * kstep;
            const char* a3 = a2 + kstep; const char* b3 = b2 + kstep;
            G8_LDB(B0, 0, 0); G8_SCHED; G8_LDA(At, 0, 0); G8_STAGE(G8_SA(1, 1), a1, vA1);
            G8_WAIT_L(8); G8_BAR; G8_WAIT_L(0); G8_MMA(0, 0, At, B0); G8_BAR; G8_SCHED;
            if (last && has_next) {
#pragma unroll
                for (int i = 0; i < 2; ++i) { int R, C; stage_rc(tid * 16 + i * 8192, R, C); vA0[i] = S.a_off(nxt, 0, R, C); vA1[i] = S.a_off(nxt, 1, R, C); }
            }
            G8_LDB(B1, 0, 1); G8_STAGE(G8_SB(0, 0), b2, voffB);
            G8_BAR; G8_WAIT_L(0); G8_MMA(0, 1, At, B1); G8_BAR;
            G8_LDA(At, 0, 1); G8_STAGE(G8_SA(0, 0), a2, vA0);
            G8_BAR; G8_WAIT_L(0); G8_MMA(1, 0, At, B0); G8_BAR; G8_SCHED;
            G8_STAGE(G8_SB(0, 1), b2 + hstep, voffB);
            G8_WAIT_V(6); G8_BAR; G8_MMA(1, 1, At, B1); G8_BAR;
            G8_LDB(B0, 1, 0); G8_SCHED; G8_LDA(At, 1, 0); G8_STAGE(G8_SA(0, 1), a2, vA1);
            G8_WAIT_L(8); G8_BAR; G8_WAIT_L(0); G8_MMA(0, 0, At, B0); G8_BAR; G8_SCHED;
            G8_LDB(B1, 1, 1); G8_STAGE(G8_SB(1, 0), b3, voffB);
            G8_BAR; G8_WAIT_L(0); G8_MMA(0, 1, At, B1); G8_BAR;
            G8_LDA(At, 1, 1); G8_STAGE(G8_SA(1, 0), a3, vA0);
            G8_BAR; G8_WAIT_L(0); G8_MMA(1, 0, At, B0); G8_BAR; G8_SCHED;
            G8_STAGE(G8_SB(1, 1), b3 + hstep, voffB);
            G8_WAIT_V(6); G8_BAR; G8_MMA(1, 1, At, B1); G8_BAR;
        }
        E(acc, cur, wr, wc, fr, fq);
        if (!has_next) break;
#pragma unroll
        for (int a = 0; a < 2; ++a)
#pragma unroll
            for (int b = 0; b < 2; ++b)
#pragma unroll
                for (int m = 0; m < 4; ++m)
#pragma unroll
                    for (int n = 0; n < 2; ++n) acc[a][b][m][n] = (f32x4){0.f, 0.f, 0.f, 0.f};
        cur = nxt; cB = nB; ++ui;
    }
    G8_WAIT_V(0);
    if (wr == 0) G8_BAR;
    G8_BAR;
#undef G8_SA
#undef G8_SB
#undef G8_STAGE
#undef G8_LDA
#undef G8_LDB
#undef G8_MMA
#undef G8_WAIT_V
#undef G8_WAIT_L
#undef G8_BAR
#undef G8_SCHED
}
}

struct Args { const float* in[29]; float* out; unsigned char* ws; int ph_lo, ph_hi; };
enum { I_X = 0, I_C, I_CTX, I_CCTX, I_WMOD, I_BMOD, I_G1, I_G2, I_WIN, I_GWF, I_GBF, I_GWB, I_GBB, I_GOUT, I_CONFW, I_CONFB, I_CONFG, I_CONFBETA, I_SCW, I_POOLW, I_POOLS, I_WOUT, I_RWG, I_RBG, I_RWE, I_RBE, I_EIN, I_EOUT, I_GFINAL };

__device__ __forceinline__ void transpose_item(const float* W, int K, int N, bf16_t* WT, int kb, int n0, int dst_row0, LAS float* scr, int lane) {
    const int k0 = 64 * kb;
#pragma unroll 8
    for (int i = 0; i < 32; ++i) { const int kk = 2 * i + (lane >> 5); scr[kk * 33 + (lane & 31)] = W[(size_t)(k0 + kk) * N + n0 + (lane & 31)]; }
    LDS_WAIT(); asm volatile("" ::: "memory");
    const int c = lane & 7;
#pragma unroll
    for (int j = 0; j < 4; ++j) { const int n = (lane >> 3) + 8 * j; const LAS float* s = scr + (8 * c) * 33 + n;
        u32x4 o; o.x = pk2(s[0 * 33], s[1 * 33]); o.y = pk2(s[2 * 33], s[3 * 33]); o.z = pk2(s[4 * 33], s[5 * 33]); o.w = pk2(s[6 * 33], s[7 * 33]);
        *(u32x4*)(WT + (size_t)(dst_row0 + n) * K + k0 + 8 * c) = o; }
    LDS_WAIT(); asm volatile("" ::: "memory");
}

__device__ __forceinline__ void phase_p0(const Args& a, LAS unsigned char* lds) {
    const int tid = tid_now(), lane = tid & 63, wid = __builtin_amdgcn_readfirstlane(tid >> 6);
    unsigned char* ws = a.ws;
    for (int job = blockIdx.x; job < 192; job += gridDim.x) {
        const int l = job / 96, n0 = (job % 96) * 64;
        LAS float* sv = (LAS float*)lds;
        LAS float* red = (LAS float*)(lds + 5 * 1024 * 4);
        for (int i = tid; i < 5 * 1024; i += 512) { const int r = i >> 10, k = i & 1023; const float v = r < 4 ? a.in[I_C][r * 1024 + k] : a.in[I_CCTX][k]; sv[i] = siluf_(v); }
        __syncthreads();
        const int ks = tid >> 6, col = tid & 63;
        const float* w = a.in[I_WMOD] + (size_t)l * 1024 * 6144 + (size_t)(ks * 128) * 6144 + n0 + col;
        float acc[5] = {0.f, 0.f, 0.f, 0.f, 0.f};
#pragma unroll 8
        for (int k = 0; k < 128; ++k) { const float wv = w[(size_t)k * 6144];
#pragma unroll
            for (int r = 0; r < 5; ++r) acc[r] += sv[r * 1024 + ks * 128 + k] * wv; }
#pragma unroll
        for (int r = 0; r < 5; ++r) red[(ks * 5 + r) * 64 + col] = acc[r];
        __syncthreads();
        if (tid < 320) { const int r = tid >> 6; float s = 0.f;
#pragma unroll
            for (int q = 0; q < 8; ++q) s += red[(q * 5 + r) * 64 + col];
            ((float*)(ws + WS_MOD))[(size_t)(l * 5 + r) * 6144 + n0 + col] = s + a.in[I_BMOD][l * 6144 + n0 + col]; }
        __syncthreads();
    }
    LAS float* scr = (LAS float*)(lds + wid * 16384);
    const int gw = blockIdx.x * 8 + wid, NGW = gridDim.x * 8;
    constexpr int I_IN = 16 * 73, I_OUT = 16 * 32, I_EI = 16 * 32, I_EO = 8 * 32;
    constexpr int N_IN = 2 * I_IN, N_OUT = 2 * I_OUT, N_EI = 64 * I_EI, N_EO = 64 * I_EO, NITEMS = N_IN + N_OUT + N_EI + N_EO;
    for (int it = gw; it < NITEMS; it += NGW) {
        int r = it;
        if (r < N_IN) { const int l = r / I_IN, q = r % I_IN, kb = q / 73, nb = q % 73;
            transpose_item(a.in[I_WIN] + (size_t)l * 1024 * NIN, 1024, NIN, (bf16_t*)(ws + WS_WIN) + (size_t)l * NINP * 1024, kb, nb * 32, nb * 32, scr, lane); continue; }
        r -= N_IN;
        if (r < N_OUT) { const int l = r / I_OUT, q = r % I_OUT, kb = q / 32, nb = q % 32;
            transpose_item(a.in[I_WOUT] + (size_t)l * 1024 * 1024, 1024, 1024, (bf16_t*)(ws + WS_WOUT) + (size_t)l * 1024 * 1024, kb, nb * 32, nb * 32, scr, lane); continue; }
        r -= N_OUT;
        if (r < N_EI) { const int le = r / I_EI, q = r % I_EI, kb = q / 32, nb = q % 32, n0 = nb * 32;
            const int dst = n0 < 512 ? (256 * (n0 >> 7) + (n0 & 127)) : (256 * ((n0 - 512) >> 7) + 128 + ((n0 - 512) & 127));
            transpose_item(a.in[I_EIN] + (size_t)le * 1024 * 1024, 1024, 1024, (bf16_t*)(ws + WS_WEIN) + (size_t)le * 1024 * 1024, kb, n0, dst, scr, lane); continue; }
        r -= N_EI;
        { const int le = r / I_EO, q = r % I_EO, kb = q / 32, nb = q % 32;
            transpose_item(a.in[I_EOUT] + (size_t)le * 512 * 1024, 512, 1024, (bf16_t*)(ws + WS_WEOUT) + (size_t)le * 1024 * 512, kb, nb * 32, nb * 32, scr, lane); }
    }
    for (int i = blockIdx.x * 512 + tid; i < 2 * 224 * 1024 / 8; i += gridDim.x * 512) { const int l = i / (224 * 128), q = i % (224 * 128);
        *(u32x4*)((bf16_t*)(ws + WS_WIN) + (size_t)l * NINP * 1024 + (size_t)NIN * 1024 + (size_t)q * 8) = (u32x4){0u, 0u, 0u, 0u}; }
}

__device__ __forceinline__ void load_row(const float* xrow, int lane, f32x4 (&v)[4]) {
    const f32x4* xr = (const f32x4*)xrow + lane;
#pragma unroll
    for (int j = 0; j < 4; ++j) v[j] = xr[64 * j];
}
__device__ __forceinline__ float row_rstd(const f32x4 (&v)[4]) {
    float s = 0.f;
#pragma unroll
    for (int j = 0; j < 4; ++j) s += (v[j].x * v[j].x + v[j].y * v[j].y) + (v[j].z * v[j].z + v[j].w * v[j].w);
    return rsqrtf(wave_sum(s) * (1.0f / D) + EPS);
}
__device__ __forceinline__ void norm_mod_store(f32x4 (&v)[4], float rstd, const float* g, const float* sc, const float* sh, bf16_t* hrow, int lane) {
#pragma unroll
    for (int j = 0; j < 4; ++j) { const f32x4 gv = *((const f32x4*)g + lane + 64 * j), scv = *((const f32x4*)sc + lane + 64 * j), shv = *((const f32x4*)sh + lane + 64 * j);
        v[j] = (v[j] * rstd * gv) * (1.0f + scv) + shv;
        u32x2 w; w.x = pk2(v[j].x, v[j].y); w.y = pk2(v[j].z, v[j].w);
        *((u32x2*)hrow + lane + 64 * j) = w; }
}

__device__ __forceinline__ void phase_norm1_l0(const Args& a) {
    const int lane = tid_now() & 63, wid = tid_now() >> 6, gw = blockIdx.x * 8 + wid, NGW = gridDim.x * 8;
    const float* MOD = (const float*)(a.ws + WS_MOD); bf16_t* H = (bf16_t*)(a.ws + WS_H);
    for (int m = gw; m < MTOT; m += 2 * NGW) {
        const int m2 = m + NGW; const bool has2 = m2 < MTOT; const int m2c = has2 ? m2 : m;
        const float* src = m < NLAT ? a.in[I_X] + (size_t)m * D : a.in[I_CTX] + (size_t)(m - NLAT) * D;
        const float* src2 = m2c < NLAT ? a.in[I_X] + (size_t)m2c * D : a.in[I_CTX] + (size_t)(m2c - NLAT) * D;
        const int b = m < NLAT ? (m >> 13) : 4, b2 = m2c < NLAT ? (m2c >> 13) : 4;
        f32x4 v[4], v2[4]; load_row(src, lane, v); load_row(src2, lane, v2);
        const float rstd = row_rstd(v), rstd2 = row_rstd(v2);
        const float* mod = MOD + (size_t)b * 6144; const float* mod2 = MOD + (size_t)b2 * 6144;
        norm_mod_store(v, rstd, a.in[I_G1], mod + 1024, mod, H + (size_t)m * D, lane);
        if (has2) norm_mod_store(v2, rstd2, a.in[I_G1], mod2 + 1024, mod2, H + (size_t)m2 * D, lane);
    }
}

struct ChunkPos { int b, sf, sb; };
__device__ __forceinline__ ChunkPos chunk_pos(int chunk) {
    ChunkPos p;
    if (chunk < 512) { p.b = chunk >> 7; const int n = chunk & 127; p.sf = 4 + n; p.sb = 4 + 127 - n; }
    else { const int cc = chunk - 512; p.b = cc >> 2; const int n = cc & 3; p.sf = n; p.sb = 3 - n; }
    return p;
}

__device__ __forceinline__ void gla_gates(const Args& a, int l, int h, const bf16_t* cols0, LAS float* Z, LAS float* WG, LAS float* LA) {
    const int tid = tid_now();
    if (tid < 256) { const int t = tid >> 2, seg = tid & 3; const u32x4 w = *(const u32x4*)(cols0 + (size_t)t * NINP + C_ZF + seg * 8); float f[8]; unpack8(w, f);
#pragma unroll
        for (int i = 0; i < 8; ++i) Z[t * 32 + seg * 8 + i] = f[i]; }
    else { const int q = tid - 256;
        const int dir = q >> 7, rr = (q >> 3) & 15, d4 = (q & 7) * 4; const float* wsrc = a.in[dir ? I_GWB : I_GWF] + (size_t)l * 16 * 128 + rr * 128 + 32 * h + d4;
#pragma unroll
        for (int i = 0; i < 4; ++i) WG[(dir * 16 + rr) * 32 + d4 + i] = wsrc[i];
        if (q < 64) { const int dd = q >> 5, d = q & 31; WG[1024 + dd * 32 + d] = a.in[dd ? I_GBB : I_GBF][l * 128 + 32 * h + d]; } }
    __syncthreads();
    { const int dir = tid >> 8, t = (tid >> 2) & 63, d0 = (tid & 3) * 8;
        float s[8];
#pragma unroll
        for (int i = 0; i < 8; ++i) s[i] = WG[1024 + dir * 32 + d0 + i];
#pragma unroll
        for (int r = 0; r < 16; ++r) { const float zv = Z[t * 32 + dir * 16 + r];
#pragma unroll
            for (int i = 0; i < 8; ++i) s[i] += zv * WG[(dir * 16 + r) * 32 + d0 + i]; }
#pragma unroll
        for (int i = 0; i < 8; ++i) LA[(dir * 64 + t) * 32 + d0 + i] = logsigf_(s[i]) * (1.0f / 16.0f); }
    __syncthreads();
}

__device__ __forceinline__ void phase_chunk(const Args& a, int l, LAS unsigned char* lds) {
    const int tid = tid_now();
    const bf16_t* COLS = (const bf16_t*)(a.ws + WS_COLS);
    float* KV = (float*)(a.ws + WS_KV); float* DEC = (float*)(a.ws + WS_DEC);
    LAS float* Kt = (LAS float*)lds;
    LAS float* Vt = Kt + 2048;
    LAS float* Z = Vt + 4096;
    LAS float* WG = Z + 2048;
    LAS float* LA = WG + 1088;
    for (int it = blockIdx.x; it < NCHUNK * 5; it += gridDim.x) {
        const int chunk = it / 5, part = it % 5; const int row0 = chunk * 64;
        if (part == 4) {
            if (chunk < 512) {
                float* AGV = (float*)(a.ws + WS_AGV); float* CXV = (float*)(a.ws + WS_CXV);
#pragma unroll
                for (int rep = 0; rep < 2; ++rep) { const int idx = tid + rep * 512, t = idx >> 4, c8 = (idx & 15) * 8; const bf16_t* rp = COLS + (size_t)(row0 + t) * NINP;
                    float fa[8], fg[8], fc[8], fx[8];
                    unpack8(*(const u32x4*)(rp + C_CA + 128 + c8), fa); unpack8(*(const u32x4*)(rp + C_CG + 128 + c8), fg);
                    unpack8(*(const u32x4*)(rp + C_SC + 128 + c8), fc); unpack8(*(const u32x4*)(rp + C_SX + 128 + c8), fx);
                    f32x4 o0, o1, p0, p1;
#pragma unroll
                    for (int i = 0; i < 4; ++i) { o0[i] = fa[i] * sigmoidf_(fg[i]); o1[i] = fa[4 + i] * sigmoidf_(fg[4 + i]); p0[i] = fc[i] * fx[i]; p1[i] = fc[4 + i] * fx[4 + i]; }
                    float* ao = AGV + (size_t)(row0 + t) * 128 + c8; float* co = CXV + (size_t)(row0 + t) * 128 + c8;
                    *(f32x4*)ao = o0; *(f32x4*)(ao + 4) = o1; *(f32x4*)co = p0; *(f32x4*)(co + 4) = p1; }
            }
            continue;
        }
        const int h = part; const ChunkPos cp = chunk_pos(chunk);
        const bf16_t* cols0 = COLS + (size_t)row0 * NINP;
        if (tid < 256) { const int t = tid >> 2, seg = tid & 3; float f[8]; unpack8(*(const u32x4*)(cols0 + (size_t)t * NINP + C_K + 32 * h + seg * 8), f);
#pragma unroll
            for (int i = 0; i < 8; ++i) Kt[t * 32 + seg * 8 + i] = f[i]; }
        { const int t = tid >> 3, seg = tid & 7; float f[8]; unpack8(*(const u32x4*)(cols0 + (size_t)t * NINP + C_V + 64 * h + seg * 8), f);
#pragma unroll
            for (int i = 0; i < 8; ++i) Vt[t * 64 + seg * 8 + i] = f[i]; }
        gla_gates(a, l, h, cols0, Z, WG, LA);
        if (tid < 64) { const int dir = tid >> 5, d = tid & 31; LAS float* p = LA + dir * 2048 + d;
            if (dir == 0) { float tot = 0.f; for (int t = 0; t < 64; ++t) tot += p[t * 32];
                float run = 0.f; for (int t = 0; t < 64; ++t) { run += p[t * 32]; p[t * 32] = __expf(tot - run); }
                DEC[((size_t)((0 * 4 + cp.b) * 4 + h) * NSEQ + cp.sf) * 32 + d] = __expf(tot); }
            else { float run = 0.f; for (int t = 0; t < 64; ++t) { const float la = p[t * 32]; p[t * 32] = __expf(run); run += la; }
                DEC[((size_t)((1 * 4 + cp.b) * 4 + h) * NSEQ + cp.sb) * 32 + d] = __expf(run); } }
        __syncthreads();
        { const int dir = tid >> 8, d = (tid >> 3) & 31, cg8 = (tid & 7) * 8;
            float o[8] = {0.f, 0.f, 0.f, 0.f, 0.f, 0.f, 0.f, 0.f};
            for (int t = 0; t < 64; ++t) { const float kd = Kt[t * 32 + d] * LA[(dir * 64 + t) * 32 + d]; const f32x4 v0 = *(const LAS f32x4*)(Vt + t * 64 + cg8), v1 = *(const LAS f32x4*)(Vt + t * 64 + cg8 + 4);
#pragma unroll
                for (int i = 0; i < 4; ++i) { o[i] += kd * v0[i]; o[4 + i] += kd * v1[i]; } }
            float* dst = KV + ((size_t)((dir * 4 + cp.b) * 4 + h) * NSEQ + (dir ? cp.sb : cp.sf)) * 2048 + d * 64 + cg8;
            *(f32x4*)dst = (f32x4){o[0], o[1], o[2], o[3]}; *(f32x4*)(dst + 4) = (f32x4){o[4], o[5], o[6], o[7]}; }
        __syncthreads();
    }
}

template <int TAPS>
__device__ __forceinline__ void vconv_item(const float* SRC, float* DST, const float* w  , int b, int col, int chg, LAS float* buf, int lane) {
    const int ch = lane & 31, rh = lane >> 5;
    const size_t base = ((size_t)b * SEQ + col) * 128 + chg * 32 + ch;
#pragma unroll 8
    for (int r = 0; r < 128; r += 2) buf[(r + rh) * 32 + ch] = SRC[base + (size_t)(r + rh) * 64 * 128];
    float wt[TAPS];
#pragma unroll
    for (int j = 0; j < TAPS; ++j) wt[j] = w[j * 256 + chg * 32 + ch];
    LDS_WAIT(); asm volatile("" ::: "memory");
    constexpr int HW = TAPS / 2;
#pragma unroll 1
    for (int r0 = 0; r0 < 64; r0 += 8) {
        const int rb = rh * 64 + r0;
        float o[8] = {0.f, 0.f, 0.f, 0.f, 0.f, 0.f, 0.f, 0.f};
#pragma unroll
        for (int j = 0; j < TAPS + 7; ++j) { const int rin = rb - HW + j; const float x = (rin >= 0 && rin < 128) ? buf[rin * 32 + ch] : 0.f;
#pragma unroll
            for (int q = 0; q < 8; ++q) { if (j - q >= 0 && j - q < TAPS) o[q] += x * wt[j - q]; } }
#pragma unroll
        for (int q = 0; q < 8; ++q) DST[base + (size_t)(rb + q) * 64 * 128] = o[q];
    }
    LDS_WAIT(); asm volatile("" ::: "memory");
}
__device__ __forceinline__ void phase_scan(const Args& a, int l, LAS unsigned char* lds) {
    const int tid = tid_now(), lane = tid & 63, wid = __builtin_amdgcn_readfirstlane(tid >> 6);
    float* KV = (float*)(a.ws + WS_KV); const float* DEC = (const float*)(a.ws + WS_DEC);
    if (tid < 256) {
        for (int gid = blockIdx.x * 256 + tid; gid < 65536; gid += gridDim.x * 256) {
            const int e = gid >> 11, dc = gid & 2047;
            float* p = KV + (size_t)e * NSEQ * 2048 + dc; const float* dp = DEC + (size_t)e * NSEQ * 32 + (dc >> 6);
            float st = 0.f;
#pragma unroll 1
            for (int s = 0; s < NSEQ; s += 12) {
                float kv[12], dd[12];
#pragma unroll
                for (int q = 0; q < 12; ++q) { kv[q] = p[(size_t)(s + q) * 2048]; dd[q] = dp[(s + q) * 32]; }
#pragma unroll
                for (int q = 0; q < 12; ++q) { p[(size_t)(s + q) * 2048] = st; st = dd[q] * st + kv[q]; }
            }
        }
    }
    LAS float* buf = (LAS float*)(lds + wid * 16384);
    const int gw = blockIdx.x * 8 + wid, NGW = gridDim.x * 8;
    for (int it = gw; it < 2048; it += NGW) {
        const int kind = it >> 10, q = it & 1023, b = q >> 8, col = (q >> 2) & 63, chg = q & 3;
        if (kind == 0) vconv_item<31>((const float*)(a.ws + WS_AGV), (float*)(a.ws + WS_UV), a.in[I_CONFW] + (size_t)l * 31 * 256 + 128, b, col, chg, buf, lane);
        else vconv_item<3>((const float*)(a.ws + WS_CXV), (float*)(a.ws + WS_SCV), a.in[I_SCW] + (size_t)l * 3 * 256 + 128, b, col, chg, buf, lane);
    }
}

__device__ __forceinline__ void mixer_gla(const Args& a, int l, int tile, int h, LAS unsigned char* lds) {
    const int tid = tid_now();
    const bf16_t* COLS = (const bf16_t*)(a.ws + WS_COLS); const float* KV = (const float*)(a.ws + WS_KV); bf16_t* MIX = (bf16_t*)(a.ws + WS_MIX);
    LAS float* Q = (LAS float*)lds; LAS float* Kt = Q + 2048; LAS float* Z = Q + 4096; LAS float* V = Q + 6144; LAS float* WG = Q + 10240; LAS float* LA = Q + 11328;
    LAS float* QF = Q + 15424; LAS float* KF = Q + 17728; LAS float* QB = Q + 20032; LAS float* KB = Q + 22336; LAS float* SF = Q + 24640; LAS float* SB = Q + 26688; LAS float* P = Q;
    const int row0 = tile * 64; const ChunkPos cp = chunk_pos(tile);
    const bf16_t* cols0 = COLS + (size_t)row0 * NINP;
    { const int t = (tid & 255) >> 2, seg = tid & 3; float f[8];
        if (tid < 256) { unpack8(*(const u32x4*)(cols0 + (size_t)t * NINP + C_Q + 32 * h + seg * 8), f);
#pragma unroll
            for (int i = 0; i < 8; ++i) Q[t * 32 + seg * 8 + i] = f[i] * 0.17677669529663687f; }
        else { unpack8(*(const u32x4*)(cols0 + (size_t)t * NINP + C_K + 32 * h + seg * 8), f);
#pragma unroll
            for (int i = 0; i < 8; ++i) Kt[t * 32 + seg * 8 + i] = f[i]; } }
    { const int t = tid >> 3, seg = tid & 7; float f[8]; unpack8(*(const u32x4*)(cols0 + (size_t)t * NINP + C_V + 64 * h + seg * 8), f);
#pragma unroll
        for (int i = 0; i < 8; ++i) V[t * 64 + seg * 8 + i] = f[i]; }
    { const float* sf = KV + ((size_t)((0 * 4 + cp.b) * 4 + h) * NSEQ + cp.sf) * 2048; const float* sb = KV + ((size_t)((1 * 4 + cp.b) * 4 + h) * NSEQ + cp.sb) * 2048;
        *(LAS f32x4*)(SF + tid * 4) = *(const f32x4*)(sf + tid * 4); *(LAS f32x4*)(SB + tid * 4) = *(const f32x4*)(sb + tid * 4); }
    gla_gates(a, l, h, cols0, Z, WG, LA);
    if (tid < 64) { const int dir = tid >> 5, d = tid & 31; LAS float* p = LA + dir * 2048 + d;
        if (dir == 0) { float run = 0.f; for (int t = 0; t < 64; ++t) { run += p[t * 32]; p[t * 32] = run; } }
        else { float run = 0.f; for (int t = 63; t >= 0; --t) { run += p[t * 32]; p[t * 32] = run; } } }
    __syncthreads();
    { const int t = tid >> 3, d0 = (tid & 7) * 4;
#pragma unroll
        for (int i = 0; i < 4; ++i) { const int d = d0 + i; const float bf_ = LA[t * 32 + d], bb_ = LA[(64 + t) * 32 + d], q = Q[t * 32 + d], k = Kt[t * 32 + d];
            QF[t * 36 + d] = q * __expf(bf_); KF[t * 36 + d] = k * __expf(-bf_); QB[t * 36 + d] = q * __expf(bb_); KB[t * 36 + d] = k * __expf(-bb_); } }
    __syncthreads();
    { const int ib = tid >> 4, jb = tid & 15; const int i0 = 2 * ib, j0 = 4 * jb;
        float sfv[2][4], sbv[2][4];
#pragma unroll
        for (int x = 0; x < 2; ++x)
#pragma unroll
            for (int y = 0; y < 4; ++y) { sfv[x][y] = 0.f; sbv[x][y] = 0.f; }
#pragma unroll 1
        for (int d4 = 0; d4 < 32; d4 += 4) {
            f32x4 qf[2], qb[2], kf[4], kb[4];
#pragma unroll
            for (int x = 0; x < 2; ++x) { qf[x] = *(const LAS f32x4*)(QF + (i0 + x) * 36 + d4); qb[x] = *(const LAS f32x4*)(QB + (i0 + x) * 36 + d4); }
#pragma unroll
            for (int y = 0; y < 4; ++y) { kf[y] = *(const LAS f32x4*)(KF + (j0 + y) * 36 + d4); kb[y] = *(const LAS f32x4*)(KB + (j0 + y) * 36 + d4); }
#pragma unroll
            for (int x = 0; x < 2; ++x)
#pragma unroll
                for (int y = 0; y < 4; ++y) { sfv[x][y] += qf[x][0] * kf[y][0] + qf[x][1] * kf[y][1] + qf[x][2] * kf[y][2] + qf[x][3] * kf[y][3];
                    sbv[x][y] += qb[x][0] * kb[y][0] + qb[x][1] * kb[y][1] + qb[x][2] * kb[y][2] + qb[x][3] * kb[y][3]; }
        }
#pragma unroll
        for (int x = 0; x < 2; ++x) { f32x4 o;
#pragma unroll
            for (int y = 0; y < 4; ++y) { const int i = i0 + x, j = j0 + y; o[y] = (j <= i ? sfv[x][y] : 0.f) + (j >= i ? sbv[x][y] : 0.f); }
            *(LAS f32x4*)(P + (i0 + x) * 68 + j0) = o; }
    }
    __syncthreads();
    { const int ib = tid >> 4, cb = tid & 15; const int i0 = 2 * ib, c0 = 4 * cb;
        f32x4 o[2] = {(f32x4){0.f, 0.f, 0.f, 0.f}, (f32x4){0.f, 0.f, 0.f, 0.f}};
#pragma unroll 2
        for (int k4 = 0; k4 < 64; k4 += 4) { const f32x4 p0 = *(const LAS f32x4*)(P + i0 * 68 + k4), p1 = *(const LAS f32x4*)(P + (i0 + 1) * 68 + k4);
#pragma unroll
            for (int q = 0; q < 4; ++q) { const f32x4 vv = *(const LAS f32x4*)(V + (k4 + q) * 64 + c0); o[0] += p0[q] * vv; o[1] += p1[q] * vv; } }
#pragma unroll 2
        for (int k4 = 0; k4 < 32; k4 += 4) { const f32x4 p0 = *(const LAS f32x4*)(QF + i0 * 36 + k4), p1 = *(const LAS f32x4*)(QF + (i0 + 1) * 36 + k4), r0 = *(const LAS f32x4*)(QB + i0 * 36 + k4), r1 = *(const LAS f32x4*)(QB + (i0 + 1) * 36 + k4);
#pragma unroll
            for (int q = 0; q < 4; ++q) { const f32x4 s1 = *(const LAS f32x4*)(SF + (k4 + q) * 64 + c0), s2 = *(const LAS f32x4*)(SB + (k4 + q) * 64 + c0); o[0] += p0[q] * s1 + r0[q] * s2; o[1] += p1[q] * s1 + r1[q] * s2; } }
        const f32x4 gout = *(const f32x4*)(a.in[I_GOUT] + l * 256 + 64 * h + c0);
#pragma unroll
        for (int x = 0; x < 2; ++x) {
            float ss = (o[x][0] * o[x][0] + o[x][1] * o[x][1]) + (o[x][2] * o[x][2] + o[x][3] * o[x][3]);
            ss += __shfl_xor(ss, 1); ss += __shfl_xor(ss, 2); ss += __shfl_xor(ss, 4); ss += __shfl_xor(ss, 8);
            const float rs = rsqrtf(ss * (1.0f / 64.0f) + EPS);
            const u32x2 gw_ = *(const u32x2*)(cols0 + (size_t)(i0 + x) * NINP + C_G + 64 * h + c0);
            const float g0 = bflo(gw_.x), g1 = bfhi(gw_.x), g2 = bflo(gw_.y), g3 = bfhi(gw_.y);
            u32x2 w; w.x = pk2(o[x][0] * rs * gout[0] * siluf_(g0), o[x][1] * rs * gout[1] * siluf_(g1)); w.y = pk2(o[x][2] * rs * gout[2] * siluf_(g2), o[x][3] * rs * gout[3] * siluf_(g3));
            *(u32x2*)(MIX + (size_t)(row0 + i0 + x) * D + 64 * h + c0) = w; }
    }
    __syncthreads();
}

__device__ __forceinline__ void mixer_local(const Args& a, int l, int tile, int half, LAS unsigned char* lds) {
    const int tid = tid_now();
    const bf16_t* COLS = (const bf16_t*)(a.ws + WS_COLS); bf16_t* MIX = (bf16_t*)(a.ws + WS_MIX);
    LAS float* AG = (LAS float*)lds;
    LAS float* U = AG + 7936;
    LAS float* CX = U + 8192;
    const bool lat = tile < 512; const int r0 = tile * 64 + half * 32;
    const int seq_lo = lat ? tile * 64 : (NLAT + ((tile - 512) >> 2) * CTXL), seq_hi = lat ? tile * 64 + 64 : seq_lo + CTXL;
    const float* confw = a.in[I_CONFW] + (size_t)l * 31 * 256; const float* scw = a.in[I_SCW] + (size_t)l * 3 * 256;
    const int npass = lat ? 1 : 2;
    for (int ps = 0; ps < npass; ++ps) {
        const int chb = ps * 128;
        for (int idx = tid; idx < 62 * 16; idx += 512) { const int tt = idx >> 4, c8 = (idx & 15) * 8, r = r0 - 15 + tt;
            float o[8] = {0.f, 0.f, 0.f, 0.f, 0.f, 0.f, 0.f, 0.f};
            if (r >= seq_lo && r < seq_hi) { const bf16_t* rp = COLS + (size_t)r * NINP; float fa[8], fg[8]; unpack8(*(const u32x4*)(rp + C_CA + chb + c8), fa); unpack8(*(const u32x4*)(rp + C_CG + chb + c8), fg);
#pragma unroll
                for (int i = 0; i < 8; ++i) o[i] = fa[i] * sigmoidf_(fg[i]); }
            *(LAS f32x4*)(AG + tt * 128 + c8) = (f32x4){o[0], o[1], o[2], o[3]}; *(LAS f32x4*)(AG + tt * 128 + c8 + 4) = (f32x4){o[4], o[5], o[6], o[7]}; }
        for (int idx = tid; idx < 34 * 16; idx += 512) { const int tt = idx >> 4, c8 = (idx & 15) * 8, r = r0 - 1 + tt;
            float o[8] = {0.f, 0.f, 0.f, 0.f, 0.f, 0.f, 0.f, 0.f};
            if (r >= seq_lo && r < seq_hi) { const bf16_t* rp = COLS + (size_t)r * NINP; float fc[8], fx[8]; unpack8(*(const u32x4*)(rp + C_SC + chb + c8), fc); unpack8(*(const u32x4*)(rp + C_SX + chb + c8), fx);
#pragma unroll
                for (int i = 0; i < 8; ++i) o[i] = fc[i] * fx[i]; }
            *(LAS f32x4*)(CX + tt * 128 + c8) = (f32x4){o[0], o[1], o[2], o[3]}; *(LAS f32x4*)(CX + tt * 128 + c8 + 4) = (f32x4){o[4], o[5], o[6], o[7]}; }
        __syncthreads();
        { const int c = tid & 127, t0 = (tid >> 7) * 8;
            float wv[31];
#pragma unroll
            for (int j = 0; j < 31; ++j) wv[j] = confw[j * 256 + chb + c];
            const float bias = a.in[I_CONFB][l * 256 + chb + c];
            const float w0 = scw[chb + c], w1 = scw[256 + chb + c], w2 = scw[512 + chb + c];
            float o[8];
#pragma unroll
            for (int q = 0; q < 8; ++q) o[q] = bias;
#pragma unroll
            for (int j = 0; j < 38; ++j) { const float x = AG[(t0 + j) * 128 + c];
#pragma unroll
                for (int q = 0; q < 8; ++q) { if (j - q >= 0 && j - q < 31) o[q] += x * wv[j - q]; } }
#pragma unroll
            for (int q = 0; q < 8; ++q) U[(t0 + q) * 256 + chb + c] = o[q];
#pragma unroll
            for (int q = 0; q < 8; ++q) { const int t = t0 + q; const float cv = CX[t * 128 + c] * w0 + CX[(t + 1) * 128 + c] * w1 + CX[(t + 2) * 128 + c] * w2;
                const float sb = __uint_as_float(((unsigned)COLS[(size_t)(r0 + t) * NINP + C_SB + chb + c]) << 16);
                MIX[(size_t)(r0 + t) * D + 512 + chb + c] = (bf16_t)(pk2(sb * cv, 0.f) & 0xffffu); }
        }
        __syncthreads();
    }
    if (lat) {
        const float* UV = (const float*)(a.ws + WS_UV); const float* SCV = (const float*)(a.ws + WS_SCV);
        for (int idx = tid; idx < 32 * 32; idx += 512) { const int t = idx >> 5, c4 = (idx & 31) * 4;
            const f32x4 u = *(const f32x4*)(UV + (size_t)(r0 + t) * 128 + c4), bz = *(const f32x4*)(a.in[I_CONFB] + l * 256 + 128 + c4);
            *(LAS f32x4*)(U + t * 256 + 128 + c4) = u + bz;
            const f32x4 sv = *(const f32x4*)(SCV + (size_t)(r0 + t) * 128 + c4);
            const u32x2 sbw = *(const u32x2*)(COLS + (size_t)(r0 + t) * NINP + C_SB + 128 + c4);
            u32x2 w; w.x = pk2(bflo(sbw.x) * sv[0], bfhi(sbw.x) * sv[1]); w.y = pk2(bflo(sbw.y) * sv[2], bfhi(sbw.y) * sv[3]);
            *(u32x2*)(MIX + (size_t)(r0 + t) * D + 512 + 128 + c4) = w; }
        __syncthreads();
    }
    { const int t = tid >> 4, c0 = (tid & 15) * 16;
        float s = 0.f;
#pragma unroll
        for (int i = 0; i < 16; i += 4) { const f32x4 v = *(const LAS f32x4*)(U + t * 256 + c0 + i); s += (v[0] + v[1]) + (v[2] + v[3]); }
        s += __shfl_xor(s, 1); s += __shfl_xor(s, 2); s += __shfl_xor(s, 4); s += __shfl_xor(s, 8);
        const float mean = s * (1.0f / 256.0f); float q = 0.f;
#pragma unroll
        for (int i = 0; i < 16; i += 4) { const f32x4 v = *(const LAS f32x4*)(U + t * 256 + c0 + i) - mean; q += (v[0] * v[0] + v[1] * v[1]) + (v[2] * v[2] + v[3] * v[3]); }
        q += __shfl_xor(q, 1); q += __shfl_xor(q, 2); q += __shfl_xor(q, 4); q += __shfl_xor(q, 8);
        const float rstd = rsqrtf(q * (1.0f / 256.0f) + EPS);
        const float* lg = a.in[I_CONFG] + l * 256 + c0; const float* lb = a.in[I_CONFBETA] + l * 256 + c0;
#pragma unroll
        for (int i = 0; i < 16; i += 8) { float y[8];
#pragma unroll
            for (int k = 0; k < 8; ++k) y[k] = siluf_((U[t * 256 + c0 + i + k] - mean) * rstd * lg[i + k] + lb[i + k]);
            u32x4 w; w.x = pk2(y[0], y[1]); w.y = pk2(y[2], y[3]); w.z = pk2(y[4], y[5]); w.w = pk2(y[6], y[7]);
            *(u32x4*)(MIX + (size_t)(r0 + t) * D + 256 + c0 + i) = w; }
    }
    __syncthreads();
    for (int hf = 0; hf < 2; ++hf) {
        LAS float* PI = (LAS float*)lds;
        LAS float* DF = PI + 6144;
        LAS float* PW = DF + 4224;
        for (int idx = tid; idx < 48 * 16; idx += 512) { const int tt = idx >> 4, c8 = (idx & 15) * 8, r = r0 - 8 + tt;
            float o[8] = {0.f, 0.f, 0.f, 0.f, 0.f, 0.f, 0.f, 0.f};
            if (r >= seq_lo && r < seq_hi) unpack8(*(const u32x4*)(COLS + (size_t)r * NINP + C_PL + hf * 128 + c8), o);
            *(LAS f32x4*)(PI + tt * 128 + c8) = (f32x4){o[0], o[1], o[2], o[3]}; *(LAS f32x4*)(PI + tt * 128 + c8 + 4) = (f32x4){o[4], o[5], o[6], o[7]}; }
        for (int idx = tid; idx < 2 * 64 * 64 / 4; idx += 512) *(LAS f32x4*)(PW + idx * 4) = *(const f32x4*)(a.in[I_POOLW] + (size_t)l * 4 * 4096 + (size_t)hf * 2 * 4096 + idx * 4);
        __syncthreads();
        for (int idx = tid; idx < 32 * 128; idx += 512) { const int t = idx >> 7, c = idx & 127, g = hf * 2 + (c >> 6); const int hw = 1 << g;
            const int r = r0 + t; int lo = r - hw, hi = r + hw; lo = lo < seq_lo ? seq_lo : lo; hi = hi > seq_hi ? seq_hi : hi;
            float sm = 0.f; for (int rr = lo; rr < hi; ++rr) sm += PI[(rr - r0 + 8) * 128 + c];
            DF[t * 132 + c] = sm / (float)(hi - lo) - PI[(t + 8) * 128 + c]; }
        __syncthreads();
        { const int gl = tid >> 8, tp = (tid >> 4) & 15, dq = tid & 15; const int dd0 = dq * 4;
            f32x4 o[2] = {(f32x4){0.f, 0.f, 0.f, 0.f}, (f32x4){0.f, 0.f, 0.f, 0.f}};
#pragma unroll 2
            for (int c4 = 0; c4 < 64; c4 += 4) { f32x4 dv[2];
#pragma unroll
                for (int x = 0; x < 2; ++x) dv[x] = *(const LAS f32x4*)(DF + (tp * 2 + x) * 132 + gl * 64 + c4);
#pragma unroll
                for (int q = 0; q < 4; ++q) { const f32x4 wv = *(const LAS f32x4*)(PW + (gl * 64 + c4 + q) * 64 + dd0);
#pragma unroll
                    for (int x = 0; x < 2; ++x) o[x] += dv[x][q] * wv; } }
            const int ch = (hf * 2 + gl) * 64 + dd0; const f32x4 ps = *(const f32x4*)(a.in[I_POOLS] + l * 256 + ch);
#pragma unroll
            for (int x = 0; x < 2; ++x) { u32x2 w; w.x = pk2(o[x][0] * ps[0], o[x][1] * ps[1]); w.y = pk2(o[x][2] * ps[2], o[x][3] * ps[3]);
                *(u32x2*)(MIX + (size_t)(r0 + tp * 2 + x) * D + 768 + ch) = w; } }
        __syncthreads();
    }
}

__device__ __forceinline__ void phase_mixer(const Args& a, int l, LAS unsigned char* lds) {
    const int ntile = (l == 1) ? 512 : NCHUNK;
    for (int it = blockIdx.x; it < ntile * 6; it += gridDim.x) { const int tile = it / 6, part = it % 6;
        if (part < 4) mixer_gla(a, l, tile, part, lds); else mixer_local(a, l, tile, part - 4, lds); }
}

__device__ __forceinline__ void phase_router(const Args& a, int l, LAS unsigned char* lds) {
    const int tid = tid_now(), lane = tid & 63, wid = tid >> 6;
    const int M = (l == 1) ? NLAT : MTOT;
    const float* MOD = (const float*)(a.ws + WS_MOD) + (size_t)l * 5 * 6144; bf16_t* H = (bf16_t*)(a.ws + WS_H);
    LAS float* WRE = (LAS float*)lds;
    LAS int* INFO = (LAS int*)(lds + MISC_OFF + 4096);
    LAS int* HIST = (LAS int*)(lds + MISC_OFF + 2048);
    const float* wre = a.in[I_RWE] + (size_t)l * 1024 * 32; const float* wrg = a.in[I_RWG] + (size_t)l * 1024 * 4;
    for (int i = tid; i < 1024 * 8; i += 512) { const int k = i >> 3, q = i & 7; *(LAS f32x4*)(WRE + k * 32 + ((q ^ ((k >> 2) & 7)) << 2)) = *(const f32x4*)(wre + k * 32 + q * 4); }
    if (tid < 64) HIST[tid] = 0;
    __syncthreads();
    const int per = (M + gridDim.x - 1) / gridDim.x; const int r_lo = blockIdx.x * per; int r_hi = r_lo + per; if (r_hi > M) r_hi = M;
    const float rbg0 = a.in[I_RBG][l * 4 + 0], rbg1 = a.in[I_RBG][l * 4 + 1], rbg2 = a.in[I_RBG][l * 4 + 2], rbg3 = a.in[I_RBG][l * 4 + 3];
    const float* X0lat = l == 0 ? a.in[I_X] : a.out; const float* X0ctx = l == 0 ? a.in[I_CTX] : (const float*)(a.ws + WS_XCTX);
    float* X1lat = a.out; float* X1ctx = (float*)(a.ws + WS_XCTX); const bf16_t* Y1 = (const bf16_t*)(a.ws + WS_Y);
#pragma unroll 1
    for (int mm = r_lo + wid; mm < r_hi; mm += 16) {
        f32x4 vv[2][4]; u32x2 yy[2][4]; int mrow[2]; bool has[2];
#pragma unroll
        for (int rr = 0; rr < 2; ++rr) { const int m = mm + 8 * rr; has[rr] = m < r_hi; const int mc = has[rr] ? m : mm; mrow[rr] = mc;
            const float* src = mc < NLAT ? X0lat + (size_t)mc * D : X0ctx + (size_t)(mc - NLAT) * D;
            load_row(src, lane, vv[rr]);
#pragma unroll
            for (int j = 0; j < 4; ++j) yy[rr][j] = *((const u32x2*)(Y1 + (size_t)mc * D) + lane + 64 * j); }
#pragma unroll
        for (int rr = 0; rr < 2; ++rr) {
            if (!has[rr]) continue;
            const int m = mrow[rr]; const int b = m < NLAT ? (m >> 13) : 4;
            const float* mod = MOD + (size_t)b * 6144;
            float* dst = m < NLAT ? X1lat + (size_t)m * D : X1ctx + (size_t)(m - NLAT) * D;
            f32x4 v[4];
#pragma unroll
            for (int j = 0; j < 4; ++j) { const f32x4 g = *((const f32x4*)(mod + 2 * 1024) + lane + 64 * j); const u32x2 y = yy[rr][j];
                v[j] = vv[rr][j] + g * (f32x4){bflo(y.x), bfhi(y.x), bflo(y.y), bfhi(y.y)};
                *((f32x4*)dst + lane + 64 * j) = v[j]; }
            const float rstd = row_rstd(v);
            norm_mod_store(v, rstd, a.in[I_G2] + l * 1024, mod + 4 * 1024, mod + 3 * 1024, H + (size_t)m * D, lane);
            f32x4 lgv = (f32x4){0.f, 0.f, 0.f, 0.f};
#pragma unroll
            for (int j = 0; j < 4; ++j)
#pragma unroll
                for (int i = 0; i < 4; ++i) { const int k = 256 * j + 4 * lane + i; lgv += v[j][i] * *(const f32x4*)(wrg + k * 4); }
            float lg0 = wave_sum(lgv[0]) + rbg0, lg1 = wave_sum(lgv[1]) + rbg1, lg2 = wave_sum(lgv[2]) + rbg2, lg3 = wave_sum(lgv[3]) + rbg3;
            int grp = 0; float best = lg0; if (lg1 > best) { best = lg1; grp = 1; } if (lg2 > best) { best = lg2; grp = 2; } if (lg3 > best) { best = lg3; grp = 3; }
            const float pg = 1.0f / (__expf(lg0 - best) + __expf(lg1 - best) + __expf(lg2 - best) + __expf(lg3 - best));
            grp = __builtin_amdgcn_readfirstlane(grp);
            f32x4 e0 = (f32x4){0.f, 0.f, 0.f, 0.f}, e1 = (f32x4){0.f, 0.f, 0.f, 0.f};
#pragma unroll
            for (int j = 0; j < 4; ++j)
#pragma unroll
                for (int i = 0; i < 4; ++i) { const int k = 256 * j + 4 * lane + i; const int sw = (k >> 2) & 7;
                    e0 += v[j][i] * *(const LAS f32x4*)(WRE + k * 32 + (((2 * grp) ^ sw) << 2)); e1 += v[j][i] * *(const LAS f32x4*)(WRE + k * 32 + (((2 * grp + 1) ^ sw) << 2)); }
            float le[8];
#pragma unroll
            for (int i = 0; i < 4; ++i) { le[i] = wave_sum(e0[i]) + a.in[I_RBE][l * 32 + grp * 8 + i]; le[4 + i] = wave_sum(e1[i]) + a.in[I_RBE][l * 32 + grp * 8 + 4 + i]; }
            int i0 = 0; float v0 = le[0];
#pragma unroll
            for (int i = 1; i < 8; ++i) if (le[i] > v0) { v0 = le[i]; i0 = i; }
            int i1 = -1; float v1 = -3.0e38f;
#pragma unroll
            for (int i = 0; i < 8; ++i) if (i != i0 && le[i] > v1) { v1 = le[i]; i1 = i; }
            const float w0 = 1.0f / (1.0f + __expf(v1 - v0)); const float w1 = 1.0f - w0;
            if (lane == 0) { const int lr = m - r_lo; INFO[lr * 4 + 0] = grp * 8 + i0; INFO[lr * 4 + 1] = grp * 8 + i1; INFO[lr * 4 + 2] = __float_as_int(w0 * pg); INFO[lr * 4 + 3] = __float_as_int(w1 * pg); }
        }
    }
    __syncthreads();
    const int nr = r_hi - r_lo; int lp0 = 0, lp1 = 0, ee0 = 0, ee1 = 0;
    if (tid < nr) { ee0 = INFO[tid * 4 + 0]; ee1 = INFO[tid * 4 + 1]; lp0 = atomicAdd((int*)(HIST + ee0), 1); lp1 = atomicAdd((int*)(HIST + ee1), 1); }
    __syncthreads();
    unsigned* cnt = (unsigned*)(a.ws + WS_CTL) + CW_CNT + l * 32 * 64;
    if (tid < 32) { const int c = HIST[tid]; HIST[32 + tid] = c ? (int)atomicAdd(cnt + tid * 64, (unsigned)c) : 0; }
    __syncthreads();
    if (tid < nr) { const int m = r_lo + tid; const int p0 = HIST[32 + ee0] + lp0, p1 = HIST[32 + ee1] + lp1;
        int* TL = (int*)(a.ws + WS_TOKLIST); TL[ee0 * MTOT + p0] = m; TL[ee1 * MTOT + p1] = m;
        *((i32x4*)(a.ws + WS_TOKINFO) + m) = (i32x4){(ee0 << 20) | p0, (ee1 << 20) | p1, INFO[tid * 4 + 2], INFO[tid * 4 + 3]}; }
    __syncthreads();
}

__device__ __forceinline__ int moe_tables(const Args& a, int l, LAS unsigned char* lds) {
    LAS int* TB = (LAS int*)(lds + MISC_OFF + 256); LAS int* CN = TB + 64; LAS int* TE = (LAS int*)(lds + MISC_OFF + 1024); LAS int* TM = TE + 320;
    const unsigned* cnt = (const unsigned*)(a.ws + WS_CTL) + CW_CNT + l * 32 * 64;
    { const int tq_ = tid_now(); if (tq_ < 32) CN[tq_] = (int)__hip_atomic_load(cnt + tq_ * 64, __ATOMIC_RELAXED, __HIP_MEMORY_SCOPE_AGENT); }
    __syncthreads();
    if (tid_now() == 0) { int t = 0;
#pragma unroll 1
        for (int e = 0; e < 32; ++e) { TB[e] = t; const int nt = (CN[e] + 255) >> 8;
#pragma unroll 1
            for (int q = 0; q < nt; ++q) { TE[t + q] = e; TM[t + q] = q; } t += nt; } TB[32] = t; }
    __syncthreads();
    return __builtin_amdgcn_readfirstlane(TB[32]);
}

__device__ __forceinline__ void phase_combine(const Args& a, int l, LAS unsigned char* lds) {
    const int lane = tid_now() & 63, wid = tid_now() >> 6, gw = blockIdx.x * 8 + wid, NGW = gridDim.x * 8;
    const int M = (l == 1) ? NLAT : MTOT;
    (void)moe_tables(a, l, lds);
    const LAS int* TB = (const LAS int*)(lds + MISC_OFF + 256);
    const float* MOD = (const float*)(a.ws + WS_MOD); const bf16_t* Y = (const bf16_t*)(a.ws + WS_Y); bf16_t* H = (bf16_t*)(a.ws + WS_H);
    float* Xlat = a.out; float* Xctx = (float*)(a.ws + WS_XCTX);
#pragma unroll 1
    for (int mm = gw; mm < M; mm += 2 * NGW) {
        f32x4 vv[2][4]; u32x2 ya[2][4], yb[2][4]; i32x4 inf[2]; int mrow[2]; bool has[2];
#pragma unroll
        for (int rr = 0; rr < 2; ++rr) { const int m = mm + rr * NGW; has[rr] = m < M; const int mc = has[rr] ? m : mm; mrow[rr] = mc;
            inf[rr] = *((const i32x4*)(a.ws + WS_TOKINFO) + mc);
            const float* xr = mc < NLAT ? Xlat + (size_t)mc * D : Xctx + (size_t)(mc - NLAT) * D; load_row(xr, lane, vv[rr]); }
#pragma unroll
        for (int rr = 0; rr < 2; ++rr) { const int e0 = inf[rr].x >> 20, p0 = inf[rr].x & 0xfffff, e1 = inf[rr].y >> 20, p1 = inf[rr].y & 0xfffff;
            const bf16_t* y0 = Y + (size_t)(TB[e0] * 256 + p0) * D; const bf16_t* y1 = Y + (size_t)(TB[e1] * 256 + p1) * D;
#pragma unroll
            for (int j = 0; j < 4; ++j) { ya[rr][j] = *((const u32x2*)y0 + lane + 64 * j); yb[rr][j] = *((const u32x2*)y1 + lane + 64 * j); } }
#pragma unroll
        for (int rr = 0; rr < 2; ++rr) {
            if (!has[rr]) continue;
            const int m = mrow[rr]; const int b = m < NLAT ? (m >> 13) : 4;
            float* xr = m < NLAT ? Xlat + (size_t)m * D : Xctx + (size_t)(m - NLAT) * D;
            const float w0 = __int_as_float(inf[rr].z), w1 = __int_as_float(inf[rr].w);
            const float* ga2 = MOD + (size_t)(l * 5 + b) * 6144 + 5 * 1024;
            f32x4 v[4];
#pragma unroll
            for (int j = 0; j < 4; ++j) { const u32x2 a0 = ya[rr][j], a1 = yb[rr][j]; const f32x4 g = *((const f32x4*)ga2 + lane + 64 * j);
                f32x4 y; y[0] = w0 * bflo(a0.x) + w1 * bflo(a1.x); y[1] = w0 * bfhi(a0.x) + w1 * bfhi(a1.x); y[2] = w0 * bflo(a0.y) + w1 * bflo(a1.y); y[3] = w0 * bfhi(a0.y) + w1 * bfhi(a1.y);
                v[j] = vv[rr][j] + g * y; }
            const float rstd = row_rstd(v);
            if (l == 0) {
#pragma unroll
                for (int j = 0; j < 4; ++j) *((f32x4*)xr + lane + 64 * j) = v[j];
                const float* mod = MOD + (size_t)(5 + b) * 6144;
                norm_mod_store(v, rstd, a.in[I_G1] + 1024, mod + 1024, mod, H + (size_t)m * D, lane);
            } else {
#pragma unroll
                for (int j = 0; j < 4; ++j) { const f32x4 g = *((const f32x4*)a.in[I_GFINAL] + lane + 64 * j); *((f32x4*)xr + lane + 64 * j) = v[j] * rstd * g; }
            }
        }
    }
}

#define XB_TMO      128
#define XB_XCNT(j)  (256  + 64 * (j))
#define XB_XSUB(j)  (1280 + 64 * (j))
#define XB_XGEN(j)  (2304 + 64 * (j))
#define XB_TOP      3328
#define XB_TOPGEN   3392
#define XCD_BAR_WORDS 3456
#define XB_SPIN_CAP (1u << 22)
__device__ __forceinline__ unsigned xb_ld(unsigned* p)              { return __hip_atomic_load(p, __ATOMIC_RELAXED, __HIP_MEMORY_SCOPE_AGENT); }
__device__ __forceinline__ unsigned xb_add(unsigned* p, unsigned v) { return __hip_atomic_fetch_add(p, v, __ATOMIC_RELAXED, __HIP_MEMORY_SCOPE_AGENT); }
__device__ __forceinline__ unsigned xb_xcc_id() { return (unsigned)__builtin_amdgcn_s_getreg((3 << 11) | 20) & 0xFu; }
#define XB_SPIN(cond, bar) do { unsigned _sp = 0; while (cond) { __builtin_amdgcn_s_sleep(1); \
    if ((++_sp & 255u) == 0u) { if (xb_ld(&(bar)[XB_TMO])) break; if (_sp > XB_SPIN_CAP) { atomicAdd(&(bar)[XB_TMO], 1u); break; } } } } while (0)
struct XcdBarrier { unsigned* bar; unsigned x; volatile LAS unsigned* st; };
__device__ __forceinline__ XcdBarrier xcd_barrier_post(unsigned* bar, volatile LAS unsigned* st) {
    XcdBarrier b; b.bar = bar; b.x = xb_xcc_id(); b.st = st;
    if (threadIdx.x == 0) (void)xb_add(&bar[XB_XCNT(b.x)], 1u);
    return b;
}
__device__ __forceinline__ void xcd_barrier_complete(unsigned* bar, unsigned x, unsigned& nloc, unsigned& nx) {
    const unsigned G = gridDim.x * gridDim.y * gridDim.z;
    unsigned sum, cnt, mine, sp = 0u;
    for (;;) {
        sum = 0u; cnt = 0u; mine = 0u;
#pragma unroll
        for (unsigned j = 0; j < 16; ++j) { const unsigned c = xb_ld(&bar[XB_XCNT(j)]); sum += c; cnt += (c > 0u) ? 1u : 0u; mine = (j == x) ? c : mine; }
        if (sum == G) break;
        __builtin_amdgcn_s_sleep(1);
        if ((++sp & 255u) == 0u) { if (xb_ld(&bar[XB_TMO])) break; if (sp > XB_SPIN_CAP) { atomicAdd(&bar[XB_TMO], 1u); break; } }
    }
    nloc = mine > 0u ? mine : 1u; nx = cnt > 0u ? cnt : 1u;
}
__device__ __forceinline__ void xcd_barrier(const XcdBarrier& b) {
    asm volatile("s_waitcnt vmcnt(0)" ::: "memory");
    __syncthreads();
    if (threadIdx.x == 0) {
        unsigned* bar = b.bar;
        __builtin_amdgcn_s_waitcnt(0);
        unsigned nloc = b.st[0], nx = b.st[1];
        if (nloc == 0u) { xcd_barrier_complete(bar, b.x, nloc, nx); b.st[0] = nloc; b.st[1] = nx; }
        const unsigned old = xb_add(&bar[XB_XSUB(b.x)], 1u);
        const unsigned gen = old / nloc;
        if (old + 1u == (gen + 1u) * nloc) {
            __builtin_amdgcn_fence(__ATOMIC_RELEASE, "agent");
            asm volatile("s_waitcnt vmcnt(0)" ::: "memory");
            const unsigned og = xb_add(&bar[XB_TOP], 1u);
            const unsigned tg = og / nx;
            if (og + 1u == (tg + 1u) * nx) xb_add(&bar[XB_TOPGEN], 1u);
            else XB_SPIN(xb_ld(&bar[XB_TOPGEN]) == tg, bar);
            __builtin_amdgcn_fence(__ATOMIC_ACQUIRE, "agent");
            xb_add(&bar[XB_XGEN(b.x)], 1u);
            asm volatile("s_waitcnt vmcnt(0)" ::: "memory");
        } else {
            XB_SPIN(xb_ld(&bar[XB_XGEN(b.x)]) == gen, bar);
            __builtin_amdgcn_fence(__ATOMIC_ACQUIRE, "agent");
            asm volatile("s_waitcnt vmcnt(0)" ::: "memory");
        }
    }
    __syncthreads();
}

constexpr int NPHASE = 20;
#ifndef DIAG_PH
#define DIAG_PH -1
#endif
#define PH_ON(x) (DIAG_PH < 0 || DIAG_PH == (x))
#ifndef REP_ID
#define REP_ID -1
#endif
__global__ void __launch_bounds__(512, 2) mega(Args a) {
    extern __shared__ __attribute__((aligned(16))) unsigned char lds_raw[];
    LAS unsigned char* lds = (LAS unsigned char*)lds_raw;
    unsigned char* ws = a.ws;
    volatile LAS unsigned* bst = (volatile LAS unsigned*)(lds + MISC_OFF);
    if (threadIdx.x < 2) bst[threadIdx.x] = 0u;
    __syncthreads();
    XcdBarrier xbar = xcd_barrier_post((unsigned*)(ws + WS_CTL) + CW_BAR, bst);
    for (int ph = a.ph_lo; ph < a.ph_hi; ++ph) {
      const int cls_ = ph < 2 ? ph : 2 + (ph - 2) % 9;
      const int nrep_ = (REP_ID >= 0 && cls_ == REP_ID) ? 2 : 1;
      for (int rep_ = 0; rep_ < nrep_; ++rep_) {
        if (rep_) cg::this_grid().sync();
        if (PH_ON(0) && ph == 0) phase_p0(a, lds);
        else if (PH_ON(1) && ph == 1) phase_norm1_l0(a);
        else {
            const int l = (ph - 2) / 9, sp = (ph - 2) % 9;
            if (PH_ON(2) && sp == 0) {
                g8::DenseSched S; S.init(ws + WS_H, ws + WS_WIN + (size_t)l * NINP * 1024 * 2, MTOT, NINP, 1024, gridDim.x, blockIdx.x);
                g8::EpiBf16 E{(bf16_t*)(ws + WS_COLS), NINP};
                g8::gemm_phase(lds, S, E);
            } else if (PH_ON(3) && sp == 1) phase_chunk(a, l, lds);
            else if (PH_ON(4) && sp == 2) phase_scan(a, l, lds);
            else if (PH_ON(5) && sp == 3) phase_mixer(a, l, lds);
            else if (PH_ON(6) && sp == 4) {
                g8::DenseSched S; S.init(ws + WS_MIX, ws + WS_WOUT + (size_t)l * 1024 * 1024 * 2, l == 1 ? NLAT : MTOT, 1024, 1024, gridDim.x, blockIdx.x);
                g8::EpiBf16 E{(bf16_t*)(ws + WS_Y), 1024};
                g8::gemm_phase(lds, S, E);
            } else if (PH_ON(7) && sp == 5) phase_router(a, l, lds);
            else if ((PH_ON(8) || PH_ON(9)) && (sp == 6 || sp == 7)) {
                const int T = moe_tables(a, l, lds);
                const int G = gridDim.x, bx = blockIdx.x, vcu = (G % 8 == 0) ? (bx % 8) * (G / 8) + bx / 8 : bx;
                const LAS int* TBp = (const LAS int*)(lds + MISC_OFF + 256);
                if (PH_ON(8) && sp == 6) {
                    g8::MoeSched<true> S; S.A = (const char*)(ws + WS_H); S.Bw = (const char*)(ws + WS_WEIN) + (size_t)l * 32 * 1024 * 1024 * 2; S.wstride = (size_t)1024 * 1024 * 2; S.K = 1024; S.T = T; S.G = G; S.c = vcu;
                    S.tile_e = (const LAS int*)(lds + MISC_OFF + 1024); S.tile_mt = S.tile_e + 320; S.cnt = TBp + 64; S.toklist = (const int*)(ws + WS_TOKLIST);
                    g8::EpiSwiGLU E{(bf16_t*)(ws + WS_ACT)};
                    g8::gemm_phase(lds, S, E);
                } else if (PH_ON(9) && sp == 7) {
                    g8::MoeSched<false> S; S.A = (const char*)(ws + WS_ACT); S.Bw = (const char*)(ws + WS_WEOUT) + (size_t)l * 32 * 1024 * 512 * 2; S.wstride = (size_t)1024 * 512 * 2; S.K = 512; S.T = T; S.G = G; S.c = vcu;
                    S.tile_e = (const LAS int*)(lds + MISC_OFF + 1024); S.tile_mt = S.tile_e + 320; S.cnt = TBp + 64; S.toklist = (const int*)(ws + WS_TOKLIST);
                    g8::EpiBf16 E{(bf16_t*)(ws + WS_Y), 1024};
                    g8::gemm_phase(lds, S, E);
                }
            } else if (PH_ON(10) && sp == 8) phase_combine(a, l, lds);
        }
      }
        if (ph + 1 < a.ph_hi) { if (ph == 0) cg::this_grid().sync(); else xcd_barrier(xbar); }
    }
}

extern "C" void kernel_launch(void* const* d_in, const int* in_sizes, int n_in, void* d_out, int out_size, void* d_ws, size_t ws_size, hipStream_t stream) {
    static int grid = 0;
    if (grid == 0) {
        if (n_in != 29 || out_size != NLAT * D || ws_size < WS_END) { fprintf(stderr, "kernel_launch: unexpected shapes (n_in %d out %d ws %zu)\n", n_in, out_size, ws_size); grid = -1; return; }
        int dev = 0, cus = 0, per_cu = 0;
        hipGetDevice(&dev); hipDeviceGetAttribute(&cus, hipDeviceAttributeMultiprocessorCount, dev);
        if (hipFuncSetAttribute((const void*)mega, hipFuncAttributeMaxDynamicSharedMemorySize, LDS_BYTES) != hipSuccess) { fprintf(stderr, "kernel_launch: hipFuncSetAttribute failed\n"); grid = -1; return; }
        if (hipOccupancyMaxActiveBlocksPerMultiprocessor(&per_cu, (const void*)mega, 512, LDS_BYTES) != hipSuccess || per_cu < 1) { fprintf(stderr, "kernel_launch: occupancy query says %d\n", per_cu); per_cu = 1; }
        (void)hipGetLastError();
        grid = cus;
    }
    if (grid < 0) return;
    hipMemsetAsync((char*)d_ws + WS_CTL, 0, CTL_BYTES, stream);
    Args a{};
    for (int i = 0; i < 29; ++i) a.in[i] = (const float*)d_in[i];
    a.out = (float*)d_out; a.ws = (unsigned char*)d_ws;
#if MK_MULTI
    for (int ph = 0; ph < NPHASE; ++ph) { a.ph_lo = ph; a.ph_hi = ph + 1; hipLaunchKernelGGL(mega, dim3(grid), dim3(512), LDS_BYTES, stream, a); }
#else
    a.ph_lo = 0; a.ph_hi = NPHASE;
    void* args[] = {&a};
    hipError_t e = hipLaunchCooperativeKernel((const void*)mega, dim3(grid), dim3(512), args, LDS_BYTES, stream);
    if (e != hipSuccess) fprintf(stderr, "cooperative launch failed: %s (grid %d)\n", hipGetErrorString(e), grid);
#endif
}
```

```cpp
#include <hip/hip_runtime.h>
#include <hip/hip_cooperative_groups.h>
#include <cstdio>
namespace cg = cooperative_groups;

#ifndef MK_MULTI
#define MK_MULTI 0
#endif

#ifndef REP_SUB
#define REP_SUB 0
#endif

#define LAS __attribute__((address_space(3)))
typedef unsigned short bf16_t;
typedef short bf16x8 __attribute__((ext_vector_type(8)));
typedef float f32x4 __attribute__((ext_vector_type(4)));
typedef float f32x2 __attribute__((ext_vector_type(2)));
typedef unsigned u32x4 __attribute__((ext_vector_type(4)));
typedef unsigned u32x2 __attribute__((ext_vector_type(2)));
typedef int i32x4 __attribute__((ext_vector_type(4)));

constexpr int D = 1024, NLAT = 32768, SEQ = 8192, NCTXT = 1024, CTXL = 256, MTOT = NLAT + NCTXT;
constexpr int NIN = 2336, NINP = 2560;
constexpr int NCHUNK = MTOT / 64, NSEQ = 132;
constexpr int NEXP = 32, DEXP = 512, SLOTS = 75776;
constexpr float EPS = 1e-6f;
constexpr int C_Q = 0, C_K = 128, C_V = 256, C_G = 512, C_ZF = 768, C_ZB = 784, C_CA = 800, C_CG = 1056, C_SB = 1312, C_SC = 1568, C_SX = 1824, C_PL = 2080;

constexpr size_t MiB = 1u << 20;
constexpr size_t WS_CTL = 0, CTL_BYTES = 1 * MiB;
constexpr size_t WS_MOD = 1 * MiB;
constexpr size_t WS_TAB = 1 * MiB + 512 * 1024;
constexpr size_t WS_WIN = 2 * MiB;
constexpr size_t WS_WOUT = 12 * MiB;
constexpr size_t WS_WEIN = 16 * MiB;
constexpr size_t WS_WEOUT = 144 * MiB;
constexpr size_t WS_XCTX = 208 * MiB;
constexpr size_t WS_H = 212 * MiB;
constexpr size_t WS_COLS = 278 * MiB;
constexpr size_t WS_MIX = 443 * MiB;
constexpr size_t WS_KV = 509 * MiB;
constexpr size_t WS_DEC = 542 * MiB;
constexpr size_t WS_AGV = 543 * MiB;
constexpr size_t WS_CXV = 559 * MiB;
constexpr size_t WS_UV = 575 * MiB;
constexpr size_t WS_SCV = 591 * MiB;
constexpr size_t WS_TOKINFO = 607 * MiB;
constexpr size_t WS_TOKLIST = 608 * MiB;
constexpr size_t WS_ACT = 613 * MiB;
constexpr size_t WS_Y = 687 * MiB;
constexpr size_t WS_SIN = 835 * MiB;
constexpr size_t WS_END = 852 * MiB;
constexpr int CW_CNT = 1024;
constexpr int CW_BAR = 8192;

constexpr int LDS_BYTES = 147456;
constexpr int MISC_OFF = 131072;

__device__ __forceinline__ unsigned pk2(float lo, float hi) { unsigned r; asm("v_cvt_pk_bf16_f32 %0, %1, %2" : "=v"(r) : "v"(lo), "v"(hi)); return r; }
__device__ __forceinline__ float bflo(unsigned w) { return __uint_as_float(w << 16); }
__device__ __forceinline__ float bfhi(unsigned w) { return __uint_as_float(w & 0xffff0000u); }
__device__ __forceinline__ void unpack8(const u32x4 w, float (&f)[8]) { f[0] = bflo(w.x); f[1] = bfhi(w.x); f[2] = bflo(w.y); f[3] = bfhi(w.y); f[4] = bflo(w.z); f[5] = bfhi(w.z); f[6] = bflo(w.w); f[7] = bfhi(w.w); }
__device__ __forceinline__ float sigmoidf_(float x) { return 1.0f / (1.0f + __expf(-x)); }
__device__ __forceinline__ float siluf_(float x) { return x / (1.0f + __expf(-x)); }
__device__ __forceinline__ float logsigf_(float x) { return fminf(x, 0.0f) - log1pf(__expf(-fabsf(x))); }
__device__ __forceinline__ float wave_sum(float v) {
#pragma unroll
    for (int o = 1; o < 64; o <<= 1) v += __shfl_xor(v, o);
    return v;
}

typedef float f32x16 __attribute__((ext_vector_type(16)));
typedef __bf16 bf16x2_t __attribute__((ext_vector_type(2)));
#define MFMA32(a, b, c) __builtin_amdgcn_mfma_f32_32x32x16_bf16((a), (b), (c), 0, 0, 0)
__device__ __forceinline__ unsigned pk2c(float lo, float hi) { const f32x2 v = {lo, hi}; return __builtin_bit_cast(unsigned, __builtin_convertvector(v, bf16x2_t)); }
__device__ __forceinline__ bf16x8 pack8f(float x0, float x1, float x2, float x3, float x4, float x5, float x6, float x7) {
    u32x4 p; p.x = pk2c(x0, x1); p.y = pk2c(x2, x3); p.z = pk2c(x4, x5); p.w = pk2c(x6, x7); return __builtin_bit_cast(bf16x8, p); }
__device__ __forceinline__ bf16x8 pack_step(const f32x16& x, int s) { return s == 0 ? pack8f(x[0], x[1], x[2], x[3], x[4], x[5], x[6], x[7]) : pack8f(x[8], x[9], x[10], x[11], x[12], x[13], x[14], x[15]); }
__device__ __forceinline__ void split8(const float (&x)[8], bf16x8& hi, bf16x8& lo) {
    u32x4 p; p.x = pk2c(x[0], x[1]); p.y = pk2c(x[2], x[3]); p.z = pk2c(x[4], x[5]); p.w = pk2c(x[6], x[7]);
    hi = __builtin_bit_cast(bf16x8, p);
    lo = pack8f(x[0] - bflo(p.x), x[1] - bfhi(p.x), x[2] - bflo(p.y), x[3] - bfhi(p.y), x[4] - bflo(p.z), x[5] - bfhi(p.z), x[6] - bflo(p.w), x[7] - bfhi(p.w)); }
__device__ __forceinline__ bf16x8 cat44(u32x2 a, u32x2 b) { u32x4 p; p.x = a.x; p.y = a.y; p.z = b.x; p.w = b.y; return __builtin_bit_cast(bf16x8, p); }
#define LDS_WAIT() asm volatile("s_waitcnt lgkmcnt(0)" ::: "memory")
__device__ __forceinline__ int tid_now() { int t = threadIdx.x; asm volatile("" : "+v"(t)); return t; }

namespace g8 {
constexpr int BM = 256, BK = 64, HALF = 128, HTB = HALF * BK * 2, NXCD = 8, WGM = 8;
__device__ __forceinline__ int lds_byte(int r, int c) { const int st = (r >> 4) * 2 + (c >> 5), rr = r & 15, cc = c & 31, ob = rr * 64 + cc * 2; return st * 1024 + (ob ^ (((ob >> 9) & 1) << 5)); }
__device__ __forceinline__ void stage_rc(int b, int& R, int& C) { const int st = b / 1024, sb = b % 1024, swz = sb ^ (((sb >> 9) & 1) << 5); R = (st >> 1) * 16 + swz / 64; C = (st & 1) * 32 + (swz % 64) / 2; }
__device__ __forceinline__ int perm32(int rho) { const int n = rho >> 4, i = rho & 15; return 8 * (i >> 2) + 4 * n + (i & 3); }

struct Unit { int pm, pn, e, mt; };

struct DenseSched {
    const char* A; const char* Bt; int K, nM, nN, nwg, G, c;
    __device__ __forceinline__ void init(const void* A_, const void* Bt_, int M, int N, int K_, int G_, int c_) { A = (const char*)A_; Bt = (const char*)Bt_; K = K_; nM = M / BM; nN = N / BM; nwg = nM * nN; G = G_; c = c_; }
    __device__ __forceinline__ bool next(int i, Unit& u) const {
        const long L = (long)i * G + c; if (L >= nwg) return false;
        int wgid = (int)L; { const int q = nwg / NXCD, r = nwg % NXCD, xcd = wgid % NXCD, off = wgid / NXCD; wgid = (xcd < r ? xcd * (q + 1) : r * (q + 1) + (xcd - r) * q) + off; }
        const int nig = WGM * nN, gid = wgid / nig, fm = gid * WGM, gsz = (nM - fm) < WGM ? (nM - fm) : WGM;
        u.pm = fm + ((wgid % nig) % gsz); u.pn = (wgid % nig) / gsz; u.e = 0; u.mt = 0; return true;
    }
    __device__ __forceinline__ unsigned a_off(const Unit& u, int h, int R, int C) const { return (unsigned)(((u.pm * BM + h * HALF + R) * K + C) * 2); }
    __device__ __forceinline__ const char* b_ptr(const Unit& u) const { return Bt + (size_t)u.pn * BM * K * 2; }
};
template <bool GATHER> struct MoeSched {
    const char* A; const char* Bw; size_t wstride; int K, T, G, c; const LAS int* tile_e; const LAS int* tile_mt; const LAS int* cnt; const int* toklist;
    __device__ __forceinline__ bool next(int i, Unit& u) const {
        const int L = i * G + c; if (L >= 4 * T) return false;
        u.pm = L >> 2; u.pn = L & 3; u.e = __builtin_amdgcn_readfirstlane(tile_e[u.pm]); u.mt = __builtin_amdgcn_readfirstlane(tile_mt[u.pm]); return true;
    }
    __device__ __forceinline__ unsigned a_off(const Unit& u, int h, int R, int C) const {
        if (GATHER) { const int pos = u.mt * BM + h * HALF + R; int tok = 0; if (pos < cnt[u.e]) tok = toklist[u.e * MTOT + pos]; return (unsigned)((tok * K + C) * 2); }
        return (unsigned)(((u.pm * BM + h * HALF + R) * K + C) * 2);
    }
    __device__ __forceinline__ const char* b_ptr(const Unit& u) const { return Bw + (size_t)u.e * wstride + (size_t)u.pn * BM * K * 2; }
};

struct EpiBf16 {
    static constexpr bool PERM = true;
    bf16_t* O; int ldc;
    __device__ __forceinline__ void operator()(const f32x4 (&acc)[2][2][4][2], const Unit& u, int wr, int wc, int fr, int fq) const {
        const int row0 = u.pm * BM + wr * 64 + fr, col0 = u.pn * BM + wc * 32 + 8 * fq;
#pragma unroll
        for (int ai = 0; ai < 2; ++ai)
#pragma unroll
            for (int m = 0; m < 4; ++m) { bf16_t* rowp = O + (size_t)(row0 + ai * HALF + m * 16) * ldc + col0;
#pragma unroll
                for (int bj = 0; bj < 2; ++bj) { const f32x4 v0 = acc[ai][bj][m][0], v1 = acc[ai][bj][m][1];
                    u32x4 w; w.x = pk2(v0[0], v0[1]); w.y = pk2(v0[2], v0[3]); w.z = pk2(v1[0], v1[1]); w.w = pk2(v1[2], v1[3]);
                    *(u32x4*)(rowp + bj * HALF) = w; } }
    }
};
struct EpiSwiGLU {
    static constexpr bool PERM = true;
    bf16_t* O;
    __device__ __forceinline__ void operator()(const f32x4 (&acc)[2][2][4][2], const Unit& u, int wr, int wc, int fr, int fq) const {
        const int row0 = u.pm * BM + wr * 64 + fr, col0 = u.pn * HALF + wc * 32 + 8 * fq;
#pragma unroll
        for (int ai = 0; ai < 2; ++ai)
#pragma unroll
            for (int m = 0; m < 4; ++m) { bf16_t* rowp = O + (size_t)(row0 + ai * HALF + m * 16) * DEXP + col0;
                const f32x4 g0 = acc[ai][0][m][0], g1 = acc[ai][0][m][1], u0 = acc[ai][1][m][0], u1 = acc[ai][1][m][1];
                u32x4 w; w.x = pk2(siluf_(g0[0]) * u0[0], siluf_(g0[1]) * u0[1]); w.y = pk2(siluf_(g0[2]) * u0[2], siluf_(g0[3]) * u0[3]);
                w.z = pk2(siluf_(g1[0]) * u1[0], siluf_(g1[1]) * u1[1]); w.w = pk2(siluf_(g1[2]) * u1[2], siluf_(g1[3]) * u1[3]);
                *(u32x4*)rowp = w; }
    }
};
template <class Epi, class Sched>
__device__ __forceinline__ void gemm_phase(LAS unsigned char* lds, const Sched& S, const Epi& E) {
    const int tid = tid_now(), wid = __builtin_amdgcn_readfirstlane(tid >> 6), lane = tid & 63, wr = wid >> 2, wc = wid & 3, fr = lane & 15, fq = lane >> 4;
    const int K = S.K, nt = K / BK;
    unsigned voffB[2];
#pragma unroll
    for (int i = 0; i < 2; ++i) { int R, C; stage_rc(tid * 16 + i * 8192, R, C); const int Rb = Epi::PERM ? ((R & ~31) + perm32(R & 31)) : R; voffB[i] = (unsigned)(Rb * K + C) * 2u; }
    const size_t kstep = (size_t)(BK * 2);
    const size_t hstep = (size_t)HALF * K * 2;
    const unsigned ldsw = (unsigned)wid * 1024u;
    const int aoff = lds_byte(wr * 64 + fr, fq * 8), boff = lds_byte(wc * 32 + fr, fq * 8);
#define G8_SA(b, h) (((b) * 2 + (h)) * HTB)
#define G8_SB(b, h) ((4 + (b) * 2 + (h)) * HTB)
#define G8_STAGE(bufoff, gbase, voff) do { const unsigned long long _g = (unsigned long long)(gbase); \
        const char* _gb = (const char*)(((unsigned long long)(unsigned)__builtin_amdgcn_readfirstlane((int)(unsigned)(_g >> 32)) << 32) | (unsigned long long)(unsigned)__builtin_amdgcn_readfirstlane((int)(unsigned)_g)); \
        _Pragma("unroll") for (int _i = 0; _i < 2; ++_i) \
        __builtin_amdgcn_global_load_lds((const unsigned*)(_gb + (voff)[_i]), (LAS unsigned*)(lds + (bufoff) + ldsw + _i * 8192), 16, 0, 0); } while (0)
#define G8_LDA(dst, b, h) do { _Pragma("unroll") for (int m = 0; m < 4; ++m) _Pragma("unroll") for (int k = 0; k < 2; ++k) dst[m][k] = *(const LAS bf16x8*)(lds + G8_SA(b, h) + aoff + m * 2048 + k * 1024); } while (0)
#define G8_LDB(dst, b, h) do { _Pragma("unroll") for (int n = 0; n < 2; ++n) _Pragma("unroll") for (int k = 0; k < 2; ++k) dst[n][k] = *(const LAS bf16x8*)(lds + G8_SB(b, h) + boff + n * 2048 + k * 1024); } while (0)
#define G8_MMA(ai, bj, At, Bt) do { __builtin_amdgcn_s_setprio(1); _Pragma("unroll") for (int m = 0; m < 4; ++m) _Pragma("unroll") for (int n = 0; n < 2; ++n) _Pragma("unroll") for (int k = 0; k < 2; ++k) \
        acc[ai][bj][m][n] = __builtin_amdgcn_mfma_f32_16x16x32_bf16(Bt[n][k], At[m][k], acc[ai][bj][m][n], 0, 0, 0); __builtin_amdgcn_s_setprio(0); } while (0)
#define G8_WAIT_V(n) asm volatile("s_waitcnt vmcnt(" #n ")" ::: "memory")
#define G8_WAIT_L(n) asm volatile("s_waitcnt lgkmcnt(" #n ")" ::: "memory")
#define G8_BAR __builtin_amdgcn_s_barrier()
#define G8_SCHED __builtin_amdgcn_sched_barrier(0)
    Unit cur, nxt; int ui = 0;
    if (!S.next(0, cur)) return;
    f32x4 acc[2][2][4][2];
#pragma unroll
    for (int a = 0; a < 2; ++a)
#pragma unroll
        for (int b = 0; b < 2; ++b)
#pragma unroll
            for (int m = 0; m < 4; ++m)
#pragma unroll
                for (int n = 0; n < 2; ++n) acc[a][b][m][n] = (f32x4){0.f, 0.f, 0.f, 0.f};
    bf16x8 At[4][2], B0[2][2], B1[2][2];
    unsigned vA0[2], vA1[2];
#pragma unroll
    for (int i = 0; i < 2; ++i) { int R, C; stage_rc(tid * 16 + i * 8192, R, C); vA0[i] = S.a_off(cur, 0, R, C); vA1[i] = S.a_off(cur, 1, R, C); }
    const char* const Ab = S.A;
    const char* cB = S.b_ptr(cur);
    G8_STAGE(G8_SB(0, 0), cB, voffB); G8_STAGE(G8_SA(0, 0), Ab, vA0); G8_STAGE(G8_SB(0, 1), cB + hstep, voffB); G8_STAGE(G8_SA(0, 1), Ab, vA1);
    if (wr == 1) G8_BAR;
    G8_WAIT_V(4); G8_BAR;
    G8_STAGE(G8_SB(1, 0), cB + kstep, voffB); G8_STAGE(G8_SA(1, 0), Ab + kstep, vA0); G8_STAGE(G8_SB(1, 1), cB + hstep + kstep, voffB);
    G8_WAIT_V(6); G8_BAR;
    for (;;) {
        const bool has_next = S.next(ui + 1, nxt);
        const char* nB = has_next ? S.b_ptr(nxt) : cB;
        for (int t = 0; t < nt; t += 2) {
            const bool last = (t == nt - 2);
            const char* a1 = Ab + (size_t)(t + 1) * kstep;
            const char* a2 = last ? Ab : Ab + (size_t)(t + 2) * kstep; const char* b2 = last ? nB : cB + (size_t)(t + 2) * kstep;
            const char* a3 = a2 + kstep; const char* b3 = b2 + kstep;
            G8_LDB(B0, 0, 0); G8_SCHED; G8_LDA(At, 0, 0); G8_STAGE(G8_SA(1, 1), a1, vA1);
            G8_WAIT_L(8); G8_BAR; G8_WAIT_L(0); G8_MMA(0, 0, At, B0); G8_BAR; G8_SCHED;
            if (last && has_next) {
#pragma unroll
                for (int i = 0; i < 2; ++i) { int R, C; stage_rc(tid * 16 + i * 8192, R, C); vA0[i] = S.a_off(nxt, 0, R, C); vA1[i] = S.a_off(nxt, 1, R, C); }
            }
            G8_LDB(B1, 0, 1); G8_STAGE(G8_SB(0, 0), b2, voffB);
            G8_BAR; G8_WAIT_L(0); G8_MMA(0, 1, At, B1); G8_BAR;
            G8_LDA(At, 0, 1); G8_STAGE(G8_SA(0, 0), a2, vA0);
            G8_BAR; G8_WAIT_L(0); G8_MMA(1, 0, At, B0); G8_BAR; G8_SCHED;
            G8_STAGE(G8_SB(0, 1), b2 + hstep, voffB);
            G8_WAIT_V(6); G8_BAR; G8_MMA(1, 1, At, B1); G8_BAR;
            G8_LDB(B0, 1, 0); G8_SCHED; G8_LDA(At, 1, 0); G8_STAGE(G8_SA(0, 1), a2, vA1);
            G8_WAIT_L(8); G8_BAR; G8_WAIT_L(0); G8_MMA(0, 0, At, B0); G8_BAR; G8_SCHED;
            G8_LDB(B1, 1, 1); G8_STAGE(G8_SB(1, 0), b3, voffB);
            G8_BAR; G8_WAIT_L(0); G8_MMA(0, 1, At, B1); G8_BAR;
            G8_LDA(At, 1, 1); G8_STAGE(G8_SA(1, 0), a3, vA0);
            G8_BAR; G8_WAIT_L(0); G8_MMA(1, 0, At, B0); G8_BAR; G8_SCHED;
            G8_STAGE(G8_SB(1, 1), b3 + hstep, voffB);
            G8_WAIT_V(6); G8_BAR; G8_MMA(1, 1, At, B1); G8_BAR;
        }
        E(acc, cur, wr, wc, fr, fq);
        if (!has_next) break;
#pragma unroll
        for (int a = 0; a < 2; ++a)
#pragma unroll
            for (int b = 0; b < 2; ++b)
#pragma unroll
                for (int m = 0; m < 4; ++m)
#pragma unroll
                    for (int n = 0; n < 2; ++n) acc[a][b][m][n] = (f32x4){0.f, 0.f, 0.f, 0.f};
        cur = nxt; cB = nB; ++ui;
    }
    G8_WAIT_V(0);
    if (wr == 0) G8_BAR;
    G8_BAR;
#undef G8_SA
#undef G8_SB
#undef G8_STAGE
#undef G8_LDA
#undef G8_LDB
#undef G8_MMA
#undef G8_WAIT_V
#undef G8_WAIT_L
#undef G8_BAR
#undef G8_SCHED
}
}

struct Args { const float* in[29]; float* out; unsigned char* ws; int ph_lo, ph_hi; };
enum { I_X = 0, I_C, I_CTX, I_CCTX, I_WMOD, I_BMOD, I_G1, I_G2, I_WIN, I_GWF, I_GBF, I_GWB, I_GBB, I_GOUT, I_CONFW, I_CONFB, I_CONFG, I_CONFBETA, I_SCW, I_POOLW, I_POOLS, I_WOUT, I_RWG, I_RBG, I_RWE, I_RBE, I_EIN, I_EOUT, I_GFINAL };

__device__ __forceinline__ void transpose_item(const float* W, int K, int N, bf16_t* WT, int kb, int n0, int dst_row0, LAS float* scr, int lane) {
    const int k0 = 64 * kb;
#pragma unroll 8
    for (int i = 0; i < 32; ++i) { const int kk = 2 * i + (lane >> 5); scr[kk * 33 + (lane & 31)] = W[(size_t)(k0 + kk) * N + n0 + (lane & 31)]; }
    LDS_WAIT(); asm volatile("" ::: "memory");
    const int c = lane & 7;
#pragma unroll
    for (int j = 0; j < 4; ++j) { const int n = (lane >> 3) + 8 * j; const LAS float* s = scr + (8 * c) * 33 + n;
        u32x4 o; o.x = pk2(s[0 * 33], s[1 * 33]); o.y = pk2(s[2 * 33], s[3 * 33]); o.z = pk2(s[4 * 33], s[5 * 33]); o.w = pk2(s[6 * 33], s[7 * 33]);
        *(u32x4*)(WT + (size_t)(dst_row0 + n) * K + k0 + 8 * c) = o; }
    LDS_WAIT(); asm volatile("" ::: "memory");
}

__device__ __forceinline__ void phase_p0(const Args& a, LAS unsigned char* lds) {
    const int tid = tid_now(), lane = tid & 63, wid = __builtin_amdgcn_readfirstlane(tid >> 6);
    unsigned char* ws = a.ws;
    for (int job = blockIdx.x; job < 192; job += gridDim.x) {
        const int l = job / 96, n0 = (job % 96) * 64;
        LAS float* sv = (LAS float*)lds;
        LAS float* red = (LAS float*)(lds + 5 * 1024 * 4);
        for (int i = tid; i < 5 * 1024; i += 512) { const int r = i >> 10, k = i & 1023; const float v = r < 4 ? a.in[I_C][r * 1024 + k] : a.in[I_CCTX][k]; sv[i] = siluf_(v); }
        __syncthreads();
        const int ks = tid >> 6, col = tid & 63;
        const float* w = a.in[I_WMOD] + (size_t)l * 1024 * 6144 + (size_t)(ks * 128) * 6144 + n0 + col;
        float acc[5] = {0.f, 0.f, 0.f, 0.f, 0.f};
#pragma unroll 8
        for (int k = 0; k < 128; ++k) { const float wv = w[(size_t)k * 6144];
#pragma unroll
            for (int r = 0; r < 5; ++r) acc[r] += sv[r * 1024 + ks * 128 + k] * wv; }
#pragma unroll
        for (int r = 0; r < 5; ++r) red[(ks * 5 + r) * 64 + col] = acc[r];
        __syncthreads();
        if (tid < 320) { const int r = tid >> 6; float s = 0.f;
#pragma unroll
            for (int q = 0; q < 8; ++q) s += red[(q * 5 + r) * 64 + col];
            ((float*)(ws + WS_MOD))[(size_t)(l * 5 + r) * 6144 + n0 + col] = s + a.in[I_BMOD][l * 6144 + n0 + col]; }
        __syncthreads();
    }
    LAS float* scr = (LAS float*)(lds + wid * 16384);
    const int gw = blockIdx.x * 8 + wid, NGW = gridDim.x * 8;
    constexpr int I_IN = 16 * 73, I_OUT = 16 * 32, I_EI = 16 * 32, I_EO = 8 * 32;
    constexpr int N_IN = 2 * I_IN, N_OUT = 2 * I_OUT, N_EI = 64 * I_EI, N_EO = 64 * I_EO, NITEMS = N_IN + N_OUT + N_EI + N_EO;
    for (int it = gw; it < NITEMS; it += NGW) {
        int r = it;
        if (r < N_IN) { const int l = r / I_IN, q = r % I_IN, kb = q / 73, nb = q % 73;
            transpose_item(a.in[I_WIN] + (size_t)l * 1024 * NIN, 1024, NIN, (bf16_t*)(ws + WS_WIN) + (size_t)l * NINP * 1024, kb, nb * 32, nb * 32, scr, lane); continue; }
        r -= N_IN;
        if (r < N_OUT) { const int l = r / I_OUT, q = r % I_OUT, kb = q / 32, nb = q % 32;
            transpose_item(a.in[I_WOUT] + (size_t)l * 1024 * 1024, 1024, 1024, (bf16_t*)(ws + WS_WOUT) + (size_t)l * 1024 * 1024, kb, nb * 32, nb * 32, scr, lane); continue; }
        r -= N_OUT;
        if (r < N_EI) { const int le = r / I_EI, q = r % I_EI, kb = q / 32, nb = q % 32, n0 = nb * 32;
            const int dst = n0 < 512 ? (256 * (n0 >> 7) + (n0 & 127)) : (256 * ((n0 - 512) >> 7) + 128 + ((n0 - 512) & 127));
            transpose_item(a.in[I_EIN] + (size_t)le * 1024 * 1024, 1024, 1024, (bf16_t*)(ws + WS_WEIN) + (size_t)le * 1024 * 1024, kb, n0, dst, scr, lane); continue; }
        r -= N_EI;
        { const int le = r / I_EO, q = r % I_EO, kb = q / 32, nb = q % 32;
            transpose_item(a.in[I_EOUT] + (size_t)le * 512 * 1024, 512, 1024, (bf16_t*)(ws + WS_WEOUT) + (size_t)le * 1024 * 512, kb, nb * 32, nb * 32, scr, lane); }
    }
    for (int i = blockIdx.x * 512 + tid; i < 2 * 4096; i += gridDim.x * 512) { const int l = i >> 12, g = (i >> 10) & 3, k = i & 1023; ((float*)(ws + WS_TAB))[i] = a.in[I_RWG][l * 4096 + k * 4 + g]; }
    for (int i = blockIdx.x * 512 + tid; i < 2 * 224 * 1024 / 8; i += gridDim.x * 512) { const int l = i / (224 * 128), q = i % (224 * 128);
        *(u32x4*)((bf16_t*)(ws + WS_WIN) + (size_t)l * NINP * 1024 + (size_t)NIN * 1024 + (size_t)q * 8) = (u32x4){0u, 0u, 0u, 0u}; }
}

__device__ __forceinline__ void load_row(const float* xrow, int lane, f32x4 (&v)[4]) {
    const f32x4* xr = (const f32x4*)xrow + lane;
#pragma unroll
    for (int j = 0; j < 4; ++j) v[j] = xr[64 * j];
}
__device__ __forceinline__ float row_rstd(const f32x4 (&v)[4]) {
    float s = 0.f;
#pragma unroll
    for (int j = 0; j < 4; ++j) s += (v[j].x * v[j].x + v[j].y * v[j].y) + (v[j].z * v[j].z + v[j].w * v[j].w);
    return rsqrtf(wave_sum(s) * (1.0f / D) + EPS);
}
__device__ __forceinline__ void norm_mod_store(f32x4 (&v)[4], float rstd, const float* g, const float* sc, const float* sh, bf16_t* hrow, int lane) {
#pragma unroll
    for (int j = 0; j < 4; ++j) { const f32x4 gv = *((const f32x4*)g + lane + 64 * j), scv = *((const f32x4*)sc + lane + 64 * j), shv = *((const f32x4*)sh + lane + 64 * j);
        v[j] = (v[j] * rstd * gv) * (1.0f + scv) + shv;
        u32x2 w; w.x = pk2(v[j].x, v[j].y); w.y = pk2(v[j].z, v[j].w);
        *((u32x2*)hrow + lane + 64 * j) = w; }
}

__device__ __forceinline__ void norm_store_cached(f32x4 (&v)[4], float rstd, const f32x4 (&GS)[4], const f32x4 (&SH)[4], bf16_t* hrow, int lane) {
#pragma unroll
    for (int j = 0; j < 4; ++j) { v[j] = (v[j] * rstd) * GS[j] + SH[j];
        u32x2 w; w.x = pk2(v[j].x, v[j].y); w.y = pk2(v[j].z, v[j].w);
        *((u32x2*)hrow + lane + 64 * j) = w; }
}
__device__ __forceinline__ void load_mod_cached(const float* g, const float* sc, const float* sh, const float* ga, int lane, f32x4 (&GS)[4], f32x4 (&SH)[4], f32x4 (&GA)[4]) {
#pragma unroll
    for (int j = 0; j < 4; ++j) { const f32x4 gv = *((const f32x4*)g + lane + 64 * j), scv = *((const f32x4*)sc + lane + 64 * j);
        GS[j] = gv * (1.0f + scv); SH[j] = *((const f32x4*)sh + lane + 64 * j); GA[j] = *((const f32x4*)ga + lane + 64 * j); }
}

__device__ __forceinline__ void phase_norm1_l0(const Args& a) {
    const int lane = tid_now() & 63, wid = tid_now() >> 6, gw = blockIdx.x * 8 + wid, NGW = gridDim.x * 8;
    const float* MOD = (const float*)(a.ws + WS_MOD); bf16_t* H = (bf16_t*)(a.ws + WS_H);
    int cur_b = -1; f32x4 GS[4], SH[4], GA[4];
#pragma unroll 1
    for (int m = gw; m < MTOT; m += 2 * NGW) {
        const int m2 = m + NGW; const bool has2 = m2 < MTOT; const int m2c = has2 ? m2 : m;
        const float* src = m < NLAT ? a.in[I_X] + (size_t)m * D : a.in[I_CTX] + (size_t)(m - NLAT) * D;
        const float* src2 = m2c < NLAT ? a.in[I_X] + (size_t)m2c * D : a.in[I_CTX] + (size_t)(m2c - NLAT) * D;
        const int b = m < NLAT ? (m >> 13) : 4, b2 = m2c < NLAT ? (m2c >> 13) : 4;
        f32x4 v[4], v2[4]; load_row(src, lane, v); load_row(src2, lane, v2);
        const float rstd = row_rstd(v), rstd2 = row_rstd(v2);
        if (b != cur_b) { const float* mod = MOD + (size_t)b * 6144; load_mod_cached(a.in[I_G1], mod + 1024, mod, mod, lane, GS, SH, GA); cur_b = b; }
        norm_store_cached(v, rstd, GS, SH, H + (size_t)m * D, lane);
        if (has2) { if (b2 != cur_b) { const float* mod = MOD + (size_t)b2 * 6144; load_mod_cached(a.in[I_G1], mod + 1024, mod, mod, lane, GS, SH, GA); cur_b = b2; }
            norm_store_cached(v2, rstd2, GS, SH, H + (size_t)m2 * D, lane); }
    }
}

struct ChunkPos { int b, sf, sb; };
__device__ __forceinline__ ChunkPos chunk_pos(int chunk) {
    ChunkPos p;
    if (chunk < 512) { p.b = chunk >> 7; const int n = chunk & 127; p.sf = 4 + n; p.sb = 4 + 127 - n; }
    else { const int cc = chunk - 512; p.b = cc >> 2; const int n = cc & 3; p.sf = n; p.sb = 3 - n; }
    return p;
}

constexpr int VS = 72;
__device__ __forceinline__ void gla_prep_dir(const Args& a, int l, int h, int dir, const bf16_t* cols0, int lane, f32x16 (&BT)[2]) {
    asm volatile("" : "+v"(lane));
    const int r = lane & 31, hf = lane >> 5;
    const f32x16 zero16 = {0.f, 0.f, 0.f, 0.f, 0.f, 0.f, 0.f, 0.f, 0.f, 0.f, 0.f, 0.f, 0.f, 0.f, 0.f, 0.f};
    u32x4 mk[2];
#pragma unroll
    for (int s = 0; s < 2; ++s) { unsigned w4[4];
#pragma unroll
        for (int jp = 0; jp < 4; ++jp) { const int j0 = 2 * jp, j1 = 2 * jp + 1;
            const int t0 = 16 * s + 8 * (j0 >> 2) + 4 * hf + (j0 & 3), t1 = 16 * s + 8 * (j1 >> 2) + 4 * hf + (j1 & 3);
            const bool c0 = dir ? (t0 >= r) : (t0 <= r), c1 = dir ? (t1 >= r) : (t1 <= r);
            w4[jp] = (c0 ? 0x3F80u : 0u) | (c1 ? 0x3F800000u : 0u); }
        mk[s].x = w4[0]; mk[s].y = w4[1]; mk[s].z = w4[2]; mk[s].w = w4[3]; }
    const float* wp = a.in[dir ? I_GWB : I_GWF] + (size_t)(l * 16 + 8 * hf) * 128 + 32 * h + r;
    float w[8];
#pragma unroll
    for (int j = 0; j < 8; ++j) w[j] = wp[j * 128];
    bf16x8 Bhi, Blo; split8(w, Bhi, Blo);
    const float bias = a.in[dir ? I_GBB : I_GBF][l * 128 + 32 * h + r];
    BT[0] = zero16; BT[1] = zero16;
#pragma unroll 1
    for (int mt = 0; mt < 2; ++mt) {
        const bf16x8 A = *(const bf16x8*)(cols0 + (size_t)(32 * mt + r) * NINP + C_ZF + 16 * dir + 8 * hf);
        f32x16 x = MFMA32(A, Bhi, zero16); x = MFMA32(A, Blo, x);
        float la[16];
#pragma unroll
        for (int i = 0; i < 16; ++i) { const float v = x[i] + bias; la[i] = (fminf(v, 0.f) - __logf(1.0f + __expf(-fabsf(v)))) * (1.0f / 16.0f); }
#pragma unroll
        for (int s = 0; s < 2; ++s) {
            const float t8[8] = {la[8 * s], la[8 * s + 1], la[8 * s + 2], la[8 * s + 3], la[8 * s + 4], la[8 * s + 5], la[8 * s + 6], la[8 * s + 7]};
            bf16x8 Lh, Ll; split8(t8, Lh, Ll);
#pragma unroll
            for (int nt = 0; nt < 2; ++nt) {
                const bool full = dir ? (mt > nt) : (mt < nt);
                u32x4 bm; const unsigned fv = full ? 0x3F803F80u : 0u;
                bm.x = (mt == nt) ? mk[s].x : fv; bm.y = (mt == nt) ? mk[s].y : fv; bm.z = (mt == nt) ? mk[s].z : fv; bm.w = (mt == nt) ? mk[s].w : fv;
                const bf16x8 Bm = __builtin_bit_cast(bf16x8, bm);
                BT[nt] = MFMA32(Lh, Bm, BT[nt]); BT[nt] = MFMA32(Ll, Bm, BT[nt]); }
        }
    }
}
__device__ __forceinline__ void stage_vT(const bf16_t* cols0, int h, int lane, LAS bf16_t* vT) {
#pragma unroll
    for (int q = 0; q < 8; ++q) { const int chunk = lane + 64 * q, t = chunk >> 3, cg = chunk & 7;
        const u32x4 w = *(const u32x4*)(cols0 + (size_t)t * NINP + C_V + 64 * h + 8 * cg);
        LAS bf16_t* p = vT + (8 * cg) * VS + t;
        p[0 * VS] = (bf16_t)(w.x & 0xffffu); p[1 * VS] = (bf16_t)(w.x >> 16); p[2 * VS] = (bf16_t)(w.y & 0xffffu); p[3 * VS] = (bf16_t)(w.y >> 16);
        p[4 * VS] = (bf16_t)(w.z & 0xffffu); p[5 * VS] = (bf16_t)(w.z >> 16); p[6 * VS] = (bf16_t)(w.w & 0xffffu); p[7 * VS] = (bf16_t)(w.w >> 16); }
}
__device__ __forceinline__ void chunk_gla_item(const Args& a, int l, int tile, int h, int lane, LAS bf16_t* vT, LAS bf16_t* kdT) {
    const int r = lane & 31, hf = lane >> 5;
    const bf16_t* cols0 = (const bf16_t*)(a.ws + WS_COLS) + (size_t)tile * 64 * NINP;
    float* KV = (float*)(a.ws + WS_KV); float* DEC = (float*)(a.ws + WS_DEC);
    const ChunkPos cp = chunk_pos(tile);
    const f32x16 zero16 = {0.f, 0.f, 0.f, 0.f, 0.f, 0.f, 0.f, 0.f, 0.f, 0.f, 0.f, 0.f, 0.f, 0.f, 0.f, 0.f};
    stage_vT(cols0, h, lane, vT);
#pragma unroll 1
    for (int dir = 0; dir < 2; ++dir) {
        f32x16 BT[2]; gla_prep_dir(a, l, h, dir, cols0, lane, BT);
        const size_t e = (size_t)((dir * 4 + cp.b) * 4 + h) * NSEQ + (dir ? cp.sb : cp.sf);
        const int srcl = (dir ? 0 : 31) + 32 * hf;
        float tot[16];
#pragma unroll
        for (int i = 0; i < 16; ++i) tot[i] = __shfl(dir ? BT[0][i] : BT[1][i], srcl);
        if (r == (dir ? 0 : 31)) {
#pragma unroll
            for (int i = 0; i < 16; ++i) DEC[e * 32 + (i & 3) + 8 * (i >> 2) + 4 * hf] = __expf(tot[i]);
        }
#pragma unroll
        for (int nt = 0; nt < 2; ++nt) {
            const bf16_t* kp = cols0 + (size_t)(32 * nt + r) * NINP + C_K + 32 * h + 4 * hf;
#pragma unroll
            for (int g = 0; g < 4; ++g) { const u32x2 kw = *(const u32x2*)(kp + 8 * g);
                const float kf[4] = {bflo(kw.x), bfhi(kw.x), bflo(kw.y), bfhi(kw.y)};
#pragma unroll
                for (int q = 0; q < 4; ++q) { const int i = 4 * g + q; const float kd = kf[q] * __expf(tot[i] - BT[nt][i]);
                    kdT[(8 * g + 4 * hf + q) * VS + 32 * nt + r] = (bf16_t)(pk2c(kd, 0.f) & 0xffffu); } }
        }
        LDS_WAIT(); asm volatile("" ::: "memory");
#pragma unroll 1
        for (int ct = 0; ct < 2; ++ct) {
            f32x16 acc = zero16;
#pragma unroll
            for (int ks = 0; ks < 4; ++ks) {
                const bf16x8 A = *(const LAS bf16x8*)(vT + (32 * ct + r) * VS + 16 * ks + 8 * hf);
                const bf16x8 B = *(const LAS bf16x8*)(kdT + r * VS + 16 * ks + 8 * hf);
                acc = MFMA32(A, B, acc); }
            float* dst = KV + e * 2048 + (size_t)(32 * ct + 4 * hf) * 32 + r;
#pragma unroll
            for (int i = 0; i < 16; ++i) dst[((i & 3) + 8 * (i >> 2)) * 32] = acc[i];
        }
        LDS_WAIT(); asm volatile("" ::: "memory");
    }
}
__device__ __forceinline__ void chunk_agv_item(const Args& a, int row0, int lane) {
    const bf16_t* COLS = (const bf16_t*)(a.ws + WS_COLS); float* AGV = (float*)(a.ws + WS_AGV); float* CXV = (float*)(a.ws + WS_CXV);
    const int t = lane >> 3;
#pragma unroll
    for (int rep = 0; rep < 2; ++rep) { const int c8 = ((lane & 7) + 8 * rep) * 8; const bf16_t* rp = COLS + (size_t)(row0 + t) * NINP;
        float fa[8], fg[8], fc[8], fx[8];
        unpack8(*(const u32x4*)(rp + C_CA + 128 + c8), fa); unpack8(*(const u32x4*)(rp + C_CG + 128 + c8), fg);
        unpack8(*(const u32x4*)(rp + C_SC + 128 + c8), fc); unpack8(*(const u32x4*)(rp + C_SX + 128 + c8), fx);
        f32x4 o0, o1, p0, p1;
#pragma unroll
        for (int i = 0; i < 4; ++i) { o0[i] = fa[i] * sigmoidf_(fg[i]); o1[i] = fa[4 + i] * sigmoidf_(fg[4 + i]); p0[i] = fc[i] * fx[i]; p1[i] = fc[4 + i] * fx[4 + i]; }
        float* ao = AGV + (size_t)(row0 + t) * 128 + c8; float* co = CXV + (size_t)(row0 + t) * 128 + c8;
        *(f32x4*)ao = o0; *(f32x4*)(ao + 4) = o1; *(f32x4*)co = p0; *(f32x4*)(co + 4) = p1; }
}
__device__ __forceinline__ void phase_chunk(const Args& a, int l, LAS unsigned char* lds) {
    const int tid = tid_now(), lane = tid & 63, wid = __builtin_amdgcn_readfirstlane(tid >> 6);
    LAS bf16_t* vT = (LAS bf16_t*)(lds + wid * 16384); LAS bf16_t* kdT = vT + 64 * VS;
    const int gw = blockIdx.x * 8 + wid, NGW = gridDim.x * 8;
    constexpr int N_GLA = NCHUNK * 4, N_AGV = 512 * 8;
    for (int rp = 0; rp < (((REP_SUB == 3 || REP_SUB == 4) && l == 0) ? 2 : 1); ++rp)
    for (int it = gw; it < N_GLA + N_AGV; it += NGW) {
        if (it < N_GLA) { if (rp == 0 || REP_SUB == 3) chunk_gla_item(a, l, it >> 2, it & 3, lane, vT, kdT); }
        else { if (rp == 0 || REP_SUB == 4) chunk_agv_item(a, (it - N_GLA) * 8, lane); }
    }
}
__device__ __forceinline__ void mixer_gla_item(const Args& a, int l, int tile, int h, int lane, LAS bf16_t* vT) {
    const bf16_t* cols0 = (const bf16_t*)(a.ws + WS_COLS) + (size_t)tile * 64 * NINP;
    const bf16_t* SIN = (const bf16_t*)(a.ws + WS_SIN); bf16_t* MIX = (bf16_t*)(a.ws + WS_MIX);
    const ChunkPos cp = chunk_pos(tile);
    const f32x16 zero16 = {0.f, 0.f, 0.f, 0.f, 0.f, 0.f, 0.f, 0.f, 0.f, 0.f, 0.f, 0.f, 0.f, 0.f, 0.f, 0.f};
    stage_vT(cols0, h, lane, vT);
    LDS_WAIT(); asm volatile("" ::: "memory");
    f32x16 OT[2][2] = {{zero16, zero16}, {zero16, zero16}};
#pragma unroll 1
    for (int dir = 0; dir < 2; ++dir) {
        int ln = lane; asm volatile("" : "+v"(ln)); const int r = ln & 31, hf = ln >> 5;
        bf16x8 QD[2][2], KI[2][2];
        { f32x16 BT[2]; gla_prep_dir(a, l, h, dir, cols0, lane, BT);
#pragma unroll
            for (int nt = 0; nt < 2; ++nt) {
                const bf16_t* qp = cols0 + (size_t)(32 * nt + r) * NINP + C_Q + 32 * h + 4 * hf; const bf16_t* kp = qp + (C_K - C_Q);
                float qd[16], ki[16];
#pragma unroll
                for (int g = 0; g < 4; ++g) { const u32x2 qw = *(const u32x2*)(qp + 8 * g), kw = *(const u32x2*)(kp + 8 * g);
                    const float qf[4] = {bflo(qw.x), bfhi(qw.x), bflo(qw.y), bfhi(qw.y)}, kf[4] = {bflo(kw.x), bfhi(kw.x), bflo(kw.y), bfhi(kw.y)};
#pragma unroll
                    for (int q = 0; q < 4; ++q) { const float bb = BT[nt][4 * g + q]; qd[4 * g + q] = qf[q] * 0.17677669529663687f * __expf(bb); ki[4 * g + q] = kf[q] * __expf(-bb); } }
#pragma unroll
                for (int s = 0; s < 2; ++s) { QD[nt][s] = pack8f(qd[8 * s], qd[8 * s + 1], qd[8 * s + 2], qd[8 * s + 3], qd[8 * s + 4], qd[8 * s + 5], qd[8 * s + 6], qd[8 * s + 7]);
                    KI[nt][s] = pack8f(ki[8 * s], ki[8 * s + 1], ki[8 * s + 2], ki[8 * s + 3], ki[8 * s + 4], ki[8 * s + 5], ki[8 * s + 6], ki[8 * s + 7]); }
            }
        }
#pragma unroll
        for (int jt = 0; jt < 2; ++jt)
#pragma unroll
            for (int it = 0; it < 2; ++it) {
                if (jt != it) { const bool keep = dir ? (jt > it) : (jt < it); if (!keep) continue; }
                f32x16 p = MFMA32(KI[jt][0], QD[it][0], zero16); p = MFMA32(KI[jt][1], QD[it][1], p);
                if (jt == it) {
#pragma unroll
                    for (int i = 0; i < 16; ++i) { const int jj = (i & 3) + 8 * (i >> 2) + 4 * hf; const bool kp_ = dir ? (jj >= r) : (jj <= r); p[i] = kp_ ? p[i] : 0.f; }
                }
                const bf16x8 P0 = pack_step(p, 0), P1 = pack_step(p, 1);
#pragma unroll
                for (int ct = 0; ct < 2; ++ct) {
                    const LAS bf16_t* vp = vT + (32 * ct + r) * VS + 32 * jt + 4 * hf;
                    const bf16x8 A0 = cat44(*(const LAS u32x2*)vp, *(const LAS u32x2*)(vp + 8)), A1 = cat44(*(const LAS u32x2*)(vp + 16), *(const LAS u32x2*)(vp + 24));
                    OT[ct][it] = MFMA32(A0, P0, OT[ct][it]); OT[ct][it] = MFMA32(A1, P1, OT[ct][it]); }
            }
        const bf16_t* st = SIN + ((size_t)((dir * 4 + cp.b) * 4 + h) * NSEQ + (dir ? cp.sb : cp.sf)) * 2048;
#pragma unroll
        for (int ct = 0; ct < 2; ++ct)
#pragma unroll
            for (int s = 0; s < 2; ++s) { const size_t off = (size_t)(32 * ct + r) * 32 + 16 * s + 4 * hf;
                const bf16x8 As = cat44(*(const u32x2*)(st + off), *(const u32x2*)(st + off + 8));
                OT[ct][0] = MFMA32(As, QD[0][s], OT[ct][0]); OT[ct][1] = MFMA32(As, QD[1][s], OT[ct][1]); }
    }
    int ln2 = lane; asm volatile("" : "+v"(ln2)); const int r = ln2 & 31, hf = ln2 >> 5;
#pragma unroll
    for (int it = 0; it < 2; ++it) {
        float ss = 0.f;
#pragma unroll
        for (int ct = 0; ct < 2; ++ct)
#pragma unroll
            for (int i = 0; i < 16; ++i) ss += OT[ct][it][i] * OT[ct][it][i];
        ss += __shfl_xor(ss, 32);
        const float rs = rsqrtf(ss * (1.0f / 64.0f) + EPS);
        const int t = 32 * it + r;
#pragma unroll
        for (int ct = 0; ct < 2; ++ct)
#pragma unroll
            for (int g = 0; g < 4; ++g) { const int c0 = 32 * ct + 8 * g + 4 * hf;
                const u32x2 gw_ = *(const u32x2*)(cols0 + (size_t)t * NINP + C_G + 64 * h + c0);
                const f32x4 go = *(const f32x4*)(a.in[I_GOUT] + l * 256 + 64 * h + c0);
                const float o0 = OT[ct][it][4 * g] * rs * go[0] * siluf_(bflo(gw_.x)), o1 = OT[ct][it][4 * g + 1] * rs * go[1] * siluf_(bfhi(gw_.x));
                const float o2 = OT[ct][it][4 * g + 2] * rs * go[2] * siluf_(bflo(gw_.y)), o3 = OT[ct][it][4 * g + 3] * rs * go[3] * siluf_(bfhi(gw_.y));
                u32x2 w; w.x = pk2c(o0, o1); w.y = pk2c(o2, o3);
                *(u32x2*)(MIX + (size_t)(tile * 64 + t) * D + 64 * h + c0) = w; }
    }
    LDS_WAIT(); asm volatile("" ::: "memory");
}
template <int TAPS>
__device__ __forceinline__ void vconv_item(const float* SRC, float* DST, const float* w  , int b, int col, int chg, LAS float* buf, int lane) {
    const int ch = lane & 31, rh = lane >> 5;
    const size_t base = ((size_t)b * SEQ + col) * 128 + chg * 32 + ch;
#pragma unroll 8
    for (int r = 0; r < 128; r += 2) buf[(r + rh) * 32 + ch] = SRC[base + (size_t)(r + rh) * 64 * 128];
    float wt[TAPS];
#pragma unroll
    for (int j = 0; j < TAPS; ++j) wt[j] = w[j * 256 + chg * 32 + ch];
    LDS_WAIT(); asm volatile("" ::: "memory");
    constexpr int HW = TAPS / 2;
#pragma unroll 1
    for (int r0 = 0; r0 < 64; r0 += 8) {
        const int rb = rh * 64 + r0;
        float o[8] = {0.f, 0.f, 0.f, 0.f, 0.f, 0.f, 0.f, 0.f};
#pragma unroll
        for (int j = 0; j < TAPS + 7; ++j) { const int rin = rb - HW + j; const float x = (rin >= 0 && rin < 128) ? buf[rin * 32 + ch] : 0.f;
#pragma unroll
            for (int q = 0; q < 8; ++q) { if (j - q >= 0 && j - q < TAPS) o[q] += x * wt[j - q]; } }
#pragma unroll
        for (int q = 0; q < 8; ++q) DST[base + (size_t)(rb + q) * 64 * 128] = o[q];
    }
    LDS_WAIT(); asm volatile("" ::: "memory");
}
__device__ __forceinline__ void phase_scan(const Args& a, int l, LAS unsigned char* lds) {
    const int tid = tid_now(), lane = tid & 63, wid = __builtin_amdgcn_readfirstlane(tid >> 6);
    const float* KV = (const float*)(a.ws + WS_KV); const float* DEC = (const float*)(a.ws + WS_DEC); bf16_t* SIN = (bf16_t*)(a.ws + WS_SIN);
    if (tid < 256) {
        for (int rp = 0; rp < ((REP_SUB == 5 && l == 0) ? 2 : 1); ++rp)
        for (int gid = blockIdx.x * 256 + tid; gid < 65536; gid += gridDim.x * 256) {
            const int e = gid >> 11, idx = gid & 2047;
            const float* p = KV + (size_t)e * NSEQ * 2048 + idx; const float* dp = DEC + (size_t)e * NSEQ * 32 + (idx & 31); bf16_t* q = SIN + (size_t)e * NSEQ * 2048 + idx;
            float st = 0.f;
#pragma unroll 1
            for (int s0 = 0; s0 < NSEQ; s0 += 12) {
                float kv[12], dd[12];
#pragma unroll
                for (int u = 0; u < 12; ++u) { kv[u] = p[(size_t)(s0 + u) * 2048]; dd[u] = dp[(s0 + u) * 32]; }
#pragma unroll
                for (int u = 0; u < 12; ++u) { q[(size_t)(s0 + u) * 2048] = (bf16_t)(pk2c(st, 0.f) & 0xffffu); st = dd[u] * st + kv[u]; }
            }
        }
    }
    LAS float* buf = (LAS float*)(lds + wid * 16384);
    const int gw = blockIdx.x * 8 + wid, NGW = gridDim.x * 8;
    for (int rp = 0; rp < ((REP_SUB == 6 && l == 0) ? 2 : 1); ++rp)
    for (int it = gw; it < 2048; it += NGW) {
        const int kind = it >> 10, q = it & 1023, b = q >> 8, col = (q >> 2) & 63, chg = q & 3;
        if (kind == 0) vconv_item<31>((const float*)(a.ws + WS_AGV), (float*)(a.ws + WS_UV), a.in[I_CONFW] + (size_t)l * 31 * 256 + 128, b, col, chg, buf, lane);
        else vconv_item<3>((const float*)(a.ws + WS_CXV), (float*)(a.ws + WS_SCV), a.in[I_SCW] + (size_t)l * 3 * 256 + 128, b, col, chg, buf, lane);
    }
}

__device__ __forceinline__ void mixer_local(const Args& a, int l, int tile, int half, LAS unsigned char* lds) {
    const int tid = tid_now();
    const bf16_t* COLS = (const bf16_t*)(a.ws + WS_COLS); bf16_t* MIX = (bf16_t*)(a.ws + WS_MIX);
    LAS float* AG = (LAS float*)lds;
    LAS float* U = AG + 7936;
    LAS float* CX = U + 8192;
    const bool lat = tile < 512; const int r0 = tile * 64 + half * 32;
    const int seq_lo = lat ? tile * 64 : (NLAT + ((tile - 512) >> 2) * CTXL), seq_hi = lat ? tile * 64 + 64 : seq_lo + CTXL;
    const float* confw = a.in[I_CONFW] + (size_t)l * 31 * 256; const float* scw = a.in[I_SCW] + (size_t)l * 3 * 256;
    const int npass = lat ? 1 : 2;
    for (int ps = 0; ps < npass; ++ps) {
        const int chb = ps * 128;
        for (int idx = tid; idx < 62 * 16; idx += 512) { const int tt = idx >> 4, c8 = (idx & 15) * 8, r = r0 - 15 + tt;
            float o[8] = {0.f, 0.f, 0.f, 0.f, 0.f, 0.f, 0.f, 0.f};
            if (r >= seq_lo && r < seq_hi) { const bf16_t* rp = COLS + (size_t)r * NINP; float fa[8], fg[8]; unpack8(*(const u32x4*)(rp + C_CA + chb + c8), fa); unpack8(*(const u32x4*)(rp + C_CG + chb + c8), fg);
#pragma unroll
                for (int i = 0; i < 8; ++i) o[i] = fa[i] * sigmoidf_(fg[i]); }
            *(LAS f32x4*)(AG + tt * 128 + c8) = (f32x4){o[0], o[1], o[2], o[3]}; *(LAS f32x4*)(AG + tt * 128 + c8 + 4) = (f32x4){o[4], o[5], o[6], o[7]}; }
        for (int idx = tid; idx < 34 * 16; idx += 512) { const int tt = idx >> 4, c8 = (idx & 15) * 8, r = r0 - 1 + tt;
            float o[8] = {0.f, 0.f, 0.f, 0.f, 0.f, 0.f, 0.f, 0.f};
            if (r >= seq_lo && r < seq_hi) { const bf16_t* rp = COLS + (size_t)r * NINP; float fc[8], fx[8]; unpack8(*(const u32x4*)(rp + C_SC + chb + c8), fc); unpack8(*(const u32x4*)(rp + C_SX + chb + c8), fx);
#pragma unroll
                for (int i = 0; i < 8; ++i) o[i] = fc[i] * fx[i]; }
            *(LAS f32x4*)(CX + tt * 128 + c8) = (f32x4){o[0], o[1], o[2], o[3]}; *(LAS f32x4*)(CX + tt * 128 + c8 + 4) = (f32x4){o[4], o[5], o[6], o[7]}; }
        __syncthreads();
        { const int c = tid & 127, t0 = (tid >> 7) * 8;
            float wv[31];
#pragma unroll
            for (int j = 0; j < 31; ++j) wv[j] = confw[j * 256 + chb + c];
            const float bias = a.in[I_CONFB][l * 256 + chb + c];
            const float w0 = scw[chb + c], w1 = scw[256 + chb + c], w2 = scw[512 + chb + c];
            float o[8];
#pragma unroll
            for (int q = 0; q < 8; ++q) o[q] = bias;
#pragma unroll
            for (int j = 0; j < 38; ++j) { const float x = AG[(t0 + j) * 128 + c];
#pragma unroll
                for (int q = 0; q < 8; ++q) { if (j - q >= 0 && j - q < 31) o[q] += x * wv[j - q]; } }
#pragma unroll
            for (int q = 0; q < 8; ++q) U[(t0 + q) * 256 + chb + c] = o[q];
#pragma unroll
            for (int q = 0; q < 8; ++q) { const int t = t0 + q; const float cv = CX[t * 128 + c] * w0 + CX[(t + 1) * 128 + c] * w1 + CX[(t + 2) * 128 + c] * w2;
                const float sb = __uint_as_float(((unsigned)COLS[(size_t)(r0 + t) * NINP + C_SB + chb + c]) << 16);
                MIX[(size_t)(r0 + t) * D + 512 + chb + c] = (bf16_t)(pk2(sb * cv, 0.f) & 0xffffu); }
        }
        __syncthreads();
    }
    if (lat) {
        const float* UV = (const float*)(a.ws + WS_UV); const float* SCV = (const float*)(a.ws + WS_SCV);
        for (int idx = tid; idx < 32 * 32; idx += 512) { const int t = idx >> 5, c4 = (idx & 31) * 4;
            const f32x4 u = *(const f32x4*)(UV + (size_t)(r0 + t) * 128 + c4), bz = *(const f32x4*)(a.in[I_CONFB] + l * 256 + 128 + c4);
            *(LAS f32x4*)(U + t * 256 + 128 + c4) = u + bz;
            const f32x4 sv = *(const f32x4*)(SCV + (size_t)(r0 + t) * 128 + c4);
            const u32x2 sbw = *(const u32x2*)(COLS + (size_t)(r0 + t) * NINP + C_SB + 128 + c4);
            u32x2 w; w.x = pk2(bflo(sbw.x) * sv[0], bfhi(sbw.x) * sv[1]); w.y = pk2(bflo(sbw.y) * sv[2], bfhi(sbw.y) * sv[3]);
            *(u32x2*)(MIX + (size_t)(r0 + t) * D + 512 + 128 + c4) = w; }
        __syncthreads();
    }
    { const int t = tid >> 4, c0 = (tid & 15) * 16;
        float s = 0.f;
#pragma unroll
        for (int i = 0; i < 16; i += 4) { const f32x4 v = *(const LAS f32x4*)(U + t * 256 + c0 + i); s += (v[0] + v[1]) + (v[2] + v[3]); }
        s += __shfl_xor(s, 1); s += __shfl_xor(s, 2); s += __shfl_xor(s, 4); s += __shfl_xor(s, 8);
        const float mean = s * (1.0f / 256.0f); float q = 0.f;
#pragma unroll
        for (int i = 0; i < 16; i += 4) { const f32x4 v = *(const LAS f32x4*)(U + t * 256 + c0 + i) - mean; q += (v[0] * v[0] + v[1] * v[1]) + (v[2] * v[2] + v[3] * v[3]); }
        q += __shfl_xor(q, 1); q += __shfl_xor(q, 2); q += __shfl_xor(q, 4); q += __shfl_xor(q, 8);
        const float rstd = rsqrtf(q * (1.0f / 256.0f) + EPS);
        const float* lg = a.in[I_CONFG] + l * 256 + c0; const float* lb = a.in[I_CONFBETA] + l * 256 + c0;
#pragma unroll
        for (int i = 0; i < 16; i += 8) { float y[8];
#pragma unroll
            for (int k = 0; k < 8; ++k) y[k] = siluf_((U[t * 256 + c0 + i + k] - mean) * rstd * lg[i + k] + lb[i + k]);
            u32x4 w; w.x = pk2(y[0], y[1]); w.y = pk2(y[2], y[3]); w.z = pk2(y[4], y[5]); w.w = pk2(y[6], y[7]);
            *(u32x4*)(MIX + (size_t)(r0 + t) * D + 256 + c0 + i) = w; }
    }
    __syncthreads();
    for (int hf = 0; hf < 2; ++hf) {
        LAS float* PI = (LAS float*)lds;
        LAS float* DF = PI + 6144;
        LAS float* PW = DF + 4224;
        for (int idx = tid; idx < 48 * 16; idx += 512) { const int tt = idx >> 4, c8 = (idx & 15) * 8, r = r0 - 8 + tt;
            float o[8] = {0.f, 0.f, 0.f, 0.f, 0.f, 0.f, 0.f, 0.f};
            if (r >= seq_lo && r < seq_hi) unpack8(*(const u32x4*)(COLS + (size_t)r * NINP + C_PL + hf * 128 + c8), o);
            *(LAS f32x4*)(PI + tt * 128 + c8) = (f32x4){o[0], o[1], o[2], o[3]}; *(LAS f32x4*)(PI + tt * 128 + c8 + 4) = (f32x4){o[4], o[5], o[6], o[7]}; }
        for (int idx = tid; idx < 2 * 64 * 64 / 4; idx += 512) *(LAS f32x4*)(PW + idx * 4) = *(const f32x4*)(a.in[I_POOLW] + (size_t)l * 4 * 4096 + (size_t)hf * 2 * 4096 + idx * 4);
        __syncthreads();
        for (int idx = tid; idx < 32 * 128; idx += 512) { const int t = idx >> 7, c = idx & 127, g = hf * 2 + (c >> 6); const int hw = 1 << g;
            const int r = r0 + t; int lo = r - hw, hi = r + hw; lo = lo < seq_lo ? seq_lo : lo; hi = hi > seq_hi ? seq_hi : hi;
            float sm = 0.f; for (int rr = lo; rr < hi; ++rr) sm += PI[(rr - r0 + 8) * 128 + c];
            DF[t * 132 + c] = sm / (float)(hi - lo) - PI[(t + 8) * 128 + c]; }
        __syncthreads();
        { const int gl = tid >> 8, tp = (tid >> 4) & 15, dq = tid & 15; const int dd0 = dq * 4;
            f32x4 o[2] = {(f32x4){0.f, 0.f, 0.f, 0.f}, (f32x4){0.f, 0.f, 0.f, 0.f}};
#pragma unroll 2
            for (int c4 = 0; c4 < 64; c4 += 4) { f32x4 dv[2];
#pragma unroll
                for (int x = 0; x < 2; ++x) dv[x] = *(const LAS f32x4*)(DF + (tp * 2 + x) * 132 + gl * 64 + c4);
#pragma unroll
                for (int q = 0; q < 4; ++q) { const f32x4 wv = *(const LAS f32x4*)(PW + (gl * 64 + c4 + q) * 64 + dd0);
#pragma unroll
                    for (int x = 0; x < 2; ++x) o[x] += dv[x][q] * wv; } }
            const int ch = (hf * 2 + gl) * 64 + dd0; const f32x4 ps = *(const f32x4*)(a.in[I_POOLS] + l * 256 + ch);
#pragma unroll
            for (int x = 0; x < 2; ++x) { u32x2 w; w.x = pk2(o[x][0] * ps[0], o[x][1] * ps[1]); w.y = pk2(o[x][2] * ps[2], o[x][3] * ps[3]);
                *(u32x2*)(MIX + (size_t)(r0 + tp * 2 + x) * D + 768 + ch) = w; } }
        __syncthreads();
    }
}

__device__ __forceinline__ void phase_mixer(const Args& a, int l, LAS unsigned char* lds) {
    const int ntile = (l == 1) ? 512 : NCHUNK;
    { const int tid = tid_now(), lane = tid & 63, wid = __builtin_amdgcn_readfirstlane(tid >> 6);
        LAS bf16_t* vT = (LAS bf16_t*)(lds + wid * 16384);
        const int gw = blockIdx.x * 8 + wid, NGW = gridDim.x * 8;
        for (int rp = 0; rp < ((REP_SUB == 1 && l == 0) ? 2 : 1); ++rp)
        for (int it = gw; it < ntile * 4; it += NGW) mixer_gla_item(a, l, it >> 2, it & 3, lane, vT); }
    __syncthreads();
    for (int rp = 0; rp < ((REP_SUB == 2 && l == 0) ? 2 : 1); ++rp)
    for (int it = blockIdx.x; it < ntile * 2; it += gridDim.x) mixer_local(a, l, it >> 1, it & 1, lds);
}

__device__ __forceinline__ void phase_router(const Args& a, int l, LAS unsigned char* lds) {
    const int tid = tid_now(), lane = tid & 63, wid = tid >> 6;
    const int M = (l == 1) ? NLAT : MTOT;
    const float* MOD = (const float*)(a.ws + WS_MOD) + (size_t)l * 5 * 6144; bf16_t* H = (bf16_t*)(a.ws + WS_H);
    LAS float* WRE = (LAS float*)lds;
    LAS int* INFO = (LAS int*)(lds + MISC_OFF + 4096);
    LAS int* HIST = (LAS int*)(lds + MISC_OFF + 2048);
    const float* wre = a.in[I_RWE] + (size_t)l * 1024 * 32; const float* wrgT = (const float*)(a.ws + WS_TAB) + (size_t)l * 4096;
    for (int i = tid; i < 1024 * 8; i += 512) { const int k = i >> 3, q = i & 7; const f32x4 w = *(const f32x4*)(wre + k * 32 + q * 4);
        WRE[(4 * q + 0) * 1024 + k] = w[0]; WRE[(4 * q + 1) * 1024 + k] = w[1]; WRE[(4 * q + 2) * 1024 + k] = w[2]; WRE[(4 * q + 3) * 1024 + k] = w[3]; }
    if (tid < 64) HIST[tid] = 0;
    __syncthreads();
    const int per = (M + gridDim.x - 1) / gridDim.x; const int r_lo = blockIdx.x * per; int r_hi = r_lo + per; if (r_hi > M) r_hi = M;
    const float rbg0 = a.in[I_RBG][l * 4 + 0], rbg1 = a.in[I_RBG][l * 4 + 1], rbg2 = a.in[I_RBG][l * 4 + 2], rbg3 = a.in[I_RBG][l * 4 + 3];
    const float* X0lat = l == 0 ? a.in[I_X] : a.out; const float* X0ctx = l == 0 ? a.in[I_CTX] : (const float*)(a.ws + WS_XCTX);
    float* X1lat = a.out; float* X1ctx = (float*)(a.ws + WS_XCTX); const bf16_t* Y1 = (const bf16_t*)(a.ws + WS_Y);
    int cur_b = -1; f32x4 GS[4], SH[4], GA[4], WGT[4][4];
#pragma unroll
    for (int g = 0; g < 4; ++g)
#pragma unroll
        for (int j = 0; j < 4; ++j) WGT[g][j] = *((const f32x4*)(wrgT + g * 1024) + lane + 64 * j);
    for (int rp = 0; rp < ((REP_SUB == 7 && l == 0) ? 2 : 1); ++rp)
#pragma unroll 1
    for (int mm = r_lo + wid; mm < r_hi; mm += 16) {
        f32x4 vv[2][4]; u32x2 yy[2][4]; int mrow[2]; bool has[2];
#pragma unroll
        for (int rr = 0; rr < 2; ++rr) { const int m = mm + 8 * rr; has[rr] = m < r_hi; const int mc = has[rr] ? m : mm; mrow[rr] = mc;
            const float* src = mc < NLAT ? X0lat + (size_t)mc * D : X0ctx + (size_t)(mc - NLAT) * D;
            load_row(src, lane, vv[rr]);
#pragma unroll
            for (int j = 0; j < 4; ++j) yy[rr][j] = *((const u32x2*)(Y1 + (size_t)mc * D) + lane + 64 * j); }
#pragma unroll
        for (int rr = 0; rr < 2; ++rr) {
            if (!has[rr]) continue;
            const int m = mrow[rr]; const int b = m < NLAT ? (m >> 13) : 4;
            if (b != cur_b) { const float* mod = MOD + (size_t)b * 6144; load_mod_cached(a.in[I_G2] + l * 1024, mod + 4 * 1024, mod + 3 * 1024, mod + 2 * 1024, lane, GS, SH, GA); cur_b = b; }
            float* dst = m < NLAT ? X1lat + (size_t)m * D : X1ctx + (size_t)(m - NLAT) * D;
            f32x4 v[4];
#pragma unroll
            for (int j = 0; j < 4; ++j) { const u32x2 y = yy[rr][j];
                v[j] = vv[rr][j] + GA[j] * (f32x4){bflo(y.x), bfhi(y.x), bflo(y.y), bfhi(y.y)};
                *((f32x4*)dst + lane + 64 * j) = v[j]; }
            const float rstd = row_rstd(v);
            norm_store_cached(v, rstd, GS, SH, H + (size_t)m * D, lane);
            float ga_[4] = {0.f, 0.f, 0.f, 0.f};
#pragma unroll
            for (int g = 0; g < 4; ++g)
#pragma unroll
                for (int j = 0; j < 4; ++j) { const f32x4 w = WGT[g][j]; ga_[g] += (v[j][0] * w[0] + v[j][1] * w[1]) + (v[j][2] * w[2] + v[j][3] * w[3]); }
            float lg0, lg1, lg2, lg3;
            { const bool h5 = (lane & 32) != 0, h4 = (lane & 16) != 0;
                float k0 = h5 ? ga_[2] : ga_[0], k1 = h5 ? ga_[3] : ga_[1]; const float s0 = h5 ? ga_[0] : ga_[2], s1 = h5 ? ga_[1] : ga_[3];
                k0 += __shfl_xor(s0, 32); k1 += __shfl_xor(s1, 32);
                float kk = h4 ? k1 : k0; const float sk = h4 ? k0 : k1; kk += __shfl_xor(sk, 16);
                kk += __shfl_xor(kk, 8); kk += __shfl_xor(kk, 4); kk += __shfl_xor(kk, 2); kk += __shfl_xor(kk, 1);
                lg0 = __int_as_float(__builtin_amdgcn_readlane(__float_as_int(kk), 0)) + rbg0; lg1 = __int_as_float(__builtin_amdgcn_readlane(__float_as_int(kk), 16)) + rbg1;
                lg2 = __int_as_float(__builtin_amdgcn_readlane(__float_as_int(kk), 32)) + rbg2; lg3 = __int_as_float(__builtin_amdgcn_readlane(__float_as_int(kk), 48)) + rbg3; }
            int grp = 0; float best = lg0; if (lg1 > best) { best = lg1; grp = 1; } if (lg2 > best) { best = lg2; grp = 2; } if (lg3 > best) { best = lg3; grp = 3; }
            const float pg = 1.0f / (__expf(lg0 - best) + __expf(lg1 - best) + __expf(lg2 - best) + __expf(lg3 - best));
            grp = __builtin_amdgcn_readfirstlane(grp);
            float ep[8];
            { const LAS float* wb = WRE + (size_t)(grp * 8) * 1024;
#pragma unroll
                for (int i = 0; i < 8; ++i) { float acc_ = 0.f;
#pragma unroll
                    for (int j = 0; j < 4; ++j) { const f32x4 w = *((const LAS f32x4*)(wb + i * 1024) + lane + 64 * j); acc_ += (v[j][0] * w[0] + v[j][1] * w[1]) + (v[j][2] * w[2] + v[j][3] * w[3]); }
                    ep[i] = acc_; } }
            float le[8];
            { const bool h5 = (lane & 32) != 0, h4 = (lane & 16) != 0, h3 = (lane & 8) != 0;
                float k4[4];
#pragma unroll
                for (int i = 0; i < 4; ++i) { const float keep = h5 ? ep[4 + i] : ep[i], send = h5 ? ep[i] : ep[4 + i]; k4[i] = keep + __shfl_xor(send, 32); }
                float k2[2];
#pragma unroll
                for (int i = 0; i < 2; ++i) { const float keep = h4 ? k4[2 + i] : k4[i], send = h4 ? k4[i] : k4[2 + i]; k2[i] = keep + __shfl_xor(send, 16); }
                float kk = h3 ? k2[1] : k2[0]; const float sk = h3 ? k2[0] : k2[1]; kk += __shfl_xor(sk, 8);
                kk += __shfl_xor(kk, 4); kk += __shfl_xor(kk, 2); kk += __shfl_xor(kk, 1);
#pragma unroll
                for (int i = 0; i < 8; ++i) le[i] = __int_as_float(__builtin_amdgcn_readlane(__float_as_int(kk), 8 * i)) + a.in[I_RBE][l * 32 + grp * 8 + i]; }
            int i0 = 0; float v0 = le[0];
#pragma unroll
            for (int i = 1; i < 8; ++i) if (le[i] > v0) { v0 = le[i]; i0 = i; }
            int i1 = -1; float v1 = -3.0e38f;
#pragma unroll
            for (int i = 0; i < 8; ++i) if (i != i0 && le[i] > v1) { v1 = le[i]; i1 = i; }
            const float w0 = 1.0f / (1.0f + __expf(v1 - v0)); const float w1 = 1.0f - w0;
            if (lane == 0) { const int lr = m - r_lo; INFO[lr * 4 + 0] = grp * 8 + i0; INFO[lr * 4 + 1] = grp * 8 + i1; INFO[lr * 4 + 2] = __float_as_int(w0 * pg); INFO[lr * 4 + 3] = __float_as_int(w1 * pg); }
        }
    }
    __syncthreads();
    const int nr = r_hi - r_lo; int lp0 = 0, lp1 = 0, ee0 = 0, ee1 = 0;
    if (tid < nr) { ee0 = INFO[tid * 4 + 0]; ee1 = INFO[tid * 4 + 1]; lp0 = atomicAdd((int*)(HIST + ee0), 1); lp1 = atomicAdd((int*)(HIST + ee1), 1); }
    __syncthreads();
    unsigned* cnt = (unsigned*)(a.ws + WS_CTL) + CW_CNT + l * 32 * 64;
    if (tid < 32) { const int c = HIST[tid]; HIST[32 + tid] = c ? (int)atomicAdd(cnt + tid * 64, (unsigned)c) : 0; }
    __syncthreads();
    if (tid < nr) { const int m = r_lo + tid; const int p0 = HIST[32 + ee0] + lp0, p1 = HIST[32 + ee1] + lp1;
        int* TL = (int*)(a.ws + WS_TOKLIST); TL[ee0 * MTOT + p0] = m; TL[ee1 * MTOT + p1] = m;
        *((i32x4*)(a.ws + WS_TOKINFO) + m) = (i32x4){(ee0 << 20) | p0, (ee1 << 20) | p1, INFO[tid * 4 + 2], INFO[tid * 4 + 3]}; }
    __syncthreads();
}

__device__ __forceinline__ int moe_tables(const Args& a, int l, LAS unsigned char* lds) {
    LAS int* TB = (LAS int*)(lds + MISC_OFF + 256); LAS int* CN = TB + 64; LAS int* TE = (LAS int*)(lds + MISC_OFF + 1024); LAS int* TM = TE + 320;
    const unsigned* cnt = (const unsigned*)(a.ws + WS_CTL) + CW_CNT + l * 32 * 64;
    { const int tq_ = tid_now(); if (tq_ < 32) CN[tq_] = (int)__hip_atomic_load(cnt + tq_ * 64, __ATOMIC_RELAXED, __HIP_MEMORY_SCOPE_AGENT); }
    __syncthreads();
    if (tid_now() == 0) { int t = 0;
#pragma unroll 1
        for (int e = 0; e < 32; ++e) { TB[e] = t; const int nt = (CN[e] + 255) >> 8;
#pragma unroll 1
            for (int q = 0; q < nt; ++q) { TE[t + q] = e; TM[t + q] = q; } t += nt; } TB[32] = t; }
    __syncthreads();
    return __builtin_amdgcn_readfirstlane(TB[32]);
}

__device__ __forceinline__ void phase_combine(const Args& a, int l, LAS unsigned char* lds) {
    const int lane = tid_now() & 63, wid = tid_now() >> 6, gw = blockIdx.x * 8 + wid, NGW = gridDim.x * 8;
    const int M = (l == 1) ? NLAT : MTOT;
    (void)moe_tables(a, l, lds);
    const LAS int* TB = (const LAS int*)(lds + MISC_OFF + 256);
    const float* MOD = (const float*)(a.ws + WS_MOD); const bf16_t* Y = (const bf16_t*)(a.ws + WS_Y); bf16_t* H = (bf16_t*)(a.ws + WS_H);
    float* Xlat = a.out; float* Xctx = (float*)(a.ws + WS_XCTX);
    int cur_b = -1; f32x4 GS[4], SH[4], GA[4];
#pragma unroll 1
    for (int mm = gw; mm < M; mm += 2 * NGW) {
        f32x4 vv[2][4]; u32x2 ya[2][4], yb[2][4]; i32x4 inf[2]; int mrow[2]; bool has[2];
#pragma unroll
        for (int rr = 0; rr < 2; ++rr) { const int m = mm + rr * NGW; has[rr] = m < M; const int mc = has[rr] ? m : mm; mrow[rr] = mc;
            inf[rr] = *((const i32x4*)(a.ws + WS_TOKINFO) + mc);
            const float* xr = mc < NLAT ? Xlat + (size_t)mc * D : Xctx + (size_t)(mc - NLAT) * D; load_row(xr, lane, vv[rr]); }
#pragma unroll
        for (int rr = 0; rr < 2; ++rr) { const int e0 = inf[rr].x >> 20, p0 = inf[rr].x & 0xfffff, e1 = inf[rr].y >> 20, p1 = inf[rr].y & 0xfffff;
            const bf16_t* y0 = Y + (size_t)(TB[e0] * 256 + p0) * D; const bf16_t* y1 = Y + (size_t)(TB[e1] * 256 + p1) * D;
#pragma unroll
            for (int j = 0; j < 4; ++j) { ya[rr][j] = *((const u32x2*)y0 + lane + 64 * j); yb[rr][j] = *((const u32x2*)y1 + lane + 64 * j); } }
#pragma unroll
        for (int rr = 0; rr < 2; ++rr) {
            if (!has[rr]) continue;
            const int m = mrow[rr]; const int b = m < NLAT ? (m >> 13) : 4;
            float* xr = m < NLAT ? Xlat + (size_t)m * D : Xctx + (size_t)(m - NLAT) * D;
            const float w0 = __int_as_float(inf[rr].z), w1 = __int_as_float(inf[rr].w);
            if (b != cur_b) { const float* ga2 = MOD + (size_t)(l * 5 + b) * 6144 + 5 * 1024;
                if (l == 0) { const float* mod = MOD + (size_t)(5 + b) * 6144; load_mod_cached(a.in[I_G1] + 1024, mod + 1024, mod, ga2, lane, GS, SH, GA); }
                else {
#pragma unroll
                    for (int j = 0; j < 4; ++j) { GS[j] = *((const f32x4*)a.in[I_GFINAL] + lane + 64 * j); SH[j] = (f32x4){0.f, 0.f, 0.f, 0.f}; GA[j] = *((const f32x4*)ga2 + lane + 64 * j); } }
                cur_b = b; }
            f32x4 v[4];
#pragma unroll
            for (int j = 0; j < 4; ++j) { const u32x2 a0 = ya[rr][j], a1 = yb[rr][j];
                f32x4 y; y[0] = w0 * bflo(a0.x) + w1 * bflo(a1.x); y[1] = w0 * bfhi(a0.x) + w1 * bfhi(a1.x); y[2] = w0 * bflo(a0.y) + w1 * bflo(a1.y); y[3] = w0 * bfhi(a0.y) + w1 * bfhi(a1.y);
                v[j] = vv[rr][j] + GA[j] * y; }
            const float rstd = row_rstd(v);
            if (l == 0) {
#pragma unroll
                for (int j = 0; j < 4; ++j) *((f32x4*)xr + lane + 64 * j) = v[j];
                norm_store_cached(v, rstd, GS, SH, H + (size_t)m * D, lane);
            } else {
#pragma unroll
                for (int j = 0; j < 4; ++j) *((f32x4*)xr + lane + 64 * j) = (v[j] * rstd) * GS[j];
            }
        }
    }
}

#define XB_TMO      128
#define XB_XCNT(j)  (256  + 64 * (j))
#define XB_XSUB(j)  (1280 + 64 * (j))
#define XB_XGEN(j)  (2304 + 64 * (j))
#define XB_TOP      3328
#define XB_TOPGEN   3392
#define XCD_BAR_WORDS 3456
#define XB_SPIN_CAP (1u << 22)
__device__ __forceinline__ unsigned xb_ld(unsigned* p)              { return __hip_atomic_load(p, __ATOMIC_RELAXED, __HIP_MEMORY_SCOPE_AGENT); }
__device__ __forceinline__ unsigned xb_add(unsigned* p, unsigned v) { return __hip_atomic_fetch_add(p, v, __ATOMIC_RELAXED, __HIP_MEMORY_SCOPE_AGENT); }
__device__ __forceinline__ unsigned xb_xcc_id() { return (unsigned)__builtin_amdgcn_s_getreg((3 << 11) | 20) & 0xFu; }
#define XB_SPIN(cond, bar) do { unsigned _sp = 0; while (cond) { __builtin_amdgcn_s_sleep(1); \
    if ((++_sp & 255u) == 0u) { if (xb_ld(&(bar)[XB_TMO])) break; if (_sp > XB_SPIN_CAP) { atomicAdd(&(bar)[XB_TMO], 1u); break; } } } } while (0)
struct XcdBarrier { unsigned* bar; unsigned x; volatile LAS unsigned* st; };
__device__ __forceinline__ XcdBarrier xcd_barrier_post(unsigned* bar, volatile LAS unsigned* st) {
    XcdBarrier b; b.bar = bar; b.x = xb_xcc_id(); b.st = st;
    if (threadIdx.x == 0) (void)xb_add(&bar[XB_XCNT(b.x)], 1u);
    return b;
}
__device__ __forceinline__ void xcd_barrier_complete(unsigned* bar, unsigned x, unsigned& nloc, unsigned& nx) {
    const unsigned G = gridDim.x * gridDim.y * gridDim.z;
    unsigned sum, cnt, mine, sp = 0u;
    for (;;) {
        sum = 0u; cnt = 0u; mine = 0u;
#pragma unroll
        for (unsigned j = 0; j < 16; ++j) { const unsigned c = xb_ld(&bar[XB_XCNT(j)]); sum += c; cnt += (c > 0u) ? 1u : 0u; mine = (j == x) ? c : mine; }
        if (sum == G) break;
        __builtin_amdgcn_s_sleep(1);
        if ((++sp & 255u) == 0u) { if (xb_ld(&bar[XB_TMO])) break; if (sp > XB_SPIN_CAP) { atomicAdd(&bar[XB_TMO], 1u); break; } }
    }
    nloc = mine > 0u ? mine : 1u; nx = cnt > 0u ? cnt : 1u;
}
__device__ __forceinline__ void xcd_barrier(const XcdBarrier& b) {
    asm volatile("s_waitcnt vmcnt(0)" ::: "memory");
    __syncthreads();
    if (threadIdx.x == 0) {
        unsigned* bar = b.bar;
        __builtin_amdgcn_s_waitcnt(0);
        unsigned nloc = b.st[0], nx = b.st[1];
        if (nloc == 0u) { xcd_barrier_complete(bar, b.x, nloc, nx); b.st[0] = nloc; b.st[1] = nx; }
        const unsigned old = xb_add(&bar[XB_XSUB(b.x)], 1u);
        const unsigned gen = old / nloc;
        if (old + 1u == (gen + 1u) * nloc) {
            __builtin_amdgcn_fence(__ATOMIC_RELEASE, "agent");
            asm volatile("s_waitcnt vmcnt(0)" ::: "memory");
            const unsigned og = xb_add(&bar[XB_TOP], 1u);
            const unsigned tg = og / nx;
            if (og + 1u == (tg + 1u) * nx) xb_add(&bar[XB_TOPGEN], 1u);
            else XB_SPIN(xb_ld(&bar[XB_TOPGEN]) == tg, bar);
            __builtin_amdgcn_fence(__ATOMIC_ACQUIRE, "agent");
            xb_add(&bar[XB_XGEN(b.x)], 1u);
            asm volatile("s_waitcnt vmcnt(0)" ::: "memory");
        } else {
            XB_SPIN(xb_ld(&bar[XB_XGEN(b.x)]) == gen, bar);
            __builtin_amdgcn_fence(__ATOMIC_ACQUIRE, "agent");
            asm volatile("s_waitcnt vmcnt(0)" ::: "memory");
        }
    }
    __syncthreads();
}

constexpr int NPHASE = 20;
#ifndef DIAG_PH
#define DIAG_PH -1
#endif
#define PH_ON(x) (DIAG_PH < 0 || DIAG_PH == (x))
#ifndef REP_ID
#define REP_ID -1
#endif
__global__ void __launch_bounds__(512, 2) mega(Args a) {
    extern __shared__ __attribute__((aligned(16))) unsigned char lds_raw[];
    LAS unsigned char* lds = (LAS unsigned char*)lds_raw;
    unsigned char* ws = a.ws;
    volatile LAS unsigned* bst = (volatile LAS unsigned*)(lds + MISC_OFF);
    if (threadIdx.x < 2) bst[threadIdx.x] = 0u;
    __syncthreads();
    XcdBarrier xbar = xcd_barrier_post((unsigned*)(ws + WS_CTL) + CW_BAR, bst);
    for (int ph = a.ph_lo; ph < a.ph_hi; ++ph) {
      const int cls_ = ph < 2 ? ph : 2 + (ph - 2) % 9;
      const int nrep_ = (REP_ID >= 0 && cls_ == REP_ID) ? 2 : 1;
      for (int rep_ = 0; rep_ < nrep_; ++rep_) {
        if (rep_) cg::this_grid().sync();
        if (PH_ON(0) && ph == 0) phase_p0(a, lds);
        else if (PH_ON(1) && ph == 1) phase_norm1_l0(a);
        else {
            const int l = (ph - 2) / 9, sp = (ph - 2) % 9;
            if (PH_ON(2) && sp == 0) {
                g8::DenseSched S; S.init(ws + WS_H, ws + WS_WIN + (size_t)l * NINP * 1024 * 2, MTOT, NINP, 1024, gridDim.x, blockIdx.x);
                g8::EpiBf16 E{(bf16_t*)(ws + WS_COLS), NINP};
                g8::gemm_phase(lds, S, E);
            } else if (PH_ON(3) && sp == 1) phase_chunk(a, l, lds);
            else if (PH_ON(4) && sp == 2) phase_scan(a, l, lds);
            else if (PH_ON(5) && sp == 3) phase_mixer(a, l, lds);
            else if (PH_ON(6) && sp == 4) {
                g8::DenseSched S; S.init(ws + WS_MIX, ws + WS_WOUT + (size_t)l * 1024 * 1024 * 2, l == 1 ? NLAT : MTOT, 1024, 1024, gridDim.x, blockIdx.x);
                g8::EpiBf16 E{(bf16_t*)(ws + WS_Y), 1024};
                g8::gemm_phase(lds, S, E);
            } else if (PH_ON(7) && sp == 5) phase_router(a, l, lds);
            else if ((PH_ON(8) || PH_ON(9)) && (sp == 6 || sp == 7)) {
                const int T = moe_tables(a, l, lds);
                const int G = gridDim.x, bx = blockIdx.x, vcu = (G % 8 == 0) ? (bx % 8) * (G / 8) + bx / 8 : bx;
                const LAS int* TBp = (const LAS int*)(lds + MISC_OFF + 256);
                if (PH_ON(8) && sp == 6) {
                    g8::MoeSched<true> S; S.A = (const char*)(ws + WS_H); S.Bw = (const char*)(ws + WS_WEIN) + (size_t)l * 32 * 1024 * 1024 * 2; S.wstride = (size_t)1024 * 1024 * 2; S.K = 1024; S.T = T; S.G = G; S.c = vcu;
                    S.tile_e = (const LAS int*)(lds + MISC_OFF + 1024); S.tile_mt = S.tile_e + 320; S.cnt = TBp + 64; S.toklist = (const int*)(ws + WS_TOKLIST);
                    g8::EpiSwiGLU E{(bf16_t*)(ws + WS_ACT)};
                    g8::gemm_phase(lds, S, E);
                } else if (PH_ON(9) && sp == 7) {
                    g8::MoeSched<false> S; S.A = (const char*)(ws + WS_ACT); S.Bw = (const char*)(ws + WS_WEOUT) + (size_t)l * 32 * 1024 * 512 * 2; S.wstride = (size_t)1024 * 512 * 2; S.K = 512; S.T = T; S.G = G; S.c = vcu;
                    S.tile_e = (const LAS int*)(lds + MISC_OFF + 1024); S.tile_mt = S.tile_e + 320; S.cnt = TBp + 64; S.toklist = (const int*)(ws + WS_TOKLIST);
                    g8::EpiBf16 E{(bf16_t*)(ws + WS_Y), 1024};
                    g8::gemm_phase(lds, S, E);
                }
            } else if (PH_ON(10) && sp == 8) phase_combine(a, l, lds);
        }
      }
        if (ph + 1 < a.ph_hi) { if (ph == 0) cg::this_grid().sync(); else xcd_barrier(xbar); }
    }
}

extern "C" void kernel_launch(void* const* d_in, const int* in_sizes, int n_in, void* d_out, int out_size, void* d_ws, size_t ws_size, hipStream_t stream) {
    static int grid = 0;
    if (grid == 0) {
        if (n_in != 29 || out_size != NLAT * D || ws_size < WS_END) { fprintf(stderr, "kernel_launch: unexpected shapes (n_in %d out %d ws %zu)\n", n_in, out_size, ws_size); grid = -1; return; }
        int dev = 0, cus = 0, per_cu = 0;
        hipGetDevice(&dev); hipDeviceGetAttribute(&cus, hipDeviceAttributeMultiprocessorCount, dev);
        if (hipFuncSetAttribute((const void*)mega, hipFuncAttributeMaxDynamicSharedMemorySize, LDS_BYTES) != hipSuccess) { fprintf(stderr, "kernel_launch: hipFuncSetAttribute failed\n"); grid = -1; return; }
        if (hipOccupancyMaxActiveBlocksPerMultiprocessor(&per_cu, (const void*)mega, 512, LDS_BYTES) != hipSuccess || per_cu < 1) { fprintf(stderr, "kernel_launch: occupancy query says %d\n", per_cu); per_cu = 1; }
        (void)hipGetLastError();
        grid = cus;
    }
    if (grid < 0) return;
    hipMemsetAsync((char*)d_ws + WS_CTL, 0, CTL_BYTES, stream);
    Args a{};
    for (int i = 0; i < 29; ++i) a.in[i] = (const float*)d_in[i];
    a.out = (float*)d_out; a.ws = (unsigned char*)d_ws;
#if MK_MULTI
    for (int ph = 0; ph < NPHASE; ++ph) { a.ph_lo = ph; a.ph_hi = ph + 1; hipLaunchKernelGGL(mega, dim3(grid), dim3(512), LDS_BYTES, stream, a); }
#else
    a.ph_lo = 0; a.ph_hi = NPHASE;
    void* args[] = {&a};
    hipError_t e = hipLaunchCooperativeKernel((const void*)mega, dim3(grid), dim3(512), args, LDS_BYTES, stream);
    if (e != hipSuccess) fprintf(stderr, "cooperative launch failed: %s (grid %d)\n", hipGetErrorString(e), grid);
#endif
}
```

```cpp
#include <hip/hip_runtime.h>
#include <hip/hip_cooperative_groups.h>
#include <cstdio>
namespace cg = cooperative_groups;

#ifndef MK_MULTI
#define MK_MULTI 0
#endif

#ifndef REP_SUB
#define REP_SUB 0
#endif

#define LAS __attribute__((address_space(3)))
typedef unsigned short bf16_t;
typedef short bf16x8 __attribute__((ext_vector_type(8)));
typedef float f32x4 __attribute__((ext_vector_type(4)));
typedef float f32x2 __attribute__((ext_vector_type(2)));
typedef unsigned u32x4 __attribute__((ext_vector_type(4)));
typedef unsigned u32x2 __attribute__((ext_vector_type(2)));
typedef int i32x4 __attribute__((ext_vector_type(4)));

constexpr int D = 1024, NLAT = 32768, SEQ = 8192, NCTXT = 1024, CTXL = 256, MTOT = NLAT + NCTXT;
constexpr int NIN = 2336, NINP = 2560;
constexpr int NCHUNK = MTOT / 64, NSEQ = 132;
constexpr int NEXP = 32, DEXP = 512, SLOTS = 75776;
constexpr float EPS = 1e-6f;
constexpr int C_Q = 0, C_K = 128, C_V = 256, C_G = 512, C_ZF = 768, C_ZB = 784, C_CA = 800, C_CG = 1056, C_SB = 1312, C_SC = 1568, C_SX = 1824, C_PL = 2080;

constexpr size_t MiB = 1u << 20;
constexpr size_t WS_CTL = 0, CTL_BYTES = 1 * MiB;
constexpr size_t WS_MOD = 1 * MiB;
constexpr size_t WS_TAB = 1 * MiB + 512 * 1024;
constexpr size_t WS_PWT = WS_TAB + 64 * 1024;
constexpr size_t WS_BAND = WS_TAB + 192 * 1024;
constexpr size_t WS_WIN = 2 * MiB;
constexpr size_t WS_WOUT = 12 * MiB;
constexpr size_t WS_WEIN = 16 * MiB;
constexpr size_t WS_WEOUT = 144 * MiB;
constexpr size_t WS_XCTX = 208 * MiB;
constexpr size_t WS_H = 212 * MiB;
constexpr size_t WS_COLS = 278 * MiB;
constexpr size_t WS_MIX = 443 * MiB;
constexpr size_t WS_KV = 509 * MiB;
constexpr size_t WS_DEC = 542 * MiB;
constexpr size_t WS_AGV = 543 * MiB;
constexpr size_t WS_CXV = 559 * MiB;
constexpr size_t WS_UV = 575 * MiB;
constexpr size_t WS_SCV = 591 * MiB;
constexpr size_t WS_TOKINFO = 607 * MiB;
constexpr size_t WS_TOKLIST = 608 * MiB;
constexpr size_t WS_ACT = 613 * MiB;
constexpr size_t WS_Y = 687 * MiB;
constexpr size_t WS_SIN = 835 * MiB;
constexpr size_t WS_XB = 852 * MiB;
constexpr size_t WS_END = 918 * MiB;
constexpr int CW_CNT = 1024;
constexpr int CW_BAR = 8192;

constexpr int LDS_BYTES = 147456;
constexpr int MISC_OFF = 131072;

__device__ __forceinline__ unsigned pk2(float lo, float hi) { unsigned r; asm("v_cvt_pk_bf16_f32 %0, %1, %2" : "=v"(r) : "v"(lo), "v"(hi)); return r; }
__device__ __forceinline__ float bflo(unsigned w) { return __uint_as_float(w << 16); }
__device__ __forceinline__ float bfhi(unsigned w) { return __uint_as_float(w & 0xffff0000u); }
__device__ __forceinline__ void unpack8(const u32x4 w, float (&f)[8]) { f[0] = bflo(w.x); f[1] = bfhi(w.x); f[2] = bflo(w.y); f[3] = bfhi(w.y); f[4] = bflo(w.z); f[5] = bfhi(w.z); f[6] = bflo(w.w); f[7] = bfhi(w.w); }
__device__ __forceinline__ float sigmoidf_(float x) { return 1.0f / (1.0f + __expf(-x)); }
__device__ __forceinline__ float siluf_(float x) { return x / (1.0f + __expf(-x)); }
__device__ __forceinline__ float logsigf_(float x) { return fminf(x, 0.0f) - log1pf(__expf(-fabsf(x))); }
__device__ __forceinline__ float wave_sum(float v) {
#pragma unroll
    for (int o = 1; o < 64; o <<= 1) v += __shfl_xor(v, o);
    return v;
}

typedef float f32x16 __attribute__((ext_vector_type(16)));
typedef __bf16 bf16x2_t __attribute__((ext_vector_type(2)));
#define MFMA32(a, b, c) __builtin_amdgcn_mfma_f32_32x32x16_bf16((a), (b), (c), 0, 0, 0)
__device__ __forceinline__ unsigned pk2c(float lo, float hi) { const f32x2 v = {lo, hi}; return __builtin_bit_cast(unsigned, __builtin_convertvector(v, bf16x2_t)); }
__device__ __forceinline__ bf16x8 pack8f(float x0, float x1, float x2, float x3, float x4, float x5, float x6, float x7) {
    u32x4 p; p.x = pk2c(x0, x1); p.y = pk2c(x2, x3); p.z = pk2c(x4, x5); p.w = pk2c(x6, x7); return __builtin_bit_cast(bf16x8, p); }
__device__ __forceinline__ bf16x8 pack_step(const f32x16& x, int s) { return s == 0 ? pack8f(x[0], x[1], x[2], x[3], x[4], x[5], x[6], x[7]) : pack8f(x[8], x[9], x[10], x[11], x[12], x[13], x[14], x[15]); }
__device__ __forceinline__ void split8(const float (&x)[8], bf16x8& hi, bf16x8& lo) {
    u32x4 p; p.x = pk2c(x[0], x[1]); p.y = pk2c(x[2], x[3]); p.z = pk2c(x[4], x[5]); p.w = pk2c(x[6], x[7]);
    hi = __builtin_bit_cast(bf16x8, p);
    lo = pack8f(x[0] - bflo(p.x), x[1] - bfhi(p.x), x[2] - bflo(p.y), x[3] - bfhi(p.y), x[4] - bflo(p.z), x[5] - bfhi(p.z), x[6] - bflo(p.w), x[7] - bfhi(p.w)); }
__device__ __forceinline__ bf16x8 cat44(u32x2 a, u32x2 b) { u32x4 p; p.x = a.x; p.y = a.y; p.z = b.x; p.w = b.y; return __builtin_bit_cast(bf16x8, p); }
#define LDS_WAIT() asm volatile("s_waitcnt lgkmcnt(0)" ::: "memory")
#define PIN(x) asm volatile("" : "+v"(x) :: "memory")
__device__ __forceinline__ int tid_now() { int t = threadIdx.x; asm volatile("" : "+v"(t)); return t; }

namespace g8 {
constexpr int BM = 256, BK = 64, HALF = 128, HTB = HALF * BK * 2, NXCD = 8, WGM = 8;
__device__ __forceinline__ int lds_byte(int r, int c) { const int st = (r >> 4) * 2 + (c >> 5), rr = r & 15, cc = c & 31, ob = rr * 64 + cc * 2; return st * 1024 + (ob ^ (((ob >> 9) & 1) << 5)); }
__device__ __forceinline__ void stage_rc(int b, int& R, int& C) { const int st = b / 1024, sb = b % 1024, swz = sb ^ (((sb >> 9) & 1) << 5); R = (st >> 1) * 16 + swz / 64; C = (st & 1) * 32 + (swz % 64) / 2; }
__device__ __forceinline__ int perm32(int rho) { const int n = rho >> 4, i = rho & 15; return 8 * (i >> 2) + 4 * n + (i & 3); }

struct Unit { int pm, pn, e, mt; };

struct DenseSched {
    const char* A; const char* Bt; int K, nM, nN, nwg, G, c;
    __device__ __forceinline__ void init(const void* A_, const void* Bt_, int M, int N, int K_, int G_, int c_) { A = (const char*)A_; Bt = (const char*)Bt_; K = K_; nM = M / BM; nN = N / BM; nwg = nM * nN; G = G_; c = c_; }
    __device__ __forceinline__ bool next(int i, Unit& u) const {
        const long L = (long)i * G + c; if (L >= nwg) return false;
        int wgid = (int)L; { const int q = nwg / NXCD, r = nwg % NXCD, xcd = wgid % NXCD, off = wgid / NXCD; wgid = (xcd < r ? xcd * (q + 1) : r * (q + 1) + (xcd - r) * q) + off; }
        const int nig = WGM * nN, gid = wgid / nig, fm = gid * WGM, gsz = (nM - fm) < WGM ? (nM - fm) : WGM;
        u.pm = fm + ((wgid % nig) % gsz); u.pn = (wgid % nig) / gsz; u.e = 0; u.mt = 0; return true;
    }
    __device__ __forceinline__ unsigned a_off(const Unit& u, int h, int R, int C) const { return (unsigned)(((u.pm * BM + h * HALF + R) * K + C) * 2); }
    __device__ __forceinline__ const char* b_ptr(const Unit& u) const { return Bt + (size_t)u.pn * BM * K * 2; }
};
template <bool GATHER> struct MoeSched {
    const char* A; const char* Bw; size_t wstride; int K, T, G, c; const LAS int* tile_e; const LAS int* tile_mt; const LAS int* cnt; const int* toklist;
    __device__ __forceinline__ bool next(int i, Unit& u) const {
        const int L = i * G + c; if (L >= 4 * T) return false;
        u.pm = L >> 2; u.pn = L & 3; u.e = __builtin_amdgcn_readfirstlane(tile_e[u.pm]); u.mt = __builtin_amdgcn_readfirstlane(tile_mt[u.pm]); return true;
    }
    __device__ __forceinline__ unsigned a_off(const Unit& u, int h, int R, int C) const {
        if (GATHER) { const int pos = u.mt * BM + h * HALF + R; int tok = 0; if (pos < cnt[u.e]) tok = toklist[u.e * MTOT + pos]; return (unsigned)((tok * K + C) * 2); }
        return (unsigned)(((u.pm * BM + h * HALF + R) * K + C) * 2);
    }
    __device__ __forceinline__ const char* b_ptr(const Unit& u) const { return Bw + (size_t)u.e * wstride + (size_t)u.pn * BM * K * 2; }
};

struct EpiBf16 {
    static constexpr bool PERM = true;
    bf16_t* O; int ldc;
    __device__ __forceinline__ void operator()(const f32x4 (&acc)[2][2][4][2], const Unit& u, int wr, int wc, int fr, int fq) const {
        const int row0 = u.pm * BM + wr * 64 + fr, col0 = u.pn * BM + wc * 32 + 8 * fq;
#pragma unroll
        for (int ai = 0; ai < 2; ++ai)
#pragma unroll
            for (int m = 0; m < 4; ++m) { bf16_t* rowp = O + (size_t)(row0 + ai * HALF + m * 16) * ldc + col0;
#pragma unroll
                for (int bj = 0; bj < 2; ++bj) { const f32x4 v0 = acc[ai][bj][m][0], v1 = acc[ai][bj][m][1];
                    u32x4 w; w.x = pk2(v0[0], v0[1]); w.y = pk2(v0[2], v0[3]); w.z = pk2(v1[0], v1[1]); w.w = pk2(v1[2], v1[3]);
                    *(u32x4*)(rowp + bj * HALF) = w; } }
    }
};
struct EpiSwiGLU {
    static constexpr bool PERM = true;
    bf16_t* O;
    __device__ __forceinline__ void operator()(const f32x4 (&acc)[2][2][4][2], const Unit& u, int wr, int wc, int fr, int fq) const {
        const int row0 = u.pm * BM + wr * 64 + fr, col0 = u.pn * HALF + wc * 32 + 8 * fq;
#pragma unroll
        for (int ai = 0; ai < 2; ++ai)
#pragma unroll
            for (int m = 0; m < 4; ++m) { bf16_t* rowp = O + (size_t)(row0 + ai * HALF + m * 16) * DEXP + col0;
                const f32x4 g0 = acc[ai][0][m][0], g1 = acc[ai][0][m][1], u0 = acc[ai][1][m][0], u1 = acc[ai][1][m][1];
                u32x4 w; w.x = pk2(siluf_(g0[0]) * u0[0], siluf_(g0[1]) * u0[1]); w.y = pk2(siluf_(g0[2]) * u0[2], siluf_(g0[3]) * u0[3]);
                w.z = pk2(siluf_(g1[0]) * u1[0], siluf_(g1[1]) * u1[1]); w.w = pk2(siluf_(g1[2]) * u1[2], siluf_(g1[3]) * u1[3]);
                *(u32x4*)rowp = w; }
    }
};
template <class Epi, class Sched>
__device__ __forceinline__ void gemm_phase(LAS unsigned char* lds, const Sched& S, const Epi& E) {
    const int tid = tid_now(), wid = __builtin_amdgcn_readfirstlane(tid >> 6), lane = tid & 63, wr = wid >> 2, wc = wid & 3, fr = lane & 15, fq = lane >> 4;
    const int K = S.K, nt = K / BK;
    unsigned voffB[2];
#pragma unroll
    for (int i = 0; i < 2; ++i) { int R, C; stage_rc(tid * 16 + i * 8192, R, C); const int Rb = Epi::PERM ? ((R & ~31) + perm32(R & 31)) : R; voffB[i] = (unsigned)(Rb * K + C) * 2u; }
    const size_t kstep = (size_t)(BK * 2);
    const size_t hstep = (size_t)HALF * K * 2;
    const unsigned ldsw = (unsigned)wid * 1024u;
    const int aoff = lds_byte(wr * 64 + fr, fq * 8), boff = lds_byte(wc * 32 + fr, fq * 8);
#define G8_SA(b, h) (((b) * 2 + (h)) * HTB)
#define G8_SB(b, h) ((4 + (b) * 2 + (h)) * HTB)
#define G8_STAGE(bufoff, gbase, voff) do { const unsigned long long _g = (unsigned long long)(gbase); \
        const char* _gb = (const char*)(((unsigned long long)(unsigned)__builtin_amdgcn_readfirstlane((int)(unsigned)(_g >> 32)) << 32) | (unsigned long long)(unsigned)__builtin_amdgcn_readfirstlane((int)(unsigned)_g)); \
        _Pragma("unroll") for (int _i = 0; _i < 2; ++_i) \
        __builtin_amdgcn_global_load_lds((const unsigned*)(_gb + (voff)[_i]), (LAS unsigned*)(lds + (bufoff) + ldsw + _i * 8192), 16, 0, 0); } while (0)
#define G8_LDA(dst, b, h) do { _Pragma("unroll") for (int m = 0; m < 4; ++m) _Pragma("unroll") for (int k = 0; k < 2; ++k) dst[m][k] = *(const LAS bf16x8*)(lds + G8_SA(b, h) + aoff + m * 2048 + k * 1024); } while (0)
#define G8_LDB(dst, b, h) do { _Pragma("unroll") for (int n = 0; n < 2; ++n) _Pragma("unroll") for (int k = 0; k < 2; ++k) dst[n][k] = *(const LAS bf16x8*)(lds + G8_SB(b, h) + boff + n * 2048 + k * 1024); } while (0)
#define G8_MMA(ai, bj, At, Bt) do { __builtin_amdgcn_s_setprio(1); _Pragma("unroll") for (int m = 0; m < 4; ++m) _Pragma("unroll") for (int n = 0; n < 2; ++n) _Pragma("unroll") for (int k = 0; k < 2; ++k) \
        acc[ai][bj][m][n] = __builtin_amdgcn_mfma_f32_16x16x32_bf16(Bt[n][k], At[m][k], acc[ai][bj][m][n], 0, 0, 0); __builtin_amdgcn_s_setprio(0); } while (0)
#define G8_WAIT_V(n) asm volatile("s_waitcnt vmcnt(" #n ")" ::: "memory")
#define G8_WAIT_L(n) asm volatile("s_waitcnt lgkmcnt(" #n ")" ::: "memory")
#define G8_BAR __builtin_amdgcn_s_barrier()
#define G8_SCHED __builtin_amdgcn_sched_barrier(0)
    Unit cur, nxt; int ui = 0;
    if (!S.next(0, cur)) return;
    f32x4 acc[2][2][4][2];
#pragma unroll
    for (int a = 0; a < 2; ++a)
#pragma unroll
        for (int b = 0; b < 2; ++b)
#pragma unroll
            for (int m = 0; m < 4; ++m)
#pragma unroll
                for (int n = 0; n < 2; ++n) acc[a][b][m][n] = (f32x4){0.f, 0.f, 0.f, 0.f};
    bf16x8 At[4][2], B0[2][2], B1[2][2];
    unsigned vA0[2], vA1[2];
#pragma unroll
    for (int i = 0; i < 2; ++i) { int R, C; stage_rc(tid * 16 + i * 8192, R, C); vA0[i] = S.a_off(cur, 0, R, C); vA1[i] = S.a_off(cur, 1, R, C); }
    const char* const Ab = S.A;
    const char* cB = S.b_ptr(cur);
    G8_STAGE(G8_SB(0, 0), cB, voffB); G8_STAGE(G8_SA(0, 0), Ab, vA0); G8_STAGE(G8_SB(0, 1), cB + hstep, voffB); G8_STAGE(G8_SA(0, 1), Ab, vA1);
    if (wr == 1) G8_BAR;
    G8_WAIT_V(4); G8_BAR;
    G8_STAGE(G8_SB(1, 0), cB + kstep, voffB); G8_STAGE(G8_SA(1, 0), Ab + kstep, vA0); G8_STAGE(G8_SB(1, 1), cB + hstep + kstep, voffB);
    G8_WAIT_V(6); G8_BAR;
    for (;;) {
        const bool has_next = S.next(ui + 1, nxt);
        const char* nB = has_next ? S.b_ptr(nxt) : cB;
        for (int t = 0; t < nt; t += 2) {
            const bool last = (t == nt - 2);
            const char* a1 = Ab + (size_t)(t + 1) * kstep;
            const char* a2 = last ? Ab : Ab + (size_t)(t + 2) * kstep; const char* b2 = last ? nB : cB + (size_t)(t + 2) * kstep;
            const char* a3 = a2 + kstep; const char* b3 = b2 + kstep;
            G8_LDB(B0, 0, 0); G8_SCHED; G8_LDA(At, 0, 0); G8_STAGE(G8_SA(1, 1), a1, vA1);
            G8_WAIT_L(8); G8_BAR; G8_WAIT_L(0); G8_MMA(0, 0, At, B0); G8_BAR; G8_SCHED;
            if (last && has_next) {
#pragma unroll
                for (int i = 0; i < 2; ++i) { int R, C; stage_rc(tid * 16 + i * 8192, R, C); vA0[i] = S.a_off(nxt, 0, R, C); vA1[i] = S.a_off(nxt, 1, R, C); }
            }
            G8_LDB(B1, 0, 1); G8_STAGE(G8_SB(0, 0), b2, voffB);
            G8_BAR; G8_WAIT_L(0); G8_MMA(0, 1, At, B1); G8_BAR;
            G8_LDA(At, 0, 1); G8_STAGE(G8_SA(0, 0), a2, vA0);
            G8_BAR; G8_WAIT_L(0); G8_MMA(1, 0, At, B0); G8_BAR; G8_SCHED;
            G8_STAGE(G8_SB(0, 1), b2 + hstep, voffB);
            G8_WAIT_V(6); G8_BAR; G8_MMA(1, 1, At, B1); G8_BAR;
            G8_LDB(B0, 1, 0); G8_SCHED; G8_LDA(At, 1, 0); G8_STAGE(G8_SA(0, 1), a2, vA1);
            G8_WAIT_L(8); G8_BAR; G8_WAIT_L(0); G8_MMA(0, 0, At, B0); G8_BAR; G8_SCHED;
            G8_LDB(B1, 1, 1); G8_STAGE(G8_SB(1, 0), b3, voffB);
            G8_BAR; G8_WAIT_L(0); G8_MMA(0, 1, At, B1); G8_BAR;
            G8_LDA(At, 1, 1); G8_STAGE(G8_SA(1, 0), a3, vA0);
            G8_BAR; G8_WAIT_L(0); G8_MMA(1, 0, At, B0); G8_BAR; G8_SCHED;
            G8_STAGE(G8_SB(1, 1), b3 + hstep, voffB);
            G8_WAIT_V(6); G8_BAR; G8_MMA(1, 1, At, B1); G8_BAR;
        }
        E(acc, cur, wr, wc, fr, fq);
        if (!has_next) break;
#pragma unroll
        for (int a = 0; a < 2; ++a)
#pragma unroll
            for (int b = 0; b < 2; ++b)
#pragma unroll
                for (int m = 0; m < 4; ++m)
#pragma unroll
                    for (int n = 0; n < 2; ++n) acc[a][b][m][n] = (f32x4){0.f, 0.f, 0.f, 0.f};
        cur = nxt; cB = nB; ++ui;
    }
    G8_WAIT_V(0);
    if (wr == 0) G8_BAR;
    G8_BAR;
#undef G8_SA
#undef G8_SB
#undef G8_STAGE
#undef G8_LDA
#undef G8_LDB
#undef G8_MMA
#undef G8_WAIT_V
#undef G8_WAIT_L
#undef G8_BAR
#undef G8_SCHED
}
}

struct Args { const float* in[29]; float* out; unsigned char* ws; int ph_lo, ph_hi; };
enum { I_X = 0, I_C, I_CTX, I_CCTX, I_WMOD, I_BMOD, I_G1, I_G2, I_WIN, I_GWF, I_GBF, I_GWB, I_GBB, I_GOUT, I_CONFW, I_CONFB, I_CONFG, I_CONFBETA, I_SCW, I_POOLW, I_POOLS, I_WOUT, I_RWG, I_RBG, I_RWE, I_RBE, I_EIN, I_EOUT, I_GFINAL };

__device__ __forceinline__ void transpose_item(const float* W, int K, int N, bf16_t* WT, int kb, int n0, int dst_row0, LAS float* scr, int lane) {
    const int k0 = 64 * kb;
#pragma unroll 8
    for (int i = 0; i < 32; ++i) { const int kk = 2 * i + (lane >> 5); scr[kk * 33 + (lane & 31)] = W[(size_t)(k0 + kk) * N + n0 + (lane & 31)]; }
    LDS_WAIT(); asm volatile("" ::: "memory");
    const int c = lane & 7;
#pragma unroll
    for (int j = 0; j < 4; ++j) { const int n = (lane >> 3) + 8 * j; const LAS float* s = scr + (8 * c) * 33 + n;
        u32x4 o; o.x = pk2(s[0 * 33], s[1 * 33]); o.y = pk2(s[2 * 33], s[3 * 33]); o.z = pk2(s[4 * 33], s[5 * 33]); o.w = pk2(s[6 * 33], s[7 * 33]);
        *(u32x4*)(WT + (size_t)(dst_row0 + n) * K + k0 + 8 * c) = o; }
    LDS_WAIT(); asm volatile("" ::: "memory");
}

__device__ __forceinline__ void phase_p0(const Args& a, LAS unsigned char* lds) {
    const int tid = tid_now(), lane = tid & 63, wid = __builtin_amdgcn_readfirstlane(tid >> 6);
    unsigned char* ws = a.ws;
    for (int job = blockIdx.x; job < 192; job += gridDim.x) {
        const int l = job / 96, n0 = (job % 96) * 64;
        LAS float* sv = (LAS float*)lds;
        LAS float* red = (LAS float*)(lds + 5 * 1024 * 4);
        for (int i = tid; i < 5 * 1024; i += 512) { const int r = i >> 10, k = i & 1023; const float v = r < 4 ? a.in[I_C][r * 1024 + k] : a.in[I_CCTX][k]; sv[i] = siluf_(v); }
        __syncthreads();
        const int ks = tid >> 6, col = tid & 63;
        const float* w = a.in[I_WMOD] + (size_t)l * 1024 * 6144 + (size_t)(ks * 128) * 6144 + n0 + col;
        float acc[5] = {0.f, 0.f, 0.f, 0.f, 0.f};
#pragma unroll 8
        for (int k = 0; k < 128; ++k) { const float wv = w[(size_t)k * 6144];
#pragma unroll
            for (int r = 0; r < 5; ++r) acc[r] += sv[r * 1024 + ks * 128 + k] * wv; }
#pragma unroll
        for (int r = 0; r < 5; ++r) red[(ks * 5 + r) * 64 + col] = acc[r];
        __syncthreads();
        if (tid < 320) { const int r = tid >> 6; float s = 0.f;
#pragma unroll
            for (int q = 0; q < 8; ++q) s += red[(q * 5 + r) * 64 + col];
            ((float*)(ws + WS_MOD))[(size_t)(l * 5 + r) * 6144 + n0 + col] = s + a.in[I_BMOD][l * 6144 + n0 + col]; }
        __syncthreads();
    }
    LAS float* scr = (LAS float*)(lds + wid * 16384);
    const int gw = blockIdx.x * 8 + wid, NGW = gridDim.x * 8;
    constexpr int I_IN = 16 * 73, I_OUT = 16 * 32, I_EI = 16 * 32, I_EO = 8 * 32;
    constexpr int N_IN = 2 * I_IN, N_OUT = 2 * I_OUT, N_EI = 64 * I_EI, N_EO = 64 * I_EO, NITEMS = N_IN + N_OUT + N_EI + N_EO;
    for (int it = gw; it < NITEMS; it += NGW) {
        int r = it;
        if (r < N_IN) { const int l = r / I_IN, q = r % I_IN, kb = q / 73, nb = q % 73;
            transpose_item(a.in[I_WIN] + (size_t)l * 1024 * NIN, 1024, NIN, (bf16_t*)(ws + WS_WIN) + (size_t)l * NINP * 1024, kb, nb * 32, nb * 32, scr, lane); continue; }
        r -= N_IN;
        if (r < N_OUT) { const int l = r / I_OUT, q = r % I_OUT, kb = q / 32, nb = q % 32;
            transpose_item(a.in[I_WOUT] + (size_t)l * 1024 * 1024, 1024, 1024, (bf16_t*)(ws + WS_WOUT) + (size_t)l * 1024 * 1024, kb, nb * 32, nb * 32, scr, lane); continue; }
        r -= N_OUT;
        if (r < N_EI) { const int le = r / I_EI, q = r % I_EI, kb = q / 32, nb = q % 32, n0 = nb * 32;
            const int dst = n0 < 512 ? (256 * (n0 >> 7) + (n0 & 127)) : (256 * ((n0 - 512) >> 7) + 128 + ((n0 - 512) & 127));
            transpose_item(a.in[I_EIN] + (size_t)le * 1024 * 1024, 1024, 1024, (bf16_t*)(ws + WS_WEIN) + (size_t)le * 1024 * 1024, kb, n0, dst, scr, lane); continue; }
        r -= N_EI;
        { const int le = r / I_EO, q = r % I_EO, kb = q / 32, nb = q % 32;
            transpose_item(a.in[I_EOUT] + (size_t)le * 512 * 1024, 512, 1024, (bf16_t*)(ws + WS_WEOUT) + (size_t)le * 1024 * 512, kb, nb * 32, nb * 32, scr, lane); }
    }
    for (int i = blockIdx.x * 512 + tid; i < 2 * 4096; i += gridDim.x * 512) { const int l = i >> 12, g = (i >> 10) & 3, k = i & 1023; ((float*)(ws + WS_TAB))[i] = a.in[I_RWG][l * 4096 + k * 4 + g]; }
    for (int i = blockIdx.x * 512 + tid; i < 2 * 4 * 64 * 64; i += gridDim.x * 512) { const int lg = i >> 12, dd = (i >> 6) & 63, c = i & 63;
        ((bf16_t*)(ws + WS_PWT))[i] = (bf16_t)(pk2(a.in[I_POOLW][(size_t)lg * 4096 + c * 64 + dd], 0.f) & 0xffffu); }
    for (int i = blockIdx.x * 512 + tid; i < 4 * 8 * 64; i += gridDim.x * 512) { const int wi = i >> 9, f = (i >> 6) & 7, ln = i & 63, mt = f >> 2, nt = (f >> 1) & 1, sq = f & 1, rr = ln & 31, hh = ln >> 5, hw = 1 << wi;
        const int t = 32 * nt + rr; int lo = t - hw, hi = t + hw; lo = lo < 0 ? 0 : lo; hi = hi > 64 ? 64 : hi; const int cnt = hi - lo;
        unsigned w4[4];
#pragma unroll
        for (int jp = 0; jp < 4; ++jp) { unsigned wd = 0u;
#pragma unroll
            for (int e = 0; e < 2; ++e) { const int j = 2 * jp + e, tp = 32 * mt + 16 * sq + 8 * (j >> 2) + 4 * hh + (j & 3);
                const int val = ((tp >= lo && tp < hi) ? 1 : 0) - (tp == t ? cnt : 0);
                wd |= (__float_as_uint((float)val) >> 16) << (16 * e); }
            w4[jp] = wd; }
        ((u32x4*)(ws + WS_BAND))[i] = (u32x4){w4[0], w4[1], w4[2], w4[3]}; }
    for (int i = blockIdx.x * 512 + tid; i < 2 * 224 * 1024 / 8; i += gridDim.x * 512) { const int l = i / (224 * 128), q = i % (224 * 128);
        *(u32x4*)((bf16_t*)(ws + WS_WIN) + (size_t)l * NINP * 1024 + (size_t)NIN * 1024 + (size_t)q * 8) = (u32x4){0u, 0u, 0u, 0u}; }
}

__device__ __forceinline__ void load_row(const float* xrow, int lane, f32x4 (&v)[4]) {
    const f32x4* xr = (const f32x4*)xrow + lane;
#pragma unroll
    for (int j = 0; j < 4; ++j) v[j] = xr[64 * j];
}
__device__ __forceinline__ void load_row_bf(const bf16_t* xrow, int lane, f32x4 (&v)[4]) {
#pragma unroll
    for (int j = 0; j < 4; ++j) { const u32x2 w = *((const u32x2*)xrow + lane + 64 * j); v[j] = (f32x4){bflo(w.x), bfhi(w.x), bflo(w.y), bfhi(w.y)}; }
}
__device__ __forceinline__ void store_row_bf(bf16_t* xrow, int lane, const f32x4 (&v)[4]) {
#pragma unroll
    for (int j = 0; j < 4; ++j) { u32x2 w; w.x = pk2(v[j].x, v[j].y); w.y = pk2(v[j].z, v[j].w); *((u32x2*)xrow + lane + 64 * j) = w; }
}
__device__ __forceinline__ float row_rstd(const f32x4 (&v)[4]) {
    float s = 0.f;
#pragma unroll
    for (int j = 0; j < 4; ++j) s += (v[j].x * v[j].x + v[j].y * v[j].y) + (v[j].z * v[j].z + v[j].w * v[j].w);
    return rsqrtf(wave_sum(s) * (1.0f / D) + EPS);
}
__device__ __forceinline__ void norm_mod_store(f32x4 (&v)[4], float rstd, const float* g, const float* sc, const float* sh, bf16_t* hrow, int lane) {
#pragma unroll
    for (int j = 0; j < 4; ++j) { const f32x4 gv = *((const f32x4*)g + lane + 64 * j), scv = *((const f32x4*)sc + lane + 64 * j), shv = *((const f32x4*)sh + lane + 64 * j);
        v[j] = (v[j] * rstd * gv) * (1.0f + scv) + shv;
        u32x2 w; w.x = pk2(v[j].x, v[j].y); w.y = pk2(v[j].z, v[j].w);
        *((u32x2*)hrow + lane + 64 * j) = w; }
}

__device__ __forceinline__ void norm_store_cached(f32x4 (&v)[4], float rstd, const f32x4 (&GS)[4], const f32x4 (&SH)[4], bf16_t* hrow, int lane) {
#pragma unroll
    for (int j = 0; j < 4; ++j) { v[j] = (v[j] * rstd) * GS[j] + SH[j];
        u32x2 w; w.x = pk2(v[j].x, v[j].y); w.y = pk2(v[j].z, v[j].w);
        *((u32x2*)hrow + lane + 64 * j) = w; }
}
__device__ __forceinline__ void load_mod_cached(const float* g, const float* sc, const float* sh, const float* ga, int lane, f32x4 (&GS)[4], f32x4 (&SH)[4], f32x4 (&GA)[4]) {
#pragma unroll
    for (int j = 0; j < 4; ++j) { const f32x4 gv = *((const f32x4*)g + lane + 64 * j), scv = *((const f32x4*)sc + lane + 64 * j);
        GS[j] = gv * (1.0f + scv); SH[j] = *((const f32x4*)sh + lane + 64 * j); GA[j] = *((const f32x4*)ga + lane + 64 * j); }
}

__device__ __forceinline__ void phase_norm1_l0(const Args& a) {
    const int lane = tid_now() & 63, wid = tid_now() >> 6, gw = blockIdx.x * 8 + wid, NGW = gridDim.x * 8;
    const float* MOD = (const float*)(a.ws + WS_MOD); bf16_t* H = (bf16_t*)(a.ws + WS_H);
    int cur_b = -1; f32x4 GS[4], SH[4], GA[4];
#pragma unroll 1
    for (int m = gw; m < MTOT; m += 2 * NGW) {
        const int m2 = m + NGW; const bool has2 = m2 < MTOT; const int m2c = has2 ? m2 : m;
        const float* src = m < NLAT ? a.in[I_X] + (size_t)m * D : a.in[I_CTX] + (size_t)(m - NLAT) * D;
        const float* src2 = m2c < NLAT ? a.in[I_X] + (size_t)m2c * D : a.in[I_CTX] + (size_t)(m2c - NLAT) * D;
        const int b = m < NLAT ? (m >> 13) : 4, b2 = m2c < NLAT ? (m2c >> 13) : 4;
        f32x4 v[4], v2[4]; load_row(src, lane, v); load_row(src2, lane, v2);
        const float rstd = row_rstd(v), rstd2 = row_rstd(v2);
        if (b != cur_b) { const float* mod = MOD + (size_t)b * 6144; load_mod_cached(a.in[I_G1], mod + 1024, mod, mod, lane, GS, SH, GA); cur_b = b; }
        norm_store_cached(v, rstd, GS, SH, H + (size_t)m * D, lane);
        if (has2) { if (b2 != cur_b) { const float* mod = MOD + (size_t)b2 * 6144; load_mod_cached(a.in[I_G1], mod + 1024, mod, mod, lane, GS, SH, GA); cur_b = b2; }
            norm_store_cached(v2, rstd2, GS, SH, H + (size_t)m2 * D, lane); }
    }
}

struct ChunkPos { int b, sf, sb; };
__device__ __forceinline__ ChunkPos chunk_pos(int chunk) {
    ChunkPos p;
    if (chunk < 512) { p.b = chunk >> 7; const int n = chunk & 127; p.sf = 4 + n; p.sb = 4 + 127 - n; }
    else { const int cc = chunk - 512; p.b = cc >> 2; const int n = cc & 3; p.sf = n; p.sb = 3 - n; }
    return p;
}

constexpr int VS = 72;
__device__ __forceinline__ void gla_prep_dir(int dir, int lane, const float (&w)[8], float bias, const bf16x8 (&Az)[2], f32x16 (&BT)[2]) {
    asm volatile("" : "+v"(lane));
    const int r = lane & 31, hf = lane >> 5;
    const f32x16 zero16 = {0.f, 0.f, 0.f, 0.f, 0.f, 0.f, 0.f, 0.f, 0.f, 0.f, 0.f, 0.f, 0.f, 0.f, 0.f, 0.f};
    u32x4 mk[2];
#pragma unroll
    for (int s = 0; s < 2; ++s) { unsigned w4[4];
#pragma unroll
        for (int jp = 0; jp < 4; ++jp) { const int j0 = 2 * jp, j1 = 2 * jp + 1;
            const int t0 = 16 * s + 8 * (j0 >> 2) + 4 * hf + (j0 & 3), t1 = 16 * s + 8 * (j1 >> 2) + 4 * hf + (j1 & 3);
            const bool c0 = dir ? (t0 >= r) : (t0 <= r), c1 = dir ? (t1 >= r) : (t1 <= r);
            w4[jp] = (c0 ? 0x3F80u : 0u) | (c1 ? 0x3F800000u : 0u); }
        mk[s].x = w4[0]; mk[s].y = w4[1]; mk[s].z = w4[2]; mk[s].w = w4[3]; }
    bf16x8 Bhi, Blo; split8(w, Bhi, Blo);
    BT[0] = zero16; BT[1] = zero16;
#pragma unroll 1
    for (int mt = 0; mt < 2; ++mt) {
        const bf16x8 A = mt ? Az[1] : Az[0];
        f32x16 x = MFMA32(A, Bhi, zero16); x = MFMA32(A, Blo, x);
        float la[16];
#pragma unroll
        for (int i = 0; i < 16; ++i) { const float v = x[i] + bias; la[i] = (fminf(v, 0.f) - __logf(1.0f + __expf(-fabsf(v)))) * (1.0f / 16.0f); }
#pragma unroll
        for (int s = 0; s < 2; ++s) {
            const float t8[8] = {la[8 * s], la[8 * s + 1], la[8 * s + 2], la[8 * s + 3], la[8 * s + 4], la[8 * s + 5], la[8 * s + 6], la[8 * s + 7]};
            bf16x8 Lh, Ll; split8(t8, Lh, Ll);
#pragma unroll
            for (int nt = 0; nt < 2; ++nt) {
                const bool full = dir ? (mt > nt) : (mt < nt);
                u32x4 bm; const unsigned fv = full ? 0x3F803F80u : 0u;
                bm.x = (mt == nt) ? mk[s].x : fv; bm.y = (mt == nt) ? mk[s].y : fv; bm.z = (mt == nt) ? mk[s].z : fv; bm.w = (mt == nt) ? mk[s].w : fv;
                const bf16x8 Bm = __builtin_bit_cast(bf16x8, bm);
                BT[nt] = MFMA32(Lh, Bm, BT[nt]); BT[nt] = MFMA32(Ll, Bm, BT[nt]); }
        }
    }
}
__device__ __forceinline__ void gla_gate_loads(const Args& a, int l, int h, int dir, const bf16_t* cols0, int lane, float (&w)[8], float& bias, bf16x8 (&Az)[2]) {
    const int r = lane & 31, hf = lane >> 5;
    const float* wp = a.in[dir ? I_GWB : I_GWF] + (size_t)(l * 16 + 8 * hf) * 128 + 32 * h + r;
#pragma unroll
    for (int j = 0; j < 8; ++j) w[j] = wp[j * 128];
    bias = a.in[dir ? I_GBB : I_GBF][l * 128 + 32 * h + r];
#pragma unroll
    for (int mt = 0; mt < 2; ++mt) Az[mt] = *(const bf16x8*)(cols0 + (size_t)(32 * mt + r) * NINP + C_ZF + 16 * dir + 8 * hf);
}
__device__ __forceinline__ void stage_vT(const bf16_t* cols0, int h, int lane, LAS bf16_t* vT) {
    u32x4 w[8];
#pragma unroll
    for (int q = 0; q < 8; ++q) { const int chunk = lane + 64 * q, t = chunk >> 3, cg = chunk & 7; w[q] = *(const u32x4*)(cols0 + (size_t)t * NINP + C_V + 64 * h + 8 * cg); }
#pragma unroll
    for (int q = 0; q < 8; ++q) PIN(w[q]);
#pragma unroll
    for (int q = 0; q < 8; ++q) { const int chunk = lane + 64 * q, t = chunk >> 3, cg = chunk & 7;
        LAS bf16_t* p = vT + (8 * cg) * VS + t;
        p[0 * VS] = (bf16_t)(w[q].x & 0xffffu); p[1 * VS] = (bf16_t)(w[q].x >> 16); p[2 * VS] = (bf16_t)(w[q].y & 0xffffu); p[3 * VS] = (bf16_t)(w[q].y >> 16);
        p[4 * VS] = (bf16_t)(w[q].z & 0xffffu); p[5 * VS] = (bf16_t)(w[q].z >> 16); p[6 * VS] = (bf16_t)(w[q].w & 0xffffu); p[7 * VS] = (bf16_t)(w[q].w >> 16); }
}
__device__ __forceinline__ void chunk_gla_item(const Args& a, int l, int tile, int h, int lane, LAS bf16_t* vT, LAS bf16_t* kdT) {
    const int r = lane & 31, hf = lane >> 5;
    const bf16_t* cols0 = (const bf16_t*)(a.ws + WS_COLS) + (size_t)tile * 64 * NINP;
    float* KV = (float*)(a.ws + WS_KV); float* DEC = (float*)(a.ws + WS_DEC);
    const ChunkPos cp = chunk_pos(tile);
    const f32x16 zero16 = {0.f, 0.f, 0.f, 0.f, 0.f, 0.f, 0.f, 0.f, 0.f, 0.f, 0.f, 0.f, 0.f, 0.f, 0.f, 0.f};
    stage_vT(cols0, h, lane, vT);
#pragma unroll 1
    for (int dir = 0; dir < 2; ++dir) {
        float gw8[8], gbias; bf16x8 Az[2]; u32x2 kraw[2][4];
        gla_gate_loads(a, l, h, dir, cols0, lane, gw8, gbias, Az);
#pragma unroll
        for (int nt = 0; nt < 2; ++nt)
#pragma unroll
            for (int g = 0; g < 4; ++g) kraw[nt][g] = *(const u32x2*)(cols0 + (size_t)(32 * nt + r) * NINP + C_K + 32 * h + 4 * hf + 8 * g);
#pragma unroll
        for (int j = 0; j < 8; ++j) PIN(gw8[j]);
        PIN(gbias); PIN(Az[0]); PIN(Az[1]);
#pragma unroll
        for (int nt = 0; nt < 2; ++nt)
#pragma unroll
            for (int g = 0; g < 4; ++g) PIN(kraw[nt][g]);
        f32x16 BT[2]; gla_prep_dir(dir, lane, gw8, gbias, Az, BT);
        const size_t e = (size_t)((dir * 4 + cp.b) * 4 + h) * NSEQ + (dir ? cp.sb : cp.sf);
        const int srcl = (dir ? 0 : 31) + 32 * hf;
        float tot[16];
#pragma unroll
        for (int i = 0; i < 16; ++i) tot[i] = __shfl(dir ? BT[0][i] : BT[1][i], srcl);
        if (r == (dir ? 0 : 31)) {
#pragma unroll
            for (int i = 0; i < 16; ++i) DEC[e * 32 + (i & 3) + 8 * (i >> 2) + 4 * hf] = __expf(tot[i]);
        }
#pragma unroll
        for (int nt = 0; nt < 2; ++nt) {
#pragma unroll
            for (int g = 0; g < 4; ++g) { const u32x2 kw = kraw[nt][g];
                const float kf[4] = {bflo(kw.x), bfhi(kw.x), bflo(kw.y), bfhi(kw.y)};
#pragma unroll
                for (int q = 0; q < 4; ++q) { const int i = 4 * g + q; const float kd = kf[q] * __expf(tot[i] - BT[nt][i]);
                    kdT[(8 * g + 4 * hf + q) * VS + 32 * nt + r] = (bf16_t)(pk2c(kd, 0.f) & 0xffffu); } }
        }
        LDS_WAIT(); asm volatile("" ::: "memory");
#pragma unroll 1
        for (int ct = 0; ct < 2; ++ct) {
            f32x16 acc = zero16;
#pragma unroll
            for (int ks = 0; ks < 4; ++ks) {
                const bf16x8 A = *(const LAS bf16x8*)(vT + (32 * ct + r) * VS + 16 * ks + 8 * hf);
                const bf16x8 B = *(const LAS bf16x8*)(kdT + r * VS + 16 * ks + 8 * hf);
                acc = MFMA32(A, B, acc); }
            float* dst = KV + e * 2048 + (size_t)(32 * ct + 4 * hf) * 32 + r;
#pragma unroll
            for (int i = 0; i < 16; ++i) dst[((i & 3) + 8 * (i >> 2)) * 32] = acc[i];
        }
        LDS_WAIT(); asm volatile("" ::: "memory");
    }
}
__device__ __forceinline__ void chunk_agv_item(const Args& a, int row0, int lane) {
    const bf16_t* COLS = (const bf16_t*)(a.ws + WS_COLS); float* AGV = (float*)(a.ws + WS_AGV); float* CXV = (float*)(a.ws + WS_CXV);
    const int t = lane >> 3;
#pragma unroll
    for (int rep = 0; rep < 2; ++rep) { const int c8 = ((lane & 7) + 8 * rep) * 8; const bf16_t* rp = COLS + (size_t)(row0 + t) * NINP;
        float fa[8], fg[8], fc[8], fx[8];
        unpack8(*(const u32x4*)(rp + C_CA + 128 + c8), fa); unpack8(*(const u32x4*)(rp + C_CG + 128 + c8), fg);
        unpack8(*(const u32x4*)(rp + C_SC + 128 + c8), fc); unpack8(*(const u32x4*)(rp + C_SX + 128 + c8), fx);
        f32x4 o0, o1, p0, p1;
#pragma unroll
        for (int i = 0; i < 4; ++i) { o0[i] = fa[i] * sigmoidf_(fg[i]); o1[i] = fa[4 + i] * sigmoidf_(fg[4 + i]); p0[i] = fc[i] * fx[i]; p1[i] = fc[4 + i] * fx[4 + i]; }
        float* ao = AGV + (size_t)(row0 + t) * 128 + c8; float* co = CXV + (size_t)(row0 + t) * 128 + c8;
        *(f32x4*)ao = o0; *(f32x4*)(ao + 4) = o1; *(f32x4*)co = p0; *(f32x4*)(co + 4) = p1; }
}
__device__ __forceinline__ void phase_chunk(const Args& a, int l, LAS unsigned char* lds) {
    const int tid = tid_now(), lane = tid & 63, wid = __builtin_amdgcn_readfirstlane(tid >> 6);
    LAS bf16_t* vT = (LAS bf16_t*)(lds + wid * 16384); LAS bf16_t* kdT = vT + 64 * VS;
    const int gw = blockIdx.x * 8 + wid, NGW = gridDim.x * 8;
    constexpr int N_GLA = NCHUNK * 4, N_AGV = 512 * 8;
    for (int rp = 0; rp < (((REP_SUB == 3 || REP_SUB == 4) && l == 0) ? 2 : 1); ++rp)
    for (int it = gw; it < N_GLA + N_AGV; it += NGW) {
        if (it < N_GLA) { if (rp == 0 || REP_SUB == 3) chunk_gla_item(a, l, it >> 2, it & 3, lane, vT, kdT); }
        else { if (rp == 0 || REP_SUB == 4) chunk_agv_item(a, (it - N_GLA) * 8, lane); }
    }
}
__device__ __forceinline__ void mixer_gla_item(const Args& a, int l, int tile, int h, int lane, LAS bf16_t* vT) {
    const bf16_t* cols0 = (const bf16_t*)(a.ws + WS_COLS) + (size_t)tile * 64 * NINP;
    const bf16_t* SIN = (const bf16_t*)(a.ws + WS_SIN); bf16_t* MIX = (bf16_t*)(a.ws + WS_MIX);
    const ChunkPos cp = chunk_pos(tile);
    const f32x16 zero16 = {0.f, 0.f, 0.f, 0.f, 0.f, 0.f, 0.f, 0.f, 0.f, 0.f, 0.f, 0.f, 0.f, 0.f, 0.f, 0.f};
    stage_vT(cols0, h, lane, vT);
    LDS_WAIT(); asm volatile("" ::: "memory");
    f32x16 OT[2][2] = {{zero16, zero16}, {zero16, zero16}};
#pragma unroll 1
    for (int dir = 0; dir < 2; ++dir) {
        int ln = lane; asm volatile("" : "+v"(ln)); const int r = ln & 31, hf = ln >> 5;
        bf16x8 QD[2][2], KI[2][2];
        const bf16_t* st = SIN + ((size_t)((dir * 4 + cp.b) * 4 + h) * NSEQ + (dir ? cp.sb : cp.sf)) * 2048;
        u32x2 sraw[2][2][2];
        { float gw8[8], gbias; bf16x8 Az[2]; u32x2 qraw[2][4], kraw[2][4];
            gla_gate_loads(a, l, h, dir, cols0, ln, gw8, gbias, Az);
#pragma unroll
            for (int nt = 0; nt < 2; ++nt)
#pragma unroll
                for (int g = 0; g < 4; ++g) { const bf16_t* qp = cols0 + (size_t)(32 * nt + r) * NINP + C_Q + 32 * h + 4 * hf + 8 * g; qraw[nt][g] = *(const u32x2*)qp; kraw[nt][g] = *(const u32x2*)(qp + (C_K - C_Q)); }
#pragma unroll
            for (int ct = 0; ct < 2; ++ct)
#pragma unroll
                for (int s = 0; s < 2; ++s) { const size_t off = (size_t)(32 * ct + r) * 32 + 16 * s + 4 * hf; sraw[ct][s][0] = *(const u32x2*)(st + off); sraw[ct][s][1] = *(const u32x2*)(st + off + 8); }
#pragma unroll
            for (int j = 0; j < 8; ++j) PIN(gw8[j]);
            PIN(gbias); PIN(Az[0]); PIN(Az[1]);
#pragma unroll
            for (int nt = 0; nt < 2; ++nt)
#pragma unroll
                for (int g = 0; g < 4; ++g) { PIN(qraw[nt][g]); PIN(kraw[nt][g]); }
#pragma unroll
            for (int ct = 0; ct < 2; ++ct)
#pragma unroll
                for (int s = 0; s < 2; ++s) { PIN(sraw[ct][s][0]); PIN(sraw[ct][s][1]); }
            f32x16 BT[2]; gla_prep_dir(dir, ln, gw8, gbias, Az, BT);
#pragma unroll
            for (int nt = 0; nt < 2; ++nt) {
                float qd[16], ki[16];
#pragma unroll
                for (int g = 0; g < 4; ++g) { const u32x2 qw = qraw[nt][g], kw = kraw[nt][g];
                    const float qf[4] = {bflo(qw.x), bfhi(qw.x), bflo(qw.y), bfhi(qw.y)}, kf[4] = {bflo(kw.x), bfhi(kw.x), bflo(kw.y), bfhi(kw.y)};
#pragma unroll
                    for (int q = 0; q < 4; ++q) { const float bb = BT[nt][4 * g + q]; qd[4 * g + q] = qf[q] * 0.17677669529663687f * __expf(bb); ki[4 * g + q] = kf[q] * __expf(-bb); } }
#pragma unroll
                for (int s = 0; s < 2; ++s) { QD[nt][s] = pack8f(qd[8 * s], qd[8 * s + 1], qd[8 * s + 2], qd[8 * s + 3], qd[8 * s + 4], qd[8 * s + 5], qd[8 * s + 6], qd[8 * s + 7]);
                    KI[nt][s] = pack8f(ki[8 * s], ki[8 * s + 1], ki[8 * s + 2], ki[8 * s + 3], ki[8 * s + 4], ki[8 * s + 5], ki[8 * s + 6], ki[8 * s + 7]); }
            }
        }
#pragma unroll
        for (int jt = 0; jt < 2; ++jt)
#pragma unroll
            for (int it = 0; it < 2; ++it) {
                if (jt != it) { const bool keep = dir ? (jt > it) : (jt < it); if (!keep) continue; }
                f32x16 p = MFMA32(KI[jt][0], QD[it][0], zero16); p = MFMA32(KI[jt][1], QD[it][1], p);
                if (jt == it) {
#pragma unroll
                    for (int i = 0; i < 16; ++i) { const int jj = (i & 3) + 8 * (i >> 2) + 4 * hf; const bool kp_ = dir ? (jj >= r) : (jj <= r); p[i] = kp_ ? p[i] : 0.f; }
                }
                const bf16x8 P0 = pack_step(p, 0), P1 = pack_step(p, 1);
#pragma unroll
                for (int ct = 0; ct < 2; ++ct) {
                    const LAS bf16_t* vp = vT + (32 * ct + r) * VS + 32 * jt + 4 * hf;
                    const bf16x8 A0 = cat44(*(const LAS u32x2*)vp, *(const LAS u32x2*)(vp + 8)), A1 = cat44(*(const LAS u32x2*)(vp + 16), *(const LAS u32x2*)(vp + 24));
                    OT[ct][it] = MFMA32(A0, P0, OT[ct][it]); OT[ct][it] = MFMA32(A1, P1, OT[ct][it]); }
            }
#pragma unroll
        for (int ct = 0; ct < 2; ++ct)
#pragma unroll
            for (int s = 0; s < 2; ++s) {
                const bf16x8 As = cat44(sraw[ct][s][0], sraw[ct][s][1]);
                OT[ct][0] = MFMA32(As, QD[0][s], OT[ct][0]); OT[ct][1] = MFMA32(As, QD[1][s], OT[ct][1]); }
    }
    int ln2 = lane; asm volatile("" : "+v"(ln2)); const int r = ln2 & 31, hf = ln2 >> 5;
    u32x2 graw[2][2][4]; f32x4 gor[2][4];
#pragma unroll
    for (int ct = 0; ct < 2; ++ct)
#pragma unroll
        for (int g = 0; g < 4; ++g) { const int c0 = 32 * ct + 8 * g + 4 * hf; gor[ct][g] = *(const f32x4*)(a.in[I_GOUT] + l * 256 + 64 * h + c0);
#pragma unroll
            for (int it = 0; it < 2; ++it) graw[it][ct][g] = *(const u32x2*)(cols0 + (size_t)(32 * it + r) * NINP + C_G + 64 * h + c0); }
#pragma unroll
    for (int ct = 0; ct < 2; ++ct)
#pragma unroll
        for (int g = 0; g < 4; ++g) { PIN(gor[ct][g]); PIN(graw[0][ct][g]); PIN(graw[1][ct][g]); }
#pragma unroll
    for (int it = 0; it < 2; ++it) {
        float ss = 0.f;
#pragma unroll
        for (int ct = 0; ct < 2; ++ct)
#pragma unroll
            for (int i = 0; i < 16; ++i) ss += OT[ct][it][i] * OT[ct][it][i];
        ss += __shfl_xor(ss, 32);
        const float rs = rsqrtf(ss * (1.0f / 64.0f) + EPS);
        const int t = 32 * it + r;
#pragma unroll
        for (int ct = 0; ct < 2; ++ct)
#pragma unroll
            for (int g = 0; g < 4; ++g) { const int c0 = 32 * ct + 8 * g + 4 * hf;
                const u32x2 gw_ = graw[it][ct][g];
                const f32x4 go = gor[ct][g];
                const float o0 = OT[ct][it][4 * g] * rs * go[0] * siluf_(bflo(gw_.x)), o1 = OT[ct][it][4 * g + 1] * rs * go[1] * siluf_(bfhi(gw_.x));
                const float o2 = OT[ct][it][4 * g + 2] * rs * go[2] * siluf_(bflo(gw_.y)), o3 = OT[ct][it][4 * g + 3] * rs * go[3] * siluf_(bfhi(gw_.y));
                u32x2 w; w.x = pk2c(o0, o1); w.y = pk2c(o2, o3);
                *(u32x2*)(MIX + (size_t)(tile * 64 + t) * D + 64 * h + c0) = w; }
    }
    LDS_WAIT(); asm volatile("" ::: "memory");
}
template <int TAPS>
__device__ __forceinline__ void vconv_item(const float* SRC, float* DST, const float* w  , int b, int col, int chg, LAS float* buf, int lane) {
    const int ch = lane & 31, rh = lane >> 5;
    const size_t base = ((size_t)b * SEQ + col) * 128 + chg * 32 + ch;
#pragma unroll 8
    for (int r = 0; r < 128; r += 2) buf[(r + rh) * 32 + ch] = SRC[base + (size_t)(r + rh) * 64 * 128];
    float wt[TAPS];
#pragma unroll
    for (int j = 0; j < TAPS; ++j) wt[j] = w[j * 256 + chg * 32 + ch];
    LDS_WAIT(); asm volatile("" ::: "memory");
    constexpr int HW = TAPS / 2;
#pragma unroll 1
    for (int r0 = 0; r0 < 64; r0 += 8) {
        const int rb = rh * 64 + r0;
        float o[8] = {0.f, 0.f, 0.f, 0.f, 0.f, 0.f, 0.f, 0.f};
#pragma unroll
        for (int j = 0; j < TAPS + 7; ++j) { const int rin = rb - HW + j; const float x = (rin >= 0 && rin < 128) ? buf[rin * 32 + ch] : 0.f;
#pragma unroll
            for (int q = 0; q < 8; ++q) { if (j - q >= 0 && j - q < TAPS) o[q] += x * wt[j - q]; } }
#pragma unroll
        for (int q = 0; q < 8; ++q) DST[base + (size_t)(rb + q) * 64 * 128] = o[q];
    }
    LDS_WAIT(); asm volatile("" ::: "memory");
}
__device__ __forceinline__ void phase_scan(const Args& a, int l, LAS unsigned char* lds) {
    const int tid = tid_now(), lane = tid & 63, wid = __builtin_amdgcn_readfirstlane(tid >> 6);
    const float* KV = (const float*)(a.ws + WS_KV); const float* DEC = (const float*)(a.ws + WS_DEC); bf16_t* SIN = (bf16_t*)(a.ws + WS_SIN);
    if (tid < 256) {
        for (int rp = 0; rp < ((REP_SUB == 5 && l == 0) ? 2 : 1); ++rp)
        for (int gid = blockIdx.x * 256 + tid; gid < 65536; gid += gridDim.x * 256) {
            const int e = gid >> 11, idx = gid & 2047;
            const float* p = KV + (size_t)e * NSEQ * 2048 + idx; const float* dp = DEC + (size_t)e * NSEQ * 32 + (idx & 31); bf16_t* q = SIN + (size_t)e * NSEQ * 2048 + idx;
            float st = 0.f;
#pragma unroll 1
            for (int s0 = 0; s0 < NSEQ; s0 += 12) {
                float kv[12], dd[12];
#pragma unroll
                for (int u = 0; u < 12; ++u) { kv[u] = p[(size_t)(s0 + u) * 2048]; dd[u] = dp[(s0 + u) * 32]; }
#pragma unroll
                for (int u = 0; u < 12; ++u) { q[(size_t)(s0 + u) * 2048] = (bf16_t)(pk2c(st, 0.f) & 0xffffu); st = dd[u] * st + kv[u]; }
            }
        }
    }
    LAS float* buf = (LAS float*)(lds + wid * 16384);
    const int gw = blockIdx.x * 8 + wid, NGW = gridDim.x * 8;
    for (int rp = 0; rp < ((REP_SUB == 6 && l == 0) ? 2 : 1); ++rp)
    for (int it = gw; it < 2048; it += NGW) {
        const int kind = it >> 10, q = it & 1023, b = q >> 8, col = (q >> 2) & 63, chg = q & 3;
        if (kind == 0) vconv_item<31>((const float*)(a.ws + WS_AGV), (float*)(a.ws + WS_UV), a.in[I_CONFW] + (size_t)l * 31 * 256 + 128, b, col, chg, buf, lane);
        else vconv_item<3>((const float*)(a.ws + WS_CXV), (float*)(a.ws + WS_SCV), a.in[I_SCW] + (size_t)l * 3 * 256 + 128, b, col, chg, buf, lane);
    }
}

__device__ __forceinline__ void mixer_conv_item(const Args& a, int l, int tile, int tg, int lane0, LAS float* U) {
    const bf16_t* COLS = (const bf16_t*)(a.ws + WS_COLS); bf16_t* MIX = (bf16_t*)(a.ws + WS_MIX);
    const int row0 = tile * 64, T0 = 16 * tg;
    const float* confw = a.in[I_CONFW] + (size_t)l * 31 * 256; const float* scw = a.in[I_SCW] + (size_t)l * 3 * 256;
#pragma unroll 1
    for (int p = 0; p < 2; ++p) {
        int lane = lane0; asm volatile("" : "+v"(lane));
        const int c = 64 * p + lane;
        float wv[31];
#pragma unroll
        for (int j = 0; j < 31; ++j) wv[j] = confw[j * 256 + c];
        float bias = a.in[I_CONFB][l * 256 + c];
        unsigned ra[46], rg[46];
#pragma unroll
        for (int i = 0; i < 46; ++i) { const int t = T0 - 15 + i, tc = t < 0 ? 0 : (t > 63 ? 63 : t); const bf16_t* rp = COLS + (size_t)(row0 + tc) * NINP + c; ra[i] = rp[C_CA]; rg[i] = rp[C_CG]; }
#pragma unroll
        for (int j = 0; j < 31; ++j) PIN(wv[j]);
        PIN(bias);
#pragma unroll
        for (int i = 0; i < 46; ++i) { PIN(ra[i]); PIN(rg[i]); }
        float ag[46];
#pragma unroll
        for (int i = 0; i < 46; ++i) { const int t = T0 - 15 + i; const float m = (t >= 0 && t < 64) ? 1.0f : 0.0f;
            ag[i] = m * __uint_as_float(ra[i] << 16) * __builtin_amdgcn_rcpf(1.0f + __expf(-__uint_as_float(rg[i] << 16))); }
#pragma unroll
        for (int q = 0; q < 16; ++q) { float o = bias;
#pragma unroll
            for (int j = 0; j < 31; ++j) o += ag[q + j] * wv[j];
            U[q * 256 + ((((c >> 2) ^ q) << 2) | (c & 3))] = o; }
        unsigned rc[18], rx[18], rsb[16];
        float w0 = scw[c], w1 = scw[256 + c], w2 = scw[512 + c];
#pragma unroll
        for (int i = 0; i < 18; ++i) { const int t = T0 - 1 + i, tc = t < 0 ? 0 : (t > 63 ? 63 : t); const bf16_t* rp = COLS + (size_t)(row0 + tc) * NINP + c; rc[i] = rp[C_SC]; rx[i] = rp[C_SX]; }
#pragma unroll
        for (int q = 0; q < 16; ++q) rsb[q] = COLS[(size_t)(row0 + T0 + q) * NINP + C_SB + c];
        PIN(w0); PIN(w1); PIN(w2);
#pragma unroll
        for (int i = 0; i < 18; ++i) { PIN(rc[i]); PIN(rx[i]); }
#pragma unroll
        for (int q = 0; q < 16; ++q) PIN(rsb[q]);
        float cx[18];
#pragma unroll
        for (int i = 0; i < 18; ++i) { const int t = T0 - 1 + i; const float m = (t >= 0 && t < 64) ? 1.0f : 0.0f; cx[i] = m * __uint_as_float(rc[i] << 16) * __uint_as_float(rx[i] << 16); }
#pragma unroll
        for (int q = 0; q < 16; ++q) { const float cv = cx[q] * w0 + cx[q + 1] * w1 + cx[q + 2] * w2;
            MIX[(size_t)(row0 + T0 + q) * D + 512 + c] = (bf16_t)(pk2c(__uint_as_float(rsb[q] << 16) * cv, 0.f) & 0xffffu); }
    }
    {
        int lane = lane0; asm volatile("" : "+v"(lane));
        const float* UV = (const float*)(a.ws + WS_UV); const float* SCV = (const float*)(a.ws + WS_SCV);
        f32x4 uu[8], svv[8], bzz[8]; u32x2 sbb[8];
#pragma unroll
        for (int k8 = 0; k8 < 8; ++k8) { const int idx = lane + 64 * k8, t = idx >> 5, c4 = (idx & 31) * 4; const size_t row = (size_t)(row0 + T0 + t);
            uu[k8] = *(const f32x4*)(UV + row * 128 + c4); bzz[k8] = *(const f32x4*)(a.in[I_CONFB] + l * 256 + 128 + c4);
            svv[k8] = *(const f32x4*)(SCV + row * 128 + c4); sbb[k8] = *(const u32x2*)(COLS + row * NINP + C_SB + 128 + c4); }
#pragma unroll
        for (int k8 = 0; k8 < 8; ++k8) { PIN(uu[k8]); PIN(bzz[k8]); PIN(svv[k8]); PIN(sbb[k8]); }
#pragma unroll
        for (int k8 = 0; k8 < 8; ++k8) { const int idx = lane + 64 * k8, t = idx >> 5, c4 = (idx & 31) * 4; const size_t row = (size_t)(row0 + T0 + t);
            *(LAS f32x4*)(U + t * 256 + ((((128 + c4) >> 2) ^ t) << 2)) = uu[k8] + bzz[k8];
            u32x2 w; w.x = pk2c(bflo(sbb[k8].x) * svv[k8][0], bfhi(sbb[k8].x) * svv[k8][1]); w.y = pk2c(bflo(sbb[k8].y) * svv[k8][2], bfhi(sbb[k8].y) * svv[k8][3]);
            *(u32x2*)(MIX + row * D + 512 + 128 + c4) = w; }
    }
    LDS_WAIT(); asm volatile("" ::: "memory");
    {
        int lane = lane0; asm volatile("" : "+v"(lane));
        const int t = lane >> 2, qd = lane & 3;
        f32x4 lgv[16], lbv[16];
        { const float* lg = a.in[I_CONFG] + l * 256 + 64 * qd; const float* lb = a.in[I_CONFBETA] + l * 256 + 64 * qd;
#pragma unroll
            for (int i = 0; i < 16; ++i) { lgv[i] = *(const f32x4*)(lg + 4 * i); lbv[i] = *(const f32x4*)(lb + 4 * i); }
#pragma unroll
            for (int i = 0; i < 16; ++i) { PIN(lgv[i]); PIN(lbv[i]); } }
        f32x4 v[16]; float s1 = 0.f;
#pragma unroll
        for (int i = 0; i < 16; ++i) { v[i] = *(const LAS f32x4*)(U + t * 256 + (((16 * qd + i) ^ t) << 2)); s1 += (v[i][0] + v[i][1]) + (v[i][2] + v[i][3]); }
        s1 += __shfl_xor(s1, 1); s1 += __shfl_xor(s1, 2);
        const float mean = s1 * (1.0f / 256.0f); float s2 = 0.f;
#pragma unroll
        for (int i = 0; i < 16; ++i) { v[i] = v[i] - mean; s2 += (v[i][0] * v[i][0] + v[i][1] * v[i][1]) + (v[i][2] * v[i][2] + v[i][3] * v[i][3]); }
        s2 += __shfl_xor(s2, 1); s2 += __shfl_xor(s2, 2);
        const float rstd = rsqrtf(s2 * (1.0f / 256.0f) + EPS);
        bf16_t* dst = MIX + (size_t)(row0 + T0 + t) * D + 256 + 64 * qd;
#pragma unroll
        for (int i = 0; i < 16; i += 2) { const f32x4 g0 = lgv[i], g1 = lgv[i + 1], b0 = lbv[i], b1 = lbv[i + 1];
            const f32x4 y0 = v[i] * rstd * g0 + b0, y1 = v[i + 1] * rstd * g1 + b1;
            u32x4 w; w.x = pk2c(siluf_(y0[0]), siluf_(y0[1])); w.y = pk2c(siluf_(y0[2]), siluf_(y0[3])); w.z = pk2c(siluf_(y1[0]), siluf_(y1[1])); w.w = pk2c(siluf_(y1[2]), siluf_(y1[3]));
            *(u32x4*)(dst + 4 * i) = w; }
    }
    LDS_WAIT(); asm volatile("" ::: "memory");
}
__device__ __forceinline__ void mixer_pool_item(const Args& a, int l, int tile, int lane0) {
    const bf16_t* COLS = (const bf16_t*)(a.ws + WS_COLS); bf16_t* MIX = (bf16_t*)(a.ws + WS_MIX);
    const f32x16 zero16 = {0.f, 0.f, 0.f, 0.f, 0.f, 0.f, 0.f, 0.f, 0.f, 0.f, 0.f, 0.f, 0.f, 0.f, 0.f, 0.f};
    const int row0 = tile * 64;
#pragma unroll 1
    for (int g = 0; g < 4; ++g) {
        int lane = lane0; asm volatile("" : "+v"(lane));
        const int r = lane & 31, hf = lane >> 5, hw = 1 << g;
        const bf16_t* pwt = (const bf16_t*)(a.ws + WS_PWT) + (size_t)(l * 4 + g) * 4096;
        const u32x4* band = (const u32x4*)(a.ws + WS_BAND) + (size_t)g * 512 + lane;
        f32x16 Y[2][2] = {{zero16, zero16}, {zero16, zero16}};
        bf16x8 Ax[2][4], Bw[2][4]; u32x4 Bb[8];
#pragma unroll
        for (int mt = 0; mt < 2; ++mt)
#pragma unroll
            for (int ks = 0; ks < 4; ++ks) { Ax[mt][ks] = *(const bf16x8*)(COLS + (size_t)(row0 + 32 * mt + r) * NINP + C_PL + 64 * g + 16 * ks + 8 * hf);
                Bw[mt][ks] = *(const bf16x8*)(pwt + (size_t)(32 * mt + r) * 64 + 16 * ks + 8 * hf); }
#pragma unroll
        for (int f = 0; f < 8; ++f) Bb[f] = band[f * 64];
#pragma unroll
        for (int mt = 0; mt < 2; ++mt)
#pragma unroll
            for (int ks = 0; ks < 4; ++ks) { PIN(Ax[mt][ks]); PIN(Bw[mt][ks]); }
#pragma unroll
        for (int f = 0; f < 8; ++f) PIN(Bb[f]);
#pragma unroll
        for (int mt = 0; mt < 2; ++mt) {
#pragma unroll
            for (int ntd = 0; ntd < 2; ++ntd) {
                f32x16 z = zero16;
#pragma unroll
                for (int ks = 0; ks < 4; ++ks) z = MFMA32(Ax[mt][ks], Bw[ntd][ks], z);
#pragma unroll
                for (int sq = 0; sq < 2; ++sq) {
                    const float t8[8] = {z[8 * sq], z[8 * sq + 1], z[8 * sq + 2], z[8 * sq + 3], z[8 * sq + 4], z[8 * sq + 5], z[8 * sq + 6], z[8 * sq + 7]};
                    bf16x8 Zh, Zl; split8(t8, Zh, Zl);
#pragma unroll
                    for (int ntt = 0; ntt < 2; ++ntt) { const bf16x8 Bq = __builtin_bit_cast(bf16x8, Bb[(mt * 2 + ntt) * 2 + sq]);
                        Y[ntd][ntt] = MFMA32(Zh, Bq, Y[ntd][ntt]); Y[ntd][ntt] = MFMA32(Zl, Bq, Y[ntd][ntt]); }
                }
            }
        }
#pragma unroll
        for (int ntt = 0; ntt < 2; ++ntt) { const int t = 32 * ntt + r; int lo = t - hw, hi = t + hw; lo = lo < 0 ? 0 : lo; hi = hi > 64 ? 64 : hi; const float inv = 1.0f / (float)(hi - lo);
#pragma unroll
            for (int ntd = 0; ntd < 2; ++ntd)
#pragma unroll
                for (int q = 0; q < 4; ++q) { const int dd0 = 32 * ntd + 8 * q + 4 * hf; const f32x4 ps = *(const f32x4*)(a.in[I_POOLS] + l * 256 + 64 * g + dd0);
                    u32x2 w; w.x = pk2c(Y[ntd][ntt][4 * q] * inv * ps[0], Y[ntd][ntt][4 * q + 1] * inv * ps[1]); w.y = pk2c(Y[ntd][ntt][4 * q + 2] * inv * ps[2], Y[ntd][ntt][4 * q + 3] * inv * ps[3]);
                    *(u32x2*)(MIX + (size_t)(row0 + t) * D + 768 + 64 * g + dd0) = w; } }
    }
}

__device__ __forceinline__ void mixer_local(const Args& a, int l, int tile, int half, LAS unsigned char* lds) {
    const int tid = tid_now();
    const bf16_t* COLS = (const bf16_t*)(a.ws + WS_COLS); bf16_t* MIX = (bf16_t*)(a.ws + WS_MIX);
    LAS float* AG = (LAS float*)lds;
    LAS float* U = AG + 7936;
    LAS float* CX = U + 8192;
    const bool lat = tile < 512; const int r0 = tile * 64 + half * 32;
    const int seq_lo = lat ? tile * 64 : (NLAT + ((tile - 512) >> 2) * CTXL), seq_hi = lat ? tile * 64 + 64 : seq_lo + CTXL;
    const float* confw = a.in[I_CONFW] + (size_t)l * 31 * 256; const float* scw = a.in[I_SCW] + (size_t)l * 3 * 256;
    const int npass = lat ? 1 : 2;
    for (int ps = 0; ps < npass; ++ps) {
        const int chb = ps * 128;
        for (int idx = tid; idx < 62 * 16; idx += 512) { const int tt = idx >> 4, c8 = (idx & 15) * 8, r = r0 - 15 + tt;
            float o[8] = {0.f, 0.f, 0.f, 0.f, 0.f, 0.f, 0.f, 0.f};
            if (r >= seq_lo && r < seq_hi) { const bf16_t* rp = COLS + (size_t)r * NINP; float fa[8], fg[8]; unpack8(*(const u32x4*)(rp + C_CA + chb + c8), fa); unpack8(*(const u32x4*)(rp + C_CG + chb + c8), fg);
#pragma unroll
                for (int i = 0; i < 8; ++i) o[i] = fa[i] * sigmoidf_(fg[i]); }
            *(LAS f32x4*)(AG + tt * 128 + c8) = (f32x4){o[0], o[1], o[2], o[3]}; *(LAS f32x4*)(AG + tt * 128 + c8 + 4) = (f32x4){o[4], o[5], o[6], o[7]}; }
        for (int idx = tid; idx < 34 * 16; idx += 512) { const int tt = idx >> 4, c8 = (idx & 15) * 8, r = r0 - 1 + tt;
            float o[8] = {0.f, 0.f, 0.f, 0.f, 0.f, 0.f, 0.f, 0.f};
            if (r >= seq_lo && r < seq_hi) { const bf16_t* rp = COLS + (size_t)r * NINP; float fc[8], fx[8]; unpack8(*(const u32x4*)(rp + C_SC + chb + c8), fc); unpack8(*(const u32x4*)(rp + C_SX + chb + c8), fx);
#pragma unroll
                for (int i = 0; i < 8; ++i) o[i] = fc[i] * fx[i]; }
            *(LAS f32x4*)(CX + tt * 128 + c8) = (f32x4){o[0], o[1], o[2], o[3]}; *(LAS f32x4*)(CX + tt * 128 + c8 + 4) = (f32x4){o[4], o[5], o[6], o[7]}; }
        __syncthreads();
        { const int c = tid & 127, t0 = (tid >> 7) * 8;
            float wv[31];
#pragma unroll
            for (int j = 0; j < 31; ++j) wv[j] = confw[j * 256 + chb + c];
            const float bias = a.in[I_CONFB][l * 256 + chb + c];
            const float w0 = scw[chb + c], w1 = scw[256 + chb + c], w2 = scw[512 + chb + c];
            float o[8];
#pragma unroll
            for (int q = 0; q < 8; ++q) o[q] = bias;
#pragma unroll
            for (int j = 0; j < 38; ++j) { const float x = AG[(t0 + j) * 128 + c];
#pragma unroll
                for (int q = 0; q < 8; ++q) { if (j - q >= 0 && j - q < 31) o[q] += x * wv[j - q]; } }
#pragma unroll
            for (int q = 0; q < 8; ++q) U[(t0 + q) * 256 + chb + c] = o[q];
#pragma unroll
            for (int q = 0; q < 8; ++q) { const int t = t0 + q; const float cv = CX[t * 128 + c] * w0 + CX[(t + 1) * 128 + c] * w1 + CX[(t + 2) * 128 + c] * w2;
                const float sb = __uint_as_float(((unsigned)COLS[(size_t)(r0 + t) * NINP + C_SB + chb + c]) << 16);
                MIX[(size_t)(r0 + t) * D + 512 + chb + c] = (bf16_t)(pk2(sb * cv, 0.f) & 0xffffu); }
        }
        __syncthreads();
    }
    if (lat) {
        const float* UV = (const float*)(a.ws + WS_UV); const float* SCV = (const float*)(a.ws + WS_SCV);
        for (int idx = tid; idx < 32 * 32; idx += 512) { const int t = idx >> 5, c4 = (idx & 31) * 4;
            const f32x4 u = *(const f32x4*)(UV + (size_t)(r0 + t) * 128 + c4), bz = *(const f32x4*)(a.in[I_CONFB] + l * 256 + 128 + c4);
            *(LAS f32x4*)(U + t * 256 + 128 + c4) = u + bz;
            const f32x4 sv = *(const f32x4*)(SCV + (size_t)(r0 + t) * 128 + c4);
            const u32x2 sbw = *(const u32x2*)(COLS + (size_t)(r0 + t) * NINP + C_SB + 128 + c4);
            u32x2 w; w.x = pk2(bflo(sbw.x) * sv[0], bfhi(sbw.x) * sv[1]); w.y = pk2(bflo(sbw.y) * sv[2], bfhi(sbw.y) * sv[3]);
            *(u32x2*)(MIX + (size_t)(r0 + t) * D + 512 + 128 + c4) = w; }
        __syncthreads();
    }
    { const int t = tid >> 4, c0 = (tid & 15) * 16;
        float s = 0.f;
#pragma unroll
        for (int i = 0; i < 16; i += 4) { const f32x4 v = *(const LAS f32x4*)(U + t * 256 + c0 + i); s += (v[0] + v[1]) + (v[2] + v[3]); }
        s += __shfl_xor(s, 1); s += __shfl_xor(s, 2); s += __shfl_xor(s, 4); s += __shfl_xor(s, 8);
        const float mean = s * (1.0f / 256.0f); float q = 0.f;
#pragma unroll
        for (int i = 0; i < 16; i += 4) { const f32x4 v = *(const LAS f32x4*)(U + t * 256 + c0 + i) - mean; q += (v[0] * v[0] + v[1] * v[1]) + (v[2] * v[2] + v[3] * v[3]); }
        q += __shfl_xor(q, 1); q += __shfl_xor(q, 2); q += __shfl_xor(q, 4); q += __shfl_xor(q, 8);
        const float rstd = rsqrtf(q * (1.0f / 256.0f) + EPS);
        const float* lg = a.in[I_CONFG] + l * 256 + c0; const float* lb = a.in[I_CONFBETA] + l * 256 + c0;
#pragma unroll
        for (int i = 0; i < 16; i += 8) { float y[8];
#pragma unroll
            for (int k = 0; k < 8; ++k) y[k] = siluf_((U[t * 256 + c0 + i + k] - mean) * rstd * lg[i + k] + lb[i + k]);
            u32x4 w; w.x = pk2(y[0], y[1]); w.y = pk2(y[2], y[3]); w.z = pk2(y[4], y[5]); w.w = pk2(y[6], y[7]);
            *(u32x4*)(MIX + (size_t)(r0 + t) * D + 256 + c0 + i) = w; }
    }
    __syncthreads();
    for (int hf = 0; hf < 2; ++hf) {
        LAS float* PI = (LAS float*)lds;
        LAS float* DF = PI + 6144;
        LAS float* PW = DF + 4224;
        for (int idx = tid; idx < 48 * 16; idx += 512) { const int tt = idx >> 4, c8 = (idx & 15) * 8, r = r0 - 8 + tt;
            float o[8] = {0.f, 0.f, 0.f, 0.f, 0.f, 0.f, 0.f, 0.f};
            if (r >= seq_lo && r < seq_hi) unpack8(*(const u32x4*)(COLS + (size_t)r * NINP + C_PL + hf * 128 + c8), o);
            *(LAS f32x4*)(PI + tt * 128 + c8) = (f32x4){o[0], o[1], o[2], o[3]}; *(LAS f32x4*)(PI + tt * 128 + c8 + 4) = (f32x4){o[4], o[5], o[6], o[7]}; }
        for (int idx = tid; idx < 2 * 64 * 64 / 4; idx += 512) *(LAS f32x4*)(PW + idx * 4) = *(const f32x4*)(a.in[I_POOLW] + (size_t)l * 4 * 4096 + (size_t)hf * 2 * 4096 + idx * 4);
        __syncthreads();
        for (int idx = tid; idx < 32 * 128; idx += 512) { const int t = idx >> 7, c = idx & 127, g = hf * 2 + (c >> 6); const int hw = 1 << g;
            const int r = r0 + t; int lo = r - hw, hi = r + hw; lo = lo < seq_lo ? seq_lo : lo; hi = hi > seq_hi ? seq_hi : hi;
            float sm = 0.f; for (int rr = lo; rr < hi; ++rr) sm += PI[(rr - r0 + 8) * 128 + c];
            DF[t * 132 + c] = sm / (float)(hi - lo) - PI[(t + 8) * 128 + c]; }
        __syncthreads();
        { const int gl = tid >> 8, tp = (tid >> 4) & 15, dq = tid & 15; const int dd0 = dq * 4;
            f32x4 o[2] = {(f32x4){0.f, 0.f, 0.f, 0.f}, (f32x4){0.f, 0.f, 0.f, 0.f}};
#pragma unroll 2
            for (int c4 = 0; c4 < 64; c4 += 4) { f32x4 dv[2];
#pragma unroll
                for (int x = 0; x < 2; ++x) dv[x] = *(const LAS f32x4*)(DF + (tp * 2 + x) * 132 + gl * 64 + c4);
#pragma unroll
                for (int q = 0; q < 4; ++q) { const f32x4 wv = *(const LAS f32x4*)(PW + (gl * 64 + c4 + q) * 64 + dd0);
#pragma unroll
                    for (int x = 0; x < 2; ++x) o[x] += dv[x][q] * wv; } }
            const int ch = (hf * 2 + gl) * 64 + dd0; const f32x4 ps = *(const f32x4*)(a.in[I_POOLS] + l * 256 + ch);
#pragma unroll
            for (int x = 0; x < 2; ++x) { u32x2 w; w.x = pk2(o[x][0] * ps[0], o[x][1] * ps[1]); w.y = pk2(o[x][2] * ps[2], o[x][3] * ps[3]);
                *(u32x2*)(MIX + (size_t)(r0 + tp * 2 + x) * D + 768 + ch) = w; } }
        __syncthreads();
    }
}

__device__ __forceinline__ void phase_mixer(const Args& a, int l, LAS unsigned char* lds) {
    const int ntile = (l == 1) ? 512 : NCHUNK;
    { const int tid = tid_now(), lane = tid & 63, wid = __builtin_amdgcn_readfirstlane(tid >> 6);
        LAS bf16_t* vT = (LAS bf16_t*)(lds + wid * 16384);
        const int gw = blockIdx.x * 8 + wid, NGW = gridDim.x * 8;
        const int n_gla = ntile * 4, n_conv = 512 * 4, n_pool = 512;
        for (int rp = 0; rp < (((REP_SUB == 1 || REP_SUB == 2 || REP_SUB == 8) && l == 0) ? 2 : 1); ++rp)
        for (int it = gw; it < n_gla + n_conv + n_pool; it += NGW) {
            if (it < n_gla) { if (rp == 0 || REP_SUB == 1) mixer_gla_item(a, l, it >> 2, it & 3, lane, vT); }
            else if (it < n_gla + n_conv) { if (rp == 0 || REP_SUB == 2) mixer_conv_item(a, l, (it - n_gla) >> 2, (it - n_gla) & 3, lane, (LAS float*)vT); }
            else { if (rp == 0 || REP_SUB == 8) mixer_pool_item(a, l, it - n_gla - n_conv, lane); } } }
    if (l == 0) {
        __syncthreads();
        for (int rp = 0; rp < (REP_SUB == 9 ? 2 : 1); ++rp)
        for (int it = blockIdx.x; it < 16 * 2; it += gridDim.x) mixer_local(a, l, 512 + (it >> 1), it & 1, lds);
    }
}

__device__ __forceinline__ void phase_router(const Args& a, int l, LAS unsigned char* lds) {
    const int tid = tid_now(), lane = tid & 63, wid = tid >> 6;
    const int M = (l == 1) ? NLAT : MTOT;
    const float* MOD = (const float*)(a.ws + WS_MOD) + (size_t)l * 5 * 6144; bf16_t* H = (bf16_t*)(a.ws + WS_H);
    LAS float* WRE = (LAS float*)lds;
    LAS int* INFO = (LAS int*)(lds + MISC_OFF + 4096);
    LAS int* HIST = (LAS int*)(lds + MISC_OFF + 2048);
    const float* wre = a.in[I_RWE] + (size_t)l * 1024 * 32; const float* wrgT = (const float*)(a.ws + WS_TAB) + (size_t)l * 4096;
    for (int i = tid; i < 1024 * 8; i += 512) { const int k = i >> 3, q = i & 7; const f32x4 w = *(const f32x4*)(wre + k * 32 + q * 4);
        WRE[(4 * q + 0) * 1024 + k] = w[0]; WRE[(4 * q + 1) * 1024 + k] = w[1]; WRE[(4 * q + 2) * 1024 + k] = w[2]; WRE[(4 * q + 3) * 1024 + k] = w[3]; }
    if (tid < 64) HIST[tid] = 0;
    __syncthreads();
    const int per = (M + gridDim.x - 1) / gridDim.x; const int r_lo = blockIdx.x * per; int r_hi = r_lo + per; if (r_hi > M) r_hi = M;
    const float rbg0 = a.in[I_RBG][l * 4 + 0], rbg1 = a.in[I_RBG][l * 4 + 1], rbg2 = a.in[I_RBG][l * 4 + 2], rbg3 = a.in[I_RBG][l * 4 + 3];
    bf16_t* XB = (bf16_t*)(a.ws + WS_XB); const bf16_t* Y1 = (const bf16_t*)(a.ws + WS_Y);
    int cur_b = -1; f32x4 GS[4], SH[4], GA[4], WGT[4][4];
#pragma unroll
    for (int g = 0; g < 4; ++g)
#pragma unroll
        for (int j = 0; j < 4; ++j) WGT[g][j] = *((const f32x4*)(wrgT + g * 1024) + lane + 64 * j);
    for (int rp = 0; rp < ((REP_SUB == 7 && l == 0) ? 2 : 1); ++rp)
#pragma unroll 1
    for (int mm = r_lo + wid; mm < r_hi; mm += 16) {
        f32x4 vv[2][4]; u32x2 yy[2][4]; int mrow[2]; bool has[2];
#pragma unroll
        for (int rr = 0; rr < 2; ++rr) { const int m = mm + 8 * rr; has[rr] = m < r_hi; const int mc = has[rr] ? m : mm; mrow[rr] = mc;
            if (l == 0) load_row(mc < NLAT ? a.in[I_X] + (size_t)mc * D : a.in[I_CTX] + (size_t)(mc - NLAT) * D, lane, vv[rr]);
            else load_row_bf(XB + (size_t)mc * D, lane, vv[rr]);
#pragma unroll
            for (int j = 0; j < 4; ++j) yy[rr][j] = *((const u32x2*)(Y1 + (size_t)mc * D) + lane + 64 * j); }
#pragma unroll
        for (int rr = 0; rr < 2; ++rr) {
            if (!has[rr]) continue;
            const int m = mrow[rr]; const int b = m < NLAT ? (m >> 13) : 4;
            if (b != cur_b) { const float* mod = MOD + (size_t)b * 6144; load_mod_cached(a.in[I_G2] + l * 1024, mod + 4 * 1024, mod + 3 * 1024, mod + 2 * 1024, lane, GS, SH, GA); cur_b = b; }
            f32x4 v[4];
#pragma unroll
            for (int j = 0; j < 4; ++j) { const u32x2 y = yy[rr][j]; v[j] = vv[rr][j] + GA[j] * (f32x4){bflo(y.x), bfhi(y.x), bflo(y.y), bfhi(y.y)}; }
            store_row_bf(XB + (size_t)m * D, lane, v);
            const float rstd = row_rstd(v);
            norm_store_cached(v, rstd, GS, SH, H + (size_t)m * D, lane);
            float ga_[4] = {0.f, 0.f, 0.f, 0.f};
#pragma unroll
            for (int g = 0; g < 4; ++g)
#pragma unroll
                for (int j = 0; j < 4; ++j) { const f32x4 w = WGT[g][j]; ga_[g] += (v[j][0] * w[0] + v[j][1] * w[1]) + (v[j][2] * w[2] + v[j][3] * w[3]); }
            float lg0, lg1, lg2, lg3;
            { const bool h5 = (lane & 32) != 0, h4 = (lane & 16) != 0;
                float k0 = h5 ? ga_[2] : ga_[0], k1 = h5 ? ga_[3] : ga_[1]; const float s0 = h5 ? ga_[0] : ga_[2], s1 = h5 ? ga_[1] : ga_[3];
                k0 += __shfl_xor(s0, 32); k1 += __shfl_xor(s1, 32);
                float kk = h4 ? k1 : k0; const float sk = h4 ? k0 : k1; kk += __shfl_xor(sk, 16);
                kk += __shfl_xor(kk, 8); kk += __shfl_xor(kk, 4); kk += __shfl_xor(kk, 2); kk += __shfl_xor(kk, 1);
                lg0 = __int_as_float(__builtin_amdgcn_readlane(__float_as_int(kk), 0)) + rbg0; lg1 = __int_as_float(__builtin_amdgcn_readlane(__float_as_int(kk), 16)) + rbg1;
                lg2 = __int_as_float(__builtin_amdgcn_readlane(__float_as_int(kk), 32)) + rbg2; lg3 = __int_as_float(__builtin_amdgcn_readlane(__float_as_int(kk), 48)) + rbg3; }
            int grp = 0; float best = lg0; if (lg1 > best) { best = lg1; grp = 1; } if (lg2 > best) { best = lg2; grp = 2; } if (lg3 > best) { best = lg3; grp = 3; }
            const float pg = 1.0f / (__expf(lg0 - best) + __expf(lg1 - best) + __expf(lg2 - best) + __expf(lg3 - best));
            grp = __builtin_amdgcn_readfirstlane(grp);
            float ep[8];
            { const LAS float* wb = WRE + (size_t)(grp * 8) * 1024;
#pragma unroll
                for (int i = 0; i < 8; i += 2) { f32x4 w[2][4];
#pragma unroll
                    for (int u = 0; u < 2; ++u)
#pragma unroll
                        for (int j = 0; j < 4; ++j) w[u][j] = *((const LAS f32x4*)(wb + (i + u) * 1024) + lane + 64 * j);
#pragma unroll
                    for (int u = 0; u < 2; ++u)
#pragma unroll
                        for (int j = 0; j < 4; ++j) PIN(w[u][j]);
#pragma unroll
                    for (int u = 0; u < 2; ++u) { float acc_ = 0.f;
#pragma unroll
                        for (int j = 0; j < 4; ++j) acc_ += (v[j][0] * w[u][j][0] + v[j][1] * w[u][j][1]) + (v[j][2] * w[u][j][2] + v[j][3] * w[u][j][3]);
                        ep[i + u] = acc_; } } }
            float le[8];
            { const bool h5 = (lane & 32) != 0, h4 = (lane & 16) != 0, h3 = (lane & 8) != 0;
                float k4[4];
#pragma unroll
                for (int i = 0; i < 4; ++i) { const float keep = h5 ? ep[4 + i] : ep[i], send = h5 ? ep[i] : ep[4 + i]; k4[i] = keep + __shfl_xor(send, 32); }
                float k2[2];
#pragma unroll
                for (int i = 0; i < 2; ++i) { const float keep = h4 ? k4[2 + i] : k4[i], send = h4 ? k4[i] : k4[2 + i]; k2[i] = keep + __shfl_xor(send, 16); }
                float kk = h3 ? k2[1] : k2[0]; const float sk = h3 ? k2[0] : k2[1]; kk += __shfl_xor(sk, 8);
                kk += __shfl_xor(kk, 4); kk += __shfl_xor(kk, 2); kk += __shfl_xor(kk, 1);
#pragma unroll
                for (int i = 0; i < 8; ++i) le[i] = __int_as_float(__builtin_amdgcn_readlane(__float_as_int(kk), 8 * i)) + a.in[I_RBE][l * 32 + grp * 8 + i]; }
            int i0 = 0; float v0 = le[0];
#pragma unroll
            for (int i = 1; i < 8; ++i) if (le[i] > v0) { v0 = le[i]; i0 = i; }
            int i1 = -1; float v1 = -3.0e38f;
#pragma unroll
            for (int i = 0; i < 8; ++i) if (i != i0 && le[i] > v1) { v1 = le[i]; i1 = i; }
            const float w0 = 1.0f / (1.0f + __expf(v1 - v0)); const float w1 = 1.0f - w0;
            if (lane == 0) { const int lr = m - r_lo; INFO[lr * 4 + 0] = grp * 8 + i0; INFO[lr * 4 + 1] = grp * 8 + i1; INFO[lr * 4 + 2] = __float_as_int(w0 * pg); INFO[lr * 4 + 3] = __float_as_int(w1 * pg); }
        }
    }
    __syncthreads();
    const int nr = r_hi - r_lo; int lp0 = 0, lp1 = 0, ee0 = 0, ee1 = 0;
    if (tid < nr) { ee0 = INFO[tid * 4 + 0]; ee1 = INFO[tid * 4 + 1]; lp0 = atomicAdd((int*)(HIST + ee0), 1); lp1 = atomicAdd((int*)(HIST + ee1), 1); }
    __syncthreads();
    unsigned* cnt = (unsigned*)(a.ws + WS_CTL) + CW_CNT + l * 32 * 64;
    if (tid < 32) { const int c = HIST[tid]; HIST[32 + tid] = c ? (int)atomicAdd(cnt + tid * 64, (unsigned)c) : 0; }
    __syncthreads();
    if (tid < nr) { const int m = r_lo + tid; const int p0 = HIST[32 + ee0] + lp0, p1 = HIST[32 + ee1] + lp1;
        int* TL = (int*)(a.ws + WS_TOKLIST); TL[ee0 * MTOT + p0] = m; TL[ee1 * MTOT + p1] = m;
        *((i32x4*)(a.ws + WS_TOKINFO) + m) = (i32x4){(ee0 << 20) | p0, (ee1 << 20) | p1, INFO[tid * 4 + 2], INFO[tid * 4 + 3]}; }
    __syncthreads();
}

__device__ __forceinline__ int moe_tables(const Args& a, int l, LAS unsigned char* lds) {
    LAS int* TB = (LAS int*)(lds + MISC_OFF + 256); LAS int* CN = TB + 64; LAS int* TE = (LAS int*)(lds + MISC_OFF + 1024); LAS int* TM = TE + 320;
    const unsigned* cnt = (const unsigned*)(a.ws + WS_CTL) + CW_CNT + l * 32 * 64;
    { const int tq_ = tid_now(); if (tq_ < 32) CN[tq_] = (int)__hip_atomic_load(cnt + tq_ * 64, __ATOMIC_RELAXED, __HIP_MEMORY_SCOPE_AGENT); }
    __syncthreads();
    if (tid_now() == 0) { int t = 0;
#pragma unroll 1
        for (int e = 0; e < 32; ++e) { TB[e] = t; const int nt = (CN[e] + 255) >> 8;
#pragma unroll 1
            for (int q = 0; q < nt; ++q) { TE[t + q] = e; TM[t + q] = q; } t += nt; } TB[32] = t; }
    __syncthreads();
    return __builtin_amdgcn_readfirstlane(TB[32]);
}

__device__ __forceinline__ void phase_combine(const Args& a, int l, LAS unsigned char* lds) {
    const int lane = tid_now() & 63, wid = tid_now() >> 6, gw = blockIdx.x * 8 + wid, NGW = gridDim.x * 8;
    const int M = (l == 1) ? NLAT : MTOT;
    (void)moe_tables(a, l, lds);
    const LAS int* TB = (const LAS int*)(lds + MISC_OFF + 256);
    const float* MOD = (const float*)(a.ws + WS_MOD); const bf16_t* Y = (const bf16_t*)(a.ws + WS_Y); bf16_t* H = (bf16_t*)(a.ws + WS_H);
    bf16_t* XB = (bf16_t*)(a.ws + WS_XB);
    int cur_b = -1; f32x4 GS[4], SH[4], GA[4];
#pragma unroll 1
    for (int mm = gw; mm < M; mm += 2 * NGW) {
        f32x4 vv[2][4]; u32x2 ya[2][4], yb[2][4]; i32x4 inf[2]; int mrow[2]; bool has[2];
#pragma unroll
        for (int rr = 0; rr < 2; ++rr) { const int m = mm + rr * NGW; has[rr] = m < M; const int mc = has[rr] ? m : mm; mrow[rr] = mc;
            inf[rr] = *((const i32x4*)(a.ws + WS_TOKINFO) + mc);
            load_row_bf(XB + (size_t)mc * D, lane, vv[rr]); }
#pragma unroll
        for (int rr = 0; rr < 2; ++rr) { const int e0 = inf[rr].x >> 20, p0 = inf[rr].x & 0xfffff, e1 = inf[rr].y >> 20, p1 = inf[rr].y & 0xfffff;
            const bf16_t* y0 = Y + (size_t)(TB[e0] * 256 + p0) * D; const bf16_t* y1 = Y + (size_t)(TB[e1] * 256 + p1) * D;
#pragma unroll
            for (int j = 0; j < 4; ++j) { ya[rr][j] = *((const u32x2*)y0 + lane + 64 * j); yb[rr][j] = *((const u32x2*)y1 + lane + 64 * j); } }
#pragma unroll
        for (int rr = 0; rr < 2; ++rr) {
            if (!has[rr]) continue;
            const int m = mrow[rr]; const int b = m < NLAT ? (m >> 13) : 4;
            const float w0 = __int_as_float(inf[rr].z), w1 = __int_as_float(inf[rr].w);
            if (b != cur_b) { const float* ga2 = MOD + (size_t)(l * 5 + b) * 6144 + 5 * 1024;
                if (l == 0) { const float* mod = MOD + (size_t)(5 + b) * 6144; load_mod_cached(a.in[I_G1] + 1024, mod + 1024, mod, ga2, lane, GS, SH, GA); }
                else {
#pragma unroll
                    for (int j = 0; j < 4; ++j) { GS[j] = *((const f32x4*)a.in[I_GFINAL] + lane + 64 * j); SH[j] = (f32x4){0.f, 0.f, 0.f, 0.f}; GA[j] = *((const f32x4*)ga2 + lane + 64 * j); } }
                cur_b = b; }
            f32x4 v[4];
#pragma unroll
            for (int j = 0; j < 4; ++j) { const u32x2 a0 = ya[rr][j], a1 = yb[rr][j];
                f32x4 y; y[0] = w0 * bflo(a0.x) + w1 * bflo(a1.x); y[1] = w0 * bfhi(a0.x) + w1 * bfhi(a1.x); y[2] = w0 * bflo(a0.y) + w1 * bflo(a1.y); y[3] = w0 * bfhi(a0.y) + w1 * bfhi(a1.y);
                v[j] = vv[rr][j] + GA[j] * y; }
            const float rstd = row_rstd(v);
            if (l == 0) {
                store_row_bf(XB + (size_t)m * D, lane, v);
                norm_store_cached(v, rstd, GS, SH, H + (size_t)m * D, lane);
            } else {
                float* xr = a.out + (size_t)m * D;
#pragma unroll
                for (int j = 0; j < 4; ++j) *((f32x4*)xr + lane + 64 * j) = (v[j] * rstd) * GS[j];
            }
        }
    }
}

#define XB_TMO      128
#define XB_XCNT(j)  (256  + 64 * (j))
#define XB_XSUB(j)  (1280 + 64 * (j))
#define XB_XGEN(j)  (2304 + 64 * (j))
#define XB_TOP      3328
#define XB_TOPGEN   3392
#define XCD_BAR_WORDS 3456
#define XB_SPIN_CAP (1u << 22)
__device__ __forceinline__ unsigned xb_ld(unsigned* p)              { return __hip_atomic_load(p, __ATOMIC_RELAXED, __HIP_MEMORY_SCOPE_AGENT); }
__device__ __forceinline__ unsigned xb_add(unsigned* p, unsigned v) { return __hip_atomic_fetch_add(p, v, __ATOMIC_RELAXED, __HIP_MEMORY_SCOPE_AGENT); }
__device__ __forceinline__ unsigned xb_xcc_id() { return (unsigned)__builtin_amdgcn_s_getreg((3 << 11) | 20) & 0xFu; }
#define XB_SPIN(cond, bar) do { unsigned _sp = 0; while (cond) { __builtin_amdgcn_s_sleep(1); \
    if ((++_sp & 255u) == 0u) { if (xb_ld(&(bar)[XB_TMO])) break; if (_sp > XB_SPIN_CAP) { atomicAdd(&(bar)[XB_TMO], 1u); break; } } } } while (0)
struct XcdBarrier { unsigned* bar; unsigned x; volatile LAS unsigned* st; };
__device__ __forceinline__ XcdBarrier xcd_barrier_post(unsigned* bar, volatile LAS unsigned* st) {
    XcdBarrier b; b.bar = bar; b.x = xb_xcc_id(); b.st = st;
    if (threadIdx.x == 0) (void)xb_add(&bar[XB_XCNT(b.x)], 1u);
    return b;
}
__device__ __forceinline__ void xcd_barrier_complete(unsigned* bar, unsigned x, unsigned& nloc, unsigned& nx) {
    const unsigned G = gridDim.x * gridDim.y * gridDim.z;
    unsigned sum, cnt, mine, sp = 0u;
    for (;;) {
        sum = 0u; cnt = 0u; mine = 0u;
#pragma unroll
        for (unsigned j = 0; j < 16; ++j) { const unsigned c = xb_ld(&bar[XB_XCNT(j)]); sum += c; cnt += (c > 0u) ? 1u : 0u; mine = (j == x) ? c : mine; }
        if (sum == G) break;
        __builtin_amdgcn_s_sleep(1);
        if ((++sp & 255u) == 0u) { if (xb_ld(&bar[XB_TMO])) break; if (sp > XB_SPIN_CAP) { atomicAdd(&bar[XB_TMO], 1u); break; } }
    }
    nloc = mine > 0u ? mine : 1u; nx = cnt > 0u ? cnt : 1u;
}
__device__ __forceinline__ void xcd_barrier(const XcdBarrier& b) {
    asm volatile("s_waitcnt vmcnt(0)" ::: "memory");
    __syncthreads();
    if (threadIdx.x == 0) {
        unsigned* bar = b.bar;
        __builtin_amdgcn_s_waitcnt(0);
        unsigned nloc = b.st[0], nx = b.st[1];
        if (nloc == 0u) { xcd_barrier_complete(bar, b.x, nloc, nx); b.st[0] = nloc; b.st[1] = nx; }
        const unsigned old = xb_add(&bar[XB_XSUB(b.x)], 1u);
        const unsigned gen = old / nloc;
        if (old + 1u == (gen + 1u) * nloc) {
            __builtin_amdgcn_fence(__ATOMIC_RELEASE, "agent");
            asm volatile("s_waitcnt vmcnt(0)" ::: "memory");
            const unsigned og = xb_add(&bar[XB_TOP], 1u);
            const unsigned tg = og / nx;
            if (og + 1u == (tg + 1u) * nx) xb_add(&bar[XB_TOPGEN], 1u);
            else XB_SPIN(xb_ld(&bar[XB_TOPGEN]) == tg, bar);
            __builtin_amdgcn_fence(__ATOMIC_ACQUIRE, "agent");
            xb_add(&bar[XB_XGEN(b.x)], 1u);
            asm volatile("s_waitcnt vmcnt(0)" ::: "memory");
        } else {
            XB_SPIN(xb_ld(&bar[XB_XGEN(b.x)]) == gen, bar);
            __builtin_amdgcn_fence(__ATOMIC_ACQUIRE, "agent");
            asm volatile("s_waitcnt vmcnt(0)" ::: "memory");
        }
    }
    __syncthreads();
}

constexpr int NPHASE = 20;
#ifndef DIAG_PH
#define DIAG_PH -1
#endif
#define PH_ON(x) (DIAG_PH < 0 || DIAG_PH == (x))
#ifndef REP_ID
#define REP_ID -1
#endif
__global__ void __launch_bounds__(512, 2) mega(Args a) {
    extern __shared__ __attribute__((aligned(16))) unsigned char lds_raw[];
    LAS unsigned char* lds = (LAS unsigned char*)lds_raw;
    unsigned char* ws = a.ws;
    volatile LAS unsigned* bst = (volatile LAS unsigned*)(lds + MISC_OFF);
    if (threadIdx.x < 2) bst[threadIdx.x] = 0u;
    __syncthreads();
    XcdBarrier xbar = xcd_barrier_post((unsigned*)(ws + WS_CTL) + CW_BAR, bst);
    for (int ph = a.ph_lo; ph < a.ph_hi; ++ph) {
      const int cls_ = ph < 2 ? ph : 2 + (ph - 2) % 9;
      const int nrep_ = (REP_ID >= 0 && cls_ == REP_ID) ? 2 : 1;
      for (int rep_ = 0; rep_ < nrep_; ++rep_) {
        if (rep_) cg::this_grid().sync();
        if (PH_ON(0) && ph == 0) phase_p0(a, lds);
        else if (PH_ON(1) && ph == 1) phase_norm1_l0(a);
        else {
            const int l = (ph - 2) / 9, sp = (ph - 2) % 9;
            if (PH_ON(2) && sp == 0) {
                g8::DenseSched S; S.init(ws + WS_H, ws + WS_WIN + (size_t)l * NINP * 1024 * 2, MTOT, NINP, 1024, gridDim.x, blockIdx.x);
                g8::EpiBf16 E{(bf16_t*)(ws + WS_COLS), NINP};
                g8::gemm_phase(lds, S, E);
            } else if (PH_ON(3) && sp == 1) phase_chunk(a, l, lds);
            else if (PH_ON(4) && sp == 2) phase_scan(a, l, lds);
            else if (PH_ON(5) && sp == 3) phase_mixer(a, l, lds);
            else if (PH_ON(6) && sp == 4) {
                g8::DenseSched S; S.init(ws + WS_MIX, ws + WS_WOUT + (size_t)l * 1024 * 1024 * 2, l == 1 ? NLAT : MTOT, 1024, 1024, gridDim.x, blockIdx.x);
                g8::EpiBf16 E{(bf16_t*)(ws + WS_Y), 1024};
                g8::gemm_phase(lds, S, E);
            } else if (PH_ON(7) && sp == 5) phase_router(a, l, lds);
            else if ((PH_ON(8) || PH_ON(9)) && (sp == 6 || sp == 7)) {
                const int T = moe_tables(a, l, lds);
                const int G = gridDim.x, bx = blockIdx.x, vcu = (G % 8 == 0) ? (bx % 8) * (G / 8) + bx / 8 : bx;
                const LAS int* TBp = (const LAS int*)(lds + MISC_OFF + 256);
                if (PH_ON(8) && sp == 6) {
                    g8::MoeSched<true> S; S.A = (const char*)(ws + WS_H); S.Bw = (const char*)(ws + WS_WEIN) + (size_t)l * 32 * 1024 * 1024 * 2; S.wstride = (size_t)1024 * 1024 * 2; S.K = 1024; S.T = T; S.G = G; S.c = vcu;
                    S.tile_e = (const LAS int*)(lds + MISC_OFF + 1024); S.tile_mt = S.tile_e + 320; S.cnt = TBp + 64; S.toklist = (const int*)(ws + WS_TOKLIST);
                    g8::EpiSwiGLU E{(bf16_t*)(ws + WS_ACT)};
                    g8::gemm_phase(lds, S, E);
                } else if (PH_ON(9) && sp == 7) {
                    g8::MoeSched<false> S; S.A = (const char*)(ws + WS_ACT); S.Bw = (const char*)(ws + WS_WEOUT) + (size_t)l * 32 * 1024 * 512 * 2; S.wstride = (size_t)1024 * 512 * 2; S.K = 512; S.T = T; S.G = G; S.c = vcu;
                    S.tile_e = (const LAS int*)(lds + MISC_OFF + 1024); S.tile_mt = S.tile_e + 320; S.cnt = TBp + 64; S.toklist = (const int*)(ws + WS_TOKLIST);
                    g8::EpiBf16 E{(bf16_t*)(ws + WS_Y), 1024};
                    g8::gemm_phase(lds, S, E);
                }
            } else if (PH_ON(10) && sp == 8) phase_combine(a, l, lds);
        }
      }
        if (ph + 1 < a.ph_hi) { if (ph == 0) cg::this_grid().sync(); else xcd_barrier(xbar); }
    }
}

extern "C" void kernel_launch(void* const* d_in, const int* in_sizes, int n_in, void* d_out, int out_size, void* d_ws, size_t ws_size, hipStream_t stream) {
    static int grid = 0;
    if (grid == 0) {
        if (n_in != 29 || out_size != NLAT * D || ws_size < WS_END) { fprintf(stderr, "kernel_launch: unexpected shapes (n_in %d out %d ws %zu)\n", n_in, out_size, ws_size); grid = -1; return; }
        int dev = 0, cus = 0, per_cu = 0;
        hipGetDevice(&dev); hipDeviceGetAttribute(&cus, hipDeviceAttributeMultiprocessorCount, dev);
        if (hipFuncSetAttribute((const void*)mega, hipFuncAttributeMaxDynamicSharedMemorySize, LDS_BYTES) != hipSuccess) { fprintf(stderr, "kernel_launch: hipFuncSetAttribute failed\n"); grid = -1; return; }
        if (hipOccupancyMaxActiveBlocksPerMultiprocessor(&per_cu, (const void*)mega, 512, LDS_BYTES) != hipSuccess || per_cu < 1) { fprintf(stderr, "kernel_launch: occupancy query says %d\n", per_cu); per_cu = 1; }
        (void)hipGetLastError();
        grid = cus;
    }
    if (grid < 0) return;
    hipMemsetAsync((char*)d_ws + WS_CTL, 0, CTL_BYTES, stream);
    Args a{};
    for (int i = 0; i < 29; ++i) a.in[i] = (const float*)d_in[i];
    a.out = (float*)d_out; a.ws = (unsigned char*)d_ws;
#if MK_MULTI
    for (int ph = 0; ph < NPHASE; ++ph) { a.ph_lo = ph; a.ph_hi = ph + 1; hipLaunchKernelGGL(mega, dim3(grid), dim3(512), LDS_BYTES, stream, a); }
#else
    a.ph_lo = 0; a.ph_hi = NPHASE;
    void* args[] = {&a};
    hipError_t e = hipLaunchCooperativeKernel((const void*)mega, dim3(grid), dim3(512), args, LDS_BYTES, stream);
    if (e != hipSuccess) fprintf(stderr, "cooperative launch failed: %s (grid %d)\n", hipGetErrorString(e), grid);
#endif
}
```

```cpp
#include <hip/hip_runtime.h>
#include <hip/hip_cooperative_groups.h>
#include <cstdio>
namespace cg = cooperative_groups;

#ifndef MK_MULTI
#define MK_MULTI 0
#endif

#ifndef REP_SUB
#define REP_SUB 0
#endif

#define LAS __attribute__((address_space(3)))
typedef unsigned short bf16_t;
typedef short bf16x8 __attribute__((ext_vector_type(8)));
typedef float f32x4 __attribute__((ext_vector_type(4)));
typedef float f32x2 __attribute__((ext_vector_type(2)));
typedef unsigned u32x4 __attribute__((ext_vector_type(4)));
typedef unsigned u32x2 __attribute__((ext_vector_type(2)));
typedef int i32x4 __attribute__((ext_vector_type(4)));

constexpr int D = 1024, NLAT = 32768, SEQ = 8192, NCTXT = 1024, CTXL = 256, MTOT = NLAT + NCTXT;
constexpr int NIN = 2336, NINP = 2560;
constexpr int NCHUNK = MTOT / 64, NSEQ = 132;
constexpr int NEXP = 32, DEXP = 512, SLOTS = 75776;
constexpr float EPS = 1e-6f;
constexpr int C_Q = 0, C_K = 128, C_V = 256, C_G = 512, C_ZF = 768, C_ZB = 784, C_CA = 800, C_CG = 1056, C_SB = 1312, C_SC = 1568, C_SX = 1824, C_PL = 2080;

constexpr size_t MiB = 1u << 20;
constexpr size_t WS_CTL = 0, CTL_BYTES = 1 * MiB;
constexpr size_t WS_MOD = 1 * MiB;
constexpr size_t WS_TAB = 1 * MiB + 512 * 1024;
constexpr size_t WS_PWT = WS_TAB + 64 * 1024;
constexpr size_t WS_BAND = WS_TAB + 192 * 1024;
constexpr size_t WS_WIN = 2 * MiB;
constexpr size_t WS_WOUT = 12 * MiB;
constexpr size_t WS_WEIN = 16 * MiB;
constexpr size_t WS_WEOUT = 144 * MiB;
constexpr size_t WS_XCTX = 208 * MiB;
constexpr size_t WS_H = 212 * MiB;
constexpr size_t WS_COLS = 278 * MiB;
constexpr size_t WS_MIX = 443 * MiB;
constexpr size_t WS_KV = 509 * MiB;
constexpr size_t WS_DEC = 542 * MiB;
constexpr size_t WS_AGV = 543 * MiB;
constexpr size_t WS_CXV = 559 * MiB;
constexpr size_t WS_UV = 575 * MiB;
constexpr size_t WS_SCV = 591 * MiB;
constexpr size_t WS_TOKINFO = 607 * MiB;
constexpr size_t WS_TOKLIST = 608 * MiB;
constexpr size_t WS_ACT = 613 * MiB;
constexpr size_t WS_Y = 687 * MiB;
constexpr size_t WS_SIN = 835 * MiB;
constexpr size_t WS_XB = 852 * MiB;
constexpr size_t WS_END = 918 * MiB;
constexpr int CW_CNT = 1024;
constexpr int CW_BAR = 8192;

constexpr int LDS_BYTES = 147456;
constexpr int MISC_OFF = 131072;

__device__ __forceinline__ unsigned pk2(float lo, float hi) { unsigned r; asm("v_cvt_pk_bf16_f32 %0, %1, %2" : "=v"(r) : "v"(lo), "v"(hi)); return r; }
__device__ __forceinline__ float bflo(unsigned w) { return __uint_as_float(w << 16); }
__device__ __forceinline__ float bfhi(unsigned w) { return __uint_as_float(w & 0xffff0000u); }
__device__ __forceinline__ void unpack8(const u32x4 w, float (&f)[8]) { f[0] = bflo(w.x); f[1] = bfhi(w.x); f[2] = bflo(w.y); f[3] = bfhi(w.y); f[4] = bflo(w.z); f[5] = bfhi(w.z); f[6] = bflo(w.w); f[7] = bfhi(w.w); }
__device__ __forceinline__ float sigmoidf_(float x) { return 1.0f / (1.0f + __expf(-x)); }
__device__ __forceinline__ float siluf_(float x) { return x / (1.0f + __expf(-x)); }
__device__ __forceinline__ float logsigf_(float x) { return fminf(x, 0.0f) - log1pf(__expf(-fabsf(x))); }
__device__ __forceinline__ float wave_sum(float v) {
#pragma unroll
    for (int o = 1; o < 64; o <<= 1) v += __shfl_xor(v, o);
    return v;
}

typedef float f32x16 __attribute__((ext_vector_type(16)));
typedef __bf16 bf16x2_t __attribute__((ext_vector_type(2)));
#define MFMA32(a, b, c) __builtin_amdgcn_mfma_f32_32x32x16_bf16((a), (b), (c), 0, 0, 0)
__device__ __forceinline__ unsigned pk2c(float lo, float hi) { const f32x2 v = {lo, hi}; return __builtin_bit_cast(unsigned, __builtin_convertvector(v, bf16x2_t)); }
__device__ __forceinline__ bf16x8 pack8f(float x0, float x1, float x2, float x3, float x4, float x5, float x6, float x7) {
    u32x4 p; p.x = pk2c(x0, x1); p.y = pk2c(x2, x3); p.z = pk2c(x4, x5); p.w = pk2c(x6, x7); return __builtin_bit_cast(bf16x8, p); }
__device__ __forceinline__ bf16x8 pack_step(const f32x16& x, int s) { return s == 0 ? pack8f(x[0], x[1], x[2], x[3], x[4], x[5], x[6], x[7]) : pack8f(x[8], x[9], x[10], x[11], x[12], x[13], x[14], x[15]); }
__device__ __forceinline__ void split8(const float (&x)[8], bf16x8& hi, bf16x8& lo) {
    u32x4 p; p.x = pk2c(x[0], x[1]); p.y = pk2c(x[2], x[3]); p.z = pk2c(x[4], x[5]); p.w = pk2c(x[6], x[7]);
    hi = __builtin_bit_cast(bf16x8, p);
    lo = pack8f(x[0] - bflo(p.x), x[1] - bfhi(p.x), x[2] - bflo(p.y), x[3] - bfhi(p.y), x[4] - bflo(p.z), x[5] - bfhi(p.z), x[6] - bflo(p.w), x[7] - bfhi(p.w)); }
__device__ __forceinline__ bf16x8 cat44(u32x2 a, u32x2 b) { u32x4 p; p.x = a.x; p.y = a.y; p.z = b.x; p.w = b.y; return __builtin_bit_cast(bf16x8, p); }
#define LDS_WAIT() asm volatile("s_waitcnt lgkmcnt(0)" ::: "memory")
#define PIN(x) asm volatile("" : "+v"(x) :: "memory")
__device__ __forceinline__ int tid_now() { int t = threadIdx.x; asm volatile("" : "+v"(t)); return t; }

namespace g8 {
constexpr int BM = 256, BK = 64, HALF = 128, HTB = HALF * BK * 2, NXCD = 8, WGM = 8;
__device__ __forceinline__ int lds_byte(int r, int c) { const int st = (r >> 4) * 2 + (c >> 5), rr = r & 15, cc = c & 31, ob = rr * 64 + cc * 2; return st * 1024 + (ob ^ (((ob >> 9) & 1) << 5)); }
__device__ __forceinline__ void stage_rc(int b, int& R, int& C) { const int st = b / 1024, sb = b % 1024, swz = sb ^ (((sb >> 9) & 1) << 5); R = (st >> 1) * 16 + swz / 64; C = (st & 1) * 32 + (swz % 64) / 2; }
__device__ __forceinline__ int perm32(int rho) { const int n = rho >> 4, i = rho & 15; return 8 * (i >> 2) + 4 * n + (i & 3); }

struct Unit { int pm, pn, e, mt; };

struct DenseSched {
    const char* A; const char* Bt; int K, nM, nN, nwg, G, c;
    __device__ __forceinline__ void init(const void* A_, const void* Bt_, int M, int N, int K_, int G_, int c_) { A = (const char*)A_; Bt = (const char*)Bt_; K = K_; nM = M / BM; nN = N / BM; nwg = nM * nN; G = G_; c = c_; }
    __device__ __forceinline__ bool next(int i, Unit& u) const {
        const long L = (long)i * G + c; if (L >= nwg) return false;
        int wgid = (int)L; { const int q = nwg / NXCD, r = nwg % NXCD, xcd = wgid % NXCD, off = wgid / NXCD; wgid = (xcd < r ? xcd * (q + 1) : r * (q + 1) + (xcd - r) * q) + off; }
        const int nig = WGM * nN, gid = wgid / nig, fm = gid * WGM, gsz = (nM - fm) < WGM ? (nM - fm) : WGM;
        u.pm = fm + ((wgid % nig) % gsz); u.pn = (wgid % nig) / gsz; u.e = 0; u.mt = 0; return true;
    }
    __device__ __forceinline__ unsigned a_off(const Unit& u, int h, int R, int C) const { return (unsigned)(((u.pm * BM + h * HALF + R) * K + C) * 2); }
    __device__ __forceinline__ const char* b_ptr(const Unit& u) const { return Bt + (size_t)u.pn * BM * K * 2; }
};
template <bool GATHER> struct MoeSched {
    const char* A; const char* Bw; size_t wstride; int K, T, G, c; const LAS int* tile_e; const LAS int* tile_mt; const LAS int* cnt; const int* toklist;
    __device__ __forceinline__ bool next(int i, Unit& u) const {
        const int L = i * G + c; if (L >= 4 * T) return false;
        u.pm = L >> 2; u.pn = L & 3; u.e = __builtin_amdgcn_readfirstlane(tile_e[u.pm]); u.mt = __builtin_amdgcn_readfirstlane(tile_mt[u.pm]); return true;
    }
    __device__ __forceinline__ unsigned a_off(const Unit& u, int h, int R, int C) const {
        if (GATHER) { const int pos = u.mt * BM + h * HALF + R; int tok = 0; if (pos < cnt[u.e]) tok = toklist[u.e * MTOT + pos]; return (unsigned)((tok * K + C) * 2); }
        return (unsigned)(((u.pm * BM + h * HALF + R) * K + C) * 2);
    }
    __device__ __forceinline__ const char* b_ptr(const Unit& u) const { return Bw + (size_t)u.e * wstride + (size_t)u.pn * BM * K * 2; }
};

struct EpiBf16 {
    static constexpr bool PERM = true;
    bf16_t* O; int ldc;
    __device__ __forceinline__ void operator()(const f32x4 (&acc)[2][2][4][2], const Unit& u, int wr, int wc, int fr, int fq) const {
        const int row0 = u.pm * BM + wr * 64 + fr, col0 = u.pn * BM + wc * 32 + 8 * fq;
#pragma unroll
        for (int ai = 0; ai < 2; ++ai)
#pragma unroll
            for (int m = 0; m < 4; ++m) { bf16_t* rowp = O + (size_t)(row0 + ai * HALF + m * 16) * ldc + col0;
#pragma unroll
                for (int bj = 0; bj < 2; ++bj) { const f32x4 v0 = acc[ai][bj][m][0], v1 = acc[ai][bj][m][1];
                    u32x4 w; w.x = pk2(v0[0], v0[1]); w.y = pk2(v0[2], v0[3]); w.z = pk2(v1[0], v1[1]); w.w = pk2(v1[2], v1[3]);
                    *(u32x4*)(rowp + bj * HALF) = w; } }
    }
};
struct EpiSwiGLU {
    static constexpr bool PERM = true;
    bf16_t* O;
    __device__ __forceinline__ void operator()(const f32x4 (&acc)[2][2][4][2], const Unit& u, int wr, int wc, int fr, int fq) const {
        const int row0 = u.pm * BM + wr * 64 + fr, col0 = u.pn * HALF + wc * 32 + 8 * fq;
#pragma unroll
        for (int ai = 0; ai < 2; ++ai)
#pragma unroll
            for (int m = 0; m < 4; ++m) { bf16_t* rowp = O + (size_t)(row0 + ai * HALF + m * 16) * DEXP + col0;
                const f32x4 g0 = acc[ai][0][m][0], g1 = acc[ai][0][m][1], u0 = acc[ai][1][m][0], u1 = acc[ai][1][m][1];
                u32x4 w; w.x = pk2(siluf_(g0[0]) * u0[0], siluf_(g0[1]) * u0[1]); w.y = pk2(siluf_(g0[2]) * u0[2], siluf_(g0[3]) * u0[3]);
                w.z = pk2(siluf_(g1[0]) * u1[0], siluf_(g1[1]) * u1[1]); w.w = pk2(siluf_(g1[2]) * u1[2], siluf_(g1[3]) * u1[3]);
                *(u32x4*)rowp = w; }
    }
};
template <class Epi, class Sched>
__device__ __forceinline__ void gemm_phase(LAS unsigned char* lds, const Sched& S, const Epi& E) {
    const int tid = tid_now(), wid = __builtin_amdgcn_readfirstlane(tid >> 6), lane = tid & 63, wr = wid >> 2, wc = wid & 3, fr = lane & 15, fq = lane >> 4;
    const int K = S.K, nt = K / BK;
    unsigned voffB[2];
#pragma unroll
    for (int i = 0; i < 2; ++i) { int R, C; stage_rc(tid * 16 + i * 8192, R, C); const int Rb = Epi::PERM ? ((R & ~31) + perm32(R & 31)) : R; voffB[i] = (unsigned)(Rb * K + C) * 2u; }
    const size_t kstep = (size_t)(BK * 2);
    const size_t hstep = (size_t)HALF * K * 2;
    const unsigned ldsw = (unsigned)wid * 1024u;
    const int aoff = lds_byte(wr * 64 + fr, fq * 8), boff = lds_byte(wc * 32 + fr, fq * 8);
#define G8_SA(b, h) (((b) * 2 + (h)) * HTB)
#define G8_SB(b, h) ((4 + (b) * 2 + (h)) * HTB)
#define G8_STAGE(bufoff, gbase, voff) do { const unsigned long long _g = (unsigned long long)(gbase); \
        const char* _gb = (const char*)(((unsigned long long)(unsigned)__builtin_amdgcn_readfirstlane((int)(unsigned)(_g >> 32)) << 32) | (unsigned long long)(unsigned)__builtin_amdgcn_readfirstlane((int)(unsigned)_g)); \
        _Pragma("unroll") for (int _i = 0; _i < 2; ++_i) \
        __builtin_amdgcn_global_load_lds((const unsigned*)(_gb + (voff)[_i]), (LAS unsigned*)(lds + (bufoff) + ldsw + _i * 8192), 16, 0, 0); } while (0)
#define G8_LDA(dst, b, h) do { _Pragma("unroll") for (int m = 0; m < 4; ++m) _Pragma("unroll") for (int k = 0; k < 2; ++k) dst[m][k] = *(const LAS bf16x8*)(lds + G8_SA(b, h) + aoff + m * 2048 + k * 1024); } while (0)
#define G8_LDB(dst, b, h) do { _Pragma("unroll") for (int n = 0; n < 2; ++n) _Pragma("unroll") for (int k = 0; k < 2; ++k) dst[n][k] = *(const LAS bf16x8*)(lds + G8_SB(b, h) + boff + n * 2048 + k * 1024); } while (0)
#define G8_MMA(ai, bj, At, Bt) do { __builtin_amdgcn_s_setprio(1); _Pragma("unroll") for (int m = 0; m < 4; ++m) _Pragma("unroll") for (int n = 0; n < 2; ++n) _Pragma("unroll") for (int k = 0; k < 2; ++k) \
        acc[ai][bj][m][n] = __builtin_amdgcn_mfma_f32_16x16x32_bf16(Bt[n][k], At[m][k], acc[ai][bj][m][n], 0, 0, 0); __builtin_amdgcn_s_setprio(0); } while (0)
#define G8_WAIT_V(n) asm volatile("s_waitcnt vmcnt(" #n ")" ::: "memory")
#define G8_WAIT_L(n) asm volatile("s_waitcnt lgkmcnt(" #n ")" ::: "memory")
#define G8_BAR __builtin_amdgcn_s_barrier()
#define G8_SCHED __builtin_amdgcn_sched_barrier(0)
    Unit cur, nxt; int ui = 0;
    if (!S.next(0, cur)) return;
    f32x4 acc[2][2][4][2];
#pragma unroll
    for (int a = 0; a < 2; ++a)
#pragma unroll
        for (int b = 0; b < 2; ++b)
#pragma unroll
            for (int m = 0; m < 4; ++m)
#pragma unroll
                for (int n = 0; n < 2; ++n) acc[a][b][m][n] = (f32x4){0.f, 0.f, 0.f, 0.f};
    bf16x8 At[4][2], B0[2][2], B1[2][2];
    unsigned vA0[2], vA1[2];
#pragma unroll
    for (int i = 0; i < 2; ++i) { int R, C; stage_rc(tid * 16 + i * 8192, R, C); vA0[i] = S.a_off(cur, 0, R, C); vA1[i] = S.a_off(cur, 1, R, C); }
    const char* const Ab = S.A;
    const char* cB = S.b_ptr(cur);
    G8_STAGE(G8_SB(0, 0), cB, voffB); G8_STAGE(G8_SA(0, 0), Ab, vA0); G8_STAGE(G8_SB(0, 1), cB + hstep, voffB); G8_STAGE(G8_SA(0, 1), Ab, vA1);
    if (wr == 1) G8_BAR;
    G8_WAIT_V(4); G8_BAR;
    G8_STAGE(G8_SB(1, 0), cB + kstep, voffB); G8_STAGE(G8_SA(1, 0), Ab + kstep, vA0); G8_STAGE(G8_SB(1, 1), cB + hstep + kstep, voffB);
    G8_WAIT_V(6); G8_BAR;
    for (;;) {
        const bool has_next = S.next(ui + 1, nxt);
        const char* nB = has_next ? S.b_ptr(nxt) : cB;
        for (int t = 0; t < nt; t += 2) {
            const bool last = (t == nt - 2);
            const char* a1 = Ab + (size_t)(t + 1) * kstep;
            const char* a2 = last ? Ab : Ab + (size_t)(t + 2) * kstep; const char* b2 = last ? nB : cB + (size_t)(t + 2) * kstep;
            const char* a3 = a2 + kstep; const char* b3 = b2 + kstep;
            G8_LDB(B0, 0, 0); G8_SCHED; G8_LDA(At, 0, 0); G8_STAGE(G8_SA(1, 1), a1, vA1);
            G8_WAIT_L(8); G8_BAR; G8_WAIT_L(0); G8_MMA(0, 0, At, B0); G8_BAR; G8_SCHED;
            if (last && has_next) {
#pragma unroll
                for (int i = 0; i < 2; ++i) { int R, C; stage_rc(tid * 16 + i * 8192, R, C); vA0[i] = S.a_off(nxt, 0, R, C); vA1[i] = S.a_off(nxt, 1, R, C); }
            }
            G8_LDB(B1, 0, 1); G8_STAGE(G8_SB(0, 0), b2, voffB);
            G8_BAR; G8_WAIT_L(0); G8_MMA(0, 1, At, B1); G8_BAR;
            G8_LDA(At, 0, 1); G8_STAGE(G8_SA(0, 0), a2, vA0);
            G8_BAR; G8_WAIT_L(0); G8_MMA(1, 0, At, B0); G8_BAR; G8_SCHED;
            G8_STAGE(G8_SB(0, 1), b2 + hstep, voffB);
            G8_WAIT_V(6); G8_BAR; G8_MMA(1, 1, At, B1); G8_BAR;
            G8_LDB(B0, 1, 0); G8_SCHED; G8_LDA(At, 1, 0); G8_STAGE(G8_SA(0, 1), a2, vA1);
            G8_WAIT_L(8); G8_BAR; G8_WAIT_L(0); G8_MMA(0, 0, At, B0); G8_BAR; G8_SCHED;
            G8_LDB(B1, 1, 1); G8_STAGE(G8_SB(1, 0), b3, voffB);
            G8_BAR; G8_WAIT_L(0); G8_MMA(0, 1, At, B1); G8_BAR;
            G8_LDA(At, 1, 1); G8_STAGE(G8_SA(1, 0), a3, vA0);
            G8_BAR; G8_WAIT_L(0); G8_MMA(1, 0, At, B0); G8_BAR; G8_SCHED;
            G8_STAGE(G8_SB(1, 1), b3 + hstep, voffB);
            G8_WAIT_V(6); G8_BAR; G8_MMA(1, 1, At, B1); G8_BAR;
        }
        E(acc, cur, wr, wc, fr, fq);
        if (!has_next) break;
#pragma unroll
        for (int a = 0; a < 2; ++a)
#pragma unroll
            for (int b = 0; b < 2; ++b)
#pragma unroll
                for (int m = 0; m < 4; ++m)
#pragma unroll
                    for (int n = 0; n < 2; ++n) acc[a][b][m][n] = (f32x4){0.f, 0.f, 0.f, 0.f};
        cur = nxt; cB = nB; ++ui;
    }
    G8_WAIT_V(0);
    if (wr == 0) G8_BAR;
    G8_BAR;
#undef G8_SA
#undef G8_SB
#undef G8_STAGE
#undef G8_LDA
#undef G8_LDB
#undef G8_MMA
#undef G8_WAIT_V
#undef G8_WAIT_L
#undef G8_BAR
#undef G8_SCHED
}
}

struct Args { const float* in[29]; float* out; unsigned char* ws; int ph_lo, ph_hi; };
enum { I_X = 0, I_C, I_CTX, I_CCTX, I_WMOD, I_BMOD, I_G1, I_G2, I_WIN, I_GWF, I_GBF, I_GWB, I_GBB, I_GOUT, I_CONFW, I_CONFB, I_CONFG, I_CONFBETA, I_SCW, I_POOLW, I_POOLS, I_WOUT, I_RWG, I_RBG, I_RWE, I_RBE, I_EIN, I_EOUT, I_GFINAL };

__device__ __forceinline__ void transpose_item(const float* W, int K, int N, bf16_t* WT, int kb, int n0, int dst_row0, LAS float* scr, int lane) {
    const int k0 = 64 * kb;
    float wv[32];
#pragma unroll
    for (int i = 0; i < 32; ++i) { const int kk = 2 * i + (lane >> 5); wv[i] = W[(size_t)(k0 + kk) * N + n0 + (lane & 31)]; }
#pragma unroll
    for (int i = 0; i < 32; ++i) PIN(wv[i]);
#pragma unroll
    for (int i = 0; i < 32; ++i) { const int kk = 2 * i + (lane >> 5); scr[kk * 33 + (lane & 31)] = wv[i]; }
    LDS_WAIT(); asm volatile("" ::: "memory");
    const int c = lane & 7;
#pragma unroll
    for (int j = 0; j < 4; ++j) { const int n = (lane >> 3) + 8 * j; const LAS float* s = scr + (8 * c) * 33 + n;
        u32x4 o; o.x = pk2(s[0 * 33], s[1 * 33]); o.y = pk2(s[2 * 33], s[3 * 33]); o.z = pk2(s[4 * 33], s[5 * 33]); o.w = pk2(s[6 * 33], s[7 * 33]);
        *(u32x4*)(WT + (size_t)(dst_row0 + n) * K + k0 + 8 * c) = o; }
    LDS_WAIT(); asm volatile("" ::: "memory");
}

__device__ __forceinline__ void phase_p0(const Args& a, LAS unsigned char* lds) {
    const int tid = tid_now(), lane = tid & 63, wid = __builtin_amdgcn_readfirstlane(tid >> 6);
    unsigned char* ws = a.ws;
    for (int job = blockIdx.x; job < 192; job += gridDim.x) {
        const int l = job / 96, n0 = (job % 96) * 64;
        LAS float* sv = (LAS float*)lds;
        LAS float* red = (LAS float*)(lds + 5 * 1024 * 4);
        for (int i = tid; i < 5 * 1024; i += 512) { const int r = i >> 10, k = i & 1023; const float v = r < 4 ? a.in[I_C][r * 1024 + k] : a.in[I_CCTX][k]; sv[i] = siluf_(v); }
        __syncthreads();
        const int ks = tid >> 6, col = tid & 63;
        const float* w = a.in[I_WMOD] + (size_t)l * 1024 * 6144 + (size_t)(ks * 128) * 6144 + n0 + col;
        float acc[5] = {0.f, 0.f, 0.f, 0.f, 0.f};
#pragma unroll 8
        for (int k = 0; k < 128; ++k) { const float wv = w[(size_t)k * 6144];
#pragma unroll
            for (int r = 0; r < 5; ++r) acc[r] += sv[r * 1024 + ks * 128 + k] * wv; }
#pragma unroll
        for (int r = 0; r < 5; ++r) red[(ks * 5 + r) * 64 + col] = acc[r];
        __syncthreads();
        if (tid < 320) { const int r = tid >> 6; float s = 0.f;
#pragma unroll
            for (int q = 0; q < 8; ++q) s += red[(q * 5 + r) * 64 + col];
            ((float*)(ws + WS_MOD))[(size_t)(l * 5 + r) * 6144 + n0 + col] = s + a.in[I_BMOD][l * 6144 + n0 + col]; }
        __syncthreads();
    }
    LAS float* scr = (LAS float*)(lds + wid * 16384);
    const int gw = blockIdx.x * 8 + wid, NGW = gridDim.x * 8;
    constexpr int I_IN = 16 * 73, I_OUT = 16 * 32, I_EI = 16 * 32, I_EO = 8 * 32;
    constexpr int N_IN = 2 * I_IN, N_OUT = 2 * I_OUT, N_EI = 64 * I_EI, N_EO = 64 * I_EO, NITEMS = N_IN + N_OUT + N_EI + N_EO;
    for (int it = gw; it < NITEMS; it += NGW) {
        int r = it;
        if (r < N_IN) { const int l = r / I_IN, q = r % I_IN, kb = q / 73, nb = q % 73;
            transpose_item(a.in[I_WIN] + (size_t)l * 1024 * NIN, 1024, NIN, (bf16_t*)(ws + WS_WIN) + (size_t)l * NINP * 1024, kb, nb * 32, nb * 32, scr, lane); continue; }
        r -= N_IN;
        if (r < N_OUT) { const int l = r / I_OUT, q = r % I_OUT, kb = q / 32, nb = q % 32;
            transpose_item(a.in[I_WOUT] + (size_t)l * 1024 * 1024, 1024, 1024, (bf16_t*)(ws + WS_WOUT) + (size_t)l * 1024 * 1024, kb, nb * 32, nb * 32, scr, lane); continue; }
        r -= N_OUT;
        if (r < N_EI) { const int le = r / I_EI, q = r % I_EI, kb = q / 32, nb = q % 32, n0 = nb * 32;
            const int dst = n0 < 512 ? (256 * (n0 >> 7) + (n0 & 127)) : (256 * ((n0 - 512) >> 7) + 128 + ((n0 - 512) & 127));
            transpose_item(a.in[I_EIN] + (size_t)le * 1024 * 1024, 1024, 1024, (bf16_t*)(ws + WS_WEIN) + (size_t)le * 1024 * 1024, kb, n0, dst, scr, lane); continue; }
        r -= N_EI;
        { const int le = r / I_EO, q = r % I_EO, kb = q / 32, nb = q % 32;
            transpose_item(a.in[I_EOUT] + (size_t)le * 512 * 1024, 512, 1024, (bf16_t*)(ws + WS_WEOUT) + (size_t)le * 1024 * 512, kb, nb * 32, nb * 32, scr, lane); }
    }
    for (int i = blockIdx.x * 512 + tid; i < 2 * 4096; i += gridDim.x * 512) { const int l = i >> 12, g = (i >> 10) & 3, k = i & 1023; ((float*)(ws + WS_TAB))[i] = a.in[I_RWG][l * 4096 + k * 4 + g]; }
    for (int i = blockIdx.x * 512 + tid; i < 2 * 4 * 64 * 64; i += gridDim.x * 512) { const int lg = i >> 12, dd = (i >> 6) & 63, c = i & 63;
        ((bf16_t*)(ws + WS_PWT))[i] = (bf16_t)(pk2(a.in[I_POOLW][(size_t)lg * 4096 + c * 64 + dd], 0.f) & 0xffffu); }
    for (int i = blockIdx.x * 512 + tid; i < 4 * 8 * 64; i += gridDim.x * 512) { const int wi = i >> 9, f = (i >> 6) & 7, ln = i & 63, mt = f >> 2, nt = (f >> 1) & 1, sq = f & 1, rr = ln & 31, hh = ln >> 5, hw = 1 << wi;
        const int t = 32 * nt + rr; int lo = t - hw, hi = t + hw; lo = lo < 0 ? 0 : lo; hi = hi > 64 ? 64 : hi; const int cnt = hi - lo;
        unsigned w4[4];
#pragma unroll
        for (int jp = 0; jp < 4; ++jp) { unsigned wd = 0u;
#pragma unroll
            for (int e = 0; e < 2; ++e) { const int j = 2 * jp + e, tp = 32 * mt + 16 * sq + 8 * (j >> 2) + 4 * hh + (j & 3);
                const int val = ((tp >= lo && tp < hi) ? 1 : 0) - (tp == t ? cnt : 0);
                wd |= (__float_as_uint((float)val) >> 16) << (16 * e); }
            w4[jp] = wd; }
        ((u32x4*)(ws + WS_BAND))[i] = (u32x4){w4[0], w4[1], w4[2], w4[3]}; }
    for (int i = blockIdx.x * 512 + tid; i < 2 * 224 * 1024 / 8; i += gridDim.x * 512) { const int l = i / (224 * 128), q = i % (224 * 128);
        *(u32x4*)((bf16_t*)(ws + WS_WIN) + (size_t)l * NINP * 1024 + (size_t)NIN * 1024 + (size_t)q * 8) = (u32x4){0u, 0u, 0u, 0u}; }
}

__device__ __forceinline__ void load_row(const float* xrow, int lane, f32x4 (&v)[4]) {
    const f32x4* xr = (const f32x4*)xrow + lane;
#pragma unroll
    for (int j = 0; j < 4; ++j) v[j] = xr[64 * j];
}
__device__ __forceinline__ void load_row_bf(const bf16_t* xrow, int lane, f32x4 (&v)[4]) {
#pragma unroll
    for (int j = 0; j < 4; ++j) { const u32x2 w = *((const u32x2*)xrow + lane + 64 * j); v[j] = (f32x4){bflo(w.x), bfhi(w.x), bflo(w.y), bfhi(w.y)}; }
}
__device__ __forceinline__ void store_row_bf(bf16_t* xrow, int lane, const f32x4 (&v)[4]) {
#pragma unroll
    for (int j = 0; j < 4; ++j) { u32x2 w; w.x = pk2(v[j].x, v[j].y); w.y = pk2(v[j].z, v[j].w); *((u32x2*)xrow + lane + 64 * j) = w; }
}
__device__ __forceinline__ float row_rstd(const f32x4 (&v)[4]) {
    float s = 0.f;
#pragma unroll
    for (int j = 0; j < 4; ++j) s += (v[j].x * v[j].x + v[j].y * v[j].y) + (v[j].z * v[j].z + v[j].w * v[j].w);
    return rsqrtf(wave_sum(s) * (1.0f / D) + EPS);
}
__device__ __forceinline__ void norm_mod_store(f32x4 (&v)[4], float rstd, const float* g, const float* sc, const float* sh, bf16_t* hrow, int lane) {
#pragma unroll
    for (int j = 0; j < 4; ++j) { const f32x4 gv = *((const f32x4*)g + lane + 64 * j), scv = *((const f32x4*)sc + lane + 64 * j), shv = *((const f32x4*)sh + lane + 64 * j);
        v[j] = (v[j] * rstd * gv) * (1.0f + scv) + shv;
        u32x2 w; w.x = pk2(v[j].x, v[j].y); w.y = pk2(v[j].z, v[j].w);
        *((u32x2*)hrow + lane + 64 * j) = w; }
}

__device__ __forceinline__ void norm_store_cached(f32x4 (&v)[4], float rstd, const f32x4 (&GS)[4], const f32x4 (&SH)[4], bf16_t* hrow, int lane) {
#pragma unroll
    for (int j = 0; j < 4; ++j) { v[j] = (v[j] * rstd) * GS[j] + SH[j];
        u32x2 w; w.x = pk2(v[j].x, v[j].y); w.y = pk2(v[j].z, v[j].w);
        *((u32x2*)hrow + lane + 64 * j) = w; }
}
__device__ __forceinline__ void load_mod_cached(const float* g, const float* sc, const float* sh, const float* ga, int lane, f32x4 (&GS)[4], f32x4 (&SH)[4], f32x4 (&GA)[4]) {
#pragma unroll
    for (int j = 0; j < 4; ++j) { const f32x4 gv = *((const f32x4*)g + lane + 64 * j), scv = *((const f32x4*)sc + lane + 64 * j);
        GS[j] = gv * (1.0f + scv); SH[j] = *((const f32x4*)sh + lane + 64 * j); GA[j] = *((const f32x4*)ga + lane + 64 * j); }
}

__device__ __forceinline__ void phase_norm1_l0(const Args& a) {
    const int lane = tid_now() & 63, wid = tid_now() >> 6, gw = blockIdx.x * 8 + wid, NGW = gridDim.x * 8;
    const float* MOD = (const float*)(a.ws + WS_MOD); bf16_t* H = (bf16_t*)(a.ws + WS_H);
    int cur_b = -1; f32x4 GS[4], SH[4], GA[4];
#pragma unroll 1
    for (int m = gw; m < MTOT; m += 2 * NGW) {
        const int m2 = m + NGW; const bool has2 = m2 < MTOT; const int m2c = has2 ? m2 : m;
        const float* src = m < NLAT ? a.in[I_X] + (size_t)m * D : a.in[I_CTX] + (size_t)(m - NLAT) * D;
        const float* src2 = m2c < NLAT ? a.in[I_X] + (size_t)m2c * D : a.in[I_CTX] + (size_t)(m2c - NLAT) * D;
        const int b = m < NLAT ? (m >> 13) : 4, b2 = m2c < NLAT ? (m2c >> 13) : 4;
        f32x4 v[4], v2[4]; load_row(src, lane, v); load_row(src2, lane, v2);
        const float rstd = row_rstd(v), rstd2 = row_rstd(v2);
        if (b != cur_b) { const float* mod = MOD + (size_t)b * 6144; load_mod_cached(a.in[I_G1], mod + 1024, mod, mod, lane, GS, SH, GA); cur_b = b; }
        norm_store_cached(v, rstd, GS, SH, H + (size_t)m * D, lane);
        if (has2) { if (b2 != cur_b) { const float* mod = MOD + (size_t)b2 * 6144; load_mod_cached(a.in[I_G1], mod + 1024, mod, mod, lane, GS, SH, GA); cur_b = b2; }
            norm_store_cached(v2, rstd2, GS, SH, H + (size_t)m2 * D, lane); }
    }
}

struct ChunkPos { int b, sf, sb; };
__device__ __forceinline__ ChunkPos chunk_pos(int chunk) {
    ChunkPos p;
    if (chunk < 512) { p.b = chunk >> 7; const int n = chunk & 127; p.sf = 4 + n; p.sb = 4 + 127 - n; }
    else { const int cc = chunk - 512; p.b = cc >> 2; const int n = cc & 3; p.sf = n; p.sb = 3 - n; }
    return p;
}

constexpr int VS = 72;
__device__ __forceinline__ void gla_prep_dir(int dir, int lane, const float (&w)[8], float bias, const bf16x8 (&Az)[2], f32x16 (&BT)[2]) {
    asm volatile("" : "+v"(lane));
    const int r = lane & 31, hf = lane >> 5;
    const f32x16 zero16 = {0.f, 0.f, 0.f, 0.f, 0.f, 0.f, 0.f, 0.f, 0.f, 0.f, 0.f, 0.f, 0.f, 0.f, 0.f, 0.f};
    u32x4 mk[2];
#pragma unroll
    for (int s = 0; s < 2; ++s) { unsigned w4[4];
#pragma unroll
        for (int jp = 0; jp < 4; ++jp) { const int j0 = 2 * jp, j1 = 2 * jp + 1;
            const int t0 = 16 * s + 8 * (j0 >> 2) + 4 * hf + (j0 & 3), t1 = 16 * s + 8 * (j1 >> 2) + 4 * hf + (j1 & 3);
            const bool c0 = dir ? (t0 >= r) : (t0 <= r), c1 = dir ? (t1 >= r) : (t1 <= r);
            w4[jp] = (c0 ? 0x3F80u : 0u) | (c1 ? 0x3F800000u : 0u); }
        mk[s].x = w4[0]; mk[s].y = w4[1]; mk[s].z = w4[2]; mk[s].w = w4[3]; }
    bf16x8 Bhi, Blo; split8(w, Bhi, Blo);
    BT[0] = zero16; BT[1] = zero16;
#pragma unroll 1
    for (int mt = 0; mt < 2; ++mt) {
        const bf16x8 A = mt ? Az[1] : Az[0];
        f32x16 x = MFMA32(A, Bhi, zero16); x = MFMA32(A, Blo, x);
        float la[16];
#pragma unroll
        for (int i = 0; i < 16; ++i) { const float v = x[i] + bias; la[i] = (fminf(v, 0.f) - __logf(1.0f + __expf(-fabsf(v)))) * (1.0f / 16.0f); }
#pragma unroll
        for (int s = 0; s < 2; ++s) {
            const float t8[8] = {la[8 * s], la[8 * s + 1], la[8 * s + 2], la[8 * s + 3], la[8 * s + 4], la[8 * s + 5], la[8 * s + 6], la[8 * s + 7]};
            bf16x8 Lh, Ll; split8(t8, Lh, Ll);
#pragma unroll
            for (int nt = 0; nt < 2; ++nt) {
                const bool full = dir ? (mt > nt) : (mt < nt);
                u32x4 bm; const unsigned fv = full ? 0x3F803F80u : 0u;
                bm.x = (mt == nt) ? mk[s].x : fv; bm.y = (mt == nt) ? mk[s].y : fv; bm.z = (mt == nt) ? mk[s].z : fv; bm.w = (mt == nt) ? mk[s].w : fv;
                const bf16x8 Bm = __builtin_bit_cast(bf16x8, bm);
                BT[nt] = MFMA32(Lh, Bm, BT[nt]); BT[nt] = MFMA32(Ll, Bm, BT[nt]); }
        }
    }
}
__device__ __forceinline__ void gla_gate_loads(const Args& a, int l, int h, int dir, const bf16_t* cols0, int lane, float (&w)[8], float& bias, bf16x8 (&Az)[2]) {
    const int r = lane & 31, hf = lane >> 5;
    const float* wp = a.in[dir ? I_GWB : I_GWF] + (size_t)(l * 16 + 8 * hf) * 128 + 32 * h + r;
#pragma unroll
    for (int j = 0; j < 8; ++j) w[j] = wp[j * 128];
    bias = a.in[dir ? I_GBB : I_GBF][l * 128 + 32 * h + r];
#pragma unroll
    for (int mt = 0; mt < 2; ++mt) Az[mt] = *(const bf16x8*)(cols0 + (size_t)(32 * mt + r) * NINP + C_ZF + 16 * dir + 8 * hf);
}
__device__ __forceinline__ void stage_vT(const bf16_t* cols0, int h, int lane, LAS bf16_t* vT) {
    u32x4 w[8];
#pragma unroll
    for (int q = 0; q < 8; ++q) { const int chunk = lane + 64 * q, t = chunk >> 3, cg = chunk & 7; w[q] = *(const u32x4*)(cols0 + (size_t)t * NINP + C_V + 64 * h + 8 * cg); }
#pragma unroll
    for (int q = 0; q < 8; ++q) PIN(w[q]);
#pragma unroll
    for (int q = 0; q < 8; ++q) { const int chunk = lane + 64 * q, t = chunk >> 3, cg = chunk & 7;
        LAS bf16_t* p = vT + (8 * cg) * VS + t;
        p[0 * VS] = (bf16_t)(w[q].x & 0xffffu); p[1 * VS] = (bf16_t)(w[q].x >> 16); p[2 * VS] = (bf16_t)(w[q].y & 0xffffu); p[3 * VS] = (bf16_t)(w[q].y >> 16);
        p[4 * VS] = (bf16_t)(w[q].z & 0xffffu); p[5 * VS] = (bf16_t)(w[q].z >> 16); p[6 * VS] = (bf16_t)(w[q].w & 0xffffu); p[7 * VS] = (bf16_t)(w[q].w >> 16); }
}
__device__ __forceinline__ void chunk_gla_item(const Args& a, int l, int tile, int h, int lane, LAS bf16_t* vT, LAS bf16_t* kdT) {
    const int r = lane & 31, hf = lane >> 5;
    const bf16_t* cols0 = (const bf16_t*)(a.ws + WS_COLS) + (size_t)tile * 64 * NINP;
    float* KV = (float*)(a.ws + WS_KV); float* DEC = (float*)(a.ws + WS_DEC);
    const ChunkPos cp = chunk_pos(tile);
    const f32x16 zero16 = {0.f, 0.f, 0.f, 0.f, 0.f, 0.f, 0.f, 0.f, 0.f, 0.f, 0.f, 0.f, 0.f, 0.f, 0.f, 0.f};
    stage_vT(cols0, h, lane, vT);
#pragma unroll 1
    for (int dir = 0; dir < 2; ++dir) {
        float gw8[8], gbias; bf16x8 Az[2]; u32x2 kraw[2][4];
        gla_gate_loads(a, l, h, dir, cols0, lane, gw8, gbias, Az);
#pragma unroll
        for (int nt = 0; nt < 2; ++nt)
#pragma unroll
            for (int g = 0; g < 4; ++g) kraw[nt][g] = *(const u32x2*)(cols0 + (size_t)(32 * nt + r) * NINP + C_K + 32 * h + 4 * hf + 8 * g);
#pragma unroll
        for (int j = 0; j < 8; ++j) PIN(gw8[j]);
        PIN(gbias); PIN(Az[0]); PIN(Az[1]);
#pragma unroll
        for (int nt = 0; nt < 2; ++nt)
#pragma unroll
            for (int g = 0; g < 4; ++g) PIN(kraw[nt][g]);
        f32x16 BT[2]; gla_prep_dir(dir, lane, gw8, gbias, Az, BT);
        const size_t e = (size_t)((dir * 4 + cp.b) * 4 + h) * NSEQ + (dir ? cp.sb : cp.sf);
        const int srcl = (dir ? 0 : 31) + 32 * hf;
        float tot[16];
#pragma unroll
        for (int i = 0; i < 16; ++i) tot[i] = __shfl(dir ? BT[0][i] : BT[1][i], srcl);
        if (r == (dir ? 0 : 31)) {
#pragma unroll
            for (int i = 0; i < 16; ++i) DEC[e * 32 + (i & 3) + 8 * (i >> 2) + 4 * hf] = __expf(tot[i]);
        }
#pragma unroll
        for (int nt = 0; nt < 2; ++nt) {
#pragma unroll
            for (int g = 0; g < 4; ++g) { const u32x2 kw = kraw[nt][g];
                const float kf[4] = {bflo(kw.x), bfhi(kw.x), bflo(kw.y), bfhi(kw.y)};
#pragma unroll
                for (int q = 0; q < 4; ++q) { const int i = 4 * g + q; const float kd = kf[q] * __expf(tot[i] - BT[nt][i]);
                    kdT[(8 * g + 4 * hf + q) * VS + 32 * nt + r] = (bf16_t)(pk2c(kd, 0.f) & 0xffffu); } }
        }
        LDS_WAIT(); asm volatile("" ::: "memory");
#pragma unroll 1
        for (int ct = 0; ct < 2; ++ct) {
            f32x16 acc = zero16;
#pragma unroll
            for (int ks = 0; ks < 4; ++ks) {
                const bf16x8 A = *(const LAS bf16x8*)(vT + (32 * ct + r) * VS + 16 * ks + 8 * hf);
                const bf16x8 B = *(const LAS bf16x8*)(kdT + r * VS + 16 * ks + 8 * hf);
                acc = MFMA32(A, B, acc); }
            float* dst = KV + e * 2048 + (size_t)(32 * ct + 4 * hf) * 32 + r;
#pragma unroll
            for (int i = 0; i < 16; ++i) dst[((i & 3) + 8 * (i >> 2)) * 32] = acc[i];
        }
        LDS_WAIT(); asm volatile("" ::: "memory");
    }
}
__device__ __forceinline__ void chunk_agv_item(const Args& a, int row0, int lane) {
    const bf16_t* COLS = (const bf16_t*)(a.ws + WS_COLS); float* AGV = (float*)(a.ws + WS_AGV); float* CXV = (float*)(a.ws + WS_CXV);
    const int t = lane >> 3;
#pragma unroll
    for (int rep = 0; rep < 2; ++rep) { const int c8 = ((lane & 7) + 8 * rep) * 8; const bf16_t* rp = COLS + (size_t)(row0 + t) * NINP;
        float fa[8], fg[8], fc[8], fx[8];
        unpack8(*(const u32x4*)(rp + C_CA + 128 + c8), fa); unpack8(*(const u32x4*)(rp + C_CG + 128 + c8), fg);
        unpack8(*(const u32x4*)(rp + C_SC + 128 + c8), fc); unpack8(*(const u32x4*)(rp + C_SX + 128 + c8), fx);
        f32x4 o0, o1, p0, p1;
#pragma unroll
        for (int i = 0; i < 4; ++i) { o0[i] = fa[i] * sigmoidf_(fg[i]); o1[i] = fa[4 + i] * sigmoidf_(fg[4 + i]); p0[i] = fc[i] * fx[i]; p1[i] = fc[4 + i] * fx[4 + i]; }
        float* ao = AGV + (size_t)(row0 + t) * 128 + c8; float* co = CXV + (size_t)(row0 + t) * 128 + c8;
        *(f32x4*)ao = o0; *(f32x4*)(ao + 4) = o1; *(f32x4*)co = p0; *(f32x4*)(co + 4) = p1; }
}
__device__ __forceinline__ int next_item(LAS int* ctr, int lane) {
    int j = 0; if (lane == 0) j = __hip_atomic_fetch_add(ctr, 1, __ATOMIC_RELAXED, __HIP_MEMORY_SCOPE_WORKGROUP);
    return __builtin_amdgcn_readfirstlane(j);
}
__device__ __forceinline__ void phase_chunk(const Args& a, int l, LAS unsigned char* lds) {
    const int tid = tid_now(), lane = tid & 63, wid = __builtin_amdgcn_readfirstlane(tid >> 6);
    LAS bf16_t* vT = (LAS bf16_t*)(lds + wid * 16384); LAS bf16_t* kdT = vT + 64 * VS;
    LAS int* ctr = (LAS int*)(lds + MISC_OFF + 16);
    if (tid == 0) *ctr = 0;
    __syncthreads();
    constexpr int N_GLA = NCHUNK * 4, N_AGV = 512 * 8;
    for (;;) { const int it = blockIdx.x + gridDim.x * next_item(ctr, lane); if (it >= N_GLA + N_AGV) break;
        if (it < N_GLA) chunk_gla_item(a, l, it >> 2, it & 3, lane, vT, kdT);
        else chunk_agv_item(a, (it - N_GLA) * 8, lane);
    }
}
__device__ __forceinline__ void mixer_gla_item(const Args& a, int l, int tile, int h, int lane, LAS bf16_t* vT) {
    const bf16_t* cols0 = (const bf16_t*)(a.ws + WS_COLS) + (size_t)tile * 64 * NINP;
    const bf16_t* SIN = (const bf16_t*)(a.ws + WS_SIN); bf16_t* MIX = (bf16_t*)(a.ws + WS_MIX);
    const ChunkPos cp = chunk_pos(tile);
    const f32x16 zero16 = {0.f, 0.f, 0.f, 0.f, 0.f, 0.f, 0.f, 0.f, 0.f, 0.f, 0.f, 0.f, 0.f, 0.f, 0.f, 0.f};
    stage_vT(cols0, h, lane, vT);
    LDS_WAIT(); asm volatile("" ::: "memory");
    f32x16 OT[2][2] = {{zero16, zero16}, {zero16, zero16}};
#pragma unroll 1
    for (int dir = 0; dir < 2; ++dir) {
        int ln = lane; asm volatile("" : "+v"(ln)); const int r = ln & 31, hf = ln >> 5;
        bf16x8 QD[2][2], KI[2][2];
        const bf16_t* st = SIN + ((size_t)((dir * 4 + cp.b) * 4 + h) * NSEQ + (dir ? cp.sb : cp.sf)) * 2048;
        u32x2 sraw[2][2][2];
        { float gw8[8], gbias; bf16x8 Az[2]; u32x2 qraw[2][4], kraw[2][4];
            gla_gate_loads(a, l, h, dir, cols0, ln, gw8, gbias, Az);
#pragma unroll
            for (int nt = 0; nt < 2; ++nt)
#pragma unroll
                for (int g = 0; g < 4; ++g) { const bf16_t* qp = cols0 + (size_t)(32 * nt + r) * NINP + C_Q + 32 * h + 4 * hf + 8 * g; qraw[nt][g] = *(const u32x2*)qp; kraw[nt][g] = *(const u32x2*)(qp + (C_K - C_Q)); }
#pragma unroll
            for (int ct = 0; ct < 2; ++ct)
#pragma unroll
                for (int s = 0; s < 2; ++s) { const size_t off = (size_t)(32 * ct + r) * 32 + 16 * s + 4 * hf; sraw[ct][s][0] = *(const u32x2*)(st + off); sraw[ct][s][1] = *(const u32x2*)(st + off + 8); }
#pragma unroll
            for (int j = 0; j < 8; ++j) PIN(gw8[j]);
            PIN(gbias); PIN(Az[0]); PIN(Az[1]);
#pragma unroll
            for (int nt = 0; nt < 2; ++nt)
#pragma unroll
                for (int g = 0; g < 4; ++g) { PIN(qraw[nt][g]); PIN(kraw[nt][g]); }
#pragma unroll
            for (int ct = 0; ct < 2; ++ct)
#pragma unroll
                for (int s = 0; s < 2; ++s) { PIN(sraw[ct][s][0]); PIN(sraw[ct][s][1]); }
            f32x16 BT[2]; gla_prep_dir(dir, ln, gw8, gbias, Az, BT);
#pragma unroll
            for (int nt = 0; nt < 2; ++nt) {
                float qd[16], ki[16];
#pragma unroll
                for (int g = 0; g < 4; ++g) { const u32x2 qw = qraw[nt][g], kw = kraw[nt][g];
                    const float qf[4] = {bflo(qw.x), bfhi(qw.x), bflo(qw.y), bfhi(qw.y)}, kf[4] = {bflo(kw.x), bfhi(kw.x), bflo(kw.y), bfhi(kw.y)};
#pragma unroll
                    for (int q = 0; q < 4; ++q) { const float bb = BT[nt][4 * g + q]; qd[4 * g + q] = qf[q] * 0.17677669529663687f * __expf(bb); ki[4 * g + q] = kf[q] * __expf(-bb); } }
#pragma unroll
                for (int s = 0; s < 2; ++s) { QD[nt][s] = pack8f(qd[8 * s], qd[8 * s + 1], qd[8 * s + 2], qd[8 * s + 3], qd[8 * s + 4], qd[8 * s + 5], qd[8 * s + 6], qd[8 * s + 7]);
                    KI[nt][s] = pack8f(ki[8 * s], ki[8 * s + 1], ki[8 * s + 2], ki[8 * s + 3], ki[8 * s + 4], ki[8 * s + 5], ki[8 * s + 6], ki[8 * s + 7]); }
            }
        }
#pragma unroll
        for (int jt = 0; jt < 2; ++jt)
#pragma unroll
            for (int it = 0; it < 2; ++it) {
                if (jt != it) { const bool keep = dir ? (jt > it) : (jt < it); if (!keep) continue; }
                f32x16 p = MFMA32(KI[jt][0], QD[it][0], zero16); p = MFMA32(KI[jt][1], QD[it][1], p);
                if (jt == it) {
#pragma unroll
                    for (int i = 0; i < 16; ++i) { const int jj = (i & 3) + 8 * (i >> 2) + 4 * hf; const bool kp_ = dir ? (jj >= r) : (jj <= r); p[i] = kp_ ? p[i] : 0.f; }
                }
                const bf16x8 P0 = pack_step(p, 0), P1 = pack_step(p, 1);
#pragma unroll
                for (int ct = 0; ct < 2; ++ct) {
                    const LAS bf16_t* vp = vT + (32 * ct + r) * VS + 32 * jt + 4 * hf;
                    const bf16x8 A0 = cat44(*(const LAS u32x2*)vp, *(const LAS u32x2*)(vp + 8)), A1 = cat44(*(const LAS u32x2*)(vp + 16), *(const LAS u32x2*)(vp + 24));
                    OT[ct][it] = MFMA32(A0, P0, OT[ct][it]); OT[ct][it] = MFMA32(A1, P1, OT[ct][it]); }
            }
#pragma unroll
        for (int ct = 0; ct < 2; ++ct)
#pragma unroll
            for (int s = 0; s < 2; ++s) {
                const bf16x8 As = cat44(sraw[ct][s][0], sraw[ct][s][1]);
                OT[ct][0] = MFMA32(As, QD[0][s], OT[ct][0]); OT[ct][1] = MFMA32(As, QD[1][s], OT[ct][1]); }
    }
    int ln2 = lane; asm volatile("" : "+v"(ln2)); const int r = ln2 & 31, hf = ln2 >> 5;
    u32x2 graw[2][2][4]; f32x4 gor[2][4];
#pragma unroll
    for (int ct = 0; ct < 2; ++ct)
#pragma unroll
        for (int g = 0; g < 4; ++g) { const int c0 = 32 * ct + 8 * g + 4 * hf; gor[ct][g] = *(const f32x4*)(a.in[I_GOUT] + l * 256 + 64 * h + c0);
#pragma unroll
            for (int it = 0; it < 2; ++it) graw[it][ct][g] = *(const u32x2*)(cols0 + (size_t)(32 * it + r) * NINP + C_G + 64 * h + c0); }
#pragma unroll
    for (int ct = 0; ct < 2; ++ct)
#pragma unroll
        for (int g = 0; g < 4; ++g) { PIN(gor[ct][g]); PIN(graw[0][ct][g]); PIN(graw[1][ct][g]); }
#pragma unroll
    for (int it = 0; it < 2; ++it) {
        float ss = 0.f;
#pragma unroll
        for (int ct = 0; ct < 2; ++ct)
#pragma unroll
            for (int i = 0; i < 16; ++i) ss += OT[ct][it][i] * OT[ct][it][i];
        ss += __shfl_xor(ss, 32);
        const float rs = rsqrtf(ss * (1.0f / 64.0f) + EPS);
        const int t = 32 * it + r;
#pragma unroll
        for (int ct = 0; ct < 2; ++ct)
#pragma unroll
            for (int g = 0; g < 4; ++g) { const int c0 = 32 * ct + 8 * g + 4 * hf;
                const u32x2 gw_ = graw[it][ct][g];
                const f32x4 go = gor[ct][g];
                const float o0 = OT[ct][it][4 * g] * rs * go[0] * siluf_(bflo(gw_.x)), o1 = OT[ct][it][4 * g + 1] * rs * go[1] * siluf_(bfhi(gw_.x));
                const float o2 = OT[ct][it][4 * g + 2] * rs * go[2] * siluf_(bflo(gw_.y)), o3 = OT[ct][it][4 * g + 3] * rs * go[3] * siluf_(bfhi(gw_.y));
                u32x2 w; w.x = pk2c(o0, o1); w.y = pk2c(o2, o3);
                *(u32x2*)(MIX + (size_t)(tile * 64 + t) * D + 64 * h + c0) = w; }
    }
    LDS_WAIT(); asm volatile("" ::: "memory");
}
template <int TAPS>
__device__ __forceinline__ void vconv_item(const float* SRC, float* DST, const float* w  , int b, int col, int chg, LAS float* buf, int lane) {
    const int ch = lane & 31, rh = lane >> 5;
    const size_t base = ((size_t)b * SEQ + col) * 128 + chg * 32 + ch;
#pragma unroll 8
    for (int r = 0; r < 128; r += 2) buf[(r + rh) * 32 + ch] = SRC[base + (size_t)(r + rh) * 64 * 128];
    float wt[TAPS];
#pragma unroll
    for (int j = 0; j < TAPS; ++j) wt[j] = w[j * 256 + chg * 32 + ch];
    LDS_WAIT(); asm volatile("" ::: "memory");
    constexpr int HW = TAPS / 2;
#pragma unroll 1
    for (int r0 = 0; r0 < 64; r0 += 8) {
        const int rb = rh * 64 + r0;
        float o[8] = {0.f, 0.f, 0.f, 0.f, 0.f, 0.f, 0.f, 0.f};
#pragma unroll
        for (int j = 0; j < TAPS + 7; ++j) { const int rin = rb - HW + j; const float x = (rin >= 0 && rin < 128) ? buf[rin * 32 + ch] : 0.f;
#pragma unroll
            for (int q = 0; q < 8; ++q) { if (j - q >= 0 && j - q < TAPS) o[q] += x * wt[j - q]; } }
#pragma unroll
        for (int q = 0; q < 8; ++q) DST[base + (size_t)(rb + q) * 64 * 128] = o[q];
    }
    LDS_WAIT(); asm volatile("" ::: "memory");
}
__device__ __forceinline__ void phase_scan(const Args& a, int l, LAS unsigned char* lds) {
    const int tid = tid_now(), lane = tid & 63, wid = __builtin_amdgcn_readfirstlane(tid >> 6);
    const float* KV = (const float*)(a.ws + WS_KV); const float* DEC = (const float*)(a.ws + WS_DEC); bf16_t* SIN = (bf16_t*)(a.ws + WS_SIN);
    if (tid < 256) {
        for (int rp = 0; rp < ((REP_SUB == 5 && l == 0) ? 2 : 1); ++rp)
        for (int gid = blockIdx.x * 256 + tid; gid < 65536; gid += gridDim.x * 256) {
            const int e = gid >> 11, idx = gid & 2047;
            const float* p = KV + (size_t)e * NSEQ * 2048 + idx; const float* dp = DEC + (size_t)e * NSEQ * 32 + (idx & 31); bf16_t* q = SIN + (size_t)e * NSEQ * 2048 + idx;
            float st = 0.f;
#pragma unroll 1
            for (int s0 = 0; s0 < NSEQ; s0 += 12) {
                float kv[12], dd[12];
#pragma unroll
                for (int u = 0; u < 12; ++u) { kv[u] = p[(size_t)(s0 + u) * 2048]; dd[u] = dp[(s0 + u) * 32]; }
#pragma unroll
                for (int u = 0; u < 12; ++u) { q[(size_t)(s0 + u) * 2048] = (bf16_t)(pk2c(st, 0.f) & 0xffffu); st = dd[u] * st + kv[u]; }
            }
        }
    }
    LAS float* buf = (LAS float*)(lds + wid * 16384);
    const int gw = blockIdx.x * 8 + wid, NGW = gridDim.x * 8;
    for (int rp = 0; rp < ((REP_SUB == 6 && l == 0) ? 2 : 1); ++rp)
    for (int it = gw; it < 2048; it += NGW) {
        const int kind = it >> 10, q = it & 1023, b = q >> 8, col = (q >> 2) & 63, chg = q & 3;
        if (kind == 0) vconv_item<31>((const float*)(a.ws + WS_AGV), (float*)(a.ws + WS_UV), a.in[I_CONFW] + (size_t)l * 31 * 256 + 128, b, col, chg, buf, lane);
        else vconv_item<3>((const float*)(a.ws + WS_CXV), (float*)(a.ws + WS_SCV), a.in[I_SCW] + (size_t)l * 3 * 256 + 128, b, col, chg, buf, lane);
    }
}

__device__ __forceinline__ void mixer_conv_item(const Args& a, int l, int tile, int tg, int lane0, LAS float* U) {
    const bf16_t* COLS = (const bf16_t*)(a.ws + WS_COLS); bf16_t* MIX = (bf16_t*)(a.ws + WS_MIX);
    const int row0 = tile * 64, T0 = 16 * tg;
    const float* confw = a.in[I_CONFW] + (size_t)l * 31 * 256; const float* scw = a.in[I_SCW] + (size_t)l * 3 * 256;
#pragma unroll 1
    for (int p = 0; p < 2; ++p) {
        int lane = lane0; asm volatile("" : "+v"(lane));
        const int c = 64 * p + lane;
        float wv[31];
#pragma unroll
        for (int j = 0; j < 31; ++j) wv[j] = confw[j * 256 + c];
        float bias = a.in[I_CONFB][l * 256 + c];
        unsigned ra[46], rg[46];
#pragma unroll
        for (int i = 0; i < 46; ++i) { const int t = T0 - 15 + i, tc = t < 0 ? 0 : (t > 63 ? 63 : t); const bf16_t* rp = COLS + (size_t)(row0 + tc) * NINP + c; ra[i] = rp[C_CA]; rg[i] = rp[C_CG]; }
#pragma unroll
        for (int j = 0; j < 31; ++j) PIN(wv[j]);
        PIN(bias);
#pragma unroll
        for (int i = 0; i < 46; ++i) { PIN(ra[i]); PIN(rg[i]); }
        float ag[46];
#pragma unroll
        for (int i = 0; i < 46; ++i) { const int t = T0 - 15 + i; const float m = (t >= 0 && t < 64) ? 1.0f : 0.0f;
            ag[i] = m * __uint_as_float(ra[i] << 16) * __builtin_amdgcn_rcpf(1.0f + __expf(-__uint_as_float(rg[i] << 16))); }
#pragma unroll
        for (int q = 0; q < 16; ++q) { float o = bias;
#pragma unroll
            for (int j = 0; j < 31; ++j) o += ag[q + j] * wv[j];
            U[q * 256 + ((((c >> 2) ^ q) << 2) | (c & 3))] = o; }
        unsigned rc[18], rx[18], rsb[16];
        float w0 = scw[c], w1 = scw[256 + c], w2 = scw[512 + c];
#pragma unroll
        for (int i = 0; i < 18; ++i) { const int t = T0 - 1 + i, tc = t < 0 ? 0 : (t > 63 ? 63 : t); const bf16_t* rp = COLS + (size_t)(row0 + tc) * NINP + c; rc[i] = rp[C_SC]; rx[i] = rp[C_SX]; }
#pragma unroll
        for (int q = 0; q < 16; ++q) rsb[q] = COLS[(size_t)(row0 + T0 + q) * NINP + C_SB + c];
        PIN(w0); PIN(w1); PIN(w2);
#pragma unroll
        for (int i = 0; i < 18; ++i) { PIN(rc[i]); PIN(rx[i]); }
#pragma unroll
        for (int q = 0; q < 16; ++q) PIN(rsb[q]);
        float cx[18];
#pragma unroll
        for (int i = 0; i < 18; ++i) { const int t = T0 - 1 + i; const float m = (t >= 0 && t < 64) ? 1.0f : 0.0f; cx[i] = m * __uint_as_float(rc[i] << 16) * __uint_as_float(rx[i] << 16); }
#pragma unroll
        for (int q = 0; q < 16; ++q) { const float cv = cx[q] * w0 + cx[q + 1] * w1 + cx[q + 2] * w2;
            MIX[(size_t)(row0 + T0 + q) * D + 512 + c] = (bf16_t)(pk2c(__uint_as_float(rsb[q] << 16) * cv, 0.f) & 0xffffu); }
    }
    {
        int lane = lane0; asm volatile("" : "+v"(lane));
        const float* UV = (const float*)(a.ws + WS_UV); const float* SCV = (const float*)(a.ws + WS_SCV);
        f32x4 uu[8], svv[8], bzz[8]; u32x2 sbb[8];
#pragma unroll
        for (int k8 = 0; k8 < 8; ++k8) { const int idx = lane + 64 * k8, t = idx >> 5, c4 = (idx & 31) * 4; const size_t row = (size_t)(row0 + T0 + t);
            uu[k8] = *(const f32x4*)(UV + row * 128 + c4); bzz[k8] = *(const f32x4*)(a.in[I_CONFB] + l * 256 + 128 + c4);
            svv[k8] = *(const f32x4*)(SCV + row * 128 + c4); sbb[k8] = *(const u32x2*)(COLS + row * NINP + C_SB + 128 + c4); }
#pragma unroll
        for (int k8 = 0; k8 < 8; ++k8) { PIN(uu[k8]); PIN(bzz[k8]); PIN(svv[k8]); PIN(sbb[k8]); }
#pragma unroll
        for (int k8 = 0; k8 < 8; ++k8) { const int idx = lane + 64 * k8, t = idx >> 5, c4 = (idx & 31) * 4; const size_t row = (size_t)(row0 + T0 + t);
            *(LAS f32x4*)(U + t * 256 + ((((128 + c4) >> 2) ^ t) << 2)) = uu[k8] + bzz[k8];
            u32x2 w; w.x = pk2c(bflo(sbb[k8].x) * svv[k8][0], bfhi(sbb[k8].x) * svv[k8][1]); w.y = pk2c(bflo(sbb[k8].y) * svv[k8][2], bfhi(sbb[k8].y) * svv[k8][3]);
            *(u32x2*)(MIX + row * D + 512 + 128 + c4) = w; }
    }
    LDS_WAIT(); asm volatile("" ::: "memory");
    {
        int lane = lane0; asm volatile("" : "+v"(lane));
        const int t = lane >> 2, qd = lane & 3;
        f32x4 lgv[16], lbv[16];
        { const float* lg = a.in[I_CONFG] + l * 256 + 64 * qd; const float* lb = a.in[I_CONFBETA] + l * 256 + 64 * qd;
#pragma unroll
            for (int i = 0; i < 16; ++i) { lgv[i] = *(const f32x4*)(lg + 4 * i); lbv[i] = *(const f32x4*)(lb + 4 * i); }
#pragma unroll
            for (int i = 0; i < 16; ++i) { PIN(lgv[i]); PIN(lbv[i]); } }
        f32x4 v[16]; float s1 = 0.f;
#pragma unroll
        for (int i = 0; i < 16; ++i) { v[i] = *(const LAS f32x4*)(U + t * 256 + (((16 * qd + i) ^ t) << 2)); s1 += (v[i][0] + v[i][1]) + (v[i][2] + v[i][3]); }
        s1 += __shfl_xor(s1, 1); s1 += __shfl_xor(s1, 2);
        const float mean = s1 * (1.0f / 256.0f); float s2 = 0.f;
#pragma unroll
        for (int i = 0; i < 16; ++i) { v[i] = v[i] - mean; s2 += (v[i][0] * v[i][0] + v[i][1] * v[i][1]) + (v[i][2] * v[i][2] + v[i][3] * v[i][3]); }
        s2 += __shfl_xor(s2, 1); s2 += __shfl_xor(s2, 2);
        const float rstd = rsqrtf(s2 * (1.0f / 256.0f) + EPS);
        bf16_t* dst = MIX + (size_t)(row0 + T0 + t) * D + 256 + 64 * qd;
#pragma unroll
        for (int i = 0; i < 16; i += 2) { const f32x4 g0 = lgv[i], g1 = lgv[i + 1], b0 = lbv[i], b1 = lbv[i + 1];
            const f32x4 y0 = v[i] * rstd * g0 + b0, y1 = v[i + 1] * rstd * g1 + b1;
            u32x4 w; w.x = pk2c(siluf_(y0[0]), siluf_(y0[1])); w.y = pk2c(siluf_(y0[2]), siluf_(y0[3])); w.z = pk2c(siluf_(y1[0]), siluf_(y1[1])); w.w = pk2c(siluf_(y1[2]), siluf_(y1[3]));
            *(u32x4*)(dst + 4 * i) = w; }
    }
    LDS_WAIT(); asm volatile("" ::: "memory");
}
__device__ __forceinline__ void mixer_pool_item(const Args& a, int l, int tile, int g, int lane0) {
    const bf16_t* COLS = (const bf16_t*)(a.ws + WS_COLS); bf16_t* MIX = (bf16_t*)(a.ws + WS_MIX);
    const f32x16 zero16 = {0.f, 0.f, 0.f, 0.f, 0.f, 0.f, 0.f, 0.f, 0.f, 0.f, 0.f, 0.f, 0.f, 0.f, 0.f, 0.f};
    const int row0 = tile * 64;
    {
        int lane = lane0; asm volatile("" : "+v"(lane));
        const int r = lane & 31, hf = lane >> 5, hw = 1 << g;
        const bf16_t* pwt = (const bf16_t*)(a.ws + WS_PWT) + (size_t)(l * 4 + g) * 4096;
        const u32x4* band = (const u32x4*)(a.ws + WS_BAND) + (size_t)g * 512 + lane;
        f32x16 Y[2][2] = {{zero16, zero16}, {zero16, zero16}};
        bf16x8 Ax[2][4], Bw[2][4]; u32x4 Bb[8];
#pragma unroll
        for (int mt = 0; mt < 2; ++mt)
#pragma unroll
            for (int ks = 0; ks < 4; ++ks) { Ax[mt][ks] = *(const bf16x8*)(COLS + (size_t)(row0 + 32 * mt + r) * NINP + C_PL + 64 * g + 16 * ks + 8 * hf);
                Bw[mt][ks] = *(const bf16x8*)(pwt + (size_t)(32 * mt + r) * 64 + 16 * ks + 8 * hf); }
#pragma unroll
        for (int f = 0; f < 8; ++f) Bb[f] = band[f * 64];
        f32x4 psv[2][4];
#pragma unroll
        for (int ntd = 0; ntd < 2; ++ntd)
#pragma unroll
            for (int q = 0; q < 4; ++q) psv[ntd][q] = *(const f32x4*)(a.in[I_POOLS] + l * 256 + 64 * g + 32 * ntd + 8 * q + 4 * hf);
#pragma unroll
        for (int mt = 0; mt < 2; ++mt)
#pragma unroll
            for (int ks = 0; ks < 4; ++ks) { PIN(Ax[mt][ks]); PIN(Bw[mt][ks]); }
#pragma unroll
        for (int f = 0; f < 8; ++f) PIN(Bb[f]);
#pragma unroll
        for (int ntd = 0; ntd < 2; ++ntd)
#pragma unroll
            for (int q = 0; q < 4; ++q) PIN(psv[ntd][q]);
#pragma unroll
        for (int mt = 0; mt < 2; ++mt) {
#pragma unroll
            for (int ntd = 0; ntd < 2; ++ntd) {
                f32x16 z = zero16;
#pragma unroll
                for (int ks = 0; ks < 4; ++ks) z = MFMA32(Ax[mt][ks], Bw[ntd][ks], z);
#pragma unroll
                for (int sq = 0; sq < 2; ++sq) {
                    const float t8[8] = {z[8 * sq], z[8 * sq + 1], z[8 * sq + 2], z[8 * sq + 3], z[8 * sq + 4], z[8 * sq + 5], z[8 * sq + 6], z[8 * sq + 7]};
                    bf16x8 Zh, Zl; split8(t8, Zh, Zl);
#pragma unroll
                    for (int ntt = 0; ntt < 2; ++ntt) { const bf16x8 Bq = __builtin_bit_cast(bf16x8, Bb[(mt * 2 + ntt) * 2 + sq]);
                        Y[ntd][ntt] = MFMA32(Zh, Bq, Y[ntd][ntt]); Y[ntd][ntt] = MFMA32(Zl, Bq, Y[ntd][ntt]); }
                }
            }
        }
#pragma unroll
        for (int ntt = 0; ntt < 2; ++ntt) { const int t = 32 * ntt + r; int lo = t - hw, hi = t + hw; lo = lo < 0 ? 0 : lo; hi = hi > 64 ? 64 : hi; const float inv = 1.0f / (float)(hi - lo);
#pragma unroll
            for (int ntd = 0; ntd < 2; ++ntd)
#pragma unroll
                for (int q = 0; q < 4; ++q) { const int dd0 = 32 * ntd + 8 * q + 4 * hf; const f32x4 ps = psv[ntd][q];
                    u32x2 w; w.x = pk2c(Y[ntd][ntt][4 * q] * inv * ps[0], Y[ntd][ntt][4 * q + 1] * inv * ps[1]); w.y = pk2c(Y[ntd][ntt][4 * q + 2] * inv * ps[2], Y[ntd][ntt][4 * q + 3] * inv * ps[3]);
                    *(u32x2*)(MIX + (size_t)(row0 + t) * D + 768 + 64 * g + dd0) = w; } }
    }
}

__device__ __forceinline__ void mixer_local(const Args& a, int l, int tile, int half, LAS unsigned char* lds) {
    const int tid = tid_now();
    const bf16_t* COLS = (const bf16_t*)(a.ws + WS_COLS); bf16_t* MIX = (bf16_t*)(a.ws + WS_MIX);
    LAS float* AG = (LAS float*)lds;
    LAS float* U = AG + 7936;
    LAS float* CX = U + 8192;
    const bool lat = tile < 512; const int r0 = tile * 64 + half * 32;
    const int seq_lo = lat ? tile * 64 : (NLAT + ((tile - 512) >> 2) * CTXL), seq_hi = lat ? tile * 64 + 64 : seq_lo + CTXL;
    const float* confw = a.in[I_CONFW] + (size_t)l * 31 * 256; const float* scw = a.in[I_SCW] + (size_t)l * 3 * 256;
    const int npass = lat ? 1 : 2;
    for (int ps = 0; ps < npass; ++ps) {
        const int chb = ps * 128;
        for (int idx = tid; idx < 62 * 16; idx += 512) { const int tt = idx >> 4, c8 = (idx & 15) * 8, r = r0 - 15 + tt;
            float o[8] = {0.f, 0.f, 0.f, 0.f, 0.f, 0.f, 0.f, 0.f};
            if (r >= seq_lo && r < seq_hi) { const bf16_t* rp = COLS + (size_t)r * NINP; float fa[8], fg[8]; unpack8(*(const u32x4*)(rp + C_CA + chb + c8), fa); unpack8(*(const u32x4*)(rp + C_CG + chb + c8), fg);
#pragma unroll
                for (int i = 0; i < 8; ++i) o[i] = fa[i] * sigmoidf_(fg[i]); }
            *(LAS f32x4*)(AG + tt * 128 + c8) = (f32x4){o[0], o[1], o[2], o[3]}; *(LAS f32x4*)(AG + tt * 128 + c8 + 4) = (f32x4){o[4], o[5], o[6], o[7]}; }
        for (int idx = tid; idx < 34 * 16; idx += 512) { const int tt = idx >> 4, c8 = (idx & 15) * 8, r = r0 - 1 + tt;
            float o[8] = {0.f, 0.f, 0.f, 0.f, 0.f, 0.f, 0.f, 0.f};
            if (r >= seq_lo && r < seq_hi) { const bf16_t* rp = COLS + (size_t)r * NINP; float fc[8], fx[8]; unpack8(*(const u32x4*)(rp + C_SC + chb + c8), fc); unpack8(*(const u32x4*)(rp + C_SX + chb + c8), fx);
#pragma unroll
                for (int i = 0; i < 8; ++i) o[i] = fc[i] * fx[i]; }
            *(LAS f32x4*)(CX + tt * 128 + c8) = (f32x4){o[0], o[1], o[2], o[3]}; *(LAS f32x4*)(CX + tt * 128 + c8 + 4) = (f32x4){o[4], o[5], o[6], o[7]}; }
        __syncthreads();
        { const int c = tid & 127, t0 = (tid >> 7) * 8;
            float wv[31];
#pragma unroll
            for (int j = 0; j < 31; ++j) wv[j] = confw[j * 256 + chb + c];
            const float bias = a.in[I_CONFB][l * 256 + chb + c];
            const float w0 = scw[chb + c], w1 = scw[256 + chb + c], w2 = scw[512 + chb + c];
            float o[8];
#pragma unroll
            for (int q = 0; q < 8; ++q) o[q] = bias;
#pragma unroll
            for (int j = 0; j < 38; ++j) { const float x = AG[(t0 + j) * 128 + c];
#pragma unroll
                for (int q = 0; q < 8; ++q) { if (j - q >= 0 && j - q < 31) o[q] += x * wv[j - q]; } }
#pragma unroll
            for (int q = 0; q < 8; ++q) U[(t0 + q) * 256 + chb + c] = o[q];
            unsigned sbr[8];
#pragma unroll
            for (int q = 0; q < 8; ++q) sbr[q] = COLS[(size_t)(r0 + t0 + q) * NINP + C_SB + chb + c];
#pragma unroll
            for (int q = 0; q < 8; ++q) PIN(sbr[q]);
#pragma unroll
            for (int q = 0; q < 8; ++q) { const int t = t0 + q; const float cv = CX[t * 128 + c] * w0 + CX[(t + 1) * 128 + c] * w1 + CX[(t + 2) * 128 + c] * w2;
                const float sb = __uint_as_float(sbr[q] << 16);
                MIX[(size_t)(r0 + t) * D + 512 + chb + c] = (bf16_t)(pk2(sb * cv, 0.f) & 0xffffu); }
        }
        __syncthreads();
    }
    if (lat) {
        const float* UV = (const float*)(a.ws + WS_UV); const float* SCV = (const float*)(a.ws + WS_SCV);
        for (int idx = tid; idx < 32 * 32; idx += 512) { const int t = idx >> 5, c4 = (idx & 31) * 4;
            const f32x4 u = *(const f32x4*)(UV + (size_t)(r0 + t) * 128 + c4), bz = *(const f32x4*)(a.in[I_CONFB] + l * 256 + 128 + c4);
            *(LAS f32x4*)(U + t * 256 + 128 + c4) = u + bz;
            const f32x4 sv = *(const f32x4*)(SCV + (size_t)(r0 + t) * 128 + c4);
            const u32x2 sbw = *(const u32x2*)(COLS + (size_t)(r0 + t) * NINP + C_SB + 128 + c4);
            u32x2 w; w.x = pk2(bflo(sbw.x) * sv[0], bfhi(sbw.x) * sv[1]); w.y = pk2(bflo(sbw.y) * sv[2], bfhi(sbw.y) * sv[3]);
            *(u32x2*)(MIX + (size_t)(r0 + t) * D + 512 + 128 + c4) = w; }
        __syncthreads();
    }
    { const int t = tid >> 4, c0 = (tid & 15) * 16;
        float s = 0.f;
#pragma unroll
        for (int i = 0; i < 16; i += 4) { const f32x4 v = *(const LAS f32x4*)(U + t * 256 + c0 + i); s += (v[0] + v[1]) + (v[2] + v[3]); }
        s += __shfl_xor(s, 1); s += __shfl_xor(s, 2); s += __shfl_xor(s, 4); s += __shfl_xor(s, 8);
        const float mean = s * (1.0f / 256.0f); float q = 0.f;
#pragma unroll
        for (int i = 0; i < 16; i += 4) { const f32x4 v = *(const LAS f32x4*)(U + t * 256 + c0 + i) - mean; q += (v[0] * v[0] + v[1] * v[1]) + (v[2] * v[2] + v[3] * v[3]); }
        q += __shfl_xor(q, 1); q += __shfl_xor(q, 2); q += __shfl_xor(q, 4); q += __shfl_xor(q, 8);
        const float rstd = rsqrtf(q * (1.0f / 256.0f) + EPS);
        const float* lg = a.in[I_CONFG] + l * 256 + c0; const float* lb = a.in[I_CONFBETA] + l * 256 + c0;
#pragma unroll
        for (int i = 0; i < 16; i += 8) { float y[8];
#pragma unroll
            for (int k = 0; k < 8; ++k) y[k] = siluf_((U[t * 256 + c0 + i + k] - mean) * rstd * lg[i + k] + lb[i + k]);
            u32x4 w; w.x = pk2(y[0], y[1]); w.y = pk2(y[2], y[3]); w.z = pk2(y[4], y[5]); w.w = pk2(y[6], y[7]);
            *(u32x4*)(MIX + (size_t)(r0 + t) * D + 256 + c0 + i) = w; }
    }
    __syncthreads();
    for (int hf = 0; hf < 2; ++hf) {
        LAS float* PI = (LAS float*)lds;
        LAS float* DF = PI + 6144;
        LAS float* PW = DF + 4224;
        for (int idx = tid; idx < 48 * 16; idx += 512) { const int tt = idx >> 4, c8 = (idx & 15) * 8, r = r0 - 8 + tt;
            float o[8] = {0.f, 0.f, 0.f, 0.f, 0.f, 0.f, 0.f, 0.f};
            if (r >= seq_lo && r < seq_hi) unpack8(*(const u32x4*)(COLS + (size_t)r * NINP + C_PL + hf * 128 + c8), o);
            *(LAS f32x4*)(PI + tt * 128 + c8) = (f32x4){o[0], o[1], o[2], o[3]}; *(LAS f32x4*)(PI + tt * 128 + c8 + 4) = (f32x4){o[4], o[5], o[6], o[7]}; }
        for (int idx = tid; idx < 2 * 64 * 64 / 4; idx += 512) *(LAS f32x4*)(PW + idx * 4) = *(const f32x4*)(a.in[I_POOLW] + (size_t)l * 4 * 4096 + (size_t)hf * 2 * 4096 + idx * 4);
        __syncthreads();
        for (int idx = tid; idx < 32 * 128; idx += 512) { const int t = idx >> 7, c = idx & 127, g = hf * 2 + (c >> 6); const int hw = 1 << g;
            const int r = r0 + t; int lo = r - hw, hi = r + hw; lo = lo < seq_lo ? seq_lo : lo; hi = hi > seq_hi ? seq_hi : hi;
            float sm = 0.f; for (int rr = lo; rr < hi; ++rr) sm += PI[(rr - r0 + 8) * 128 + c];
            DF[t * 132 + c] = sm / (float)(hi - lo) - PI[(t + 8) * 128 + c]; }
        __syncthreads();
        { const int gl = tid >> 8, tp = (tid >> 4) & 15, dq = tid & 15; const int dd0 = dq * 4;
            f32x4 o[2] = {(f32x4){0.f, 0.f, 0.f, 0.f}, (f32x4){0.f, 0.f, 0.f, 0.f}};
#pragma unroll 2
            for (int c4 = 0; c4 < 64; c4 += 4) { f32x4 dv[2];
#pragma unroll
                for (int x = 0; x < 2; ++x) dv[x] = *(const LAS f32x4*)(DF + (tp * 2 + x) * 132 + gl * 64 + c4);
#pragma unroll
                for (int q = 0; q < 4; ++q) { const f32x4 wv = *(const LAS f32x4*)(PW + (gl * 64 + c4 + q) * 64 + dd0);
#pragma unroll
                    for (int x = 0; x < 2; ++x) o[x] += dv[x][q] * wv; } }
            const int ch = (hf * 2 + gl) * 64 + dd0; const f32x4 ps = *(const f32x4*)(a.in[I_POOLS] + l * 256 + ch);
#pragma unroll
            for (int x = 0; x < 2; ++x) { u32x2 w; w.x = pk2(o[x][0] * ps[0], o[x][1] * ps[1]); w.y = pk2(o[x][2] * ps[2], o[x][3] * ps[3]);
                *(u32x2*)(MIX + (size_t)(r0 + tp * 2 + x) * D + 768 + ch) = w; } }
        __syncthreads();
    }
}

__device__ __forceinline__ void phase_mixer(const Args& a, int l, LAS unsigned char* lds) {
    const int ntile = (l == 1) ? 512 : NCHUNK;
    { const int tid = tid_now(), lane = tid & 63, wid = __builtin_amdgcn_readfirstlane(tid >> 6);
        LAS bf16_t* vT = (LAS bf16_t*)(lds + wid * 16384);
        LAS int* ctr = (LAS int*)(lds + MISC_OFF + 16);
        if (tid == 0) *ctr = 0;
        __syncthreads();
        const int n_gla = ntile * 4, n_conv = 512 * 4, n_pool = 512 * 4;
        for (;;) { const int it = blockIdx.x + gridDim.x * next_item(ctr, lane); if (it >= n_gla + n_conv + n_pool) break;
            if (it < n_gla) mixer_gla_item(a, l, it >> 2, it & 3, lane, vT);
            else if (it < n_gla + n_conv) mixer_conv_item(a, l, (it - n_gla) >> 2, (it - n_gla) & 3, lane, (LAS float*)vT);
            else mixer_pool_item(a, l, (it - n_gla - n_conv) >> 2, (it - n_gla - n_conv) & 3, lane); } }
    if (l == 0) {
        __syncthreads();
        for (int it = blockIdx.x; it < 16 * 2; it += gridDim.x) mixer_local(a, l, 512 + (it >> 1), it & 1, lds);
    }
}

__device__ __forceinline__ void phase_router(const Args& a, int l, LAS unsigned char* lds) {
    const int tid = tid_now(), lane = tid & 63, wid = tid >> 6;
    const int M = (l == 1) ? NLAT : MTOT;
    const float* MOD = (const float*)(a.ws + WS_MOD) + (size_t)l * 5 * 6144; bf16_t* H = (bf16_t*)(a.ws + WS_H);
    LAS float* WRE = (LAS float*)lds;
    LAS int* INFO = (LAS int*)(lds + MISC_OFF + 4096);
    LAS int* HIST = (LAS int*)(lds + MISC_OFF + 2048);
    const float* wre = a.in[I_RWE] + (size_t)l * 1024 * 32; const float* wrgT = (const float*)(a.ws + WS_TAB) + (size_t)l * 4096;
    for (int i = tid; i < 1024 * 8; i += 512) { const int k = i >> 3, q = i & 7; const f32x4 w = *(const f32x4*)(wre + k * 32 + q * 4);
        WRE[(4 * q + 0) * 1024 + k] = w[0]; WRE[(4 * q + 1) * 1024 + k] = w[1]; WRE[(4 * q + 2) * 1024 + k] = w[2]; WRE[(4 * q + 3) * 1024 + k] = w[3]; }
    if (tid < 64) HIST[tid] = 0;
    __syncthreads();
    const int per = (M + gridDim.x - 1) / gridDim.x; const int r_lo = blockIdx.x * per; int r_hi = r_lo + per; if (r_hi > M) r_hi = M;
    const float rbg0 = a.in[I_RBG][l * 4 + 0], rbg1 = a.in[I_RBG][l * 4 + 1], rbg2 = a.in[I_RBG][l * 4 + 2], rbg3 = a.in[I_RBG][l * 4 + 3];
    bf16_t* XB = (bf16_t*)(a.ws + WS_XB); const bf16_t* Y1 = (const bf16_t*)(a.ws + WS_Y);
    int cur_b = -1; f32x4 GS[4], SH[4], GA[4], WGT[4][4];
#pragma unroll
    for (int g = 0; g < 4; ++g)
#pragma unroll
        for (int j = 0; j < 4; ++j) WGT[g][j] = *((const f32x4*)(wrgT + g * 1024) + lane + 64 * j);
    for (int rp = 0; rp < ((REP_SUB == 7 && l == 0) ? 2 : 1); ++rp)
#pragma unroll 1
    for (int mm = r_lo + wid; mm < r_hi; mm += 16) {
        f32x4 vv[2][4]; u32x2 yy[2][4]; int mrow[2]; bool has[2];
#pragma unroll
        for (int rr = 0; rr < 2; ++rr) { const int m = mm + 8 * rr; has[rr] = m < r_hi; const int mc = has[rr] ? m : mm; mrow[rr] = mc;
            if (l == 0) load_row(mc < NLAT ? a.in[I_X] + (size_t)mc * D : a.in[I_CTX] + (size_t)(mc - NLAT) * D, lane, vv[rr]);
            else load_row_bf(XB + (size_t)mc * D, lane, vv[rr]);
#pragma unroll
            for (int j = 0; j < 4; ++j) yy[rr][j] = *((const u32x2*)(Y1 + (size_t)mc * D) + lane + 64 * j); }
#pragma unroll
        for (int rr = 0; rr < 2; ++rr) {
            if (!has[rr]) continue;
            const int m = mrow[rr]; const int b = m < NLAT ? (m >> 13) : 4;
            if (b != cur_b) { const float* mod = MOD + (size_t)b * 6144; load_mod_cached(a.in[I_G2] + l * 1024, mod + 4 * 1024, mod + 3 * 1024, mod + 2 * 1024, lane, GS, SH, GA); cur_b = b; }
            f32x4 v[4];
#pragma unroll
            for (int j = 0; j < 4; ++j) { const u32x2 y = yy[rr][j]; v[j] = vv[rr][j] + GA[j] * (f32x4){bflo(y.x), bfhi(y.x), bflo(y.y), bfhi(y.y)}; }
            store_row_bf(XB + (size_t)m * D, lane, v);
            const float rstd = row_rstd(v);
            norm_store_cached(v, rstd, GS, SH, H + (size_t)m * D, lane);
            float ga_[4] = {0.f, 0.f, 0.f, 0.f};
#pragma unroll
            for (int g = 0; g < 4; ++g)
#pragma unroll
                for (int j = 0; j < 4; ++j) { const f32x4 w = WGT[g][j]; ga_[g] += (v[j][0] * w[0] + v[j][1] * w[1]) + (v[j][2] * w[2] + v[j][3] * w[3]); }
            float lg0, lg1, lg2, lg3;
            { const bool h5 = (lane & 32) != 0, h4 = (lane & 16) != 0;
                float k0 = h5 ? ga_[2] : ga_[0], k1 = h5 ? ga_[3] : ga_[1]; const float s0 = h5 ? ga_[0] : ga_[2], s1 = h5 ? ga_[1] : ga_[3];
                k0 += __shfl_xor(s0, 32); k1 += __shfl_xor(s1, 32);
                float kk = h4 ? k1 : k0; const float sk = h4 ? k0 : k1; kk += __shfl_xor(sk, 16);
                kk += __shfl_xor(kk, 8); kk += __shfl_xor(kk, 4); kk += __shfl_xor(kk, 2); kk += __shfl_xor(kk, 1);
                lg0 = __int_as_float(__builtin_amdgcn_readlane(__float_as_int(kk), 0)) + rbg0; lg1 = __int_as_float(__builtin_amdgcn_readlane(__float_as_int(kk), 16)) + rbg1;
                lg2 = __int_as_float(__builtin_amdgcn_readlane(__float_as_int(kk), 32)) + rbg2; lg3 = __int_as_float(__builtin_amdgcn_readlane(__float_as_int(kk), 48)) + rbg3; }
            int grp = 0; float best = lg0; if (lg1 > best) { best = lg1; grp = 1; } if (lg2 > best) { best = lg2; grp = 2; } if (lg3 > best) { best = lg3; grp = 3; }
            const float pg = 1.0f / (__expf(lg0 - best) + __expf(lg1 - best) + __expf(lg2 - best) + __expf(lg3 - best));
            grp = __builtin_amdgcn_readfirstlane(grp);
            float ep[8];
            { const LAS float* wb = WRE + (size_t)(grp * 8) * 1024;
#pragma unroll
                for (int i = 0; i < 8; i += 2) { f32x4 w[2][4];
#pragma unroll
                    for (int u = 0; u < 2; ++u)
#pragma unroll
                        for (int j = 0; j < 4; ++j) w[u][j] = *((const LAS f32x4*)(wb + (i + u) * 1024) + lane + 64 * j);
#pragma unroll
                    for (int u = 0; u < 2; ++u)
#pragma unroll
                        for (int j = 0; j < 4; ++j) PIN(w[u][j]);
#pragma unroll
                    for (int u = 0; u < 2; ++u) { float acc_ = 0.f;
#pragma unroll
                        for (int j = 0; j < 4; ++j) acc_ += (v[j][0] * w[u][j][0] + v[j][1] * w[u][j][1]) + (v[j][2] * w[u][j][2] + v[j][3] * w[u][j][3]);
                        ep[i + u] = acc_; } } }
            float le[8];
            { const bool h5 = (lane & 32) != 0, h4 = (lane & 16) != 0, h3 = (lane & 8) != 0;
                float k4[4];
#pragma unroll
                for (int i = 0; i < 4; ++i) { const float keep = h5 ? ep[4 + i] : ep[i], send = h5 ? ep[i] : ep[4 + i]; k4[i] = keep + __shfl_xor(send, 32); }
                float k2[2];
#pragma unroll
                for (int i = 0; i < 2; ++i) { const float keep = h4 ? k4[2 + i] : k4[i], send = h4 ? k4[i] : k4[2 + i]; k2[i] = keep + __shfl_xor(send, 16); }
                float kk = h3 ? k2[1] : k2[0]; const float sk = h3 ? k2[0] : k2[1]; kk += __shfl_xor(sk, 8);
                kk += __shfl_xor(kk, 4); kk += __shfl_xor(kk, 2); kk += __shfl_xor(kk, 1);
#pragma unroll
                for (int i = 0; i < 8; ++i) le[i] = __int_as_float(__builtin_amdgcn_readlane(__float_as_int(kk), 8 * i)) + a.in[I_RBE][l * 32 + grp * 8 + i]; }
            int i0 = 0; float v0 = le[0];
#pragma unroll
            for (int i = 1; i < 8; ++i) if (le[i] > v0) { v0 = le[i]; i0 = i; }
            int i1 = -1; float v1 = -3.0e38f;
#pragma unroll
            for (int i = 0; i < 8; ++i) if (i != i0 && le[i] > v1) { v1 = le[i]; i1 = i; }
            const float w0 = 1.0f / (1.0f + __expf(v1 - v0)); const float w1 = 1.0f - w0;
            if (lane == 0) { const int lr = m - r_lo; INFO[lr * 4 + 0] = grp * 8 + i0; INFO[lr * 4 + 1] = grp * 8 + i1; INFO[lr * 4 + 2] = __float_as_int(w0 * pg); INFO[lr * 4 + 3] = __float_as_int(w1 * pg); }
        }
    }
    __syncthreads();
    const int nr = r_hi - r_lo; int lp0 = 0, lp1 = 0, ee0 = 0, ee1 = 0;
    if (tid < nr) { ee0 = INFO[tid * 4 + 0]; ee1 = INFO[tid * 4 + 1]; lp0 = atomicAdd((int*)(HIST + ee0), 1); lp1 = atomicAdd((int*)(HIST + ee1), 1); }
    __syncthreads();
    unsigned* cnt = (unsigned*)(a.ws + WS_CTL) + CW_CNT + l * 32 * 64;
    if (tid < 32) { const int c = HIST[tid]; HIST[32 + tid] = c ? (int)atomicAdd(cnt + tid * 64, (unsigned)c) : 0; }
    __syncthreads();
    if (tid < nr) { const int m = r_lo + tid; const int p0 = HIST[32 + ee0] + lp0, p1 = HIST[32 + ee1] + lp1;
        int* TL = (int*)(a.ws + WS_TOKLIST); TL[ee0 * MTOT + p0] = m; TL[ee1 * MTOT + p1] = m;
        *((i32x4*)(a.ws + WS_TOKINFO) + m) = (i32x4){(ee0 << 20) | p0, (ee1 << 20) | p1, INFO[tid * 4 + 2], INFO[tid * 4 + 3]}; }
    __syncthreads();
}

__device__ __forceinline__ int moe_tables(const Args& a, int l, LAS unsigned char* lds) {
    LAS int* TB = (LAS int*)(lds + MISC_OFF + 256); LAS int* CN = TB + 64; LAS int* TE = (LAS int*)(lds + MISC_OFF + 1024); LAS int* TM = TE + 320;
    const unsigned* cnt = (const unsigned*)(a.ws + WS_CTL) + CW_CNT + l * 32 * 64;
    { const int tq_ = tid_now(); if (tq_ < 32) CN[tq_] = (int)__hip_atomic_load(cnt + tq_ * 64, __ATOMIC_RELAXED, __HIP_MEMORY_SCOPE_AGENT); }
    __syncthreads();
    if (tid_now() == 0) { int t = 0;
#pragma unroll 1
        for (int e = 0; e < 32; ++e) { TB[e] = t; const int nt = (CN[e] + 255) >> 8;
#pragma unroll 1
            for (int q = 0; q < nt; ++q) { TE[t + q] = e; TM[t + q] = q; } t += nt; } TB[32] = t; }
    __syncthreads();
    return __builtin_amdgcn_readfirstlane(TB[32]);
}

__device__ __forceinline__ void phase_combine(const Args& a, int l, LAS unsigned char* lds) {
    const int lane = tid_now() & 63, wid = tid_now() >> 6, gw = blockIdx.x * 8 + wid, NGW = gridDim.x * 8;
    const int M = (l == 1) ? NLAT : MTOT;
    (void)moe_tables(a, l, lds);
    const LAS int* TB = (const LAS int*)(lds + MISC_OFF + 256);
    const float* MOD = (const float*)(a.ws + WS_MOD); const bf16_t* Y = (const bf16_t*)(a.ws + WS_Y); bf16_t* H = (bf16_t*)(a.ws + WS_H);
    bf16_t* XB = (bf16_t*)(a.ws + WS_XB);
    int cur_b = -1; f32x4 GS[4], SH[4], GA[4];
#pragma unroll 1
    for (int mm = gw; mm < M; mm += 2 * NGW) {
        f32x4 vv[2][4]; u32x2 ya[2][4], yb[2][4]; i32x4 inf[2]; int mrow[2]; bool has[2];
#pragma unroll
        for (int rr = 0; rr < 2; ++rr) { const int m = mm + rr * NGW; has[rr] = m < M; const int mc = has[rr] ? m : mm; mrow[rr] = mc;
            inf[rr] = *((const i32x4*)(a.ws + WS_TOKINFO) + mc);
            load_row_bf(XB + (size_t)mc * D, lane, vv[rr]); }
#pragma unroll
        for (int rr = 0; rr < 2; ++rr) { const int e0 = inf[rr].x >> 20, p0 = inf[rr].x & 0xfffff, e1 = inf[rr].y >> 20, p1 = inf[rr].y & 0xfffff;
            const bf16_t* y0 = Y + (size_t)(TB[e0] * 256 + p0) * D; const bf16_t* y1 = Y + (size_t)(TB[e1] * 256 + p1) * D;
#pragma unroll
            for (int j = 0; j < 4; ++j) { ya[rr][j] = *((const u32x2*)y0 + lane + 64 * j); yb[rr][j] = *((const u32x2*)y1 + lane + 64 * j); } }
#pragma unroll
        for (int rr = 0; rr < 2; ++rr) {
            if (!has[rr]) continue;
            const int m = mrow[rr]; const int b = m < NLAT ? (m >> 13) : 4;
            const float w0 = __int_as_float(inf[rr].z), w1 = __int_as_float(inf[rr].w);
            if (b != cur_b) { const float* ga2 = MOD + (size_t)(l * 5 + b) * 6144 + 5 * 1024;
                if (l == 0) { const float* mod = MOD + (size_t)(5 + b) * 6144; load_mod_cached(a.in[I_G1] + 1024, mod + 1024, mod, ga2, lane, GS, SH, GA); }
                else {
#pragma unroll
                    for (int j = 0; j < 4; ++j) { GS[j] = *((const f32x4*)a.in[I_GFINAL] + lane + 64 * j); SH[j] = (f32x4){0.f, 0.f, 0.f, 0.f}; GA[j] = *((const f32x4*)ga2 + lane + 64 * j); } }
                cur_b = b; }
            f32x4 v[4];
#pragma unroll
            for (int j = 0; j < 4; ++j) { const u32x2 a0 = ya[rr][j], a1 = yb[rr][j];
                f32x4 y; y[0] = w0 * bflo(a0.x) + w1 * bflo(a1.x); y[1] = w0 * bfhi(a0.x) + w1 * bfhi(a1.x); y[2] = w0 * bflo(a0.y) + w1 * bflo(a1.y); y[3] = w0 * bfhi(a0.y) + w1 * bfhi(a1.y);
                v[j] = vv[rr][j] + GA[j] * y; }
            const float rstd = row_rstd(v);
            if (l == 0) {
                store_row_bf(XB + (size_t)m * D, lane, v);
                norm_store_cached(v, rstd, GS, SH, H + (size_t)m * D, lane);
            } else {
                float* xr = a.out + (size_t)m * D;
#pragma unroll
                for (int j = 0; j < 4; ++j) *((f32x4*)xr + lane + 64 * j) = (v[j] * rstd) * GS[j];
            }
        }
    }
}

#define XB_TMO      128
#define XB_XCNT(j)  (256  + 64 * (j))
#define XB_XSUB(j)  (1280 + 64 * (j))
#define XB_XGEN(j)  (2304 + 64 * (j))
#define XB_TOP      3328
#define XB_TOPGEN   3392
#define XCD_BAR_WORDS 3456
#define XB_SPIN_CAP (1u << 22)
__device__ __forceinline__ unsigned xb_ld(unsigned* p)              { return __hip_atomic_load(p, __ATOMIC_RELAXED, __HIP_MEMORY_SCOPE_AGENT); }
__device__ __forceinline__ unsigned xb_add(unsigned* p, unsigned v) { return __hip_atomic_fetch_add(p, v, __ATOMIC_RELAXED, __HIP_MEMORY_SCOPE_AGENT); }
__device__ __forceinline__ unsigned xb_xcc_id() { return (unsigned)__builtin_amdgcn_s_getreg((3 << 11) | 20) & 0xFu; }
#define XB_SPIN(cond, bar) do { unsigned _sp = 0; while (cond) { __builtin_amdgcn_s_sleep(1); \
    if ((++_sp & 255u) == 0u) { if (xb_ld(&(bar)[XB_TMO])) break; if (_sp > XB_SPIN_CAP) { atomicAdd(&(bar)[XB_TMO], 1u); break; } } } } while (0)
struct XcdBarrier { unsigned* bar; unsigned x; volatile LAS unsigned* st; };
__device__ __forceinline__ XcdBarrier xcd_barrier_post(unsigned* bar, volatile LAS unsigned* st) {
    XcdBarrier b; b.bar = bar; b.x = xb_xcc_id(); b.st = st;
    if (threadIdx.x == 0) (void)xb_add(&bar[XB_XCNT(b.x)], 1u);
    return b;
}
__device__ __forceinline__ void xcd_barrier_complete(unsigned* bar, unsigned x, unsigned& nloc, unsigned& nx) {
    const unsigned G = gridDim.x * gridDim.y * gridDim.z;
    unsigned sum, cnt, mine, sp = 0u;
    for (;;) {
        sum = 0u; cnt = 0u; mine = 0u;
#pragma unroll
        for (unsigned j = 0; j < 16; ++j) { const unsigned c = xb_ld(&bar[XB_XCNT(j)]); sum += c; cnt += (c > 0u) ? 1u : 0u; mine = (j == x) ? c : mine; }
        if (sum == G) break;
        __builtin_amdgcn_s_sleep(1);
        if ((++sp & 255u) == 0u) { if (xb_ld(&bar[XB_TMO])) break; if (sp > XB_SPIN_CAP) { atomicAdd(&bar[XB_TMO], 1u); break; } }
    }
    nloc = mine > 0u ? mine : 1u; nx = cnt > 0u ? cnt : 1u;
}
__device__ __forceinline__ void xcd_barrier(const XcdBarrier& b) {
    asm volatile("s_waitcnt vmcnt(0)" ::: "memory");
    __syncthreads();
    if (threadIdx.x == 0) {
        unsigned* bar = b.bar;
        __builtin_amdgcn_s_waitcnt(0);
        unsigned nloc = b.st[0], nx = b.st[1];
        if (nloc == 0u) { xcd_barrier_complete(bar, b.x, nloc, nx); b.st[0] = nloc; b.st[1] = nx; }
        const unsigned old = xb_add(&bar[XB_XSUB(b.x)], 1u);
        const unsigned gen = old / nloc;
        if (old + 1u == (gen + 1u) * nloc) {
            __builtin_amdgcn_fence(__ATOMIC_RELEASE, "agent");
            asm volatile("s_waitcnt vmcnt(0)" ::: "memory");
            const unsigned og = xb_add(&bar[XB_TOP], 1u);
            const unsigned tg = og / nx;
            if (og + 1u == (tg + 1u) * nx) xb_add(&bar[XB_TOPGEN], 1u);
            else XB_SPIN(xb_ld(&bar[XB_TOPGEN]) == tg, bar);
            __builtin_amdgcn_fence(__ATOMIC_ACQUIRE, "agent");
            xb_add(&bar[XB_XGEN(b.x)], 1u);
            asm volatile("s_waitcnt vmcnt(0)" ::: "memory");
        } else {
            XB_SPIN(xb_ld(&bar[XB_XGEN(b.x)]) == gen, bar);
            __builtin_amdgcn_fence(__ATOMIC_ACQUIRE, "agent");
            asm volatile("s_waitcnt vmcnt(0)" ::: "memory");
        }
    }
    __syncthreads();
}

constexpr int NPHASE = 20;
#ifndef DIAG_PH
#define DIAG_PH -1
#endif
#define PH_ON(x) (DIAG_PH < 0 || DIAG_PH == (x))
#ifndef REP_ID
#define REP_ID -1
#endif
__global__ void __launch_bounds__(512, 2) mega(Args a) {
    extern __shared__ __attribute__((aligned(16))) unsigned char lds_raw[];
    LAS unsigned char* lds = (LAS unsigned char*)lds_raw;
    unsigned char* ws = a.ws;
    volatile LAS unsigned* bst = (volatile LAS unsigned*)(lds + MISC_OFF);
    if (threadIdx.x < 2) bst[threadIdx.x] = 0u;
    __syncthreads();
    XcdBarrier xbar = xcd_barrier_post((unsigned*)(ws + WS_CTL) + CW_BAR, bst);
    for (int ph = a.ph_lo; ph < a.ph_hi; ++ph) {
      const int cls_ = ph < 2 ? ph : 2 + (ph - 2) % 9;
      const int nrep_ = (REP_ID >= 0 && cls_ == REP_ID) ? 2 : 1;
      for (int rep_ = 0; rep_ < nrep_; ++rep_) {
        if (rep_) xcd_barrier(xbar);
        if (PH_ON(0) && ph == 0) phase_p0(a, lds);
        else if (PH_ON(1) && ph == 1) phase_norm1_l0(a);
        else {
            const int l = (ph - 2) / 9, sp = (ph - 2) % 9;
            if (PH_ON(2) && sp == 0) {
                g8::DenseSched S; S.init(ws + WS_H, ws + WS_WIN + (size_t)l * NINP * 1024 * 2, MTOT, NINP, 1024, gridDim.x, blockIdx.x);
                g8::EpiBf16 E{(bf16_t*)(ws + WS_COLS), NINP};
                g8::gemm_phase(lds, S, E);
            } else if (PH_ON(3) && sp == 1) phase_chunk(a, l, lds);
            else if (PH_ON(4) && sp == 2) phase_scan(a, l, lds);
            else if (PH_ON(5) && sp == 3) phase_mixer(a, l, lds);
            else if (PH_ON(6) && sp == 4) {
                g8::DenseSched S; S.init(ws + WS_MIX, ws + WS_WOUT + (size_t)l * 1024 * 1024 * 2, l == 1 ? NLAT : MTOT, 1024, 1024, gridDim.x, blockIdx.x);
                g8::EpiBf16 E{(bf16_t*)(ws + WS_Y), 1024};
                g8::gemm_phase(lds, S, E);
            } else if (PH_ON(7) && sp == 5) phase_router(a, l, lds);
            else if ((PH_ON(8) || PH_ON(9)) && (sp == 6 || sp == 7)) {
                const int T = moe_tables(a, l, lds);
                const int G = gridDim.x, bx = blockIdx.x, vcu = (G % 8 == 0) ? (bx % 8) * (G / 8) + bx / 8 : bx;
                const LAS int* TBp = (const LAS int*)(lds + MISC_OFF + 256);
                if (PH_ON(8) && sp == 6) {
                    g8::MoeSched<true> S; S.A = (const char*)(ws + WS_H); S.Bw = (const char*)(ws + WS_WEIN) + (size_t)l * 32 * 1024 * 1024 * 2; S.wstride = (size_t)1024 * 1024 * 2; S.K = 1024; S.T = T; S.G = G; S.c = vcu;
                    S.tile_e = (const LAS int*)(lds + MISC_OFF + 1024); S.tile_mt = S.tile_e + 320; S.cnt = TBp + 64; S.toklist = (const int*)(ws + WS_TOKLIST);
                    g8::EpiSwiGLU E{(bf16_t*)(ws + WS_ACT)};
                    g8::gemm_phase(lds, S, E);
                } else if (PH_ON(9) && sp == 7) {
                    g8::MoeSched<false> S; S.A = (const char*)(ws + WS_ACT); S.Bw = (const char*)(ws + WS_WEOUT) + (size_t)l * 32 * 1024 * 512 * 2; S.wstride = (size_t)1024 * 512 * 2; S.K = 512; S.T = T; S.G = G; S.c = vcu;
                    S.tile_e = (const LAS int*)(lds + MISC_OFF + 1024); S.tile_mt = S.tile_e + 320; S.cnt = TBp + 64; S.toklist = (const int*)(ws + WS_TOKLIST);
                    g8::EpiBf16 E{(bf16_t*)(ws + WS_Y), 1024};
                    g8::gemm_phase(lds, S, E);
                }
            } else if (PH_ON(10) && sp == 8) phase_combine(a, l, lds);
        }
      }
        if (ph + 1 < a.ph_hi) { if (a.ph_lo < 0) cg::this_grid().sync(); else xcd_barrier(xbar); }
    }
}

extern "C" void kernel_launch(void* const* d_in, const int* in_sizes, int n_in, void* d_out, int out_size, void* d_ws, size_t ws_size, hipStream_t stream) {
    static int grid = 0;
    if (grid == 0) {
        if (n_in != 29 || out_size != NLAT * D || ws_size < WS_END) { fprintf(stderr, "kernel_launch: unexpected shapes (n_in %d out %d ws %zu)\n", n_in, out_size, ws_size); grid = -1; return; }
        int dev = 0, cus = 0, per_cu = 0;
        hipGetDevice(&dev); hipDeviceGetAttribute(&cus, hipDeviceAttributeMultiprocessorCount, dev);
        if (hipFuncSetAttribute((const void*)mega, hipFuncAttributeMaxDynamicSharedMemorySize, LDS_BYTES) != hipSuccess) { fprintf(stderr, "kernel_launch: hipFuncSetAttribute failed\n"); grid = -1; return; }
        if (hipOccupancyMaxActiveBlocksPerMultiprocessor(&per_cu, (const void*)mega, 512, LDS_BYTES) != hipSuccess || per_cu < 1) { fprintf(stderr, "kernel_launch: occupancy query says %d\n", per_cu); per_cu = 1; }
        (void)hipGetLastError();
        grid = cus;
    }
    if (grid < 0) return;
    hipMemsetAsync((char*)d_ws + WS_CTL, 0, CTL_BYTES, stream);
    Args a{};
    for (int i = 0; i < 29; ++i) a.in[i] = (const float*)d_in[i];
    a.out = (float*)d_out; a.ws = (unsigned char*)d_ws;
#if MK_MULTI
    for (int ph = 0; ph < NPHASE; ++ph) { a.ph_lo = ph; a.ph_hi = ph + 1; hipLaunchKernelGGL(mega, dim3(grid), dim3(512), LDS_BYTES, stream, a); }
#else
    a.ph_lo = 0; a.ph_hi = NPHASE;
    void* args[] = {&a};
    hipError_t e = hipLaunchCooperativeKernel((const void*)mega, dim3(grid), dim3(512), args, LDS_BYTES, stream);
    if (e != hipSuccess) fprintf(stderr, "cooperative launch failed: %s (grid %d)\n", hipGetErrorString(e), grid);
#endif
}
```

```cpp
#include <hip/hip_runtime.h>
#include <hip/hip_cooperative_groups.h>
#include <cstdio>
namespace cg = cooperative_groups;

#ifndef MK_MULTI
#define MK_MULTI 0
#endif

#ifndef TIME_PH
#define TIME_PH -1
#endif
#ifndef REP_SUB
#define REP_SUB 0
#endif

#define LAS __attribute__((address_space(3)))
typedef unsigned short bf16_t;
typedef short bf16x8 __attribute__((ext_vector_type(8)));
typedef float f32x4 __attribute__((ext_vector_type(4)));
typedef float f32x2 __attribute__((ext_vector_type(2)));
typedef unsigned u32x4 __attribute__((ext_vector_type(4)));
typedef unsigned u32x2 __attribute__((ext_vector_type(2)));
typedef int i32x4 __attribute__((ext_vector_type(4)));

constexpr int D = 1024, NLAT = 32768, SEQ = 8192, NCTXT = 1024, CTXL = 256, MTOT = NLAT + NCTXT;
constexpr int NIN = 2336, NINP = 2560;
constexpr int NCHUNK = MTOT / 64, NSEQ = 132;
constexpr int NEXP = 32, DEXP = 512, SLOTS = 75776;
constexpr float EPS = 1e-6f;
constexpr int C_Q = 0, C_K = 128, C_V = 256, C_G = 512, C_ZF = 768, C_ZB = 784, C_CA = 800, C_CG = 1056, C_SB = 1312, C_SC = 1568, C_SX = 1824, C_PL = 2080;

constexpr size_t MiB = 1u << 20;
constexpr size_t WS_CTL = 0, CTL_BYTES = 1 * MiB;
constexpr size_t WS_MOD = 1 * MiB;
constexpr size_t WS_TAB = 1 * MiB + 512 * 1024;
constexpr size_t WS_PWT = WS_TAB + 64 * 1024;
constexpr size_t WS_BAND = WS_TAB + 192 * 1024;
constexpr size_t WS_WIN = 2 * MiB;
constexpr size_t WS_WOUT = 12 * MiB;
constexpr size_t WS_WEIN = 16 * MiB;
constexpr size_t WS_WEOUT = 144 * MiB;
constexpr size_t WS_XCTX = 208 * MiB;
constexpr size_t WS_H = 212 * MiB;
constexpr size_t WS_COLS = 278 * MiB;
constexpr size_t WS_MIX = 443 * MiB;
constexpr size_t WS_KV = 509 * MiB;
constexpr size_t WS_DEC = 542 * MiB;
constexpr size_t WS_AGV = 543 * MiB;
constexpr size_t WS_CXV = 559 * MiB;
constexpr size_t WS_UV = 575 * MiB;
constexpr size_t WS_SCV = 591 * MiB;
constexpr size_t WS_TOKINFO = 607 * MiB;
constexpr size_t WS_TOKLIST = 608 * MiB;
constexpr size_t WS_ACT = 613 * MiB;
constexpr size_t WS_Y = 687 * MiB;
constexpr size_t WS_SIN = 835 * MiB;
constexpr size_t WS_XB = 852 * MiB;
constexpr size_t WS_END = 918 * MiB;
constexpr int CW_CNT = 1024;
constexpr int CW_BAR = 8192;

constexpr int LDS_BYTES = 147456;
constexpr int MISC_OFF = 131072;

__device__ __forceinline__ unsigned pk2(float lo, float hi) { unsigned r; asm("v_cvt_pk_bf16_f32 %0, %1, %2" : "=v"(r) : "v"(lo), "v"(hi)); return r; }
__device__ __forceinline__ float bflo(unsigned w) { return __uint_as_float(w << 16); }
__device__ __forceinline__ float bfhi(unsigned w) { return __uint_as_float(w & 0xffff0000u); }
__device__ __forceinline__ void unpack8(const u32x4 w, float (&f)[8]) { f[0] = bflo(w.x); f[1] = bfhi(w.x); f[2] = bflo(w.y); f[3] = bfhi(w.y); f[4] = bflo(w.z); f[5] = bfhi(w.z); f[6] = bflo(w.w); f[7] = bfhi(w.w); }
__device__ __forceinline__ float sigmoidf_(float x) { return __builtin_amdgcn_rcpf(1.0f + __expf(-x)); }
__device__ __forceinline__ float siluf_(float x) { return x * __builtin_amdgcn_rcpf(1.0f + __expf(-x)); }
__device__ __forceinline__ float logsigf_(float x) { return fminf(x, 0.0f) - log1pf(__expf(-fabsf(x))); }
__device__ __forceinline__ float wave_sum(float v) {
#pragma unroll
    for (int o = 1; o < 64; o <<= 1) v += __shfl_xor(v, o);
    return v;
}

typedef float f32x16 __attribute__((ext_vector_type(16)));
typedef __bf16 bf16x2_t __attribute__((ext_vector_type(2)));
#define MFMA32(a, b, c) __builtin_amdgcn_mfma_f32_32x32x16_bf16((a), (b), (c), 0, 0, 0)
__device__ __forceinline__ unsigned pk2c(float lo, float hi) { const f32x2 v = {lo, hi}; return __builtin_bit_cast(unsigned, __builtin_convertvector(v, bf16x2_t)); }
__device__ __forceinline__ bf16x8 pack8f(float x0, float x1, float x2, float x3, float x4, float x5, float x6, float x7) {
    u32x4 p; p.x = pk2c(x0, x1); p.y = pk2c(x2, x3); p.z = pk2c(x4, x5); p.w = pk2c(x6, x7); return __builtin_bit_cast(bf16x8, p); }
__device__ __forceinline__ bf16x8 pack_step(const f32x16& x, int s) { return s == 0 ? pack8f(x[0], x[1], x[2], x[3], x[4], x[5], x[6], x[7]) : pack8f(x[8], x[9], x[10], x[11], x[12], x[13], x[14], x[15]); }
__device__ __forceinline__ void split8(const float (&x)[8], bf16x8& hi, bf16x8& lo) {
    u32x4 p; p.x = pk2c(x[0], x[1]); p.y = pk2c(x[2], x[3]); p.z = pk2c(x[4], x[5]); p.w = pk2c(x[6], x[7]);
    hi = __builtin_bit_cast(bf16x8, p);
    lo = pack8f(x[0] - bflo(p.x), x[1] - bfhi(p.x), x[2] - bflo(p.y), x[3] - bfhi(p.y), x[4] - bflo(p.z), x[5] - bfhi(p.z), x[6] - bflo(p.w), x[7] - bfhi(p.w)); }
__device__ __forceinline__ bf16x8 cat44(u32x2 a, u32x2 b) { u32x4 p; p.x = a.x; p.y = a.y; p.z = b.x; p.w = b.y; return __builtin_bit_cast(bf16x8, p); }
#define LDS_WAIT() asm volatile("s_waitcnt lgkmcnt(0)" ::: "memory")
#define PIN(x) asm volatile("" : "+v"(x) :: "memory")
__device__ __forceinline__ int tid_now() { int t = threadIdx.x; asm volatile("" : "+v"(t)); return t; }

namespace g8 {
constexpr int BM = 256, BK = 64, HALF = 128, HTB = HALF * BK * 2, NXCD = 8, WGM = 8;
__device__ __forceinline__ int lds_byte(int r, int c) { const int st = (r >> 4) * 2 + (c >> 5), rr = r & 15, cc = c & 31, ob = rr * 64 + cc * 2; return st * 1024 + (ob ^ (((ob >> 9) & 1) << 5)); }
__device__ __forceinline__ void stage_rc(int b, int& R, int& C) { const int st = b / 1024, sb = b % 1024, swz = sb ^ (((sb >> 9) & 1) << 5); R = (st >> 1) * 16 + swz / 64; C = (st & 1) * 32 + (swz % 64) / 2; }
__device__ __forceinline__ int perm32(int rho) { const int n = rho >> 4, i = rho & 15; return 8 * (i >> 2) + 4 * n + (i & 3); }

struct Unit { int pm, pn, e, mt; };

struct DenseSched {
    const char* A; const char* Bt; int K, nM, nN, nwg, G, c;
    __device__ __forceinline__ void init(const void* A_, const void* Bt_, int M, int N, int K_, int G_, int c_) { A = (const char*)A_; Bt = (const char*)Bt_; K = K_; nM = M / BM; nN = N / BM; nwg = nM * nN; G = G_; c = c_; }
    __device__ __forceinline__ bool next(int i, Unit& u) const {
        const long L = (long)i * G + c; if (L >= nwg) return false;
        int wgid = (int)L; { const int q = nwg / NXCD, r = nwg % NXCD, xcd = wgid % NXCD, off = wgid / NXCD; wgid = (xcd < r ? xcd * (q + 1) : r * (q + 1) + (xcd - r) * q) + off; }
        const int nig = WGM * nN, gid = wgid / nig, fm = gid * WGM, gsz = (nM - fm) < WGM ? (nM - fm) : WGM;
        u.pm = fm + ((wgid % nig) % gsz); u.pn = (wgid % nig) / gsz; u.e = 0; u.mt = 0; return true;
    }
    __device__ __forceinline__ unsigned a_off(const Unit& u, int h, int R, int C) const { return (unsigned)(((u.pm * BM + h * HALF + R) * K + C) * 2); }
    __device__ __forceinline__ const char* b_ptr(const Unit& u) const { return Bt + (size_t)u.pn * BM * K * 2; }
};
template <bool GATHER> struct MoeSched {
    const char* A; const char* Bw; size_t wstride; int K, T, G, c; const LAS int* tile_e; const LAS int* tile_mt; const LAS int* cnt; const int* toklist;
    __device__ __forceinline__ bool next(int i, Unit& u) const {
        const int L = i * G + c; if (L >= 4 * T) return false;
        u.pm = L >> 2; u.pn = L & 3; u.e = __builtin_amdgcn_readfirstlane(tile_e[u.pm]); u.mt = __builtin_amdgcn_readfirstlane(tile_mt[u.pm]); return true;
    }
    __device__ __forceinline__ unsigned a_off(const Unit& u, int h, int R, int C) const {
        if (GATHER) { const int pos = u.mt * BM + h * HALF + R; int tok = 0; if (pos < cnt[u.e]) tok = toklist[u.e * MTOT + pos]; return (unsigned)((tok * K + C) * 2); }
        return (unsigned)(((u.pm * BM + h * HALF + R) * K + C) * 2);
    }
    __device__ __forceinline__ const char* b_ptr(const Unit& u) const { return Bw + (size_t)u.e * wstride + (size_t)u.pn * BM * K * 2; }
};

struct EpiBf16 {
    static constexpr bool PERM = true;
    bf16_t* O; int ldc;
    __device__ __forceinline__ void operator()(const f32x4 (&acc)[2][2][4][2], const Unit& u, int wr, int wc, int fr, int fq) const {
        const int row0 = u.pm * BM + wr * 64 + fr, col0 = u.pn * BM + wc * 32 + 8 * fq;
#pragma unroll
        for (int ai = 0; ai < 2; ++ai)
#pragma unroll
            for (int m = 0; m < 4; ++m) { bf16_t* rowp = O + (size_t)(row0 + ai * HALF + m * 16) * ldc + col0;
#pragma unroll
                for (int bj = 0; bj < 2; ++bj) { const f32x4 v0 = acc[ai][bj][m][0], v1 = acc[ai][bj][m][1];
                    u32x4 w; w.x = pk2(v0[0], v0[1]); w.y = pk2(v0[2], v0[3]); w.z = pk2(v1[0], v1[1]); w.w = pk2(v1[2], v1[3]);
                    *(u32x4*)(rowp + bj * HALF) = w; } }
    }
};
struct EpiFp8 {
    static constexpr bool PERM = true;
    unsigned char* O;
    __device__ __forceinline__ void operator()(const f32x4 (&acc)[2][2][4][2], const Unit& u, int wr, int wc, int fr, int fq) const {
        const int row0 = u.pm * BM + wr * 64 + fr, col0 = u.pn * BM + wc * 32 + 8 * fq;
#pragma unroll
        for (int ai = 0; ai < 2; ++ai)
#pragma unroll
            for (int m = 0; m < 4; ++m) { unsigned char* rowp = O + (size_t)(row0 + ai * HALF + m * 16) * 1024 + col0;
#pragma unroll
                for (int bj = 0; bj < 2; ++bj) { float v[8];
#pragma unroll
                    for (int i = 0; i < 4; ++i) { v[i] = fminf(fmaxf(acc[ai][bj][m][0][i] * 16.0f, -440.0f), 440.0f); v[4 + i] = fminf(fmaxf(acc[ai][bj][m][1][i] * 16.0f, -440.0f), 440.0f); }
                    int w0 = 0, w1 = 0;
                    w0 = __builtin_amdgcn_cvt_pk_fp8_f32(v[0], v[1], w0, false); w0 = __builtin_amdgcn_cvt_pk_fp8_f32(v[2], v[3], w0, true);
                    w1 = __builtin_amdgcn_cvt_pk_fp8_f32(v[4], v[5], w1, false); w1 = __builtin_amdgcn_cvt_pk_fp8_f32(v[6], v[7], w1, true);
                    *(u32x2*)(rowp + bj * HALF) = (u32x2){(unsigned)w0, (unsigned)w1}; } }
    }
};
struct EpiSwiGLU {
    static constexpr bool PERM = true;
    bf16_t* O;
    __device__ __forceinline__ void operator()(const f32x4 (&acc)[2][2][4][2], const Unit& u, int wr, int wc, int fr, int fq) const {
        const int row0 = u.pm * BM + wr * 64 + fr, col0 = u.pn * HALF + wc * 32 + 8 * fq;
#pragma unroll
        for (int ai = 0; ai < 2; ++ai)
#pragma unroll
            for (int m = 0; m < 4; ++m) { bf16_t* rowp = O + (size_t)(row0 + ai * HALF + m * 16) * DEXP + col0;
                const f32x4 g0 = acc[ai][0][m][0], g1 = acc[ai][0][m][1], u0 = acc[ai][1][m][0], u1 = acc[ai][1][m][1];
                u32x4 w; w.x = pk2(siluf_(g0[0]) * u0[0], siluf_(g0[1]) * u0[1]); w.y = pk2(siluf_(g0[2]) * u0[2], siluf_(g0[3]) * u0[3]);
                w.z = pk2(siluf_(g1[0]) * u1[0], siluf_(g1[1]) * u1[1]); w.w = pk2(siluf_(g1[2]) * u1[2], siluf_(g1[3]) * u1[3]);
                *(u32x4*)rowp = w; }
    }
};
template <class Epi, class Sched>
__device__ __forceinline__ void gemm_phase(LAS unsigned char* lds, const Sched& S, const Epi& E) {
    const int tid = tid_now(), wid = __builtin_amdgcn_readfirstlane(tid >> 6), lane = tid & 63, wr = wid >> 2, wc = wid & 3, fr = lane & 15, fq = lane >> 4;
    const int K = S.K, nt = K / BK;
    unsigned voffB[2];
#pragma unroll
    for (int i = 0; i < 2; ++i) { int R, C; stage_rc(tid * 16 + i * 8192, R, C); const int Rb = Epi::PERM ? ((R & ~31) + perm32(R & 31)) : R; voffB[i] = (unsigned)(Rb * K + C) * 2u; }
    const size_t kstep = (size_t)(BK * 2);
    const size_t hstep = (size_t)HALF * K * 2;
    const unsigned ldsw = (unsigned)wid * 1024u;
    const int aoff = lds_byte(wr * 64 + fr, fq * 8), boff = lds_byte(wc * 32 + fr, fq * 8);
#define G8_SA(b, h) (((b) * 2 + (h)) * HTB)
#define G8_SB(b, h) ((4 + (b) * 2 + (h)) * HTB)
#define G8_STAGE(bufoff, gbase, voff) do { const unsigned long long _g = (unsigned long long)(gbase); \
        const char* _gb = (const char*)(((unsigned long long)(unsigned)__builtin_amdgcn_readfirstlane((int)(unsigned)(_g >> 32)) << 32) | (unsigned long long)(unsigned)__builtin_amdgcn_readfirstlane((int)(unsigned)_g)); \
        _Pragma("unroll") for (int _i = 0; _i < 2; ++_i) \
        __builtin_amdgcn_global_load_lds((const unsigned*)(_gb + (voff)[_i]), (LAS unsigned*)(lds + (bufoff) + ldsw + _i * 8192), 16, 0, 0); } while (0)
#define G8_LDA(dst, b, h) do { _Pragma("unroll") for (int m = 0; m < 4; ++m) _Pragma("unroll") for (int k = 0; k < 2; ++k) dst[m][k] = *(const LAS bf16x8*)(lds + G8_SA(b, h) + aoff + m * 2048 + k * 1024); } while (0)
#define G8_LDB(dst, b, h) do { _Pragma("unroll") for (int n = 0; n < 2; ++n) _Pragma("unroll") for (int k = 0; k < 2; ++k) dst[n][k] = *(const LAS bf16x8*)(lds + G8_SB(b, h) + boff + n * 2048 + k * 1024); } while (0)
#define G8_MMA(ai, bj, At, Bt) do { __builtin_amdgcn_s_setprio(1); _Pragma("unroll") for (int m = 0; m < 4; ++m) _Pragma("unroll") for (int n = 0; n < 2; ++n) _Pragma("unroll") for (int k = 0; k < 2; ++k) \
        acc[ai][bj][m][n] = __builtin_amdgcn_mfma_f32_16x16x32_bf16(Bt[n][k], At[m][k], acc[ai][bj][m][n], 0, 0, 0); __builtin_amdgcn_s_setprio(0); } while (0)
#define G8_WAIT_V(n) asm volatile("s_waitcnt vmcnt(" #n ")" ::: "memory")
#define G8_WAIT_L(n) asm volatile("s_waitcnt lgkmcnt(" #n ")" ::: "memory")
#define G8_BAR __builtin_amdgcn_s_barrier()
#define G8_SCHED __builtin_amdgcn_sched_barrier(0)
    Unit cur, nxt; int ui = 0;
    if (!S.next(0, cur)) return;
    f32x4 acc[2][2][4][2];
#pragma unroll
    for (int a = 0; a < 2; ++a)
#pragma unroll
        for (int b = 0; b < 2; ++b)
#pragma unroll
            for (int m = 0; m < 4; ++m)
#pragma unroll
                for (int n = 0; n < 2; ++n) acc[a][b][m][n] = (f32x4){0.f, 0.f, 0.f, 0.f};
    bf16x8 At[4][2], B0[2][2], B1[2][2];
    unsigned vA0[2], vA1[2];
#pragma unroll
    for (int i = 0; i < 2; ++i) { int R, C; stage_rc(tid * 16 + i * 8192, R, C); vA0[i] = S.a_off(cur, 0, R, C); vA1[i] = S.a_off(cur, 1, R, C); }
    const char* const Ab = S.A;
    const char* cB = S.b_ptr(cur);
    G8_STAGE(G8_SB(0, 0), cB, voffB); G8_STAGE(G8_SA(0, 0), Ab, vA0); G8_STAGE(G8_SB(0, 1), cB + hstep, voffB); G8_STAGE(G8_SA(0, 1), Ab, vA1);
    if (wr == 1) G8_BAR;
    G8_WAIT_V(4); G8_BAR;
    G8_STAGE(G8_SB(1, 0), cB + kstep, voffB); G8_STAGE(G8_SA(1, 0), Ab + kstep, vA0); G8_STAGE(G8_SB(1, 1), cB + hstep + kstep, voffB);
    G8_WAIT_V(6); G8_BAR;
    for (;;) {
        const bool has_next = S.next(ui + 1, nxt);
        const char* nB = has_next ? S.b_ptr(nxt) : cB;
        unsigned nA0[2] = {vA0[0], vA0[1]}, nA1[2] = {vA1[0], vA1[1]};
        if (has_next) {
#pragma unroll
            for (int i = 0; i < 2; ++i) { int R, C; stage_rc(tid * 16 + i * 8192, R, C); nA0[i] = S.a_off(nxt, 0, R, C); nA1[i] = S.a_off(nxt, 1, R, C); }
        }
        for (int t = 0; t < nt; t += 2) {
            const bool last = (t == nt - 2);
            const char* a1 = Ab + (size_t)(t + 1) * kstep;
            const char* a2 = last ? Ab : Ab + (size_t)(t + 2) * kstep; const char* b2 = last ? nB : cB + (size_t)(t + 2) * kstep;
            const char* a3 = a2 + kstep; const char* b3 = b2 + kstep;
            G8_LDB(B0, 0, 0); G8_SCHED; G8_LDA(At, 0, 0); G8_STAGE(G8_SA(1, 1), a1, vA1);
            G8_WAIT_L(8); G8_BAR; G8_WAIT_L(0); G8_MMA(0, 0, At, B0); G8_BAR; G8_SCHED;
            if (last) {
#pragma unroll
                for (int i = 0; i < 2; ++i) { vA0[i] = nA0[i]; vA1[i] = nA1[i]; }
            }
            G8_LDB(B1, 0, 1); G8_STAGE(G8_SB(0, 0), b2, voffB);
            G8_BAR; G8_WAIT_L(0); G8_MMA(0, 1, At, B1); G8_BAR;
            G8_LDA(At, 0, 1); G8_STAGE(G8_SA(0, 0), a2, vA0);
            G8_BAR; G8_WAIT_L(0); G8_MMA(1, 0, At, B0); G8_BAR; G8_SCHED;
            G8_STAGE(G8_SB(0, 1), b2 + hstep, voffB);
            G8_WAIT_V(6); G8_BAR; G8_MMA(1, 1, At, B1); G8_BAR;
            G8_LDB(B0, 1, 0); G8_SCHED; G8_LDA(At, 1, 0); G8_STAGE(G8_SA(0, 1), a2, vA1);
            G8_WAIT_L(8); G8_BAR; G8_WAIT_L(0); G8_MMA(0, 0, At, B0); G8_BAR; G8_SCHED;
            G8_LDB(B1, 1, 1); G8_STAGE(G8_SB(1, 0), b3, voffB);
            G8_BAR; G8_WAIT_L(0); G8_MMA(0, 1, At, B1); G8_BAR;
            G8_LDA(At, 1, 1); G8_STAGE(G8_SA(1, 0), a3, vA0);
            G8_BAR; G8_WAIT_L(0); G8_MMA(1, 0, At, B0); G8_BAR; G8_SCHED;
            G8_STAGE(G8_SB(1, 1), b3 + hstep, voffB);
            G8_WAIT_V(6); G8_BAR; G8_MMA(1, 1, At, B1); G8_BAR;
        }
        E(acc, cur, wr, wc, fr, fq);
        if (!has_next) break;
#pragma unroll
        for (int a = 0; a < 2; ++a)
#pragma unroll
            for (int b = 0; b < 2; ++b)
#pragma unroll
                for (int m = 0; m < 4; ++m)
#pragma unroll
                    for (int n = 0; n < 2; ++n) acc[a][b][m][n] = (f32x4){0.f, 0.f, 0.f, 0.f};
        cur = nxt; cB = nB; ++ui;
    }
    G8_WAIT_V(0);
    if (wr == 0) G8_BAR;
    G8_BAR;
#undef G8_SA
#undef G8_SB
#undef G8_STAGE
#undef G8_LDA
#undef G8_LDB
#undef G8_MMA
#undef G8_WAIT_V
#undef G8_WAIT_L
#undef G8_BAR
#undef G8_SCHED
}
}

struct Args { const float* in[29]; float* out; unsigned char* ws; int ph_lo, ph_hi; };
enum { I_X = 0, I_C, I_CTX, I_CCTX, I_WMOD, I_BMOD, I_G1, I_G2, I_WIN, I_GWF, I_GBF, I_GWB, I_GBB, I_GOUT, I_CONFW, I_CONFB, I_CONFG, I_CONFBETA, I_SCW, I_POOLW, I_POOLS, I_WOUT, I_RWG, I_RBG, I_RWE, I_RBE, I_EIN, I_EOUT, I_GFINAL };

__device__ __forceinline__ void transpose_item(const float* W, int K, int N, bf16_t* WT, int kb, int n0, int dst_row0, LAS float* scr, int lane) {
    const int k0 = 64 * kb;
    float wv[32];
#pragma unroll
    for (int i = 0; i < 32; ++i) { const int kk = 2 * i + (lane >> 5); wv[i] = W[(size_t)(k0 + kk) * N + n0 + (lane & 31)]; }
#pragma unroll
    for (int i = 0; i < 32; ++i) PIN(wv[i]);
#pragma unroll
    for (int i = 0; i < 32; ++i) { const int kk = 2 * i + (lane >> 5); scr[kk * 33 + (lane & 31)] = wv[i]; }
    LDS_WAIT(); asm volatile("" ::: "memory");
    const int c = lane & 7;
#pragma unroll
    for (int j = 0; j < 4; ++j) { const int n = (lane >> 3) + 8 * j; const LAS float* s = scr + (8 * c) * 33 + n;
        u32x4 o; o.x = pk2(s[0 * 33], s[1 * 33]); o.y = pk2(s[2 * 33], s[3 * 33]); o.z = pk2(s[4 * 33], s[5 * 33]); o.w = pk2(s[6 * 33], s[7 * 33]);
        *(u32x4*)(WT + (size_t)(dst_row0 + n) * K + k0 + 8 * c) = o; }
    LDS_WAIT(); asm volatile("" ::: "memory");
}

constexpr int CV_SMALL = 3360, CV_E0 = 3360, CV_EI1 = 27936, CV_EO1 = 44320, CV_END = 52512;
constexpr int CV_G = 4480;
constexpr int CV_A = 5184, CV_B = 5760;
constexpr int CV_C = 4096, CV_D = 2048, CV_E = 5184;
constexpr int CV_F = 4096;
constexpr int CV_P0_E0 = (CV_EI1 - CV_E0) - CV_G - CV_A - CV_B, CV_P0_EI1 = (CV_EO1 - CV_EI1) - CV_C - CV_D - CV_E, CV_P0_EO1 = (CV_END - CV_EO1) - CV_F;
__device__ __forceinline__ void convert_item(const Args& a, int idx, LAS float* scr, int lane) {
    unsigned char* ws = a.ws;
    if (idx < CV_SMALL) { const int l = idx / 1680; int r = idx % 1680;
        if (r < 1168) { const int kb = r / 73, nb = r % 73; transpose_item(a.in[I_WIN] + (size_t)l * 1024 * NIN, 1024, NIN, (bf16_t*)(ws + WS_WIN) + (size_t)l * NINP * 1024, kb, nb * 32, nb * 32, scr, lane); }
        else { r -= 1168; const int kb = r / 32, nb = r % 32; transpose_item(a.in[I_WOUT] + (size_t)l * 1024 * 1024, 1024, 1024, (bf16_t*)(ws + WS_WOUT) + (size_t)l * 1024 * 1024, kb, nb * 32, nb * 32, scr, lane); }
        return; }
    int l, r; bool is_in;
    if (idx < CV_EI1) { l = 0; r = idx - CV_E0; is_in = r < 16384; if (!is_in) r -= 16384; }
    else if (idx < CV_EO1) { l = 1; r = idx - CV_EI1; is_in = true; }
    else { l = 1; r = idx - CV_EO1; is_in = false; }
    if (is_in) { const int le = l * 32 + r / 512, q = r % 512, kb = q / 32, n0 = (q % 32) * 32;
        const int dst = n0 < 512 ? (256 * (n0 >> 7) + (n0 & 127)) : (256 * ((n0 - 512) >> 7) + 128 + ((n0 - 512) & 127));
        transpose_item(a.in[I_EIN] + (size_t)le * 1024 * 1024, 1024, 1024, (bf16_t*)(ws + WS_WEIN) + (size_t)le * 1024 * 1024, kb, n0, dst, scr, lane); }
    else { const int le = l * 32 + r / 256, q = r % 256, kb = q / 32, nb = q % 32;
        transpose_item(a.in[I_EOUT] + (size_t)le * 512 * 1024, 512, 1024, (bf16_t*)(ws + WS_WEOUT) + (size_t)le * 1024 * 512, kb, nb * 32, nb * 32, scr, lane); }
}
__device__ __forceinline__ void convert_range(const Args& a, LAS unsigned char* lds, int first, int count, int rank, int nparts) {
    const int tid = tid_now(), lane = tid & 63, wid = __builtin_amdgcn_readfirstlane(tid >> 6);
    LAS float* scr = (LAS float*)(lds + wid * 16384);
    const int per = (count + nparts - 1) / nparts, lo = rank * per, hi = (lo + per < count) ? lo + per : count;
    for (int j = lo + wid; j < hi; j += 8) convert_item(a, first + j, scr, lane);
}
__device__ __forceinline__ void convert_in_tail(const Args& a, LAS unsigned char* lds, int first, int count, int tot_units, int G, int c) {
    const int rem = tot_units % G;
    if (rem == 0) convert_range(a, lds, first, count, c, G);
    else if (c >= rem) convert_range(a, lds, first, count, c - rem, G - rem);
}

__device__ __forceinline__ void phase_p0(const Args& a, LAS unsigned char* lds) {
    const int tid = tid_now(), lane = tid & 63, wid = __builtin_amdgcn_readfirstlane(tid >> 6);
    unsigned char* ws = a.ws;
    for (int job = blockIdx.x; job < 192; job += gridDim.x) {
        const int l = job / 96, n0 = (job % 96) * 64;
        LAS float* sv = (LAS float*)lds;
        LAS float* red = (LAS float*)(lds + 5 * 1024 * 4);
        for (int i = tid; i < 5 * 1024; i += 512) { const int r = i >> 10, k = i & 1023; const float v = r < 4 ? a.in[I_C][r * 1024 + k] : a.in[I_CCTX][k]; sv[i] = siluf_(v); }
        __syncthreads();
        const int ks = tid >> 6, col = tid & 63;
        const float* w = a.in[I_WMOD] + (size_t)l * 1024 * 6144 + (size_t)(ks * 128) * 6144 + n0 + col;
        float acc[5] = {0.f, 0.f, 0.f, 0.f, 0.f};
#pragma unroll 8
        for (int k = 0; k < 128; ++k) { const float wv = w[(size_t)k * 6144];
#pragma unroll
            for (int r = 0; r < 5; ++r) acc[r] += sv[r * 1024 + ks * 128 + k] * wv; }
#pragma unroll
        for (int r = 0; r < 5; ++r) red[(ks * 5 + r) * 64 + col] = acc[r];
        __syncthreads();
        if (tid < 320) { const int r = tid >> 6; float s = 0.f;
#pragma unroll
            for (int q = 0; q < 8; ++q) s += red[(q * 5 + r) * 64 + col];
            ((float*)(ws + WS_MOD))[(size_t)(l * 5 + r) * 6144 + n0 + col] = s + a.in[I_BMOD][l * 6144 + n0 + col]; }
        __syncthreads();
    }
    LAS float* scr = (LAS float*)(lds + wid * 16384);
    const int gw = blockIdx.x * 8 + wid, NGW = gridDim.x * 8;
    constexpr int P0_N0 = CV_E0 + CV_P0_E0, P0_N1 = P0_N0 + CV_P0_EI1, P0_N2 = P0_N1 + CV_P0_EO1;
    for (int j = gw; j < P0_N2; j += NGW) { const int idx = j < P0_N0 ? j : (j < P0_N1 ? CV_EI1 + (j - P0_N0) : CV_EO1 + (j - P0_N1)); convert_item(a, idx, scr, lane); }
    for (int i = blockIdx.x * 512 + tid; i < 2 * 4096; i += gridDim.x * 512) { const int l = i >> 12, g = (i >> 10) & 3, k = i & 1023; ((float*)(ws + WS_TAB))[i] = a.in[I_RWG][l * 4096 + k * 4 + g]; }
    for (int i = blockIdx.x * 512 + tid; i < 2 * 4 * 64 * 64; i += gridDim.x * 512) { const int lg = i >> 12, dd = (i >> 6) & 63, c = i & 63;
        ((bf16_t*)(ws + WS_PWT))[i] = (bf16_t)(pk2(a.in[I_POOLW][(size_t)lg * 4096 + c * 64 + dd], 0.f) & 0xffffu); }
    for (int i = blockIdx.x * 512 + tid; i < 4 * 8 * 64; i += gridDim.x * 512) { const int wi = i >> 9, f = (i >> 6) & 7, ln = i & 63, mt = f >> 2, nt = (f >> 1) & 1, sq = f & 1, rr = ln & 31, hh = ln >> 5, hw = 1 << wi;
        const int t = 32 * nt + rr; int lo = t - hw, hi = t + hw; lo = lo < 0 ? 0 : lo; hi = hi > 64 ? 64 : hi; const int cnt = hi - lo;
        unsigned w4[4];
#pragma unroll
        for (int jp = 0; jp < 4; ++jp) { unsigned wd = 0u;
#pragma unroll
            for (int e = 0; e < 2; ++e) { const int j = 2 * jp + e, tp = 32 * mt + 16 * sq + 8 * (j >> 2) + 4 * hh + (j & 3);
                const int val = ((tp >= lo && tp < hi) ? 1 : 0) - (tp == t ? cnt : 0);
                wd |= (__float_as_uint((float)val) >> 16) << (16 * e); }
            w4[jp] = wd; }
        ((u32x4*)(ws + WS_BAND))[i] = (u32x4){w4[0], w4[1], w4[2], w4[3]}; }
    for (int i = blockIdx.x * 512 + tid; i < 2 * 224 * 1024 / 8; i += gridDim.x * 512) { const int l = i / (224 * 128), q = i % (224 * 128);
        *(u32x4*)((bf16_t*)(ws + WS_WIN) + (size_t)l * NINP * 1024 + (size_t)NIN * 1024 + (size_t)q * 8) = (u32x4){0u, 0u, 0u, 0u}; }
}

__device__ __forceinline__ void load_row(const float* xrow, int lane, f32x4 (&v)[4]) {
    const f32x4* xr = (const f32x4*)xrow + lane;
#pragma unroll
    for (int j = 0; j < 4; ++j) v[j] = xr[64 * j];
}
__device__ __forceinline__ void load_row_bf(const bf16_t* xrow, int lane, f32x4 (&v)[4]) {
#pragma unroll
    for (int j = 0; j < 4; ++j) { const u32x2 w = *((const u32x2*)xrow + lane + 64 * j); v[j] = (f32x4){bflo(w.x), bfhi(w.x), bflo(w.y), bfhi(w.y)}; }
}
__device__ __forceinline__ void store_row_bf(bf16_t* xrow, int lane, const f32x4 (&v)[4]) {
#pragma unroll
    for (int j = 0; j < 4; ++j) { u32x2 w; w.x = pk2(v[j].x, v[j].y); w.y = pk2(v[j].z, v[j].w); *((u32x2*)xrow + lane + 64 * j) = w; }
}
__device__ __forceinline__ float row_rstd(const f32x4 (&v)[4]) {
    float s = 0.f;
#pragma unroll
    for (int j = 0; j < 4; ++j) s += (v[j].x * v[j].x + v[j].y * v[j].y) + (v[j].z * v[j].z + v[j].w * v[j].w);
    return rsqrtf(wave_sum(s) * (1.0f / D) + EPS);
}
__device__ __forceinline__ void norm_mod_store(f32x4 (&v)[4], float rstd, const float* g, const float* sc, const float* sh, bf16_t* hrow, int lane) {
#pragma unroll
    for (int j = 0; j < 4; ++j) { const f32x4 gv = *((const f32x4*)g + lane + 64 * j), scv = *((const f32x4*)sc + lane + 64 * j), shv = *((const f32x4*)sh + lane + 64 * j);
        v[j] = (v[j] * rstd * gv) * (1.0f + scv) + shv;
        u32x2 w; w.x = pk2(v[j].x, v[j].y); w.y = pk2(v[j].z, v[j].w);
        *((u32x2*)hrow + lane + 64 * j) = w; }
}

__device__ __forceinline__ void norm_store_cached(f32x4 (&v)[4], float rstd, const f32x4 (&GS)[4], const f32x4 (&SH)[4], bf16_t* hrow, int lane) {
#pragma unroll
    for (int j = 0; j < 4; ++j) { v[j] = (v[j] * rstd) * GS[j] + SH[j];
        u32x2 w; w.x = pk2(v[j].x, v[j].y); w.y = pk2(v[j].z, v[j].w);
        *((u32x2*)hrow + lane + 64 * j) = w; }
}
__device__ __forceinline__ void load_mod_cached(const float* g, const float* sc, const float* sh, const float* ga, int lane, f32x4 (&GS)[4], f32x4 (&SH)[4], f32x4 (&GA)[4]) {
#pragma unroll
    for (int j = 0; j < 4; ++j) { const f32x4 gv = *((const f32x4*)g + lane + 64 * j), scv = *((const f32x4*)sc + lane + 64 * j);
        GS[j] = gv * (1.0f + scv); SH[j] = *((const f32x4*)sh + lane + 64 * j); GA[j] = *((const f32x4*)ga + lane + 64 * j); }
}

__device__ __forceinline__ void phase_norm1_l0(const Args& a) {
    const int lane = tid_now() & 63, wid = tid_now() >> 6, gw = blockIdx.x * 8 + wid, NGW = gridDim.x * 8;
    const float* MOD = (const float*)(a.ws + WS_MOD); bf16_t* H = (bf16_t*)(a.ws + WS_H);
    int cur_b = -1; f32x4 GS[4], SH[4], GA[4];
#pragma unroll 1
    for (int m = gw; m < MTOT; m += 2 * NGW) {
        const int m2 = m + NGW; const bool has2 = m2 < MTOT; const int m2c = has2 ? m2 : m;
        const float* src = m < NLAT ? a.in[I_X] + (size_t)m * D : a.in[I_CTX] + (size_t)(m - NLAT) * D;
        const float* src2 = m2c < NLAT ? a.in[I_X] + (size_t)m2c * D : a.in[I_CTX] + (size_t)(m2c - NLAT) * D;
        const int b = m < NLAT ? (m >> 13) : 4, b2 = m2c < NLAT ? (m2c >> 13) : 4;
        f32x4 v[4], v2[4]; load_row(src, lane, v); load_row(src2, lane, v2);
        const float rstd = row_rstd(v), rstd2 = row_rstd(v2);
        if (b != cur_b) { const float* mod = MOD + (size_t)b * 6144; load_mod_cached(a.in[I_G1], mod + 1024, mod, mod, lane, GS, SH, GA); cur_b = b; }
        norm_store_cached(v, rstd, GS, SH, H + (size_t)m * D, lane);
        if (has2) { if (b2 != cur_b) { const float* mod = MOD + (size_t)b2 * 6144; load_mod_cached(a.in[I_G1], mod + 1024, mod, mod, lane, GS, SH, GA); cur_b = b2; }
            norm_store_cached(v2, rstd2, GS, SH, H + (size_t)m2 * D, lane); }
    }
}

struct ChunkPos { int b, sf, sb; };
__device__ __forceinline__ ChunkPos chunk_pos(int chunk) {
    ChunkPos p;
    if (chunk < 512) { p.b = chunk >> 7; const int n = chunk & 127; p.sf = 4 + n; p.sb = 4 + 127 - n; }
    else { const int cc = chunk - 512; p.b = cc >> 2; const int n = cc & 3; p.sf = n; p.sb = 3 - n; }
    return p;
}

constexpr int VS = 72;
__device__ __forceinline__ void gla_prep_dir(int dir, int lane, const float (&w)[8], float bias, const bf16x8 (&Az)[2], f32x16 (&BT)[2]) {
    asm volatile("" : "+v"(lane));
    const int r = lane & 31, hf = lane >> 5;
    const f32x16 zero16 = {0.f, 0.f, 0.f, 0.f, 0.f, 0.f, 0.f, 0.f, 0.f, 0.f, 0.f, 0.f, 0.f, 0.f, 0.f, 0.f};
    u32x4 mk[2];
#pragma unroll
    for (int s = 0; s < 2; ++s) { unsigned w4[4];
#pragma unroll
        for (int jp = 0; jp < 4; ++jp) { const int j0 = 2 * jp, j1 = 2 * jp + 1;
            const int t0 = 16 * s + 8 * (j0 >> 2) + 4 * hf + (j0 & 3), t1 = 16 * s + 8 * (j1 >> 2) + 4 * hf + (j1 & 3);
            const bool c0 = dir ? (t0 >= r) : (t0 <= r), c1 = dir ? (t1 >= r) : (t1 <= r);
            w4[jp] = (c0 ? 0x3F80u : 0u) | (c1 ? 0x3F800000u : 0u); }
        mk[s].x = w4[0]; mk[s].y = w4[1]; mk[s].z = w4[2]; mk[s].w = w4[3]; }
    bf16x8 Bhi, Blo; split8(w, Bhi, Blo);
    BT[0] = zero16; BT[1] = zero16;
#pragma unroll 1
    for (int mt = 0; mt < 2; ++mt) {
        const bf16x8 A = mt ? Az[1] : Az[0];
        f32x16 x = MFMA32(A, Bhi, zero16); x = MFMA32(A, Blo, x);
        float la[16];
#pragma unroll
        for (int i = 0; i < 16; ++i) { const float v = x[i] + bias; la[i] = (fminf(v, 0.f) - __logf(1.0f + __expf(-fabsf(v)))) * (1.0f / 16.0f); }
#pragma unroll
        for (int s = 0; s < 2; ++s) {
            const float t8[8] = {la[8 * s], la[8 * s + 1], la[8 * s + 2], la[8 * s + 3], la[8 * s + 4], la[8 * s + 5], la[8 * s + 6], la[8 * s + 7]};
            bf16x8 Lh, Ll; split8(t8, Lh, Ll);
#pragma unroll
            for (int nt = 0; nt < 2; ++nt) {
                const bool full = dir ? (mt > nt) : (mt < nt);
                u32x4 bm; const unsigned fv = full ? 0x3F803F80u : 0u;
                bm.x = (mt == nt) ? mk[s].x : fv; bm.y = (mt == nt) ? mk[s].y : fv; bm.z = (mt == nt) ? mk[s].z : fv; bm.w = (mt == nt) ? mk[s].w : fv;
                const bf16x8 Bm = __builtin_bit_cast(bf16x8, bm);
                BT[nt] = MFMA32(Lh, Bm, BT[nt]); BT[nt] = MFMA32(Ll, Bm, BT[nt]); }
        }
    }
}
__device__ __forceinline__ void gla_gate_loads(const Args& a, int l, int h, int dir, const bf16_t* cols0, int lane, float (&w)[8], float& bias, bf16x8 (&Az)[2]) {
    const int r = lane & 31, hf = lane >> 5;
    const float* wp = a.in[dir ? I_GWB : I_GWF] + (size_t)(l * 16 + 8 * hf) * 128 + 32 * h + r;
#pragma unroll
    for (int j = 0; j < 8; ++j) w[j] = wp[j * 128];
    bias = a.in[dir ? I_GBB : I_GBF][l * 128 + 32 * h + r];
#pragma unroll
    for (int mt = 0; mt < 2; ++mt) Az[mt] = *(const bf16x8*)(cols0 + (size_t)(32 * mt + r) * NINP + C_ZF + 16 * dir + 8 * hf);
}
__device__ __forceinline__ void stage_vT(const bf16_t* cols0, int h, int lane, LAS bf16_t* vT) {
    u32x4 w[8];
#pragma unroll
    for (int q = 0; q < 8; ++q) { const int chunk = lane + 64 * q, t = chunk >> 3, cg = chunk & 7; w[q] = *(const u32x4*)(cols0 + (size_t)t * NINP + C_V + 64 * h + 8 * cg); }
#pragma unroll
    for (int q = 0; q < 8; ++q) PIN(w[q]);
#pragma unroll
    for (int q = 0; q < 8; ++q) { const int chunk = lane + 64 * q, t = chunk >> 3, cg = chunk & 7;
        LAS bf16_t* p = vT + (8 * cg) * VS + t;
        p[0 * VS] = (bf16_t)(w[q].x & 0xffffu); p[1 * VS] = (bf16_t)(w[q].x >> 16); p[2 * VS] = (bf16_t)(w[q].y & 0xffffu); p[3 * VS] = (bf16_t)(w[q].y >> 16);
        p[4 * VS] = (bf16_t)(w[q].z & 0xffffu); p[5 * VS] = (bf16_t)(w[q].z >> 16); p[6 * VS] = (bf16_t)(w[q].w & 0xffffu); p[7 * VS] = (bf16_t)(w[q].w >> 16); }
}
__device__ __forceinline__ void chunk_gla_item(const Args& a, int l, int tile, int h, int lane, LAS bf16_t* vT, LAS bf16_t* kdT) {
    const int r = lane & 31, hf = lane >> 5;
    const bf16_t* cols0 = (const bf16_t*)(a.ws + WS_COLS) + (size_t)tile * 64 * NINP;
    float* KV = (float*)(a.ws + WS_KV); float* DEC = (float*)(a.ws + WS_DEC);
    const ChunkPos cp = chunk_pos(tile);
    const f32x16 zero16 = {0.f, 0.f, 0.f, 0.f, 0.f, 0.f, 0.f, 0.f, 0.f, 0.f, 0.f, 0.f, 0.f, 0.f, 0.f, 0.f};
    stage_vT(cols0, h, lane, vT);
#pragma unroll 1
    for (int dir = 0; dir < 2; ++dir) {
        float gw8[8], gbias; bf16x8 Az[2]; u32x2 kraw[2][4];
        gla_gate_loads(a, l, h, dir, cols0, lane, gw8, gbias, Az);
#pragma unroll
        for (int nt = 0; nt < 2; ++nt)
#pragma unroll
            for (int g = 0; g < 4; ++g) kraw[nt][g] = *(const u32x2*)(cols0 + (size_t)(32 * nt + r) * NINP + C_K + 32 * h + 4 * hf + 8 * g);
#pragma unroll
        for (int j = 0; j < 8; ++j) PIN(gw8[j]);
        PIN(gbias); PIN(Az[0]); PIN(Az[1]);
#pragma unroll
        for (int nt = 0; nt < 2; ++nt)
#pragma unroll
            for (int g = 0; g < 4; ++g) PIN(kraw[nt][g]);
        f32x16 BT[2]; gla_prep_dir(dir, lane, gw8, gbias, Az, BT);
        const size_t e = (size_t)((dir * 4 + cp.b) * 4 + h) * NSEQ + (dir ? cp.sb : cp.sf);
        const int srcl = (dir ? 0 : 31) + 32 * hf;
        float tot[16];
#pragma unroll
        for (int i = 0; i < 16; ++i) tot[i] = __shfl(dir ? BT[0][i] : BT[1][i], srcl);
        if (r == (dir ? 0 : 31)) {
#pragma unroll
            for (int i = 0; i < 16; ++i) DEC[e * 32 + (i & 3) + 8 * (i >> 2) + 4 * hf] = __expf(tot[i]);
        }
#pragma unroll
        for (int nt = 0; nt < 2; ++nt) {
#pragma unroll
            for (int g = 0; g < 4; ++g) { const u32x2 kw = kraw[nt][g];
                const float kf[4] = {bflo(kw.x), bfhi(kw.x), bflo(kw.y), bfhi(kw.y)};
#pragma unroll
                for (int q = 0; q < 4; ++q) { const int i = 4 * g + q; const float kd = kf[q] * __expf(tot[i] - BT[nt][i]);
                    kdT[(8 * g + 4 * hf + q) * VS + 32 * nt + r] = (bf16_t)(pk2c(kd, 0.f) & 0xffffu); } }
        }
        LDS_WAIT(); asm volatile("" ::: "memory");
#pragma unroll 1
        for (int ct = 0; ct < 2; ++ct) {
            f32x16 acc = zero16;
#pragma unroll
            for (int ks = 0; ks < 4; ++ks) {
                const bf16x8 A = *(const LAS bf16x8*)(vT + (32 * ct + r) * VS + 16 * ks + 8 * hf);
                const bf16x8 B = *(const LAS bf16x8*)(kdT + r * VS + 16 * ks + 8 * hf);
                acc = MFMA32(A, B, acc); }
            float* dst = KV + e * 2048 + (size_t)(32 * ct + 4 * hf) * 32 + r;
#pragma unroll
            for (int i = 0; i < 16; ++i) dst[((i & 3) + 8 * (i >> 2)) * 32] = acc[i];
        }
        LDS_WAIT(); asm volatile("" ::: "memory");
    }
}
__device__ __forceinline__ void chunk_agv_item(const Args& a, int row0, int lane) {
    const bf16_t* COLS = (const bf16_t*)(a.ws + WS_COLS); float* AGV = (float*)(a.ws + WS_AGV); float* CXV = (float*)(a.ws + WS_CXV);
    const int t = lane >> 3;
#pragma unroll
    for (int rep = 0; rep < 2; ++rep) { const int c8 = ((lane & 7) + 8 * rep) * 8; const bf16_t* rp = COLS + (size_t)(row0 + t) * NINP;
        float fa[8], fg[8], fc[8], fx[8];
        unpack8(*(const u32x4*)(rp + C_CA + 128 + c8), fa); unpack8(*(const u32x4*)(rp + C_CG + 128 + c8), fg);
        unpack8(*(const u32x4*)(rp + C_SC + 128 + c8), fc); unpack8(*(const u32x4*)(rp + C_SX + 128 + c8), fx);
        f32x4 o0, o1, p0, p1;
#pragma unroll
        for (int i = 0; i < 4; ++i) { o0[i] = fa[i] * sigmoidf_(fg[i]); o1[i] = fa[4 + i] * sigmoidf_(fg[4 + i]); p0[i] = fc[i] * fx[i]; p1[i] = fc[4 + i] * fx[4 + i]; }
        float* ao = AGV + (size_t)(row0 + t) * 128 + c8; float* co = CXV + (size_t)(row0 + t) * 128 + c8;
        *(f32x4*)ao = o0; *(f32x4*)(ao + 4) = o1; *(f32x4*)co = p0; *(f32x4*)(co + 4) = p1; }
}
__device__ __forceinline__ int next_item(LAS int* ctr, int lane) {
    int j = 0; if (lane == 0) j = __hip_atomic_fetch_add(ctr, 1, __ATOMIC_RELAXED, __HIP_MEMORY_SCOPE_WORKGROUP);
    return __builtin_amdgcn_readfirstlane(j);
}
__device__ __forceinline__ void phase_chunk(const Args& a, int l, LAS unsigned char* lds) {
    const int tid = tid_now(), lane = tid & 63, wid = __builtin_amdgcn_readfirstlane(tid >> 6);
    LAS bf16_t* vT = (LAS bf16_t*)(lds + wid * 16384); LAS bf16_t* kdT = vT + 64 * VS;
    LAS int* ctr = (LAS int*)(lds + MISC_OFF + 16);
    if (tid == 0) *ctr = 0;
    __syncthreads();
    const int b = blockIdx.x, G = gridDim.x, nT = b < NCHUNK ? (NCHUNK - 1 - b) / G + 1 : 0, nL = b < 512 ? (511 - b) / G + 1 : 0;
    for (;;) { int j = next_item(ctr, lane);
        if (j < 4 * nT) { chunk_gla_item(a, l, b + G * (j >> 2), j & 3, lane, vT, kdT); continue; }
        j -= 4 * nT; if (j >= 8 * nL) break;
        chunk_agv_item(a, (b + G * (j >> 3)) * 64 + (j & 7) * 8, lane);
    }
}
__device__ __forceinline__ void mixer_gla_item(const Args& a, int l, int tile, int h, int lane, LAS bf16_t* vT) {
    const bf16_t* cols0 = (const bf16_t*)(a.ws + WS_COLS) + (size_t)tile * 64 * NINP;
    const bf16_t* SIN = (const bf16_t*)(a.ws + WS_SIN); bf16_t* MIX = (bf16_t*)(a.ws + WS_MIX);
    const ChunkPos cp = chunk_pos(tile);
    const f32x16 zero16 = {0.f, 0.f, 0.f, 0.f, 0.f, 0.f, 0.f, 0.f, 0.f, 0.f, 0.f, 0.f, 0.f, 0.f, 0.f, 0.f};
    stage_vT(cols0, h, lane, vT);
    LDS_WAIT(); asm volatile("" ::: "memory");
    f32x16 OT[2][2] = {{zero16, zero16}, {zero16, zero16}};
#pragma unroll 1
    for (int dir = 0; dir < 2; ++dir) {
        int ln = lane; asm volatile("" : "+v"(ln)); const int r = ln & 31, hf = ln >> 5;
        bf16x8 QD[2][2], KI[2][2];
        const bf16_t* st = SIN + ((size_t)((dir * 4 + cp.b) * 4 + h) * NSEQ + (dir ? cp.sb : cp.sf)) * 2048;
        u32x2 sraw[2][2][2];
        { float gw8[8], gbias; bf16x8 Az[2]; u32x2 qraw[2][4], kraw[2][4];
            gla_gate_loads(a, l, h, dir, cols0, ln, gw8, gbias, Az);
#pragma unroll
            for (int nt = 0; nt < 2; ++nt)
#pragma unroll
                for (int g = 0; g < 4; ++g) { const bf16_t* qp = cols0 + (size_t)(32 * nt + r) * NINP + C_Q + 32 * h + 4 * hf + 8 * g; qraw[nt][g] = *(const u32x2*)qp; kraw[nt][g] = *(const u32x2*)(qp + (C_K - C_Q)); }
#pragma unroll
            for (int ct = 0; ct < 2; ++ct)
#pragma unroll
                for (int s = 0; s < 2; ++s) { const size_t off = (size_t)(32 * ct + r) * 32 + 16 * s + 4 * hf; sraw[ct][s][0] = *(const u32x2*)(st + off); sraw[ct][s][1] = *(const u32x2*)(st + off + 8); }
#pragma unroll
            for (int j = 0; j < 8; ++j) PIN(gw8[j]);
            PIN(gbias); PIN(Az[0]); PIN(Az[1]);
#pragma unroll
            for (int nt = 0; nt < 2; ++nt)
#pragma unroll
                for (int g = 0; g < 4; ++g) { PIN(qraw[nt][g]); PIN(kraw[nt][g]); }
#pragma unroll
            for (int ct = 0; ct < 2; ++ct)
#pragma unroll
                for (int s = 0; s < 2; ++s) { PIN(sraw[ct][s][0]); PIN(sraw[ct][s][1]); }
            f32x16 BT[2]; gla_prep_dir(dir, ln, gw8, gbias, Az, BT);
#pragma unroll
            for (int nt = 0; nt < 2; ++nt) {
                float qd[16], ki[16];
#pragma unroll
                for (int g = 0; g < 4; ++g) { const u32x2 qw = qraw[nt][g], kw = kraw[nt][g];
                    const float qf[4] = {bflo(qw.x), bfhi(qw.x), bflo(qw.y), bfhi(qw.y)}, kf[4] = {bflo(kw.x), bfhi(kw.x), bflo(kw.y), bfhi(kw.y)};
#pragma unroll
                    for (int q = 0; q < 4; ++q) { const float bb = BT[nt][4 * g + q]; qd[4 * g + q] = qf[q] * 0.17677669529663687f * __expf(bb); ki[4 * g + q] = kf[q] * __expf(-bb); } }
#pragma unroll
                for (int s = 0; s < 2; ++s) { QD[nt][s] = pack8f(qd[8 * s], qd[8 * s + 1], qd[8 * s + 2], qd[8 * s + 3], qd[8 * s + 4], qd[8 * s + 5], qd[8 * s + 6], qd[8 * s + 7]);
                    KI[nt][s] = pack8f(ki[8 * s], ki[8 * s + 1], ki[8 * s + 2], ki[8 * s + 3], ki[8 * s + 4], ki[8 * s + 5], ki[8 * s + 6], ki[8 * s + 7]); }
            }
        }
#pragma unroll
        for (int jt = 0; jt < 2; ++jt)
#pragma unroll
            for (int it = 0; it < 2; ++it) {
                if (jt != it) { const bool keep = dir ? (jt > it) : (jt < it); if (!keep) continue; }
                f32x16 p = MFMA32(KI[jt][0], QD[it][0], zero16); p = MFMA32(KI[jt][1], QD[it][1], p);
                if (jt == it) {
#pragma unroll
                    for (int i = 0; i < 16; ++i) { const int jj = (i & 3) + 8 * (i >> 2) + 4 * hf; const bool kp_ = dir ? (jj >= r) : (jj <= r); p[i] = kp_ ? p[i] : 0.f; }
                }
                const bf16x8 P0 = pack_step(p, 0), P1 = pack_step(p, 1);
#pragma unroll
                for (int ct = 0; ct < 2; ++ct) {
                    const LAS bf16_t* vp = vT + (32 * ct + r) * VS + 32 * jt + 4 * hf;
                    const bf16x8 A0 = cat44(*(const LAS u32x2*)vp, *(const LAS u32x2*)(vp + 8)), A1 = cat44(*(const LAS u32x2*)(vp + 16), *(const LAS u32x2*)(vp + 24));
                    OT[ct][it] = MFMA32(A0, P0, OT[ct][it]); OT[ct][it] = MFMA32(A1, P1, OT[ct][it]); }
            }
#pragma unroll
        for (int ct = 0; ct < 2; ++ct)
#pragma unroll
            for (int s = 0; s < 2; ++s) {
                const bf16x8 As = cat44(sraw[ct][s][0], sraw[ct][s][1]);
                OT[ct][0] = MFMA32(As, QD[0][s], OT[ct][0]); OT[ct][1] = MFMA32(As, QD[1][s], OT[ct][1]); }
    }
    int ln2 = lane; asm volatile("" : "+v"(ln2)); const int r = ln2 & 31, hf = ln2 >> 5;
    u32x2 graw[2][2][4]; f32x4 gor[2][4];
#pragma unroll
    for (int ct = 0; ct < 2; ++ct)
#pragma unroll
        for (int g = 0; g < 4; ++g) { const int c0 = 32 * ct + 8 * g + 4 * hf; gor[ct][g] = *(const f32x4*)(a.in[I_GOUT] + l * 256 + 64 * h + c0);
#pragma unroll
            for (int it = 0; it < 2; ++it) graw[it][ct][g] = *(const u32x2*)(cols0 + (size_t)(32 * it + r) * NINP + C_G + 64 * h + c0); }
#pragma unroll
    for (int ct = 0; ct < 2; ++ct)
#pragma unroll
        for (int g = 0; g < 4; ++g) { PIN(gor[ct][g]); PIN(graw[0][ct][g]); PIN(graw[1][ct][g]); }
#pragma unroll
    for (int it = 0; it < 2; ++it) {
        float ss = 0.f;
#pragma unroll
        for (int ct = 0; ct < 2; ++ct)
#pragma unroll
            for (int i = 0; i < 16; ++i) ss += OT[ct][it][i] * OT[ct][it][i];
        ss += __shfl_xor(ss, 32);
        const float rs = rsqrtf(ss * (1.0f / 64.0f) + EPS);
        const int t = 32 * it + r;
#pragma unroll
        for (int ct = 0; ct < 2; ++ct)
#pragma unroll
            for (int g = 0; g < 4; ++g) { const int c0 = 32 * ct + 8 * g + 4 * hf;
                const u32x2 gw_ = graw[it][ct][g];
                const f32x4 go = gor[ct][g];
                const float o0 = OT[ct][it][4 * g] * rs * go[0] * siluf_(bflo(gw_.x)), o1 = OT[ct][it][4 * g + 1] * rs * go[1] * siluf_(bfhi(gw_.x));
                const float o2 = OT[ct][it][4 * g + 2] * rs * go[2] * siluf_(bflo(gw_.y)), o3 = OT[ct][it][4 * g + 3] * rs * go[3] * siluf_(bfhi(gw_.y));
                u32x2 w; w.x = pk2c(o0, o1); w.y = pk2c(o2, o3);
                *(u32x2*)(MIX + (size_t)(tile * 64 + t) * D + 64 * h + c0) = w; }
    }
    LDS_WAIT(); asm volatile("" ::: "memory");
}
template <int TAPS>
__device__ __forceinline__ void vconv_item(const float* SRC, float* DST, const float* w  , int b, int col, int chg, LAS float* buf, int lane) {
    const int ch = lane & 31, rh = lane >> 5;
    const size_t base = ((size_t)b * SEQ + col) * 128 + chg * 32 + ch;
#pragma unroll 8
    for (int r = 0; r < 128; r += 2) buf[(r + rh) * 32 + ch] = SRC[base + (size_t)(r + rh) * 64 * 128];
    float wt[TAPS];
#pragma unroll
    for (int j = 0; j < TAPS; ++j) wt[j] = w[j * 256 + chg * 32 + ch];
    LDS_WAIT(); asm volatile("" ::: "memory");
    constexpr int HW = TAPS / 2;
#pragma unroll 1
    for (int r0 = 0; r0 < 64; r0 += 8) {
        const int rb = rh * 64 + r0;
        float o[8] = {0.f, 0.f, 0.f, 0.f, 0.f, 0.f, 0.f, 0.f};
#pragma unroll
        for (int j = 0; j < TAPS + 7; ++j) { const int rin = rb - HW + j; const float x = (rin >= 0 && rin < 128) ? buf[rin * 32 + ch] : 0.f;
#pragma unroll
            for (int q = 0; q < 8; ++q) { if (j - q >= 0 && j - q < TAPS) o[q] += x * wt[j - q]; } }
#pragma unroll
        for (int q = 0; q < 8; ++q) DST[base + (size_t)(rb + q) * 64 * 128] = o[q];
    }
    LDS_WAIT(); asm volatile("" ::: "memory");
}
__device__ __forceinline__ void phase_scan(const Args& a, int l, LAS unsigned char* lds) {
    const int tid = tid_now(), lane = tid & 63, wid = __builtin_amdgcn_readfirstlane(tid >> 6);
    const float* KV = (const float*)(a.ws + WS_KV); const float* DEC = (const float*)(a.ws + WS_DEC); bf16_t* SIN = (bf16_t*)(a.ws + WS_SIN);
    if (tid < 256) {
        for (int rp = 0; rp < ((REP_SUB == 5 && l == 0) ? 2 : 1); ++rp)
        for (int gid = blockIdx.x * 256 + tid; gid < 65536; gid += gridDim.x * 256) {
            const int e = gid >> 11, idx = gid & 2047;
            const float* p = KV + (size_t)e * NSEQ * 2048 + idx; const float* dp = DEC + (size_t)e * NSEQ * 32 + (idx & 31); bf16_t* q = SIN + (size_t)e * NSEQ * 2048 + idx;
            float st = 0.f;
#pragma unroll 1
            for (int s0 = 0; s0 < NSEQ; s0 += 22) {
                float kv[22], dd[22];
#pragma unroll
                for (int u = 0; u < 22; ++u) { kv[u] = p[(size_t)(s0 + u) * 2048]; dd[u] = dp[(s0 + u) * 32]; }
#pragma unroll
                for (int u = 0; u < 22; ++u) { PIN(kv[u]); PIN(dd[u]); }
#pragma unroll
                for (int u = 0; u < 22; ++u) { q[(size_t)(s0 + u) * 2048] = (bf16_t)(pk2c(st, 0.f) & 0xffffu); st = dd[u] * st + kv[u]; }
            }
        }
    }
    LAS float* buf = (LAS float*)(lds + wid * 16384);
    const int gw = blockIdx.x * 8 + wid, NGW = gridDim.x * 8;
    for (int rp = 0; rp < ((REP_SUB == 6 && l == 0) ? 2 : 1); ++rp)
    for (int it = gw; it < 2048; it += NGW) {
        const int kind = it >> 10, q = it & 1023, b = q >> 8, col = (q >> 2) & 63, chg = q & 3;
        if (kind == 0) vconv_item<31>((const float*)(a.ws + WS_AGV), (float*)(a.ws + WS_UV), a.in[I_CONFW] + (size_t)l * 31 * 256 + 128, b, col, chg, buf, lane);
        else vconv_item<3>((const float*)(a.ws + WS_CXV), (float*)(a.ws + WS_SCV), a.in[I_SCW] + (size_t)l * 3 * 256 + 128, b, col, chg, buf, lane);
    }
}

__device__ __forceinline__ void mixer_conv_item(const Args& a, int l, int tile, int tg, int lane0, LAS float* U) {
    const bf16_t* COLS = (const bf16_t*)(a.ws + WS_COLS); bf16_t* MIX = (bf16_t*)(a.ws + WS_MIX);
    const int row0 = tile * 64, T0 = 16 * tg;
    const float* confw = a.in[I_CONFW] + (size_t)l * 31 * 256; const float* scw = a.in[I_SCW] + (size_t)l * 3 * 256;
#pragma unroll 1
    for (int p = 0; p < 2; ++p) {
        int lane = lane0; asm volatile("" : "+v"(lane));
        const int c = 64 * p + lane;
        float wv[31];
#pragma unroll
        for (int j = 0; j < 31; ++j) wv[j] = confw[j * 256 + c];
        float bias = a.in[I_CONFB][l * 256 + c];
        unsigned ra[46], rg[46];
#pragma unroll
        for (int i = 0; i < 46; ++i) { const int t = T0 - 15 + i, tc = t < 0 ? 0 : (t > 63 ? 63 : t); const bf16_t* rp = COLS + (size_t)(row0 + tc) * NINP + c; ra[i] = rp[C_CA]; rg[i] = rp[C_CG]; }
#pragma unroll
        for (int j = 0; j < 31; ++j) PIN(wv[j]);
        PIN(bias);
#pragma unroll
        for (int i = 0; i < 46; ++i) { PIN(ra[i]); PIN(rg[i]); }
        float ag[46];
#pragma unroll
        for (int i = 0; i < 46; ++i) { const int t = T0 - 15 + i; const float m = (t >= 0 && t < 64) ? 1.0f : 0.0f;
            ag[i] = m * __uint_as_float(ra[i] << 16) * __builtin_amdgcn_rcpf(1.0f + __expf(-__uint_as_float(rg[i] << 16))); }
#pragma unroll
        for (int q = 0; q < 16; ++q) { float o = bias;
#pragma unroll
            for (int j = 0; j < 31; ++j) o += ag[q + j] * wv[j];
            U[q * 256 + ((((c >> 2) ^ q) << 2) | (c & 3))] = o; }
        unsigned rc[18], rx[18], rsb[16];
        float w0 = scw[c], w1 = scw[256 + c], w2 = scw[512 + c];
#pragma unroll
        for (int i = 0; i < 18; ++i) { const int t = T0 - 1 + i, tc = t < 0 ? 0 : (t > 63 ? 63 : t); const bf16_t* rp = COLS + (size_t)(row0 + tc) * NINP + c; rc[i] = rp[C_SC]; rx[i] = rp[C_SX]; }
#pragma unroll
        for (int q = 0; q < 16; ++q) rsb[q] = COLS[(size_t)(row0 + T0 + q) * NINP + C_SB + c];
        PIN(w0); PIN(w1); PIN(w2);
#pragma unroll
        for (int i = 0; i < 18; ++i) { PIN(rc[i]); PIN(rx[i]); }
#pragma unroll
        for (int q = 0; q < 16; ++q) PIN(rsb[q]);
        float cx[18];
#pragma unroll
        for (int i = 0; i < 18; ++i) { const int t = T0 - 1 + i; const float m = (t >= 0 && t < 64) ? 1.0f : 0.0f; cx[i] = m * __uint_as_float(rc[i] << 16) * __uint_as_float(rx[i] << 16); }
#pragma unroll
        for (int q = 0; q < 16; ++q) { const float cv = cx[q] * w0 + cx[q + 1] * w1 + cx[q + 2] * w2;
            MIX[(size_t)(row0 + T0 + q) * D + 512 + c] = (bf16_t)(pk2c(__uint_as_float(rsb[q] << 16) * cv, 0.f) & 0xffffu); }
    }
    {
        int lane = lane0; asm volatile("" : "+v"(lane));
        const float* UV = (const float*)(a.ws + WS_UV); const float* SCV = (const float*)(a.ws + WS_SCV);
        f32x4 uu[8], svv[8], bzz[8]; u32x2 sbb[8];
#pragma unroll
        for (int k8 = 0; k8 < 8; ++k8) { const int idx = lane + 64 * k8, t = idx >> 5, c4 = (idx & 31) * 4; const size_t row = (size_t)(row0 + T0 + t);
            uu[k8] = *(const f32x4*)(UV + row * 128 + c4); bzz[k8] = *(const f32x4*)(a.in[I_CONFB] + l * 256 + 128 + c4);
            svv[k8] = *(const f32x4*)(SCV + row * 128 + c4); sbb[k8] = *(const u32x2*)(COLS + row * NINP + C_SB + 128 + c4); }
#pragma unroll
        for (int k8 = 0; k8 < 8; ++k8) { PIN(uu[k8]); PIN(bzz[k8]); PIN(svv[k8]); PIN(sbb[k8]); }
#pragma unroll
        for (int k8 = 0; k8 < 8; ++k8) { const int idx = lane + 64 * k8, t = idx >> 5, c4 = (idx & 31) * 4; const size_t row = (size_t)(row0 + T0 + t);
            *(LAS f32x4*)(U + t * 256 + ((((128 + c4) >> 2) ^ t) << 2)) = uu[k8] + bzz[k8];
            u32x2 w; w.x = pk2c(bflo(sbb[k8].x) * svv[k8][0], bfhi(sbb[k8].x) * svv[k8][1]); w.y = pk2c(bflo(sbb[k8].y) * svv[k8][2], bfhi(sbb[k8].y) * svv[k8][3]);
            *(u32x2*)(MIX + row * D + 512 + 128 + c4) = w; }
    }
    LDS_WAIT(); asm volatile("" ::: "memory");
    {
        int lane = lane0; asm volatile("" : "+v"(lane));
        const int t = lane >> 2, qd = lane & 3;
        f32x4 lgv[16], lbv[16];
        { const float* lg = a.in[I_CONFG] + l * 256 + 64 * qd; const float* lb = a.in[I_CONFBETA] + l * 256 + 64 * qd;
#pragma unroll
            for (int i = 0; i < 16; ++i) { lgv[i] = *(const f32x4*)(lg + 4 * i); lbv[i] = *(const f32x4*)(lb + 4 * i); }
#pragma unroll
            for (int i = 0; i < 16; ++i) { PIN(lgv[i]); PIN(lbv[i]); } }
        f32x4 v[16]; float s1 = 0.f;
#pragma unroll
        for (int i = 0; i < 16; ++i) { v[i] = *(const LAS f32x4*)(U + t * 256 + (((16 * qd + i) ^ t) << 2)); s1 += (v[i][0] + v[i][1]) + (v[i][2] + v[i][3]); }
        s1 += __shfl_xor(s1, 1); s1 += __shfl_xor(s1, 2);
        const float mean = s1 * (1.0f / 256.0f); float s2 = 0.f;
#pragma unroll
        for (int i = 0; i < 16; ++i) { v[i] = v[i] - mean; s2 += (v[i][0] * v[i][0] + v[i][1] * v[i][1]) + (v[i][2] * v[i][2] + v[i][3] * v[i][3]); }
        s2 += __shfl_xor(s2, 1); s2 += __shfl_xor(s2, 2);
        const float rstd = rsqrtf(s2 * (1.0f / 256.0f) + EPS);
        bf16_t* dst = MIX + (size_t)(row0 + T0 + t) * D + 256 + 64 * qd;
#pragma unroll
        for (int i = 0; i < 16; i += 2) { const f32x4 g0 = lgv[i], g1 = lgv[i + 1], b0 = lbv[i], b1 = lbv[i + 1];
            const f32x4 y0 = v[i] * rstd * g0 + b0, y1 = v[i + 1] * rstd * g1 + b1;
            u32x4 w; w.x = pk2c(siluf_(y0[0]), siluf_(y0[1])); w.y = pk2c(siluf_(y0[2]), siluf_(y0[3])); w.z = pk2c(siluf_(y1[0]), siluf_(y1[1])); w.w = pk2c(siluf_(y1[2]), siluf_(y1[3]));
            *(u32x4*)(dst + 4 * i) = w; }
    }
    LDS_WAIT(); asm volatile("" ::: "memory");
}
__device__ __forceinline__ void mixer_pool_item(const Args& a, int l, int tile, int g, int lane0) {
    const bf16_t* COLS = (const bf16_t*)(a.ws + WS_COLS); bf16_t* MIX = (bf16_t*)(a.ws + WS_MIX);
    const f32x16 zero16 = {0.f, 0.f, 0.f, 0.f, 0.f, 0.f, 0.f, 0.f, 0.f, 0.f, 0.f, 0.f, 0.f, 0.f, 0.f, 0.f};
    const int row0 = tile * 64;
    {
        int lane = lane0; asm volatile("" : "+v"(lane));
        const int r = lane & 31, hf = lane >> 5, hw = 1 << g;
        const bf16_t* pwt = (const bf16_t*)(a.ws + WS_PWT) + (size_t)(l * 4 + g) * 4096;
        const u32x4* band = (const u32x4*)(a.ws + WS_BAND) + (size_t)g * 512 + lane;
        f32x16 Y[2][2] = {{zero16, zero16}, {zero16, zero16}};
        bf16x8 Ax[2][4], Bw[2][4]; u32x4 Bb[8];
#pragma unroll
        for (int mt = 0; mt < 2; ++mt)
#pragma unroll
            for (int ks = 0; ks < 4; ++ks) { Ax[mt][ks] = *(const bf16x8*)(COLS + (size_t)(row0 + 32 * mt + r) * NINP + C_PL + 64 * g + 16 * ks + 8 * hf);
                Bw[mt][ks] = *(const bf16x8*)(pwt + (size_t)(32 * mt + r) * 64 + 16 * ks + 8 * hf); }
#pragma unroll
        for (int f = 0; f < 8; ++f) Bb[f] = band[f * 64];
        f32x4 psv[2][4];
#pragma unroll
        for (int ntd = 0; ntd < 2; ++ntd)
#pragma unroll
            for (int q = 0; q < 4; ++q) psv[ntd][q] = *(const f32x4*)(a.in[I_POOLS] + l * 256 + 64 * g + 32 * ntd + 8 * q + 4 * hf);
#pragma unroll
        for (int mt = 0; mt < 2; ++mt)
#pragma unroll
            for (int ks = 0; ks < 4; ++ks) { PIN(Ax[mt][ks]); PIN(Bw[mt][ks]); }
#pragma unroll
        for (int f = 0; f < 8; ++f) PIN(Bb[f]);
#pragma unroll
        for (int ntd = 0; ntd < 2; ++ntd)
#pragma unroll
            for (int q = 0; q < 4; ++q) PIN(psv[ntd][q]);
#pragma unroll
        for (int mt = 0; mt < 2; ++mt) {
#pragma unroll
            for (int ntd = 0; ntd < 2; ++ntd) {
                f32x16 z = zero16;
#pragma unroll
                for (int ks = 0; ks < 4; ++ks) z = MFMA32(Ax[mt][ks], Bw[ntd][ks], z);
#pragma unroll
                for (int sq = 0; sq < 2; ++sq) {
                    const float t8[8] = {z[8 * sq], z[8 * sq + 1], z[8 * sq + 2], z[8 * sq + 3], z[8 * sq + 4], z[8 * sq + 5], z[8 * sq + 6], z[8 * sq + 7]};
                    bf16x8 Zh, Zl; split8(t8, Zh, Zl);
#pragma unroll
                    for (int ntt = 0; ntt < 2; ++ntt) { const bf16x8 Bq = __builtin_bit_cast(bf16x8, Bb[(mt * 2 + ntt) * 2 + sq]);
                        Y[ntd][ntt] = MFMA32(Zh, Bq, Y[ntd][ntt]); Y[ntd][ntt] = MFMA32(Zl, Bq, Y[ntd][ntt]); }
                }
            }
        }
#pragma unroll
        for (int ntt = 0; ntt < 2; ++ntt) { const int t = 32 * ntt + r; int lo = t - hw, hi = t + hw; lo = lo < 0 ? 0 : lo; hi = hi > 64 ? 64 : hi; const float inv = 1.0f / (float)(hi - lo);
#pragma unroll
            for (int ntd = 0; ntd < 2; ++ntd)
#pragma unroll
                for (int q = 0; q < 4; ++q) { const int dd0 = 32 * ntd + 8 * q + 4 * hf; const f32x4 ps = psv[ntd][q];
                    u32x2 w; w.x = pk2c(Y[ntd][ntt][4 * q] * inv * ps[0], Y[ntd][ntt][4 * q + 1] * inv * ps[1]); w.y = pk2c(Y[ntd][ntt][4 * q + 2] * inv * ps[2], Y[ntd][ntt][4 * q + 3] * inv * ps[3]);
                    *(u32x2*)(MIX + (size_t)(row0 + t) * D + 768 + 64 * g + dd0) = w; } }
    }
}

__device__ __forceinline__ void mixer_local(const Args& a, int l, int tile, int half, LAS unsigned char* lds) {
    const int tid = tid_now();
    const bf16_t* COLS = (const bf16_t*)(a.ws + WS_COLS); bf16_t* MIX = (bf16_t*)(a.ws + WS_MIX);
    LAS float* AG = (LAS float*)lds;
    LAS float* U = AG + 7936;
    LAS float* CX = U + 8192;
    const bool lat = tile < 512; const int r0 = tile * 64 + half * 32;
    const int seq_lo = lat ? tile * 64 : (NLAT + ((tile - 512) >> 2) * CTXL), seq_hi = lat ? tile * 64 + 64 : seq_lo + CTXL;
    const float* confw = a.in[I_CONFW] + (size_t)l * 31 * 256; const float* scw = a.in[I_SCW] + (size_t)l * 3 * 256;
    const int npass = lat ? 1 : 2;
    for (int ps = 0; ps < npass; ++ps) {
        const int chb = ps * 128;
        for (int idx = tid; idx < 62 * 16; idx += 512) { const int tt = idx >> 4, c8 = (idx & 15) * 8, r = r0 - 15 + tt;
            float o[8] = {0.f, 0.f, 0.f, 0.f, 0.f, 0.f, 0.f, 0.f};
            if (r >= seq_lo && r < seq_hi) { const bf16_t* rp = COLS + (size_t)r * NINP; float fa[8], fg[8]; unpack8(*(const u32x4*)(rp + C_CA + chb + c8), fa); unpack8(*(const u32x4*)(rp + C_CG + chb + c8), fg);
#pragma unroll
                for (int i = 0; i < 8; ++i) o[i] = fa[i] * sigmoidf_(fg[i]); }
            *(LAS f32x4*)(AG + tt * 128 + c8) = (f32x4){o[0], o[1], o[2], o[3]}; *(LAS f32x4*)(AG + tt * 128 + c8 + 4) = (f32x4){o[4], o[5], o[6], o[7]}; }
        for (int idx = tid; idx < 34 * 16; idx += 512) { const int tt = idx >> 4, c8 = (idx & 15) * 8, r = r0 - 1 + tt;
            float o[8] = {0.f, 0.f, 0.f, 0.f, 0.f, 0.f, 0.f, 0.f};
            if (r >= seq_lo && r < seq_hi) { const bf16_t* rp = COLS + (size_t)r * NINP; float fc[8], fx[8]; unpack8(*(const u32x4*)(rp + C_SC + chb + c8), fc); unpack8(*(const u32x4*)(rp + C_SX + chb + c8), fx);
#pragma unroll
                for (int i = 0; i < 8; ++i) o[i] = fc[i] * fx[i]; }
            *(LAS f32x4*)(CX + tt * 128 + c8) = (f32x4){o[0], o[1], o[2], o[3]}; *(LAS f32x4*)(CX + tt * 128 + c8 + 4) = (f32x4){o[4], o[5], o[6], o[7]}; }
        __syncthreads();
        { const int c = tid & 127, t0 = (tid >> 7) * 8;
            float wv[31];
#pragma unroll
            for (int j = 0; j < 31; ++j) wv[j] = confw[j * 256 + chb + c];
            const float bias = a.in[I_CONFB][l * 256 + chb + c];
            const float w0 = scw[chb + c], w1 = scw[256 + chb + c], w2 = scw[512 + chb + c];
            float o[8];
#pragma unroll
            for (int q = 0; q < 8; ++q) o[q] = bias;
#pragma unroll
            for (int j = 0; j < 38; ++j) { const float x = AG[(t0 + j) * 128 + c];
#pragma unroll
                for (int q = 0; q < 8; ++q) { if (j - q >= 0 && j - q < 31) o[q] += x * wv[j - q]; } }
#pragma unroll
            for (int q = 0; q < 8; ++q) U[(t0 + q) * 256 + chb + c] = o[q];
            unsigned sbr[8];
#pragma unroll
            for (int q = 0; q < 8; ++q) sbr[q] = COLS[(size_t)(r0 + t0 + q) * NINP + C_SB + chb + c];
#pragma unroll
            for (int q = 0; q < 8; ++q) PIN(sbr[q]);
#pragma unroll
            for (int q = 0; q < 8; ++q) { const int t = t0 + q; const float cv = CX[t * 128 + c] * w0 + CX[(t + 1) * 128 + c] * w1 + CX[(t + 2) * 128 + c] * w2;
                const float sb = __uint_as_float(sbr[q] << 16);
                MIX[(size_t)(r0 + t) * D + 512 + chb + c] = (bf16_t)(pk2(sb * cv, 0.f) & 0xffffu); }
        }
        __syncthreads();
    }
    if (lat) {
        const float* UV = (const float*)(a.ws + WS_UV); const float* SCV = (const float*)(a.ws + WS_SCV);
        for (int idx = tid; idx < 32 * 32; idx += 512) { const int t = idx >> 5, c4 = (idx & 31) * 4;
            const f32x4 u = *(const f32x4*)(UV + (size_t)(r0 + t) * 128 + c4), bz = *(const f32x4*)(a.in[I_CONFB] + l * 256 + 128 + c4);
            *(LAS f32x4*)(U + t * 256 + 128 + c4) = u + bz;
            const f32x4 sv = *(const f32x4*)(SCV + (size_t)(r0 + t) * 128 + c4);
            const u32x2 sbw = *(const u32x2*)(COLS + (size_t)(r0 + t) * NINP + C_SB + 128 + c4);
            u32x2 w; w.x = pk2(bflo(sbw.x) * sv[0], bfhi(sbw.x) * sv[1]); w.y = pk2(bflo(sbw.y) * sv[2], bfhi(sbw.y) * sv[3]);
            *(u32x2*)(MIX + (size_t)(r0 + t) * D + 512 + 128 + c4) = w; }
        __syncthreads();
    }
    { const int t = tid >> 4, c0 = (tid & 15) * 16;
        float s = 0.f;
#pragma unroll
        for (int i = 0; i < 16; i += 4) { const f32x4 v = *(const LAS f32x4*)(U + t * 256 + c0 + i); s += (v[0] + v[1]) + (v[2] + v[3]); }
        s += __shfl_xor(s, 1); s += __shfl_xor(s, 2); s += __shfl_xor(s, 4); s += __shfl_xor(s, 8);
        const float mean = s * (1.0f / 256.0f); float q = 0.f;
#pragma unroll
        for (int i = 0; i < 16; i += 4) { const f32x4 v = *(const LAS f32x4*)(U + t * 256 + c0 + i) - mean; q += (v[0] * v[0] + v[1] * v[1]) + (v[2] * v[2] + v[3] * v[3]); }
        q += __shfl_xor(q, 1); q += __shfl_xor(q, 2); q += __shfl_xor(q, 4); q += __shfl_xor(q, 8);
        const float rstd = rsqrtf(q * (1.0f / 256.0f) + EPS);
        const float* lg = a.in[I_CONFG] + l * 256 + c0; const float* lb = a.in[I_CONFBETA] + l * 256 + c0;
#pragma unroll
        for (int i = 0; i < 16; i += 8) { float y[8];
#pragma unroll
            for (int k = 0; k < 8; ++k) y[k] = siluf_((U[t * 256 + c0 + i + k] - mean) * rstd * lg[i + k] + lb[i + k]);
            u32x4 w; w.x = pk2(y[0], y[1]); w.y = pk2(y[2], y[3]); w.z = pk2(y[4], y[5]); w.w = pk2(y[6], y[7]);
            *(u32x4*)(MIX + (size_t)(r0 + t) * D + 256 + c0 + i) = w; }
    }
    __syncthreads();
    for (int hf = 0; hf < 2; ++hf) {
        LAS float* PI = (LAS float*)lds;
        LAS float* DF = PI + 6144;
        LAS float* PW = DF + 4224;
        for (int idx = tid; idx < 48 * 16; idx += 512) { const int tt = idx >> 4, c8 = (idx & 15) * 8, r = r0 - 8 + tt;
            float o[8] = {0.f, 0.f, 0.f, 0.f, 0.f, 0.f, 0.f, 0.f};
            if (r >= seq_lo && r < seq_hi) unpack8(*(const u32x4*)(COLS + (size_t)r * NINP + C_PL + hf * 128 + c8), o);
            *(LAS f32x4*)(PI + tt * 128 + c8) = (f32x4){o[0], o[1], o[2], o[3]}; *(LAS f32x4*)(PI + tt * 128 + c8 + 4) = (f32x4){o[4], o[5], o[6], o[7]}; }
        for (int idx = tid; idx < 2 * 64 * 64 / 4; idx += 512) *(LAS f32x4*)(PW + idx * 4) = *(const f32x4*)(a.in[I_POOLW] + (size_t)l * 4 * 4096 + (size_t)hf * 2 * 4096 + idx * 4);
        __syncthreads();
        for (int idx = tid; idx < 32 * 128; idx += 512) { const int t = idx >> 7, c = idx & 127, g = hf * 2 + (c >> 6); const int hw = 1 << g;
            const int r = r0 + t; int lo = r - hw, hi = r + hw; lo = lo < seq_lo ? seq_lo : lo; hi = hi > seq_hi ? seq_hi : hi;
            float sm = 0.f; for (int rr = lo; rr < hi; ++rr) sm += PI[(rr - r0 + 8) * 128 + c];
            DF[t * 132 + c] = sm / (float)(hi - lo) - PI[(t + 8) * 128 + c]; }
        __syncthreads();
        { const int gl = tid >> 8, tp = (tid >> 4) & 15, dq = tid & 15; const int dd0 = dq * 4;
            f32x4 o[2] = {(f32x4){0.f, 0.f, 0.f, 0.f}, (f32x4){0.f, 0.f, 0.f, 0.f}};
#pragma unroll 2
            for (int c4 = 0; c4 < 64; c4 += 4) { f32x4 dv[2];
#pragma unroll
                for (int x = 0; x < 2; ++x) dv[x] = *(const LAS f32x4*)(DF + (tp * 2 + x) * 132 + gl * 64 + c4);
#pragma unroll
                for (int q = 0; q < 4; ++q) { const f32x4 wv = *(const LAS f32x4*)(PW + (gl * 64 + c4 + q) * 64 + dd0);
#pragma unroll
                    for (int x = 0; x < 2; ++x) o[x] += dv[x][q] * wv; } }
            const int ch = (hf * 2 + gl) * 64 + dd0; const f32x4 ps = *(const f32x4*)(a.in[I_POOLS] + l * 256 + ch);
#pragma unroll
            for (int x = 0; x < 2; ++x) { u32x2 w; w.x = pk2(o[x][0] * ps[0], o[x][1] * ps[1]); w.y = pk2(o[x][2] * ps[2], o[x][3] * ps[3]);
                *(u32x2*)(MIX + (size_t)(r0 + tp * 2 + x) * D + 768 + ch) = w; } }
        __syncthreads();
    }
}

__device__ __forceinline__ void phase_mixer(const Args& a, int l, LAS unsigned char* lds) {
    const int ntile = (l == 1) ? 512 : NCHUNK;
    { const int tid = tid_now(), lane = tid & 63, wid = __builtin_amdgcn_readfirstlane(tid >> 6);
        LAS bf16_t* vT = (LAS bf16_t*)(lds + wid * 16384);
        LAS int* ctr = (LAS int*)(lds + MISC_OFF + 16);
        if (tid == 0) *ctr = 0;
        __syncthreads();
        const int b = blockIdx.x, G = gridDim.x, nT = b < ntile ? (ntile - 1 - b) / G + 1 : 0, nL = b < 512 ? (511 - b) / G + 1 : 0;
        for (;;) { int j = next_item(ctr, lane);
            if (j < 4 * nT) { mixer_gla_item(a, l, b + G * (j >> 2), j & 3, lane, vT); continue; }
            j -= 4 * nT;
            if (j < 4 * nL) { mixer_conv_item(a, l, b + G * (j >> 2), j & 3, lane, (LAS float*)vT); continue; }
            j -= 4 * nL; if (j >= 4 * nL) break;
            mixer_pool_item(a, l, b + G * (j >> 2), j & 3, lane); } }
    if (l == 0) {
        if ((int)gridDim.x > 32 && (int)blockIdx.x >= 32) convert_range(a, lds, CV_E0 + CV_P0_E0, CV_G, (int)blockIdx.x - 32, (int)gridDim.x - 32);
        else { if ((int)gridDim.x <= 32) convert_range(a, lds, CV_E0 + CV_P0_E0, CV_G, (int)blockIdx.x, (int)gridDim.x);
            __syncthreads();
            for (int it = blockIdx.x; it < 16 * 2; it += gridDim.x) mixer_local(a, l, 512 + (it >> 1), it & 1, lds); }
    }
}

__device__ __forceinline__ void phase_router(const Args& a, int l, LAS unsigned char* lds) {
    const int tid = tid_now(), lane = tid & 63, wid = tid >> 6;
    const int M = (l == 1) ? NLAT : MTOT;
    const float* MOD = (const float*)(a.ws + WS_MOD) + (size_t)l * 5 * 6144; bf16_t* H = (bf16_t*)(a.ws + WS_H);
    LAS float* WRE = (LAS float*)lds;
    LAS int* INFO = (LAS int*)(lds + MISC_OFF + 4096);
    LAS int* HIST = (LAS int*)(lds + MISC_OFF + 2048);
    const float* wre = a.in[I_RWE] + (size_t)l * 1024 * 32; const float* wrgT = (const float*)(a.ws + WS_TAB) + (size_t)l * 4096;
    for (int i = tid; i < 1024 * 8; i += 512) { const int k = i >> 3, q = i & 7; const f32x4 w = *(const f32x4*)(wre + k * 32 + q * 4);
        WRE[(4 * q + 0) * 1024 + k] = w[0]; WRE[(4 * q + 1) * 1024 + k] = w[1]; WRE[(4 * q + 2) * 1024 + k] = w[2]; WRE[(4 * q + 3) * 1024 + k] = w[3]; }
    if (tid < 64) HIST[tid] = 0;
    __syncthreads();
    const int per = (M + gridDim.x - 1) / gridDim.x; const int r_lo = blockIdx.x * per; int r_hi = r_lo + per; if (r_hi > M) r_hi = M;
    const float rbg0 = a.in[I_RBG][l * 4 + 0], rbg1 = a.in[I_RBG][l * 4 + 1], rbg2 = a.in[I_RBG][l * 4 + 2], rbg3 = a.in[I_RBG][l * 4 + 3];
    bf16_t* XB = (bf16_t*)(a.ws + WS_XB); const bf16_t* Y1 = (const bf16_t*)(a.ws + WS_Y);
    int cur_b = -1; f32x4 GS[4], SH[4], GA[4], WGT[4][4];
#pragma unroll
    for (int g = 0; g < 4; ++g)
#pragma unroll
        for (int j = 0; j < 4; ++j) WGT[g][j] = *((const f32x4*)(wrgT + g * 1024) + lane + 64 * j);
    for (int rp = 0; rp < ((REP_SUB == 7 && l == 0) ? 2 : 1); ++rp)
#pragma unroll 1
    for (int mm = r_lo + wid; mm < r_hi; mm += 16) {
        f32x4 vv[2][4]; u32x2 yy[2][4]; int mrow[2]; bool has[2];
#pragma unroll
        for (int rr = 0; rr < 2; ++rr) { const int m = mm + 8 * rr; has[rr] = m < r_hi; const int mc = has[rr] ? m : mm; mrow[rr] = mc;
            if (l == 0) load_row(mc < NLAT ? a.in[I_X] + (size_t)mc * D : a.in[I_CTX] + (size_t)(mc - NLAT) * D, lane, vv[rr]);
            else load_row_bf(XB + (size_t)mc * D, lane, vv[rr]);
#pragma unroll
            for (int j = 0; j < 4; ++j) yy[rr][j] = *((const u32x2*)(Y1 + (size_t)mc * D) + lane + 64 * j); }
#pragma unroll
        for (int rr = 0; rr < 2; ++rr) {
            if (!has[rr]) continue;
            const int m = mrow[rr]; const int b = m < NLAT ? (m >> 13) : 4;
            if (b != cur_b) { const float* mod = MOD + (size_t)b * 6144; load_mod_cached(a.in[I_G2] + l * 1024, mod + 4 * 1024, mod + 3 * 1024, mod + 2 * 1024, lane, GS, SH, GA); cur_b = b; }
            f32x4 v[4];
#pragma unroll
            for (int j = 0; j < 4; ++j) { const u32x2 y = yy[rr][j]; v[j] = vv[rr][j] + GA[j] * (f32x4){bflo(y.x), bfhi(y.x), bflo(y.y), bfhi(y.y)}; }
            store_row_bf(XB + (size_t)m * D, lane, v);
            const float rstd = row_rstd(v);
            norm_store_cached(v, rstd, GS, SH, H + (size_t)m * D, lane);
            float ga_[4] = {0.f, 0.f, 0.f, 0.f};
#pragma unroll
            for (int g = 0; g < 4; ++g)
#pragma unroll
                for (int j = 0; j < 4; ++j) { const f32x4 w = WGT[g][j]; ga_[g] += (v[j][0] * w[0] + v[j][1] * w[1]) + (v[j][2] * w[2] + v[j][3] * w[3]); }
            float lg0, lg1, lg2, lg3;
            { const bool h5 = (lane & 32) != 0, h4 = (lane & 16) != 0;
                float k0 = h5 ? ga_[2] : ga_[0], k1 = h5 ? ga_[3] : ga_[1]; const float s0 = h5 ? ga_[0] : ga_[2], s1 = h5 ? ga_[1] : ga_[3];
                k0 += __shfl_xor(s0, 32); k1 += __shfl_xor(s1, 32);
                float kk = h4 ? k1 : k0; const float sk = h4 ? k0 : k1; kk += __shfl_xor(sk, 16);
                kk += __shfl_xor(kk, 8); kk += __shfl_xor(kk, 4); kk += __shfl_xor(kk, 2); kk += __shfl_xor(kk, 1);
                lg0 = __int_as_float(__builtin_amdgcn_readlane(__float_as_int(kk), 0)) + rbg0; lg1 = __int_as_float(__builtin_amdgcn_readlane(__float_as_int(kk), 16)) + rbg1;
                lg2 = __int_as_float(__builtin_amdgcn_readlane(__float_as_int(kk), 32)) + rbg2; lg3 = __int_as_float(__builtin_amdgcn_readlane(__float_as_int(kk), 48)) + rbg3; }
            int grp = 0; float best = lg0; if (lg1 > best) { best = lg1; grp = 1; } if (lg2 > best) { best = lg2; grp = 2; } if (lg3 > best) { best = lg3; grp = 3; }
            const float pg = 1.0f / (__expf(lg0 - best) + __expf(lg1 - best) + __expf(lg2 - best) + __expf(lg3 - best));
            grp = __builtin_amdgcn_readfirstlane(grp);
            float ep[8];
            { const LAS float* wb = WRE + (size_t)(grp * 8) * 1024;
#pragma unroll
                for (int i = 0; i < 8; i += 2) { f32x4 w[2][4];
#pragma unroll
                    for (int u = 0; u < 2; ++u)
#pragma unroll
                        for (int j = 0; j < 4; ++j) w[u][j] = *((const LAS f32x4*)(wb + (i + u) * 1024) + lane + 64 * j);
#pragma unroll
                    for (int u = 0; u < 2; ++u)
#pragma unroll
                        for (int j = 0; j < 4; ++j) PIN(w[u][j]);
#pragma unroll
                    for (int u = 0; u < 2; ++u) { float acc_ = 0.f;
#pragma unroll
                        for (int j = 0; j < 4; ++j) acc_ += (v[j][0] * w[u][j][0] + v[j][1] * w[u][j][1]) + (v[j][2] * w[u][j][2] + v[j][3] * w[u][j][3]);
                        ep[i + u] = acc_; } } }
            float le[8];
            { const bool h5 = (lane & 32) != 0, h4 = (lane & 16) != 0, h3 = (lane & 8) != 0;
                float k4[4];
#pragma unroll
                for (int i = 0; i < 4; ++i) { const float keep = h5 ? ep[4 + i] : ep[i], send = h5 ? ep[i] : ep[4 + i]; k4[i] = keep + __shfl_xor(send, 32); }
                float k2[2];
#pragma unroll
                for (int i = 0; i < 2; ++i) { const float keep = h4 ? k4[2 + i] : k4[i], send = h4 ? k4[i] : k4[2 + i]; k2[i] = keep + __shfl_xor(send, 16); }
                float kk = h3 ? k2[1] : k2[0]; const float sk = h3 ? k2[0] : k2[1]; kk += __shfl_xor(sk, 8);
                kk += __shfl_xor(kk, 4); kk += __shfl_xor(kk, 2); kk += __shfl_xor(kk, 1);
#pragma unroll
                for (int i = 0; i < 8; ++i) le[i] = __int_as_float(__builtin_amdgcn_readlane(__float_as_int(kk), 8 * i)) + a.in[I_RBE][l * 32 + grp * 8 + i]; }
            int i0 = 0; float v0 = le[0];
#pragma unroll
            for (int i = 1; i < 8; ++i) if (le[i] > v0) { v0 = le[i]; i0 = i; }
            int i1 = -1; float v1 = -3.0e38f;
#pragma unroll
            for (int i = 0; i < 8; ++i) if (i != i0 && le[i] > v1) { v1 = le[i]; i1 = i; }
            const float w0 = 1.0f / (1.0f + __expf(v1 - v0)); const float w1 = 1.0f - w0;
            if (lane == 0) { const int lr = m - r_lo; INFO[lr * 4 + 0] = grp * 8 + i0; INFO[lr * 4 + 1] = grp * 8 + i1; INFO[lr * 4 + 2] = __float_as_int(w0 * pg); INFO[lr * 4 + 3] = __float_as_int(w1 * pg); }
        }
    }
    __syncthreads();
    const int nr = r_hi - r_lo; int lp0 = 0, lp1 = 0, ee0 = 0, ee1 = 0;
    if (tid < nr) { ee0 = INFO[tid * 4 + 0]; ee1 = INFO[tid * 4 + 1]; lp0 = atomicAdd((int*)(HIST + ee0), 1); lp1 = atomicAdd((int*)(HIST + ee1), 1); }
    __syncthreads();
    unsigned* cnt = (unsigned*)(a.ws + WS_CTL) + CW_CNT + l * 32 * 64;
    if (tid < 32) { const int c = HIST[tid]; HIST[32 + tid] = c ? (int)atomicAdd(cnt + tid * 64, (unsigned)c) : 0; }
    __syncthreads();
    if (tid < nr) { const int m = r_lo + tid; const int p0 = HIST[32 + ee0] + lp0, p1 = HIST[32 + ee1] + lp1;
        int* TL = (int*)(a.ws + WS_TOKLIST); TL[ee0 * MTOT + p0] = m; TL[ee1 * MTOT + p1] = m;
        *((i32x4*)(a.ws + WS_TOKINFO) + m) = (i32x4){(ee0 << 20) | p0, (ee1 << 20) | p1, INFO[tid * 4 + 2], INFO[tid * 4 + 3]}; }
    __syncthreads();
}

__device__ __forceinline__ int moe_tables(const Args& a, int l, LAS unsigned char* lds) {
    LAS int* TB = (LAS int*)(lds + MISC_OFF + 256); LAS int* CN = TB + 64; LAS int* TE = (LAS int*)(lds + MISC_OFF + 1024); LAS int* TM = TE + 320;
    const unsigned* cnt = (const unsigned*)(a.ws + WS_CTL) + CW_CNT + l * 32 * 64;
    { const int tq_ = tid_now(); if (tq_ < 32) CN[tq_] = (int)__hip_atomic_load(cnt + tq_ * 64, __ATOMIC_RELAXED, __HIP_MEMORY_SCOPE_AGENT); }
    __syncthreads();
    if (tid_now() == 0) { int t = 0;
#pragma unroll 1
        for (int e = 0; e < 32; ++e) { TB[e] = t; const int nt = (CN[e] + 255) >> 8;
#pragma unroll 1
            for (int q = 0; q < nt; ++q) { TE[t + q] = e; TM[t + q] = q; } t += nt; } TB[32] = t; }
    __syncthreads();
    return __builtin_amdgcn_readfirstlane(TB[32]);
}

__device__ __forceinline__ void phase_combine(const Args& a, int l, LAS unsigned char* lds) {
    const int lane = tid_now() & 63, wid = tid_now() >> 6, gw = blockIdx.x * 8 + wid, NGW = gridDim.x * 8;
    const int M = (l == 1) ? NLAT : MTOT;
    (void)moe_tables(a, l, lds);
    const LAS int* TB = (const LAS int*)(lds + MISC_OFF + 256);
    const float* MOD = (const float*)(a.ws + WS_MOD); const unsigned char* Y = (const unsigned char*)(a.ws + WS_Y); bf16_t* H = (bf16_t*)(a.ws + WS_H);
    bf16_t* XB = (bf16_t*)(a.ws + WS_XB);
    int cur_b = -1; f32x4 GS[4], SH[4], GA[4];
#pragma unroll 1
    for (int mm = gw; mm < M; mm += 2 * NGW) {
        f32x4 vv[2][4]; unsigned ya[2][4], yb[2][4]; i32x4 inf[2]; int mrow[2]; bool has[2];
#pragma unroll
        for (int rr = 0; rr < 2; ++rr) { const int m = mm + rr * NGW; has[rr] = m < M; const int mc = has[rr] ? m : mm; mrow[rr] = mc;
            inf[rr] = *((const i32x4*)(a.ws + WS_TOKINFO) + mc);
            load_row_bf(XB + (size_t)mc * D, lane, vv[rr]); }
#pragma unroll
        for (int rr = 0; rr < 2; ++rr) { const int e0 = inf[rr].x >> 20, p0 = inf[rr].x & 0xfffff, e1 = inf[rr].y >> 20, p1 = inf[rr].y & 0xfffff;
            const unsigned char* y0 = Y + (size_t)(TB[e0] * 256 + p0) * D; const unsigned char* y1 = Y + (size_t)(TB[e1] * 256 + p1) * D;
#pragma unroll
            for (int j = 0; j < 4; ++j) { ya[rr][j] = *((const unsigned*)y0 + lane + 64 * j); yb[rr][j] = *((const unsigned*)y1 + lane + 64 * j); } }
#pragma unroll
        for (int rr = 0; rr < 2; ++rr) {
            if (!has[rr]) continue;
            const int m = mrow[rr]; const int b = m < NLAT ? (m >> 13) : 4;
            const float w0s = __int_as_float(inf[rr].z) * (1.0f / 16.0f), w1s = __int_as_float(inf[rr].w) * (1.0f / 16.0f);
            if (b != cur_b) { const float* ga2 = MOD + (size_t)(l * 5 + b) * 6144 + 5 * 1024;
                if (l == 0) { const float* mod = MOD + (size_t)(5 + b) * 6144; load_mod_cached(a.in[I_G1] + 1024, mod + 1024, mod, ga2, lane, GS, SH, GA); }
                else {
#pragma unroll
                    for (int j = 0; j < 4; ++j) { GS[j] = *((const f32x4*)a.in[I_GFINAL] + lane + 64 * j); SH[j] = (f32x4){0.f, 0.f, 0.f, 0.f}; GA[j] = *((const f32x4*)ga2 + lane + 64 * j); } }
                cur_b = b; }
            f32x4 v[4];
#pragma unroll
            for (int j = 0; j < 4; ++j) { const int a0 = (int)ya[rr][j], a1 = (int)yb[rr][j];
                f32x4 y; y[0] = w0s * __builtin_amdgcn_cvt_f32_fp8(a0, 0) + w1s * __builtin_amdgcn_cvt_f32_fp8(a1, 0); y[1] = w0s * __builtin_amdgcn_cvt_f32_fp8(a0, 1) + w1s * __builtin_amdgcn_cvt_f32_fp8(a1, 1);
                y[2] = w0s * __builtin_amdgcn_cvt_f32_fp8(a0, 2) + w1s * __builtin_amdgcn_cvt_f32_fp8(a1, 2); y[3] = w0s * __builtin_amdgcn_cvt_f32_fp8(a0, 3) + w1s * __builtin_amdgcn_cvt_f32_fp8(a1, 3);
                v[j] = vv[rr][j] + GA[j] * y; }
            const float rstd = row_rstd(v);
            if (l == 0) {
                store_row_bf(XB + (size_t)m * D, lane, v);
                norm_store_cached(v, rstd, GS, SH, H + (size_t)m * D, lane);
            } else {
                float* xr = a.out + (size_t)m * D;
#pragma unroll
                for (int j = 0; j < 4; ++j) *((f32x4*)xr + lane + 64 * j) = (v[j] * rstd) * GS[j];
            }
        }
    }
}

#define XB_TMO      128
#define XB_XCNT(j)  (256  + 64 * (j))
#define XB_XSUB(j)  (1280 + 64 * (j))
#define XB_XGEN(j)  (2304 + 64 * (j))
#define XB_TOP      3328
#define XB_TOPGEN   3392
#define XCD_BAR_WORDS 3456
#define XB_SPIN_CAP (1u << 22)
__device__ __forceinline__ unsigned xb_ld(unsigned* p)              { return __hip_atomic_load(p, __ATOMIC_RELAXED, __HIP_MEMORY_SCOPE_AGENT); }
__device__ __forceinline__ unsigned xb_add(unsigned* p, unsigned v) { return __hip_atomic_fetch_add(p, v, __ATOMIC_RELAXED, __HIP_MEMORY_SCOPE_AGENT); }
__device__ __forceinline__ unsigned xb_xcc_id() { return (unsigned)__builtin_amdgcn_s_getreg((3 << 11) | 20) & 0xFu; }
#define XB_SPIN(cond, bar) do { unsigned _sp = 0; while (cond) { __builtin_amdgcn_s_sleep(1); \
    if ((++_sp & 255u) == 0u) { if (xb_ld(&(bar)[XB_TMO])) break; if (_sp > XB_SPIN_CAP) { atomicAdd(&(bar)[XB_TMO], 1u); break; } } } } while (0)
struct XcdBarrier { unsigned* bar; unsigned x; volatile LAS unsigned* st; };
__device__ __forceinline__ XcdBarrier xcd_barrier_post(unsigned* bar, volatile LAS unsigned* st) {
    XcdBarrier b; b.bar = bar; b.x = xb_xcc_id(); b.st = st;
    if (threadIdx.x == 0) (void)xb_add(&bar[XB_XCNT(b.x)], 1u);
    return b;
}
__device__ __forceinline__ void xcd_barrier_complete(unsigned* bar, unsigned x, unsigned& nloc, unsigned& nx) {
    const unsigned G = gridDim.x * gridDim.y * gridDim.z;
    unsigned sum, cnt, mine, sp = 0u;
    for (;;) {
        sum = 0u; cnt = 0u; mine = 0u;
#pragma unroll
        for (unsigned j = 0; j < 16; ++j) { const unsigned c = xb_ld(&bar[XB_XCNT(j)]); sum += c; cnt += (c > 0u) ? 1u : 0u; mine = (j == x) ? c : mine; }
        if (sum == G) break;
        __builtin_amdgcn_s_sleep(1);
        if ((++sp & 255u) == 0u) { if (xb_ld(&bar[XB_TMO])) break; if (sp > XB_SPIN_CAP) { atomicAdd(&bar[XB_TMO], 1u); break; } }
    }
    nloc = mine > 0u ? mine : 1u; nx = cnt > 0u ? cnt : 1u;
}
__device__ __forceinline__ void xcd_barrier(const XcdBarrier& b) {
    asm volatile("s_waitcnt vmcnt(0)" ::: "memory");
    __syncthreads();
    if (threadIdx.x == 0) {
        unsigned* bar = b.bar;
        __builtin_amdgcn_s_waitcnt(0);
        unsigned nloc = b.st[0], nx = b.st[1];
        if (nloc == 0u) { xcd_barrier_complete(bar, b.x, nloc, nx); b.st[0] = nloc; b.st[1] = nx; }
        const unsigned old = xb_add(&bar[XB_XSUB(b.x)], 1u);
        const unsigned gen = old / nloc;
        if (old + 1u == (gen + 1u) * nloc) {
            __builtin_amdgcn_fence(__ATOMIC_RELEASE, "agent");
            asm volatile("s_waitcnt vmcnt(0)" ::: "memory");
            const unsigned og = xb_add(&bar[XB_TOP], 1u);
            const unsigned tg = og / nx;
            if (og + 1u == (tg + 1u) * nx) xb_add(&bar[XB_TOPGEN], 1u);
            else XB_SPIN(xb_ld(&bar[XB_TOPGEN]) == tg, bar);
            __builtin_amdgcn_fence(__ATOMIC_ACQUIRE, "agent");
            xb_add(&bar[XB_XGEN(b.x)], 1u);
            asm volatile("s_waitcnt vmcnt(0)" ::: "memory");
        } else {
            XB_SPIN(xb_ld(&bar[XB_XGEN(b.x)]) == gen, bar);
            __builtin_amdgcn_fence(__ATOMIC_ACQUIRE, "agent");
            asm volatile("s_waitcnt vmcnt(0)" ::: "memory");
        }
    }
    __syncthreads();
}

constexpr int NPHASE = 20;
#ifndef DIAG_PH
#define DIAG_PH -1
#endif
#define PH_ON(x) (DIAG_PH < 0 || DIAG_PH == (x))
#ifndef REP_ID
#define REP_ID -1
#endif
__global__ void __launch_bounds__(512, 2) mega(Args a) {
    extern __shared__ __attribute__((aligned(16))) unsigned char lds_raw[];
    LAS unsigned char* lds = (LAS unsigned char*)lds_raw;
    unsigned char* ws = a.ws;
    volatile LAS unsigned* bst = (volatile LAS unsigned*)(lds + MISC_OFF);
    if (threadIdx.x < 2) bst[threadIdx.x] = 0u;
    __syncthreads();
    XcdBarrier xbar = xcd_barrier_post((unsigned*)(ws + WS_CTL) + CW_BAR, bst);
    unsigned long long tph_ = 0ull;
    for (int ph = a.ph_lo; ph < a.ph_hi; ++ph) {
      unsigned long long t0_ = 0ull; if (TIME_PH >= 0 && ph == TIME_PH) t0_ = __builtin_amdgcn_s_memrealtime();
      const int cls_ = ph < 2 ? ph : 2 + (ph - 2) % 9;
      const int nrep_ = (REP_ID >= 0 && cls_ == REP_ID) ? 2 : 1;
      for (int rep_ = 0; rep_ < nrep_; ++rep_) {
        if (rep_) xcd_barrier(xbar);
        if (PH_ON(0) && ph == 0) phase_p0(a, lds);
        else if (PH_ON(1) && ph == 1) phase_norm1_l0(a);
        else {
            const int l = (ph - 2) / 9, sp = (ph - 2) % 9;
            if (PH_ON(2) && sp == 0) {
                g8::DenseSched S; S.init(ws + WS_H, ws + WS_WIN + (size_t)l * NINP * 1024 * 2, MTOT, NINP, 1024, gridDim.x, blockIdx.x);
                g8::EpiBf16 E{(bf16_t*)(ws + WS_COLS), NINP};
                g8::gemm_phase(lds, S, E);
                if (l == 0) convert_in_tail(a, lds, CV_E0 + CV_P0_E0 + CV_G, CV_A, S.nwg, S.G, S.c); else convert_in_tail(a, lds, CV_EI1 + CV_P0_EI1 + CV_C + CV_D, CV_E, S.nwg, S.G, S.c);
            } else if (PH_ON(3) && sp == 1) phase_chunk(a, l, lds);
            else if (PH_ON(4) && sp == 2) phase_scan(a, l, lds);
            else if (PH_ON(5) && sp == 3) phase_mixer(a, l, lds);
            else if (PH_ON(6) && sp == 4) {
                g8::DenseSched S; S.init(ws + WS_MIX, ws + WS_WOUT + (size_t)l * 1024 * 1024 * 2, l == 1 ? NLAT : MTOT, 1024, 1024, gridDim.x, blockIdx.x);
                g8::EpiBf16 E{(bf16_t*)(ws + WS_Y), 1024};
                g8::gemm_phase(lds, S, E);
                if (l == 0) convert_in_tail(a, lds, CV_E0 + CV_P0_E0 + CV_G + CV_A, CV_B, S.nwg, S.G, S.c);
            } else if (PH_ON(7) && sp == 5) phase_router(a, l, lds);
            else if ((PH_ON(8) || PH_ON(9)) && (sp == 6 || sp == 7)) {
                const int T = moe_tables(a, l, lds);
                const int G = gridDim.x, bx = blockIdx.x, vcu = (G % 8 == 0) ? (bx % 8) * (G / 8) + bx / 8 : bx;
                const LAS int* TBp = (const LAS int*)(lds + MISC_OFF + 256);
                if (PH_ON(8) && sp == 6) {
                    g8::MoeSched<true> S; S.A = (const char*)(ws + WS_H); S.Bw = (const char*)(ws + WS_WEIN) + (size_t)l * 32 * 1024 * 1024 * 2; S.wstride = (size_t)1024 * 1024 * 2; S.K = 1024; S.T = T; S.G = G; S.c = vcu;
                    S.tile_e = (const LAS int*)(lds + MISC_OFF + 1024); S.tile_mt = S.tile_e + 320; S.cnt = TBp + 64; S.toklist = (const int*)(ws + WS_TOKLIST);
                    g8::EpiSwiGLU E{(bf16_t*)(ws + WS_ACT)};
                    g8::gemm_phase(lds, S, E);
                    if (l == 0) convert_in_tail(a, lds, CV_EI1 + CV_P0_EI1, CV_C, 4 * T, G, vcu); else convert_in_tail(a, lds, CV_EO1 + CV_P0_EO1, CV_F, 4 * T, G, vcu);
                } else if (PH_ON(9) && sp == 7) {
                    g8::MoeSched<false> S; S.A = (const char*)(ws + WS_ACT); S.Bw = (const char*)(ws + WS_WEOUT) + (size_t)l * 32 * 1024 * 512 * 2; S.wstride = (size_t)1024 * 512 * 2; S.K = 512; S.T = T; S.G = G; S.c = vcu;
                    S.tile_e = (const LAS int*)(lds + MISC_OFF + 1024); S.tile_mt = S.tile_e + 320; S.cnt = TBp + 64; S.toklist = (const int*)(ws + WS_TOKLIST);
                    g8::EpiFp8 E{(unsigned char*)(ws + WS_Y)};
                    g8::gemm_phase(lds, S, E);
                    if (l == 0) convert_in_tail(a, lds, CV_EI1 + CV_P0_EI1 + CV_C, CV_D, 4 * T, G, vcu);
                }
            } else if (PH_ON(10) && sp == 8) phase_combine(a, l, lds);
        }
      }
        if (ph + 1 < a.ph_hi) { if (a.ph_lo < 0) cg::this_grid().sync(); else xcd_barrier(xbar); }
        if (TIME_PH >= 0 && ph == TIME_PH) tph_ = __builtin_amdgcn_s_memrealtime() - t0_;
    }
    if (TIME_PH >= 0 && blockIdx.x == 0 && threadIdx.x == 0) { const unsigned long long te_ = __builtin_amdgcn_s_memrealtime(); while (__builtin_amdgcn_s_memrealtime() - te_ < 4ull * tph_) __builtin_amdgcn_s_sleep(8); }
}

extern "C" void kernel_launch(void* const* d_in, const int* in_sizes, int n_in, void* d_out, int out_size, void* d_ws, size_t ws_size, hipStream_t stream) {
    static int grid = 0;
    if (grid == 0) {
        if (n_in != 29 || out_size != NLAT * D || ws_size < WS_END) { fprintf(stderr, "kernel_launch: unexpected shapes (n_in %d out %d ws %zu)\n", n_in, out_size, ws_size); grid = -1; return; }
        int dev = 0, cus = 0, per_cu = 0;
        hipGetDevice(&dev); hipDeviceGetAttribute(&cus, hipDeviceAttributeMultiprocessorCount, dev);
        if (hipFuncSetAttribute((const void*)mega, hipFuncAttributeMaxDynamicSharedMemorySize, LDS_BYTES) != hipSuccess) { fprintf(stderr, "kernel_launch: hipFuncSetAttribute failed\n"); grid = -1; return; }
        if (hipOccupancyMaxActiveBlocksPerMultiprocessor(&per_cu, (const void*)mega, 512, LDS_BYTES) != hipSuccess || per_cu < 1) { fprintf(stderr, "kernel_launch: occupancy query says %d\n", per_cu); per_cu = 1; }
        (void)hipGetLastError();
        grid = cus;
    }
    if (grid < 0) return;
    hipMemsetAsync((char*)d_ws + WS_CTL, 0, CTL_BYTES, stream);
    Args a{};
    for (int i = 0; i < 29; ++i) a.in[i] = (const float*)d_in[i];
    a.out = (float*)d_out; a.ws = (unsigned char*)d_ws;
#if MK_MULTI
    for (int ph = 0; ph < NPHASE; ++ph) { a.ph_lo = ph; a.ph_hi = ph + 1; hipLaunchKernelGGL(mega, dim3(grid), dim3(512), LDS_BYTES, stream, a); }
#else
    a.ph_lo = 0; a.ph_hi = NPHASE;
    void* args[] = {&a};
    hipError_t e = hipLaunchCooperativeKernel((const void*)mega, dim3(grid), dim3(512), args, LDS_BYTES, stream);
    if (e != hipSuccess) fprintf(stderr, "cooperative launch failed: %s (grid %d)\n", hipGetErrorString(e), grid);
#endif
}
```

```cpp
#include <hip/hip_runtime.h>
#include <hip/hip_cooperative_groups.h>
#include <cstdio>
namespace cg = cooperative_groups;

#ifndef MK_MULTI
#define MK_MULTI 0
#endif

#ifndef TIME_PH
#define TIME_PH -1
#endif
#ifndef REP_SUB
#define REP_SUB 0
#endif

#define LAS __attribute__((address_space(3)))
typedef unsigned short bf16_t;
typedef short bf16x8 __attribute__((ext_vector_type(8)));
typedef float f32x4 __attribute__((ext_vector_type(4)));
typedef float f32x2 __attribute__((ext_vector_type(2)));
typedef unsigned u32x4 __attribute__((ext_vector_type(4)));
typedef unsigned u32x2 __attribute__((ext_vector_type(2)));
typedef int i32x4 __attribute__((ext_vector_type(4)));

constexpr int D = 1024, NLAT = 32768, SEQ = 8192, NCTXT = 1024, CTXL = 256, MTOT = NLAT + NCTXT;
constexpr int NIN = 2336, NINP = 2560;
constexpr int NCHUNK = MTOT / 64, NSEQ = 132;
constexpr int NEXP = 32, DEXP = 512, SLOTS = 75776;
constexpr float EPS = 1e-6f;
constexpr int C_Q = 0, C_K = 128, C_V = 256, C_G = 512, C_ZF = 768, C_ZB = 784, C_CA = 800, C_CG = 1056, C_SB = 1312, C_SC = 1568, C_SX = 1824, C_PL = 2080;

constexpr size_t MiB = 1u << 20;
constexpr size_t WS_CTL = 0, CTL_BYTES = 1 * MiB;
constexpr size_t WS_MOD = 1 * MiB;
constexpr size_t WS_TAB = 1 * MiB + 512 * 1024;
constexpr size_t WS_PWT = WS_TAB + 64 * 1024;
constexpr size_t WS_BAND = WS_TAB + 192 * 1024;
constexpr size_t WS_WIN = 2 * MiB;
constexpr size_t WS_WOUT = 12 * MiB;
constexpr size_t WS_WEIN = 16 * MiB;
constexpr size_t WS_WEOUT = 144 * MiB;
constexpr size_t WS_XCTX = 208 * MiB;
constexpr size_t WS_H = 212 * MiB;
constexpr size_t WS_COLS = 278 * MiB;
constexpr size_t WS_MIX = 443 * MiB;
constexpr size_t WS_KV = 509 * MiB;
constexpr size_t WS_DEC = 542 * MiB;
constexpr size_t WS_AGV = 543 * MiB;
constexpr size_t WS_CXV = 559 * MiB;
constexpr size_t WS_UV = 575 * MiB;
constexpr size_t WS_SCV = 591 * MiB;
constexpr size_t WS_TOKINFO = 607 * MiB;
constexpr size_t WS_TOKLIST = 608 * MiB;
constexpr size_t WS_ACT = 613 * MiB;
constexpr size_t WS_Y = 687 * MiB;
constexpr size_t WS_SIN = 835 * MiB;
constexpr size_t WS_XB = 852 * MiB;
constexpr size_t WS_END = 918 * MiB;
constexpr int CW_CNT = 1024;
constexpr int CW_BAR = 8192;

constexpr int LDS_BYTES = 147456;
constexpr int MISC_OFF = 131072;

__device__ __forceinline__ unsigned pk2(float lo, float hi) { unsigned r; asm("v_cvt_pk_bf16_f32 %0, %1, %2" : "=v"(r) : "v"(lo), "v"(hi)); return r; }
__device__ __forceinline__ float bflo(unsigned w) { return __uint_as_float(w << 16); }
__device__ __forceinline__ float bfhi(unsigned w) { return __uint_as_float(w & 0xffff0000u); }
__device__ __forceinline__ void unpack8(const u32x4 w, float (&f)[8]) { f[0] = bflo(w.x); f[1] = bfhi(w.x); f[2] = bflo(w.y); f[3] = bfhi(w.y); f[4] = bflo(w.z); f[5] = bfhi(w.z); f[6] = bflo(w.w); f[7] = bfhi(w.w); }
__device__ __forceinline__ float sigmoidf_(float x) { return __builtin_amdgcn_rcpf(1.0f + __expf(-x)); }
__device__ __forceinline__ float siluf_(float x) { return x * __builtin_amdgcn_rcpf(1.0f + __expf(-x)); }
__device__ __forceinline__ float logsigf_(float x) { return fminf(x, 0.0f) - log1pf(__expf(-fabsf(x))); }
__device__ __forceinline__ float wave_sum(float v) {
#pragma unroll
    for (int o = 1; o < 64; o <<= 1) v += __shfl_xor(v, o);
    return v;
}

typedef float f32x16 __attribute__((ext_vector_type(16)));
typedef __bf16 bf16x2_t __attribute__((ext_vector_type(2)));
#define MFMA32(a, b, c) __builtin_amdgcn_mfma_f32_32x32x16_bf16((a), (b), (c), 0, 0, 0)
__device__ __forceinline__ unsigned pk2c(float lo, float hi) { const f32x2 v = {lo, hi}; return __builtin_bit_cast(unsigned, __builtin_convertvector(v, bf16x2_t)); }
__device__ __forceinline__ bf16x8 pack8f(float x0, float x1, float x2, float x3, float x4, float x5, float x6, float x7) {
    u32x4 p; p.x = pk2c(x0, x1); p.y = pk2c(x2, x3); p.z = pk2c(x4, x5); p.w = pk2c(x6, x7); return __builtin_bit_cast(bf16x8, p); }
__device__ __forceinline__ bf16x8 pack_step(const f32x16& x, int s) { return s == 0 ? pack8f(x[0], x[1], x[2], x[3], x[4], x[5], x[6], x[7]) : pack8f(x[8], x[9], x[10], x[11], x[12], x[13], x[14], x[15]); }
__device__ __forceinline__ void split8(const float (&x)[8], bf16x8& hi, bf16x8& lo) {
    u32x4 p; p.x = pk2c(x[0], x[1]); p.y = pk2c(x[2], x[3]); p.z = pk2c(x[4], x[5]); p.w = pk2c(x[6], x[7]);
    hi = __builtin_bit_cast(bf16x8, p);
    lo = pack8f(x[0] - bflo(p.x), x[1] - bfhi(p.x), x[2] - bflo(p.y), x[3] - bfhi(p.y), x[4] - bflo(p.z), x[5] - bfhi(p.z), x[6] - bflo(p.w), x[7] - bfhi(p.w)); }
__device__ __forceinline__ bf16x8 cat44(u32x2 a, u32x2 b) { u32x4 p; p.x = a.x; p.y = a.y; p.z = b.x; p.w = b.y; return __builtin_bit_cast(bf16x8, p); }
#define LDS_WAIT() asm volatile("s_waitcnt lgkmcnt(0)" ::: "memory")
#define PIN(x) asm volatile("" : "+v"(x) :: "memory")
__device__ __forceinline__ int tid_now() { int t = threadIdx.x; asm volatile("" : "+v"(t)); return t; }

namespace g8 {
constexpr int BM = 256, BK = 64, HALF = 128, HTB = HALF * BK * 2, NXCD = 8, WGM = 8;
__device__ __forceinline__ int lds_byte(int r, int c) { const int st = (r >> 4) * 2 + (c >> 5), rr = r & 15, cc = c & 31, ob = rr * 64 + cc * 2; return st * 1024 + (ob ^ (((ob >> 9) & 1) << 5)); }
__device__ __forceinline__ void stage_rc(int b, int& R, int& C) { const int st = b / 1024, sb = b % 1024, swz = sb ^ (((sb >> 9) & 1) << 5); R = (st >> 1) * 16 + swz / 64; C = (st & 1) * 32 + (swz % 64) / 2; }
__device__ __forceinline__ int perm32(int rho) { const int n = rho >> 4, i = rho & 15; return 8 * (i >> 2) + 4 * n + (i & 3); }

struct Unit { int pm, pn, e, mt; };

struct DenseSched {
    const char* A; const char* Bt; int K, nM, nN, nwg, G, c;
    __device__ __forceinline__ void init(const void* A_, const void* Bt_, int M, int N, int K_, int G_, int c_) { A = (const char*)A_; Bt = (const char*)Bt_; K = K_; nM = M / BM; nN = N / BM; nwg = nM * nN; G = G_; c = c_; }
    __device__ __forceinline__ bool next(int i, Unit& u) const {
        const long L = (long)i * G + c; if (L >= nwg) return false;
        int wgid = (int)L; { const int q = nwg / NXCD, r = nwg % NXCD, xcd = wgid % NXCD, off = wgid / NXCD; wgid = (xcd < r ? xcd * (q + 1) : r * (q + 1) + (xcd - r) * q) + off; }
        const int nig = WGM * nN, gid = wgid / nig, fm = gid * WGM, gsz = (nM - fm) < WGM ? (nM - fm) : WGM;
        u.pm = fm + ((wgid % nig) % gsz); u.pn = (wgid % nig) / gsz; u.e = 0; u.mt = 0; return true;
    }
    __device__ __forceinline__ unsigned a_off(const Unit& u, int h, int R, int C) const { return (unsigned)(((u.pm * BM + h * HALF + R) * K + C) * 2); }
    __device__ __forceinline__ const char* b_ptr(const Unit& u) const { return Bt + (size_t)u.pn * BM * K * 2; }
};
template <bool GATHER> struct MoeSched {
    const char* A; const char* Bw; size_t wstride; int K, T, G, c; const LAS int* tile_e; const LAS int* tile_mt; const LAS int* cnt; const int* toklist;
    __device__ __forceinline__ bool next(int i, Unit& u) const {
        const int L = i * G + c; if (L >= 4 * T) return false;
        u.pm = L >> 2; u.pn = L & 3; u.e = __builtin_amdgcn_readfirstlane(tile_e[u.pm]); u.mt = __builtin_amdgcn_readfirstlane(tile_mt[u.pm]); return true;
    }
    __device__ __forceinline__ unsigned a_off(const Unit& u, int h, int R, int C) const {
        if (GATHER) { const int pos = u.mt * BM + h * HALF + R; int tok = 0; if (pos < cnt[u.e]) tok = toklist[u.e * MTOT + pos]; return (unsigned)((tok * K + C) * 2); }
        return (unsigned)(((u.pm * BM + h * HALF + R) * K + C) * 2);
    }
    __device__ __forceinline__ const char* b_ptr(const Unit& u) const { return Bw + (size_t)u.e * wstride + (size_t)u.pn * BM * K * 2; }
};

struct EpiBf16 {
    static constexpr bool PERM = true;
    bf16_t* O; int ldc;
    __device__ __forceinline__ void operator()(const f32x4 (&acc)[2][2][4][2], const Unit& u, int wr, int wc, int fr, int fq) const {
        const int row0 = u.pm * BM + wr * 64 + fr, col0 = u.pn * BM + wc * 32 + 8 * fq;
#pragma unroll
        for (int ai = 0; ai < 2; ++ai)
#pragma unroll
            for (int m = 0; m < 4; ++m) { bf16_t* rowp = O + (size_t)(row0 + ai * HALF + m * 16) * ldc + col0;
#pragma unroll
                for (int bj = 0; bj < 2; ++bj) { const f32x4 v0 = acc[ai][bj][m][0], v1 = acc[ai][bj][m][1];
                    u32x4 w; w.x = pk2(v0[0], v0[1]); w.y = pk2(v0[2], v0[3]); w.z = pk2(v1[0], v1[1]); w.w = pk2(v1[2], v1[3]);
                    *(u32x4*)(rowp + bj * HALF) = w; } }
    }
};
struct EpiFp8 {
    static constexpr bool PERM = true;
    unsigned char* O;
    __device__ __forceinline__ void operator()(const f32x4 (&acc)[2][2][4][2], const Unit& u, int wr, int wc, int fr, int fq) const {
        const int row0 = u.pm * BM + wr * 64 + fr, col0 = u.pn * BM + wc * 32 + 8 * fq;
#pragma unroll
        for (int ai = 0; ai < 2; ++ai)
#pragma unroll
            for (int m = 0; m < 4; ++m) { unsigned char* rowp = O + (size_t)(row0 + ai * HALF + m * 16) * 1024 + col0;
#pragma unroll
                for (int bj = 0; bj < 2; ++bj) { float v[8];
#pragma unroll
                    for (int i = 0; i < 4; ++i) { v[i] = fminf(fmaxf(acc[ai][bj][m][0][i] * 16.0f, -440.0f), 440.0f); v[4 + i] = fminf(fmaxf(acc[ai][bj][m][1][i] * 16.0f, -440.0f), 440.0f); }
                    int w0 = 0, w1 = 0;
                    w0 = __builtin_amdgcn_cvt_pk_fp8_f32(v[0], v[1], w0, false); w0 = __builtin_amdgcn_cvt_pk_fp8_f32(v[2], v[3], w0, true);
                    w1 = __builtin_amdgcn_cvt_pk_fp8_f32(v[4], v[5], w1, false); w1 = __builtin_amdgcn_cvt_pk_fp8_f32(v[6], v[7], w1, true);
                    *(u32x2*)(rowp + bj * HALF) = (u32x2){(unsigned)w0, (unsigned)w1}; } }
    }
};
struct EpiSwiGLU {
    static constexpr bool PERM = true;
    bf16_t* O;
    __device__ __forceinline__ void operator()(const f32x4 (&acc)[2][2][4][2], const Unit& u, int wr, int wc, int fr, int fq) const {
        const int row0 = u.pm * BM + wr * 64 + fr, col0 = u.pn * HALF + wc * 32 + 8 * fq;
#pragma unroll
        for (int ai = 0; ai < 2; ++ai)
#pragma unroll
            for (int m = 0; m < 4; ++m) { bf16_t* rowp = O + (size_t)(row0 + ai * HALF + m * 16) * DEXP + col0;
                const f32x4 g0 = acc[ai][0][m][0], g1 = acc[ai][0][m][1], u0 = acc[ai][1][m][0], u1 = acc[ai][1][m][1];
                u32x4 w; w.x = pk2(siluf_(g0[0]) * u0[0], siluf_(g0[1]) * u0[1]); w.y = pk2(siluf_(g0[2]) * u0[2], siluf_(g0[3]) * u0[3]);
                w.z = pk2(siluf_(g1[0]) * u1[0], siluf_(g1[1]) * u1[1]); w.w = pk2(siluf_(g1[2]) * u1[2], siluf_(g1[3]) * u1[3]);
                *(u32x4*)rowp = w; }
    }
};
template <class Epi, class Sched>
__device__ __forceinline__ void gemm_phase(LAS unsigned char* lds, const Sched& S, const Epi& E) {
    const int tid = tid_now(), wid = __builtin_amdgcn_readfirstlane(tid >> 6), lane = tid & 63, wr = wid >> 2, wc = wid & 3, fr = lane & 15, fq = lane >> 4;
    const int K = S.K, nt = K / BK;
    unsigned voffB[2];
#pragma unroll
    for (int i = 0; i < 2; ++i) { int R, C; stage_rc(tid * 16 + i * 8192, R, C); const int Rb = Epi::PERM ? ((R & ~31) + perm32(R & 31)) : R; voffB[i] = (unsigned)(Rb * K + C) * 2u; }
    const size_t kstep = (size_t)(BK * 2);
    const size_t hstep = (size_t)HALF * K * 2;
    const unsigned ldsw = (unsigned)wid * 1024u;
    const int aoff = lds_byte(wr * 64 + fr, fq * 8), boff = lds_byte(wc * 32 + fr, fq * 8);
#define G8_SA(b, h) (((b) * 2 + (h)) * HTB)
#define G8_SB(b, h) ((4 + (b) * 2 + (h)) * HTB)
#define G8_STAGE(bufoff, gbase, voff) do { const unsigned long long _g = (unsigned long long)(gbase); \
        const char* _gb = (const char*)(((unsigned long long)(unsigned)__builtin_amdgcn_readfirstlane((int)(unsigned)(_g >> 32)) << 32) | (unsigned long long)(unsigned)__builtin_amdgcn_readfirstlane((int)(unsigned)_g)); \
        _Pragma("unroll") for (int _i = 0; _i < 2; ++_i) \
        __builtin_amdgcn_global_load_lds((const unsigned*)(_gb + (voff)[_i]), (LAS unsigned*)(lds + (bufoff) + ldsw + _i * 8192), 16, 0, 0); } while (0)
#define G8_LDA(dst, b, h) do { _Pragma("unroll") for (int m = 0; m < 4; ++m) _Pragma("unroll") for (int k = 0; k < 2; ++k) dst[m][k] = *(const LAS bf16x8*)(lds + G8_SA(b, h) + aoff + m * 2048 + k * 1024); } while (0)
#define G8_LDB(dst, b, h) do { _Pragma("unroll") for (int n = 0; n < 2; ++n) _Pragma("unroll") for (int k = 0; k < 2; ++k) dst[n][k] = *(const LAS bf16x8*)(lds + G8_SB(b, h) + boff + n * 2048 + k * 1024); } while (0)
#define G8_MMA(ai, bj, At, Bt) do { __builtin_amdgcn_s_setprio(1); _Pragma("unroll") for (int m = 0; m < 4; ++m) _Pragma("unroll") for (int n = 0; n < 2; ++n) _Pragma("unroll") for (int k = 0; k < 2; ++k) \
        acc[ai][bj][m][n] = __builtin_amdgcn_mfma_f32_16x16x32_bf16(Bt[n][k], At[m][k], acc[ai][bj][m][n], 0, 0, 0); __builtin_amdgcn_s_setprio(0); } while (0)
#define G8_WAIT_V(n) asm volatile("s_waitcnt vmcnt(" #n ")" ::: "memory")
#define G8_WAIT_L(n) asm volatile("s_waitcnt lgkmcnt(" #n ")" ::: "memory")
#define G8_BAR __builtin_amdgcn_s_barrier()
#define G8_SCHED __builtin_amdgcn_sched_barrier(0)
    Unit cur, nxt; int ui = 0;
    if (!S.next(0, cur)) return;
    f32x4 acc[2][2][4][2];
#pragma unroll
    for (int a = 0; a < 2; ++a)
#pragma unroll
        for (int b = 0; b < 2; ++b)
#pragma unroll
            for (int m = 0; m < 4; ++m)
#pragma unroll
                for (int n = 0; n < 2; ++n) acc[a][b][m][n] = (f32x4){0.f, 0.f, 0.f, 0.f};
    bf16x8 At[4][2], B0[2][2], B1[2][2];
    unsigned vA0[2], vA1[2];
#pragma unroll
    for (int i = 0; i < 2; ++i) { int R, C; stage_rc(tid * 16 + i * 8192, R, C); vA0[i] = S.a_off(cur, 0, R, C); vA1[i] = S.a_off(cur, 1, R, C); }
    const char* const Ab = S.A;
    const char* cB = S.b_ptr(cur);
    G8_STAGE(G8_SB(0, 0), cB, voffB); G8_STAGE(G8_SA(0, 0), Ab, vA0); G8_STAGE(G8_SB(0, 1), cB + hstep, voffB); G8_STAGE(G8_SA(0, 1), Ab, vA1);
    if (wr == 1) G8_BAR;
    G8_WAIT_V(4); G8_BAR;
    G8_STAGE(G8_SB(1, 0), cB + kstep, voffB); G8_STAGE(G8_SA(1, 0), Ab + kstep, vA0); G8_STAGE(G8_SB(1, 1), cB + hstep + kstep, voffB);
    G8_WAIT_V(6); G8_BAR;
    for (;;) {
        const bool has_next = S.next(ui + 1, nxt);
        const char* nB = has_next ? S.b_ptr(nxt) : cB;
        unsigned nA0[2] = {vA0[0], vA0[1]}, nA1[2] = {vA1[0], vA1[1]};
        if (has_next) {
#pragma unroll
            for (int i = 0; i < 2; ++i) { int R, C; stage_rc(tid * 16 + i * 8192, R, C); nA0[i] = S.a_off(nxt, 0, R, C); nA1[i] = S.a_off(nxt, 1, R, C); }
        }
        for (int t = 0; t < nt; t += 2) {
            const bool last = (t == nt - 2);
            const char* a1 = Ab + (size_t)(t + 1) * kstep;
            const char* a2 = last ? Ab : Ab + (size_t)(t + 2) * kstep; const char* b2 = last ? nB : cB + (size_t)(t + 2) * kstep;
            const char* a3 = a2 + kstep; const char* b3 = b2 + kstep;
            G8_LDB(B0, 0, 0); G8_SCHED; G8_LDA(At, 0, 0); G8_STAGE(G8_SA(1, 1), a1, vA1);
            G8_WAIT_L(8); G8_BAR; G8_WAIT_L(0); G8_MMA(0, 0, At, B0); G8_BAR; G8_SCHED;
            if (last) {
#pragma unroll
                for (int i = 0; i < 2; ++i) { vA0[i] = nA0[i]; vA1[i] = nA1[i]; }
            }
            G8_LDB(B1, 0, 1); G8_STAGE(G8_SB(0, 0), b2, voffB);
            G8_BAR; G8_WAIT_L(0); G8_MMA(0, 1, At, B1); G8_BAR;
            G8_LDA(At, 0, 1); G8_STAGE(G8_SA(0, 0), a2, vA0);
            G8_BAR; G8_WAIT_L(0); G8_MMA(1, 0, At, B0); G8_BAR; G8_SCHED;
            G8_STAGE(G8_SB(0, 1), b2 + hstep, voffB);
            G8_WAIT_V(6); G8_BAR; G8_MMA(1, 1, At, B1); G8_BAR;
            G8_LDB(B0, 1, 0); G8_SCHED; G8_LDA(At, 1, 0); G8_STAGE(G8_SA(0, 1), a2, vA1);
            G8_WAIT_L(8); G8_BAR; G8_WAIT_L(0); G8_MMA(0, 0, At, B0); G8_BAR; G8_SCHED;
            G8_LDB(B1, 1, 1); G8_STAGE(G8_SB(1, 0), b3, voffB);
            G8_BAR; G8_WAIT_L(0); G8_MMA(0, 1, At, B1); G8_BAR;
            G8_LDA(At, 1, 1); G8_STAGE(G8_SA(1, 0), a3, vA0);
            G8_BAR; G8_WAIT_L(0); G8_MMA(1, 0, At, B0); G8_BAR; G8_SCHED;
            G8_STAGE(G8_SB(1, 1), b3 + hstep, voffB);
            G8_WAIT_V(6); G8_BAR; G8_MMA(1, 1, At, B1); G8_BAR;
        }
        E(acc, cur, wr, wc, fr, fq);
        if (!has_next) break;
#pragma unroll
        for (int a = 0; a < 2; ++a)
#pragma unroll
            for (int b = 0; b < 2; ++b)
#pragma unroll
                for (int m = 0; m < 4; ++m)
#pragma unroll
                    for (int n = 0; n < 2; ++n) acc[a][b][m][n] = (f32x4){0.f, 0.f, 0.f, 0.f};
        cur = nxt; cB = nB; ++ui;
    }
    G8_WAIT_V(0);
    if (wr == 0) G8_BAR;
    G8_BAR;
#undef G8_SA
#undef G8_SB
#undef G8_STAGE
#undef G8_LDA
#undef G8_LDB
#undef G8_MMA
#undef G8_WAIT_V
#undef G8_WAIT_L
#undef G8_BAR
#undef G8_SCHED
}
}

struct Args { const float* in[29]; float* out; unsigned char* ws; int ph_lo, ph_hi; };
enum { I_X = 0, I_C, I_CTX, I_CCTX, I_WMOD, I_BMOD, I_G1, I_G2, I_WIN, I_GWF, I_GBF, I_GWB, I_GBB, I_GOUT, I_CONFW, I_CONFB, I_CONFG, I_CONFBETA, I_SCW, I_POOLW, I_POOLS, I_WOUT, I_RWG, I_RBG, I_RWE, I_RBE, I_EIN, I_EOUT, I_GFINAL };

__device__ __forceinline__ void transpose_item(const float* W, int K, int N, bf16_t* WT, int kb, int n0, int dst_row0, LAS float* scr, int lane) {
    const int k0 = 64 * kb;
    float wv[32];
#pragma unroll
    for (int i = 0; i < 32; ++i) { const int kk = 2 * i + (lane >> 5); wv[i] = W[(size_t)(k0 + kk) * N + n0 + (lane & 31)]; }
#pragma unroll
    for (int i = 0; i < 32; ++i) PIN(wv[i]);
#pragma unroll
    for (int i = 0; i < 32; ++i) { const int kk = 2 * i + (lane >> 5); scr[kk * 33 + (lane & 31)] = wv[i]; }
    LDS_WAIT(); asm volatile("" ::: "memory");
    const int c = lane & 7;
#pragma unroll
    for (int j = 0; j < 4; ++j) { const int n = (lane >> 3) + 8 * j; const LAS float* s = scr + (8 * c) * 33 + n;
        u32x4 o; o.x = pk2(s[0 * 33], s[1 * 33]); o.y = pk2(s[2 * 33], s[3 * 33]); o.z = pk2(s[4 * 33], s[5 * 33]); o.w = pk2(s[6 * 33], s[7 * 33]);
        *(u32x4*)(WT + (size_t)(dst_row0 + n) * K + k0 + 8 * c) = o; }
    LDS_WAIT(); asm volatile("" ::: "memory");
}

constexpr int CV_SMALL = 3360, CV_E0 = 3360, CV_EI1 = 27936, CV_EO1 = 44320, CV_END = 52512;
constexpr int CV_G = 4480;
constexpr int CV_A = 5184, CV_B = 5760;
constexpr int CV_C = 4096, CV_D = 2048, CV_E = 5184;
constexpr int CV_F = 4096;
constexpr int CV_P0_E0 = (CV_EI1 - CV_E0) - CV_G - CV_A - CV_B, CV_P0_EI1 = (CV_EO1 - CV_EI1) - CV_C - CV_D - CV_E, CV_P0_EO1 = (CV_END - CV_EO1) - CV_F;
__device__ __forceinline__ void convert_item(const Args& a, int idx, LAS float* scr, int lane) {
    unsigned char* ws = a.ws;
    if (idx < CV_SMALL) { const int l = idx / 1680; int r = idx % 1680;
        if (r < 1168) { const int kb = r / 73, nb = r % 73; transpose_item(a.in[I_WIN] + (size_t)l * 1024 * NIN, 1024, NIN, (bf16_t*)(ws + WS_WIN) + (size_t)l * NINP * 1024, kb, nb * 32, nb * 32, scr, lane); }
        else { r -= 1168; const int kb = r / 32, nb = r % 32; transpose_item(a.in[I_WOUT] + (size_t)l * 1024 * 1024, 1024, 1024, (bf16_t*)(ws + WS_WOUT) + (size_t)l * 1024 * 1024, kb, nb * 32, nb * 32, scr, lane); }
        return; }
    int l, r; bool is_in;
    if (idx < CV_EI1) { l = 0; r = idx - CV_E0; is_in = r < 16384; if (!is_in) r -= 16384; }
    else if (idx < CV_EO1) { l = 1; r = idx - CV_EI1; is_in = true; }
    else { l = 1; r = idx - CV_EO1; is_in = false; }
    if (is_in) { const int le = l * 32 + r / 512, q = r % 512, kb = q / 32, n0 = (q % 32) * 32;
        const int dst = n0 < 512 ? (256 * (n0 >> 7) + (n0 & 127)) : (256 * ((n0 - 512) >> 7) + 128 + ((n0 - 512) & 127));
        transpose_item(a.in[I_EIN] + (size_t)le * 1024 * 1024, 1024, 1024, (bf16_t*)(ws + WS_WEIN) + (size_t)le * 1024 * 1024, kb, n0, dst, scr, lane); }
    else { const int le = l * 32 + r / 256, q = r % 256, kb = q / 32, nb = q % 32;
        transpose_item(a.in[I_EOUT] + (size_t)le * 512 * 1024, 512, 1024, (bf16_t*)(ws + WS_WEOUT) + (size_t)le * 1024 * 512, kb, nb * 32, nb * 32, scr, lane); }
}
__device__ __forceinline__ void convert_range(const Args& a, LAS unsigned char* lds, int first, int count, int rank, int nparts) {
    const int tid = tid_now(), lane = tid & 63, wid = __builtin_amdgcn_readfirstlane(tid >> 6);
    LAS float* scr = (LAS float*)(lds + wid * 16384);
    const int per = (count + nparts - 1) / nparts, lo = rank * per, hi = (lo + per < count) ? lo + per : count;
    for (int j = lo + wid; j < hi; j += 8) convert_item(a, first + j, scr, lane);
}
__device__ __forceinline__ void convert_in_tail(const Args& a, LAS unsigned char* lds, int first, int count, int tot_units, int G, int c) {
    const int rem = tot_units % G;
    if (rem == 0) convert_range(a, lds, first, count, c, G);
    else if (c >= rem) convert_range(a, lds, first, count, c - rem, G - rem);
}

__device__ __forceinline__ void phase_p0(const Args& a, LAS unsigned char* lds) {
    const int tid = tid_now(), lane = tid & 63, wid = __builtin_amdgcn_readfirstlane(tid >> 6);
    unsigned char* ws = a.ws;
    for (int job = blockIdx.x; job < 192; job += gridDim.x) {
        const int l = job / 96, n0 = (job % 96) * 64;
        LAS float* sv = (LAS float*)lds;
        LAS float* red = (LAS float*)(lds + 5 * 1024 * 4);
        for (int i = tid; i < 5 * 1024; i += 512) { const int r = i >> 10, k = i & 1023; const float v = r < 4 ? a.in[I_C][r * 1024 + k] : a.in[I_CCTX][k]; sv[i] = siluf_(v); }
        __syncthreads();
        const int ks = tid >> 6, col = tid & 63;
        const float* w = a.in[I_WMOD] + (size_t)l * 1024 * 6144 + (size_t)(ks * 128) * 6144 + n0 + col;
        float acc[5] = {0.f, 0.f, 0.f, 0.f, 0.f};
#pragma unroll 8
        for (int k = 0; k < 128; ++k) { const float wv = w[(size_t)k * 6144];
#pragma unroll
            for (int r = 0; r < 5; ++r) acc[r] += sv[r * 1024 + ks * 128 + k] * wv; }
#pragma unroll
        for (int r = 0; r < 5; ++r) red[(ks * 5 + r) * 64 + col] = acc[r];
        __syncthreads();
        if (tid < 320) { const int r = tid >> 6; float s = 0.f;
#pragma unroll
            for (int q = 0; q < 8; ++q) s += red[(q * 5 + r) * 64 + col];
            ((float*)(ws + WS_MOD))[(size_t)(l * 5 + r) * 6144 + n0 + col] = s + a.in[I_BMOD][l * 6144 + n0 + col]; }
        __syncthreads();
    }
    LAS float* scr = (LAS float*)(lds + wid * 16384);
    const int gw = blockIdx.x * 8 + wid, NGW = gridDim.x * 8;
    constexpr int P0_N0 = CV_E0 + CV_P0_E0, P0_N1 = P0_N0 + CV_P0_EI1, P0_N2 = P0_N1 + CV_P0_EO1;
    for (int j = gw; j < P0_N2; j += NGW) { const int idx = j < P0_N0 ? j : (j < P0_N1 ? CV_EI1 + (j - P0_N0) : CV_EO1 + (j - P0_N1)); convert_item(a, idx, scr, lane); }
    for (int i = blockIdx.x * 512 + tid; i < 2 * 4096; i += gridDim.x * 512) { const int l = i >> 12, g = (i >> 10) & 3, k = i & 1023; ((float*)(ws + WS_TAB))[i] = a.in[I_RWG][l * 4096 + k * 4 + g]; }
    for (int i = blockIdx.x * 512 + tid; i < 2 * 4 * 64 * 64; i += gridDim.x * 512) { const int lg = i >> 12, dd = (i >> 6) & 63, c = i & 63;
        ((bf16_t*)(ws + WS_PWT))[i] = (bf16_t)(pk2(a.in[I_POOLW][(size_t)lg * 4096 + c * 64 + dd], 0.f) & 0xffffu); }
    for (int i = blockIdx.x * 512 + tid; i < 4 * 8 * 64; i += gridDim.x * 512) { const int wi = i >> 9, f = (i >> 6) & 7, ln = i & 63, mt = f >> 2, nt = (f >> 1) & 1, sq = f & 1, rr = ln & 31, hh = ln >> 5, hw = 1 << wi;
        const int t = 32 * nt + rr; int lo = t - hw, hi = t + hw; lo = lo < 0 ? 0 : lo; hi = hi > 64 ? 64 : hi; const int cnt = hi - lo;
        unsigned w4[4];
#pragma unroll
        for (int jp = 0; jp < 4; ++jp) { unsigned wd = 0u;
#pragma unroll
            for (int e = 0; e < 2; ++e) { const int j = 2 * jp + e, tp = 32 * mt + 16 * sq + 8 * (j >> 2) + 4 * hh + (j & 3);
                const int val = ((tp >= lo && tp < hi) ? 1 : 0) - (tp == t ? cnt : 0);
                wd |= (__float_as_uint((float)val) >> 16) << (16 * e); }
            w4[jp] = wd; }
        ((u32x4*)(ws + WS_BAND))[i] = (u32x4){w4[0], w4[1], w4[2], w4[3]}; }
    for (int i = blockIdx.x * 512 + tid; i < 2 * 224 * 1024 / 8; i += gridDim.x * 512) { const int l = i / (224 * 128), q = i % (224 * 128);
        *(u32x4*)((bf16_t*)(ws + WS_WIN) + (size_t)l * NINP * 1024 + (size_t)NIN * 1024 + (size_t)q * 8) = (u32x4){0u, 0u, 0u, 0u}; }
}

__device__ __forceinline__ void load_row(const float* xrow, int lane, f32x4 (&v)[4]) {
    const f32x4* xr = (const f32x4*)xrow + lane;
#pragma unroll
    for (int j = 0; j < 4; ++j) v[j] = xr[64 * j];
}
__device__ __forceinline__ void load_row_bf(const bf16_t* xrow, int lane, f32x4 (&v)[4]) {
#pragma unroll
    for (int j = 0; j < 4; ++j) { const u32x2 w = *((const u32x2*)xrow + lane + 64 * j); v[j] = (f32x4){bflo(w.x), bfhi(w.x), bflo(w.y), bfhi(w.y)}; }
}
__device__ __forceinline__ void store_row_bf(bf16_t* xrow, int lane, const f32x4 (&v)[4]) {
#pragma unroll
    for (int j = 0; j < 4; ++j) { u32x2 w; w.x = pk2(v[j].x, v[j].y); w.y = pk2(v[j].z, v[j].w); *((u32x2*)xrow + lane + 64 * j) = w; }
}
__device__ __forceinline__ float row_rstd(const f32x4 (&v)[4]) {
    float s = 0.f;
#pragma unroll
    for (int j = 0; j < 4; ++j) s += (v[j].x * v[j].x + v[j].y * v[j].y) + (v[j].z * v[j].z + v[j].w * v[j].w);
    return rsqrtf(wave_sum(s) * (1.0f / D) + EPS);
}
__device__ __forceinline__ void norm_mod_store(f32x4 (&v)[4], float rstd, const float* g, const float* sc, const float* sh, bf16_t* hrow, int lane) {
#pragma unroll
    for (int j = 0; j < 4; ++j) { const f32x4 gv = *((const f32x4*)g + lane + 64 * j), scv = *((const f32x4*)sc + lane + 64 * j), shv = *((const f32x4*)sh + lane + 64 * j);
        v[j] = (v[j] * rstd * gv) * (1.0f + scv) + shv;
        u32x2 w; w.x = pk2(v[j].x, v[j].y); w.y = pk2(v[j].z, v[j].w);
        *((u32x2*)hrow + lane + 64 * j) = w; }
}

__device__ __forceinline__ void norm_store_cached(f32x4 (&v)[4], float rstd, const f32x4 (&GS)[4], const f32x4 (&SH)[4], bf16_t* hrow, int lane) {
#pragma unroll
    for (int j = 0; j < 4; ++j) { v[j] = (v[j] * rstd) * GS[j] + SH[j];
        u32x2 w; w.x = pk2(v[j].x, v[j].y); w.y = pk2(v[j].z, v[j].w);
        *((u32x2*)hrow + lane + 64 * j) = w; }
}
__device__ __forceinline__ void load_mod_cached(const float* g, const float* sc, const float* sh, const float* ga, int lane, f32x4 (&GS)[4], f32x4 (&SH)[4], f32x4 (&GA)[4]) {
#pragma unroll
    for (int j = 0; j < 4; ++j) { const f32x4 gv = *((const f32x4*)g + lane + 64 * j), scv = *((const f32x4*)sc + lane + 64 * j);
        GS[j] = gv * (1.0f + scv); SH[j] = *((const f32x4*)sh + lane + 64 * j); GA[j] = *((const f32x4*)ga + lane + 64 * j); }
}

__device__ __forceinline__ void phase_norm1_l0(const Args& a) {
    const int lane = tid_now() & 63, wid = tid_now() >> 6, gw = blockIdx.x * 8 + wid, NGW = gridDim.x * 8;
    const float* MOD = (const float*)(a.ws + WS_MOD); bf16_t* H = (bf16_t*)(a.ws + WS_H);
    int cur_b = -1; f32x4 GS[4], SH[4], GA[4];
#pragma unroll 1
    for (int m = gw; m < MTOT; m += 2 * NGW) {
        const int m2 = m + NGW; const bool has2 = m2 < MTOT; const int m2c = has2 ? m2 : m;
        const float* src = m < NLAT ? a.in[I_X] + (size_t)m * D : a.in[I_CTX] + (size_t)(m - NLAT) * D;
        const float* src2 = m2c < NLAT ? a.in[I_X] + (size_t)m2c * D : a.in[I_CTX] + (size_t)(m2c - NLAT) * D;
        const int b = m < NLAT ? (m >> 13) : 4, b2 = m2c < NLAT ? (m2c >> 13) : 4;
        f32x4 v[4], v2[4]; load_row(src, lane, v); load_row(src2, lane, v2);
        const float rstd = row_rstd(v), rstd2 = row_rstd(v2);
        if (b != cur_b) { const float* mod = MOD + (size_t)b * 6144; load_mod_cached(a.in[I_G1], mod + 1024, mod, mod, lane, GS, SH, GA); cur_b = b; }
        norm_store_cached(v, rstd, GS, SH, H + (size_t)m * D, lane);
        if (has2) { if (b2 != cur_b) { const float* mod = MOD + (size_t)b2 * 6144; load_mod_cached(a.in[I_G1], mod + 1024, mod, mod, lane, GS, SH, GA); cur_b = b2; }
            norm_store_cached(v2, rstd2, GS, SH, H + (size_t)m2 * D, lane); }
    }
}

struct ChunkPos { int b, sf, sb; };
__device__ __forceinline__ ChunkPos chunk_pos(int chunk) {
    ChunkPos p;
    if (chunk < 512) { p.b = chunk >> 7; const int n = chunk & 127; p.sf = 4 + n; p.sb = 4 + 127 - n; }
    else { const int cc = chunk - 512; p.b = cc >> 2; const int n = cc & 3; p.sf = n; p.sb = 3 - n; }
    return p;
}

constexpr int VS = 72;
__device__ __forceinline__ void gla_prep_dir(int dir, int lane, const float (&w)[8], float bias, const bf16x8 (&Az)[2], f32x16 (&BT)[2]) {
    asm volatile("" : "+v"(lane));
    const int r = lane & 31, hf = lane >> 5;
    const f32x16 zero16 = {0.f, 0.f, 0.f, 0.f, 0.f, 0.f, 0.f, 0.f, 0.f, 0.f, 0.f, 0.f, 0.f, 0.f, 0.f, 0.f};
    u32x4 mk[2];
#pragma unroll
    for (int s = 0; s < 2; ++s) { unsigned w4[4];
#pragma unroll
        for (int jp = 0; jp < 4; ++jp) { const int j0 = 2 * jp, j1 = 2 * jp + 1;
            const int t0 = 16 * s + 8 * (j0 >> 2) + 4 * hf + (j0 & 3), t1 = 16 * s + 8 * (j1 >> 2) + 4 * hf + (j1 & 3);
            const bool c0 = dir ? (t0 >= r) : (t0 <= r), c1 = dir ? (t1 >= r) : (t1 <= r);
            w4[jp] = (c0 ? 0x3F80u : 0u) | (c1 ? 0x3F800000u : 0u); }
        mk[s].x = w4[0]; mk[s].y = w4[1]; mk[s].z = w4[2]; mk[s].w = w4[3]; }
    bf16x8 Bhi, Blo; split8(w, Bhi, Blo);
    BT[0] = zero16; BT[1] = zero16;
#pragma unroll 1
    for (int mt = 0; mt < 2; ++mt) {
        const bf16x8 A = mt ? Az[1] : Az[0];
        f32x16 x = MFMA32(A, Bhi, zero16); x = MFMA32(A, Blo, x);
        float la[16];
#pragma unroll
        for (int i = 0; i < 16; ++i) { const float v = x[i] + bias; la[i] = (fminf(v, 0.f) - __logf(1.0f + __expf(-fabsf(v)))) * (1.0f / 16.0f); }
#pragma unroll
        for (int s = 0; s < 2; ++s) {
            const float t8[8] = {la[8 * s], la[8 * s + 1], la[8 * s + 2], la[8 * s + 3], la[8 * s + 4], la[8 * s + 5], la[8 * s + 6], la[8 * s + 7]};
            bf16x8 Lh, Ll; split8(t8, Lh, Ll);
#pragma unroll
            for (int nt = 0; nt < 2; ++nt) {
                const bool full = dir ? (mt > nt) : (mt < nt);
                u32x4 bm; const unsigned fv = full ? 0x3F803F80u : 0u;
                bm.x = (mt == nt) ? mk[s].x : fv; bm.y = (mt == nt) ? mk[s].y : fv; bm.z = (mt == nt) ? mk[s].z : fv; bm.w = (mt == nt) ? mk[s].w : fv;
                const bf16x8 Bm = __builtin_bit_cast(bf16x8, bm);
                BT[nt] = MFMA32(Lh, Bm, BT[nt]); BT[nt] = MFMA32(Ll, Bm, BT[nt]); }
        }
    }
}
__device__ __forceinline__ void gla_gate_loads(const Args& a, int l, int h, int dir, const bf16_t* cols0, int lane, float (&w)[8], float& bias, bf16x8 (&Az)[2]) {
    const int r = lane & 31, hf = lane >> 5;
    const float* wp = a.in[dir ? I_GWB : I_GWF] + (size_t)(l * 16 + 8 * hf) * 128 + 32 * h + r;
#pragma unroll
    for (int j = 0; j < 8; ++j) w[j] = wp[j * 128];
    bias = a.in[dir ? I_GBB : I_GBF][l * 128 + 32 * h + r];
#pragma unroll
    for (int mt = 0; mt < 2; ++mt) Az[mt] = *(const bf16x8*)(cols0 + (size_t)(32 * mt + r) * NINP + C_ZF + 16 * dir + 8 * hf);
}
__device__ __forceinline__ void stage_vT(const bf16_t* cols0, int h, int lane, LAS bf16_t* vT) {
    u32x4 w[8];
#pragma unroll
    for (int q = 0; q < 8; ++q) { const int chunk = lane + 64 * q, t = chunk >> 3, cg = chunk & 7; w[q] = *(const u32x4*)(cols0 + (size_t)t * NINP + C_V + 64 * h + 8 * cg); }
#pragma unroll
    for (int q = 0; q < 8; ++q) PIN(w[q]);
#pragma unroll
    for (int q = 0; q < 8; ++q) { const int chunk = lane + 64 * q, t = chunk >> 3, cg = chunk & 7;
        LAS bf16_t* p = vT + (8 * cg) * VS + t;
        p[0 * VS] = (bf16_t)(w[q].x & 0xffffu); p[1 * VS] = (bf16_t)(w[q].x >> 16); p[2 * VS] = (bf16_t)(w[q].y & 0xffffu); p[3 * VS] = (bf16_t)(w[q].y >> 16);
        p[4 * VS] = (bf16_t)(w[q].z & 0xffffu); p[5 * VS] = (bf16_t)(w[q].z >> 16); p[6 * VS] = (bf16_t)(w[q].w & 0xffffu); p[7 * VS] = (bf16_t)(w[q].w >> 16); }
}
__device__ __forceinline__ void chunk_gla_item(const Args& a, int l, int tile, int h, int lane, LAS bf16_t* vT, LAS bf16_t* kdT) {
    const int r = lane & 31, hf = lane >> 5;
    const bf16_t* cols0 = (const bf16_t*)(a.ws + WS_COLS) + (size_t)tile * 64 * NINP;
    float* KV = (float*)(a.ws + WS_KV); float* DEC = (float*)(a.ws + WS_DEC);
    const ChunkPos cp = chunk_pos(tile);
    const f32x16 zero16 = {0.f, 0.f, 0.f, 0.f, 0.f, 0.f, 0.f, 0.f, 0.f, 0.f, 0.f, 0.f, 0.f, 0.f, 0.f, 0.f};
    stage_vT(cols0, h, lane, vT);
#pragma unroll 1
    for (int dir = 0; dir < 2; ++dir) {
        float gw8[8], gbias; bf16x8 Az[2]; u32x2 kraw[2][4];
        gla_gate_loads(a, l, h, dir, cols0, lane, gw8, gbias, Az);
#pragma unroll
        for (int nt = 0; nt < 2; ++nt)
#pragma unroll
            for (int g = 0; g < 4; ++g) kraw[nt][g] = *(const u32x2*)(cols0 + (size_t)(32 * nt + r) * NINP + C_K + 32 * h + 4 * hf + 8 * g);
#pragma unroll
        for (int j = 0; j < 8; ++j) PIN(gw8[j]);
        PIN(gbias); PIN(Az[0]); PIN(Az[1]);
#pragma unroll
        for (int nt = 0; nt < 2; ++nt)
#pragma unroll
            for (int g = 0; g < 4; ++g) PIN(kraw[nt][g]);
        f32x16 BT[2]; gla_prep_dir(dir, lane, gw8, gbias, Az, BT);
        const size_t e = (size_t)((dir * 4 + cp.b) * 4 + h) * NSEQ + (dir ? cp.sb : cp.sf);
        const int srcl = (dir ? 0 : 31) + 32 * hf;
        float tot[16];
#pragma unroll
        for (int i = 0; i < 16; ++i) tot[i] = __shfl(dir ? BT[0][i] : BT[1][i], srcl);
        if (r == (dir ? 0 : 31)) {
#pragma unroll
            for (int i = 0; i < 16; ++i) DEC[e * 32 + (i & 3) + 8 * (i >> 2) + 4 * hf] = __expf(tot[i]);
        }
#pragma unroll
        for (int nt = 0; nt < 2; ++nt) {
#pragma unroll
            for (int g = 0; g < 4; ++g) { const u32x2 kw = kraw[nt][g];
                const float kf[4] = {bflo(kw.x), bfhi(kw.x), bflo(kw.y), bfhi(kw.y)};
#pragma unroll
                for (int q = 0; q < 4; ++q) { const int i = 4 * g + q; const float kd = kf[q] * __expf(tot[i] - BT[nt][i]);
                    kdT[(8 * g + 4 * hf + q) * VS + 32 * nt + r] = (bf16_t)(pk2c(kd, 0.f) & 0xffffu); } }
        }
        LDS_WAIT(); asm volatile("" ::: "memory");
#pragma unroll 1
        for (int ct = 0; ct < 2; ++ct) {
            f32x16 acc = zero16;
#pragma unroll
            for (int ks = 0; ks < 4; ++ks) {
                const bf16x8 A = *(const LAS bf16x8*)(vT + (32 * ct + r) * VS + 16 * ks + 8 * hf);
                const bf16x8 B = *(const LAS bf16x8*)(kdT + r * VS + 16 * ks + 8 * hf);
                acc = MFMA32(A, B, acc); }
            float* dst = KV + e * 2048 + (size_t)(32 * ct + 4 * hf) * 32 + r;
#pragma unroll
            for (int i = 0; i < 16; ++i) dst[((i & 3) + 8 * (i >> 2)) * 32] = acc[i];
        }
        LDS_WAIT(); asm volatile("" ::: "memory");
    }
}
__device__ __forceinline__ void chunk_agv_item(const Args& a, int row0, int lane) {
    const bf16_t* COLS = (const bf16_t*)(a.ws + WS_COLS); float* AGV = (float*)(a.ws + WS_AGV); float* CXV = (float*)(a.ws + WS_CXV);
    const int t = lane >> 3;
#pragma unroll
    for (int rep = 0; rep < 2; ++rep) { const int c8 = ((lane & 7) + 8 * rep) * 8; const bf16_t* rp = COLS + (size_t)(row0 + t) * NINP;
        float fa[8], fg[8], fc[8], fx[8];
        unpack8(*(const u32x4*)(rp + C_CA + 128 + c8), fa); unpack8(*(const u32x4*)(rp + C_CG + 128 + c8), fg);
        unpack8(*(const u32x4*)(rp + C_SC + 128 + c8), fc); unpack8(*(const u32x4*)(rp + C_SX + 128 + c8), fx);
        f32x4 o0, o1, p0, p1;
#pragma unroll
        for (int i = 0; i < 4; ++i) { o0[i] = fa[i] * sigmoidf_(fg[i]); o1[i] = fa[4 + i] * sigmoidf_(fg[4 + i]); p0[i] = fc[i] * fx[i]; p1[i] = fc[4 + i] * fx[4 + i]; }
        float* ao = AGV + (size_t)(row0 + t) * 128 + c8; float* co = CXV + (size_t)(row0 + t) * 128 + c8;
        *(f32x4*)ao = o0; *(f32x4*)(ao + 4) = o1; *(f32x4*)co = p0; *(f32x4*)(co + 4) = p1; }
}
__device__ __forceinline__ int next_item(LAS int* ctr, int lane) {
    int j = 0; if (lane == 0) j = __hip_atomic_fetch_add(ctr, 1, __ATOMIC_RELAXED, __HIP_MEMORY_SCOPE_WORKGROUP);
    return __builtin_amdgcn_readfirstlane(j);
}
__device__ __forceinline__ void phase_chunk(const Args& a, int l, LAS unsigned char* lds) {
    const int tid = tid_now(), lane = tid & 63, wid = __builtin_amdgcn_readfirstlane(tid >> 6);
    LAS bf16_t* vT = (LAS bf16_t*)(lds + wid * 16384); LAS bf16_t* kdT = vT + 64 * VS;
    LAS int* ctr = (LAS int*)(lds + MISC_OFF + 16);
    if (tid == 0) *ctr = 0;
    __syncthreads();
    const int b = blockIdx.x, G = gridDim.x, nL = b < 512 ? (511 - b) / G + 1 : 0, cx = (G >= 48 ? (b >= 32 && b < 48) : (b < 16)) ? 1 : 0, cxt = 512 + (G >= 48 ? b - 32 : b);
    for (;;) { int j = next_item(ctr, lane);
        if (j < 4 * nL) { chunk_gla_item(a, l, b + G * (j >> 2), j & 3, lane, vT, kdT); continue; }
        j -= 4 * nL;
        if (j < 4 * cx) { chunk_gla_item(a, l, cxt, j & 3, lane, vT, kdT); continue; }
        j -= 4 * cx; if (j >= 8 * nL) break;
        chunk_agv_item(a, (b + G * (j >> 3)) * 64 + (j & 7) * 8, lane);
    }
}
__device__ __forceinline__ void mixer_gla_item(const Args& a, int l, int tile, int h, int lane, LAS bf16_t* vT) {
    const bf16_t* cols0 = (const bf16_t*)(a.ws + WS_COLS) + (size_t)tile * 64 * NINP;
    const bf16_t* SIN = (const bf16_t*)(a.ws + WS_SIN); bf16_t* MIX = (bf16_t*)(a.ws + WS_MIX);
    const ChunkPos cp = chunk_pos(tile);
    const f32x16 zero16 = {0.f, 0.f, 0.f, 0.f, 0.f, 0.f, 0.f, 0.f, 0.f, 0.f, 0.f, 0.f, 0.f, 0.f, 0.f, 0.f};
    stage_vT(cols0, h, lane, vT);
    LDS_WAIT(); asm volatile("" ::: "memory");
    f32x16 OT[2][2] = {{zero16, zero16}, {zero16, zero16}};
#pragma unroll 1
    for (int dir = 0; dir < 2; ++dir) {
        int ln = lane; asm volatile("" : "+v"(ln)); const int r = ln & 31, hf = ln >> 5;
        bf16x8 QD[2][2], KI[2][2];
        const bf16_t* st = SIN + ((size_t)((dir * 4 + cp.b) * 4 + h) * NSEQ + (dir ? cp.sb : cp.sf)) * 2048;
        u32x2 sraw[2][2][2];
        { float gw8[8], gbias; bf16x8 Az[2]; u32x2 qraw[2][4], kraw[2][4];
            gla_gate_loads(a, l, h, dir, cols0, ln, gw8, gbias, Az);
#pragma unroll
            for (int nt = 0; nt < 2; ++nt)
#pragma unroll
                for (int g = 0; g < 4; ++g) { const bf16_t* qp = cols0 + (size_t)(32 * nt + r) * NINP + C_Q + 32 * h + 4 * hf + 8 * g; qraw[nt][g] = *(const u32x2*)qp; kraw[nt][g] = *(const u32x2*)(qp + (C_K - C_Q)); }
#pragma unroll
            for (int ct = 0; ct < 2; ++ct)
#pragma unroll
                for (int s = 0; s < 2; ++s) { const size_t off = (size_t)(32 * ct + r) * 32 + 16 * s + 4 * hf; sraw[ct][s][0] = *(const u32x2*)(st + off); sraw[ct][s][1] = *(const u32x2*)(st + off + 8); }
#pragma unroll
            for (int j = 0; j < 8; ++j) PIN(gw8[j]);
            PIN(gbias); PIN(Az[0]); PIN(Az[1]);
#pragma unroll
            for (int nt = 0; nt < 2; ++nt)
#pragma unroll
                for (int g = 0; g < 4; ++g) { PIN(qraw[nt][g]); PIN(kraw[nt][g]); }
#pragma unroll
            for (int ct = 0; ct < 2; ++ct)
#pragma unroll
                for (int s = 0; s < 2; ++s) { PIN(sraw[ct][s][0]); PIN(sraw[ct][s][1]); }
            f32x16 BT[2]; gla_prep_dir(dir, ln, gw8, gbias, Az, BT);
#pragma unroll
            for (int nt = 0; nt < 2; ++nt) {
                float qd[16], ki[16];
#pragma unroll
                for (int g = 0; g < 4; ++g) { const u32x2 qw = qraw[nt][g], kw = kraw[nt][g];
                    const float qf[4] = {bflo(qw.x), bfhi(qw.x), bflo(qw.y), bfhi(qw.y)}, kf[4] = {bflo(kw.x), bfhi(kw.x), bflo(kw.y), bfhi(kw.y)};
#pragma unroll
                    for (int q = 0; q < 4; ++q) { const float bb = BT[nt][4 * g + q]; qd[4 * g + q] = qf[q] * 0.17677669529663687f * __expf(bb); ki[4 * g + q] = kf[q] * __expf(-bb); } }
#pragma unroll
                for (int s = 0; s < 2; ++s) { QD[nt][s] = pack8f(qd[8 * s], qd[8 * s + 1], qd[8 * s + 2], qd[8 * s + 3], qd[8 * s + 4], qd[8 * s + 5], qd[8 * s + 6], qd[8 * s + 7]);
                    KI[nt][s] = pack8f(ki[8 * s], ki[8 * s + 1], ki[8 * s + 2], ki[8 * s + 3], ki[8 * s + 4], ki[8 * s + 5], ki[8 * s + 6], ki[8 * s + 7]); }
            }
        }
#pragma unroll
        for (int jt = 0; jt < 2; ++jt)
#pragma unroll
            for (int it = 0; it < 2; ++it) {
                if (jt != it) { const bool keep = dir ? (jt > it) : (jt < it); if (!keep) continue; }
                f32x16 p = MFMA32(KI[jt][0], QD[it][0], zero16); p = MFMA32(KI[jt][1], QD[it][1], p);
                if (jt == it) {
#pragma unroll
                    for (int i = 0; i < 16; ++i) { const int jj = (i & 3) + 8 * (i >> 2) + 4 * hf; const bool kp_ = dir ? (jj >= r) : (jj <= r); p[i] = kp_ ? p[i] : 0.f; }
                }
                const bf16x8 P0 = pack_step(p, 0), P1 = pack_step(p, 1);
#pragma unroll
                for (int ct = 0; ct < 2; ++ct) {
                    const LAS bf16_t* vp = vT + (32 * ct + r) * VS + 32 * jt + 4 * hf;
                    const bf16x8 A0 = cat44(*(const LAS u32x2*)vp, *(const LAS u32x2*)(vp + 8)), A1 = cat44(*(const LAS u32x2*)(vp + 16), *(const LAS u32x2*)(vp + 24));
                    OT[ct][it] = MFMA32(A0, P0, OT[ct][it]); OT[ct][it] = MFMA32(A1, P1, OT[ct][it]); }
            }
#pragma unroll
        for (int ct = 0; ct < 2; ++ct)
#pragma unroll
            for (int s = 0; s < 2; ++s) {
                const bf16x8 As = cat44(sraw[ct][s][0], sraw[ct][s][1]);
                OT[ct][0] = MFMA32(As, QD[0][s], OT[ct][0]); OT[ct][1] = MFMA32(As, QD[1][s], OT[ct][1]); }
    }
    int ln2 = lane; asm volatile("" : "+v"(ln2)); const int r = ln2 & 31, hf = ln2 >> 5;
    u32x2 graw[2][2][4]; f32x4 gor[2][4];
#pragma unroll
    for (int ct = 0; ct < 2; ++ct)
#pragma unroll
        for (int g = 0; g < 4; ++g) { const int c0 = 32 * ct + 8 * g + 4 * hf; gor[ct][g] = *(const f32x4*)(a.in[I_GOUT] + l * 256 + 64 * h + c0);
#pragma unroll
            for (int it = 0; it < 2; ++it) graw[it][ct][g] = *(const u32x2*)(cols0 + (size_t)(32 * it + r) * NINP + C_G + 64 * h + c0); }
#pragma unroll
    for (int ct = 0; ct < 2; ++ct)
#pragma unroll
        for (int g = 0; g < 4; ++g) { PIN(gor[ct][g]); PIN(graw[0][ct][g]); PIN(graw[1][ct][g]); }
#pragma unroll
    for (int it = 0; it < 2; ++it) {
        float ss = 0.f;
#pragma unroll
        for (int ct = 0; ct < 2; ++ct)
#pragma unroll
            for (int i = 0; i < 16; ++i) ss += OT[ct][it][i] * OT[ct][it][i];
        ss += __shfl_xor(ss, 32);
        const float rs = rsqrtf(ss * (1.0f / 64.0f) + EPS);
        const int t = 32 * it + r;
#pragma unroll
        for (int ct = 0; ct < 2; ++ct)
#pragma unroll
            for (int g = 0; g < 4; ++g) { const int c0 = 32 * ct + 8 * g + 4 * hf;
                const u32x2 gw_ = graw[it][ct][g];
                const f32x4 go = gor[ct][g];
                const float o0 = OT[ct][it][4 * g] * rs * go[0] * siluf_(bflo(gw_.x)), o1 = OT[ct][it][4 * g + 1] * rs * go[1] * siluf_(bfhi(gw_.x));
                const float o2 = OT[ct][it][4 * g + 2] * rs * go[2] * siluf_(bflo(gw_.y)), o3 = OT[ct][it][4 * g + 3] * rs * go[3] * siluf_(bfhi(gw_.y));
                u32x2 w; w.x = pk2c(o0, o1); w.y = pk2c(o2, o3);
                *(u32x2*)(MIX + (size_t)(tile * 64 + t) * D + 64 * h + c0) = w; }
    }
    LDS_WAIT(); asm volatile("" ::: "memory");
}
template <int TAPS>
__device__ __forceinline__ void vconv_item(const float* SRC, float* DST, const float* w  , int b, int col, int chg, LAS float* buf, int lane) {
    const int ch = lane & 31, rh = lane >> 5;
    const size_t base = ((size_t)b * SEQ + col) * 128 + chg * 32 + ch;
#pragma unroll 8
    for (int r = 0; r < 128; r += 2) buf[(r + rh) * 32 + ch] = SRC[base + (size_t)(r + rh) * 64 * 128];
    float wt[TAPS];
#pragma unroll
    for (int j = 0; j < TAPS; ++j) wt[j] = w[j * 256 + chg * 32 + ch];
    LDS_WAIT(); asm volatile("" ::: "memory");
    constexpr int HW = TAPS / 2;
#pragma unroll 1
    for (int r0 = 0; r0 < 64; r0 += 8) {
        const int rb = rh * 64 + r0;
        float o[8] = {0.f, 0.f, 0.f, 0.f, 0.f, 0.f, 0.f, 0.f};
#pragma unroll
        for (int j = 0; j < TAPS + 7; ++j) { const int rin = rb - HW + j; const float x = (rin >= 0 && rin < 128) ? buf[rin * 32 + ch] : 0.f;
#pragma unroll
            for (int q = 0; q < 8; ++q) { if (j - q >= 0 && j - q < TAPS) o[q] += x * wt[j - q]; } }
#pragma unroll
        for (int q = 0; q < 8; ++q) DST[base + (size_t)(rb + q) * 64 * 128] = o[q];
    }
    LDS_WAIT(); asm volatile("" ::: "memory");
}
__device__ __forceinline__ void phase_scan(const Args& a, int l, LAS unsigned char* lds) {
    const int tid = tid_now(), lane = tid & 63, wid = __builtin_amdgcn_readfirstlane(tid >> 6);
    const float* KV = (const float*)(a.ws + WS_KV); const float* DEC = (const float*)(a.ws + WS_DEC); bf16_t* SIN = (bf16_t*)(a.ws + WS_SIN);
    if (tid < 256) {
        for (int rp = 0; rp < ((REP_SUB == 5 && l == 0) ? 2 : 1); ++rp)
        for (int gid = blockIdx.x * 256 + tid; gid < 65536; gid += gridDim.x * 256) {
            const int e = gid >> 11, idx = gid & 2047;
            const float* p = KV + (size_t)e * NSEQ * 2048 + idx; const float* dp = DEC + (size_t)e * NSEQ * 32 + (idx & 31); bf16_t* q = SIN + (size_t)e * NSEQ * 2048 + idx;
            float st = 0.f;
#pragma unroll 1
            for (int s0 = 0; s0 < NSEQ; s0 += 22) {
                float kv[22], dd[22];
#pragma unroll
                for (int u = 0; u < 22; ++u) { kv[u] = p[(size_t)(s0 + u) * 2048]; dd[u] = dp[(s0 + u) * 32]; }
#pragma unroll
                for (int u = 0; u < 22; ++u) { PIN(kv[u]); PIN(dd[u]); }
#pragma unroll
                for (int u = 0; u < 22; ++u) { q[(size_t)(s0 + u) * 2048] = (bf16_t)(pk2c(st, 0.f) & 0xffffu); st = dd[u] * st + kv[u]; }
            }
        }
    }
    LAS float* buf = (LAS float*)(lds + wid * 16384);
    const int gw = blockIdx.x * 8 + wid, NGW = gridDim.x * 8;
    for (int rp = 0; rp < ((REP_SUB == 6 && l == 0) ? 2 : 1); ++rp)
    for (int it = gw; it < 2048; it += NGW) {
        const int kind = it >> 10, q = it & 1023, b = q >> 8, col = (q >> 2) & 63, chg = q & 3;
        if (kind == 0) vconv_item<31>((const float*)(a.ws + WS_AGV), (float*)(a.ws + WS_UV), a.in[I_CONFW] + (size_t)l * 31 * 256 + 128, b, col, chg, buf, lane);
        else vconv_item<3>((const float*)(a.ws + WS_CXV), (float*)(a.ws + WS_SCV), a.in[I_SCW] + (size_t)l * 3 * 256 + 128, b, col, chg, buf, lane);
    }
}

__device__ __forceinline__ void mixer_conv_item(const Args& a, int l, int tile, int tg, int lane0, LAS float* U) {
    const bf16_t* COLS = (const bf16_t*)(a.ws + WS_COLS); bf16_t* MIX = (bf16_t*)(a.ws + WS_MIX);
    const int row0 = tile * 64, T0 = 16 * tg;
    const float* confw = a.in[I_CONFW] + (size_t)l * 31 * 256; const float* scw = a.in[I_SCW] + (size_t)l * 3 * 256;
#pragma unroll 1
    for (int p = 0; p < 2; ++p) {
        int lane = lane0; asm volatile("" : "+v"(lane));
        const int c = 64 * p + lane;
        float wv[31];
#pragma unroll
        for (int j = 0; j < 31; ++j) wv[j] = confw[j * 256 + c];
        float bias = a.in[I_CONFB][l * 256 + c];
        unsigned ra[46], rg[46];
#pragma unroll
        for (int i = 0; i < 46; ++i) { const int t = T0 - 15 + i, tc = t < 0 ? 0 : (t > 63 ? 63 : t); const bf16_t* rp = COLS + (size_t)(row0 + tc) * NINP + c; ra[i] = rp[C_CA]; rg[i] = rp[C_CG]; }
#pragma unroll
        for (int j = 0; j < 31; ++j) PIN(wv[j]);
        PIN(bias);
#pragma unroll
        for (int i = 0; i < 46; ++i) { PIN(ra[i]); PIN(rg[i]); }
        float ag[46];
#pragma unroll
        for (int i = 0; i < 46; ++i) { const int t = T0 - 15 + i; const float m = (t >= 0 && t < 64) ? 1.0f : 0.0f;
            ag[i] = m * __uint_as_float(ra[i] << 16) * __builtin_amdgcn_rcpf(1.0f + __expf(-__uint_as_float(rg[i] << 16))); }
#pragma unroll
        for (int q = 0; q < 16; ++q) { float o = bias;
#pragma unroll
            for (int j = 0; j < 31; ++j) o += ag[q + j] * wv[j];
            U[q * 256 + ((((c >> 2) ^ q) << 2) | (c & 3))] = o; }
        unsigned rc[18], rx[18], rsb[16];
        float w0 = scw[c], w1 = scw[256 + c], w2 = scw[512 + c];
#pragma unroll
        for (int i = 0; i < 18; ++i) { const int t = T0 - 1 + i, tc = t < 0 ? 0 : (t > 63 ? 63 : t); const bf16_t* rp = COLS + (size_t)(row0 + tc) * NINP + c; rc[i] = rp[C_SC]; rx[i] = rp[C_SX]; }
#pragma unroll
        for (int q = 0; q < 16; ++q) rsb[q] = COLS[(size_t)(row0 + T0 + q) * NINP + C_SB + c];
        PIN(w0); PIN(w1); PIN(w2);
#pragma unroll
        for (int i = 0; i < 18; ++i) { PIN(rc[i]); PIN(rx[i]); }
#pragma unroll
        for (int q = 0; q < 16; ++q) PIN(rsb[q]);
        float cx[18];
#pragma unroll
        for (int i = 0; i < 18; ++i) { const int t = T0 - 1 + i; const float m = (t >= 0 && t < 64) ? 1.0f : 0.0f; cx[i] = m * __uint_as_float(rc[i] << 16) * __uint_as_float(rx[i] << 16); }
#pragma unroll
        for (int q = 0; q < 16; ++q) { const float cv = cx[q] * w0 + cx[q + 1] * w1 + cx[q + 2] * w2;
            MIX[(size_t)(row0 + T0 + q) * D + 512 + c] = (bf16_t)(pk2c(__uint_as_float(rsb[q] << 16) * cv, 0.f) & 0xffffu); }
    }
    {
        int lane = lane0; asm volatile("" : "+v"(lane));
        const float* UV = (const float*)(a.ws + WS_UV); const float* SCV = (const float*)(a.ws + WS_SCV);
        f32x4 uu[8], svv[8], bzz[8]; u32x2 sbb[8];
#pragma unroll
        for (int k8 = 0; k8 < 8; ++k8) { const int idx = lane + 64 * k8, t = idx >> 5, c4 = (idx & 31) * 4; const size_t row = (size_t)(row0 + T0 + t);
            uu[k8] = *(const f32x4*)(UV + row * 128 + c4); bzz[k8] = *(const f32x4*)(a.in[I_CONFB] + l * 256 + 128 + c4);
            svv[k8] = *(const f32x4*)(SCV + row * 128 + c4); sbb[k8] = *(const u32x2*)(COLS + row * NINP + C_SB + 128 + c4); }
#pragma unroll
        for (int k8 = 0; k8 < 8; ++k8) { PIN(uu[k8]); PIN(bzz[k8]); PIN(svv[k8]); PIN(sbb[k8]); }
#pragma unroll
        for (int k8 = 0; k8 < 8; ++k8) { const int idx = lane + 64 * k8, t = idx >> 5, c4 = (idx & 31) * 4; const size_t row = (size_t)(row0 + T0 + t);
            *(LAS f32x4*)(U + t * 256 + ((((128 + c4) >> 2) ^ t) << 2)) = uu[k8] + bzz[k8];
            u32x2 w; w.x = pk2c(bflo(sbb[k8].x) * svv[k8][0], bfhi(sbb[k8].x) * svv[k8][1]); w.y = pk2c(bflo(sbb[k8].y) * svv[k8][2], bfhi(sbb[k8].y) * svv[k8][3]);
            *(u32x2*)(MIX + row * D + 512 + 128 + c4) = w; }
    }
    LDS_WAIT(); asm volatile("" ::: "memory");
    {
        int lane = lane0; asm volatile("" : "+v"(lane));
        const int t = lane >> 2, qd = lane & 3;
        f32x4 lgv[16], lbv[16];
        { const float* lg = a.in[I_CONFG] + l * 256 + 64 * qd; const float* lb = a.in[I_CONFBETA] + l * 256 + 64 * qd;
#pragma unroll
            for (int i = 0; i < 16; ++i) { lgv[i] = *(const f32x4*)(lg + 4 * i); lbv[i] = *(const f32x4*)(lb + 4 * i); }
#pragma unroll
            for (int i = 0; i < 16; ++i) { PIN(lgv[i]); PIN(lbv[i]); } }
        f32x4 v[16]; float s1 = 0.f;
#pragma unroll
        for (int i = 0; i < 16; ++i) { v[i] = *(const LAS f32x4*)(U + t * 256 + (((16 * qd + i) ^ t) << 2)); s1 += (v[i][0] + v[i][1]) + (v[i][2] + v[i][3]); }
        s1 += __shfl_xor(s1, 1); s1 += __shfl_xor(s1, 2);
        const float mean = s1 * (1.0f / 256.0f); float s2 = 0.f;
#pragma unroll
        for (int i = 0; i < 16; ++i) { v[i] = v[i] - mean; s2 += (v[i][0] * v[i][0] + v[i][1] * v[i][1]) + (v[i][2] * v[i][2] + v[i][3] * v[i][3]); }
        s2 += __shfl_xor(s2, 1); s2 += __shfl_xor(s2, 2);
        const float rstd = rsqrtf(s2 * (1.0f / 256.0f) + EPS);
        bf16_t* dst = MIX + (size_t)(row0 + T0 + t) * D + 256 + 64 * qd;
#pragma unroll
        for (int i = 0; i < 16; i += 2) { const f32x4 g0 = lgv[i], g1 = lgv[i + 1], b0 = lbv[i], b1 = lbv[i + 1];
            const f32x4 y0 = v[i] * rstd * g0 + b0, y1 = v[i + 1] * rstd * g1 + b1;
            u32x4 w; w.x = pk2c(siluf_(y0[0]), siluf_(y0[1])); w.y = pk2c(siluf_(y0[2]), siluf_(y0[3])); w.z = pk2c(siluf_(y1[0]), siluf_(y1[1])); w.w = pk2c(siluf_(y1[2]), siluf_(y1[3]));
            *(u32x4*)(dst + 4 * i) = w; }
    }
    LDS_WAIT(); asm volatile("" ::: "memory");
}
__device__ __forceinline__ void mixer_pool_item(const Args& a, int l, int tile, int g, int lane0) {
    const bf16_t* COLS = (const bf16_t*)(a.ws + WS_COLS); bf16_t* MIX = (bf16_t*)(a.ws + WS_MIX);
    const f32x16 zero16 = {0.f, 0.f, 0.f, 0.f, 0.f, 0.f, 0.f, 0.f, 0.f, 0.f, 0.f, 0.f, 0.f, 0.f, 0.f, 0.f};
    const int row0 = tile * 64;
    {
        int lane = lane0; asm volatile("" : "+v"(lane));
        const int r = lane & 31, hf = lane >> 5, hw = 1 << g;
        const bf16_t* pwt = (const bf16_t*)(a.ws + WS_PWT) + (size_t)(l * 4 + g) * 4096;
        const u32x4* band = (const u32x4*)(a.ws + WS_BAND) + (size_t)g * 512 + lane;
        f32x16 Y[2][2] = {{zero16, zero16}, {zero16, zero16}};
        bf16x8 Ax[2][4], Bw[2][4]; u32x4 Bb[8];
#pragma unroll
        for (int mt = 0; mt < 2; ++mt)
#pragma unroll
            for (int ks = 0; ks < 4; ++ks) { Ax[mt][ks] = *(const bf16x8*)(COLS + (size_t)(row0 + 32 * mt + r) * NINP + C_PL + 64 * g + 16 * ks + 8 * hf);
                Bw[mt][ks] = *(const bf16x8*)(pwt + (size_t)(32 * mt + r) * 64 + 16 * ks + 8 * hf); }
#pragma unroll
        for (int f = 0; f < 8; ++f) Bb[f] = band[f * 64];
        f32x4 psv[2][4];
#pragma unroll
        for (int ntd = 0; ntd < 2; ++ntd)
#pragma unroll
            for (int q = 0; q < 4; ++q) psv[ntd][q] = *(const f32x4*)(a.in[I_POOLS] + l * 256 + 64 * g + 32 * ntd + 8 * q + 4 * hf);
#pragma unroll
        for (int mt = 0; mt < 2; ++mt)
#pragma unroll
            for (int ks = 0; ks < 4; ++ks) { PIN(Ax[mt][ks]); PIN(Bw[mt][ks]); }
#pragma unroll
        for (int f = 0; f < 8; ++f) PIN(Bb[f]);
#pragma unroll
        for (int ntd = 0; ntd < 2; ++ntd)
#pragma unroll
            for (int q = 0; q < 4; ++q) PIN(psv[ntd][q]);
#pragma unroll
        for (int mt = 0; mt < 2; ++mt) {
#pragma unroll
            for (int ntd = 0; ntd < 2; ++ntd) {
                f32x16 z = zero16;
#pragma unroll
                for (int ks = 0; ks < 4; ++ks) z = MFMA32(Ax[mt][ks], Bw[ntd][ks], z);
#pragma unroll
                for (int sq = 0; sq < 2; ++sq) {
                    const float t8[8] = {z[8 * sq], z[8 * sq + 1], z[8 * sq + 2], z[8 * sq + 3], z[8 * sq + 4], z[8 * sq + 5], z[8 * sq + 6], z[8 * sq + 7]};
                    bf16x8 Zh, Zl; split8(t8, Zh, Zl);
#pragma unroll
                    for (int ntt = 0; ntt < 2; ++ntt) { const bf16x8 Bq = __builtin_bit_cast(bf16x8, Bb[(mt * 2 + ntt) * 2 + sq]);
                        Y[ntd][ntt] = MFMA32(Zh, Bq, Y[ntd][ntt]); Y[ntd][ntt] = MFMA32(Zl, Bq, Y[ntd][ntt]); }
                }
            }
        }
#pragma unroll
        for (int ntt = 0; ntt < 2; ++ntt) { const int t = 32 * ntt + r; int lo = t - hw, hi = t + hw; lo = lo < 0 ? 0 : lo; hi = hi > 64 ? 64 : hi; const float inv = 1.0f / (float)(hi - lo);
#pragma unroll
            for (int ntd = 0; ntd < 2; ++ntd)
#pragma unroll
                for (int q = 0; q < 4; ++q) { const int dd0 = 32 * ntd + 8 * q + 4 * hf; const f32x4 ps = psv[ntd][q];
                    u32x2 w; w.x = pk2c(Y[ntd][ntt][4 * q] * inv * ps[0], Y[ntd][ntt][4 * q + 1] * inv * ps[1]); w.y = pk2c(Y[ntd][ntt][4 * q + 2] * inv * ps[2], Y[ntd][ntt][4 * q + 3] * inv * ps[3]);
                    *(u32x2*)(MIX + (size_t)(row0 + t) * D + 768 + 64 * g + dd0) = w; } }
    }
}

__device__ __forceinline__ void mixer_local(const Args& a, int l, int tile, int half, LAS unsigned char* lds) {
    const int tid = tid_now();
    const bf16_t* COLS = (const bf16_t*)(a.ws + WS_COLS); bf16_t* MIX = (bf16_t*)(a.ws + WS_MIX);
    LAS float* AG = (LAS float*)lds;
    LAS float* U = AG + 7936;
    LAS float* CX = U + 8192;
    const bool lat = tile < 512; const int r0 = tile * 64 + half * 32;
    const int seq_lo = lat ? tile * 64 : (NLAT + ((tile - 512) >> 2) * CTXL), seq_hi = lat ? tile * 64 + 64 : seq_lo + CTXL;
    const float* confw = a.in[I_CONFW] + (size_t)l * 31 * 256; const float* scw = a.in[I_SCW] + (size_t)l * 3 * 256;
    const int npass = lat ? 1 : 2;
    for (int ps = 0; ps < npass; ++ps) {
        const int chb = ps * 128;
        for (int idx = tid; idx < 62 * 16; idx += 512) { const int tt = idx >> 4, c8 = (idx & 15) * 8, r = r0 - 15 + tt;
            float o[8] = {0.f, 0.f, 0.f, 0.f, 0.f, 0.f, 0.f, 0.f};
            if (r >= seq_lo && r < seq_hi) { const bf16_t* rp = COLS + (size_t)r * NINP; float fa[8], fg[8]; unpack8(*(const u32x4*)(rp + C_CA + chb + c8), fa); unpack8(*(const u32x4*)(rp + C_CG + chb + c8), fg);
#pragma unroll
                for (int i = 0; i < 8; ++i) o[i] = fa[i] * sigmoidf_(fg[i]); }
            *(LAS f32x4*)(AG + tt * 128 + c8) = (f32x4){o[0], o[1], o[2], o[3]}; *(LAS f32x4*)(AG + tt * 128 + c8 + 4) = (f32x4){o[4], o[5], o[6], o[7]}; }
        for (int idx = tid; idx < 34 * 16; idx += 512) { const int tt = idx >> 4, c8 = (idx & 15) * 8, r = r0 - 1 + tt;
            float o[8] = {0.f, 0.f, 0.f, 0.f, 0.f, 0.f, 0.f, 0.f};
            if (r >= seq_lo && r < seq_hi) { const bf16_t* rp = COLS + (size_t)r * NINP; float fc[8], fx[8]; unpack8(*(const u32x4*)(rp + C_SC + chb + c8), fc); unpack8(*(const u32x4*)(rp + C_SX + chb + c8), fx);
#pragma unroll
                for (int i = 0; i < 8; ++i) o[i] = fc[i] * fx[i]; }
            *(LAS f32x4*)(CX + tt * 128 + c8) = (f32x4){o[0], o[1], o[2], o[3]}; *(LAS f32x4*)(CX + tt * 128 + c8 + 4) = (f32x4){o[4], o[5], o[6], o[7]}; }
        __syncthreads();
        { const int c = tid & 127, t0 = (tid >> 7) * 8;
            float wv[31];
#pragma unroll
            for (int j = 0; j < 31; ++j) wv[j] = confw[j * 256 + chb + c];
            const float bias = a.in[I_CONFB][l * 256 + chb + c];
            const float w0 = scw[chb + c], w1 = scw[256 + chb + c], w2 = scw[512 + chb + c];
            float o[8];
#pragma unroll
            for (int q = 0; q < 8; ++q) o[q] = bias;
#pragma unroll
            for (int j = 0; j < 38; ++j) { const float x = AG[(t0 + j) * 128 + c];
#pragma unroll
                for (int q = 0; q < 8; ++q) { if (j - q >= 0 && j - q < 31) o[q] += x * wv[j - q]; } }
#pragma unroll
            for (int q = 0; q < 8; ++q) U[(t0 + q) * 256 + chb + c] = o[q];
            unsigned sbr[8];
#pragma unroll
            for (int q = 0; q < 8; ++q) sbr[q] = COLS[(size_t)(r0 + t0 + q) * NINP + C_SB + chb + c];
#pragma unroll
            for (int q = 0; q < 8; ++q) PIN(sbr[q]);
#pragma unroll
            for (int q = 0; q < 8; ++q) { const int t = t0 + q; const float cv = CX[t * 128 + c] * w0 + CX[(t + 1) * 128 + c] * w1 + CX[(t + 2) * 128 + c] * w2;
                const float sb = __uint_as_float(sbr[q] << 16);
                MIX[(size_t)(r0 + t) * D + 512 + chb + c] = (bf16_t)(pk2(sb * cv, 0.f) & 0xffffu); }
        }
        __syncthreads();
    }
    if (lat) {
        const float* UV = (const float*)(a.ws + WS_UV); const float* SCV = (const float*)(a.ws + WS_SCV);
        for (int idx = tid; idx < 32 * 32; idx += 512) { const int t = idx >> 5, c4 = (idx & 31) * 4;
            const f32x4 u = *(const f32x4*)(UV + (size_t)(r0 + t) * 128 + c4), bz = *(const f32x4*)(a.in[I_CONFB] + l * 256 + 128 + c4);
            *(LAS f32x4*)(U + t * 256 + 128 + c4) = u + bz;
            const f32x4 sv = *(const f32x4*)(SCV + (size_t)(r0 + t) * 128 + c4);
            const u32x2 sbw = *(const u32x2*)(COLS + (size_t)(r0 + t) * NINP + C_SB + 128 + c4);
            u32x2 w; w.x = pk2(bflo(sbw.x) * sv[0], bfhi(sbw.x) * sv[1]); w.y = pk2(bflo(sbw.y) * sv[2], bfhi(sbw.y) * sv[3]);
            *(u32x2*)(MIX + (size_t)(r0 + t) * D + 512 + 128 + c4) = w; }
        __syncthreads();
    }
    { const int t = tid >> 4, c0 = (tid & 15) * 16;
        float s = 0.f;
#pragma unroll
        for (int i = 0; i < 16; i += 4) { const f32x4 v = *(const LAS f32x4*)(U + t * 256 + c0 + i); s += (v[0] + v[1]) + (v[2] + v[3]); }
        s += __shfl_xor(s, 1); s += __shfl_xor(s, 2); s += __shfl_xor(s, 4); s += __shfl_xor(s, 8);
        const float mean = s * (1.0f / 256.0f); float q = 0.f;
#pragma unroll
        for (int i = 0; i < 16; i += 4) { const f32x4 v = *(const LAS f32x4*)(U + t * 256 + c0 + i) - mean; q += (v[0] * v[0] + v[1] * v[1]) + (v[2] * v[2] + v[3] * v[3]); }
        q += __shfl_xor(q, 1); q += __shfl_xor(q, 2); q += __shfl_xor(q, 4); q += __shfl_xor(q, 8);
        const float rstd = rsqrtf(q * (1.0f / 256.0f) + EPS);
        const float* lg = a.in[I_CONFG] + l * 256 + c0; const float* lb = a.in[I_CONFBETA] + l * 256 + c0;
#pragma unroll
        for (int i = 0; i < 16; i += 8) { float y[8];
#pragma unroll
            for (int k = 0; k < 8; ++k) y[k] = siluf_((U[t * 256 + c0 + i + k] - mean) * rstd * lg[i + k] + lb[i + k]);
            u32x4 w; w.x = pk2(y[0], y[1]); w.y = pk2(y[2], y[3]); w.z = pk2(y[4], y[5]); w.w = pk2(y[6], y[7]);
            *(u32x4*)(MIX + (size_t)(r0 + t) * D + 256 + c0 + i) = w; }
    }
    __syncthreads();
    for (int hf = 0; hf < 2; ++hf) {
        LAS float* PI = (LAS float*)lds;
        LAS float* DF = PI + 6144;
        LAS float* PW = DF + 4224;
        for (int idx = tid; idx < 48 * 16; idx += 512) { const int tt = idx >> 4, c8 = (idx & 15) * 8, r = r0 - 8 + tt;
            float o[8] = {0.f, 0.f, 0.f, 0.f, 0.f, 0.f, 0.f, 0.f};
            if (r >= seq_lo && r < seq_hi) unpack8(*(const u32x4*)(COLS + (size_t)r * NINP + C_PL + hf * 128 + c8), o);
            *(LAS f32x4*)(PI + tt * 128 + c8) = (f32x4){o[0], o[1], o[2], o[3]}; *(LAS f32x4*)(PI + tt * 128 + c8 + 4) = (f32x4){o[4], o[5], o[6], o[7]}; }
        for (int idx = tid; idx < 2 * 64 * 64 / 4; idx += 512) *(LAS f32x4*)(PW + idx * 4) = *(const f32x4*)(a.in[I_POOLW] + (size_t)l * 4 * 4096 + (size_t)hf * 2 * 4096 + idx * 4);
        __syncthreads();
        for (int idx = tid; idx < 32 * 128; idx += 512) { const int t = idx >> 7, c = idx & 127, g = hf * 2 + (c >> 6); const int hw = 1 << g;
            const int r = r0 + t; int lo = r - hw, hi = r + hw; lo = lo < seq_lo ? seq_lo : lo; hi = hi > seq_hi ? seq_hi : hi;
            float sm = 0.f; for (int rr = lo; rr < hi; ++rr) sm += PI[(rr - r0 + 8) * 128 + c];
            DF[t * 132 + c] = sm / (float)(hi - lo) - PI[(t + 8) * 128 + c]; }
        __syncthreads();
        { const int gl = tid >> 8, tp = (tid >> 4) & 15, dq = tid & 15; const int dd0 = dq * 4;
            f32x4 o[2] = {(f32x4){0.f, 0.f, 0.f, 0.f}, (f32x4){0.f, 0.f, 0.f, 0.f}};
#pragma unroll 2
            for (int c4 = 0; c4 < 64; c4 += 4) { f32x4 dv[2];
#pragma unroll
                for (int x = 0; x < 2; ++x) dv[x] = *(const LAS f32x4*)(DF + (tp * 2 + x) * 132 + gl * 64 + c4);
#pragma unroll
                for (int q = 0; q < 4; ++q) { const f32x4 wv = *(const LAS f32x4*)(PW + (gl * 64 + c4 + q) * 64 + dd0);
#pragma unroll
                    for (int x = 0; x < 2; ++x) o[x] += dv[x][q] * wv; } }
            const int ch = (hf * 2 + gl) * 64 + dd0; const f32x4 ps = *(const f32x4*)(a.in[I_POOLS] + l * 256 + ch);
#pragma unroll
            for (int x = 0; x < 2; ++x) { u32x2 w; w.x = pk2(o[x][0] * ps[0], o[x][1] * ps[1]); w.y = pk2(o[x][2] * ps[2], o[x][3] * ps[3]);
                *(u32x2*)(MIX + (size_t)(r0 + tp * 2 + x) * D + 768 + ch) = w; } }
        __syncthreads();
    }
}

__device__ __forceinline__ void phase_mixer(const Args& a, int l, LAS unsigned char* lds) {
    const int ntile = (l == 1) ? 512 : NCHUNK;
    { const int tid = tid_now(), lane = tid & 63, wid = __builtin_amdgcn_readfirstlane(tid >> 6);
        LAS bf16_t* vT = (LAS bf16_t*)(lds + wid * 16384);
        LAS int* ctr = (LAS int*)(lds + MISC_OFF + 16);
        if (tid == 0) *ctr = 0;
        __syncthreads();
        const int b = blockIdx.x, G = gridDim.x, nL = b < 512 ? (511 - b) / G + 1 : 0, cx = (l == 0 && (G >= 48 ? (b >= 32 && b < 48) : (b < 16))) ? 1 : 0, cxt = 512 + (G >= 48 ? b - 32 : b);
        for (;;) { int j = next_item(ctr, lane);
            if (j < 4 * nL) { mixer_gla_item(a, l, b + G * (j >> 2), j & 3, lane, vT); continue; }
            j -= 4 * nL;
            if (j < 4 * cx) { mixer_gla_item(a, l, cxt, j & 3, lane, vT); continue; }
            j -= 4 * cx;
            if (j < 4 * nL) { mixer_conv_item(a, l, b + G * (j >> 2), j & 3, lane, (LAS float*)vT); continue; }
            j -= 4 * nL; if (j >= 4 * nL) break;
            mixer_pool_item(a, l, b + G * (j >> 2), j & 3, lane); } }
    if (l == 0) {
        if ((int)gridDim.x > 32 && (int)blockIdx.x >= 32) convert_range(a, lds, CV_E0 + CV_P0_E0, CV_G, (int)blockIdx.x - 32, (int)gridDim.x - 32);
        else { if ((int)gridDim.x <= 32) convert_range(a, lds, CV_E0 + CV_P0_E0, CV_G, (int)blockIdx.x, (int)gridDim.x);
            __syncthreads();
            for (int it = blockIdx.x; it < 16 * 2; it += gridDim.x) mixer_local(a, l, 512 + (it >> 1), it & 1, lds); }
    }
}

__device__ __forceinline__ void phase_router(const Args& a, int l, LAS unsigned char* lds) {
    const int tid = tid_now(), lane = tid & 63, wid = tid >> 6;
    const int M = (l == 1) ? NLAT : MTOT;
    const float* MOD = (const float*)(a.ws + WS_MOD) + (size_t)l * 5 * 6144; bf16_t* H = (bf16_t*)(a.ws + WS_H);
    LAS float* WRE = (LAS float*)lds;
    LAS int* INFO = (LAS int*)(lds + MISC_OFF + 4096);
    LAS int* HIST = (LAS int*)(lds + MISC_OFF + 2048);
    const float* wre = a.in[I_RWE] + (size_t)l * 1024 * 32; const float* wrgT = (const float*)(a.ws + WS_TAB) + (size_t)l * 4096;
    for (int i = tid; i < 1024 * 8; i += 512) { const int k = i >> 3, q = i & 7; const f32x4 w = *(const f32x4*)(wre + k * 32 + q * 4);
        WRE[(4 * q + 0) * 1024 + k] = w[0]; WRE[(4 * q + 1) * 1024 + k] = w[1]; WRE[(4 * q + 2) * 1024 + k] = w[2]; WRE[(4 * q + 3) * 1024 + k] = w[3]; }
    if (tid < 64) HIST[tid] = 0;
    __syncthreads();
    const int per = (M + gridDim.x - 1) / gridDim.x; const int r_lo = blockIdx.x * per; int r_hi = r_lo + per; if (r_hi > M) r_hi = M;
    const float rbg0 = a.in[I_RBG][l * 4 + 0], rbg1 = a.in[I_RBG][l * 4 + 1], rbg2 = a.in[I_RBG][l * 4 + 2], rbg3 = a.in[I_RBG][l * 4 + 3];
    bf16_t* XB = (bf16_t*)(a.ws + WS_XB); const bf16_t* Y1 = (const bf16_t*)(a.ws + WS_Y);
    int cur_b = -1; f32x4 GS[4], SH[4], GA[4], WGT[4][4];
#pragma unroll
    for (int g = 0; g < 4; ++g)
#pragma unroll
        for (int j = 0; j < 4; ++j) WGT[g][j] = *((const f32x4*)(wrgT + g * 1024) + lane + 64 * j);
    for (int rp = 0; rp < ((REP_SUB == 7 && l == 0) ? 2 : 1); ++rp)
#pragma unroll 1
    for (int mm = r_lo + wid; mm < r_hi; mm += 16) {
        f32x4 vv[2][4]; u32x2 yy[2][4]; int mrow[2]; bool has[2];
#pragma unroll
        for (int rr = 0; rr < 2; ++rr) { const int m = mm + 8 * rr; has[rr] = m < r_hi; const int mc = has[rr] ? m : mm; mrow[rr] = mc;
            if (l == 0) load_row(mc < NLAT ? a.in[I_X] + (size_t)mc * D : a.in[I_CTX] + (size_t)(mc - NLAT) * D, lane, vv[rr]);
            else load_row_bf(XB + (size_t)mc * D, lane, vv[rr]);
#pragma unroll
            for (int j = 0; j < 4; ++j) yy[rr][j] = *((const u32x2*)(Y1 + (size_t)mc * D) + lane + 64 * j); }
#pragma unroll
        for (int rr = 0; rr < 2; ++rr) {
            if (!has[rr]) continue;
            const int m = mrow[rr]; const int b = m < NLAT ? (m >> 13) : 4;
            if (b != cur_b) { const float* mod = MOD + (size_t)b * 6144; load_mod_cached(a.in[I_G2] + l * 1024, mod + 4 * 1024, mod + 3 * 1024, mod + 2 * 1024, lane, GS, SH, GA); cur_b = b; }
            f32x4 v[4];
#pragma unroll
            for (int j = 0; j < 4; ++j) { const u32x2 y = yy[rr][j]; v[j] = vv[rr][j] + GA[j] * (f32x4){bflo(y.x), bfhi(y.x), bflo(y.y), bfhi(y.y)}; }
            store_row_bf(XB + (size_t)m * D, lane, v);
            const float rstd = row_rstd(v);
            norm_store_cached(v, rstd, GS, SH, H + (size_t)m * D, lane);
            float ga_[4] = {0.f, 0.f, 0.f, 0.f};
#pragma unroll
            for (int g = 0; g < 4; ++g)
#pragma unroll
                for (int j = 0; j < 4; ++j) { const f32x4 w = WGT[g][j]; ga_[g] += (v[j][0] * w[0] + v[j][1] * w[1]) + (v[j][2] * w[2] + v[j][3] * w[3]); }
            float lg0, lg1, lg2, lg3;
            { const bool h5 = (lane & 32) != 0, h4 = (lane & 16) != 0;
                float k0 = h5 ? ga_[2] : ga_[0], k1 = h5 ? ga_[3] : ga_[1]; const float s0 = h5 ? ga_[0] : ga_[2], s1 = h5 ? ga_[1] : ga_[3];
                k0 += __shfl_xor(s0, 32); k1 += __shfl_xor(s1, 32);
                float kk = h4 ? k1 : k0; const float sk = h4 ? k0 : k1; kk += __shfl_xor(sk, 16);
                kk += __shfl_xor(kk, 8); kk += __shfl_xor(kk, 4); kk += __shfl_xor(kk, 2); kk += __shfl_xor(kk, 1);
                lg0 = __int_as_float(__builtin_amdgcn_readlane(__float_as_int(kk), 0)) + rbg0; lg1 = __int_as_float(__builtin_amdgcn_readlane(__float_as_int(kk), 16)) + rbg1;
                lg2 = __int_as_float(__builtin_amdgcn_readlane(__float_as_int(kk), 32)) + rbg2; lg3 = __int_as_float(__builtin_amdgcn_readlane(__float_as_int(kk), 48)) + rbg3; }
            int grp = 0; float best = lg0; if (lg1 > best) { best = lg1; grp = 1; } if (lg2 > best) { best = lg2; grp = 2; } if (lg3 > best) { best = lg3; grp = 3; }
            const float pg = 1.0f / (__expf(lg0 - best) + __expf(lg1 - best) + __expf(lg2 - best) + __expf(lg3 - best));
            grp = __builtin_amdgcn_readfirstlane(grp);
            float ep[8];
            { const LAS float* wb = WRE + (size_t)(grp * 8) * 1024;
#pragma unroll
                for (int i = 0; i < 8; i += 2) { f32x4 w[2][4];
#pragma unroll
                    for (int u = 0; u < 2; ++u)
#pragma unroll
                        for (int j = 0; j < 4; ++j) w[u][j] = *((const LAS f32x4*)(wb + (i + u) * 1024) + lane + 64 * j);
#pragma unroll
                    for (int u = 0; u < 2; ++u)
#pragma unroll
                        for (int j = 0; j < 4; ++j) PIN(w[u][j]);
#pragma unroll
                    for (int u = 0; u < 2; ++u) { float acc_ = 0.f;
#pragma unroll
                        for (int j = 0; j < 4; ++j) acc_ += (v[j][0] * w[u][j][0] + v[j][1] * w[u][j][1]) + (v[j][2] * w[u][j][2] + v[j][3] * w[u][j][3]);
                        ep[i + u] = acc_; } } }
            float le[8];
            { const bool h5 = (lane & 32) != 0, h4 = (lane & 16) != 0, h3 = (lane & 8) != 0;
                float k4[4];
#pragma unroll
                for (int i = 0; i < 4; ++i) { const float keep = h5 ? ep[4 + i] : ep[i], send = h5 ? ep[i] : ep[4 + i]; k4[i] = keep + __shfl_xor(send, 32); }
                float k2[2];
#pragma unroll
                for (int i = 0; i < 2; ++i) { const float keep = h4 ? k4[2 + i] : k4[i], send = h4 ? k4[i] : k4[2 + i]; k2[i] = keep + __shfl_xor(send, 16); }
                float kk = h3 ? k2[1] : k2[0]; const float sk = h3 ? k2[0] : k2[1]; kk += __shfl_xor(sk, 8);
                kk += __shfl_xor(kk, 4); kk += __shfl_xor(kk, 2); kk += __shfl_xor(kk, 1);
#pragma unroll
                for (int i = 0; i < 8; ++i) le[i] = __int_as_float(__builtin_amdgcn_readlane(__float_as_int(kk), 8 * i)) + a.in[I_RBE][l * 32 + grp * 8 + i]; }
            int i0 = 0; float v0 = le[0];
#pragma unroll
            for (int i = 1; i < 8; ++i) if (le[i] > v0) { v0 = le[i]; i0 = i; }
            int i1 = -1; float v1 = -3.0e38f;
#pragma unroll
            for (int i = 0; i < 8; ++i) if (i != i0 && le[i] > v1) { v1 = le[i]; i1 = i; }
            const float w0 = 1.0f / (1.0f + __expf(v1 - v0)); const float w1 = 1.0f - w0;
            if (lane == 0) { const int lr = m - r_lo; INFO[lr * 4 + 0] = grp * 8 + i0; INFO[lr * 4 + 1] = grp * 8 + i1; INFO[lr * 4 + 2] = __float_as_int(w0 * pg); INFO[lr * 4 + 3] = __float_as_int(w1 * pg); }
        }
    }
    __syncthreads();
    const int nr = r_hi - r_lo; int lp0 = 0, lp1 = 0, ee0 = 0, ee1 = 0;
    if (tid < nr) { ee0 = INFO[tid * 4 + 0]; ee1 = INFO[tid * 4 + 1]; lp0 = atomicAdd((int*)(HIST + ee0), 1); lp1 = atomicAdd((int*)(HIST + ee1), 1); }
    __syncthreads();
    unsigned* cnt = (unsigned*)(a.ws + WS_CTL) + CW_CNT + l * 32 * 64;
    if (tid < 32) { const int c = HIST[tid]; HIST[32 + tid] = c ? (int)atomicAdd(cnt + tid * 64, (unsigned)c) : 0; }
    __syncthreads();
    if (tid < nr) { const int m = r_lo + tid; const int p0 = HIST[32 + ee0] + lp0, p1 = HIST[32 + ee1] + lp1;
        int* TL = (int*)(a.ws + WS_TOKLIST); TL[ee0 * MTOT + p0] = m; TL[ee1 * MTOT + p1] = m;
        *((i32x4*)(a.ws + WS_TOKINFO) + m) = (i32x4){(ee0 << 20) | p0, (ee1 << 20) | p1, INFO[tid * 4 + 2], INFO[tid * 4 + 3]}; }
    __syncthreads();
}

__device__ __forceinline__ int moe_tables(const Args& a, int l, LAS unsigned char* lds) {
    LAS int* TB = (LAS int*)(lds + MISC_OFF + 256); LAS int* CN = TB + 64; LAS int* TE = (LAS int*)(lds + MISC_OFF + 1024); LAS int* TM = TE + 320;
    const unsigned* cnt = (const unsigned*)(a.ws + WS_CTL) + CW_CNT + l * 32 * 64;
    { const int tq_ = tid_now(); if (tq_ < 32) CN[tq_] = (int)__hip_atomic_load(cnt + tq_ * 64, __ATOMIC_RELAXED, __HIP_MEMORY_SCOPE_AGENT); }
    __syncthreads();
    if (tid_now() == 0) { int t = 0;
#pragma unroll 1
        for (int e = 0; e < 32; ++e) { TB[e] = t; const int nt = (CN[e] + 255) >> 8;
#pragma unroll 1
            for (int q = 0; q < nt; ++q) { TE[t + q] = e; TM[t + q] = q; } t += nt; } TB[32] = t; }
    __syncthreads();
    return __builtin_amdgcn_readfirstlane(TB[32]);
}

__device__ __forceinline__ void phase_combine(const Args& a, int l, LAS unsigned char* lds) {
    const int lane = tid_now() & 63, wid = tid_now() >> 6, gw = blockIdx.x * 8 + wid, NGW = gridDim.x * 8;
    const int M = (l == 1) ? NLAT : MTOT;
    (void)moe_tables(a, l, lds);
    const LAS int* TB = (const LAS int*)(lds + MISC_OFF + 256);
    const float* MOD = (const float*)(a.ws + WS_MOD); const unsigned char* Y = (const unsigned char*)(a.ws + WS_Y); bf16_t* H = (bf16_t*)(a.ws + WS_H);
    bf16_t* XB = (bf16_t*)(a.ws + WS_XB);
    int cur_b = -1; f32x4 GS[4], SH[4], GA[4];
#pragma unroll 1
    for (int mm = gw; mm < M; mm += 2 * NGW) {
        f32x4 vv[2][4]; unsigned ya[2][4], yb[2][4]; i32x4 inf[2]; int mrow[2]; bool has[2];
#pragma unroll
        for (int rr = 0; rr < 2; ++rr) { const int m = mm + rr * NGW; has[rr] = m < M; const int mc = has[rr] ? m : mm; mrow[rr] = mc;
            inf[rr] = *((const i32x4*)(a.ws + WS_TOKINFO) + mc);
            load_row_bf(XB + (size_t)mc * D, lane, vv[rr]); }
#pragma unroll
        for (int rr = 0; rr < 2; ++rr) { const int e0 = inf[rr].x >> 20, p0 = inf[rr].x & 0xfffff, e1 = inf[rr].y >> 20, p1 = inf[rr].y & 0xfffff;
            const unsigned char* y0 = Y + (size_t)(TB[e0] * 256 + p0) * D; const unsigned char* y1 = Y + (size_t)(TB[e1] * 256 + p1) * D;
#pragma unroll
            for (int j = 0; j < 4; ++j) { ya[rr][j] = *((const unsigned*)y0 + lane + 64 * j); yb[rr][j] = *((const unsigned*)y1 + lane + 64 * j); } }
#pragma unroll
        for (int rr = 0; rr < 2; ++rr) {
            if (!has[rr]) continue;
            const int m = mrow[rr]; const int b = m < NLAT ? (m >> 13) : 4;
            const float w0s = __int_as_float(inf[rr].z) * (1.0f / 16.0f), w1s = __int_as_float(inf[rr].w) * (1.0f / 16.0f);
            if (b != cur_b) { const float* ga2 = MOD + (size_t)(l * 5 + b) * 6144 + 5 * 1024;
                if (l == 0) { const float* mod = MOD + (size_t)(5 + b) * 6144; load_mod_cached(a.in[I_G1] + 1024, mod + 1024, mod, ga2, lane, GS, SH, GA); }
                else {
#pragma unroll
                    for (int j = 0; j < 4; ++j) { GS[j] = *((const f32x4*)a.in[I_GFINAL] + lane + 64 * j); SH[j] = (f32x4){0.f, 0.f, 0.f, 0.f}; GA[j] = *((const f32x4*)ga2 + lane + 64 * j); } }
                cur_b = b; }
            f32x4 v[4];
#pragma unroll
            for (int j = 0; j < 4; ++j) { const int a0 = (int)ya[rr][j], a1 = (int)yb[rr][j];
                f32x4 y; y[0] = w0s * __builtin_amdgcn_cvt_f32_fp8(a0, 0) + w1s * __builtin_amdgcn_cvt_f32_fp8(a1, 0); y[1] = w0s * __builtin_amdgcn_cvt_f32_fp8(a0, 1) + w1s * __builtin_amdgcn_cvt_f32_fp8(a1, 1);
                y[2] = w0s * __builtin_amdgcn_cvt_f32_fp8(a0, 2) + w1s * __builtin_amdgcn_cvt_f32_fp8(a1, 2); y[3] = w0s * __builtin_amdgcn_cvt_f32_fp8(a0, 3) + w1s * __builtin_amdgcn_cvt_f32_fp8(a1, 3);
                v[j] = vv[rr][j] + GA[j] * y; }
            const float rstd = row_rstd(v);
            if (l == 0) {
                store_row_bf(XB + (size_t)m * D, lane, v);
                norm_store_cached(v, rstd, GS, SH, H + (size_t)m * D, lane);
            } else {
                float* xr = a.out + (size_t)m * D;
#pragma unroll
                for (int j = 0; j < 4; ++j) *((f32x4*)xr + lane + 64 * j) = (v[j] * rstd) * GS[j];
            }
        }
    }
}

#define XB_TMO      128
#define XB_XCNT(j)  (256  + 64 * (j))
#define XB_XSUB(j)  (1280 + 64 * (j))
#define XB_XGEN(j)  (2304 + 64 * (j))
#define XB_TOP      3328
#define XB_TOPGEN   3392
#define XCD_BAR_WORDS 3456
#define XB_SPIN_CAP (1u << 22)
__device__ __forceinline__ unsigned xb_ld(unsigned* p)              { return __hip_atomic_load(p, __ATOMIC_RELAXED, __HIP_MEMORY_SCOPE_AGENT); }
__device__ __forceinline__ unsigned xb_add(unsigned* p, unsigned v) { return __hip_atomic_fetch_add(p, v, __ATOMIC_RELAXED, __HIP_MEMORY_SCOPE_AGENT); }
__device__ __forceinline__ unsigned xb_xcc_id() { return (unsigned)__builtin_amdgcn_s_getreg((3 << 11) | 20) & 0xFu; }
#define XB_SPIN(cond, bar) do { unsigned _sp = 0; while (cond) { __builtin_amdgcn_s_sleep(1); \
    if ((++_sp & 255u) == 0u) { if (xb_ld(&(bar)[XB_TMO])) break; if (_sp > XB_SPIN_CAP) { atomicAdd(&(bar)[XB_TMO], 1u); break; } } } } while (0)
struct XcdBarrier { unsigned* bar; unsigned x; volatile LAS unsigned* st; };
__device__ __forceinline__ XcdBarrier xcd_barrier_post(unsigned* bar, volatile LAS unsigned* st) {
    XcdBarrier b; b.bar = bar; b.x = xb_xcc_id(); b.st = st;
    if (threadIdx.x == 0) (void)xb_add(&bar[XB_XCNT(b.x)], 1u);
    return b;
}
__device__ __forceinline__ void xcd_barrier_complete(unsigned* bar, unsigned x, unsigned& nloc, unsigned& nx) {
    const unsigned G = gridDim.x * gridDim.y * gridDim.z;
    unsigned sum, cnt, mine, sp = 0u;
    for (;;) {
        sum = 0u; cnt = 0u; mine = 0u;
#pragma unroll
        for (unsigned j = 0; j < 16; ++j) { const unsigned c = xb_ld(&bar[XB_XCNT(j)]); sum += c; cnt += (c > 0u) ? 1u : 0u; mine = (j == x) ? c : mine; }
        if (sum == G) break;
        __builtin_amdgcn_s_sleep(1);
        if ((++sp & 255u) == 0u) { if (xb_ld(&bar[XB_TMO])) break; if (sp > XB_SPIN_CAP) { atomicAdd(&bar[XB_TMO], 1u); break; } }
    }
    nloc = mine > 0u ? mine : 1u; nx = cnt > 0u ? cnt : 1u;
}
__device__ __forceinline__ void xcd_barrier(const XcdBarrier& b) {
    asm volatile("s_waitcnt vmcnt(0)" ::: "memory");
    __syncthreads();
    if (threadIdx.x == 0) {
        unsigned* bar = b.bar;
        __builtin_amdgcn_s_waitcnt(0);
        unsigned nloc = b.st[0], nx = b.st[1];
        if (nloc == 0u) { xcd_barrier_complete(bar, b.x, nloc, nx); b.st[0] = nloc; b.st[1] = nx; }
        const unsigned old = xb_add(&bar[XB_XSUB(b.x)], 1u);
        const unsigned gen = old / nloc;
        if (old + 1u == (gen + 1u) * nloc) {
            __builtin_amdgcn_fence(__ATOMIC_RELEASE, "agent");
            asm volatile("s_waitcnt vmcnt(0)" ::: "memory");
            const unsigned og = xb_add(&bar[XB_TOP], 1u);
            const unsigned tg = og / nx;
            if (og + 1u == (tg + 1u) * nx) xb_add(&bar[XB_TOPGEN], 1u);
            else XB_SPIN(xb_ld(&bar[XB_TOPGEN]) == tg, bar);
            __builtin_amdgcn_fence(__ATOMIC_ACQUIRE, "agent");
            xb_add(&bar[XB_XGEN(b.x)], 1u);
            asm volatile("s_waitcnt vmcnt(0)" ::: "memory");
        } else {
            XB_SPIN(xb_ld(&bar[XB_XGEN(b.x)]) == gen, bar);
            __builtin_amdgcn_fence(__ATOMIC_ACQUIRE, "agent");
            asm volatile("s_waitcnt vmcnt(0)" ::: "memory");
        }
    }
    __syncthreads();
}

constexpr int NPHASE = 20;
#ifndef DIAG_PH
#define DIAG_PH -1
#endif
#define PH_ON(x) (DIAG_PH < 0 || DIAG_PH == (x))
#ifndef REP_ID
#define REP_ID -1
#endif
__global__ void __launch_bounds__(512, 2) mega(Args a) {
    extern __shared__ __attribute__((aligned(16))) unsigned char lds_raw[];
    LAS unsigned char* lds = (LAS unsigned char*)lds_raw;
    unsigned char* ws = a.ws;
    volatile LAS unsigned* bst = (volatile LAS unsigned*)(lds + MISC_OFF);
    if (threadIdx.x < 2) bst[threadIdx.x] = 0u;
    __syncthreads();
    XcdBarrier xbar = xcd_barrier_post((unsigned*)(ws + WS_CTL) + CW_BAR, bst);
    unsigned long long tph_ = 0ull;
    for (int ph = a.ph_lo; ph < a.ph_hi; ++ph) {
      unsigned long long t0_ = 0ull; if (TIME_PH >= 0 && ph == TIME_PH) t0_ = __builtin_amdgcn_s_memrealtime();
      const int cls_ = ph < 2 ? ph : 2 + (ph - 2) % 9;
      const int nrep_ = (REP_ID >= 0 && cls_ == REP_ID) ? 2 : 1;
      for (int rep_ = 0; rep_ < nrep_; ++rep_) {
        if (rep_) xcd_barrier(xbar);
        if (PH_ON(0) && ph == 0) phase_p0(a, lds);
        else if (PH_ON(1) && ph == 1) phase_norm1_l0(a);
        else {
            const int l = (ph - 2) / 9, sp = (ph - 2) % 9;
            if (PH_ON(2) && sp == 0) {
                g8::DenseSched S; S.init(ws + WS_H, ws + WS_WIN + (size_t)l * NINP * 1024 * 2, MTOT, NINP, 1024, gridDim.x, blockIdx.x);
                g8::EpiBf16 E{(bf16_t*)(ws + WS_COLS), NINP};
                g8::gemm_phase(lds, S, E);
                if (l == 0) convert_in_tail(a, lds, CV_E0 + CV_P0_E0 + CV_G, CV_A, S.nwg, S.G, S.c); else convert_in_tail(a, lds, CV_EI1 + CV_P0_EI1 + CV_C + CV_D, CV_E, S.nwg, S.G, S.c);
            } else if (PH_ON(3) && sp == 1) phase_chunk(a, l, lds);
            else if (PH_ON(4) && sp == 2) phase_scan(a, l, lds);
            else if (PH_ON(5) && sp == 3) phase_mixer(a, l, lds);
            else if (PH_ON(6) && sp == 4) {
                g8::DenseSched S; S.init(ws + WS_MIX, ws + WS_WOUT + (size_t)l * 1024 * 1024 * 2, l == 1 ? NLAT : MTOT, 1024, 1024, gridDim.x, blockIdx.x);
                g8::EpiBf16 E{(bf16_t*)(ws + WS_Y), 1024};
                g8::gemm_phase(lds, S, E);
                if (l == 0) convert_in_tail(a, lds, CV_E0 + CV_P0_E0 + CV_G + CV_A, CV_B, S.nwg, S.G, S.c);
            } else if (PH_ON(7) && sp == 5) phase_router(a, l, lds);
            else if ((PH_ON(8) || PH_ON(9)) && (sp == 6 || sp == 7)) {
                const int T = moe_tables(a, l, lds);
                const int G = gridDim.x, bx = blockIdx.x, vcu = (G % 8 == 0) ? (bx % 8) * (G / 8) + bx / 8 : bx;
                const LAS int* TBp = (const LAS int*)(lds + MISC_OFF + 256);
                if (PH_ON(8) && sp == 6) {
                    g8::MoeSched<true> S; S.A = (const char*)(ws + WS_H); S.Bw = (const char*)(ws + WS_WEIN) + (size_t)l * 32 * 1024 * 1024 * 2; S.wstride = (size_t)1024 * 1024 * 2; S.K = 1024; S.T = T; S.G = G; S.c = vcu;
                    S.tile_e = (const LAS int*)(lds + MISC_OFF + 1024); S.tile_mt = S.tile_e + 320; S.cnt = TBp + 64; S.toklist = (const int*)(ws + WS_TOKLIST);
                    g8::EpiSwiGLU E{(bf16_t*)(ws + WS_ACT)};
                    g8::gemm_phase(lds, S, E);
                    if (l == 0) convert_in_tail(a, lds, CV_EI1 + CV_P0_EI1, CV_C, 4 * T, G, vcu); else convert_in_tail(a, lds, CV_EO1 + CV_P0_EO1, CV_F, 4 * T, G, vcu);
                } else if (PH_ON(9) && sp == 7) {
                    g8::MoeSched<false> S; S.A = (const char*)(ws + WS_ACT); S.Bw = (const char*)(ws + WS_WEOUT) + (size_t)l * 32 * 1024 * 512 * 2; S.wstride = (size_t)1024 * 512 * 2; S.K = 512; S.T = T; S.G = G; S.c = vcu;
                    S.tile_e = (const LAS int*)(lds + MISC_OFF + 1024); S.tile_mt = S.tile_e + 320; S.cnt = TBp + 64; S.toklist = (const int*)(ws + WS_TOKLIST);
                    g8::EpiFp8 E{(unsigned char*)(ws + WS_Y)};
                    g8::gemm_phase(lds, S, E);
                    if (l == 0) convert_in_tail(a, lds, CV_EI1 + CV_P0_EI1 + CV_C, CV_D, 4 * T, G, vcu);
                }
            } else if (PH_ON(10) && sp == 8) phase_combine(a, l, lds);
        }
      }
        if (ph + 1 < a.ph_hi) { if (a.ph_lo < 0) cg::this_grid().sync(); else xcd_barrier(xbar); }
        if (TIME_PH >= 0 && ph == TIME_PH) tph_ = __builtin_amdgcn_s_memrealtime() - t0_;
    }
    if (TIME_PH >= 0 && blockIdx.x == 0 && threadIdx.x == 0) { const unsigned long long te_ = __builtin_amdgcn_s_memrealtime(); while (__builtin_amdgcn_s_memrealtime() - te_ < 4ull * tph_) __builtin_amdgcn_s_sleep(8); }
}

extern "C" void kernel_launch(void* const* d_in, const int* in_sizes, int n_in, void* d_out, int out_size, void* d_ws, size_t ws_size, hipStream_t stream) {
    static int grid = 0;
    if (grid == 0) {
        if (n_in != 29 || out_size != NLAT * D || ws_size < WS_END) { fprintf(stderr, "kernel_launch: unexpected shapes (n_in %d out %d ws %zu)\n", n_in, out_size, ws_size); grid = -1; return; }
        int dev = 0, cus = 0, per_cu = 0;
        hipGetDevice(&dev); hipDeviceGetAttribute(&cus, hipDeviceAttributeMultiprocessorCount, dev);
        if (hipFuncSetAttribute((const void*)mega, hipFuncAttributeMaxDynamicSharedMemorySize, LDS_BYTES) != hipSuccess) { fprintf(stderr, "kernel_launch: hipFuncSetAttribute failed\n"); grid = -1; return; }
        if (hipOccupancyMaxActiveBlocksPerMultiprocessor(&per_cu, (const void*)mega, 512, LDS_BYTES) != hipSuccess || per_cu < 1) { fprintf(stderr, "kernel_launch: occupancy query says %d\n", per_cu); per_cu = 1; }
        (void)hipGetLastError();
        grid = cus;
    }
    if (grid < 0) return;
    hipMemsetAsync((char*)d_ws + WS_CTL, 0, CTL_BYTES, stream);
    Args a{};
    for (int i = 0; i < 29; ++i) a.in[i] = (const float*)d_in[i];
    a.out = (float*)d_out; a.ws = (unsigned char*)d_ws;
#if MK_MULTI
    for (int ph = 0; ph < NPHASE; ++ph) { a.ph_lo = ph; a.ph_hi = ph + 1; hipLaunchKernelGGL(mega, dim3(grid), dim3(512), LDS_BYTES, stream, a); }
#else
    a.ph_lo = 0; a.ph_hi = NPHASE;
    void* args[] = {&a};
    hipError_t e = hipLaunchCooperativeKernel((const void*)mega, dim3(grid), dim3(512), args, LDS_BYTES, stream);
    if (e != hipSuccess) fprintf(stderr, "cooperative launch failed: %s (grid %d)\n", hipGetErrorString(e), grid);
#endif
}
```

```cpp
#include <hip/hip_runtime.h>
#include <hip/hip_cooperative_groups.h>
#include <cstdio>
namespace cg = cooperative_groups;

#ifndef MK_MULTI
#define MK_MULTI 0
#endif

#ifndef TIME_PH
#define TIME_PH -1
#endif
#ifndef REP_SUB
#define REP_SUB 0
#endif

#define LAS __attribute__((address_space(3)))
typedef unsigned short bf16_t;
typedef short bf16x8 __attribute__((ext_vector_type(8)));
typedef float f32x4 __attribute__((ext_vector_type(4)));
typedef float f32x2 __attribute__((ext_vector_type(2)));
typedef unsigned u32x4 __attribute__((ext_vector_type(4)));
typedef unsigned u32x2 __attribute__((ext_vector_type(2)));
typedef int i32x4 __attribute__((ext_vector_type(4)));
typedef int i32x8 __attribute__((ext_vector_type(8)));

constexpr int D = 1024, NLAT = 32768, SEQ = 8192, NCTXT = 1024, CTXL = 256, MTOT = NLAT + NCTXT;
constexpr int NIN = 2336, NINP = 2560;
constexpr int NCHUNK = MTOT / 64, NSEQ = 132;
constexpr int NEXP = 32, DEXP = 512, SLOTS = 75776;
constexpr float EPS = 1e-6f;
constexpr float F8_WSC = 256.0f, F8_HSC = 16.0f, F8_ASC = 8.0f;
constexpr int C_Q = 0, C_K = 128, C_V = 256, C_G = 512, C_ZF = 768, C_ZB = 784, C_CA = 800, C_CG = 1056, C_SB = 1312, C_SC = 1568, C_SX = 1824, C_PL = 2080;

constexpr size_t MiB = 1u << 20;
constexpr size_t WS_CTL = 0, CTL_BYTES = 1 * MiB;
constexpr size_t WS_MOD = 1 * MiB;
constexpr size_t WS_TAB = 1 * MiB + 512 * 1024;
constexpr size_t WS_PWT = WS_TAB + 64 * 1024;
constexpr size_t WS_BAND = WS_TAB + 192 * 1024;
constexpr size_t WS_WIN = 2 * MiB;
constexpr size_t WS_WOUT = 12 * MiB;
constexpr size_t WS_WEIN = 16 * MiB;
constexpr size_t WS_WEOUT = 144 * MiB;
constexpr size_t WS_XCTX = 208 * MiB;
constexpr size_t WS_H = 212 * MiB;
constexpr size_t WS_COLS = 278 * MiB;
constexpr size_t WS_MIX = 443 * MiB;
constexpr size_t WS_KV = 509 * MiB;
constexpr size_t WS_DEC = 542 * MiB;
constexpr size_t WS_AGV = 543 * MiB;
constexpr size_t WS_CXV = 559 * MiB;
constexpr size_t WS_UV = 575 * MiB;
constexpr size_t WS_SCV = 591 * MiB;
constexpr size_t WS_TOKINFO = 607 * MiB;
constexpr size_t WS_TOKLIST = 608 * MiB;
constexpr size_t WS_ACT = 613 * MiB;
constexpr size_t WS_Y = 687 * MiB;
constexpr size_t WS_SIN = 835 * MiB;
constexpr size_t WS_XB = 852 * MiB;
constexpr size_t WS_END = 918 * MiB;
constexpr int CW_CNT = 1024;
constexpr int CW_BAR = 8192;

constexpr int LDS_BYTES = 147456;
constexpr int MISC_OFF = 131072;

__device__ __forceinline__ unsigned pk2(float lo, float hi) { unsigned r; asm("v_cvt_pk_bf16_f32 %0, %1, %2" : "=v"(r) : "v"(lo), "v"(hi)); return r; }
__device__ __forceinline__ float bflo(unsigned w) { return __uint_as_float(w << 16); }
__device__ __forceinline__ float bfhi(unsigned w) { return __uint_as_float(w & 0xffff0000u); }
__device__ __forceinline__ void unpack8(const u32x4 w, float (&f)[8]) { f[0] = bflo(w.x); f[1] = bfhi(w.x); f[2] = bflo(w.y); f[3] = bfhi(w.y); f[4] = bflo(w.z); f[5] = bfhi(w.z); f[6] = bflo(w.w); f[7] = bfhi(w.w); }
__device__ __forceinline__ float sigmoidf_(float x) { return __builtin_amdgcn_rcpf(1.0f + __expf(-x)); }
__device__ __forceinline__ float siluf_(float x) { return x * __builtin_amdgcn_rcpf(1.0f + __expf(-x)); }
__device__ __forceinline__ float logsigf_(float x) { return fminf(x, 0.0f) - log1pf(__expf(-fabsf(x))); }
__device__ __forceinline__ float wave_sum(float v) {
#pragma unroll
    for (int o = 1; o < 64; o <<= 1) v += __shfl_xor(v, o);
    return v;
}

typedef float f32x16 __attribute__((ext_vector_type(16)));
typedef __bf16 bf16x2_t __attribute__((ext_vector_type(2)));
#define MFMA32(a, b, c) __builtin_amdgcn_mfma_f32_32x32x16_bf16((a), (b), (c), 0, 0, 0)
__device__ __forceinline__ unsigned pk2c(float lo, float hi) { const f32x2 v = {lo, hi}; return __builtin_bit_cast(unsigned, __builtin_convertvector(v, bf16x2_t)); }
__device__ __forceinline__ bf16x8 pack8f(float x0, float x1, float x2, float x3, float x4, float x5, float x6, float x7) {
    u32x4 p; p.x = pk2c(x0, x1); p.y = pk2c(x2, x3); p.z = pk2c(x4, x5); p.w = pk2c(x6, x7); return __builtin_bit_cast(bf16x8, p); }
__device__ __forceinline__ bf16x8 pack_step(const f32x16& x, int s) { return s == 0 ? pack8f(x[0], x[1], x[2], x[3], x[4], x[5], x[6], x[7]) : pack8f(x[8], x[9], x[10], x[11], x[12], x[13], x[14], x[15]); }
__device__ __forceinline__ void split8(const float (&x)[8], bf16x8& hi, bf16x8& lo) {
    u32x4 p; p.x = pk2c(x[0], x[1]); p.y = pk2c(x[2], x[3]); p.z = pk2c(x[4], x[5]); p.w = pk2c(x[6], x[7]);
    hi = __builtin_bit_cast(bf16x8, p);
    lo = pack8f(x[0] - bflo(p.x), x[1] - bfhi(p.x), x[2] - bflo(p.y), x[3] - bfhi(p.y), x[4] - bflo(p.z), x[5] - bfhi(p.z), x[6] - bflo(p.w), x[7] - bfhi(p.w)); }
__device__ __forceinline__ bf16x8 cat44(u32x2 a, u32x2 b) { u32x4 p; p.x = a.x; p.y = a.y; p.z = b.x; p.w = b.y; return __builtin_bit_cast(bf16x8, p); }
#define LDS_WAIT() asm volatile("s_waitcnt lgkmcnt(0)" ::: "memory")
#define PIN(x) asm volatile("" : "+v"(x) :: "memory")
__device__ __forceinline__ int tid_now() { int t = threadIdx.x; asm volatile("" : "+v"(t)); return t; }

namespace g8 {
constexpr int BM = 256, BK = 64, HALF = 128, HTB = HALF * BK * 2, NXCD = 8, WGM = 8;
__device__ __forceinline__ int lds_byte(int r, int c) { const int st = (r >> 4) * 2 + (c >> 5), rr = r & 15, cc = c & 31, ob = rr * 64 + cc * 2; return st * 1024 + (ob ^ (((ob >> 9) & 1) << 5)); }
__device__ __forceinline__ void stage_rc(int b, int& R, int& C) { const int st = b / 1024, sb = b % 1024, swz = sb ^ (((sb >> 9) & 1) << 5); R = (st >> 1) * 16 + swz / 64; C = (st & 1) * 32 + (swz % 64) / 2; }
__device__ __forceinline__ int perm32(int rho) { const int n = rho >> 4, i = rho & 15; return 8 * (i >> 2) + 4 * n + (i & 3); }

__device__ __forceinline__ i32x8 cat8(bf16x8 lo, bf16x8 hi) { const i32x4 a = __builtin_bit_cast(i32x4, lo), b = __builtin_bit_cast(i32x4, hi); return __builtin_shufflevector(a, b, 0, 1, 2, 3, 4, 5, 6, 7); }
struct Unit { int pm, pn, e, mt; };

struct DenseSched {
    const char* A; const char* Bt; int K, nM, nN, nwg, G, c;
    __device__ __forceinline__ void init(const void* A_, const void* Bt_, int M, int N, int K_, int G_, int c_) { A = (const char*)A_; Bt = (const char*)Bt_; K = K_; nM = M / BM; nN = N / BM; nwg = nM * nN; G = G_; c = c_; }
    __device__ __forceinline__ bool next(int i, Unit& u) const {
        const long L = (long)i * G + c; if (L >= nwg) return false;
        int wgid = (int)L; { const int q = nwg / NXCD, r = nwg % NXCD, xcd = wgid % NXCD, off = wgid / NXCD; wgid = (xcd < r ? xcd * (q + 1) : r * (q + 1) + (xcd - r) * q) + off; }
        const int nig = WGM * nN, gid = wgid / nig, fm = gid * WGM, gsz = (nM - fm) < WGM ? (nM - fm) : WGM;
        u.pm = fm + ((wgid % nig) % gsz); u.pn = (wgid % nig) / gsz; u.e = 0; u.mt = 0; return true;
    }
    __device__ __forceinline__ unsigned a_off(const Unit& u, int h, int R, int C) const { return (unsigned)(((u.pm * BM + h * HALF + R) * K + C) * 2); }
    __device__ __forceinline__ const char* b_ptr(const Unit& u) const { return Bt + (size_t)u.pn * BM * K * 2; }
};
template <bool GATHER> struct MoeSched {
    const char* A; const char* Bw; size_t wstride; int K, T, G, c; const LAS int* tile_e; const LAS int* tile_mt; const LAS int* cnt; const int* toklist;
    __device__ __forceinline__ bool next(int i, Unit& u) const {
        const int L = i * G + c; if (L >= 4 * T) return false;
        u.pm = L >> 2; u.pn = L & 3; u.e = __builtin_amdgcn_readfirstlane(tile_e[u.pm]); u.mt = __builtin_amdgcn_readfirstlane(tile_mt[u.pm]); return true;
    }
    __device__ __forceinline__ unsigned a_off(const Unit& u, int h, int R, int C) const {
        if (GATHER) { const int pos = u.mt * BM + h * HALF + R; int tok = 0; if (pos < cnt[u.e]) tok = toklist[u.e * MTOT + pos]; return (unsigned)((tok * K + C) * 2); }
        return (unsigned)(((u.pm * BM + h * HALF + R) * K + C) * 2);
    }
    __device__ __forceinline__ const char* b_ptr(const Unit& u) const { return Bw + (size_t)u.e * wstride + (size_t)u.pn * BM * K * 2; }
};

struct EpiBf16 {
    static constexpr bool PERM = true;
    bf16_t* O; int ldc;
    __device__ __forceinline__ void operator()(const f32x4 (&acc)[2][2][4][2], const Unit& u, int wr, int wc, int fr, int fq) const {
        const int row0 = u.pm * BM + wr * 64 + fr, col0 = u.pn * BM + wc * 32 + 8 * fq;
#pragma unroll
        for (int ai = 0; ai < 2; ++ai)
#pragma unroll
            for (int m = 0; m < 4; ++m) { bf16_t* rowp = O + (size_t)(row0 + ai * HALF + m * 16) * ldc + col0;
#pragma unroll
                for (int bj = 0; bj < 2; ++bj) { const f32x4 v0 = acc[ai][bj][m][0], v1 = acc[ai][bj][m][1];
                    u32x4 w; w.x = pk2(v0[0], v0[1]); w.y = pk2(v0[2], v0[3]); w.z = pk2(v1[0], v1[1]); w.w = pk2(v1[2], v1[3]);
                    *(u32x4*)(rowp + bj * HALF) = w; } }
    }
};
struct EpiFp8 {
    static constexpr bool PERM = true;
    unsigned char* O; float sc;
    __device__ __forceinline__ void operator()(const f32x4 (&acc)[2][2][4][2], const Unit& u, int wr, int wc, int fr, int fq) const {
        const int row0 = u.pm * BM + wr * 64 + fr, col0 = u.pn * BM + wc * 32 + 8 * fq;
#pragma unroll
        for (int ai = 0; ai < 2; ++ai)
#pragma unroll
            for (int m = 0; m < 4; ++m) { unsigned char* rowp = O + (size_t)(row0 + ai * HALF + m * 16) * 1024 + col0;
#pragma unroll
                for (int bj = 0; bj < 2; ++bj) { float v[8];
#pragma unroll
                    for (int i = 0; i < 4; ++i) { v[i] = fminf(fmaxf(acc[ai][bj][m][0][i] * sc, -440.0f), 440.0f); v[4 + i] = fminf(fmaxf(acc[ai][bj][m][1][i] * sc, -440.0f), 440.0f); }
                    int w0 = 0, w1 = 0;
                    w0 = __builtin_amdgcn_cvt_pk_fp8_f32(v[0], v[1], w0, false); w0 = __builtin_amdgcn_cvt_pk_fp8_f32(v[2], v[3], w0, true);
                    w1 = __builtin_amdgcn_cvt_pk_fp8_f32(v[4], v[5], w1, false); w1 = __builtin_amdgcn_cvt_pk_fp8_f32(v[6], v[7], w1, true);
                    *(u32x2*)(rowp + bj * HALF) = (u32x2){(unsigned)w0, (unsigned)w1}; } }
    }
};
struct EpiSwiGLU {
    static constexpr bool PERM = true;
    unsigned char* O; float isc, osc;
    __device__ __forceinline__ void operator()(const f32x4 (&acc)[2][2][4][2], const Unit& u, int wr, int wc, int fr, int fq) const {
        const int row0 = u.pm * BM + wr * 64 + fr, col0 = u.pn * HALF + wc * 32 + 8 * fq;
#pragma unroll
        for (int ai = 0; ai < 2; ++ai)
#pragma unroll
            for (int m = 0; m < 4; ++m) { unsigned char* rowp = O + (size_t)(row0 + ai * HALF + m * 16) * DEXP + col0;
                float v[8];
#pragma unroll
                for (int i = 0; i < 4; ++i) { v[i] = fminf(fmaxf(siluf_(acc[ai][0][m][0][i] * isc) * (acc[ai][1][m][0][i] * osc), -440.0f), 440.0f); v[4 + i] = fminf(fmaxf(siluf_(acc[ai][0][m][1][i] * isc) * (acc[ai][1][m][1][i] * osc), -440.0f), 440.0f); }
                int w0 = 0, w1 = 0;
                w0 = __builtin_amdgcn_cvt_pk_fp8_f32(v[0], v[1], w0, false); w0 = __builtin_amdgcn_cvt_pk_fp8_f32(v[2], v[3], w0, true);
                w1 = __builtin_amdgcn_cvt_pk_fp8_f32(v[4], v[5], w1, false); w1 = __builtin_amdgcn_cvt_pk_fp8_f32(v[6], v[7], w1, true);
                *(u32x2*)rowp = (u32x2){(unsigned)w0, (unsigned)w1}; }
    }
};
template <bool F8, class Epi, class Sched>
__device__ __forceinline__ void gemm_phase(LAS unsigned char* lds, const Sched& S, const Epi& E) {
    const int tid = tid_now(), wid = __builtin_amdgcn_readfirstlane(tid >> 6), lane = tid & 63, wr = wid >> 2, wc = wid & 3, fr = lane & 15, fq = lane >> 4;
    const int K = S.K, nt = K / BK;
    int mxsc = 0x7F7F7F7F; asm volatile("" : "+v"(mxsc));
    unsigned voffB[2];
#pragma unroll
    for (int i = 0; i < 2; ++i) { int R, C; stage_rc(tid * 16 + i * 8192, R, C); const int Rb = Epi::PERM ? ((R & ~31) + perm32(R & 31)) : R; voffB[i] = (unsigned)(Rb * K + C) * 2u; }
    const size_t kstep = (size_t)(BK * 2);
    const size_t hstep = (size_t)HALF * K * 2;
    const unsigned ldsw = (unsigned)wid * 1024u;
    const int aoff = lds_byte(wr * 64 + fr, fq * 8), boff = lds_byte(wc * 32 + fr, fq * 8);
#define G8_SA(b, h) (((b) * 2 + (h)) * HTB)
#define G8_SB(b, h) ((4 + (b) * 2 + (h)) * HTB)
#define G8_STAGE(bufoff, gbase, voff) do { const unsigned long long _g = (unsigned long long)(gbase); \
        const char* _gb = (const char*)(((unsigned long long)(unsigned)__builtin_amdgcn_readfirstlane((int)(unsigned)(_g >> 32)) << 32) | (unsigned long long)(unsigned)__builtin_amdgcn_readfirstlane((int)(unsigned)_g)); \
        _Pragma("unroll") for (int _i = 0; _i < 2; ++_i) \
        __builtin_amdgcn_global_load_lds((const unsigned*)(_gb + (voff)[_i]), (LAS unsigned*)(lds + (bufoff) + ldsw + _i * 8192), 16, 0, 0); } while (0)
#define G8_LDA(dst, b, h) do { _Pragma("unroll") for (int m = 0; m < 4; ++m) _Pragma("unroll") for (int k = 0; k < 2; ++k) dst[m][k] = *(const LAS bf16x8*)(lds + G8_SA(b, h) + aoff + m * 2048 + k * 1024); } while (0)
#define G8_LDB(dst, b, h) do { _Pragma("unroll") for (int n = 0; n < 2; ++n) _Pragma("unroll") for (int k = 0; k < 2; ++k) dst[n][k] = *(const LAS bf16x8*)(lds + G8_SB(b, h) + boff + n * 2048 + k * 1024); } while (0)
#define G8_MMA(ai, bj, At, Bt) do { __builtin_amdgcn_s_setprio(1); _Pragma("unroll") for (int m = 0; m < 4; ++m) _Pragma("unroll") for (int n = 0; n < 2; ++n) _Pragma("unroll") for (int k = 0; k < 2; ++k) \
        acc[ai][bj][m][n] = __builtin_amdgcn_mfma_f32_16x16x32_bf16(Bt[n][k], At[m][k], acc[ai][bj][m][n], 0, 0, 0); __builtin_amdgcn_s_setprio(0); } while (0)
#define G8_MMA8(ai, bj, At, Bt) do { __builtin_amdgcn_s_setprio(1); _Pragma("unroll") for (int m = 0; m < 4; ++m) _Pragma("unroll") for (int n = 0; n < 2; ++n) \
        acc[ai][bj][m][n] = __builtin_amdgcn_mfma_scale_f32_16x16x128_f8f6f4(cat8(Bt[n][0], Bt[n][1]), cat8(At[m][0], At[m][1]), acc[ai][bj][m][n], 0, 0, 0, mxsc, 0, mxsc); __builtin_amdgcn_s_setprio(0); } while (0)
#define G8_MM(ai, bj, At, Bt) do { if (F8) G8_MMA8(ai, bj, At, Bt); else G8_MMA(ai, bj, At, Bt); } while (0)
#define G8_WAIT_V(n) asm volatile("s_waitcnt vmcnt(" #n ")" ::: "memory")
#define G8_WAIT_L(n) asm volatile("s_waitcnt lgkmcnt(" #n ")" ::: "memory")
#define G8_BAR __builtin_amdgcn_s_barrier()
#define G8_SCHED __builtin_amdgcn_sched_barrier(0)
    Unit cur, nxt; int ui = 0;
    if (!S.next(0, cur)) return;
    f32x4 acc[2][2][4][2];
#pragma unroll
    for (int a = 0; a < 2; ++a)
#pragma unroll
        for (int b = 0; b < 2; ++b)
#pragma unroll
            for (int m = 0; m < 4; ++m)
#pragma unroll
                for (int n = 0; n < 2; ++n) acc[a][b][m][n] = (f32x4){0.f, 0.f, 0.f, 0.f};
    bf16x8 At[4][2], B0[2][2], B1[2][2];
    unsigned vA0[2], vA1[2];
#pragma unroll
    for (int i = 0; i < 2; ++i) { int R, C; stage_rc(tid * 16 + i * 8192, R, C); vA0[i] = S.a_off(cur, 0, R, C); vA1[i] = S.a_off(cur, 1, R, C); }
    const char* const Ab = S.A;
    const char* cB = S.b_ptr(cur);
    G8_STAGE(G8_SB(0, 0), cB, voffB); G8_STAGE(G8_SA(0, 0), Ab, vA0); G8_STAGE(G8_SB(0, 1), cB + hstep, voffB); G8_STAGE(G8_SA(0, 1), Ab, vA1);
    if (wr == 1) G8_BAR;
    G8_WAIT_V(4); G8_BAR;
    G8_STAGE(G8_SB(1, 0), cB + kstep, voffB); G8_STAGE(G8_SA(1, 0), Ab + kstep, vA0); G8_STAGE(G8_SB(1, 1), cB + hstep + kstep, voffB);
    G8_WAIT_V(6); G8_BAR;
    for (;;) {
        const bool has_next = S.next(ui + 1, nxt);
        const char* nB = has_next ? S.b_ptr(nxt) : cB;
        unsigned nA0[2] = {vA0[0], vA0[1]}, nA1[2] = {vA1[0], vA1[1]};
        if (has_next) {
#pragma unroll
            for (int i = 0; i < 2; ++i) { int R, C; stage_rc(tid * 16 + i * 8192, R, C); nA0[i] = S.a_off(nxt, 0, R, C); nA1[i] = S.a_off(nxt, 1, R, C); }
        }
#pragma unroll 1
        for (int t = 0; t < nt; t += 2) {
            const bool last = (t == nt - 2);
            const char* a1 = Ab + (size_t)(t + 1) * kstep;
            const char* a2 = last ? Ab : Ab + (size_t)(t + 2) * kstep; const char* b2 = last ? nB : cB + (size_t)(t + 2) * kstep;
            const char* a3 = a2 + kstep; const char* b3 = b2 + kstep;
            G8_LDB(B0, 0, 0); G8_SCHED; G8_LDA(At, 0, 0); G8_STAGE(G8_SA(1, 1), a1, vA1);
            G8_WAIT_L(8); G8_BAR; G8_WAIT_L(0); G8_MM(0, 0, At, B0); G8_BAR; G8_SCHED;
            if (last) {
#pragma unroll
                for (int i = 0; i < 2; ++i) { vA0[i] = nA0[i]; vA1[i] = nA1[i]; }
            }
            G8_LDB(B1, 0, 1); G8_STAGE(G8_SB(0, 0), b2, voffB);
            G8_BAR; G8_WAIT_L(0); G8_MM(0, 1, At, B1); G8_BAR;
            G8_LDA(At, 0, 1); G8_STAGE(G8_SA(0, 0), a2, vA0);
            G8_BAR; G8_WAIT_L(0); G8_MM(1, 0, At, B0); G8_BAR; G8_SCHED;
            G8_STAGE(G8_SB(0, 1), b2 + hstep, voffB);
            G8_WAIT_V(6); G8_BAR; G8_MM(1, 1, At, B1); G8_BAR;
            G8_LDB(B0, 1, 0); G8_SCHED; G8_LDA(At, 1, 0); G8_STAGE(G8_SA(0, 1), a2, vA1);
            G8_WAIT_L(8); G8_BAR; G8_WAIT_L(0); G8_MM(0, 0, At, B0); G8_BAR; G8_SCHED;
            G8_LDB(B1, 1, 1); G8_STAGE(G8_SB(1, 0), b3, voffB);
            G8_BAR; G8_WAIT_L(0); G8_MM(0, 1, At, B1); G8_BAR;
            G8_LDA(At, 1, 1); G8_STAGE(G8_SA(1, 0), a3, vA0);
            G8_BAR; G8_WAIT_L(0); G8_MM(1, 0, At, B0); G8_BAR; G8_SCHED;
            G8_STAGE(G8_SB(1, 1), b3 + hstep, voffB);
            G8_WAIT_V(6); G8_BAR; G8_MM(1, 1, At, B1); G8_BAR;
        }
        E(acc, cur, wr, wc, fr, fq);
        if (!has_next) break;
#pragma unroll
        for (int a = 0; a < 2; ++a)
#pragma unroll
            for (int b = 0; b < 2; ++b)
#pragma unroll
                for (int m = 0; m < 4; ++m)
#pragma unroll
                    for (int n = 0; n < 2; ++n) acc[a][b][m][n] = (f32x4){0.f, 0.f, 0.f, 0.f};
        cur = nxt; cB = nB; ++ui;
    }
    G8_WAIT_V(0);
    if (wr == 0) G8_BAR;
    G8_BAR;
#undef G8_SA
#undef G8_SB
#undef G8_STAGE
#undef G8_LDA
#undef G8_LDB
#undef G8_MMA
#undef G8_MMA8
#undef G8_MM
#undef G8_WAIT_V
#undef G8_WAIT_L
#undef G8_BAR
#undef G8_SCHED
}
}

struct Args { const float* in[29]; float* out; unsigned char* ws; int ph_lo, ph_hi; };
enum { I_X = 0, I_C, I_CTX, I_CCTX, I_WMOD, I_BMOD, I_G1, I_G2, I_WIN, I_GWF, I_GBF, I_GWB, I_GBB, I_GOUT, I_CONFW, I_CONFB, I_CONFG, I_CONFBETA, I_SCW, I_POOLW, I_POOLS, I_WOUT, I_RWG, I_RBG, I_RWE, I_RBE, I_EIN, I_EOUT, I_GFINAL };

__device__ __forceinline__ void transpose_item(const float* W, int K, int N, bf16_t* WT, int kb, int n0, int dst_row0, LAS float* scr, int lane) {
    const int k0 = 64 * kb;
    float wv[32];
#pragma unroll
    for (int i = 0; i < 32; ++i) { const int kk = 2 * i + (lane >> 5); wv[i] = W[(size_t)(k0 + kk) * N + n0 + (lane & 31)]; }
#pragma unroll
    for (int i = 0; i < 32; ++i) PIN(wv[i]);
#pragma unroll
    for (int i = 0; i < 32; ++i) { const int kk = 2 * i + (lane >> 5); scr[kk * 33 + (lane & 31)] = wv[i]; }
    LDS_WAIT(); asm volatile("" ::: "memory");
    const int c = lane & 7;
#pragma unroll
    for (int j = 0; j < 4; ++j) { const int n = (lane >> 3) + 8 * j; const LAS float* s = scr + (8 * c) * 33 + n;
        u32x4 o; o.x = pk2(s[0 * 33], s[1 * 33]); o.y = pk2(s[2 * 33], s[3 * 33]); o.z = pk2(s[4 * 33], s[5 * 33]); o.w = pk2(s[6 * 33], s[7 * 33]);
        *(u32x4*)(WT + (size_t)(dst_row0 + n) * K + k0 + 8 * c) = o; }
    LDS_WAIT(); asm volatile("" ::: "memory");
}

__device__ __forceinline__ void transpose_item8(const float* W, int K, int N, unsigned char* WT, int kb, int n0, int dst_row0, LAS float* scr, int lane) {
    const int k0 = 64 * kb;
    float wv[32];
#pragma unroll
    for (int i = 0; i < 32; ++i) { const int kk = 2 * i + (lane >> 5); wv[i] = W[(size_t)(k0 + kk) * N + n0 + (lane & 31)]; }
#pragma unroll
    for (int i = 0; i < 32; ++i) PIN(wv[i]);
#pragma unroll
    for (int i = 0; i < 32; ++i) { const int kk = 2 * i + (lane >> 5); scr[kk * 33 + (lane & 31)] = wv[i]; }
    LDS_WAIT(); asm volatile("" ::: "memory");
    const int c = lane & 7;
#pragma unroll
    for (int j = 0; j < 4; ++j) { const int n = (lane >> 3) + 8 * j; const LAS float* s = scr + (8 * c) * 33 + n;
        float v[8];
#pragma unroll
        for (int i = 0; i < 8; ++i) v[i] = fminf(fmaxf(s[i * 33] * F8_WSC, -440.0f), 440.0f);
        int w0 = 0, w1 = 0;
        w0 = __builtin_amdgcn_cvt_pk_fp8_f32(v[0], v[1], w0, false); w0 = __builtin_amdgcn_cvt_pk_fp8_f32(v[2], v[3], w0, true);
        w1 = __builtin_amdgcn_cvt_pk_fp8_f32(v[4], v[5], w1, false); w1 = __builtin_amdgcn_cvt_pk_fp8_f32(v[6], v[7], w1, true);
        *(u32x2*)(WT + (size_t)(dst_row0 + n) * K + k0 + 8 * c) = (u32x2){(unsigned)w0, (unsigned)w1}; }
    LDS_WAIT(); asm volatile("" ::: "memory");
}

constexpr int CV_SMALL = 3360, CV_E0 = 3360, CV_EI1 = 27936, CV_EO1 = 44320, CV_END = 52512;
constexpr int CV_G = 4480;
constexpr int CV_A = 5184, CV_B = 5760;
constexpr int CV_C = 4096, CV_D = 2048, CV_E = 5184;
constexpr int CV_F = 4096;
constexpr int CV_P0_E0 = (CV_EI1 - CV_E0) - CV_G - CV_A - CV_B, CV_P0_EI1 = (CV_EO1 - CV_EI1) - CV_C - CV_D - CV_E, CV_P0_EO1 = (CV_END - CV_EO1) - CV_F;
__device__ __forceinline__ void convert_item(const Args& a, int idx, LAS float* scr, int lane) {
    unsigned char* ws = a.ws;
    if (idx < CV_SMALL) { const int l = idx / 1680; int r = idx % 1680;
        if (r < 1168) { const int kb = r / 73, nb = r % 73; transpose_item(a.in[I_WIN] + (size_t)l * 1024 * NIN, 1024, NIN, (bf16_t*)(ws + WS_WIN) + (size_t)l * NINP * 1024, kb, nb * 32, nb * 32, scr, lane); }
        else { r -= 1168; const int kb = r / 32, nb = r % 32; transpose_item(a.in[I_WOUT] + (size_t)l * 1024 * 1024, 1024, 1024, (bf16_t*)(ws + WS_WOUT) + (size_t)l * 1024 * 1024, kb, nb * 32, nb * 32, scr, lane); }
        return; }
    int l, r; bool is_in;
    if (idx < CV_EI1) { l = 0; r = idx - CV_E0; is_in = r < 16384; if (!is_in) r -= 16384; }
    else if (idx < CV_EO1) { l = 1; r = idx - CV_EI1; is_in = true; }
    else { l = 1; r = idx - CV_EO1; is_in = false; }
    if (is_in) { const int le = l * 32 + r / 512, q = r % 512, kb = q / 32, n0 = (q % 32) * 32;
        const int dst = n0 < 512 ? (256 * (n0 >> 7) + (n0 & 127)) : (256 * ((n0 - 512) >> 7) + 128 + ((n0 - 512) & 127));
        transpose_item8(a.in[I_EIN] + (size_t)le * 1024 * 1024, 1024, 1024, ws + WS_WEIN + (size_t)le * 1024 * 1024, kb, n0, dst, scr, lane); }
    else { const int le = l * 32 + r / 256, q = r % 256, kb = q / 32, nb = q % 32;
        transpose_item8(a.in[I_EOUT] + (size_t)le * 512 * 1024, 512, 1024, ws + WS_WEOUT + (size_t)le * 1024 * 512, kb, nb * 32, nb * 32, scr, lane); }
}
__device__ __forceinline__ void convert_range(const Args& a, LAS unsigned char* lds, int first, int count, int rank, int nparts) {
    const int tid = tid_now(), lane = tid & 63, wid = __builtin_amdgcn_readfirstlane(tid >> 6);
    LAS float* scr = (LAS float*)(lds + wid * 16384);
    const int per = (count + nparts - 1) / nparts, lo = rank * per, hi = (lo + per < count) ? lo + per : count;
    for (int j = lo + wid; j < hi; j += 8) convert_item(a, first + j, scr, lane);
}
__device__ __forceinline__ void convert_in_tail(const Args& a, LAS unsigned char* lds, int first, int count, int tot_units, int G, int c) {
    const int rem = tot_units % G;
    if (rem == 0) convert_range(a, lds, first, count, c, G);
    else if (c >= rem) convert_range(a, lds, first, count, c - rem, G - rem);
}

__device__ __forceinline__ void phase_p0(const Args& a, LAS unsigned char* lds) {
    const int tid = tid_now(), lane = tid & 63, wid = __builtin_amdgcn_readfirstlane(tid >> 6);
    unsigned char* ws = a.ws;
    for (int job = blockIdx.x; job < 192; job += gridDim.x) {
        const int l = job / 96, n0 = (job % 96) * 64;
        LAS float* sv = (LAS float*)lds;
        LAS float* red = (LAS float*)(lds + 5 * 1024 * 4);
        for (int i = tid; i < 5 * 1024; i += 512) { const int r = i >> 10, k = i & 1023; const float v = r < 4 ? a.in[I_C][r * 1024 + k] : a.in[I_CCTX][k]; sv[i] = siluf_(v); }
        __syncthreads();
        const int ks = tid >> 6, col = tid & 63;
        const float* w = a.in[I_WMOD] + (size_t)l * 1024 * 6144 + (size_t)(ks * 128) * 6144 + n0 + col;
        float acc[5] = {0.f, 0.f, 0.f, 0.f, 0.f};
#pragma unroll 8
        for (int k = 0; k < 128; ++k) { const float wv = w[(size_t)k * 6144];
#pragma unroll
            for (int r = 0; r < 5; ++r) acc[r] += sv[r * 1024 + ks * 128 + k] * wv; }
#pragma unroll
        for (int r = 0; r < 5; ++r) red[(ks * 5 + r) * 64 + col] = acc[r];
        __syncthreads();
        if (tid < 320) { const int r = tid >> 6; float s = 0.f;
#pragma unroll
            for (int q = 0; q < 8; ++q) s += red[(q * 5 + r) * 64 + col];
            ((float*)(ws + WS_MOD))[(size_t)(l * 5 + r) * 6144 + n0 + col] = s + a.in[I_BMOD][l * 6144 + n0 + col]; }
        __syncthreads();
    }
    LAS float* scr = (LAS float*)(lds + wid * 16384);
    const int gw = blockIdx.x * 8 + wid, NGW = gridDim.x * 8;
    constexpr int P0_N0 = CV_E0 + CV_P0_E0, P0_N1 = P0_N0 + CV_P0_EI1, P0_N2 = P0_N1 + CV_P0_EO1;
    for (int j = gw; j < P0_N2; j += NGW) { const int idx = j < P0_N0 ? j : (j < P0_N1 ? CV_EI1 + (j - P0_N0) : CV_EO1 + (j - P0_N1)); convert_item(a, idx, scr, lane); }
    for (int i = blockIdx.x * 512 + tid; i < 2 * 4096; i += gridDim.x * 512) { const int l = i >> 12, g = (i >> 10) & 3, k = i & 1023; ((float*)(ws + WS_TAB))[i] = a.in[I_RWG][l * 4096 + k * 4 + g]; }
    for (int i = blockIdx.x * 512 + tid; i < 2 * 4 * 64 * 64; i += gridDim.x * 512) { const int lg = i >> 12, dd = (i >> 6) & 63, c = i & 63;
        ((bf16_t*)(ws + WS_PWT))[i] = (bf16_t)(pk2(a.in[I_POOLW][(size_t)lg * 4096 + c * 64 + dd], 0.f) & 0xffffu); }
    for (int i = blockIdx.x * 512 + tid; i < 4 * 8 * 64; i += gridDim.x * 512) { const int wi = i >> 9, f = (i >> 6) & 7, ln = i & 63, mt = f >> 2, nt = (f >> 1) & 1, sq = f & 1, rr = ln & 31, hh = ln >> 5, hw = 1 << wi;
        const int t = 32 * nt + rr; int lo = t - hw, hi = t + hw; lo = lo < 0 ? 0 : lo; hi = hi > 64 ? 64 : hi; const int cnt = hi - lo;
        unsigned w4[4];
#pragma unroll
        for (int jp = 0; jp < 4; ++jp) { unsigned wd = 0u;
#pragma unroll
            for (int e = 0; e < 2; ++e) { const int j = 2 * jp + e, tp = 32 * mt + 16 * sq + 8 * (j >> 2) + 4 * hh + (j & 3);
                const int val = ((tp >= lo && tp < hi) ? 1 : 0) - (tp == t ? cnt : 0);
                wd |= (__float_as_uint((float)val) >> 16) << (16 * e); }
            w4[jp] = wd; }
        ((u32x4*)(ws + WS_BAND))[i] = (u32x4){w4[0], w4[1], w4[2], w4[3]}; }
    for (int i = blockIdx.x * 512 + tid; i < 2 * 224 * 1024 / 8; i += gridDim.x * 512) { const int l = i / (224 * 128), q = i % (224 * 128);
        *(u32x4*)((bf16_t*)(ws + WS_WIN) + (size_t)l * NINP * 1024 + (size_t)NIN * 1024 + (size_t)q * 8) = (u32x4){0u, 0u, 0u, 0u}; }
}

__device__ __forceinline__ void load_row(const float* xrow, int lane, f32x4 (&v)[4]) {
    const f32x4* xr = (const f32x4*)xrow + lane;
#pragma unroll
    for (int j = 0; j < 4; ++j) v[j] = xr[64 * j];
}
__device__ __forceinline__ void load_row_bf(const bf16_t* xrow, int lane, f32x4 (&v)[4]) {
#pragma unroll
    for (int j = 0; j < 4; ++j) { const u32x2 w = *((const u32x2*)xrow + lane + 64 * j); v[j] = (f32x4){bflo(w.x), bfhi(w.x), bflo(w.y), bfhi(w.y)}; }
}
__device__ __forceinline__ void store_row_bf(bf16_t* xrow, int lane, const f32x4 (&v)[4]) {
#pragma unroll
    for (int j = 0; j < 4; ++j) { u32x2 w; w.x = pk2(v[j].x, v[j].y); w.y = pk2(v[j].z, v[j].w); *((u32x2*)xrow + lane + 64 * j) = w; }
}
__device__ __forceinline__ float row_rstd(const f32x4 (&v)[4]) {
    float s = 0.f;
#pragma unroll
    for (int j = 0; j < 4; ++j) s += (v[j].x * v[j].x + v[j].y * v[j].y) + (v[j].z * v[j].z + v[j].w * v[j].w);
    return rsqrtf(wave_sum(s) * (1.0f / D) + EPS);
}
__device__ __forceinline__ void norm_mod_store(f32x4 (&v)[4], float rstd, const float* g, const float* sc, const float* sh, bf16_t* hrow, int lane) {
#pragma unroll
    for (int j = 0; j < 4; ++j) { const f32x4 gv = *((const f32x4*)g + lane + 64 * j), scv = *((const f32x4*)sc + lane + 64 * j), shv = *((const f32x4*)sh + lane + 64 * j);
        v[j] = (v[j] * rstd * gv) * (1.0f + scv) + shv;
        u32x2 w; w.x = pk2(v[j].x, v[j].y); w.y = pk2(v[j].z, v[j].w);
        *((u32x2*)hrow + lane + 64 * j) = w; }
}

__device__ __forceinline__ void norm_store_cached(f32x4 (&v)[4], float rstd, const f32x4 (&GS)[4], const f32x4 (&SH)[4], bf16_t* hrow, int lane) {
#pragma unroll
    for (int j = 0; j < 4; ++j) { v[j] = (v[j] * rstd) * GS[j] + SH[j];
        u32x2 w; w.x = pk2(v[j].x, v[j].y); w.y = pk2(v[j].z, v[j].w);
        *((u32x2*)hrow + lane + 64 * j) = w; }
}
__device__ __forceinline__ void norm_store_cached8(f32x4 (&v)[4], float rstd, const f32x4 (&GS)[4], const f32x4 (&SH)[4], unsigned char* hrow, int lane) {
#pragma unroll
    for (int j = 0; j < 4; ++j) { v[j] = (v[j] * rstd) * GS[j] + SH[j];
        float q[4];
#pragma unroll
        for (int i = 0; i < 4; ++i) q[i] = fminf(fmaxf(v[j][i] * F8_HSC, -440.0f), 440.0f);
        int w = 0; w = __builtin_amdgcn_cvt_pk_fp8_f32(q[0], q[1], w, false); w = __builtin_amdgcn_cvt_pk_fp8_f32(q[2], q[3], w, true);
        *((unsigned*)hrow + lane + 64 * j) = (unsigned)w; }
}
__device__ __forceinline__ void load_mod_cached(const float* g, const float* sc, const float* sh, const float* ga, int lane, f32x4 (&GS)[4], f32x4 (&SH)[4], f32x4 (&GA)[4]) {
#pragma unroll
    for (int j = 0; j < 4; ++j) { const f32x4 gv = *((const f32x4*)g + lane + 64 * j), scv = *((const f32x4*)sc + lane + 64 * j);
        GS[j] = gv * (1.0f + scv); SH[j] = *((const f32x4*)sh + lane + 64 * j); GA[j] = *((const f32x4*)ga + lane + 64 * j); }
}

__device__ __forceinline__ void phase_norm1_l0(const Args& a) {
    const int lane = tid_now() & 63, wid = tid_now() >> 6, gw = blockIdx.x * 8 + wid, NGW = gridDim.x * 8;
    const float* MOD = (const float*)(a.ws + WS_MOD); bf16_t* H = (bf16_t*)(a.ws + WS_H);
    int cur_b = -1; f32x4 GS[4], SH[4], GA[4];
#pragma unroll 1
    for (int m = gw; m < MTOT; m += 2 * NGW) {
        const int m2 = m + NGW; const bool has2 = m2 < MTOT; const int m2c = has2 ? m2 : m;
        const float* src = m < NLAT ? a.in[I_X] + (size_t)m * D : a.in[I_CTX] + (size_t)(m - NLAT) * D;
        const float* src2 = m2c < NLAT ? a.in[I_X] + (size_t)m2c * D : a.in[I_CTX] + (size_t)(m2c - NLAT) * D;
        const int b = m < NLAT ? (m >> 13) : 4, b2 = m2c < NLAT ? (m2c >> 13) : 4;
        f32x4 v[4], v2[4]; load_row(src, lane, v); load_row(src2, lane, v2);
        const float rstd = row_rstd(v), rstd2 = row_rstd(v2);
        if (b != cur_b) { const float* mod = MOD + (size_t)b * 6144; load_mod_cached(a.in[I_G1], mod + 1024, mod, mod, lane, GS, SH, GA); cur_b = b; }
        norm_store_cached(v, rstd, GS, SH, H + (size_t)m * D, lane);
        if (has2) { if (b2 != cur_b) { const float* mod = MOD + (size_t)b2 * 6144; load_mod_cached(a.in[I_G1], mod + 1024, mod, mod, lane, GS, SH, GA); cur_b = b2; }
            norm_store_cached(v2, rstd2, GS, SH, H + (size_t)m2 * D, lane); }
    }
}

struct ChunkPos { int b, sf, sb; };
__device__ __forceinline__ ChunkPos chunk_pos(int chunk) {
    ChunkPos p;
    if (chunk < 512) { p.b = chunk >> 7; const int n = chunk & 127; p.sf = 4 + n; p.sb = 4 + 127 - n; }
    else { const int cc = chunk - 512; p.b = cc >> 2; const int n = cc & 3; p.sf = n; p.sb = 3 - n; }
    return p;
}

constexpr int VS = 72;
__device__ __forceinline__ void gla_prep_dir(int dir, int lane, const float (&w)[8], float bias, const bf16x8 (&Az)[2], f32x16 (&BT)[2]) {
    asm volatile("" : "+v"(lane));
    const int r = lane & 31, hf = lane >> 5;
    const f32x16 zero16 = {0.f, 0.f, 0.f, 0.f, 0.f, 0.f, 0.f, 0.f, 0.f, 0.f, 0.f, 0.f, 0.f, 0.f, 0.f, 0.f};
    u32x4 mk[2];
#pragma unroll
    for (int s = 0; s < 2; ++s) { unsigned w4[4];
#pragma unroll
        for (int jp = 0; jp < 4; ++jp) { const int j0 = 2 * jp, j1 = 2 * jp + 1;
            const int t0 = 16 * s + 8 * (j0 >> 2) + 4 * hf + (j0 & 3), t1 = 16 * s + 8 * (j1 >> 2) + 4 * hf + (j1 & 3);
            const bool c0 = dir ? (t0 >= r) : (t0 <= r), c1 = dir ? (t1 >= r) : (t1 <= r);
            w4[jp] = (c0 ? 0x3F80u : 0u) | (c1 ? 0x3F800000u : 0u); }
        mk[s].x = w4[0]; mk[s].y = w4[1]; mk[s].z = w4[2]; mk[s].w = w4[3]; }
    bf16x8 Bhi, Blo; split8(w, Bhi, Blo);
    BT[0] = zero16; BT[1] = zero16;
#pragma unroll 1
    for (int mt = 0; mt < 2; ++mt) {
        const bf16x8 A = mt ? Az[1] : Az[0];
        f32x16 x = MFMA32(A, Bhi, zero16); x = MFMA32(A, Blo, x);
        float la[16];
#pragma unroll
        for (int i = 0; i < 16; ++i) { const float v = x[i] + bias; la[i] = (fminf(v, 0.f) - __logf(1.0f + __expf(-fabsf(v)))) * (1.0f / 16.0f); }
#pragma unroll
        for (int s = 0; s < 2; ++s) {
            const float t8[8] = {la[8 * s], la[8 * s + 1], la[8 * s + 2], la[8 * s + 3], la[8 * s + 4], la[8 * s + 5], la[8 * s + 6], la[8 * s + 7]};
            bf16x8 Lh, Ll; split8(t8, Lh, Ll);
#pragma unroll
            for (int nt = 0; nt < 2; ++nt) {
                const bool full = dir ? (mt > nt) : (mt < nt);
                u32x4 bm; const unsigned fv = full ? 0x3F803F80u : 0u;
                bm.x = (mt == nt) ? mk[s].x : fv; bm.y = (mt == nt) ? mk[s].y : fv; bm.z = (mt == nt) ? mk[s].z : fv; bm.w = (mt == nt) ? mk[s].w : fv;
                const bf16x8 Bm = __builtin_bit_cast(bf16x8, bm);
                BT[nt] = MFMA32(Lh, Bm, BT[nt]); BT[nt] = MFMA32(Ll, Bm, BT[nt]); }
        }
    }
}
__device__ __forceinline__ void gla_gate_loads(const Args& a, int l, int h, int dir, const bf16_t* cols0, int lane, float (&w)[8], float& bias, bf16x8 (&Az)[2]) {
    const int r = lane & 31, hf = lane >> 5;
    const float* wp = a.in[dir ? I_GWB : I_GWF] + (size_t)(l * 16 + 8 * hf) * 128 + 32 * h + r;
#pragma unroll
    for (int j = 0; j < 8; ++j) w[j] = wp[j * 128];
    bias = a.in[dir ? I_GBB : I_GBF][l * 128 + 32 * h + r];
#pragma unroll
    for (int mt = 0; mt < 2; ++mt) Az[mt] = *(const bf16x8*)(cols0 + (size_t)(32 * mt + r) * NINP + C_ZF + 16 * dir + 8 * hf);
}
__device__ __forceinline__ void stage_vT(const bf16_t* cols0, int h, int lane, LAS bf16_t* vT) {
    u32x4 w[8];
#pragma unroll
    for (int q = 0; q < 8; ++q) { const int chunk = lane + 64 * q, t = chunk >> 3, cg = chunk & 7; w[q] = *(const u32x4*)(cols0 + (size_t)t * NINP + C_V + 64 * h + 8 * cg); }
#pragma unroll
    for (int q = 0; q < 8; ++q) PIN(w[q]);
#pragma unroll
    for (int q = 0; q < 8; ++q) { const int chunk = lane + 64 * q, t = chunk >> 3, cg = chunk & 7;
        LAS bf16_t* p = vT + (8 * cg) * VS + t;
        p[0 * VS] = (bf16_t)(w[q].x & 0xffffu); p[1 * VS] = (bf16_t)(w[q].x >> 16); p[2 * VS] = (bf16_t)(w[q].y & 0xffffu); p[3 * VS] = (bf16_t)(w[q].y >> 16);
        p[4 * VS] = (bf16_t)(w[q].z & 0xffffu); p[5 * VS] = (bf16_t)(w[q].z >> 16); p[6 * VS] = (bf16_t)(w[q].w & 0xffffu); p[7 * VS] = (bf16_t)(w[q].w >> 16); }
}
__device__ __forceinline__ void chunk_gla_item(const Args& a, int l, int tile, int h, int lane, LAS bf16_t* vT, LAS bf16_t* kdT) {
    const int r = lane & 31, hf = lane >> 5;
    const bf16_t* cols0 = (const bf16_t*)(a.ws + WS_COLS) + (size_t)tile * 64 * NINP;
    float* KV = (float*)(a.ws + WS_KV); float* DEC = (float*)(a.ws + WS_DEC);
    const ChunkPos cp = chunk_pos(tile);
    const f32x16 zero16 = {0.f, 0.f, 0.f, 0.f, 0.f, 0.f, 0.f, 0.f, 0.f, 0.f, 0.f, 0.f, 0.f, 0.f, 0.f, 0.f};
    stage_vT(cols0, h, lane, vT);
#pragma unroll 1
    for (int dir = 0; dir < 2; ++dir) {
        float gw8[8], gbias; bf16x8 Az[2]; u32x2 kraw[2][4];
        gla_gate_loads(a, l, h, dir, cols0, lane, gw8, gbias, Az);
#pragma unroll
        for (int nt = 0; nt < 2; ++nt)
#pragma unroll
            for (int g = 0; g < 4; ++g) kraw[nt][g] = *(const u32x2*)(cols0 + (size_t)(32 * nt + r) * NINP + C_K + 32 * h + 4 * hf + 8 * g);
#pragma unroll
        for (int j = 0; j < 8; ++j) PIN(gw8[j]);
        PIN(gbias); PIN(Az[0]); PIN(Az[1]);
#pragma unroll
        for (int nt = 0; nt < 2; ++nt)
#pragma unroll
            for (int g = 0; g < 4; ++g) PIN(kraw[nt][g]);
        f32x16 BT[2]; gla_prep_dir(dir, lane, gw8, gbias, Az, BT);
        const size_t e = (size_t)((dir * 4 + cp.b) * 4 + h) * NSEQ + (dir ? cp.sb : cp.sf);
        const int srcl = (dir ? 0 : 31) + 32 * hf;
        float tot[16];
#pragma unroll
        for (int i = 0; i < 16; ++i) tot[i] = __shfl(dir ? BT[0][i] : BT[1][i], srcl);
        if (r == (dir ? 0 : 31)) {
#pragma unroll
            for (int i = 0; i < 16; ++i) DEC[e * 32 + (i & 3) + 8 * (i >> 2) + 4 * hf] = __expf(tot[i]);
        }
#pragma unroll
        for (int nt = 0; nt < 2; ++nt) {
#pragma unroll
            for (int g = 0; g < 4; ++g) { const u32x2 kw = kraw[nt][g];
                const float kf[4] = {bflo(kw.x), bfhi(kw.x), bflo(kw.y), bfhi(kw.y)};
#pragma unroll
                for (int q = 0; q < 4; ++q) { const int i = 4 * g + q; const float kd = kf[q] * __expf(tot[i] - BT[nt][i]);
                    kdT[(8 * g + 4 * hf + q) * VS + 32 * nt + r] = (bf16_t)(pk2c(kd, 0.f) & 0xffffu); } }
        }
        LDS_WAIT(); asm volatile("" ::: "memory");
#pragma unroll 1
        for (int ct = 0; ct < 2; ++ct) {
            f32x16 acc = zero16;
#pragma unroll
            for (int ks = 0; ks < 4; ++ks) {
                const bf16x8 A = *(const LAS bf16x8*)(vT + (32 * ct + r) * VS + 16 * ks + 8 * hf);
                const bf16x8 B = *(const LAS bf16x8*)(kdT + r * VS + 16 * ks + 8 * hf);
                acc = MFMA32(A, B, acc); }
            float* dst = KV + e * 2048 + (size_t)(32 * ct + 4 * hf) * 32 + r;
#pragma unroll
            for (int i = 0; i < 16; ++i) dst[((i & 3) + 8 * (i >> 2)) * 32] = acc[i];
        }
        LDS_WAIT(); asm volatile("" ::: "memory");
    }
}
__device__ __forceinline__ void chunk_agv_item(const Args& a, int row0, int lane) {
    const bf16_t* COLS = (const bf16_t*)(a.ws + WS_COLS); float* AGV = (float*)(a.ws + WS_AGV); float* CXV = (float*)(a.ws + WS_CXV);
    const int t = lane >> 3;
#pragma unroll
    for (int rep = 0; rep < 2; ++rep) { const int c8 = ((lane & 7) + 8 * rep) * 8; const bf16_t* rp = COLS + (size_t)(row0 + t) * NINP;
        float fa[8], fg[8], fc[8], fx[8];
        unpack8(*(const u32x4*)(rp + C_CA + 128 + c8), fa); unpack8(*(const u32x4*)(rp + C_CG + 128 + c8), fg);
        unpack8(*(const u32x4*)(rp + C_SC + 128 + c8), fc); unpack8(*(const u32x4*)(rp + C_SX + 128 + c8), fx);
        f32x4 o0, o1, p0, p1;
#pragma unroll
        for (int i = 0; i < 4; ++i) { o0[i] = fa[i] * sigmoidf_(fg[i]); o1[i] = fa[4 + i] * sigmoidf_(fg[4 + i]); p0[i] = fc[i] * fx[i]; p1[i] = fc[4 + i] * fx[4 + i]; }
        float* ao = AGV + (size_t)(row0 + t) * 128 + c8; float* co = CXV + (size_t)(row0 + t) * 128 + c8;
        *(f32x4*)ao = o0; *(f32x4*)(ao + 4) = o1; *(f32x4*)co = p0; *(f32x4*)(co + 4) = p1; }
}
__device__ __forceinline__ int next_item(LAS int* ctr, int lane) {
    int j = 0; if (lane == 0) j = __hip_atomic_fetch_add(ctr, 1, __ATOMIC_RELAXED, __HIP_MEMORY_SCOPE_WORKGROUP);
    return __builtin_amdgcn_readfirstlane(j);
}
__device__ __forceinline__ void phase_chunk(const Args& a, int l, LAS unsigned char* lds) {
    const int tid = tid_now(), lane = tid & 63, wid = __builtin_amdgcn_readfirstlane(tid >> 6);
    LAS bf16_t* vT = (LAS bf16_t*)(lds + wid * 16384); LAS bf16_t* kdT = vT + 64 * VS;
    LAS int* ctr = (LAS int*)(lds + MISC_OFF + 16);
    if (tid == 0) *ctr = 0;
    __syncthreads();
    const int b = blockIdx.x, G = gridDim.x, nL = b < 512 ? (511 - b) / G + 1 : 0, cx = (G >= 48 ? (b >= 32 && b < 48) : (b < 16)) ? 1 : 0, cxt = 512 + (G >= 48 ? b - 32 : b);
    for (;;) { int j = next_item(ctr, lane);
        if (j < 4 * nL) { chunk_gla_item(a, l, b + G * (j >> 2), j & 3, lane, vT, kdT); continue; }
        j -= 4 * nL;
        if (j < 4 * cx) { chunk_gla_item(a, l, cxt, j & 3, lane, vT, kdT); continue; }
        j -= 4 * cx; if (j >= 8 * nL) break;
        chunk_agv_item(a, (b + G * (j >> 3)) * 64 + (j & 7) * 8, lane);
    }
}
__device__ __forceinline__ void mixer_gla_item(const Args& a, int l, int tile, int h, int lane, LAS bf16_t* vT) {
    const bf16_t* cols0 = (const bf16_t*)(a.ws + WS_COLS) + (size_t)tile * 64 * NINP;
    const bf16_t* SIN = (const bf16_t*)(a.ws + WS_SIN); bf16_t* MIX = (bf16_t*)(a.ws + WS_MIX);
    const ChunkPos cp = chunk_pos(tile);
    const f32x16 zero16 = {0.f, 0.f, 0.f, 0.f, 0.f, 0.f, 0.f, 0.f, 0.f, 0.f, 0.f, 0.f, 0.f, 0.f, 0.f, 0.f};
    stage_vT(cols0, h, lane, vT);
    LDS_WAIT(); asm volatile("" ::: "memory");
    f32x16 OT[2][2] = {{zero16, zero16}, {zero16, zero16}};
#pragma unroll 1
    for (int dir = 0; dir < 2; ++dir) {
        int ln = lane; asm volatile("" : "+v"(ln)); const int r = ln & 31, hf = ln >> 5;
        bf16x8 QD[2][2], KI[2][2];
        const bf16_t* st = SIN + ((size_t)((dir * 4 + cp.b) * 4 + h) * NSEQ + (dir ? cp.sb : cp.sf)) * 2048;
        u32x2 sraw[2][2][2];
        { float gw8[8], gbias; bf16x8 Az[2]; u32x2 qraw[2][4], kraw[2][4];
            gla_gate_loads(a, l, h, dir, cols0, ln, gw8, gbias, Az);
#pragma unroll
            for (int nt = 0; nt < 2; ++nt)
#pragma unroll
                for (int g = 0; g < 4; ++g) { const bf16_t* qp = cols0 + (size_t)(32 * nt + r) * NINP + C_Q + 32 * h + 4 * hf + 8 * g; qraw[nt][g] = *(const u32x2*)qp; kraw[nt][g] = *(const u32x2*)(qp + (C_K - C_Q)); }
#pragma unroll
            for (int ct = 0; ct < 2; ++ct)
#pragma unroll
                for (int s = 0; s < 2; ++s) { const size_t off = (size_t)(32 * ct + r) * 32 + 16 * s + 4 * hf; sraw[ct][s][0] = *(const u32x2*)(st + off); sraw[ct][s][1] = *(const u32x2*)(st + off + 8); }
#pragma unroll
            for (int j = 0; j < 8; ++j) PIN(gw8[j]);
            PIN(gbias); PIN(Az[0]); PIN(Az[1]);
#pragma unroll
            for (int nt = 0; nt < 2; ++nt)
#pragma unroll
                for (int g = 0; g < 4; ++g) { PIN(qraw[nt][g]); PIN(kraw[nt][g]); }
#pragma unroll
            for (int ct = 0; ct < 2; ++ct)
#pragma unroll
                for (int s = 0; s < 2; ++s) { PIN(sraw[ct][s][0]); PIN(sraw[ct][s][1]); }
            f32x16 BT[2]; gla_prep_dir(dir, ln, gw8, gbias, Az, BT);
#pragma unroll
            for (int nt = 0; nt < 2; ++nt) {
                float qd[16], ki[16];
#pragma unroll
                for (int g = 0; g < 4; ++g) { const u32x2 qw = qraw[nt][g], kw = kraw[nt][g];
                    const float qf[4] = {bflo(qw.x), bfhi(qw.x), bflo(qw.y), bfhi(qw.y)}, kf[4] = {bflo(kw.x), bfhi(kw.x), bflo(kw.y), bfhi(kw.y)};
#pragma unroll
                    for (int q = 0; q < 4; ++q) { const float bb = BT[nt][4 * g + q]; qd[4 * g + q] = qf[q] * 0.17677669529663687f * __expf(bb); ki[4 * g + q] = kf[q] * __expf(-bb); } }
#pragma unroll
                for (int s = 0; s < 2; ++s) { QD[nt][s] = pack8f(qd[8 * s], qd[8 * s + 1], qd[8 * s + 2], qd[8 * s + 3], qd[8 * s + 4], qd[8 * s + 5], qd[8 * s + 6], qd[8 * s + 7]);
                    KI[nt][s] = pack8f(ki[8 * s], ki[8 * s + 1], ki[8 * s + 2], ki[8 * s + 3], ki[8 * s + 4], ki[8 * s + 5], ki[8 * s + 6], ki[8 * s + 7]); }
            }
        }
#pragma unroll
        for (int jt = 0; jt < 2; ++jt)
#pragma unroll
            for (int it = 0; it < 2; ++it) {
                if (jt != it) { const bool keep = dir ? (jt > it) : (jt < it); if (!keep) continue; }
                f32x16 p = MFMA32(KI[jt][0], QD[it][0], zero16); p = MFMA32(KI[jt][1], QD[it][1], p);
                if (jt == it) {
#pragma unroll
                    for (int i = 0; i < 16; ++i) { const int jj = (i & 3) + 8 * (i >> 2) + 4 * hf; const bool kp_ = dir ? (jj >= r) : (jj <= r); p[i] = kp_ ? p[i] : 0.f; }
                }
                const bf16x8 P0 = pack_step(p, 0), P1 = pack_step(p, 1);
#pragma unroll
                for (int ct = 0; ct < 2; ++ct) {
                    const LAS bf16_t* vp = vT + (32 * ct + r) * VS + 32 * jt + 4 * hf;
                    const bf16x8 A0 = cat44(*(const LAS u32x2*)vp, *(const LAS u32x2*)(vp + 8)), A1 = cat44(*(const LAS u32x2*)(vp + 16), *(const LAS u32x2*)(vp + 24));
                    OT[ct][it] = MFMA32(A0, P0, OT[ct][it]); OT[ct][it] = MFMA32(A1, P1, OT[ct][it]); }
            }
#pragma unroll
        for (int ct = 0; ct < 2; ++ct)
#pragma unroll
            for (int s = 0; s < 2; ++s) {
                const bf16x8 As = cat44(sraw[ct][s][0], sraw[ct][s][1]);
                OT[ct][0] = MFMA32(As, QD[0][s], OT[ct][0]); OT[ct][1] = MFMA32(As, QD[1][s], OT[ct][1]); }
    }
    int ln2 = lane; asm volatile("" : "+v"(ln2)); const int r = ln2 & 31, hf = ln2 >> 5;
    u32x2 graw[2][2][4]; f32x4 gor[2][4];
#pragma unroll
    for (int ct = 0; ct < 2; ++ct)
#pragma unroll
        for (int g = 0; g < 4; ++g) { const int c0 = 32 * ct + 8 * g + 4 * hf; gor[ct][g] = *(const f32x4*)(a.in[I_GOUT] + l * 256 + 64 * h + c0);
#pragma unroll
            for (int it = 0; it < 2; ++it) graw[it][ct][g] = *(const u32x2*)(cols0 + (size_t)(32 * it + r) * NINP + C_G + 64 * h + c0); }
#pragma unroll
    for (int ct = 0; ct < 2; ++ct)
#pragma unroll
        for (int g = 0; g < 4; ++g) { PIN(gor[ct][g]); PIN(graw[0][ct][g]); PIN(graw[1][ct][g]); }
#pragma unroll
    for (int it = 0; it < 2; ++it) {
        float ss = 0.f;
#pragma unroll
        for (int ct = 0; ct < 2; ++ct)
#pragma unroll
            for (int i = 0; i < 16; ++i) ss += OT[ct][it][i] * OT[ct][it][i];
        ss += __shfl_xor(ss, 32);
        const float rs = rsqrtf(ss * (1.0f / 64.0f) + EPS);
        const int t = 32 * it + r;
#pragma unroll
        for (int ct = 0; ct < 2; ++ct)
#pragma unroll
            for (int g = 0; g < 4; ++g) { const int c0 = 32 * ct + 8 * g + 4 * hf;
                const u32x2 gw_ = graw[it][ct][g];
                const f32x4 go = gor[ct][g];
                const float o0 = OT[ct][it][4 * g] * rs * go[0] * siluf_(bflo(gw_.x)), o1 = OT[ct][it][4 * g + 1] * rs * go[1] * siluf_(bfhi(gw_.x));
                const float o2 = OT[ct][it][4 * g + 2] * rs * go[2] * siluf_(bflo(gw_.y)), o3 = OT[ct][it][4 * g + 3] * rs * go[3] * siluf_(bfhi(gw_.y));
                u32x2 w; w.x = pk2c(o0, o1); w.y = pk2c(o2, o3);
                *(u32x2*)(MIX + (size_t)(tile * 64 + t) * D + 64 * h + c0) = w; }
    }
    LDS_WAIT(); asm volatile("" ::: "memory");
}
template <int TAPS>
__device__ __forceinline__ void vconv_item(const float* SRC, float* DST, const float* w  , int b, int col, int chg, LAS float* buf, int lane) {
    const int ch = lane & 31, rh = lane >> 5;
    const size_t base = ((size_t)b * SEQ + col) * 128 + chg * 32 + ch;
#pragma unroll 8
    for (int r = 0; r < 128; r += 2) buf[(r + rh) * 32 + ch] = SRC[base + (size_t)(r + rh) * 64 * 128];
    float wt[TAPS];
#pragma unroll
    for (int j = 0; j < TAPS; ++j) wt[j] = w[j * 256 + chg * 32 + ch];
    LDS_WAIT(); asm volatile("" ::: "memory");
    constexpr int HW = TAPS / 2;
#pragma unroll 1
    for (int r0 = 0; r0 < 64; r0 += 8) {
        const int rb = rh * 64 + r0;
        float o[8] = {0.f, 0.f, 0.f, 0.f, 0.f, 0.f, 0.f, 0.f};
#pragma unroll
        for (int j = 0; j < TAPS + 7; ++j) { const int rin = rb - HW + j; const float x = (rin >= 0 && rin < 128) ? buf[rin * 32 + ch] : 0.f;
#pragma unroll
            for (int q = 0; q < 8; ++q) { if (j - q >= 0 && j - q < TAPS) o[q] += x * wt[j - q]; } }
#pragma unroll
        for (int q = 0; q < 8; ++q) DST[base + (size_t)(rb + q) * 64 * 128] = o[q];
    }
    LDS_WAIT(); asm volatile("" ::: "memory");
}
__device__ __forceinline__ void phase_scan(const Args& a, int l, LAS unsigned char* lds) {
    const int tid = tid_now(), lane = tid & 63, wid = __builtin_amdgcn_readfirstlane(tid >> 6);
    const float* KV = (const float*)(a.ws + WS_KV); const float* DEC = (const float*)(a.ws + WS_DEC); bf16_t* SIN = (bf16_t*)(a.ws + WS_SIN);
    if (tid < 256) {
        for (int rp = 0; rp < ((REP_SUB == 5 && l == 0) ? 2 : 1); ++rp)
        for (int gid = blockIdx.x * 256 + tid; gid < 65536; gid += gridDim.x * 256) {
            const int e = gid >> 11, idx = gid & 2047;
            const float* p = KV + (size_t)e * NSEQ * 2048 + idx; const float* dp = DEC + (size_t)e * NSEQ * 32 + (idx & 31); bf16_t* q = SIN + (size_t)e * NSEQ * 2048 + idx;
            float st = 0.f;
#pragma unroll 1
            for (int s0 = 0; s0 < NSEQ; s0 += 22) {
                float kv[22], dd[22];
#pragma unroll
                for (int u = 0; u < 22; ++u) { kv[u] = p[(size_t)(s0 + u) * 2048]; dd[u] = dp[(s0 + u) * 32]; }
#pragma unroll
                for (int u = 0; u < 22; ++u) { PIN(kv[u]); PIN(dd[u]); }
#pragma unroll
                for (int u = 0; u < 22; ++u) { q[(size_t)(s0 + u) * 2048] = (bf16_t)(pk2c(st, 0.f) & 0xffffu); st = dd[u] * st + kv[u]; }
            }
        }
    }
    LAS float* buf = (LAS float*)(lds + wid * 16384);
    const int gw = blockIdx.x * 8 + wid, NGW = gridDim.x * 8;
    for (int rp = 0; rp < ((REP_SUB == 6 && l == 0) ? 2 : 1); ++rp)
    for (int it = gw; it < 2048; it += NGW) {
        const int kind = it >> 10, q = it & 1023, b = q >> 8, col = (q >> 2) & 63, chg = q & 3;
        if (kind == 0) vconv_item<31>((const float*)(a.ws + WS_AGV), (float*)(a.ws + WS_UV), a.in[I_CONFW] + (size_t)l * 31 * 256 + 128, b, col, chg, buf, lane);
        else vconv_item<3>((const float*)(a.ws + WS_CXV), (float*)(a.ws + WS_SCV), a.in[I_SCW] + (size_t)l * 3 * 256 + 128, b, col, chg, buf, lane);
    }
}

__device__ __forceinline__ void mixer_conv_item(const Args& a, int l, int tile, int tg, int lane0, LAS float* U) {
    const bf16_t* COLS = (const bf16_t*)(a.ws + WS_COLS); bf16_t* MIX = (bf16_t*)(a.ws + WS_MIX);
    const int row0 = tile * 64, T0 = 16 * tg;
    const float* confw = a.in[I_CONFW] + (size_t)l * 31 * 256; const float* scw = a.in[I_SCW] + (size_t)l * 3 * 256;
#pragma unroll 1
    for (int p = 0; p < 2; ++p) {
        int lane = lane0; asm volatile("" : "+v"(lane));
        const int c = 64 * p + lane;
        float wv[31];
#pragma unroll
        for (int j = 0; j < 31; ++j) wv[j] = confw[j * 256 + c];
        float bias = a.in[I_CONFB][l * 256 + c];
        unsigned ra[46], rg[46];
#pragma unroll
        for (int i = 0; i < 46; ++i) { const int t = T0 - 15 + i, tc = t < 0 ? 0 : (t > 63 ? 63 : t); const bf16_t* rp = COLS + (size_t)(row0 + tc) * NINP + c; ra[i] = rp[C_CA]; rg[i] = rp[C_CG]; }
#pragma unroll
        for (int j = 0; j < 31; ++j) PIN(wv[j]);
        PIN(bias);
#pragma unroll
        for (int i = 0; i < 46; ++i) { PIN(ra[i]); PIN(rg[i]); }
        float ag[46];
#pragma unroll
        for (int i = 0; i < 46; ++i) { const int t = T0 - 15 + i; const float m = (t >= 0 && t < 64) ? 1.0f : 0.0f;
            ag[i] = m * __uint_as_float(ra[i] << 16) * __builtin_amdgcn_rcpf(1.0f + __expf(-__uint_as_float(rg[i] << 16))); }
#pragma unroll
        for (int q = 0; q < 16; ++q) { float o = bias;
#pragma unroll
            for (int j = 0; j < 31; ++j) o += ag[q + j] * wv[j];
            U[q * 256 + ((((c >> 2) ^ q) << 2) | (c & 3))] = o; }
        unsigned rc[18], rx[18], rsb[16];
        float w0 = scw[c], w1 = scw[256 + c], w2 = scw[512 + c];
#pragma unroll
        for (int i = 0; i < 18; ++i) { const int t = T0 - 1 + i, tc = t < 0 ? 0 : (t > 63 ? 63 : t); const bf16_t* rp = COLS + (size_t)(row0 + tc) * NINP + c; rc[i] = rp[C_SC]; rx[i] = rp[C_SX]; }
#pragma unroll
        for (int q = 0; q < 16; ++q) rsb[q] = COLS[(size_t)(row0 + T0 + q) * NINP + C_SB + c];
        PIN(w0); PIN(w1); PIN(w2);
#pragma unroll
        for (int i = 0; i < 18; ++i) { PIN(rc[i]); PIN(rx[i]); }
#pragma unroll
        for (int q = 0; q < 16; ++q) PIN(rsb[q]);
        float cx[18];
#pragma unroll
        for (int i = 0; i < 18; ++i) { const int t = T0 - 1 + i; const float m = (t >= 0 && t < 64) ? 1.0f : 0.0f; cx[i] = m * __uint_as_float(rc[i] << 16) * __uint_as_float(rx[i] << 16); }
#pragma unroll
        for (int q = 0; q < 16; ++q) { const float cv = cx[q] * w0 + cx[q + 1] * w1 + cx[q + 2] * w2;
            MIX[(size_t)(row0 + T0 + q) * D + 512 + c] = (bf16_t)(pk2c(__uint_as_float(rsb[q] << 16) * cv, 0.f) & 0xffffu); }
    }
    {
        int lane = lane0; asm volatile("" : "+v"(lane));
        const float* UV = (const float*)(a.ws + WS_UV); const float* SCV = (const float*)(a.ws + WS_SCV);
        f32x4 uu[8], svv[8], bzz[8]; u32x2 sbb[8];
#pragma unroll
        for (int k8 = 0; k8 < 8; ++k8) { const int idx = lane + 64 * k8, t = idx >> 5, c4 = (idx & 31) * 4; const size_t row = (size_t)(row0 + T0 + t);
            uu[k8] = *(const f32x4*)(UV + row * 128 + c4); bzz[k8] = *(const f32x4*)(a.in[I_CONFB] + l * 256 + 128 + c4);
            svv[k8] = *(const f32x4*)(SCV + row * 128 + c4); sbb[k8] = *(const u32x2*)(COLS + row * NINP + C_SB + 128 + c4); }
#pragma unroll
        for (int k8 = 0; k8 < 8; ++k8) { PIN(uu[k8]); PIN(bzz[k8]); PIN(svv[k8]); PIN(sbb[k8]); }
#pragma unroll
        for (int k8 = 0; k8 < 8; ++k8) { const int idx = lane + 64 * k8, t = idx >> 5, c4 = (idx & 31) * 4; const size_t row = (size_t)(row0 + T0 + t);
            *(LAS f32x4*)(U + t * 256 + ((((128 + c4) >> 2) ^ t) << 2)) = uu[k8] + bzz[k8];
            u32x2 w; w.x = pk2c(bflo(sbb[k8].x) * svv[k8][0], bfhi(sbb[k8].x) * svv[k8][1]); w.y = pk2c(bflo(sbb[k8].y) * svv[k8][2], bfhi(sbb[k8].y) * svv[k8][3]);
            *(u32x2*)(MIX + row * D + 512 + 128 + c4) = w; }
    }
    LDS_WAIT(); asm volatile("" ::: "memory");
    {
        int lane = lane0; asm volatile("" : "+v"(lane));
        const int t = lane >> 2, qd = lane & 3;
        f32x4 lgv[16], lbv[16];
        { const float* lg = a.in[I_CONFG] + l * 256 + 64 * qd; const float* lb = a.in[I_CONFBETA] + l * 256 + 64 * qd;
#pragma unroll
            for (int i = 0; i < 16; ++i) { lgv[i] = *(const f32x4*)(lg + 4 * i); lbv[i] = *(const f32x4*)(lb + 4 * i); }
#pragma unroll
            for (int i = 0; i < 16; ++i) { PIN(lgv[i]); PIN(lbv[i]); } }
        f32x4 v[16]; float s1 = 0.f;
#pragma unroll
        for (int i = 0; i < 16; ++i) { v[i] = *(const LAS f32x4*)(U + t * 256 + (((16 * qd + i) ^ t) << 2)); s1 += (v[i][0] + v[i][1]) + (v[i][2] + v[i][3]); }
        s1 += __shfl_xor(s1, 1); s1 += __shfl_xor(s1, 2);
        const float mean = s1 * (1.0f / 256.0f); float s2 = 0.f;
#pragma unroll
        for (int i = 0; i < 16; ++i) { v[i] = v[i] - mean; s2 += (v[i][0] * v[i][0] + v[i][1] * v[i][1]) + (v[i][2] * v[i][2] + v[i][3] * v[i][3]); }
        s2 += __shfl_xor(s2, 1); s2 += __shfl_xor(s2, 2);
        const float rstd = rsqrtf(s2 * (1.0f / 256.0f) + EPS);
        bf16_t* dst = MIX + (size_t)(row0 + T0 + t) * D + 256 + 64 * qd;
#pragma unroll
        for (int i = 0; i < 16; i += 2) { const f32x4 g0 = lgv[i], g1 = lgv[i + 1], b0 = lbv[i], b1 = lbv[i + 1];
            const f32x4 y0 = v[i] * rstd * g0 + b0, y1 = v[i + 1] * rstd * g1 + b1;
            u32x4 w; w.x = pk2c(siluf_(y0[0]), siluf_(y0[1])); w.y = pk2c(siluf_(y0[2]), siluf_(y0[3])); w.z = pk2c(siluf_(y1[0]), siluf_(y1[1])); w.w = pk2c(siluf_(y1[2]), siluf_(y1[3]));
            *(u32x4*)(dst + 4 * i) = w; }
    }
    LDS_WAIT(); asm volatile("" ::: "memory");
}
__device__ __forceinline__ void mixer_pool_item(const Args& a, int l, int tile, int g, int lane0) {
    const bf16_t* COLS = (const bf16_t*)(a.ws + WS_COLS); bf16_t* MIX = (bf16_t*)(a.ws + WS_MIX);
    const f32x16 zero16 = {0.f, 0.f, 0.f, 0.f, 0.f, 0.f, 0.f, 0.f, 0.f, 0.f, 0.f, 0.f, 0.f, 0.f, 0.f, 0.f};
    const int row0 = tile * 64;
    {
        int lane = lane0; asm volatile("" : "+v"(lane));
        const int r = lane & 31, hf = lane >> 5, hw = 1 << g;
        const bf16_t* pwt = (const bf16_t*)(a.ws + WS_PWT) + (size_t)(l * 4 + g) * 4096;
        const u32x4* band = (const u32x4*)(a.ws + WS_BAND) + (size_t)g * 512 + lane;
        f32x16 Y[2][2] = {{zero16, zero16}, {zero16, zero16}};
        bf16x8 Ax[2][4], Bw[2][4]; u32x4 Bb[8];
#pragma unroll
        for (int mt = 0; mt < 2; ++mt)
#pragma unroll
            for (int ks = 0; ks < 4; ++ks) { Ax[mt][ks] = *(const bf16x8*)(COLS + (size_t)(row0 + 32 * mt + r) * NINP + C_PL + 64 * g + 16 * ks + 8 * hf);
                Bw[mt][ks] = *(const bf16x8*)(pwt + (size_t)(32 * mt + r) * 64 + 16 * ks + 8 * hf); }
#pragma unroll
        for (int f = 0; f < 8; ++f) Bb[f] = band[f * 64];
        f32x4 psv[2][4];
#pragma unroll
        for (int ntd = 0; ntd < 2; ++ntd)
#pragma unroll
            for (int q = 0; q < 4; ++q) psv[ntd][q] = *(const f32x4*)(a.in[I_POOLS] + l * 256 + 64 * g + 32 * ntd + 8 * q + 4 * hf);
#pragma unroll
        for (int mt = 0; mt < 2; ++mt)
#pragma unroll
            for (int ks = 0; ks < 4; ++ks) { PIN(Ax[mt][ks]); PIN(Bw[mt][ks]); }
#pragma unroll
        for (int f = 0; f < 8; ++f) PIN(Bb[f]);
#pragma unroll
        for (int ntd = 0; ntd < 2; ++ntd)
#pragma unroll
            for (int q = 0; q < 4; ++q) PIN(psv[ntd][q]);
#pragma unroll
        for (int mt = 0; mt < 2; ++mt) {
#pragma unroll
            for (int ntd = 0; ntd < 2; ++ntd) {
                f32x16 z = zero16;
#pragma unroll
                for (int ks = 0; ks < 4; ++ks) z = MFMA32(Ax[mt][ks], Bw[ntd][ks], z);
#pragma unroll
                for (int sq = 0; sq < 2; ++sq) {
                    const float t8[8] = {z[8 * sq], z[8 * sq + 1], z[8 * sq + 2], z[8 * sq + 3], z[8 * sq + 4], z[8 * sq + 5], z[8 * sq + 6], z[8 * sq + 7]};
                    bf16x8 Zh, Zl; split8(t8, Zh, Zl);
#pragma unroll
                    for (int ntt = 0; ntt < 2; ++ntt) { const bf16x8 Bq = __builtin_bit_cast(bf16x8, Bb[(mt * 2 + ntt) * 2 + sq]);
                        Y[ntd][ntt] = MFMA32(Zh, Bq, Y[ntd][ntt]); Y[ntd][ntt] = MFMA32(Zl, Bq, Y[ntd][ntt]); }
                }
            }
        }
#pragma unroll
        for (int ntt = 0; ntt < 2; ++ntt) { const int t = 32 * ntt + r; int lo = t - hw, hi = t + hw; lo = lo < 0 ? 0 : lo; hi = hi > 64 ? 64 : hi; const float inv = 1.0f / (float)(hi - lo);
#pragma unroll
            for (int ntd = 0; ntd < 2; ++ntd)
#pragma unroll
                for (int q = 0; q < 4; ++q) { const int dd0 = 32 * ntd + 8 * q + 4 * hf; const f32x4 ps = psv[ntd][q];
                    u32x2 w; w.x = pk2c(Y[ntd][ntt][4 * q] * inv * ps[0], Y[ntd][ntt][4 * q + 1] * inv * ps[1]); w.y = pk2c(Y[ntd][ntt][4 * q + 2] * inv * ps[2], Y[ntd][ntt][4 * q + 3] * inv * ps[3]);
                    *(u32x2*)(MIX + (size_t)(row0 + t) * D + 768 + 64 * g + dd0) = w; } }
    }
}

__device__ __forceinline__ void mixer_local(const Args& a, int l, int tile, int half, LAS unsigned char* lds) {
    const int tid = tid_now();
    const bf16_t* COLS = (const bf16_t*)(a.ws + WS_COLS); bf16_t* MIX = (bf16_t*)(a.ws + WS_MIX);
    LAS float* AG = (LAS float*)lds;
    LAS float* U = AG + 7936;
    LAS float* CX = U + 8192;
    const bool lat = tile < 512; const int r0 = tile * 64 + half * 32;
    const int seq_lo = lat ? tile * 64 : (NLAT + ((tile - 512) >> 2) * CTXL), seq_hi = lat ? tile * 64 + 64 : seq_lo + CTXL;
    const float* confw = a.in[I_CONFW] + (size_t)l * 31 * 256; const float* scw = a.in[I_SCW] + (size_t)l * 3 * 256;
    const int npass = lat ? 1 : 2;
    for (int ps = 0; ps < npass; ++ps) {
        const int chb = ps * 128;
        for (int idx = tid; idx < 62 * 16; idx += 512) { const int tt = idx >> 4, c8 = (idx & 15) * 8, r = r0 - 15 + tt;
            float o[8] = {0.f, 0.f, 0.f, 0.f, 0.f, 0.f, 0.f, 0.f};
            if (r >= seq_lo && r < seq_hi) { const bf16_t* rp = COLS + (size_t)r * NINP; float fa[8], fg[8]; unpack8(*(const u32x4*)(rp + C_CA + chb + c8), fa); unpack8(*(const u32x4*)(rp + C_CG + chb + c8), fg);
#pragma unroll
                for (int i = 0; i < 8; ++i) o[i] = fa[i] * sigmoidf_(fg[i]); }
            *(LAS f32x4*)(AG + tt * 128 + c8) = (f32x4){o[0], o[1], o[2], o[3]}; *(LAS f32x4*)(AG + tt * 128 + c8 + 4) = (f32x4){o[4], o[5], o[6], o[7]}; }
        for (int idx = tid; idx < 34 * 16; idx += 512) { const int tt = idx >> 4, c8 = (idx & 15) * 8, r = r0 - 1 + tt;
            float o[8] = {0.f, 0.f, 0.f, 0.f, 0.f, 0.f, 0.f, 0.f};
            if (r >= seq_lo && r < seq_hi) { const bf16_t* rp = COLS + (size_t)r * NINP; float fc[8], fx[8]; unpack8(*(const u32x4*)(rp + C_SC + chb + c8), fc); unpack8(*(const u32x4*)(rp + C_SX + chb + c8), fx);
#pragma unroll
                for (int i = 0; i < 8; ++i) o[i] = fc[i] * fx[i]; }
            *(LAS f32x4*)(CX + tt * 128 + c8) = (f32x4){o[0], o[1], o[2], o[3]}; *(LAS f32x4*)(CX + tt * 128 + c8 + 4) = (f32x4){o[4], o[5], o[6], o[7]}; }
        __syncthreads();
        { const int c = tid & 127, t0 = (tid >> 7) * 8;
            float wv[31];
#pragma unroll
            for (int j = 0; j < 31; ++j) wv[j] = confw[j * 256 + chb + c];
            const float bias = a.in[I_CONFB][l * 256 + chb + c];
            const float w0 = scw[chb + c], w1 = scw[256 + chb + c], w2 = scw[512 + chb + c];
            float o[8];
#pragma unroll
            for (int q = 0; q < 8; ++q) o[q] = bias;
#pragma unroll
            for (int j = 0; j < 38; ++j) { const float x = AG[(t0 + j) * 128 + c];
#pragma unroll
                for (int q = 0; q < 8; ++q) { if (j - q >= 0 && j - q < 31) o[q] += x * wv[j - q]; } }
#pragma unroll
            for (int q = 0; q < 8; ++q) U[(t0 + q) * 256 + chb + c] = o[q];
            unsigned sbr[8];
#pragma unroll
            for (int q = 0; q < 8; ++q) sbr[q] = COLS[(size_t)(r0 + t0 + q) * NINP + C_SB + chb + c];
#pragma unroll
            for (int q = 0; q < 8; ++q) PIN(sbr[q]);
#pragma unroll
            for (int q = 0; q < 8; ++q) { const int t = t0 + q; const float cv = CX[t * 128 + c] * w0 + CX[(t + 1) * 128 + c] * w1 + CX[(t + 2) * 128 + c] * w2;
                const float sb = __uint_as_float(sbr[q] << 16);
                MIX[(size_t)(r0 + t) * D + 512 + chb + c] = (bf16_t)(pk2(sb * cv, 0.f) & 0xffffu); }
        }
        __syncthreads();
    }
    if (lat) {
        const float* UV = (const float*)(a.ws + WS_UV); const float* SCV = (const float*)(a.ws + WS_SCV);
        for (int idx = tid; idx < 32 * 32; idx += 512) { const int t = idx >> 5, c4 = (idx & 31) * 4;
            const f32x4 u = *(const f32x4*)(UV + (size_t)(r0 + t) * 128 + c4), bz = *(const f32x4*)(a.in[I_CONFB] + l * 256 + 128 + c4);
            *(LAS f32x4*)(U + t * 256 + 128 + c4) = u + bz;
            const f32x4 sv = *(const f32x4*)(SCV + (size_t)(r0 + t) * 128 + c4);
            const u32x2 sbw = *(const u32x2*)(COLS + (size_t)(r0 + t) * NINP + C_SB + 128 + c4);
            u32x2 w; w.x = pk2(bflo(sbw.x) * sv[0], bfhi(sbw.x) * sv[1]); w.y = pk2(bflo(sbw.y) * sv[2], bfhi(sbw.y) * sv[3]);
            *(u32x2*)(MIX + (size_t)(r0 + t) * D + 512 + 128 + c4) = w; }
        __syncthreads();
    }
    { const int t = tid >> 4, c0 = (tid & 15) * 16;
        float s = 0.f;
#pragma unroll
        for (int i = 0; i < 16; i += 4) { const f32x4 v = *(const LAS f32x4*)(U + t * 256 + c0 + i); s += (v[0] + v[1]) + (v[2] + v[3]); }
        s += __shfl_xor(s, 1); s += __shfl_xor(s, 2); s += __shfl_xor(s, 4); s += __shfl_xor(s, 8);
        const float mean = s * (1.0f / 256.0f); float q = 0.f;
#pragma unroll
        for (int i = 0; i < 16; i += 4) { const f32x4 v = *(const LAS f32x4*)(U + t * 256 + c0 + i) - mean; q += (v[0] * v[0] + v[1] * v[1]) + (v[2] * v[2] + v[3] * v[3]); }
        q += __shfl_xor(q, 1); q += __shfl_xor(q, 2); q += __shfl_xor(q, 4); q += __shfl_xor(q, 8);
        const float rstd = rsqrtf(q * (1.0f / 256.0f) + EPS);
        const float* lg = a.in[I_CONFG] + l * 256 + c0; const float* lb = a.in[I_CONFBETA] + l * 256 + c0;
#pragma unroll
        for (int i = 0; i < 16; i += 8) { float y[8];
#pragma unroll
            for (int k = 0; k < 8; ++k) y[k] = siluf_((U[t * 256 + c0 + i + k] - mean) * rstd * lg[i + k] + lb[i + k]);
            u32x4 w; w.x = pk2(y[0], y[1]); w.y = pk2(y[2], y[3]); w.z = pk2(y[4], y[5]); w.w = pk2(y[6], y[7]);
            *(u32x4*)(MIX + (size_t)(r0 + t) * D + 256 + c0 + i) = w; }
    }
    __syncthreads();
    for (int hf = 0; hf < 2; ++hf) {
        LAS float* PI = (LAS float*)lds;
        LAS float* DF = PI + 6144;
        LAS float* PW = DF + 4224;
        for (int idx = tid; idx < 48 * 16; idx += 512) { const int tt = idx >> 4, c8 = (idx & 15) * 8, r = r0 - 8 + tt;
            float o[8] = {0.f, 0.f, 0.f, 0.f, 0.f, 0.f, 0.f, 0.f};
            if (r >= seq_lo && r < seq_hi) unpack8(*(const u32x4*)(COLS + (size_t)r * NINP + C_PL + hf * 128 + c8), o);
            *(LAS f32x4*)(PI + tt * 128 + c8) = (f32x4){o[0], o[1], o[2], o[3]}; *(LAS f32x4*)(PI + tt * 128 + c8 + 4) = (f32x4){o[4], o[5], o[6], o[7]}; }
        for (int idx = tid; idx < 2 * 64 * 64 / 4; idx += 512) *(LAS f32x4*)(PW + idx * 4) = *(const f32x4*)(a.in[I_POOLW] + (size_t)l * 4 * 4096 + (size_t)hf * 2 * 4096 + idx * 4);
        __syncthreads();
        for (int idx = tid; idx < 32 * 128; idx += 512) { const int t = idx >> 7, c = idx & 127, g = hf * 2 + (c >> 6); const int hw = 1 << g;
            const int r = r0 + t; int lo = r - hw, hi = r + hw; lo = lo < seq_lo ? seq_lo : lo; hi = hi > seq_hi ? seq_hi : hi;
            float sm = 0.f; for (int rr = lo; rr < hi; ++rr) sm += PI[(rr - r0 + 8) * 128 + c];
            DF[t * 132 + c] = sm / (float)(hi - lo) - PI[(t + 8) * 128 + c]; }
        __syncthreads();
        { const int gl = tid >> 8, tp = (tid >> 4) & 15, dq = tid & 15; const int dd0 = dq * 4;
            f32x4 o[2] = {(f32x4){0.f, 0.f, 0.f, 0.f}, (f32x4){0.f, 0.f, 0.f, 0.f}};
#pragma unroll 2
            for (int c4 = 0; c4 < 64; c4 += 4) { f32x4 dv[2];
#pragma unroll
                for (int x = 0; x < 2; ++x) dv[x] = *(const LAS f32x4*)(DF + (tp * 2 + x) * 132 + gl * 64 + c4);
#pragma unroll
                for (int q = 0; q < 4; ++q) { const f32x4 wv = *(const LAS f32x4*)(PW + (gl * 64 + c4 + q) * 64 + dd0);
#pragma unroll
                    for (int x = 0; x < 2; ++x) o[x] += dv[x][q] * wv; } }
            const int ch = (hf * 2 + gl) * 64 + dd0; const f32x4 ps = *(const f32x4*)(a.in[I_POOLS] + l * 256 + ch);
#pragma unroll
            for (int x = 0; x < 2; ++x) { u32x2 w; w.x = pk2(o[x][0] * ps[0], o[x][1] * ps[1]); w.y = pk2(o[x][2] * ps[2], o[x][3] * ps[3]);
                *(u32x2*)(MIX + (size_t)(r0 + tp * 2 + x) * D + 768 + ch) = w; } }
        __syncthreads();
    }
}

__device__ __forceinline__ void phase_mixer(const Args& a, int l, LAS unsigned char* lds) {
    const int ntile = (l == 1) ? 512 : NCHUNK;
    { const int tid = tid_now(), lane = tid & 63, wid = __builtin_amdgcn_readfirstlane(tid >> 6);
        LAS bf16_t* vT = (LAS bf16_t*)(lds + wid * 16384);
        LAS int* ctr = (LAS int*)(lds + MISC_OFF + 16);
        if (tid == 0) *ctr = 0;
        __syncthreads();
        const int b = blockIdx.x, G = gridDim.x, nL = b < 512 ? (511 - b) / G + 1 : 0, cx = (l == 0 && (G >= 48 ? (b >= 32 && b < 48) : (b < 16))) ? 1 : 0, cxt = 512 + (G >= 48 ? b - 32 : b);
        for (;;) { int j = next_item(ctr, lane);
            if (j < 4 * nL) { mixer_gla_item(a, l, b + G * (j >> 2), j & 3, lane, vT); continue; }
            j -= 4 * nL;
            if (j < 4 * cx) { mixer_gla_item(a, l, cxt, j & 3, lane, vT); continue; }
            j -= 4 * cx;
            if (j < 4 * nL) { mixer_conv_item(a, l, b + G * (j >> 2), j & 3, lane, (LAS float*)vT); continue; }
            j -= 4 * nL; if (j >= 4 * nL) break;
            mixer_pool_item(a, l, b + G * (j >> 2), j & 3, lane); } }
    if (l == 0) {
        if ((int)gridDim.x > 32 && (int)blockIdx.x >= 32) convert_range(a, lds, CV_E0 + CV_P0_E0, CV_G, (int)blockIdx.x - 32, (int)gridDim.x - 32);
        else { if ((int)gridDim.x <= 32) convert_range(a, lds, CV_E0 + CV_P0_E0, CV_G, (int)blockIdx.x, (int)gridDim.x);
            __syncthreads();
            for (int it = blockIdx.x; it < 16 * 2; it += gridDim.x) mixer_local(a, l, 512 + (it >> 1), it & 1, lds); }
    }
}

__device__ __forceinline__ void phase_router(const Args& a, int l, LAS unsigned char* lds) {
    const int tid = tid_now(), lane = tid & 63, wid = tid >> 6;
    const int M = (l == 1) ? NLAT : MTOT;
    const float* MOD = (const float*)(a.ws + WS_MOD) + (size_t)l * 5 * 6144; unsigned char* H = a.ws + WS_H;
    LAS float* WRE = (LAS float*)lds;
    LAS int* INFO = (LAS int*)(lds + MISC_OFF + 4096);
    LAS int* HIST = (LAS int*)(lds + MISC_OFF + 2048);
    const float* wre = a.in[I_RWE] + (size_t)l * 1024 * 32; const float* wrgT = (const float*)(a.ws + WS_TAB) + (size_t)l * 4096;
    for (int i = tid; i < 1024 * 8; i += 512) { const int k = i >> 3, q = i & 7; const f32x4 w = *(const f32x4*)(wre + k * 32 + q * 4);
        WRE[(4 * q + 0) * 1024 + k] = w[0]; WRE[(4 * q + 1) * 1024 + k] = w[1]; WRE[(4 * q + 2) * 1024 + k] = w[2]; WRE[(4 * q + 3) * 1024 + k] = w[3]; }
    if (tid < 64) HIST[tid] = 0;
    __syncthreads();
    const int per = (M + gridDim.x - 1) / gridDim.x; const int r_lo = blockIdx.x * per; int r_hi = r_lo + per; if (r_hi > M) r_hi = M;
    const float rbg0 = a.in[I_RBG][l * 4 + 0], rbg1 = a.in[I_RBG][l * 4 + 1], rbg2 = a.in[I_RBG][l * 4 + 2], rbg3 = a.in[I_RBG][l * 4 + 3];
    bf16_t* XB = (bf16_t*)(a.ws + WS_XB); const bf16_t* Y1 = (const bf16_t*)(a.ws + WS_Y);
    int cur_b = -1; f32x4 GS[4], SH[4], GA[4], WGT[4][4];
#pragma unroll
    for (int g = 0; g < 4; ++g)
#pragma unroll
        for (int j = 0; j < 4; ++j) WGT[g][j] = *((const f32x4*)(wrgT + g * 1024) + lane + 64 * j);
    for (int rp = 0; rp < ((REP_SUB == 7 && l == 0) ? 2 : 1); ++rp)
#pragma unroll 1
    for (int mm = r_lo + wid; mm < r_hi; mm += 16) {
        f32x4 vv[2][4]; u32x2 yy[2][4]; int mrow[2]; bool has[2];
#pragma unroll
        for (int rr = 0; rr < 2; ++rr) { const int m = mm + 8 * rr; has[rr] = m < r_hi; const int mc = has[rr] ? m : mm; mrow[rr] = mc;
            if (l == 0) load_row(mc < NLAT ? a.in[I_X] + (size_t)mc * D : a.in[I_CTX] + (size_t)(mc - NLAT) * D, lane, vv[rr]);
            else load_row_bf(XB + (size_t)mc * D, lane, vv[rr]);
#pragma unroll
            for (int j = 0; j < 4; ++j) yy[rr][j] = *((const u32x2*)(Y1 + (size_t)mc * D) + lane + 64 * j); }
#pragma unroll
        for (int rr = 0; rr < 2; ++rr) {
            if (!has[rr]) continue;
            const int m = mrow[rr]; const int b = m < NLAT ? (m >> 13) : 4;
            if (b != cur_b) { const float* mod = MOD + (size_t)b * 6144; load_mod_cached(a.in[I_G2] + l * 1024, mod + 4 * 1024, mod + 3 * 1024, mod + 2 * 1024, lane, GS, SH, GA); cur_b = b; }
            f32x4 v[4];
#pragma unroll
            for (int j = 0; j < 4; ++j) { const u32x2 y = yy[rr][j]; v[j] = vv[rr][j] + GA[j] * (f32x4){bflo(y.x), bfhi(y.x), bflo(y.y), bfhi(y.y)}; }
            store_row_bf(XB + (size_t)m * D, lane, v);
            const float rstd = row_rstd(v);
            norm_store_cached8(v, rstd, GS, SH, H + (size_t)m * D, lane);
            float ga_[4] = {0.f, 0.f, 0.f, 0.f};
#pragma unroll
            for (int g = 0; g < 4; ++g)
#pragma unroll
                for (int j = 0; j < 4; ++j) { const f32x4 w = WGT[g][j]; ga_[g] += (v[j][0] * w[0] + v[j][1] * w[1]) + (v[j][2] * w[2] + v[j][3] * w[3]); }
            float lg0, lg1, lg2, lg3;
            { const bool h5 = (lane & 32) != 0, h4 = (lane & 16) != 0;
                float k0 = h5 ? ga_[2] : ga_[0], k1 = h5 ? ga_[3] : ga_[1]; const float s0 = h5 ? ga_[0] : ga_[2], s1 = h5 ? ga_[1] : ga_[3];
                k0 += __shfl_xor(s0, 32); k1 += __shfl_xor(s1, 32);
                float kk = h4 ? k1 : k0; const float sk = h4 ? k0 : k1; kk += __shfl_xor(sk, 16);
                kk += __shfl_xor(kk, 8); kk += __shfl_xor(kk, 4); kk += __shfl_xor(kk, 2); kk += __shfl_xor(kk, 1);
                lg0 = __int_as_float(__builtin_amdgcn_readlane(__float_as_int(kk), 0)) + rbg0; lg1 = __int_as_float(__builtin_amdgcn_readlane(__float_as_int(kk), 16)) + rbg1;
                lg2 = __int_as_float(__builtin_amdgcn_readlane(__float_as_int(kk), 32)) + rbg2; lg3 = __int_as_float(__builtin_amdgcn_readlane(__float_as_int(kk), 48)) + rbg3; }
            int grp = 0; float best = lg0; if (lg1 > best) { best = lg1; grp = 1; } if (lg2 > best) { best = lg2; grp = 2; } if (lg3 > best) { best = lg3; grp = 3; }
            const float pg = 1.0f / (__expf(lg0 - best) + __expf(lg1 - best) + __expf(lg2 - best) + __expf(lg3 - best));
            grp = __builtin_amdgcn_readfirstlane(grp);
            float ep[8];
            { const LAS float* wb = WRE + (size_t)(grp * 8) * 1024;
#pragma unroll
                for (int i = 0; i < 8; i += 2) { f32x4 w[2][4];
#pragma unroll
                    for (int u = 0; u < 2; ++u)
#pragma unroll
                        for (int j = 0; j < 4; ++j) w[u][j] = *((const LAS f32x4*)(wb + (i + u) * 1024) + lane + 64 * j);
#pragma unroll
                    for (int u = 0; u < 2; ++u)
#pragma unroll
                        for (int j = 0; j < 4; ++j) PIN(w[u][j]);
#pragma unroll
                    for (int u = 0; u < 2; ++u) { float acc_ = 0.f;
#pragma unroll
                        for (int j = 0; j < 4; ++j) acc_ += (v[j][0] * w[u][j][0] + v[j][1] * w[u][j][1]) + (v[j][2] * w[u][j][2] + v[j][3] * w[u][j][3]);
                        ep[i + u] = acc_; } } }
            float le[8];
            { const bool h5 = (lane & 32) != 0, h4 = (lane & 16) != 0, h3 = (lane & 8) != 0;
                float k4[4];
#pragma unroll
                for (int i = 0; i < 4; ++i) { const float keep = h5 ? ep[4 + i] : ep[i], send = h5 ? ep[i] : ep[4 + i]; k4[i] = keep + __shfl_xor(send, 32); }
                float k2[2];
#pragma unroll
                for (int i = 0; i < 2; ++i) { const float keep = h4 ? k4[2 + i] : k4[i], send = h4 ? k4[i] : k4[2 + i]; k2[i] = keep + __shfl_xor(send, 16); }
                float kk = h3 ? k2[1] : k2[0]; const float sk = h3 ? k2[0] : k2[1]; kk += __shfl_xor(sk, 8);
                kk += __shfl_xor(kk, 4); kk += __shfl_xor(kk, 2); kk += __shfl_xor(kk, 1);
#pragma unroll
                for (int i = 0; i < 8; ++i) le[i] = __int_as_float(__builtin_amdgcn_readlane(__float_as_int(kk), 8 * i)) + a.in[I_RBE][l * 32 + grp * 8 + i]; }
            int i0 = 0; float v0 = le[0];
#pragma unroll
            for (int i = 1; i < 8; ++i) if (le[i] > v0) { v0 = le[i]; i0 = i; }
            int i1 = -1; float v1 = -3.0e38f;
#pragma unroll
            for (int i = 0; i < 8; ++i) if (i != i0 && le[i] > v1) { v1 = le[i]; i1 = i; }
            const float w0 = 1.0f / (1.0f + __expf(v1 - v0)); const float w1 = 1.0f - w0;
            if (lane == 0) { const int lr = m - r_lo; INFO[lr * 4 + 0] = grp * 8 + i0; INFO[lr * 4 + 1] = grp * 8 + i1; INFO[lr * 4 + 2] = __float_as_int(w0 * pg); INFO[lr * 4 + 3] = __float_as_int(w1 * pg); }
        }
    }
    __syncthreads();
    const int nr = r_hi - r_lo; int lp0 = 0, lp1 = 0, ee0 = 0, ee1 = 0;
    if (tid < nr) { ee0 = INFO[tid * 4 + 0]; ee1 = INFO[tid * 4 + 1]; lp0 = atomicAdd((int*)(HIST + ee0), 1); lp1 = atomicAdd((int*)(HIST + ee1), 1); }
    __syncthreads();
    unsigned* cnt = (unsigned*)(a.ws + WS_CTL) + CW_CNT + l * 32 * 64;
    if (tid < 32) { const int c = HIST[tid]; HIST[32 + tid] = c ? (int)atomicAdd(cnt + tid * 64, (unsigned)c) : 0; }
    __syncthreads();
    if (tid < nr) { const int m = r_lo + tid; const int p0 = HIST[32 + ee0] + lp0, p1 = HIST[32 + ee1] + lp1;
        int* TL = (int*)(a.ws + WS_TOKLIST); TL[ee0 * MTOT + p0] = m; TL[ee1 * MTOT + p1] = m;
        *((i32x4*)(a.ws + WS_TOKINFO) + m) = (i32x4){(ee0 << 20) | p0, (ee1 << 20) | p1, INFO[tid * 4 + 2], INFO[tid * 4 + 3]}; }
    __syncthreads();
}

__device__ __forceinline__ int moe_tables(const Args& a, int l, LAS unsigned char* lds) {
    LAS int* TB = (LAS int*)(lds + MISC_OFF + 256); LAS int* CN = TB + 64; LAS int* TE = (LAS int*)(lds + MISC_OFF + 1024); LAS int* TM = TE + 320;
    const unsigned* cnt = (const unsigned*)(a.ws + WS_CTL) + CW_CNT + l * 32 * 64;
    { const int tq_ = tid_now(); if (tq_ < 32) CN[tq_] = (int)__hip_atomic_load(cnt + tq_ * 64, __ATOMIC_RELAXED, __HIP_MEMORY_SCOPE_AGENT); }
    __syncthreads();
    if (tid_now() == 0) { int t = 0;
#pragma unroll 1
        for (int e = 0; e < 32; ++e) { TB[e] = t; const int nt = (CN[e] + 255) >> 8;
#pragma unroll 1
            for (int q = 0; q < nt; ++q) { TE[t + q] = e; TM[t + q] = q; } t += nt; } TB[32] = t; }
    __syncthreads();
    return __builtin_amdgcn_readfirstlane(TB[32]);
}

__device__ __forceinline__ void phase_combine(const Args& a, int l, LAS unsigned char* lds) {
    const int lane = tid_now() & 63, wid = tid_now() >> 6, gw = blockIdx.x * 8 + wid, NGW = gridDim.x * 8;
    const int M = (l == 1) ? NLAT : MTOT;
    (void)moe_tables(a, l, lds);
    const LAS int* TB = (const LAS int*)(lds + MISC_OFF + 256);
    const float* MOD = (const float*)(a.ws + WS_MOD); const unsigned char* Y = (const unsigned char*)(a.ws + WS_Y); bf16_t* H = (bf16_t*)(a.ws + WS_H);
    bf16_t* XB = (bf16_t*)(a.ws + WS_XB);
    int cur_b = -1; f32x4 GS[4], SH[4], GA[4];
#pragma unroll 1
    for (int mm = gw; mm < M; mm += 2 * NGW) {
        f32x4 vv[2][4]; unsigned ya[2][4], yb[2][4]; i32x4 inf[2]; int mrow[2]; bool has[2];
#pragma unroll
        for (int rr = 0; rr < 2; ++rr) { const int m = mm + rr * NGW; has[rr] = m < M; const int mc = has[rr] ? m : mm; mrow[rr] = mc;
            inf[rr] = *((const i32x4*)(a.ws + WS_TOKINFO) + mc);
            load_row_bf(XB + (size_t)mc * D, lane, vv[rr]); }
#pragma unroll
        for (int rr = 0; rr < 2; ++rr) { const int e0 = inf[rr].x >> 20, p0 = inf[rr].x & 0xfffff, e1 = inf[rr].y >> 20, p1 = inf[rr].y & 0xfffff;
            const unsigned char* y0 = Y + (size_t)(TB[e0] * 256 + p0) * D; const unsigned char* y1 = Y + (size_t)(TB[e1] * 256 + p1) * D;
#pragma unroll
            for (int j = 0; j < 4; ++j) { ya[rr][j] = *((const unsigned*)y0 + lane + 64 * j); yb[rr][j] = *((const unsigned*)y1 + lane + 64 * j); } }
#pragma unroll
        for (int rr = 0; rr < 2; ++rr) {
            if (!has[rr]) continue;
            const int m = mrow[rr]; const int b = m < NLAT ? (m >> 13) : 4;
            const float w0s = __int_as_float(inf[rr].z) * (1.0f / 16.0f), w1s = __int_as_float(inf[rr].w) * (1.0f / 16.0f);
            if (b != cur_b) { const float* ga2 = MOD + (size_t)(l * 5 + b) * 6144 + 5 * 1024;
                if (l == 0) { const float* mod = MOD + (size_t)(5 + b) * 6144; load_mod_cached(a.in[I_G1] + 1024, mod + 1024, mod, ga2, lane, GS, SH, GA); }
                else {
#pragma unroll
                    for (int j = 0; j < 4; ++j) { GS[j] = *((const f32x4*)a.in[I_GFINAL] + lane + 64 * j); SH[j] = (f32x4){0.f, 0.f, 0.f, 0.f}; GA[j] = *((const f32x4*)ga2 + lane + 64 * j); } }
                cur_b = b; }
            f32x4 v[4];
#pragma unroll
            for (int j = 0; j < 4; ++j) { const int a0 = (int)ya[rr][j], a1 = (int)yb[rr][j];
                f32x4 y; y[0] = w0s * __builtin_amdgcn_cvt_f32_fp8(a0, 0) + w1s * __builtin_amdgcn_cvt_f32_fp8(a1, 0); y[1] = w0s * __builtin_amdgcn_cvt_f32_fp8(a0, 1) + w1s * __builtin_amdgcn_cvt_f32_fp8(a1, 1);
                y[2] = w0s * __builtin_amdgcn_cvt_f32_fp8(a0, 2) + w1s * __builtin_amdgcn_cvt_f32_fp8(a1, 2); y[3] = w0s * __builtin_amdgcn_cvt_f32_fp8(a0, 3) + w1s * __builtin_amdgcn_cvt_f32_fp8(a1, 3);
                v[j] = vv[rr][j] + GA[j] * y; }
            const float rstd = row_rstd(v);
            if (l == 0) {
                store_row_bf(XB + (size_t)m * D, lane, v);
                norm_store_cached(v, rstd, GS, SH, H + (size_t)m * D, lane);
            } else {
                float* xr = a.out + (size_t)m * D;
#pragma unroll
                for (int j = 0; j < 4; ++j) *((f32x4*)xr + lane + 64 * j) = (v[j] * rstd) * GS[j];
            }
        }
    }
}

#define XB_TMO      128
#define XB_XCNT(j)  (256  + 64 * (j))
#define XB_XSUB(j)  (1280 + 64 * (j))
#define XB_XGEN(j)  (2304 + 64 * (j))
#define XB_TOP      3328
#define XB_TOPGEN   3392
#define XCD_BAR_WORDS 3456
#define XB_SPIN_CAP (1u << 22)
__device__ __forceinline__ unsigned xb_ld(unsigned* p)              { return __hip_atomic_load(p, __ATOMIC_RELAXED, __HIP_MEMORY_SCOPE_AGENT); }
__device__ __forceinline__ unsigned xb_add(unsigned* p, unsigned v) { return __hip_atomic_fetch_add(p, v, __ATOMIC_RELAXED, __HIP_MEMORY_SCOPE_AGENT); }
__device__ __forceinline__ unsigned xb_xcc_id() { return (unsigned)__builtin_amdgcn_s_getreg((3 << 11) | 20) & 0xFu; }
#define XB_SPIN(cond, bar) do { unsigned _sp = 0; while (cond) { __builtin_amdgcn_s_sleep(1); \
    if ((++_sp & 255u) == 0u) { if (xb_ld(&(bar)[XB_TMO])) break; if (_sp > XB_SPIN_CAP) { atomicAdd(&(bar)[XB_TMO], 1u); break; } } } } while (0)
struct XcdBarrier { unsigned* bar; unsigned x; volatile LAS unsigned* st; };
__device__ __forceinline__ XcdBarrier xcd_barrier_post(unsigned* bar, volatile LAS unsigned* st) {
    XcdBarrier b; b.bar = bar; b.x = xb_xcc_id(); b.st = st;
    if (threadIdx.x == 0) (void)xb_add(&bar[XB_XCNT(b.x)], 1u);
    return b;
}
__device__ __forceinline__ void xcd_barrier_complete(unsigned* bar, unsigned x, unsigned& nloc, unsigned& nx) {
    const unsigned G = gridDim.x * gridDim.y * gridDim.z;
    unsigned sum, cnt, mine, sp = 0u;
    for (;;) {
        sum = 0u; cnt = 0u; mine = 0u;
#pragma unroll
        for (unsigned j = 0; j < 16; ++j) { const unsigned c = xb_ld(&bar[XB_XCNT(j)]); sum += c; cnt += (c > 0u) ? 1u : 0u; mine = (j == x) ? c : mine; }
        if (sum == G) break;
        __builtin_amdgcn_s_sleep(1);
        if ((++sp & 255u) == 0u) { if (xb_ld(&bar[XB_TMO])) break; if (sp > XB_SPIN_CAP) { atomicAdd(&bar[XB_TMO], 1u); break; } }
    }
    nloc = mine > 0u ? mine : 1u; nx = cnt > 0u ? cnt : 1u;
}
__device__ __forceinline__ void xcd_barrier(const XcdBarrier& b) {
    asm volatile("s_waitcnt vmcnt(0)" ::: "memory");
    __syncthreads();
    if (threadIdx.x == 0) {
        unsigned* bar = b.bar;
        __builtin_amdgcn_s_waitcnt(0);
        unsigned nloc = b.st[0], nx = b.st[1];
        if (nloc == 0u) { xcd_barrier_complete(bar, b.x, nloc, nx); b.st[0] = nloc; b.st[1] = nx; }
        const unsigned old = xb_add(&bar[XB_XSUB(b.x)], 1u);
        const unsigned gen = old / nloc;
        if (old + 1u == (gen + 1u) * nloc) {
            __builtin_amdgcn_fence(__ATOMIC_RELEASE, "agent");
            asm volatile("s_waitcnt vmcnt(0)" ::: "memory");
            const unsigned og = xb_add(&bar[XB_TOP], 1u);
            const unsigned tg = og / nx;
            if (og + 1u == (tg + 1u) * nx) xb_add(&bar[XB_TOPGEN], 1u);
            else XB_SPIN(xb_ld(&bar[XB_TOPGEN]) == tg, bar);
            __builtin_amdgcn_fence(__ATOMIC_ACQUIRE, "agent");
            xb_add(&bar[XB_XGEN(b.x)], 1u);
            asm volatile("s_waitcnt vmcnt(0)" ::: "memory");
        } else {
            XB_SPIN(xb_ld(&bar[XB_XGEN(b.x)]) == gen, bar);
            __builtin_amdgcn_fence(__ATOMIC_ACQUIRE, "agent");
            asm volatile("s_waitcnt vmcnt(0)" ::: "memory");
        }
    }
    __syncthreads();
}

constexpr int NPHASE = 20;
#ifndef DIAG_PH
#define DIAG_PH -1
#endif
#define PH_ON(x) (DIAG_PH < 0 || DIAG_PH == (x))
#ifndef REP_ID
#define REP_ID -1
#endif
__global__ void __launch_bounds__(512, 2) mega(Args a) {
    extern __shared__ __attribute__((aligned(16))) unsigned char lds_raw[];
    LAS unsigned char* lds = (LAS unsigned char*)lds_raw;
    unsigned char* ws = a.ws;
    volatile LAS unsigned* bst = (volatile LAS unsigned*)(lds + MISC_OFF);
    if (threadIdx.x < 2) bst[threadIdx.x] = 0u;
    __syncthreads();
    XcdBarrier xbar = xcd_barrier_post((unsigned*)(ws + WS_CTL) + CW_BAR, bst);
    unsigned long long tph_ = 0ull;
    for (int ph = a.ph_lo; ph < a.ph_hi; ++ph) {
      unsigned long long t0_ = 0ull; if (TIME_PH >= 0 && ph == TIME_PH) t0_ = __builtin_amdgcn_s_memrealtime();
      const int cls_ = ph < 2 ? ph : 2 + (ph - 2) % 9;
      const int nrep_ = (REP_ID >= 0 && cls_ == REP_ID) ? 2 : 1;
      for (int rep_ = 0; rep_ < nrep_; ++rep_) {
        if (rep_) xcd_barrier(xbar);
        if (PH_ON(0) && ph == 0) phase_p0(a, lds);
        else if (PH_ON(1) && ph == 1) phase_norm1_l0(a);
        else {
            const int l = (ph - 2) / 9, sp = (ph - 2) % 9;
            if (PH_ON(2) && sp == 0) {
                g8::DenseSched S; S.init(ws + WS_H, ws + WS_WIN + (size_t)l * NINP * 1024 * 2, MTOT, NINP, 1024, gridDim.x, blockIdx.x);
                g8::EpiBf16 E{(bf16_t*)(ws + WS_COLS), NINP};
                g8::gemm_phase<false>(lds, S, E);
                if (l == 0) convert_in_tail(a, lds, CV_E0 + CV_P0_E0 + CV_G, CV_A, S.nwg, S.G, S.c); else convert_in_tail(a, lds, CV_EI1 + CV_P0_EI1 + CV_C + CV_D, CV_E, S.nwg, S.G, S.c);
            } else if (PH_ON(3) && sp == 1) phase_chunk(a, l, lds);
            else if (PH_ON(4) && sp == 2) phase_scan(a, l, lds);
            else if (PH_ON(5) && sp == 3) phase_mixer(a, l, lds);
            else if (PH_ON(6) && sp == 4) {
                g8::DenseSched S; S.init(ws + WS_MIX, ws + WS_WOUT + (size_t)l * 1024 * 1024 * 2, l == 1 ? NLAT : MTOT, 1024, 1024, gridDim.x, blockIdx.x);
                g8::EpiBf16 E{(bf16_t*)(ws + WS_Y), 1024};
                g8::gemm_phase<false>(lds, S, E);
                if (l == 0) convert_in_tail(a, lds, CV_E0 + CV_P0_E0 + CV_G + CV_A, CV_B, S.nwg, S.G, S.c);
            } else if (PH_ON(7) && sp == 5) phase_router(a, l, lds);
            else if ((PH_ON(8) || PH_ON(9)) && (sp == 6 || sp == 7)) {
                const int T = moe_tables(a, l, lds);
                const int G = gridDim.x, bx = blockIdx.x, vcu = (G % 8 == 0) ? (bx % 8) * (G / 8) + bx / 8 : bx;
                const LAS int* TBp = (const LAS int*)(lds + MISC_OFF + 256);
                if (PH_ON(8) && sp == 6) {
                    g8::MoeSched<true> S; S.A = (const char*)(ws + WS_H); S.Bw = (const char*)(ws + WS_WEIN) + (size_t)l * 32 * 1024 * 1024; S.wstride = (size_t)1024 * 1024; S.K = 512;     S.T = T; S.G = G; S.c = vcu;
                    S.tile_e = (const LAS int*)(lds + MISC_OFF + 1024); S.tile_mt = S.tile_e + 320; S.cnt = TBp + 64; S.toklist = (const int*)(ws + WS_TOKLIST);
                    g8::EpiSwiGLU E{ws + WS_ACT, 1.0f / (F8_WSC * F8_HSC), F8_ASC / (F8_WSC * F8_HSC)};
                    g8::gemm_phase<true>(lds, S, E);
                    if (l == 0) convert_in_tail(a, lds, CV_EI1 + CV_P0_EI1, CV_C, 4 * T, G, vcu); else convert_in_tail(a, lds, CV_EO1 + CV_P0_EO1, CV_F, 4 * T, G, vcu);
                } else if (PH_ON(9) && sp == 7) {
                    g8::MoeSched<false> S; S.A = (const char*)(ws + WS_ACT); S.Bw = (const char*)(ws + WS_WEOUT) + (size_t)l * 32 * 1024 * 512; S.wstride = (size_t)1024 * 512; S.K = 256; S.T = T; S.G = G; S.c = vcu;
                    S.tile_e = (const LAS int*)(lds + MISC_OFF + 1024); S.tile_mt = S.tile_e + 320; S.cnt = TBp + 64; S.toklist = (const int*)(ws + WS_TOKLIST);
                    g8::EpiFp8 E{(unsigned char*)(ws + WS_Y), 16.0f / (F8_WSC * F8_ASC)};
                    g8::gemm_phase<true>(lds, S, E);
                    if (l == 0) convert_in_tail(a, lds, CV_EI1 + CV_P0_EI1 + CV_C, CV_D, 4 * T, G, vcu);
                }
            } else if (PH_ON(10) && sp == 8) phase_combine(a, l, lds);
        }
      }
        if (ph + 1 < a.ph_hi) { if (a.ph_lo < 0) cg::this_grid().sync(); else xcd_barrier(xbar); }
        if (TIME_PH >= 0 && ph == TIME_PH) tph_ = __builtin_amdgcn_s_memrealtime() - t0_;
    }
    if (TIME_PH >= 0 && blockIdx.x == 0 && threadIdx.x == 0) { const unsigned long long te_ = __builtin_amdgcn_s_memrealtime(); while (__builtin_amdgcn_s_memrealtime() - te_ < 4ull * tph_) __builtin_amdgcn_s_sleep(8); }
}

extern "C" void kernel_launch(void* const* d_in, const int* in_sizes, int n_in, void* d_out, int out_size, void* d_ws, size_t ws_size, hipStream_t stream) {
    static int grid = 0;
    if (grid == 0) {
        if (n_in != 29 || out_size != NLAT * D || ws_size < WS_END) { fprintf(stderr, "kernel_launch: unexpected shapes (n_in %d out %d ws %zu)\n", n_in, out_size, ws_size); grid = -1; return; }
        int dev = 0, cus = 0, per_cu = 0;
        hipGetDevice(&dev); hipDeviceGetAttribute(&cus, hipDeviceAttributeMultiprocessorCount, dev);
        if (hipFuncSetAttribute((const void*)mega, hipFuncAttributeMaxDynamicSharedMemorySize, LDS_BYTES) != hipSuccess) { fprintf(stderr, "kernel_launch: hipFuncSetAttribute failed\n"); grid = -1; return; }
        if (hipOccupancyMaxActiveBlocksPerMultiprocessor(&per_cu, (const void*)mega, 512, LDS_BYTES) != hipSuccess || per_cu < 1) { fprintf(stderr, "kernel_launch: occupancy query says %d\n", per_cu); per_cu = 1; }
        (void)hipGetLastError();
        grid = cus;
    }
    if (grid < 0) return;
    hipMemsetAsync((char*)d_ws + WS_CTL, 0, CTL_BYTES, stream);
    Args a{};
    for (int i = 0; i < 29; ++i) a.in[i] = (const float*)d_in[i];
    a.out = (float*)d_out; a.ws = (unsigned char*)d_ws;
#if MK_MULTI
    for (int ph = 0; ph < NPHASE; ++ph) { a.ph_lo = ph; a.ph_hi = ph + 1; hipLaunchKernelGGL(mega, dim3(grid), dim3(512), LDS_BYTES, stream, a); }
#else
    a.ph_lo = 0; a.ph_hi = NPHASE;
    void* args[] = {&a};
    hipError_t e = hipLaunchCooperativeKernel((const void*)mega, dim3(grid), dim3(512), args, LDS_BYTES, stream);
    if (e != hipSuccess) fprintf(stderr, "cooperative launch failed: %s (grid %d)\n", hipGetErrorString(e), grid);
#endif
}
```

```cpp
#include <hip/hip_runtime.h>
#include <hip/hip_cooperative_groups.h>
#include <cstdio>
namespace cg = cooperative_groups;

#ifndef MK_MULTI
#define MK_MULTI 0
#endif

#ifndef TIME_PH
#define TIME_PH -1
#endif
#ifndef REP_SUB
#define REP_SUB 0
#endif

#define LAS __attribute__((address_space(3)))
typedef unsigned short bf16_t;
typedef short bf16x8 __attribute__((ext_vector_type(8)));
typedef float f32x4 __attribute__((ext_vector_type(4)));
typedef float f32x2 __attribute__((ext_vector_type(2)));
typedef unsigned u32x4 __attribute__((ext_vector_type(4)));
typedef unsigned u32x2 __attribute__((ext_vector_type(2)));
typedef int i32x4 __attribute__((ext_vector_type(4)));
typedef int i32x8 __attribute__((ext_vector_type(8)));

constexpr int D = 1024, NLAT = 32768, SEQ = 8192, NCTXT = 1024, CTXL = 256, MTOT = NLAT + NCTXT;
constexpr int NIN = 2336, NINP = 2560;
constexpr int NCHUNK = MTOT / 64, NSEQ = 132;
constexpr int NEXP = 32, DEXP = 512, SLOTS = 75776;
constexpr float EPS = 1e-6f;
constexpr float F8_WSC = 256.0f, F8_HSC = 16.0f, F8_ASC = 8.0f;
constexpr int C_Q = 0, C_K = 128, C_V = 256, C_G = 512, C_ZF = 768, C_ZB = 784, C_CA = 800, C_CG = 1056, C_SB = 1312, C_SC = 1568, C_SX = 1824, C_PL = 2080;

constexpr size_t MiB = 1u << 20;
constexpr size_t WS_CTL = 0, CTL_BYTES = 1 * MiB;
constexpr size_t WS_MOD = 1 * MiB;
constexpr size_t WS_TAB = 1 * MiB + 512 * 1024;
constexpr size_t WS_PWT = WS_TAB + 64 * 1024;
constexpr size_t WS_BAND = WS_TAB + 192 * 1024;
constexpr size_t WS_WIN = 2 * MiB;
constexpr size_t WS_WOUT = 12 * MiB;
constexpr size_t WS_WEIN = 16 * MiB;
constexpr size_t WS_WEOUT = 144 * MiB;
constexpr size_t WS_XCTX = 208 * MiB;
constexpr size_t WS_H = 212 * MiB;
constexpr size_t WS_COLS = 278 * MiB;
constexpr size_t WS_MIX = 443 * MiB;
constexpr size_t WS_KV = 509 * MiB;
constexpr size_t WS_DEC = 542 * MiB;
constexpr size_t WS_AGV = 543 * MiB;
constexpr size_t WS_CXV = 559 * MiB;
constexpr size_t WS_UV = 575 * MiB;
constexpr size_t WS_SCV = 591 * MiB;
constexpr size_t WS_TOKINFO = 607 * MiB;
constexpr size_t WS_TOKLIST = 608 * MiB;
constexpr size_t WS_ACT = 613 * MiB;
constexpr size_t WS_Y = 687 * MiB;
constexpr size_t WS_SIN = 835 * MiB;
constexpr size_t WS_XB = 852 * MiB;
constexpr size_t WS_END = 918 * MiB;
constexpr int CW_CNT = 1024;
constexpr int CW_BAR = 8192;

constexpr int LDS_BYTES = 147456;
constexpr int MISC_OFF = 131072;

__device__ __forceinline__ unsigned pk2(float lo, float hi) { unsigned r; asm("v_cvt_pk_bf16_f32 %0, %1, %2" : "=v"(r) : "v"(lo), "v"(hi)); return r; }
__device__ __forceinline__ float bflo(unsigned w) { return __uint_as_float(w << 16); }
__device__ __forceinline__ float bfhi(unsigned w) { return __uint_as_float(w & 0xffff0000u); }
__device__ __forceinline__ void unpack8(const u32x4 w, float (&f)[8]) { f[0] = bflo(w.x); f[1] = bfhi(w.x); f[2] = bflo(w.y); f[3] = bfhi(w.y); f[4] = bflo(w.z); f[5] = bfhi(w.z); f[6] = bflo(w.w); f[7] = bfhi(w.w); }
__device__ __forceinline__ float sigmoidf_(float x) { return __builtin_amdgcn_rcpf(1.0f + __expf(-x)); }
__device__ __forceinline__ float siluf_(float x) { return x * __builtin_amdgcn_rcpf(1.0f + __expf(-x)); }
__device__ __forceinline__ float logsigf_(float x) { return fminf(x, 0.0f) - log1pf(__expf(-fabsf(x))); }
__device__ __forceinline__ float wave_sum(float v) {
#pragma unroll
    for (int o = 1; o < 64; o <<= 1) v += __shfl_xor(v, o);
    return v;
}

typedef float f32x16 __attribute__((ext_vector_type(16)));
typedef __bf16 bf16x2_t __attribute__((ext_vector_type(2)));
#define MFMA32(a, b, c) __builtin_amdgcn_mfma_f32_32x32x16_bf16((a), (b), (c), 0, 0, 0)
__device__ __forceinline__ unsigned pk2c(float lo, float hi) { const f32x2 v = {lo, hi}; return __builtin_bit_cast(unsigned, __builtin_convertvector(v, bf16x2_t)); }
__device__ __forceinline__ bf16x8 pack8f(float x0, float x1, float x2, float x3, float x4, float x5, float x6, float x7) {
    u32x4 p; p.x = pk2c(x0, x1); p.y = pk2c(x2, x3); p.z = pk2c(x4, x5); p.w = pk2c(x6, x7); return __builtin_bit_cast(bf16x8, p); }
__device__ __forceinline__ bf16x8 pack_step(const f32x16& x, int s) { return s == 0 ? pack8f(x[0], x[1], x[2], x[3], x[4], x[5], x[6], x[7]) : pack8f(x[8], x[9], x[10], x[11], x[12], x[13], x[14], x[15]); }
__device__ __forceinline__ void split8(const float (&x)[8], bf16x8& hi, bf16x8& lo) {
    u32x4 p; p.x = pk2c(x[0], x[1]); p.y = pk2c(x[2], x[3]); p.z = pk2c(x[4], x[5]); p.w = pk2c(x[6], x[7]);
    hi = __builtin_bit_cast(bf16x8, p);
    lo = pack8f(x[0] - bflo(p.x), x[1] - bfhi(p.x), x[2] - bflo(p.y), x[3] - bfhi(p.y), x[4] - bflo(p.z), x[5] - bfhi(p.z), x[6] - bflo(p.w), x[7] - bfhi(p.w)); }
__device__ __forceinline__ bf16x8 cat44(u32x2 a, u32x2 b) { u32x4 p; p.x = a.x; p.y = a.y; p.z = b.x; p.w = b.y; return __builtin_bit_cast(bf16x8, p); }
#define LDS_WAIT() asm volatile("s_waitcnt lgkmcnt(0)" ::: "memory")
#define PIN(x) asm volatile("" : "+v"(x) :: "memory")
__device__ __forceinline__ int tid_now() { int t = threadIdx.x; asm volatile("" : "+v"(t)); return t; }

namespace g8 {
constexpr int BM = 256, BK = 64, HALF = 128, HTB = HALF * BK * 2, NXCD = 8, WGM = 8;
__device__ __forceinline__ int lds_byte(int r, int c) { const int st = (r >> 4) * 2 + (c >> 5), rr = r & 15, cc = c & 31, ob = rr * 64 + cc * 2; return st * 1024 + (ob ^ (((ob >> 9) & 1) << 5)); }
__device__ __forceinline__ void stage_rc(int b, int& R, int& C) { const int st = b / 1024, sb = b % 1024, swz = sb ^ (((sb >> 9) & 1) << 5); R = (st >> 1) * 16 + swz / 64; C = (st & 1) * 32 + (swz % 64) / 2; }
__device__ __forceinline__ int perm32(int rho) { const int n = rho >> 4, i = rho & 15; return 8 * (i >> 2) + 4 * n + (i & 3); }

__device__ __forceinline__ i32x8 cat8(bf16x8 lo, bf16x8 hi) { const i32x4 a = __builtin_bit_cast(i32x4, lo), b = __builtin_bit_cast(i32x4, hi); return __builtin_shufflevector(a, b, 0, 1, 2, 3, 4, 5, 6, 7); }
struct Unit { int pm, pn, e, mt; };

struct DenseSched {
    const char* A; const char* Bt; int K, nM, nN, nwg, G, c;
    __device__ __forceinline__ void init(const void* A_, const void* Bt_, int M, int N, int K_, int G_, int c_) { A = (const char*)A_; Bt = (const char*)Bt_; K = K_; nM = M / BM; nN = N / BM; nwg = nM * nN; G = G_; c = c_; }
    __device__ __forceinline__ bool next(int i, Unit& u) const {
        const long L = (long)i * G + c; if (L >= nwg) return false;
        int wgid = (int)L; { const int q = nwg / NXCD, r = nwg % NXCD, xcd = wgid % NXCD, off = wgid / NXCD; wgid = (xcd < r ? xcd * (q + 1) : r * (q + 1) + (xcd - r) * q) + off; }
        const int nig = WGM * nN, gid = wgid / nig, fm = gid * WGM, gsz = (nM - fm) < WGM ? (nM - fm) : WGM;
        u.pm = fm + ((wgid % nig) % gsz); u.pn = (wgid % nig) / gsz; u.e = 0; u.mt = 0; return true;
    }
    __device__ __forceinline__ unsigned a_off(const Unit& u, int h, int R, int C) const { return (unsigned)(((u.pm * BM + h * HALF + R) * K + C) * 2); }
    __device__ __forceinline__ const char* b_ptr(const Unit& u) const { return Bt + (size_t)u.pn * BM * K * 2; }
};
template <bool GATHER> struct MoeSched {
    const char* A; const char* Bw; size_t wstride; int K, T, G, c; const LAS int* tile_e; const LAS int* tile_mt; const LAS int* cnt; const int* toklist;
    __device__ __forceinline__ bool next(int i, Unit& u) const {
        const int L = i * G + c; if (L >= 4 * T) return false;
        u.pm = L >> 2; u.pn = L & 3; u.e = __builtin_amdgcn_readfirstlane(tile_e[u.pm]); u.mt = __builtin_amdgcn_readfirstlane(tile_mt[u.pm]); return true;
    }
    __device__ __forceinline__ unsigned a_off(const Unit& u, int h, int R, int C) const {
        if (GATHER) { const int pos = u.mt * BM + h * HALF + R; int tok = 0; if (pos < cnt[u.e]) tok = toklist[u.e * MTOT + pos]; return (unsigned)((tok * K + C) * 2); }
        return (unsigned)(((u.pm * BM + h * HALF + R) * K + C) * 2);
    }
    __device__ __forceinline__ const char* b_ptr(const Unit& u) const { return Bw + (size_t)u.e * wstride + (size_t)u.pn * BM * K * 2; }
};

struct EpiBf16 {
    static constexpr int PERM = 1; static constexpr int SC0 = 0x7F, SC1 = 0x7F;
    bf16_t* O; int ldc;
    __device__ __forceinline__ void operator()(const f32x4 (&acc)[2][2][4][2], const Unit& u, int wr, int wc, int fr, int fq) const {
        const int row0 = u.pm * BM + wr * 64 + fr, col0 = u.pn * BM + wc * 32 + 8 * fq;
#pragma unroll
        for (int ai = 0; ai < 2; ++ai)
#pragma unroll
            for (int m = 0; m < 4; ++m) { bf16_t* rowp = O + (size_t)(row0 + ai * HALF + m * 16) * ldc + col0;
#pragma unroll
                for (int bj = 0; bj < 2; ++bj) { const f32x4 v0 = acc[ai][bj][m][0], v1 = acc[ai][bj][m][1];
                    u32x4 w; w.x = pk2(v0[0], v0[1]); w.y = pk2(v0[2], v0[3]); w.z = pk2(v1[0], v1[1]); w.w = pk2(v1[2], v1[3]);
                    *(u32x4*)(rowp + bj * HALF) = w; } }
    }
};
struct EpiFp8 {
    static constexpr int PERM = 2;
    static constexpr int SC0 = 0x78, SC1 = 0x78;
    unsigned char* O;
    __device__ __forceinline__ void operator()(const f32x4 (&acc)[2][2][4][2], const Unit& u, int wr, int wc, int fr, int fq) const {
        const int row0 = u.pm * BM + wr * 64 + fr, col0 = u.pn * BM + wc * 64 + 16 * fq;
        int W[4] = {0, 0, 0, 0};
#pragma unroll
        for (int ai = 0; ai < 2; ++ai)
#pragma unroll
            for (int m = 0; m < 4; ++m) { unsigned char* rowp = O + (size_t)(row0 + ai * HALF + m * 16) * 1024 + col0;
#pragma unroll
                for (int bj = 0; bj < 2; ++bj)
#pragma unroll
                    for (int n = 0; n < 2; ++n) { const f32x4 x = acc[ai][bj][m][n]; int w = W[bj * 2 + n];
                        w = __builtin_amdgcn_cvt_pk_fp8_f32(__builtin_amdgcn_fmed3f(x[0], -440.0f, 440.0f), __builtin_amdgcn_fmed3f(x[1], -440.0f, 440.0f), w, false);
                        w = __builtin_amdgcn_cvt_pk_fp8_f32(__builtin_amdgcn_fmed3f(x[2], -440.0f, 440.0f), __builtin_amdgcn_fmed3f(x[3], -440.0f, 440.0f), w, true); W[bj * 2 + n] = w; }
                *(u32x4*)rowp = (u32x4){(unsigned)W[0], (unsigned)W[1], (unsigned)W[2], (unsigned)W[3]}; }
    }
};
struct EpiSwiGLU {
    static constexpr int PERM = 1;
    static constexpr int SC0 = 0x73, SC1 = 0x76;
    unsigned char* O;
    __device__ __forceinline__ void operator()(const f32x4 (&acc)[2][2][4][2], const Unit& u, int wr, int wc, int fr, int fq) const {
        const int row0 = u.pm * BM + wr * 64 + fr, col0 = u.pn * HALF + wc * 32 + 8 * fq;
        int W[2] = {0, 0};
#pragma unroll
        for (int ai = 0; ai < 2; ++ai)
#pragma unroll
            for (int m = 0; m < 4; ++m) { unsigned char* rowp = O + (size_t)(row0 + ai * HALF + m * 16) * DEXP + col0;
#pragma unroll
                for (int n = 0; n < 2; ++n) { const f32x4 g = acc[ai][0][m][n], up = acc[ai][1][m][n]; float v[4];
#pragma unroll
                    for (int i = 0; i < 4; ++i) v[i] = __builtin_amdgcn_fmed3f(siluf_(g[i]) * up[i], -440.0f, 440.0f);
                    int w = W[n]; w = __builtin_amdgcn_cvt_pk_fp8_f32(v[0], v[1], w, false); w = __builtin_amdgcn_cvt_pk_fp8_f32(v[2], v[3], w, true); W[n] = w; }
                *(u32x2*)rowp = (u32x2){(unsigned)W[0], (unsigned)W[1]}; }
    }
};
template <bool F8, class Epi, class Sched>
__device__ __forceinline__ void gemm_phase(LAS unsigned char* lds, const Sched& S, const Epi& E) {
    const int tid = tid_now(), wid = __builtin_amdgcn_readfirstlane(tid >> 6), lane = tid & 63, wr = wid >> 2, wc = wid & 3, fr = lane & 15, fq = lane >> 4;
    const int K = S.K, nt = K / BK;
    int mxsc = 0x7F7F7F7F, mxs0 = Epi::SC0 * 0x01010101, mxs1 = Epi::SC1 * 0x01010101; asm volatile("" : "+v"(mxsc)); asm volatile("" : "+v"(mxs0)); if (Epi::SC0 != Epi::SC1) asm volatile("" : "+v"(mxs1)); else mxs1 = mxs0;
    unsigned voffB[2];
#pragma unroll
    for (int i = 0; i < 2; ++i) { int R, C; stage_rc(tid * 16 + i * 8192, R, C); const int Rb = Epi::PERM == 2 ? (((R >> 5) & 3) * 64 + 16 * ((R & 15) >> 2) + 4 * ((R >> 4) & 1) + (R & 3)) : (Epi::PERM == 1 ? ((R & ~31) + perm32(R & 31)) : R); voffB[i] = (unsigned)(Rb * K + C) * 2u; }
    const size_t kstep = (size_t)(BK * 2);
    const size_t hstep = (size_t)(Epi::PERM == 2 ? 8 : HALF) * K * 2;
    const unsigned ldsw = (unsigned)wid * 1024u;
    const int aoff = lds_byte(wr * 64 + fr, fq * 8), boff = lds_byte(wc * 32 + fr, fq * 8);
#define G8_SA(b, h) (((b) * 2 + (h)) * HTB)
#define G8_SB(b, h) ((4 + (b) * 2 + (h)) * HTB)
#define G8_STAGE(bufoff, gbase, voff) do { const unsigned long long _g = (unsigned long long)(gbase); \
        const char* _gb = (const char*)(((unsigned long long)(unsigned)__builtin_amdgcn_readfirstlane((int)(unsigned)(_g >> 32)) << 32) | (unsigned long long)(unsigned)__builtin_amdgcn_readfirstlane((int)(unsigned)_g)); \
        _Pragma("unroll") for (int _i = 0; _i < 2; ++_i) \
        __builtin_amdgcn_global_load_lds((const unsigned*)(_gb + (voff)[_i]), (LAS unsigned*)(lds + (bufoff) + ldsw + _i * 8192), 16, 0, 0); } while (0)
#define G8_LDA(dst, b, h) do { _Pragma("unroll") for (int m = 0; m < 4; ++m) _Pragma("unroll") for (int k = 0; k < 2; ++k) dst[m][k] = *(const LAS bf16x8*)(lds + G8_SA(b, h) + aoff + m * 2048 + k * 1024); } while (0)
#define G8_LDB(dst, b, h) do { _Pragma("unroll") for (int n = 0; n < 2; ++n) _Pragma("unroll") for (int k = 0; k < 2; ++k) dst[n][k] = *(const LAS bf16x8*)(lds + G8_SB(b, h) + boff + n * 2048 + k * 1024); } while (0)
#define G8_MMA(ai, bj, At, Bt) do { __builtin_amdgcn_s_setprio(1); _Pragma("unroll") for (int m = 0; m < 4; ++m) _Pragma("unroll") for (int n = 0; n < 2; ++n) _Pragma("unroll") for (int k = 0; k < 2; ++k) \
        acc[ai][bj][m][n] = __builtin_amdgcn_mfma_f32_16x16x32_bf16(Bt[n][k], At[m][k], acc[ai][bj][m][n], 0, 0, 0); __builtin_amdgcn_s_setprio(0); } while (0)
#define G8_MMA8(ai, bj, At, Bt) do { __builtin_amdgcn_s_setprio(1); _Pragma("unroll") for (int m = 0; m < 4; ++m) _Pragma("unroll") for (int n = 0; n < 2; ++n) \
        acc[ai][bj][m][n] = __builtin_amdgcn_mfma_scale_f32_16x16x128_f8f6f4(cat8(Bt[n][0], Bt[n][1]), cat8(At[m][0], At[m][1]), acc[ai][bj][m][n], 0, 0, 0, (bj) ? mxs1 : mxs0, 0, mxsc); __builtin_amdgcn_s_setprio(0); } while (0)
#define G8_MM(ai, bj, At, Bt) do { if (F8) G8_MMA8(ai, bj, At, Bt); else G8_MMA(ai, bj, At, Bt); } while (0)
#define G8_WAIT_V(n) asm volatile("s_waitcnt vmcnt(" #n ")" ::: "memory")
#define G8_WAIT_L(n) asm volatile("s_waitcnt lgkmcnt(" #n ")" ::: "memory")
#define G8_BAR __builtin_amdgcn_s_barrier()
#define G8_SCHED __builtin_amdgcn_sched_barrier(0)
    Unit cur, nxt; int ui = 0;
    if (!S.next(0, cur)) return;
    f32x4 acc[2][2][4][2];
#pragma unroll
    for (int a = 0; a < 2; ++a)
#pragma unroll
        for (int b = 0; b < 2; ++b)
#pragma unroll
            for (int m = 0; m < 4; ++m)
#pragma unroll
                for (int n = 0; n < 2; ++n) acc[a][b][m][n] = (f32x4){0.f, 0.f, 0.f, 0.f};
    bf16x8 At[4][2], B0[2][2], B1[2][2];
    unsigned vA0[2], vA1[2];
#pragma unroll
    for (int i = 0; i < 2; ++i) { int R, C; stage_rc(tid * 16 + i * 8192, R, C); vA0[i] = S.a_off(cur, 0, R, C); vA1[i] = S.a_off(cur, 1, R, C); }
    const char* const Ab = S.A;
    const char* cB = S.b_ptr(cur);
    G8_STAGE(G8_SB(0, 0), cB, voffB); G8_STAGE(G8_SA(0, 0), Ab, vA0); G8_STAGE(G8_SB(0, 1), cB + hstep, voffB); G8_STAGE(G8_SA(0, 1), Ab, vA1);
    if (wr == 1) G8_BAR;
    G8_WAIT_V(4); G8_BAR;
    G8_STAGE(G8_SB(1, 0), cB + kstep, voffB); G8_STAGE(G8_SA(1, 0), Ab + kstep, vA0); G8_STAGE(G8_SB(1, 1), cB + hstep + kstep, voffB);
    G8_WAIT_V(6); G8_BAR;
    for (;;) {
        const bool has_next = S.next(ui + 1, nxt);
        const char* nB = has_next ? S.b_ptr(nxt) : cB;
        unsigned nA0[2] = {vA0[0], vA0[1]}, nA1[2] = {vA1[0], vA1[1]};
        if (has_next) {
#pragma unroll
            for (int i = 0; i < 2; ++i) { int R, C; stage_rc(tid * 16 + i * 8192, R, C); nA0[i] = S.a_off(nxt, 0, R, C); nA1[i] = S.a_off(nxt, 1, R, C); }
        }
#pragma unroll 1
        for (int t = 0; t < nt; t += 2) {
            const bool last = (t == nt - 2);
            const char* a1 = Ab + (size_t)(t + 1) * kstep;
            const char* a2 = last ? Ab : Ab + (size_t)(t + 2) * kstep; const char* b2 = last ? nB : cB + (size_t)(t + 2) * kstep;
            const char* a3 = a2 + kstep; const char* b3 = b2 + kstep;
            G8_LDB(B0, 0, 0); G8_SCHED; G8_LDA(At, 0, 0); G8_STAGE(G8_SA(1, 1), a1, vA1);
            G8_WAIT_L(8); G8_BAR; G8_WAIT_L(0); G8_MM(0, 0, At, B0); G8_BAR; G8_SCHED;
            if (last) {
#pragma unroll
                for (int i = 0; i < 2; ++i) { vA0[i] = nA0[i]; vA1[i] = nA1[i]; }
            }
            G8_LDB(B1, 0, 1); G8_STAGE(G8_SB(0, 0), b2, voffB);
            G8_BAR; G8_WAIT_L(0); G8_MM(0, 1, At, B1); G8_BAR;
            G8_LDA(At, 0, 1); G8_STAGE(G8_SA(0, 0), a2, vA0);
            G8_BAR; G8_WAIT_L(0); G8_MM(1, 0, At, B0); G8_BAR; G8_SCHED;
            G8_STAGE(G8_SB(0, 1), b2 + hstep, voffB);
            G8_WAIT_V(6); G8_BAR; G8_MM(1, 1, At, B1); G8_BAR;
            G8_LDB(B0, 1, 0); G8_SCHED; G8_LDA(At, 1, 0); G8_STAGE(G8_SA(0, 1), a2, vA1);
            G8_WAIT_L(8); G8_BAR; G8_WAIT_L(0); G8_MM(0, 0, At, B0); G8_BAR; G8_SCHED;
            G8_LDB(B1, 1, 1); G8_STAGE(G8_SB(1, 0), b3, voffB);
            G8_BAR; G8_WAIT_L(0); G8_MM(0, 1, At, B1); G8_BAR;
            G8_LDA(At, 1, 1); G8_STAGE(G8_SA(1, 0), a3, vA0);
            G8_BAR; G8_WAIT_L(0); G8_MM(1, 0, At, B0); G8_BAR; G8_SCHED;
            G8_STAGE(G8_SB(1, 1), b3 + hstep, voffB);
            G8_WAIT_V(6); G8_BAR; G8_MM(1, 1, At, B1); G8_BAR;
        }
        E(acc, cur, wr, wc, fr, fq);
        if (!has_next) break;
#pragma unroll
        for (int a = 0; a < 2; ++a)
#pragma unroll
            for (int b = 0; b < 2; ++b)
#pragma unroll
                for (int m = 0; m < 4; ++m)
#pragma unroll
                    for (int n = 0; n < 2; ++n) acc[a][b][m][n] = (f32x4){0.f, 0.f, 0.f, 0.f};
        cur = nxt; cB = nB; ++ui;
    }
    G8_WAIT_V(0);
    if (wr == 0) G8_BAR;
    G8_BAR;
#undef G8_SA
#undef G8_SB
#undef G8_STAGE
#undef G8_LDA
#undef G8_LDB
#undef G8_MMA
#undef G8_MMA8
#undef G8_MM
#undef G8_WAIT_V
#undef G8_WAIT_L
#undef G8_BAR
#undef G8_SCHED
}
}

struct Args { const float* in[29]; float* out; unsigned char* ws; int ph_lo, ph_hi; };
enum { I_X = 0, I_C, I_CTX, I_CCTX, I_WMOD, I_BMOD, I_G1, I_G2, I_WIN, I_GWF, I_GBF, I_GWB, I_GBB, I_GOUT, I_CONFW, I_CONFB, I_CONFG, I_CONFBETA, I_SCW, I_POOLW, I_POOLS, I_WOUT, I_RWG, I_RBG, I_RWE, I_RBE, I_EIN, I_EOUT, I_GFINAL };

__device__ __forceinline__ void transpose_item(const float* W, int K, int N, bf16_t* WT, int kb, int n0, int dst_row0, LAS float* scr, int lane) {
    const int k0 = 64 * kb;
    float wv[32];
#pragma unroll
    for (int i = 0; i < 32; ++i) { const int kk = 2 * i + (lane >> 5); wv[i] = W[(size_t)(k0 + kk) * N + n0 + (lane & 31)]; }
#pragma unroll
    for (int i = 0; i < 32; ++i) PIN(wv[i]);
#pragma unroll
    for (int i = 0; i < 32; ++i) { const int kk = 2 * i + (lane >> 5); scr[kk * 33 + (lane & 31)] = wv[i]; }
    LDS_WAIT(); asm volatile("" ::: "memory");
    const int c = lane & 7;
#pragma unroll
    for (int j = 0; j < 4; ++j) { const int n = (lane >> 3) + 8 * j; const LAS float* s = scr + (8 * c) * 33 + n;
        u32x4 o; o.x = pk2(s[0 * 33], s[1 * 33]); o.y = pk2(s[2 * 33], s[3 * 33]); o.z = pk2(s[4 * 33], s[5 * 33]); o.w = pk2(s[6 * 33], s[7 * 33]);
        *(u32x4*)(WT + (size_t)(dst_row0 + n) * K + k0 + 8 * c) = o; }
    LDS_WAIT(); asm volatile("" ::: "memory");
}

__device__ __forceinline__ void transpose_item8(const float* W, int K, int N, unsigned char* WT, int kb, int n0, int dst_row0, LAS float* scr, int lane) {
    const int k0 = 64 * kb;
    float wv[32];
#pragma unroll
    for (int i = 0; i < 32; ++i) { const int kk = 2 * i + (lane >> 5); wv[i] = W[(size_t)(k0 + kk) * N + n0 + (lane & 31)]; }
#pragma unroll
    for (int i = 0; i < 32; ++i) PIN(wv[i]);
#pragma unroll
    for (int i = 0; i < 32; ++i) { const int kk = 2 * i + (lane >> 5); scr[kk * 33 + (lane & 31)] = wv[i]; }
    LDS_WAIT(); asm volatile("" ::: "memory");
    const int c = lane & 7;
#pragma unroll
    for (int j = 0; j < 4; ++j) { const int n = (lane >> 3) + 8 * j; const LAS float* s = scr + (8 * c) * 33 + n;
        float v[8];
#pragma unroll
        for (int i = 0; i < 8; ++i) v[i] = fminf(fmaxf(s[i * 33] * F8_WSC, -440.0f), 440.0f);
        int w0 = 0, w1 = 0;
        w0 = __builtin_amdgcn_cvt_pk_fp8_f32(v[0], v[1], w0, false); w0 = __builtin_amdgcn_cvt_pk_fp8_f32(v[2], v[3], w0, true);
        w1 = __builtin_amdgcn_cvt_pk_fp8_f32(v[4], v[5], w1, false); w1 = __builtin_amdgcn_cvt_pk_fp8_f32(v[6], v[7], w1, true);
        *(u32x2*)(WT + (size_t)(dst_row0 + n) * K + k0 + 8 * c) = (u32x2){(unsigned)w0, (unsigned)w1}; }
    LDS_WAIT(); asm volatile("" ::: "memory");
}

constexpr int CV_SMALL = 3360, CV_E0 = 3360, CV_EI1 = 27936, CV_EO1 = 44320, CV_END = 52512;
constexpr int CV_G = 4480;
constexpr int CV_A = 5184, CV_B = 5760;
constexpr int CV_C = 4096, CV_D = 2048, CV_E = 5184;
constexpr int CV_F = 4096;
constexpr int CV_P0_E0 = (CV_EI1 - CV_E0) - CV_G - CV_A - CV_B, CV_P0_EI1 = (CV_EO1 - CV_EI1) - CV_C - CV_D - CV_E, CV_P0_EO1 = (CV_END - CV_EO1) - CV_F;
__device__ __forceinline__ void convert_item(const Args& a, int idx, LAS float* scr, int lane) {
    unsigned char* ws = a.ws;
    if (idx < CV_SMALL) { const int l = idx / 1680; int r = idx % 1680;
        if (r < 1168) { const int kb = r / 73, nb = r % 73; transpose_item(a.in[I_WIN] + (size_t)l * 1024 * NIN, 1024, NIN, (bf16_t*)(ws + WS_WIN) + (size_t)l * NINP * 1024, kb, nb * 32, nb * 32, scr, lane); }
        else { r -= 1168; const int kb = r / 32, nb = r % 32; transpose_item(a.in[I_WOUT] + (size_t)l * 1024 * 1024, 1024, 1024, (bf16_t*)(ws + WS_WOUT) + (size_t)l * 1024 * 1024, kb, nb * 32, nb * 32, scr, lane); }
        return; }
    int l, r; bool is_in;
    if (idx < CV_EI1) { l = 0; r = idx - CV_E0; is_in = r < 16384; if (!is_in) r -= 16384; }
    else if (idx < CV_EO1) { l = 1; r = idx - CV_EI1; is_in = true; }
    else { l = 1; r = idx - CV_EO1; is_in = false; }
    if (is_in) { const int le = l * 32 + r / 512, q = r % 512, kb = q / 32, n0 = (q % 32) * 32;
        const int dst = n0 < 512 ? (256 * (n0 >> 7) + (n0 & 127)) : (256 * ((n0 - 512) >> 7) + 128 + ((n0 - 512) & 127));
        transpose_item8(a.in[I_EIN] + (size_t)le * 1024 * 1024, 1024, 1024, ws + WS_WEIN + (size_t)le * 1024 * 1024, kb, n0, dst, scr, lane); }
    else { const int le = l * 32 + r / 256, q = r % 256, kb = q / 32, nb = q % 32;
        transpose_item8(a.in[I_EOUT] + (size_t)le * 512 * 1024, 512, 1024, ws + WS_WEOUT + (size_t)le * 1024 * 512, kb, nb * 32, nb * 32, scr, lane); }
}
__device__ __forceinline__ void convert_range(const Args& a, LAS unsigned char* lds, int first, int count, int rank, int nparts) {
    const int tid = tid_now(), lane = tid & 63, wid = __builtin_amdgcn_readfirstlane(tid >> 6);
    LAS float* scr = (LAS float*)(lds + wid * 16384);
    const int per = (count + nparts - 1) / nparts, lo = rank * per, hi = (lo + per < count) ? lo + per : count;
    for (int j = lo + wid; j < hi; j += 8) convert_item(a, first + j, scr, lane);
}
__device__ __forceinline__ void convert_in_tail(const Args& a, LAS unsigned char* lds, int first, int count, int tot_units, int G, int c) {
    const int rem = tot_units % G;
    if (rem == 0) convert_range(a, lds, first, count, c, G);
    else if (c >= rem) convert_range(a, lds, first, count, c - rem, G - rem);
}

__device__ __forceinline__ void phase_p0(const Args& a, LAS unsigned char* lds) {
    const int tid = tid_now(), lane = tid & 63, wid = __builtin_amdgcn_readfirstlane(tid >> 6);
    unsigned char* ws = a.ws;
    for (int job = blockIdx.x; job < 192; job += gridDim.x) {
        const int l = job / 96, n0 = (job % 96) * 64;
        LAS float* sv = (LAS float*)lds;
        LAS float* red = (LAS float*)(lds + 5 * 1024 * 4);
        for (int i = tid; i < 5 * 1024; i += 512) { const int r = i >> 10, k = i & 1023; const float v = r < 4 ? a.in[I_C][r * 1024 + k] : a.in[I_CCTX][k]; sv[i] = siluf_(v); }
        __syncthreads();
        const int ks = tid >> 6, col = tid & 63;
        const float* w = a.in[I_WMOD] + (size_t)l * 1024 * 6144 + (size_t)(ks * 128) * 6144 + n0 + col;
        float acc[5] = {0.f, 0.f, 0.f, 0.f, 0.f};
#pragma unroll 8
        for (int k = 0; k < 128; ++k) { const float wv = w[(size_t)k * 6144];
#pragma unroll
            for (int r = 0; r < 5; ++r) acc[r] += sv[r * 1024 + ks * 128 + k] * wv; }
#pragma unroll
        for (int r = 0; r < 5; ++r) red[(ks * 5 + r) * 64 + col] = acc[r];
        __syncthreads();
        if (tid < 320) { const int r = tid >> 6; float s = 0.f;
#pragma unroll
            for (int q = 0; q < 8; ++q) s += red[(q * 5 + r) * 64 + col];
            ((float*)(ws + WS_MOD))[(size_t)(l * 5 + r) * 6144 + n0 + col] = s + a.in[I_BMOD][l * 6144 + n0 + col]; }
        __syncthreads();
    }
    LAS float* scr = (LAS float*)(lds + wid * 16384);
    const int gw = blockIdx.x * 8 + wid, NGW = gridDim.x * 8;
    constexpr int P0_N0 = CV_E0 + CV_P0_E0, P0_N1 = P0_N0 + CV_P0_EI1, P0_N2 = P0_N1 + CV_P0_EO1;
    for (int j = gw; j < P0_N2; j += NGW) { const int idx = j < P0_N0 ? j : (j < P0_N1 ? CV_EI1 + (j - P0_N0) : CV_EO1 + (j - P0_N1)); convert_item(a, idx, scr, lane); }
    for (int i = blockIdx.x * 512 + tid; i < 2 * 4096; i += gridDim.x * 512) { const int l = i >> 12, g = (i >> 10) & 3, k = i & 1023; ((float*)(ws + WS_TAB))[i] = a.in[I_RWG][l * 4096 + k * 4 + g]; }
    for (int i = blockIdx.x * 512 + tid; i < 2 * 4 * 64 * 64; i += gridDim.x * 512) { const int lg = i >> 12, dd = (i >> 6) & 63, c = i & 63;
        ((bf16_t*)(ws + WS_PWT))[i] = (bf16_t)(pk2(a.in[I_POOLW][(size_t)lg * 4096 + c * 64 + dd], 0.f) & 0xffffu); }
    for (int i = blockIdx.x * 512 + tid; i < 4 * 8 * 64; i += gridDim.x * 512) { const int wi = i >> 9, f = (i >> 6) & 7, ln = i & 63, mt = f >> 2, nt = (f >> 1) & 1, sq = f & 1, rr = ln & 31, hh = ln >> 5, hw = 1 << wi;
        const int t = 32 * nt + rr; int lo = t - hw, hi = t + hw; lo = lo < 0 ? 0 : lo; hi = hi > 64 ? 64 : hi; const int cnt = hi - lo;
        unsigned w4[4];
#pragma unroll
        for (int jp = 0; jp < 4; ++jp) { unsigned wd = 0u;
#pragma unroll
            for (int e = 0; e < 2; ++e) { const int j = 2 * jp + e, tp = 32 * mt + 16 * sq + 8 * (j >> 2) + 4 * hh + (j & 3);
                const int val = ((tp >= lo && tp < hi) ? 1 : 0) - (tp == t ? cnt : 0);
                wd |= (__float_as_uint((float)val) >> 16) << (16 * e); }
            w4[jp] = wd; }
        ((u32x4*)(ws + WS_BAND))[i] = (u32x4){w4[0], w4[1], w4[2], w4[3]}; }
    for (int i = blockIdx.x * 512 + tid; i < 2 * 224 * 1024 / 8; i += gridDim.x * 512) { const int l = i / (224 * 128), q = i % (224 * 128);
        *(u32x4*)((bf16_t*)(ws + WS_WIN) + (size_t)l * NINP * 1024 + (size_t)NIN * 1024 + (size_t)q * 8) = (u32x4){0u, 0u, 0u, 0u}; }
}

__device__ __forceinline__ void load_row(const float* xrow, int lane, f32x4 (&v)[4]) {
    const f32x4* xr = (const f32x4*)xrow + lane;
#pragma unroll
    for (int j = 0; j < 4; ++j) v[j] = xr[64 * j];
}
__device__ __forceinline__ void load_row_bf(const bf16_t* xrow, int lane, f32x4 (&v)[4]) {
#pragma unroll
    for (int j = 0; j < 4; ++j) { const u32x2 w = *((const u32x2*)xrow + lane + 64 * j); v[j] = (f32x4){bflo(w.x), bfhi(w.x), bflo(w.y), bfhi(w.y)}; }
}
__device__ __forceinline__ void store_row_bf(bf16_t* xrow, int lane, const f32x4 (&v)[4]) {
#pragma unroll
    for (int j = 0; j < 4; ++j) { u32x2 w; w.x = pk2(v[j].x, v[j].y); w.y = pk2(v[j].z, v[j].w); *((u32x2*)xrow + lane + 64 * j) = w; }
}
__device__ __forceinline__ float row_rstd(const f32x4 (&v)[4]) {
    float s = 0.f;
#pragma unroll
    for (int j = 0; j < 4; ++j) s += (v[j].x * v[j].x + v[j].y * v[j].y) + (v[j].z * v[j].z + v[j].w * v[j].w);
    return rsqrtf(wave_sum(s) * (1.0f / D) + EPS);
}
__device__ __forceinline__ void norm_mod_store(f32x4 (&v)[4], float rstd, const float* g, const float* sc, const float* sh, bf16_t* hrow, int lane) {
#pragma unroll
    for (int j = 0; j < 4; ++j) { const f32x4 gv = *((const f32x4*)g + lane + 64 * j), scv = *((const f32x4*)sc + lane + 64 * j), shv = *((const f32x4*)sh + lane + 64 * j);
        v[j] = (v[j] * rstd * gv) * (1.0f + scv) + shv;
        u32x2 w; w.x = pk2(v[j].x, v[j].y); w.y = pk2(v[j].z, v[j].w);
        *((u32x2*)hrow + lane + 64 * j) = w; }
}

__device__ __forceinline__ void norm_store_cached(f32x4 (&v)[4], float rstd, const f32x4 (&GS)[4], const f32x4 (&SH)[4], bf16_t* hrow, int lane) {
#pragma unroll
    for (int j = 0; j < 4; ++j) { v[j] = (v[j] * rstd) * GS[j] + SH[j];
        u32x2 w; w.x = pk2(v[j].x, v[j].y); w.y = pk2(v[j].z, v[j].w);
        *((u32x2*)hrow + lane + 64 * j) = w; }
}
__device__ __forceinline__ void norm_store_cached8(f32x4 (&v)[4], float rstd, const f32x4 (&GS)[4], const f32x4 (&SH)[4], unsigned char* hrow, int lane) {
#pragma unroll
    for (int j = 0; j < 4; ++j) { v[j] = (v[j] * rstd) * GS[j] + SH[j];
        float q[4];
#pragma unroll
        for (int i = 0; i < 4; ++i) q[i] = fminf(fmaxf(v[j][i] * F8_HSC, -440.0f), 440.0f);
        int w = 0; w = __builtin_amdgcn_cvt_pk_fp8_f32(q[0], q[1], w, false); w = __builtin_amdgcn_cvt_pk_fp8_f32(q[2], q[3], w, true);
        *((unsigned*)hrow + lane + 64 * j) = (unsigned)w; }
}
__device__ __forceinline__ void load_mod_cached(const float* g, const float* sc, const float* sh, const float* ga, int lane, f32x4 (&GS)[4], f32x4 (&SH)[4], f32x4 (&GA)[4]) {
#pragma unroll
    for (int j = 0; j < 4; ++j) { const f32x4 gv = *((const f32x4*)g + lane + 64 * j), scv = *((const f32x4*)sc + lane + 64 * j);
        GS[j] = gv * (1.0f + scv); SH[j] = *((const f32x4*)sh + lane + 64 * j); GA[j] = *((const f32x4*)ga + lane + 64 * j); }
}

__device__ __forceinline__ void phase_norm1_l0(const Args& a) {
    const int lane = tid_now() & 63, wid = tid_now() >> 6, gw = blockIdx.x * 8 + wid, NGW = gridDim.x * 8;
    const float* MOD = (const float*)(a.ws + WS_MOD); bf16_t* H = (bf16_t*)(a.ws + WS_H);
    int cur_b = -1; f32x4 GS[4], SH[4], GA[4];
#pragma unroll 1
    for (int m = gw; m < MTOT; m += 2 * NGW) {
        const int m2 = m + NGW; const bool has2 = m2 < MTOT; const int m2c = has2 ? m2 : m;
        const float* src = m < NLAT ? a.in[I_X] + (size_t)m * D : a.in[I_CTX] + (size_t)(m - NLAT) * D;
        const float* src2 = m2c < NLAT ? a.in[I_X] + (size_t)m2c * D : a.in[I_CTX] + (size_t)(m2c - NLAT) * D;
        const int b = m < NLAT ? (m >> 13) : 4, b2 = m2c < NLAT ? (m2c >> 13) : 4;
        f32x4 v[4], v2[4]; load_row(src, lane, v); load_row(src2, lane, v2);
        const float rstd = row_rstd(v), rstd2 = row_rstd(v2);
        if (b != cur_b) { const float* mod = MOD + (size_t)b * 6144; load_mod_cached(a.in[I_G1], mod + 1024, mod, mod, lane, GS, SH, GA); cur_b = b; }
        norm_store_cached(v, rstd, GS, SH, H + (size_t)m * D, lane);
        if (has2) { if (b2 != cur_b) { const float* mod = MOD + (size_t)b2 * 6144; load_mod_cached(a.in[I_G1], mod + 1024, mod, mod, lane, GS, SH, GA); cur_b = b2; }
            norm_store_cached(v2, rstd2, GS, SH, H + (size_t)m2 * D, lane); }
    }
}

struct ChunkPos { int b, sf, sb; };
__device__ __forceinline__ ChunkPos chunk_pos(int chunk) {
    ChunkPos p;
    if (chunk < 512) { p.b = chunk >> 7; const int n = chunk & 127; p.sf = 4 + n; p.sb = 4 + 127 - n; }
    else { const int cc = chunk - 512; p.b = cc >> 2; const int n = cc & 3; p.sf = n; p.sb = 3 - n; }
    return p;
}

constexpr int VS = 72;
__device__ __forceinline__ void gla_prep_dir(int dir, int lane, const float (&w)[8], float bias, const bf16x8 (&Az)[2], f32x16 (&BT)[2]) {
    asm volatile("" : "+v"(lane));
    const int r = lane & 31, hf = lane >> 5;
    const f32x16 zero16 = {0.f, 0.f, 0.f, 0.f, 0.f, 0.f, 0.f, 0.f, 0.f, 0.f, 0.f, 0.f, 0.f, 0.f, 0.f, 0.f};
    u32x4 mk[2];
#pragma unroll
    for (int s = 0; s < 2; ++s) { unsigned w4[4];
#pragma unroll
        for (int jp = 0; jp < 4; ++jp) { const int j0 = 2 * jp, j1 = 2 * jp + 1;
            const int t0 = 16 * s + 8 * (j0 >> 2) + 4 * hf + (j0 & 3), t1 = 16 * s + 8 * (j1 >> 2) + 4 * hf + (j1 & 3);
            const bool c0 = dir ? (t0 >= r) : (t0 <= r), c1 = dir ? (t1 >= r) : (t1 <= r);
            w4[jp] = (c0 ? 0x3F80u : 0u) | (c1 ? 0x3F800000u : 0u); }
        mk[s].x = w4[0]; mk[s].y = w4[1]; mk[s].z = w4[2]; mk[s].w = w4[3]; }
    bf16x8 Bhi, Blo; split8(w, Bhi, Blo);
    BT[0] = zero16; BT[1] = zero16;
#pragma unroll 1
    for (int mt = 0; mt < 2; ++mt) {
        const bf16x8 A = mt ? Az[1] : Az[0];
        f32x16 x = MFMA32(A, Bhi, zero16); x = MFMA32(A, Blo, x);
        float la[16];
#pragma unroll
        for (int i = 0; i < 16; ++i) { const float v = x[i] + bias; la[i] = (fminf(v, 0.f) - __logf(1.0f + __expf(-fabsf(v)))) * (1.0f / 16.0f); }
#pragma unroll
        for (int s = 0; s < 2; ++s) {
            const float t8[8] = {la[8 * s], la[8 * s + 1], la[8 * s + 2], la[8 * s + 3], la[8 * s + 4], la[8 * s + 5], la[8 * s + 6], la[8 * s + 7]};
            bf16x8 Lh, Ll; split8(t8, Lh, Ll);
#pragma unroll
            for (int nt = 0; nt < 2; ++nt) {
                const bool full = dir ? (mt > nt) : (mt < nt);
                u32x4 bm; const unsigned fv = full ? 0x3F803F80u : 0u;
                bm.x = (mt == nt) ? mk[s].x : fv; bm.y = (mt == nt) ? mk[s].y : fv; bm.z = (mt == nt) ? mk[s].z : fv; bm.w = (mt == nt) ? mk[s].w : fv;
                const bf16x8 Bm = __builtin_bit_cast(bf16x8, bm);
                BT[nt] = MFMA32(Lh, Bm, BT[nt]); BT[nt] = MFMA32(Ll, Bm, BT[nt]); }
        }
    }
}
__device__ __forceinline__ void gla_gate_loads(const Args& a, int l, int h, int dir, const bf16_t* cols0, int lane, float (&w)[8], float& bias, bf16x8 (&Az)[2]) {
    const int r = lane & 31, hf = lane >> 5;
    const float* wp = a.in[dir ? I_GWB : I_GWF] + (size_t)(l * 16 + 8 * hf) * 128 + 32 * h + r;
#pragma unroll
    for (int j = 0; j < 8; ++j) w[j] = wp[j * 128];
    bias = a.in[dir ? I_GBB : I_GBF][l * 128 + 32 * h + r];
#pragma unroll
    for (int mt = 0; mt < 2; ++mt) Az[mt] = *(const bf16x8*)(cols0 + (size_t)(32 * mt + r) * NINP + C_ZF + 16 * dir + 8 * hf);
}
__device__ __forceinline__ void stage_vT(const bf16_t* cols0, int h, int lane, LAS bf16_t* vT) {
    u32x4 w[8];
#pragma unroll
    for (int q = 0; q < 8; ++q) { const int chunk = lane + 64 * q, t = chunk >> 3, cg = chunk & 7; w[q] = *(const u32x4*)(cols0 + (size_t)t * NINP + C_V + 64 * h + 8 * cg); }
#pragma unroll
    for (int q = 0; q < 8; ++q) PIN(w[q]);
#pragma unroll
    for (int q = 0; q < 8; ++q) { const int chunk = lane + 64 * q, t = chunk >> 3, cg = chunk & 7;
        LAS bf16_t* p = vT + (8 * cg) * VS + t;
        p[0 * VS] = (bf16_t)(w[q].x & 0xffffu); p[1 * VS] = (bf16_t)(w[q].x >> 16); p[2 * VS] = (bf16_t)(w[q].y & 0xffffu); p[3 * VS] = (bf16_t)(w[q].y >> 16);
        p[4 * VS] = (bf16_t)(w[q].z & 0xffffu); p[5 * VS] = (bf16_t)(w[q].z >> 16); p[6 * VS] = (bf16_t)(w[q].w & 0xffffu); p[7 * VS] = (bf16_t)(w[q].w >> 16); }
}
__device__ __forceinline__ void chunk_gla_item(const Args& a, int l, int tile, int h, int lane, LAS bf16_t* vT, LAS bf16_t* kdT) {
    const int r = lane & 31, hf = lane >> 5;
    const bf16_t* cols0 = (const bf16_t*)(a.ws + WS_COLS) + (size_t)tile * 64 * NINP;
    float* KV = (float*)(a.ws + WS_KV); float* DEC = (float*)(a.ws + WS_DEC);
    const ChunkPos cp = chunk_pos(tile);
    const f32x16 zero16 = {0.f, 0.f, 0.f, 0.f, 0.f, 0.f, 0.f, 0.f, 0.f, 0.f, 0.f, 0.f, 0.f, 0.f, 0.f, 0.f};
    stage_vT(cols0, h, lane, vT);
#pragma unroll 1
    for (int dir = 0; dir < 2; ++dir) {
        float gw8[8], gbias; bf16x8 Az[2]; u32x2 kraw[2][4];
        gla_gate_loads(a, l, h, dir, cols0, lane, gw8, gbias, Az);
#pragma unroll
        for (int nt = 0; nt < 2; ++nt)
#pragma unroll
            for (int g = 0; g < 4; ++g) kraw[nt][g] = *(const u32x2*)(cols0 + (size_t)(32 * nt + r) * NINP + C_K + 32 * h + 4 * hf + 8 * g);
#pragma unroll
        for (int j = 0; j < 8; ++j) PIN(gw8[j]);
        PIN(gbias); PIN(Az[0]); PIN(Az[1]);
#pragma unroll
        for (int nt = 0; nt < 2; ++nt)
#pragma unroll
            for (int g = 0; g < 4; ++g) PIN(kraw[nt][g]);
        f32x16 BT[2]; gla_prep_dir(dir, lane, gw8, gbias, Az, BT);
        const size_t e = (size_t)((dir * 4 + cp.b) * 4 + h) * NSEQ + (dir ? cp.sb : cp.sf);
        const int srcl = (dir ? 0 : 31) + 32 * hf;
        float tot[16];
#pragma unroll
        for (int i = 0; i < 16; ++i) tot[i] = __shfl(dir ? BT[0][i] : BT[1][i], srcl);
        if (r == (dir ? 0 : 31)) {
#pragma unroll
            for (int i = 0; i < 16; ++i) DEC[e * 32 + (i & 3) + 8 * (i >> 2) + 4 * hf] = __expf(tot[i]);
        }
#pragma unroll
        for (int nt = 0; nt < 2; ++nt) {
#pragma unroll
            for (int g = 0; g < 4; ++g) { const u32x2 kw = kraw[nt][g];
                const float kf[4] = {bflo(kw.x), bfhi(kw.x), bflo(kw.y), bfhi(kw.y)};
#pragma unroll
                for (int q = 0; q < 4; ++q) { const int i = 4 * g + q; const float kd = kf[q] * __expf(tot[i] - BT[nt][i]);
                    kdT[(8 * g + 4 * hf + q) * VS + 32 * nt + r] = (bf16_t)(pk2c(kd, 0.f) & 0xffffu); } }
        }
        LDS_WAIT(); asm volatile("" ::: "memory");
#pragma unroll 1
        for (int ct = 0; ct < 2; ++ct) {
            f32x16 acc = zero16;
#pragma unroll
            for (int ks = 0; ks < 4; ++ks) {
                const bf16x8 A = *(const LAS bf16x8*)(vT + (32 * ct + r) * VS + 16 * ks + 8 * hf);
                const bf16x8 B = *(const LAS bf16x8*)(kdT + r * VS + 16 * ks + 8 * hf);
                acc = MFMA32(A, B, acc); }
            float* dst = KV + e * 2048 + (size_t)(32 * ct + 4 * hf) * 32 + r;
#pragma unroll
            for (int i = 0; i < 16; ++i) dst[((i & 3) + 8 * (i >> 2)) * 32] = acc[i];
        }
        LDS_WAIT(); asm volatile("" ::: "memory");
    }
}
__device__ __forceinline__ void chunk_agv_item(const Args& a, int row0, int lane) {
    const bf16_t* COLS = (const bf16_t*)(a.ws + WS_COLS); float* AGV = (float*)(a.ws + WS_AGV); float* CXV = (float*)(a.ws + WS_CXV);
    const int t = lane >> 3;
#pragma unroll
    for (int rep = 0; rep < 2; ++rep) { const int c8 = ((lane & 7) + 8 * rep) * 8; const bf16_t* rp = COLS + (size_t)(row0 + t) * NINP;
        float fa[8], fg[8], fc[8], fx[8];
        unpack8(*(const u32x4*)(rp + C_CA + 128 + c8), fa); unpack8(*(const u32x4*)(rp + C_CG + 128 + c8), fg);
        unpack8(*(const u32x4*)(rp + C_SC + 128 + c8), fc); unpack8(*(const u32x4*)(rp + C_SX + 128 + c8), fx);
        f32x4 o0, o1, p0, p1;
#pragma unroll
        for (int i = 0; i < 4; ++i) { o0[i] = fa[i] * sigmoidf_(fg[i]); o1[i] = fa[4 + i] * sigmoidf_(fg[4 + i]); p0[i] = fc[i] * fx[i]; p1[i] = fc[4 + i] * fx[4 + i]; }
        float* ao = AGV + (size_t)(row0 + t) * 128 + c8; float* co = CXV + (size_t)(row0 + t) * 128 + c8;
        *(f32x4*)ao = o0; *(f32x4*)(ao + 4) = o1; *(f32x4*)co = p0; *(f32x4*)(co + 4) = p1; }
}
__device__ __forceinline__ int next_item(LAS int* ctr, int lane) {
    int j = 0; if (lane == 0) j = __hip_atomic_fetch_add(ctr, 1, __ATOMIC_RELAXED, __HIP_MEMORY_SCOPE_WORKGROUP);
    return __builtin_amdgcn_readfirstlane(j);
}
__device__ __forceinline__ void phase_chunk(const Args& a, int l, LAS unsigned char* lds) {
    const int tid = tid_now(), lane = tid & 63, wid = __builtin_amdgcn_readfirstlane(tid >> 6);
    LAS bf16_t* vT = (LAS bf16_t*)(lds + wid * 16384); LAS bf16_t* kdT = vT + 64 * VS;
    LAS int* ctr = (LAS int*)(lds + MISC_OFF + 16);
    if (tid == 0) *ctr = 0;
    __syncthreads();
    const int b = blockIdx.x, G = gridDim.x, nL = b < 512 ? (511 - b) / G + 1 : 0, cx = (G >= 48 ? (b >= 32 && b < 48) : (b < 16)) ? 1 : 0, cxt = 512 + (G >= 48 ? b - 32 : b);
    for (;;) { int j = next_item(ctr, lane);
        if (j < 4 * nL) { chunk_gla_item(a, l, b + G * (j >> 2), j & 3, lane, vT, kdT); continue; }
        j -= 4 * nL;
        if (j < 4 * cx) { chunk_gla_item(a, l, cxt, j & 3, lane, vT, kdT); continue; }
        j -= 4 * cx; if (j >= 8 * nL) break;
        chunk_agv_item(a, (b + G * (j >> 3)) * 64 + (j & 7) * 8, lane);
    }
}
__device__ __forceinline__ void mixer_gla_item(const Args& a, int l, int tile, int h, int lane, LAS bf16_t* vT) {
    const bf16_t* cols0 = (const bf16_t*)(a.ws + WS_COLS) + (size_t)tile * 64 * NINP;
    const bf16_t* SIN = (const bf16_t*)(a.ws + WS_SIN); bf16_t* MIX = (bf16_t*)(a.ws + WS_MIX);
    const ChunkPos cp = chunk_pos(tile);
    const f32x16 zero16 = {0.f, 0.f, 0.f, 0.f, 0.f, 0.f, 0.f, 0.f, 0.f, 0.f, 0.f, 0.f, 0.f, 0.f, 0.f, 0.f};
    stage_vT(cols0, h, lane, vT);
    LDS_WAIT(); asm volatile("" ::: "memory");
    f32x16 OT[2][2] = {{zero16, zero16}, {zero16, zero16}};
#pragma unroll 1
    for (int dir = 0; dir < 2; ++dir) {
        int ln = lane; asm volatile("" : "+v"(ln)); const int r = ln & 31, hf = ln >> 5;
        bf16x8 QD[2][2], KI[2][2];
        const bf16_t* st = SIN + ((size_t)((dir * 4 + cp.b) * 4 + h) * NSEQ + (dir ? cp.sb : cp.sf)) * 2048;
        u32x2 sraw[2][2][2];
        { float gw8[8], gbias; bf16x8 Az[2]; u32x2 qraw[2][4], kraw[2][4];
            gla_gate_loads(a, l, h, dir, cols0, ln, gw8, gbias, Az);
#pragma unroll
            for (int nt = 0; nt < 2; ++nt)
#pragma unroll
                for (int g = 0; g < 4; ++g) { const bf16_t* qp = cols0 + (size_t)(32 * nt + r) * NINP + C_Q + 32 * h + 4 * hf + 8 * g; qraw[nt][g] = *(const u32x2*)qp; kraw[nt][g] = *(const u32x2*)(qp + (C_K - C_Q)); }
#pragma unroll
            for (int ct = 0; ct < 2; ++ct)
#pragma unroll
                for (int s = 0; s < 2; ++s) { const size_t off = (size_t)(32 * ct + r) * 32 + 16 * s + 4 * hf; sraw[ct][s][0] = *(const u32x2*)(st + off); sraw[ct][s][1] = *(const u32x2*)(st + off + 8); }
#pragma unroll
            for (int j = 0; j < 8; ++j) PIN(gw8[j]);
            PIN(gbias); PIN(Az[0]); PIN(Az[1]);
#pragma unroll
            for (int nt = 0; nt < 2; ++nt)
#pragma unroll
                for (int g = 0; g < 4; ++g) { PIN(qraw[nt][g]); PIN(kraw[nt][g]); }
#pragma unroll
            for (int ct = 0; ct < 2; ++ct)
#pragma unroll
                for (int s = 0; s < 2; ++s) { PIN(sraw[ct][s][0]); PIN(sraw[ct][s][1]); }
            f32x16 BT[2]; gla_prep_dir(dir, ln, gw8, gbias, Az, BT);
#pragma unroll
            for (int nt = 0; nt < 2; ++nt) {
                float qd[16], ki[16];
#pragma unroll
                for (int g = 0; g < 4; ++g) { const u32x2 qw = qraw[nt][g], kw = kraw[nt][g];
                    const float qf[4] = {bflo(qw.x), bfhi(qw.x), bflo(qw.y), bfhi(qw.y)}, kf[4] = {bflo(kw.x), bfhi(kw.x), bflo(kw.y), bfhi(kw.y)};
#pragma unroll
                    for (int q = 0; q < 4; ++q) { const float bb = BT[nt][4 * g + q]; qd[4 * g + q] = qf[q] * 0.17677669529663687f * __expf(bb); ki[4 * g + q] = kf[q] * __expf(-bb); } }
#pragma unroll
                for (int s = 0; s < 2; ++s) { QD[nt][s] = pack8f(qd[8 * s], qd[8 * s + 1], qd[8 * s + 2], qd[8 * s + 3], qd[8 * s + 4], qd[8 * s + 5], qd[8 * s + 6], qd[8 * s + 7]);
                    KI[nt][s] = pack8f(ki[8 * s], ki[8 * s + 1], ki[8 * s + 2], ki[8 * s + 3], ki[8 * s + 4], ki[8 * s + 5], ki[8 * s + 6], ki[8 * s + 7]); }
            }
        }
#pragma unroll
        for (int jt = 0; jt < 2; ++jt)
#pragma unroll
            for (int it = 0; it < 2; ++it) {
                if (jt != it) { const bool keep = dir ? (jt > it) : (jt < it); if (!keep) continue; }
                f32x16 p = MFMA32(KI[jt][0], QD[it][0], zero16); p = MFMA32(KI[jt][1], QD[it][1], p);
                if (jt == it) {
#pragma unroll
                    for (int i = 0; i < 16; ++i) { const int jj = (i & 3) + 8 * (i >> 2) + 4 * hf; const bool kp_ = dir ? (jj >= r) : (jj <= r); p[i] = kp_ ? p[i] : 0.f; }
                }
                const bf16x8 P0 = pack_step(p, 0), P1 = pack_step(p, 1);
#pragma unroll
                for (int ct = 0; ct < 2; ++ct) {
                    const LAS bf16_t* vp = vT + (32 * ct + r) * VS + 32 * jt + 4 * hf;
                    const bf16x8 A0 = cat44(*(const LAS u32x2*)vp, *(const LAS u32x2*)(vp + 8)), A1 = cat44(*(const LAS u32x2*)(vp + 16), *(const LAS u32x2*)(vp + 24));
                    OT[ct][it] = MFMA32(A0, P0, OT[ct][it]); OT[ct][it] = MFMA32(A1, P1, OT[ct][it]); }
            }
#pragma unroll
        for (int ct = 0; ct < 2; ++ct)
#pragma unroll
            for (int s = 0; s < 2; ++s) {
                const bf16x8 As = cat44(sraw[ct][s][0], sraw[ct][s][1]);
                OT[ct][0] = MFMA32(As, QD[0][s], OT[ct][0]); OT[ct][1] = MFMA32(As, QD[1][s], OT[ct][1]); }
    }
    int ln2 = lane; asm volatile("" : "+v"(ln2)); const int r = ln2 & 31, hf = ln2 >> 5;
    u32x2 graw[2][2][4]; f32x4 gor[2][4];
#pragma unroll
    for (int ct = 0; ct < 2; ++ct)
#pragma unroll
        for (int g = 0; g < 4; ++g) { const int c0 = 32 * ct + 8 * g + 4 * hf; gor[ct][g] = *(const f32x4*)(a.in[I_GOUT] + l * 256 + 64 * h + c0);
#pragma unroll
            for (int it = 0; it < 2; ++it) graw[it][ct][g] = *(const u32x2*)(cols0 + (size_t)(32 * it + r) * NINP + C_G + 64 * h + c0); }
#pragma unroll
    for (int ct = 0; ct < 2; ++ct)
#pragma unroll
        for (int g = 0; g < 4; ++g) { PIN(gor[ct][g]); PIN(graw[0][ct][g]); PIN(graw[1][ct][g]); }
#pragma unroll
    for (int it = 0; it < 2; ++it) {
        float ss = 0.f;
#pragma unroll
        for (int ct = 0; ct < 2; ++ct)
#pragma unroll
            for (int i = 0; i < 16; ++i) ss += OT[ct][it][i] * OT[ct][it][i];
        ss += __shfl_xor(ss, 32);
        const float rs = rsqrtf(ss * (1.0f / 64.0f) + EPS);
        const int t = 32 * it + r;
#pragma unroll
        for (int ct = 0; ct < 2; ++ct)
#pragma unroll
            for (int g = 0; g < 4; ++g) { const int c0 = 32 * ct + 8 * g + 4 * hf;
                const u32x2 gw_ = graw[it][ct][g];
                const f32x4 go = gor[ct][g];
                const float o0 = OT[ct][it][4 * g] * rs * go[0] * siluf_(bflo(gw_.x)), o1 = OT[ct][it][4 * g + 1] * rs * go[1] * siluf_(bfhi(gw_.x));
                const float o2 = OT[ct][it][4 * g + 2] * rs * go[2] * siluf_(bflo(gw_.y)), o3 = OT[ct][it][4 * g + 3] * rs * go[3] * siluf_(bfhi(gw_.y));
                u32x2 w; w.x = pk2c(o0, o1); w.y = pk2c(o2, o3);
                *(u32x2*)(MIX + (size_t)(tile * 64 + t) * D + 64 * h + c0) = w; }
    }
    LDS_WAIT(); asm volatile("" ::: "memory");
}
template <int TAPS>
__device__ __forceinline__ void vconv_item(const float* SRC, float* DST, const float* w  , int b, int col, int chg, LAS float* buf, int lane) {
    const int ch = lane & 31, rh = lane >> 5;
    const size_t base = ((size_t)b * SEQ + col) * 128 + chg * 32 + ch;
#pragma unroll 8
    for (int r = 0; r < 128; r += 2) buf[(r + rh) * 32 + ch] = SRC[base + (size_t)(r + rh) * 64 * 128];
    float wt[TAPS];
#pragma unroll
    for (int j = 0; j < TAPS; ++j) wt[j] = w[j * 256 + chg * 32 + ch];
    LDS_WAIT(); asm volatile("" ::: "memory");
    constexpr int HW = TAPS / 2;
#pragma unroll 1
    for (int r0 = 0; r0 < 64; r0 += 8) {
        const int rb = rh * 64 + r0;
        float o[8] = {0.f, 0.f, 0.f, 0.f, 0.f, 0.f, 0.f, 0.f};
#pragma unroll
        for (int j = 0; j < TAPS + 7; ++j) { const int rin = rb - HW + j; const float x = (rin >= 0 && rin < 128) ? buf[rin * 32 + ch] : 0.f;
#pragma unroll
            for (int q = 0; q < 8; ++q) { if (j - q >= 0 && j - q < TAPS) o[q] += x * wt[j - q]; } }
#pragma unroll
        for (int q = 0; q < 8; ++q) DST[base + (size_t)(rb + q) * 64 * 128] = o[q];
    }
    LDS_WAIT(); asm volatile("" ::: "memory");
}
__device__ __forceinline__ void phase_scan(const Args& a, int l, LAS unsigned char* lds) {
    const int tid = tid_now(), lane = tid & 63, wid = __builtin_amdgcn_readfirstlane(tid >> 6);
    const float* KV = (const float*)(a.ws + WS_KV); const float* DEC = (const float*)(a.ws + WS_DEC); bf16_t* SIN = (bf16_t*)(a.ws + WS_SIN);
    if (tid < 256) {
        for (int rp = 0; rp < ((REP_SUB == 5 && l == 0) ? 2 : 1); ++rp)
        for (int gid = blockIdx.x * 256 + tid; gid < 65536; gid += gridDim.x * 256) {
            const int e = gid >> 11, idx = gid & 2047;
            const float* p = KV + (size_t)e * NSEQ * 2048 + idx; const float* dp = DEC + (size_t)e * NSEQ * 32 + (idx & 31); bf16_t* q = SIN + (size_t)e * NSEQ * 2048 + idx;
            float st = 0.f;
#pragma unroll 1
            for (int s0 = 0; s0 < NSEQ; s0 += 22) {
                float kv[22], dd[22];
#pragma unroll
                for (int u = 0; u < 22; ++u) { kv[u] = p[(size_t)(s0 + u) * 2048]; dd[u] = dp[(s0 + u) * 32]; }
#pragma unroll
                for (int u = 0; u < 22; ++u) { PIN(kv[u]); PIN(dd[u]); }
#pragma unroll
                for (int u = 0; u < 22; ++u) { q[(size_t)(s0 + u) * 2048] = (bf16_t)(pk2c(st, 0.f) & 0xffffu); st = dd[u] * st + kv[u]; }
            }
        }
    }
    LAS float* buf = (LAS float*)(lds + wid * 16384);
    const int gw = blockIdx.x * 8 + wid, NGW = gridDim.x * 8;
    for (int rp = 0; rp < ((REP_SUB == 6 && l == 0) ? 2 : 1); ++rp)
    for (int it = gw; it < 2048; it += NGW) {
        const int kind = it >> 10, q = it & 1023, b = q >> 8, col = (q >> 2) & 63, chg = q & 3;
        if (kind == 0) vconv_item<31>((const float*)(a.ws + WS_AGV), (float*)(a.ws + WS_UV), a.in[I_CONFW] + (size_t)l * 31 * 256 + 128, b, col, chg, buf, lane);
        else vconv_item<3>((const float*)(a.ws + WS_CXV), (float*)(a.ws + WS_SCV), a.in[I_SCW] + (size_t)l * 3 * 256 + 128, b, col, chg, buf, lane);
    }
}

__device__ __forceinline__ void mixer_conv_item(const Args& a, int l, int tile, int tg, int lane0, LAS float* U) {
    const bf16_t* COLS = (const bf16_t*)(a.ws + WS_COLS); bf16_t* MIX = (bf16_t*)(a.ws + WS_MIX);
    const int row0 = tile * 64, T0 = 16 * tg;
    const float* confw = a.in[I_CONFW] + (size_t)l * 31 * 256; const float* scw = a.in[I_SCW] + (size_t)l * 3 * 256;
#pragma unroll 1
    for (int p = 0; p < 2; ++p) {
        int lane = lane0; asm volatile("" : "+v"(lane));
        const int c = 64 * p + lane;
        float wv[31];
#pragma unroll
        for (int j = 0; j < 31; ++j) wv[j] = confw[j * 256 + c];
        float bias = a.in[I_CONFB][l * 256 + c];
        unsigned ra[46], rg[46];
#pragma unroll
        for (int i = 0; i < 46; ++i) { const int t = T0 - 15 + i, tc = t < 0 ? 0 : (t > 63 ? 63 : t); const bf16_t* rp = COLS + (size_t)(row0 + tc) * NINP + c; ra[i] = rp[C_CA]; rg[i] = rp[C_CG]; }
#pragma unroll
        for (int j = 0; j < 31; ++j) PIN(wv[j]);
        PIN(bias);
#pragma unroll
        for (int i = 0; i < 46; ++i) { PIN(ra[i]); PIN(rg[i]); }
        float ag[46];
#pragma unroll
        for (int i = 0; i < 46; ++i) { const int t = T0 - 15 + i; const float m = (t >= 0 && t < 64) ? 1.0f : 0.0f;
            ag[i] = m * __uint_as_float(ra[i] << 16) * __builtin_amdgcn_rcpf(1.0f + __expf(-__uint_as_float(rg[i] << 16))); }
#pragma unroll
        for (int q = 0; q < 16; ++q) { float o = bias;
#pragma unroll
            for (int j = 0; j < 31; ++j) o += ag[q + j] * wv[j];
            U[q * 256 + ((((c >> 2) ^ q) << 2) | (c & 3))] = o; }
        unsigned rc[18], rx[18], rsb[16];
        float w0 = scw[c], w1 = scw[256 + c], w2 = scw[512 + c];
#pragma unroll
        for (int i = 0; i < 18; ++i) { const int t = T0 - 1 + i, tc = t < 0 ? 0 : (t > 63 ? 63 : t); const bf16_t* rp = COLS + (size_t)(row0 + tc) * NINP + c; rc[i] = rp[C_SC]; rx[i] = rp[C_SX]; }
#pragma unroll
        for (int q = 0; q < 16; ++q) rsb[q] = COLS[(size_t)(row0 + T0 + q) * NINP + C_SB + c];
        PIN(w0); PIN(w1); PIN(w2);
#pragma unroll
        for (int i = 0; i < 18; ++i) { PIN(rc[i]); PIN(rx[i]); }
#pragma unroll
        for (int q = 0; q < 16; ++q) PIN(rsb[q]);
        float cx[18];
#pragma unroll
        for (int i = 0; i < 18; ++i) { const int t = T0 - 1 + i; const float m = (t >= 0 && t < 64) ? 1.0f : 0.0f; cx[i] = m * __uint_as_float(rc[i] << 16) * __uint_as_float(rx[i] << 16); }
#pragma unroll
        for (int q = 0; q < 16; ++q) { const float cv = cx[q] * w0 + cx[q + 1] * w1 + cx[q + 2] * w2;
            MIX[(size_t)(row0 + T0 + q) * D + 512 + c] = (bf16_t)(pk2c(__uint_as_float(rsb[q] << 16) * cv, 0.f) & 0xffffu); }
    }
    {
        int lane = lane0; asm volatile("" : "+v"(lane));
        const float* UV = (const float*)(a.ws + WS_UV); const float* SCV = (const float*)(a.ws + WS_SCV);
        f32x4 uu[8], svv[8], bzz[8]; u32x2 sbb[8];
#pragma unroll
        for (int k8 = 0; k8 < 8; ++k8) { const int idx = lane + 64 * k8, t = idx >> 5, c4 = (idx & 31) * 4; const size_t row = (size_t)(row0 + T0 + t);
            uu[k8] = *(const f32x4*)(UV + row * 128 + c4); bzz[k8] = *(const f32x4*)(a.in[I_CONFB] + l * 256 + 128 + c4);
            svv[k8] = *(const f32x4*)(SCV + row * 128 + c4); sbb[k8] = *(const u32x2*)(COLS + row * NINP + C_SB + 128 + c4); }
#pragma unroll
        for (int k8 = 0; k8 < 8; ++k8) { PIN(uu[k8]); PIN(bzz[k8]); PIN(svv[k8]); PIN(sbb[k8]); }
#pragma unroll
        for (int k8 = 0; k8 < 8; ++k8) { const int idx = lane + 64 * k8, t = idx >> 5, c4 = (idx & 31) * 4; const size_t row = (size_t)(row0 + T0 + t);
            *(LAS f32x4*)(U + t * 256 + ((((128 + c4) >> 2) ^ t) << 2)) = uu[k8] + bzz[k8];
            u32x2 w; w.x = pk2c(bflo(sbb[k8].x) * svv[k8][0], bfhi(sbb[k8].x) * svv[k8][1]); w.y = pk2c(bflo(sbb[k8].y) * svv[k8][2], bfhi(sbb[k8].y) * svv[k8][3]);
            *(u32x2*)(MIX + row * D + 512 + 128 + c4) = w; }
    }
    LDS_WAIT(); asm volatile("" ::: "memory");
    {
        int lane = lane0; asm volatile("" : "+v"(lane));
        const int t = lane >> 2, qd = lane & 3;
        f32x4 lgv[16], lbv[16];
        { const float* lg = a.in[I_CONFG] + l * 256 + 64 * qd; const float* lb = a.in[I_CONFBETA] + l * 256 + 64 * qd;
#pragma unroll
            for (int i = 0; i < 16; ++i) { lgv[i] = *(const f32x4*)(lg + 4 * i); lbv[i] = *(const f32x4*)(lb + 4 * i); }
#pragma unroll
            for (int i = 0; i < 16; ++i) { PIN(lgv[i]); PIN(lbv[i]); } }
        f32x4 v[16]; float s1 = 0.f;
#pragma unroll
        for (int i = 0; i < 16; ++i) { v[i] = *(const LAS f32x4*)(U + t * 256 + (((16 * qd + i) ^ t) << 2)); s1 += (v[i][0] + v[i][1]) + (v[i][2] + v[i][3]); }
        s1 += __shfl_xor(s1, 1); s1 += __shfl_xor(s1, 2);
        const float mean = s1 * (1.0f / 256.0f); float s2 = 0.f;
#pragma unroll
        for (int i = 0; i < 16; ++i) { v[i] = v[i] - mean; s2 += (v[i][0] * v[i][0] + v[i][1] * v[i][1]) + (v[i][2] * v[i][2] + v[i][3] * v[i][3]); }
        s2 += __shfl_xor(s2, 1); s2 += __shfl_xor(s2, 2);
        const float rstd = rsqrtf(s2 * (1.0f / 256.0f) + EPS);
        bf16_t* dst = MIX + (size_t)(row0 + T0 + t) * D + 256 + 64 * qd;
#pragma unroll
        for (int i = 0; i < 16; i += 2) { const f32x4 g0 = lgv[i], g1 = lgv[i + 1], b0 = lbv[i], b1 = lbv[i + 1];
            const f32x4 y0 = v[i] * rstd * g0 + b0, y1 = v[i + 1] * rstd * g1 + b1;
            u32x4 w; w.x = pk2c(siluf_(y0[0]), siluf_(y0[1])); w.y = pk2c(siluf_(y0[2]), siluf_(y0[3])); w.z = pk2c(siluf_(y1[0]), siluf_(y1[1])); w.w = pk2c(siluf_(y1[2]), siluf_(y1[3]));
            *(u32x4*)(dst + 4 * i) = w; }
    }
    LDS_WAIT(); asm volatile("" ::: "memory");
}
__device__ __forceinline__ void mixer_pool_item(const Args& a, int l, int tile, int g, int lane0) {
    const bf16_t* COLS = (const bf16_t*)(a.ws + WS_COLS); bf16_t* MIX = (bf16_t*)(a.ws + WS_MIX);
    const f32x16 zero16 = {0.f, 0.f, 0.f, 0.f, 0.f, 0.f, 0.f, 0.f, 0.f, 0.f, 0.f, 0.f, 0.f, 0.f, 0.f, 0.f};
    const int row0 = tile * 64;
    {
        int lane = lane0; asm volatile("" : "+v"(lane));
        const int r = lane & 31, hf = lane >> 5, hw = 1 << g;
        const bf16_t* pwt = (const bf16_t*)(a.ws + WS_PWT) + (size_t)(l * 4 + g) * 4096;
        const u32x4* band = (const u32x4*)(a.ws + WS_BAND) + (size_t)g * 512 + lane;
        f32x16 Y[2][2] = {{zero16, zero16}, {zero16, zero16}};
        bf16x8 Ax[2][4], Bw[2][4]; u32x4 Bb[8];
#pragma unroll
        for (int mt = 0; mt < 2; ++mt)
#pragma unroll
            for (int ks = 0; ks < 4; ++ks) { Ax[mt][ks] = *(const bf16x8*)(COLS + (size_t)(row0 + 32 * mt + r) * NINP + C_PL + 64 * g + 16 * ks + 8 * hf);
                Bw[mt][ks] = *(const bf16x8*)(pwt + (size_t)(32 * mt + r) * 64 + 16 * ks + 8 * hf); }
#pragma unroll
        for (int f = 0; f < 8; ++f) Bb[f] = band[f * 64];
        f32x4 psv[2][4];
#pragma unroll
        for (int ntd = 0; ntd < 2; ++ntd)
#pragma unroll
            for (int q = 0; q < 4; ++q) psv[ntd][q] = *(const f32x4*)(a.in[I_POOLS] + l * 256 + 64 * g + 32 * ntd + 8 * q + 4 * hf);
#pragma unroll
        for (int mt = 0; mt < 2; ++mt)
#pragma unroll
            for (int ks = 0; ks < 4; ++ks) { PIN(Ax[mt][ks]); PIN(Bw[mt][ks]); }
#pragma unroll
        for (int f = 0; f < 8; ++f) PIN(Bb[f]);
#pragma unroll
        for (int ntd = 0; ntd < 2; ++ntd)
#pragma unroll
            for (int q = 0; q < 4; ++q) PIN(psv[ntd][q]);
#pragma unroll
        for (int mt = 0; mt < 2; ++mt) {
#pragma unroll
            for (int ntd = 0; ntd < 2; ++ntd) {
                f32x16 z = zero16;
#pragma unroll
                for (int ks = 0; ks < 4; ++ks) z = MFMA32(Ax[mt][ks], Bw[ntd][ks], z);
#pragma unroll
                for (int sq = 0; sq < 2; ++sq) {
                    const float t8[8] = {z[8 * sq], z[8 * sq + 1], z[8 * sq + 2], z[8 * sq + 3], z[8 * sq + 4], z[8 * sq + 5], z[8 * sq + 6], z[8 * sq + 7]};
                    bf16x8 Zh, Zl; split8(t8, Zh, Zl);
#pragma unroll
                    for (int ntt = 0; ntt < 2; ++ntt) { const bf16x8 Bq = __builtin_bit_cast(bf16x8, Bb[(mt * 2 + ntt) * 2 + sq]);
                        Y[ntd][ntt] = MFMA32(Zh, Bq, Y[ntd][ntt]); Y[ntd][ntt] = MFMA32(Zl, Bq, Y[ntd][ntt]); }
                }
            }
        }
#pragma unroll
        for (int ntt = 0; ntt < 2; ++ntt) { const int t = 32 * ntt + r; int lo = t - hw, hi = t + hw; lo = lo < 0 ? 0 : lo; hi = hi > 64 ? 64 : hi; const float inv = 1.0f / (float)(hi - lo);
#pragma unroll
            for (int ntd = 0; ntd < 2; ++ntd)
#pragma unroll
                for (int q = 0; q < 4; ++q) { const int dd0 = 32 * ntd + 8 * q + 4 * hf; const f32x4 ps = psv[ntd][q];
                    u32x2 w; w.x = pk2c(Y[ntd][ntt][4 * q] * inv * ps[0], Y[ntd][ntt][4 * q + 1] * inv * ps[1]); w.y = pk2c(Y[ntd][ntt][4 * q + 2] * inv * ps[2], Y[ntd][ntt][4 * q + 3] * inv * ps[3]);
                    *(u32x2*)(MIX + (size_t)(row0 + t) * D + 768 + 64 * g + dd0) = w; } }
    }
}

__device__ __forceinline__ void mixer_local(const Args& a, int l, int tile, int half, LAS unsigned char* lds) {
    const int tid = tid_now();
    const bf16_t* COLS = (const bf16_t*)(a.ws + WS_COLS); bf16_t* MIX = (bf16_t*)(a.ws + WS_MIX);
    LAS float* AG = (LAS float*)lds;
    LAS float* U = AG + 7936;
    LAS float* CX = U + 8192;
    const bool lat = tile < 512; const int r0 = tile * 64 + half * 32;
    const int seq_lo = lat ? tile * 64 : (NLAT + ((tile - 512) >> 2) * CTXL), seq_hi = lat ? tile * 64 + 64 : seq_lo + CTXL;
    const float* confw = a.in[I_CONFW] + (size_t)l * 31 * 256; const float* scw = a.in[I_SCW] + (size_t)l * 3 * 256;
    const int npass = lat ? 1 : 2;
    for (int ps = 0; ps < npass; ++ps) {
        const int chb = ps * 128;
        for (int idx = tid; idx < 62 * 16; idx += 512) { const int tt = idx >> 4, c8 = (idx & 15) * 8, r = r0 - 15 + tt;
            float o[8] = {0.f, 0.f, 0.f, 0.f, 0.f, 0.f, 0.f, 0.f};
            if (r >= seq_lo && r < seq_hi) { const bf16_t* rp = COLS + (size_t)r * NINP; float fa[8], fg[8]; unpack8(*(const u32x4*)(rp + C_CA + chb + c8), fa); unpack8(*(const u32x4*)(rp + C_CG + chb + c8), fg);
#pragma unroll
                for (int i = 0; i < 8; ++i) o[i] = fa[i] * sigmoidf_(fg[i]); }
            *(LAS f32x4*)(AG + tt * 128 + c8) = (f32x4){o[0], o[1], o[2], o[3]}; *(LAS f32x4*)(AG + tt * 128 + c8 + 4) = (f32x4){o[4], o[5], o[6], o[7]}; }
        for (int idx = tid; idx < 34 * 16; idx += 512) { const int tt = idx >> 4, c8 = (idx & 15) * 8, r = r0 - 1 + tt;
            float o[8] = {0.f, 0.f, 0.f, 0.f, 0.f, 0.f, 0.f, 0.f};
            if (r >= seq_lo && r < seq_hi) { const bf16_t* rp = COLS + (size_t)r * NINP; float fc[8], fx[8]; unpack8(*(const u32x4*)(rp + C_SC + chb + c8), fc); unpack8(*(const u32x4*)(rp + C_SX + chb + c8), fx);
#pragma unroll
                for (int i = 0; i < 8; ++i) o[i] = fc[i] * fx[i]; }
            *(LAS f32x4*)(CX + tt * 128 + c8) = (f32x4){o[0], o[1], o[2], o[3]}; *(LAS f32x4*)(CX + tt * 128 + c8 + 4) = (f32x4){o[4], o[5], o[6], o[7]}; }
        __syncthreads();
        { const int c = tid & 127, t0 = (tid >> 7) * 8;
            float wv[31];
#pragma unroll
            for (int j = 0; j < 31; ++j) wv[j] = confw[j * 256 + chb + c];
            const float bias = a.in[I_CONFB][l * 256 + chb + c];
            const float w0 = scw[chb + c], w1 = scw[256 + chb + c], w2 = scw[512 + chb + c];
            float o[8];
#pragma unroll
            for (int q = 0; q < 8; ++q) o[q] = bias;
#pragma unroll
            for (int j = 0; j < 38; ++j) { const float x = AG[(t0 + j) * 128 + c];
#pragma unroll
                for (int q = 0; q < 8; ++q) { if (j - q >= 0 && j - q < 31) o[q] += x * wv[j - q]; } }
#pragma unroll
            for (int q = 0; q < 8; ++q) U[(t0 + q) * 256 + chb + c] = o[q];
            unsigned sbr[8];
#pragma unroll
            for (int q = 0; q < 8; ++q) sbr[q] = COLS[(size_t)(r0 + t0 + q) * NINP + C_SB + chb + c];
#pragma unroll
            for (int q = 0; q < 8; ++q) PIN(sbr[q]);
#pragma unroll
            for (int q = 0; q < 8; ++q) { const int t = t0 + q; const float cv = CX[t * 128 + c] * w0 + CX[(t + 1) * 128 + c] * w1 + CX[(t + 2) * 128 + c] * w2;
                const float sb = __uint_as_float(sbr[q] << 16);
                MIX[(size_t)(r0 + t) * D + 512 + chb + c] = (bf16_t)(pk2(sb * cv, 0.f) & 0xffffu); }
        }
        __syncthreads();
    }
    if (lat) {
        const float* UV = (const float*)(a.ws + WS_UV); const float* SCV = (const float*)(a.ws + WS_SCV);
        for (int idx = tid; idx < 32 * 32; idx += 512) { const int t = idx >> 5, c4 = (idx & 31) * 4;
            const f32x4 u = *(const f32x4*)(UV + (size_t)(r0 + t) * 128 + c4), bz = *(const f32x4*)(a.in[I_CONFB] + l * 256 + 128 + c4);
            *(LAS f32x4*)(U + t * 256 + 128 + c4) = u + bz;
            const f32x4 sv = *(const f32x4*)(SCV + (size_t)(r0 + t) * 128 + c4);
            const u32x2 sbw = *(const u32x2*)(COLS + (size_t)(r0 + t) * NINP + C_SB + 128 + c4);
            u32x2 w; w.x = pk2(bflo(sbw.x) * sv[0], bfhi(sbw.x) * sv[1]); w.y = pk2(bflo(sbw.y) * sv[2], bfhi(sbw.y) * sv[3]);
            *(u32x2*)(MIX + (size_t)(r0 + t) * D + 512 + 128 + c4) = w; }
        __syncthreads();
    }
    { const int t = tid >> 4, c0 = (tid & 15) * 16;
        float s = 0.f;
#pragma unroll
        for (int i = 0; i < 16; i += 4) { const f32x4 v = *(const LAS f32x4*)(U + t * 256 + c0 + i); s += (v[0] + v[1]) + (v[2] + v[3]); }
        s += __shfl_xor(s, 1); s += __shfl_xor(s, 2); s += __shfl_xor(s, 4); s += __shfl_xor(s, 8);
        const float mean = s * (1.0f / 256.0f); float q = 0.f;
#pragma unroll
        for (int i = 0; i < 16; i += 4) { const f32x4 v = *(const LAS f32x4*)(U + t * 256 + c0 + i) - mean; q += (v[0] * v[0] + v[1] * v[1]) + (v[2] * v[2] + v[3] * v[3]); }
        q += __shfl_xor(q, 1); q += __shfl_xor(q, 2); q += __shfl_xor(q, 4); q += __shfl_xor(q, 8);
        const float rstd = rsqrtf(q * (1.0f / 256.0f) + EPS);
        const float* lg = a.in[I_CONFG] + l * 256 + c0; const float* lb = a.in[I_CONFBETA] + l * 256 + c0;
#pragma unroll
        for (int i = 0; i < 16; i += 8) { float y[8];
#pragma unroll
            for (int k = 0; k < 8; ++k) y[k] = siluf_((U[t * 256 + c0 + i + k] - mean) * rstd * lg[i + k] + lb[i + k]);
            u32x4 w; w.x = pk2(y[0], y[1]); w.y = pk2(y[2], y[3]); w.z = pk2(y[4], y[5]); w.w = pk2(y[6], y[7]);
            *(u32x4*)(MIX + (size_t)(r0 + t) * D + 256 + c0 + i) = w; }
    }
    __syncthreads();
    for (int hf = 0; hf < 2; ++hf) {
        LAS float* PI = (LAS float*)lds;
        LAS float* DF = PI + 6144;
        LAS float* PW = DF + 4224;
        for (int idx = tid; idx < 48 * 16; idx += 512) { const int tt = idx >> 4, c8 = (idx & 15) * 8, r = r0 - 8 + tt;
            float o[8] = {0.f, 0.f, 0.f, 0.f, 0.f, 0.f, 0.f, 0.f};
            if (r >= seq_lo && r < seq_hi) unpack8(*(const u32x4*)(COLS + (size_t)r * NINP + C_PL + hf * 128 + c8), o);
            *(LAS f32x4*)(PI + tt * 128 + c8) = (f32x4){o[0], o[1], o[2], o[3]}; *(LAS f32x4*)(PI + tt * 128 + c8 + 4) = (f32x4){o[4], o[5], o[6], o[7]}; }
        for (int idx = tid; idx < 2 * 64 * 64 / 4; idx += 512) *(LAS f32x4*)(PW + idx * 4) = *(const f32x4*)(a.in[I_POOLW] + (size_t)l * 4 * 4096 + (size_t)hf * 2 * 4096 + idx * 4);
        __syncthreads();
        for (int idx = tid; idx < 32 * 128; idx += 512) { const int t = idx >> 7, c = idx & 127, g = hf * 2 + (c >> 6); const int hw = 1 << g;
            const int r = r0 + t; int lo = r - hw, hi = r + hw; lo = lo < seq_lo ? seq_lo : lo; hi = hi > seq_hi ? seq_hi : hi;
            float sm = 0.f; for (int rr = lo; rr < hi; ++rr) sm += PI[(rr - r0 + 8) * 128 + c];
            DF[t * 132 + c] = sm / (float)(hi - lo) - PI[(t + 8) * 128 + c]; }
        __syncthreads();
        { const int gl = tid >> 8, tp = (tid >> 4) & 15, dq = tid & 15; const int dd0 = dq * 4;
            f32x4 o[2] = {(f32x4){0.f, 0.f, 0.f, 0.f}, (f32x4){0.f, 0.f, 0.f, 0.f}};
#pragma unroll 2
            for (int c4 = 0; c4 < 64; c4 += 4) { f32x4 dv[2];
#pragma unroll
                for (int x = 0; x < 2; ++x) dv[x] = *(const LAS f32x4*)(DF + (tp * 2 + x) * 132 + gl * 64 + c4);
#pragma unroll
                for (int q = 0; q < 4; ++q) { const f32x4 wv = *(const LAS f32x4*)(PW + (gl * 64 + c4 + q) * 64 + dd0);
#pragma unroll
                    for (int x = 0; x < 2; ++x) o[x] += dv[x][q] * wv; } }
            const int ch = (hf * 2 + gl) * 64 + dd0; const f32x4 ps = *(const f32x4*)(a.in[I_POOLS] + l * 256 + ch);
#pragma unroll
            for (int x = 0; x < 2; ++x) { u32x2 w; w.x = pk2(o[x][0] * ps[0], o[x][1] * ps[1]); w.y = pk2(o[x][2] * ps[2], o[x][3] * ps[3]);
                *(u32x2*)(MIX + (size_t)(r0 + tp * 2 + x) * D + 768 + ch) = w; } }
        __syncthreads();
    }
}

__device__ __forceinline__ void phase_mixer(const Args& a, int l, LAS unsigned char* lds) {
    const int ntile = (l == 1) ? 512 : NCHUNK;
    { const int tid = tid_now(), lane = tid & 63, wid = __builtin_amdgcn_readfirstlane(tid >> 6);
        LAS bf16_t* vT = (LAS bf16_t*)(lds + wid * 16384);
        LAS int* ctr = (LAS int*)(lds + MISC_OFF + 16);
        if (tid == 0) *ctr = 0;
        __syncthreads();
        const int b = blockIdx.x, G = gridDim.x, nL = b < 512 ? (511 - b) / G + 1 : 0, cx = (l == 0 && (G >= 48 ? (b >= 32 && b < 48) : (b < 16))) ? 1 : 0, cxt = 512 + (G >= 48 ? b - 32 : b);
        for (;;) { int j = next_item(ctr, lane);
            if (j < 4 * nL) { mixer_gla_item(a, l, b + G * (j >> 2), j & 3, lane, vT); continue; }
            j -= 4 * nL;
            if (j < 4 * cx) { mixer_gla_item(a, l, cxt, j & 3, lane, vT); continue; }
            j -= 4 * cx;
            if (j < 4 * nL) { mixer_conv_item(a, l, b + G * (j >> 2), j & 3, lane, (LAS float*)vT); continue; }
            j -= 4 * nL; if (j >= 4 * nL) break;
            mixer_pool_item(a, l, b + G * (j >> 2), j & 3, lane); } }
    if (l == 0) {
        if ((int)gridDim.x > 32 && (int)blockIdx.x >= 32) convert_range(a, lds, CV_E0 + CV_P0_E0, CV_G, (int)blockIdx.x - 32, (int)gridDim.x - 32);
        else { if ((int)gridDim.x <= 32) convert_range(a, lds, CV_E0 + CV_P0_E0, CV_G, (int)blockIdx.x, (int)gridDim.x);
            __syncthreads();
            for (int it = blockIdx.x; it < 16 * 2; it += gridDim.x) mixer_local(a, l, 512 + (it >> 1), it & 1, lds); }
    }
}

__device__ __forceinline__ void phase_router(const Args& a, int l, LAS unsigned char* lds) {
    const int tid = tid_now(), lane = tid & 63, wid = tid >> 6;
    const int M = (l == 1) ? NLAT : MTOT;
    const float* MOD = (const float*)(a.ws + WS_MOD) + (size_t)l * 5 * 6144; unsigned char* H = a.ws + WS_H;
    LAS float* WRE = (LAS float*)lds;
    LAS int* INFO = (LAS int*)(lds + MISC_OFF + 4096);
    LAS int* HIST = (LAS int*)(lds + MISC_OFF + 2048);
    const float* wre = a.in[I_RWE] + (size_t)l * 1024 * 32; const float* wrgT = (const float*)(a.ws + WS_TAB) + (size_t)l * 4096;
    for (int i = tid; i < 1024 * 8; i += 512) { const int k = i >> 3, q = i & 7; const f32x4 w = *(const f32x4*)(wre + k * 32 + q * 4);
        WRE[(4 * q + 0) * 1024 + k] = w[0]; WRE[(4 * q + 1) * 1024 + k] = w[1]; WRE[(4 * q + 2) * 1024 + k] = w[2]; WRE[(4 * q + 3) * 1024 + k] = w[3]; }
    if (tid < 64) HIST[tid] = 0;
    __syncthreads();
    const int per = (M + gridDim.x - 1) / gridDim.x; const int r_lo = blockIdx.x * per; int r_hi = r_lo + per; if (r_hi > M) r_hi = M;
    const float rbg0 = a.in[I_RBG][l * 4 + 0], rbg1 = a.in[I_RBG][l * 4 + 1], rbg2 = a.in[I_RBG][l * 4 + 2], rbg3 = a.in[I_RBG][l * 4 + 3];
    bf16_t* XB = (bf16_t*)(a.ws + WS_XB); const bf16_t* Y1 = (const bf16_t*)(a.ws + WS_Y);
    int cur_b = -1; f32x4 GS[4], SH[4], GA[4], WGT[4][4];
#pragma unroll
    for (int g = 0; g < 4; ++g)
#pragma unroll
        for (int j = 0; j < 4; ++j) WGT[g][j] = *((const f32x4*)(wrgT + g * 1024) + lane + 64 * j);
    for (int rp = 0; rp < ((REP_SUB == 7 && l == 0) ? 2 : 1); ++rp)
#pragma unroll 1
    for (int mm = r_lo + wid; mm < r_hi; mm += 16) {
        f32x4 vv[2][4]; u32x2 yy[2][4]; int mrow[2]; bool has[2];
#pragma unroll
        for (int rr = 0; rr < 2; ++rr) { const int m = mm + 8 * rr; has[rr] = m < r_hi; const int mc = has[rr] ? m : mm; mrow[rr] = mc;
            if (l == 0) load_row(mc < NLAT ? a.in[I_X] + (size_t)mc * D : a.in[I_CTX] + (size_t)(mc - NLAT) * D, lane, vv[rr]);
            else load_row_bf(XB + (size_t)mc * D, lane, vv[rr]);
#pragma unroll
            for (int j = 0; j < 4; ++j) yy[rr][j] = *((const u32x2*)(Y1 + (size_t)mc * D) + lane + 64 * j); }
#pragma unroll
        for (int rr = 0; rr < 2; ++rr) {
            if (!has[rr]) continue;
            const int m = mrow[rr]; const int b = m < NLAT ? (m >> 13) : 4;
            if (b != cur_b) { const float* mod = MOD + (size_t)b * 6144; load_mod_cached(a.in[I_G2] + l * 1024, mod + 4 * 1024, mod + 3 * 1024, mod + 2 * 1024, lane, GS, SH, GA); cur_b = b; }
            f32x4 v[4];
#pragma unroll
            for (int j = 0; j < 4; ++j) { const u32x2 y = yy[rr][j]; v[j] = vv[rr][j] + GA[j] * (f32x4){bflo(y.x), bfhi(y.x), bflo(y.y), bfhi(y.y)}; }
            store_row_bf(XB + (size_t)m * D, lane, v);
            const float rstd = row_rstd(v);
            norm_store_cached8(v, rstd, GS, SH, H + (size_t)m * D, lane);
            float ga_[4] = {0.f, 0.f, 0.f, 0.f};
#pragma unroll
            for (int g = 0; g < 4; ++g)
#pragma unroll
                for (int j = 0; j < 4; ++j) { const f32x4 w = WGT[g][j]; ga_[g] += (v[j][0] * w[0] + v[j][1] * w[1]) + (v[j][2] * w[2] + v[j][3] * w[3]); }
            float lg0, lg1, lg2, lg3;
            { const bool h5 = (lane & 32) != 0, h4 = (lane & 16) != 0;
                float k0 = h5 ? ga_[2] : ga_[0], k1 = h5 ? ga_[3] : ga_[1]; const float s0 = h5 ? ga_[0] : ga_[2], s1 = h5 ? ga_[1] : ga_[3];
                k0 += __shfl_xor(s0, 32); k1 += __shfl_xor(s1, 32);
                float kk = h4 ? k1 : k0; const float sk = h4 ? k0 : k1; kk += __shfl_xor(sk, 16);
                kk += __shfl_xor(kk, 8); kk += __shfl_xor(kk, 4); kk += __shfl_xor(kk, 2); kk += __shfl_xor(kk, 1);
                lg0 = __int_as_float(__builtin_amdgcn_readlane(__float_as_int(kk), 0)) + rbg0; lg1 = __int_as_float(__builtin_amdgcn_readlane(__float_as_int(kk), 16)) + rbg1;
                lg2 = __int_as_float(__builtin_amdgcn_readlane(__float_as_int(kk), 32)) + rbg2; lg3 = __int_as_float(__builtin_amdgcn_readlane(__float_as_int(kk), 48)) + rbg3; }
            int grp = 0; float best = lg0; if (lg1 > best) { best = lg1; grp = 1; } if (lg2 > best) { best = lg2; grp = 2; } if (lg3 > best) { best = lg3; grp = 3; }
            const float pg = 1.0f / (__expf(lg0 - best) + __expf(lg1 - best) + __expf(lg2 - best) + __expf(lg3 - best));
            grp = __builtin_amdgcn_readfirstlane(grp);
            float ep[8];
            { const LAS float* wb = WRE + (size_t)(grp * 8) * 1024;
#pragma unroll
                for (int i = 0; i < 8; i += 2) { f32x4 w[2][4];
#pragma unroll
                    for (int u = 0; u < 2; ++u)
#pragma unroll
                        for (int j = 0; j < 4; ++j) w[u][j] = *((const LAS f32x4*)(wb + (i + u) * 1024) + lane + 64 * j);
#pragma unroll
                    for (int u = 0; u < 2; ++u)
#pragma unroll
                        for (int j = 0; j < 4; ++j) PIN(w[u][j]);
#pragma unroll
                    for (int u = 0; u < 2; ++u) { float acc_ = 0.f;
#pragma unroll
                        for (int j = 0; j < 4; ++j) acc_ += (v[j][0] * w[u][j][0] + v[j][1] * w[u][j][1]) + (v[j][2] * w[u][j][2] + v[j][3] * w[u][j][3]);
                        ep[i + u] = acc_; } } }
            float le[8];
            { const bool h5 = (lane & 32) != 0, h4 = (lane & 16) != 0, h3 = (lane & 8) != 0;
                float k4[4];
#pragma unroll
                for (int i = 0; i < 4; ++i) { const float keep = h5 ? ep[4 + i] : ep[i], send = h5 ? ep[i] : ep[4 + i]; k4[i] = keep + __shfl_xor(send, 32); }
                float k2[2];
#pragma unroll
                for (int i = 0; i < 2; ++i) { const float keep = h4 ? k4[2 + i] : k4[i], send = h4 ? k4[i] : k4[2 + i]; k2[i] = keep + __shfl_xor(send, 16); }
                float kk = h3 ? k2[1] : k2[0]; const float sk = h3 ? k2[0] : k2[1]; kk += __shfl_xor(sk, 8);
                kk += __shfl_xor(kk, 4); kk += __shfl_xor(kk, 2); kk += __shfl_xor(kk, 1);
#pragma unroll
                for (int i = 0; i < 8; ++i) le[i] = __int_as_float(__builtin_amdgcn_readlane(__float_as_int(kk), 8 * i)) + a.in[I_RBE][l * 32 + grp * 8 + i]; }
            int i0 = 0; float v0 = le[0];
#pragma unroll
            for (int i = 1; i < 8; ++i) if (le[i] > v0) { v0 = le[i]; i0 = i; }
            int i1 = -1; float v1 = -3.0e38f;
#pragma unroll
            for (int i = 0; i < 8; ++i) if (i != i0 && le[i] > v1) { v1 = le[i]; i1 = i; }
            const float w0 = 1.0f / (1.0f + __expf(v1 - v0)); const float w1 = 1.0f - w0;
            if (lane == 0) { const int lr = m - r_lo; INFO[lr * 4 + 0] = grp * 8 + i0; INFO[lr * 4 + 1] = grp * 8 + i1; INFO[lr * 4 + 2] = __float_as_int(w0 * pg); INFO[lr * 4 + 3] = __float_as_int(w1 * pg); }
        }
    }
    __syncthreads();
    const int nr = r_hi - r_lo; int lp0 = 0, lp1 = 0, ee0 = 0, ee1 = 0;
    if (tid < nr) { ee0 = INFO[tid * 4 + 0]; ee1 = INFO[tid * 4 + 1]; lp0 = atomicAdd((int*)(HIST + ee0), 1); lp1 = atomicAdd((int*)(HIST + ee1), 1); }
    __syncthreads();
    unsigned* cnt = (unsigned*)(a.ws + WS_CTL) + CW_CNT + l * 32 * 64;
    if (tid < 32) { const int c = HIST[tid]; HIST[32 + tid] = c ? (int)atomicAdd(cnt + tid * 64, (unsigned)c) : 0; }
    __syncthreads();
    if (tid < nr) { const int m = r_lo + tid; const int p0 = HIST[32 + ee0] + lp0, p1 = HIST[32 + ee1] + lp1;
        int* TL = (int*)(a.ws + WS_TOKLIST); TL[ee0 * MTOT + p0] = m; TL[ee1 * MTOT + p1] = m;
        *((i32x4*)(a.ws + WS_TOKINFO) + m) = (i32x4){(ee0 << 20) | p0, (ee1 << 20) | p1, INFO[tid * 4 + 2], INFO[tid * 4 + 3]}; }
    __syncthreads();
}

__device__ __forceinline__ int moe_tables(const Args& a, int l, LAS unsigned char* lds) {
    LAS int* TB = (LAS int*)(lds + MISC_OFF + 256); LAS int* CN = TB + 64; LAS int* TE = (LAS int*)(lds + MISC_OFF + 1024); LAS int* TM = TE + 320;
    const unsigned* cnt = (const unsigned*)(a.ws + WS_CTL) + CW_CNT + l * 32 * 64;
    { const int tq_ = tid_now(); if (tq_ < 32) CN[tq_] = (int)__hip_atomic_load(cnt + tq_ * 64, __ATOMIC_RELAXED, __HIP_MEMORY_SCOPE_AGENT); }
    __syncthreads();
    if (tid_now() == 0) { int t = 0;
#pragma unroll 1
        for (int e = 0; e < 32; ++e) { TB[e] = t; const int nt = (CN[e] + 255) >> 8;
#pragma unroll 1
            for (int q = 0; q < nt; ++q) { TE[t + q] = e; TM[t + q] = q; } t += nt; } TB[32] = t; }
    __syncthreads();
    return __builtin_amdgcn_readfirstlane(TB[32]);
}

__device__ __forceinline__ void phase_combine(const Args& a, int l, LAS unsigned char* lds) {
    const int lane = tid_now() & 63, wid = tid_now() >> 6, gw = blockIdx.x * 8 + wid, NGW = gridDim.x * 8;
    const int M = (l == 1) ? NLAT : MTOT;
    (void)moe_tables(a, l, lds);
    const LAS int* TB = (const LAS int*)(lds + MISC_OFF + 256);
    const float* MOD = (const float*)(a.ws + WS_MOD); const unsigned char* Y = (const unsigned char*)(a.ws + WS_Y); bf16_t* H = (bf16_t*)(a.ws + WS_H);
    bf16_t* XB = (bf16_t*)(a.ws + WS_XB);
    int cur_b = -1; f32x4 GS[4], SH[4], GA[4];
#pragma unroll 1
    for (int mm = gw; mm < M; mm += 2 * NGW) {
        f32x4 vv[2][4]; unsigned ya[2][4], yb[2][4]; i32x4 inf[2]; int mrow[2]; bool has[2];
#pragma unroll
        for (int rr = 0; rr < 2; ++rr) { const int m = mm + rr * NGW; has[rr] = m < M; const int mc = has[rr] ? m : mm; mrow[rr] = mc;
            inf[rr] = *((const i32x4*)(a.ws + WS_TOKINFO) + mc);
            load_row_bf(XB + (size_t)mc * D, lane, vv[rr]); }
#pragma unroll
        for (int rr = 0; rr < 2; ++rr) { const int e0 = inf[rr].x >> 20, p0 = inf[rr].x & 0xfffff, e1 = inf[rr].y >> 20, p1 = inf[rr].y & 0xfffff;
            const unsigned char* y0 = Y + (size_t)(TB[e0] * 256 + p0) * D; const unsigned char* y1 = Y + (size_t)(TB[e1] * 256 + p1) * D;
#pragma unroll
            for (int j = 0; j < 4; ++j) { ya[rr][j] = *((const unsigned*)y0 + lane + 64 * j); yb[rr][j] = *((const unsigned*)y1 + lane + 64 * j); } }
#pragma unroll
        for (int rr = 0; rr < 2; ++rr) {
            if (!has[rr]) continue;
            const int m = mrow[rr]; const int b = m < NLAT ? (m >> 13) : 4;
            const float w0s = __int_as_float(inf[rr].z) * (1.0f / 16.0f), w1s = __int_as_float(inf[rr].w) * (1.0f / 16.0f);
            if (b != cur_b) { const float* ga2 = MOD + (size_t)(l * 5 + b) * 6144 + 5 * 1024;
                if (l == 0) { const float* mod = MOD + (size_t)(5 + b) * 6144; load_mod_cached(a.in[I_G1] + 1024, mod + 1024, mod, ga2, lane, GS, SH, GA); }
                else {
#pragma unroll
                    for (int j = 0; j < 4; ++j) { GS[j] = *((const f32x4*)a.in[I_GFINAL] + lane + 64 * j); SH[j] = (f32x4){0.f, 0.f, 0.f, 0.f}; GA[j] = *((const f32x4*)ga2 + lane + 64 * j); } }
                cur_b = b; }
            f32x4 v[4];
#pragma unroll
            for (int j = 0; j < 4; ++j) { const int a0 = (int)ya[rr][j], a1 = (int)yb[rr][j];
                f32x4 y; y[0] = w0s * __builtin_amdgcn_cvt_f32_fp8(a0, 0) + w1s * __builtin_amdgcn_cvt_f32_fp8(a1, 0); y[1] = w0s * __builtin_amdgcn_cvt_f32_fp8(a0, 1) + w1s * __builtin_amdgcn_cvt_f32_fp8(a1, 1);
                y[2] = w0s * __builtin_amdgcn_cvt_f32_fp8(a0, 2) + w1s * __builtin_amdgcn_cvt_f32_fp8(a1, 2); y[3] = w0s * __builtin_amdgcn_cvt_f32_fp8(a0, 3) + w1s * __builtin_amdgcn_cvt_f32_fp8(a1, 3);
                v[j] = vv[rr][j] + GA[j] * y; }
            const float rstd = row_rstd(v);
            if (l == 0) {
                store_row_bf(XB + (size_t)m * D, lane, v);
                norm_store_cached(v, rstd, GS, SH, H + (size_t)m * D, lane);
            } else {
                float* xr = a.out + (size_t)m * D;
#pragma unroll
                for (int j = 0; j < 4; ++j) *((f32x4*)xr + lane + 64 * j) = (v[j] * rstd) * GS[j];
            }
        }
    }
}

#define XB_TMO      128
#define XB_XCNT(j)  (256  + 64 * (j))
#define XB_XSUB(j)  (1280 + 64 * (j))
#define XB_XGEN(j)  (2304 + 64 * (j))
#define XB_TOP      3328
#define XB_TOPGEN   3392
#define XCD_BAR_WORDS 3456
#define XB_SPIN_CAP (1u << 22)
__device__ __forceinline__ unsigned xb_ld(unsigned* p)              { return __hip_atomic_load(p, __ATOMIC_RELAXED, __HIP_MEMORY_SCOPE_AGENT); }
__device__ __forceinline__ unsigned xb_add(unsigned* p, unsigned v) { return __hip_atomic_fetch_add(p, v, __ATOMIC_RELAXED, __HIP_MEMORY_SCOPE_AGENT); }
__device__ __forceinline__ unsigned xb_xcc_id() { return (unsigned)__builtin_amdgcn_s_getreg((3 << 11) | 20) & 0xFu; }
#define XB_SPIN(cond, bar) do { unsigned _sp = 0; while (cond) { __builtin_amdgcn_s_sleep(1); \
    if ((++_sp & 255u) == 0u) { if (xb_ld(&(bar)[XB_TMO])) break; if (_sp > XB_SPIN_CAP) { atomicAdd(&(bar)[XB_TMO], 1u); break; } } } } while (0)
struct XcdBarrier { unsigned* bar; unsigned x; volatile LAS unsigned* st; };
__device__ __forceinline__ XcdBarrier xcd_barrier_post(unsigned* bar, volatile LAS unsigned* st) {
    XcdBarrier b; b.bar = bar; b.x = xb_xcc_id(); b.st = st;
    if (threadIdx.x == 0) (void)xb_add(&bar[XB_XCNT(b.x)], 1u);
    return b;
}
__device__ __forceinline__ void xcd_barrier_complete(unsigned* bar, unsigned x, unsigned& nloc, unsigned& nx) {
    const unsigned G = gridDim.x * gridDim.y * gridDim.z;
    unsigned sum, cnt, mine, sp = 0u;
    for (;;) {
        sum = 0u; cnt = 0u; mine = 0u;
#pragma unroll
        for (unsigned j = 0; j < 16; ++j) { const unsigned c = xb_ld(&bar[XB_XCNT(j)]); sum += c; cnt += (c > 0u) ? 1u : 0u; mine = (j == x) ? c : mine; }
        if (sum == G) break;
        __builtin_amdgcn_s_sleep(1);
        if ((++sp & 255u) == 0u) { if (xb_ld(&bar[XB_TMO])) break; if (sp > XB_SPIN_CAP) { atomicAdd(&bar[XB_TMO], 1u); break; } }
    }
    nloc = mine > 0u ? mine : 1u; nx = cnt > 0u ? cnt : 1u;
}
__device__ __forceinline__ void xcd_barrier(const XcdBarrier& b) {
    asm volatile("s_waitcnt vmcnt(0)" ::: "memory");
    __syncthreads();
    if (threadIdx.x == 0) {
        unsigned* bar = b.bar;
        __builtin_amdgcn_s_waitcnt(0);
        unsigned nloc = b.st[0], nx = b.st[1];
        if (nloc == 0u) { xcd_barrier_complete(bar, b.x, nloc, nx); b.st[0] = nloc; b.st[1] = nx; }
        const unsigned old = xb_add(&bar[XB_XSUB(b.x)], 1u);
        const unsigned gen = old / nloc;
        if (old + 1u == (gen + 1u) * nloc) {
            __builtin_amdgcn_fence(__ATOMIC_RELEASE, "agent");
            asm volatile("s_waitcnt vmcnt(0)" ::: "memory");
            const unsigned og = xb_add(&bar[XB_TOP], 1u);
            const unsigned tg = og / nx;
            if (og + 1u == (tg + 1u) * nx) xb_add(&bar[XB_TOPGEN], 1u);
            else XB_SPIN(xb_ld(&bar[XB_TOPGEN]) == tg, bar);
            __builtin_amdgcn_fence(__ATOMIC_ACQUIRE, "agent");
            xb_add(&bar[XB_XGEN(b.x)], 1u);
            asm volatile("s_waitcnt vmcnt(0)" ::: "memory");
        } else {
            XB_SPIN(xb_ld(&bar[XB_XGEN(b.x)]) == gen, bar);
            __builtin_amdgcn_fence(__ATOMIC_ACQUIRE, "agent");
            asm volatile("s_waitcnt vmcnt(0)" ::: "memory");
        }
    }
    __syncthreads();
}

constexpr int NPHASE = 20;
#ifndef DIAG_PH
#define DIAG_PH -1
#endif
#define PH_ON(x) (DIAG_PH < 0 || DIAG_PH == (x))
#ifndef REP_ID
#define REP_ID -1
#endif
__global__ void __launch_bounds__(512, 2) mega(Args a) {
    extern __shared__ __attribute__((aligned(16))) unsigned char lds_raw[];
    LAS unsigned char* lds = (LAS unsigned char*)lds_raw;
    unsigned char* ws = a.ws;
    volatile LAS unsigned* bst = (volatile LAS unsigned*)(lds + MISC_OFF);
    if (threadIdx.x < 2) bst[threadIdx.x] = 0u;
    __syncthreads();
    XcdBarrier xbar = xcd_barrier_post((unsigned*)(ws + WS_CTL) + CW_BAR, bst);
    unsigned long long tph_ = 0ull;
    for (int ph = a.ph_lo; ph < a.ph_hi; ++ph) {
      unsigned long long t0_ = 0ull; if (TIME_PH >= 0 && ph == TIME_PH) t0_ = __builtin_amdgcn_s_memrealtime();
      const int cls_ = ph < 2 ? ph : 2 + (ph - 2) % 9;
      const int nrep_ = (REP_ID >= 0 && cls_ == REP_ID) ? 2 : 1;
      for (int rep_ = 0; rep_ < nrep_; ++rep_) {
        if (rep_) xcd_barrier(xbar);
        if (PH_ON(0) && ph == 0) phase_p0(a, lds);
        else if (PH_ON(1) && ph == 1) phase_norm1_l0(a);
        else {
            const int l = (ph - 2) / 9, sp = (ph - 2) % 9;
            if (PH_ON(2) && sp == 0) {
                g8::DenseSched S; S.init(ws + WS_H, ws + WS_WIN + (size_t)l * NINP * 1024 * 2, MTOT, NINP, 1024, gridDim.x, blockIdx.x);
                g8::EpiBf16 E{(bf16_t*)(ws + WS_COLS), NINP};
                g8::gemm_phase<false>(lds, S, E);
                if (l == 0) convert_in_tail(a, lds, CV_E0 + CV_P0_E0 + CV_G, CV_A, S.nwg, S.G, S.c); else convert_in_tail(a, lds, CV_EI1 + CV_P0_EI1 + CV_C + CV_D, CV_E, S.nwg, S.G, S.c);
            } else if (PH_ON(3) && sp == 1) phase_chunk(a, l, lds);
            else if (PH_ON(4) && sp == 2) phase_scan(a, l, lds);
            else if (PH_ON(5) && sp == 3) phase_mixer(a, l, lds);
            else if (PH_ON(6) && sp == 4) {
                g8::DenseSched S; S.init(ws + WS_MIX, ws + WS_WOUT + (size_t)l * 1024 * 1024 * 2, l == 1 ? NLAT : MTOT, 1024, 1024, gridDim.x, blockIdx.x);
                g8::EpiBf16 E{(bf16_t*)(ws + WS_Y), 1024};
                g8::gemm_phase<false>(lds, S, E);
                if (l == 0) convert_in_tail(a, lds, CV_E0 + CV_P0_E0 + CV_G + CV_A, CV_B, S.nwg, S.G, S.c);
            } else if (PH_ON(7) && sp == 5) phase_router(a, l, lds);
            else if ((PH_ON(8) || PH_ON(9)) && (sp == 6 || sp == 7)) {
                const int T = moe_tables(a, l, lds);
                const int G = gridDim.x, bx = blockIdx.x, vcu = (G % 8 == 0) ? (bx % 8) * (G / 8) + bx / 8 : bx;
                const LAS int* TBp = (const LAS int*)(lds + MISC_OFF + 256);
                if (PH_ON(8) && sp == 6) {
                    g8::MoeSched<true> S; S.A = (const char*)(ws + WS_H); S.Bw = (const char*)(ws + WS_WEIN) + (size_t)l * 32 * 1024 * 1024; S.wstride = (size_t)1024 * 1024; S.K = 512;     S.T = T; S.G = G; S.c = vcu;
                    S.tile_e = (const LAS int*)(lds + MISC_OFF + 1024); S.tile_mt = S.tile_e + 320; S.cnt = TBp + 64; S.toklist = (const int*)(ws + WS_TOKLIST);
                    g8::EpiSwiGLU E{ws + WS_ACT};
                    g8::gemm_phase<true>(lds, S, E);
                    if (l == 0) convert_in_tail(a, lds, CV_EI1 + CV_P0_EI1, CV_C, 4 * T, G, vcu); else convert_in_tail(a, lds, CV_EO1 + CV_P0_EO1, CV_F, 4 * T, G, vcu);
                } else if (PH_ON(9) && sp == 7) {
                    g8::MoeSched<false> S; S.A = (const char*)(ws + WS_ACT); S.Bw = (const char*)(ws + WS_WEOUT) + (size_t)l * 32 * 1024 * 512; S.wstride = (size_t)1024 * 512; S.K = 256; S.T = T; S.G = G; S.c = vcu;
                    S.tile_e = (const LAS int*)(lds + MISC_OFF + 1024); S.tile_mt = S.tile_e + 320; S.cnt = TBp + 64; S.toklist = (const int*)(ws + WS_TOKLIST);
                    g8::EpiFp8 E{(unsigned char*)(ws + WS_Y)};
                    g8::gemm_phase<true>(lds, S, E);
                    if (l == 0) convert_in_tail(a, lds, CV_EI1 + CV_P0_EI1 + CV_C, CV_D, 4 * T, G, vcu);
                }
            } else if (PH_ON(10) && sp == 8) phase_combine(a, l, lds);
        }
      }
        if (ph + 1 < a.ph_hi) { if (a.ph_lo < 0) cg::this_grid().sync(); else xcd_barrier(xbar); }
        if (TIME_PH >= 0 && ph == TIME_PH) tph_ = __builtin_amdgcn_s_memrealtime() - t0_;
    }
    if (TIME_PH >= 0 && blockIdx.x == 0 && threadIdx.x == 0) { const unsigned long long te_ = __builtin_amdgcn_s_memrealtime(); while (__builtin_amdgcn_s_memrealtime() - te_ < 4ull * tph_) __builtin_amdgcn_s_sleep(8); }
}

extern "C" void kernel_launch(void* const* d_in, const int* in_sizes, int n_in, void* d_out, int out_size, void* d_ws, size_t ws_size, hipStream_t stream) {
    static int grid = 0;
    if (grid == 0) {
        if (n_in != 29 || out_size != NLAT * D || ws_size < WS_END) { fprintf(stderr, "kernel_launch: unexpected shapes (n_in %d out %d ws %zu)\n", n_in, out_size, ws_size); grid = -1; return; }
        int dev = 0, cus = 0, per_cu = 0;
        hipGetDevice(&dev); hipDeviceGetAttribute(&cus, hipDeviceAttributeMultiprocessorCount, dev);
        if (hipFuncSetAttribute((const void*)mega, hipFuncAttributeMaxDynamicSharedMemorySize, LDS_BYTES) != hipSuccess) { fprintf(stderr, "kernel_launch: hipFuncSetAttribute failed\n"); grid = -1; return; }
        if (hipOccupancyMaxActiveBlocksPerMultiprocessor(&per_cu, (const void*)mega, 512, LDS_BYTES) != hipSuccess || per_cu < 1) { fprintf(stderr, "kernel_launch: occupancy query says %d\n", per_cu); per_cu = 1; }
        (void)hipGetLastError();
        grid = cus;
    }
    if (grid < 0) return;
    hipMemsetAsync((char*)d_ws + WS_CTL, 0, CTL_BYTES, stream);
    Args a{};
    for (int i = 0; i < 29; ++i) a.in[i] = (const float*)d_in[i];
    a.out = (float*)d_out; a.ws = (unsigned char*)d_ws;
#if MK_MULTI
    for (int ph = 0; ph < NPHASE; ++ph) { a.ph_lo = ph; a.ph_hi = ph + 1; hipLaunchKernelGGL(mega, dim3(grid), dim3(512), LDS_BYTES, stream, a); }
#else
    a.ph_lo = 0; a.ph_hi = NPHASE;
    void* args[] = {&a};
    hipError_t e = hipLaunchCooperativeKernel((const void*)mega, dim3(grid), dim3(512), args, LDS_BYTES, stream);
    if (e != hipSuccess) fprintf(stderr, "cooperative launch failed: %s (grid %d)\n", hipGetErrorString(e), grid);
#endif
}
```

```cpp
#include <hip/hip_runtime.h>
#include <hip/hip_cooperative_groups.h>
#include <cstdio>
namespace cg = cooperative_groups;

#ifndef MK_MULTI
#define MK_MULTI 0
#endif

#ifndef TIME_PH
#define TIME_PH -1
#endif
#ifndef REP_SUB
#define REP_SUB 0
#endif

#define LAS __attribute__((address_space(3)))
typedef unsigned short bf16_t;
typedef short bf16x8 __attribute__((ext_vector_type(8)));
typedef float f32x4 __attribute__((ext_vector_type(4)));
typedef float f32x2 __attribute__((ext_vector_type(2)));
typedef unsigned u32x4 __attribute__((ext_vector_type(4)));
typedef unsigned u32x2 __attribute__((ext_vector_type(2)));
typedef int i32x4 __attribute__((ext_vector_type(4)));
typedef int i32x8 __attribute__((ext_vector_type(8)));

constexpr int D = 1024, NLAT = 32768, SEQ = 8192, NCTXT = 1024, CTXL = 256, MTOT = NLAT + NCTXT;
constexpr int NIN = 2336, NINP = 2560;
constexpr int NCHUNK = MTOT / 64, NSEQ = 132;
constexpr int NEXP = 32, DEXP = 512, SLOTS = 75776;
constexpr float EPS = 1e-6f;
constexpr float F8_WSC = 256.0f, F8_HSC = 16.0f, F8_ASC = 8.0f;
constexpr int C_Q = 0, C_K = 128, C_V = 256, C_G = 512, C_ZF = 768, C_ZB = 784, C_CA = 800, C_CG = 1056, C_SB = 1312, C_SC = 1568, C_SX = 1824, C_PL = 2080;

constexpr size_t MiB = 1u << 20;
constexpr size_t WS_CTL = 0, CTL_BYTES = 1 * MiB;
constexpr size_t WS_MOD = 1 * MiB;
constexpr size_t WS_TAB = 1 * MiB + 512 * 1024;
constexpr size_t WS_PWT = WS_TAB + 64 * 1024;
constexpr size_t WS_BAND = WS_TAB + 192 * 1024;
constexpr size_t WS_WIN = 2 * MiB;
constexpr size_t WS_WOUT = 12 * MiB;
constexpr size_t WS_WEIN = 16 * MiB;
constexpr size_t WS_WEOUT = 144 * MiB;
constexpr size_t WS_XCTX = 208 * MiB;
constexpr size_t WS_H = 212 * MiB;
constexpr size_t WS_COLS = 278 * MiB;
constexpr size_t WS_MIX = 443 * MiB;
constexpr size_t WS_KV = 509 * MiB;
constexpr size_t WS_DEC = 542 * MiB;
constexpr size_t WS_AGV = 543 * MiB;
constexpr size_t WS_CXV = 559 * MiB;
constexpr size_t WS_UV = 575 * MiB;
constexpr size_t WS_SCV = 591 * MiB;
constexpr size_t WS_TOKINFO = 607 * MiB;
constexpr size_t WS_TOKLIST = 608 * MiB;
constexpr size_t WS_ACT = 613 * MiB;
constexpr size_t WS_Y = 687 * MiB;
constexpr size_t WS_SIN = 835 * MiB;
constexpr size_t WS_XB = 852 * MiB;
constexpr size_t WS_END = 918 * MiB;
constexpr int CW_CNT = 1024;
constexpr int CW_BAR = 8192;

constexpr int LDS_BYTES = 147456;
constexpr int MISC_OFF = 131072;

__device__ __forceinline__ unsigned pk2(float lo, float hi) { unsigned r; asm("v_cvt_pk_bf16_f32 %0, %1, %2" : "=v"(r) : "v"(lo), "v"(hi)); return r; }
__device__ __forceinline__ float bflo(unsigned w) { return __uint_as_float(w << 16); }
__device__ __forceinline__ float bfhi(unsigned w) { return __uint_as_float(w & 0xffff0000u); }
__device__ __forceinline__ void unpack8(const u32x4 w, float (&f)[8]) { f[0] = bflo(w.x); f[1] = bfhi(w.x); f[2] = bflo(w.y); f[3] = bfhi(w.y); f[4] = bflo(w.z); f[5] = bfhi(w.z); f[6] = bflo(w.w); f[7] = bfhi(w.w); }
__device__ __forceinline__ float sigmoidf_(float x) { return __builtin_amdgcn_rcpf(1.0f + __expf(-x)); }
__device__ __forceinline__ float siluf_(float x) { return x * __builtin_amdgcn_rcpf(1.0f + __expf(-x)); }
__device__ __forceinline__ float logsigf_(float x) { return fminf(x, 0.0f) - log1pf(__expf(-fabsf(x))); }
template <int CTRL> __device__ __forceinline__ float dppf(float v) { return __int_as_float(__builtin_amdgcn_update_dpp(0, __float_as_int(v), CTRL, 0xF, 0xF, true)); }
__device__ __forceinline__ float quad_sum(float v) { v += dppf<0xB1>(v); v += dppf<0x4E>(v); return v; }
__device__ __forceinline__ float oct_sum(float v) { v = quad_sum(v); v += dppf<0x141>(v); return v; }
__device__ __forceinline__ float row_sum16(float v) { v = oct_sum(v); v += dppf<0x140>(v); return v; }
__device__ __forceinline__ float swap32_add(float a, float b) { const auto r = __builtin_amdgcn_permlane32_swap(__float_as_uint(a), __float_as_uint(b), false, false); return __uint_as_float(r[0]) + __uint_as_float(r[1]); }
__device__ __forceinline__ float swap16_add(float a, float b) { const auto r = __builtin_amdgcn_permlane16_swap(__float_as_uint(a), __float_as_uint(b), false, false); return __uint_as_float(r[0]) + __uint_as_float(r[1]); }
__device__ __forceinline__ float wave_sum(float v) { v = row_sum16(v); v = swap16_add(v, v); return swap32_add(v, v); }
__device__ __forceinline__ f32x2 fma2(f32x2 a, f32x2 b, f32x2 c) { return __builtin_elementwise_fma(a, b, c); }
#define LO2(x) __builtin_shufflevector((x), (x), 0, 1)
#define HI2(x) __builtin_shufflevector((x), (x), 2, 3)

typedef float f32x16 __attribute__((ext_vector_type(16)));
typedef __bf16 bf16x2_t __attribute__((ext_vector_type(2)));
#define MFMA32(a, b, c) __builtin_amdgcn_mfma_f32_32x32x16_bf16((a), (b), (c), 0, 0, 0)
__device__ __forceinline__ unsigned pk2c(float lo, float hi) { const f32x2 v = {lo, hi}; return __builtin_bit_cast(unsigned, __builtin_convertvector(v, bf16x2_t)); }
__device__ __forceinline__ bf16x8 pack8f(float x0, float x1, float x2, float x3, float x4, float x5, float x6, float x7) {
    u32x4 p; p.x = pk2c(x0, x1); p.y = pk2c(x2, x3); p.z = pk2c(x4, x5); p.w = pk2c(x6, x7); return __builtin_bit_cast(bf16x8, p); }
__device__ __forceinline__ bf16x8 pack_step(const f32x16& x, int s) { return s == 0 ? pack8f(x[0], x[1], x[2], x[3], x[4], x[5], x[6], x[7]) : pack8f(x[8], x[9], x[10], x[11], x[12], x[13], x[14], x[15]); }
__device__ __forceinline__ void split8(const float (&x)[8], bf16x8& hi, bf16x8& lo) {
    u32x4 p; p.x = pk2c(x[0], x[1]); p.y = pk2c(x[2], x[3]); p.z = pk2c(x[4], x[5]); p.w = pk2c(x[6], x[7]);
    hi = __builtin_bit_cast(bf16x8, p);
    lo = pack8f(x[0] - bflo(p.x), x[1] - bfhi(p.x), x[2] - bflo(p.y), x[3] - bfhi(p.y), x[4] - bflo(p.z), x[5] - bfhi(p.z), x[6] - bflo(p.w), x[7] - bfhi(p.w)); }
__device__ __forceinline__ bf16x8 cat44(u32x2 a, u32x2 b) { u32x4 p; p.x = a.x; p.y = a.y; p.z = b.x; p.w = b.y; return __builtin_bit_cast(bf16x8, p); }
#define LDS_WAIT() asm volatile("s_waitcnt lgkmcnt(0)" ::: "memory")
#define PIN(x) asm volatile("" : "+v"(x) :: "memory")
__device__ __forceinline__ int tid_now() { int t = threadIdx.x; asm volatile("" : "+v"(t)); return t; }

namespace g8 {
constexpr int BM = 256, BK = 64, HALF = 128, HTB = HALF * BK * 2, NXCD = 8, WGM = 8;
__device__ __forceinline__ int lds_byte(int r, int c) { const int st = (r >> 4) * 2 + (c >> 5), rr = r & 15, cc = c & 31, ob = rr * 64 + cc * 2; return st * 1024 + (ob ^ (((ob >> 9) & 1) << 5)); }
__device__ __forceinline__ void stage_rc(int b, int& R, int& C) { const int st = b / 1024, sb = b % 1024, swz = sb ^ (((sb >> 9) & 1) << 5); R = (st >> 1) * 16 + swz / 64; C = (st & 1) * 32 + (swz % 64) / 2; }
__device__ __forceinline__ int perm32(int rho) { const int n = rho >> 4, i = rho & 15; return 8 * (i >> 2) + 4 * n + (i & 3); }

__device__ __forceinline__ i32x8 cat8(bf16x8 lo, bf16x8 hi) { const i32x4 a = __builtin_bit_cast(i32x4, lo), b = __builtin_bit_cast(i32x4, hi); return __builtin_shufflevector(a, b, 0, 1, 2, 3, 4, 5, 6, 7); }
struct Unit { int pm, pn, e, mt; };

struct DenseSched {
    const char* A; const char* Bt; int K, nM, nN, nwg, G, c;
    __device__ __forceinline__ void init(const void* A_, const void* Bt_, int M, int N, int K_, int G_, int c_) { A = (const char*)A_; Bt = (const char*)Bt_; K = K_; nM = M / BM; nN = N / BM; nwg = nM * nN; G = G_; c = c_; }
    __device__ __forceinline__ bool next(int i, Unit& u) const {
        const long L = (long)i * G + c; if (L >= nwg) return false;
        int wgid = (int)L; { const int q = nwg / NXCD, r = nwg % NXCD, xcd = wgid % NXCD, off = wgid / NXCD; wgid = (xcd < r ? xcd * (q + 1) : r * (q + 1) + (xcd - r) * q) + off; }
        const int nig = WGM * nN, gid = wgid / nig, fm = gid * WGM, gsz = (nM - fm) < WGM ? (nM - fm) : WGM;
        u.pm = fm + ((wgid % nig) % gsz); u.pn = (wgid % nig) / gsz; u.e = 0; u.mt = 0; return true;
    }
    __device__ __forceinline__ unsigned a_off(const Unit& u, int h, int R, int C) const { return (unsigned)(((u.pm * BM + h * HALF + R) * K + C) * 2); }
    __device__ __forceinline__ const char* b_ptr(const Unit& u) const { return Bt + (size_t)u.pn * BM * K * 2; }
};
template <bool GATHER> struct MoeSched {
    const char* A; const char* Bw; size_t wstride; int K, T, G, c; const LAS int* tile_e; const LAS int* tile_mt; const LAS int* cnt; const int* toklist;
    __device__ __forceinline__ bool next(int i, Unit& u) const {
        const int L = i * G + c; if (L >= 4 * T) return false;
        u.pm = L >> 2; u.pn = L & 3; u.e = __builtin_amdgcn_readfirstlane(tile_e[u.pm]); u.mt = __builtin_amdgcn_readfirstlane(tile_mt[u.pm]); return true;
    }
    __device__ __forceinline__ unsigned a_off(const Unit& u, int h, int R, int C) const {
        if (GATHER) { const int pos = u.mt * BM + h * HALF + R; int tok = 0; if (pos < cnt[u.e]) tok = toklist[u.e * MTOT + pos]; return (unsigned)((tok * K + C) * 2); }
        return (unsigned)(((u.pm * BM + h * HALF + R) * K + C) * 2);
    }
    __device__ __forceinline__ const char* b_ptr(const Unit& u) const { return Bw + (size_t)u.e * wstride + (size_t)u.pn * BM * K * 2; }
};

struct EpiBf16 {
    static constexpr int PERM = 1; static constexpr int SC0 = 0x7F, SC1 = 0x7F;
    bf16_t* O; int ldc;
    __device__ __forceinline__ void operator()(const f32x4 (&acc)[2][2][4][2], const Unit& u, int wr, int wc, int fr, int fq) const {
        const int row0 = u.pm * BM + wr * 64 + fr, col0 = u.pn * BM + wc * 32 + 8 * fq;
#pragma unroll
        for (int ai = 0; ai < 2; ++ai)
#pragma unroll
            for (int m = 0; m < 4; ++m) { bf16_t* rowp = O + (size_t)(row0 + ai * HALF + m * 16) * ldc + col0;
#pragma unroll
                for (int bj = 0; bj < 2; ++bj) { const f32x4 v0 = acc[ai][bj][m][0], v1 = acc[ai][bj][m][1];
                    u32x4 w; w.x = pk2(v0[0], v0[1]); w.y = pk2(v0[2], v0[3]); w.z = pk2(v1[0], v1[1]); w.w = pk2(v1[2], v1[3]);
                    *(u32x4*)(rowp + bj * HALF) = w; } }
    }
};
struct EpiFp8 {
    static constexpr int PERM = 2;
    static constexpr int SC0 = 0x78, SC1 = 0x78;
    unsigned char* O;
    __device__ __forceinline__ void operator()(const f32x4 (&acc)[2][2][4][2], const Unit& u, int wr, int wc, int fr, int fq) const {
        const int row0 = u.pm * BM + wr * 64 + fr, col0 = u.pn * BM + wc * 64 + 16 * fq;
        int W[4] = {0, 0, 0, 0};
#pragma unroll
        for (int ai = 0; ai < 2; ++ai)
#pragma unroll
            for (int m = 0; m < 4; ++m) { unsigned char* rowp = O + (size_t)(row0 + ai * HALF + m * 16) * 1024 + col0;
#pragma unroll
                for (int bj = 0; bj < 2; ++bj)
#pragma unroll
                    for (int n = 0; n < 2; ++n) { const f32x4 x = acc[ai][bj][m][n]; int w = W[bj * 2 + n];
                        w = __builtin_amdgcn_cvt_pk_fp8_f32(__builtin_amdgcn_fmed3f(x[0], -440.0f, 440.0f), __builtin_amdgcn_fmed3f(x[1], -440.0f, 440.0f), w, false);
                        w = __builtin_amdgcn_cvt_pk_fp8_f32(__builtin_amdgcn_fmed3f(x[2], -440.0f, 440.0f), __builtin_amdgcn_fmed3f(x[3], -440.0f, 440.0f), w, true); W[bj * 2 + n] = w; }
                *(u32x4*)rowp = (u32x4){(unsigned)W[0], (unsigned)W[1], (unsigned)W[2], (unsigned)W[3]}; }
    }
};
struct EpiSwiGLU {
    static constexpr int PERM = 1;
    static constexpr int SC0 = 0x73, SC1 = 0x76;
    unsigned char* O;
    __device__ __forceinline__ void operator()(const f32x4 (&acc)[2][2][4][2], const Unit& u, int wr, int wc, int fr, int fq) const {
        const int row0 = u.pm * BM + wr * 64 + fr, col0 = u.pn * HALF + wc * 32 + 8 * fq;
        int W[2] = {0, 0};
#pragma unroll
        for (int ai = 0; ai < 2; ++ai)
#pragma unroll
            for (int m = 0; m < 4; ++m) { unsigned char* rowp = O + (size_t)(row0 + ai * HALF + m * 16) * DEXP + col0;
#pragma unroll
                for (int n = 0; n < 2; ++n) { const f32x4 g = acc[ai][0][m][n], up = acc[ai][1][m][n]; float v[4];
#pragma unroll
                    for (int i = 0; i < 4; ++i) v[i] = __builtin_amdgcn_fmed3f(siluf_(g[i]) * up[i], -440.0f, 440.0f);
                    int w = W[n]; w = __builtin_amdgcn_cvt_pk_fp8_f32(v[0], v[1], w, false); w = __builtin_amdgcn_cvt_pk_fp8_f32(v[2], v[3], w, true); W[n] = w; }
                *(u32x2*)rowp = (u32x2){(unsigned)W[0], (unsigned)W[1]}; }
    }
};
template <bool F8, class Epi, class Sched>
__device__ __forceinline__ void gemm_phase(LAS unsigned char* lds, const Sched& S, const Epi& E) {
    const int tid = tid_now(), wid = __builtin_amdgcn_readfirstlane(tid >> 6), lane = tid & 63, wr = wid >> 2, wc = wid & 3, fr = lane & 15, fq = lane >> 4;
    const int K = S.K, nt = K / BK;
    int mxsc = 0x7F7F7F7F, mxs0 = Epi::SC0 * 0x01010101, mxs1 = Epi::SC1 * 0x01010101; asm volatile("" : "+v"(mxsc)); asm volatile("" : "+v"(mxs0)); if (Epi::SC0 != Epi::SC1) asm volatile("" : "+v"(mxs1)); else mxs1 = mxs0;
    unsigned voffB[2];
#pragma unroll
    for (int i = 0; i < 2; ++i) { int R, C; stage_rc(tid * 16 + i * 8192, R, C); const int Rb = Epi::PERM == 2 ? (((R >> 5) & 3) * 64 + 16 * ((R & 15) >> 2) + 4 * ((R >> 4) & 1) + (R & 3)) : (Epi::PERM == 1 ? ((R & ~31) + perm32(R & 31)) : R); voffB[i] = (unsigned)(Rb * K + C) * 2u; }
    const size_t kstep = (size_t)(BK * 2);
    const size_t hstep = (size_t)(Epi::PERM == 2 ? 8 : HALF) * K * 2;
    const unsigned ldsw = (unsigned)wid * 1024u;
    const int aoff = lds_byte(wr * 64 + fr, fq * 8), boff = lds_byte(wc * 32 + fr, fq * 8);
#define G8_SA(b, h) (((b) * 2 + (h)) * HTB)
#define G8_SB(b, h) ((4 + (b) * 2 + (h)) * HTB)
#define G8_STAGE(bufoff, gbase, voff) do { const unsigned long long _g = (unsigned long long)(gbase); \
        const char* _gb = (const char*)(((unsigned long long)(unsigned)__builtin_amdgcn_readfirstlane((int)(unsigned)(_g >> 32)) << 32) | (unsigned long long)(unsigned)__builtin_amdgcn_readfirstlane((int)(unsigned)_g)); \
        _Pragma("unroll") for (int _i = 0; _i < 2; ++_i) \
        __builtin_amdgcn_global_load_lds((const unsigned*)(_gb + (voff)[_i]), (LAS unsigned*)(lds + (bufoff) + ldsw + _i * 8192), 16, 0, 0); } while (0)
#define G8_LDA(dst, b, h) do { _Pragma("unroll") for (int m = 0; m < 4; ++m) _Pragma("unroll") for (int k = 0; k < 2; ++k) dst[m][k] = *(const LAS bf16x8*)(lds + G8_SA(b, h) + aoff + m * 2048 + k * 1024); } while (0)
#define G8_LDB(dst, b, h) do { _Pragma("unroll") for (int n = 0; n < 2; ++n) _Pragma("unroll") for (int k = 0; k < 2; ++k) dst[n][k] = *(const LAS bf16x8*)(lds + G8_SB(b, h) + boff + n * 2048 + k * 1024); } while (0)
#define G8_MMA(ai, bj, At, Bt) do { __builtin_amdgcn_s_setprio(1); _Pragma("unroll") for (int m = 0; m < 4; ++m) _Pragma("unroll") for (int n = 0; n < 2; ++n) _Pragma("unroll") for (int k = 0; k < 2; ++k) \
        acc[ai][bj][m][n] = __builtin_amdgcn_mfma_f32_16x16x32_bf16(Bt[n][k], At[m][k], acc[ai][bj][m][n], 0, 0, 0); __builtin_amdgcn_s_setprio(0); } while (0)
#define G8_MMA8(ai, bj, At, Bt) do { __builtin_amdgcn_s_setprio(1); _Pragma("unroll") for (int m = 0; m < 4; ++m) _Pragma("unroll") for (int n = 0; n < 2; ++n) \
        acc[ai][bj][m][n] = __builtin_amdgcn_mfma_scale_f32_16x16x128_f8f6f4(cat8(Bt[n][0], Bt[n][1]), cat8(At[m][0], At[m][1]), acc[ai][bj][m][n], 0, 0, 0, (bj) ? mxs1 : mxs0, 0, mxsc); __builtin_amdgcn_s_setprio(0); } while (0)
#define G8_MM(ai, bj, At, Bt) do { if (F8) G8_MMA8(ai, bj, At, Bt); else G8_MMA(ai, bj, At, Bt); } while (0)
#define G8_WAIT_V(n) asm volatile("s_waitcnt vmcnt(" #n ")" ::: "memory")
#define G8_WAIT_L(n) asm volatile("s_waitcnt lgkmcnt(" #n ")" ::: "memory")
#define G8_BAR __builtin_amdgcn_s_barrier()
#define G8_SCHED __builtin_amdgcn_sched_barrier(0)
    Unit cur, nxt; int ui = 0;
    if (!S.next(0, cur)) return;
    f32x4 acc[2][2][4][2];
#pragma unroll
    for (int a = 0; a < 2; ++a)
#pragma unroll
        for (int b = 0; b < 2; ++b)
#pragma unroll
            for (int m = 0; m < 4; ++m)
#pragma unroll
                for (int n = 0; n < 2; ++n) acc[a][b][m][n] = (f32x4){0.f, 0.f, 0.f, 0.f};
    bf16x8 At[4][2], B0[2][2], B1[2][2];
    unsigned vA0[2], vA1[2];
#pragma unroll
    for (int i = 0; i < 2; ++i) { int R, C; stage_rc(tid * 16 + i * 8192, R, C); vA0[i] = S.a_off(cur, 0, R, C); vA1[i] = S.a_off(cur, 1, R, C); }
    const char* const Ab = S.A;
    const char* cB = S.b_ptr(cur);
    G8_STAGE(G8_SB(0, 0), cB, voffB); G8_STAGE(G8_SA(0, 0), Ab, vA0); G8_STAGE(G8_SB(0, 1), cB + hstep, voffB); G8_STAGE(G8_SA(0, 1), Ab, vA1);
    if (wr == 1) G8_BAR;
    G8_WAIT_V(4); G8_BAR;
    G8_STAGE(G8_SB(1, 0), cB + kstep, voffB); G8_STAGE(G8_SA(1, 0), Ab + kstep, vA0); G8_STAGE(G8_SB(1, 1), cB + hstep + kstep, voffB);
    G8_WAIT_V(6); G8_BAR;
    for (;;) {
        const bool has_next = S.next(ui + 1, nxt);
        const char* nB = has_next ? S.b_ptr(nxt) : cB;
        unsigned nA0[2] = {vA0[0], vA0[1]}, nA1[2] = {vA1[0], vA1[1]};
        if (has_next) {
#pragma unroll
            for (int i = 0; i < 2; ++i) { int R, C; stage_rc(tid * 16 + i * 8192, R, C); nA0[i] = S.a_off(nxt, 0, R, C); nA1[i] = S.a_off(nxt, 1, R, C); }
        }
#pragma unroll 1
        for (int t = 0; t < nt; t += 2) {
            const bool last = (t == nt - 2);
            const char* a1 = Ab + (size_t)(t + 1) * kstep;
            const char* a2 = last ? Ab : Ab + (size_t)(t + 2) * kstep; const char* b2 = last ? nB : cB + (size_t)(t + 2) * kstep;
            const char* a3 = a2 + kstep; const char* b3 = b2 + kstep;
            G8_LDB(B0, 0, 0); G8_SCHED; G8_LDA(At, 0, 0); G8_STAGE(G8_SA(1, 1), a1, vA1);
            G8_WAIT_L(8); G8_BAR; G8_WAIT_L(0); G8_MM(0, 0, At, B0); G8_BAR; G8_SCHED;
            if (last) {
#pragma unroll
                for (int i = 0; i < 2; ++i) { vA0[i] = nA0[i]; vA1[i] = nA1[i]; }
            }
            G8_LDB(B1, 0, 1); G8_STAGE(G8_SB(0, 0), b2, voffB);
            G8_BAR; G8_WAIT_L(0); G8_MM(0, 1, At, B1); G8_BAR;
            G8_LDA(At, 0, 1); G8_STAGE(G8_SA(0, 0), a2, vA0);
            G8_BAR; G8_WAIT_L(0); G8_MM(1, 0, At, B0); G8_BAR; G8_SCHED;
            G8_STAGE(G8_SB(0, 1), b2 + hstep, voffB);
            G8_WAIT_V(6); G8_BAR; G8_MM(1, 1, At, B1); G8_BAR;
            G8_LDB(B0, 1, 0); G8_SCHED; G8_LDA(At, 1, 0); G8_STAGE(G8_SA(0, 1), a2, vA1);
            G8_WAIT_L(8); G8_BAR; G8_WAIT_L(0); G8_MM(0, 0, At, B0); G8_BAR; G8_SCHED;
            G8_LDB(B1, 1, 1); G8_STAGE(G8_SB(1, 0), b3, voffB);
            G8_BAR; G8_WAIT_L(0); G8_MM(0, 1, At, B1); G8_BAR;
            G8_LDA(At, 1, 1); G8_STAGE(G8_SA(1, 0), a3, vA0);
            G8_BAR; G8_WAIT_L(0); G8_MM(1, 0, At, B0); G8_BAR; G8_SCHED;
            G8_STAGE(G8_SB(1, 1), b3 + hstep, voffB);
            G8_WAIT_V(6); G8_BAR; G8_MM(1, 1, At, B1); G8_BAR;
        }
        E(acc, cur, wr, wc, fr, fq);
        if (!has_next) break;
#pragma unroll
        for (int a = 0; a < 2; ++a)
#pragma unroll
            for (int b = 0; b < 2; ++b)
#pragma unroll
                for (int m = 0; m < 4; ++m)
#pragma unroll
                    for (int n = 0; n < 2; ++n) acc[a][b][m][n] = (f32x4){0.f, 0.f, 0.f, 0.f};
        cur = nxt; cB = nB; ++ui;
    }
    G8_WAIT_V(0);
    if (wr == 0) G8_BAR;
    G8_BAR;
#undef G8_SA
#undef G8_SB
#undef G8_STAGE
#undef G8_LDA
#undef G8_LDB
#undef G8_MMA
#undef G8_MMA8
#undef G8_MM
#undef G8_WAIT_V
#undef G8_WAIT_L
#undef G8_BAR
#undef G8_SCHED
}
}

struct Args { const float* in[29]; float* out; unsigned char* ws; int ph_lo, ph_hi; };
enum { I_X = 0, I_C, I_CTX, I_CCTX, I_WMOD, I_BMOD, I_G1, I_G2, I_WIN, I_GWF, I_GBF, I_GWB, I_GBB, I_GOUT, I_CONFW, I_CONFB, I_CONFG, I_CONFBETA, I_SCW, I_POOLW, I_POOLS, I_WOUT, I_RWG, I_RBG, I_RWE, I_RBE, I_EIN, I_EOUT, I_GFINAL };

__device__ __forceinline__ void transpose_item(const float* W, int K, int N, bf16_t* WT, int kb, int n0, int dst_row0, LAS float* scr, int lane) {
    const int k0 = 64 * kb;
    float wv[32];
#pragma unroll
    for (int i = 0; i < 32; ++i) { const int kk = 2 * i + (lane >> 5); wv[i] = W[(size_t)(k0 + kk) * N + n0 + (lane & 31)]; }
#pragma unroll
    for (int i = 0; i < 32; ++i) PIN(wv[i]);
#pragma unroll
    for (int i = 0; i < 32; ++i) { const int kk = 2 * i + (lane >> 5); scr[kk * 33 + (lane & 31)] = wv[i]; }
    LDS_WAIT(); asm volatile("" ::: "memory");
    const int c = lane & 7;
#pragma unroll
    for (int j = 0; j < 4; ++j) { const int n = (lane >> 3) + 8 * j; const LAS float* s = scr + (8 * c) * 33 + n;
        u32x4 o; o.x = pk2(s[0 * 33], s[1 * 33]); o.y = pk2(s[2 * 33], s[3 * 33]); o.z = pk2(s[4 * 33], s[5 * 33]); o.w = pk2(s[6 * 33], s[7 * 33]);
        *(u32x4*)(WT + (size_t)(dst_row0 + n) * K + k0 + 8 * c) = o; }
    LDS_WAIT(); asm volatile("" ::: "memory");
}

__device__ __forceinline__ void transpose_item8(const float* W, int K, int N, unsigned char* WT, int kb, int n0, int dst_row0, LAS float* scr, int lane) {
    const int k0 = 64 * kb;
    float wv[32];
#pragma unroll
    for (int i = 0; i < 32; ++i) { const int kk = 2 * i + (lane >> 5); wv[i] = W[(size_t)(k0 + kk) * N + n0 + (lane & 31)]; }
#pragma unroll
    for (int i = 0; i < 32; ++i) PIN(wv[i]);
#pragma unroll
    for (int i = 0; i < 32; ++i) { const int kk = 2 * i + (lane >> 5); scr[kk * 33 + (lane & 31)] = wv[i]; }
    LDS_WAIT(); asm volatile("" ::: "memory");
    const int c = lane & 7;
#pragma unroll
    for (int j = 0; j < 4; ++j) { const int n = (lane >> 3) + 8 * j; const LAS float* s = scr + (8 * c) * 33 + n;
        float v[8];
#pragma unroll
        for (int i = 0; i < 8; ++i) v[i] = fminf(fmaxf(s[i * 33] * F8_WSC, -440.0f), 440.0f);
        int w0 = 0, w1 = 0;
        w0 = __builtin_amdgcn_cvt_pk_fp8_f32(v[0], v[1], w0, false); w0 = __builtin_amdgcn_cvt_pk_fp8_f32(v[2], v[3], w0, true);
        w1 = __builtin_amdgcn_cvt_pk_fp8_f32(v[4], v[5], w1, false); w1 = __builtin_amdgcn_cvt_pk_fp8_f32(v[6], v[7], w1, true);
        *(u32x2*)(WT + (size_t)(dst_row0 + n) * K + k0 + 8 * c) = (u32x2){(unsigned)w0, (unsigned)w1}; }
    LDS_WAIT(); asm volatile("" ::: "memory");
}

constexpr int CV_SMALL = 3360, CV_E0 = 3360, CV_EI1 = 27936, CV_EO1 = 44320, CV_END = 52512;
constexpr int CV_G = 4480;
constexpr int CV_A = 5184, CV_B = 5760;
constexpr int CV_C = 4096, CV_D = 2048, CV_E = 5184;
constexpr int CV_F = 4096;
constexpr int CV_P0_E0 = (CV_EI1 - CV_E0) - CV_G - CV_A - CV_B, CV_P0_EI1 = (CV_EO1 - CV_EI1) - CV_C - CV_D - CV_E, CV_P0_EO1 = (CV_END - CV_EO1) - CV_F;
__device__ __forceinline__ void convert_item(const Args& a, int idx, LAS float* scr, int lane) {
    unsigned char* ws = a.ws;
    if (idx < CV_SMALL) { const int l = idx / 1680; int r = idx % 1680;
        if (r < 1168) { const int kb = r / 73, nb = r % 73; transpose_item(a.in[I_WIN] + (size_t)l * 1024 * NIN, 1024, NIN, (bf16_t*)(ws + WS_WIN) + (size_t)l * NINP * 1024, kb, nb * 32, nb * 32, scr, lane); }
        else { r -= 1168; const int kb = r / 32, nb = r % 32; transpose_item(a.in[I_WOUT] + (size_t)l * 1024 * 1024, 1024, 1024, (bf16_t*)(ws + WS_WOUT) + (size_t)l * 1024 * 1024, kb, nb * 32, nb * 32, scr, lane); }
        return; }
    int l, r; bool is_in;
    if (idx < CV_EI1) { l = 0; r = idx - CV_E0; is_in = r < 16384; if (!is_in) r -= 16384; }
    else if (idx < CV_EO1) { l = 1; r = idx - CV_EI1; is_in = true; }
    else { l = 1; r = idx - CV_EO1; is_in = false; }
    if (is_in) { const int le = l * 32 + r / 512, q = r % 512, kb = q / 32, n0 = (q % 32) * 32;
        const int dst = n0 < 512 ? (256 * (n0 >> 7) + (n0 & 127)) : (256 * ((n0 - 512) >> 7) + 128 + ((n0 - 512) & 127));
        transpose_item8(a.in[I_EIN] + (size_t)le * 1024 * 1024, 1024, 1024, ws + WS_WEIN + (size_t)le * 1024 * 1024, kb, n0, dst, scr, lane); }
    else { const int le = l * 32 + r / 256, q = r % 256, kb = q / 32, nb = q % 32;
        transpose_item8(a.in[I_EOUT] + (size_t)le * 512 * 1024, 512, 1024, ws + WS_WEOUT + (size_t)le * 1024 * 512, kb, nb * 32, nb * 32, scr, lane); }
}
__device__ __forceinline__ void convert_range(const Args& a, LAS unsigned char* lds, int first, int count, int rank, int nparts) {
    const int tid = tid_now(), lane = tid & 63, wid = __builtin_amdgcn_readfirstlane(tid >> 6);
    LAS float* scr = (LAS float*)(lds + wid * 16384);
    const int per = (count + nparts - 1) / nparts, lo = rank * per, hi = (lo + per < count) ? lo + per : count;
    for (int j = lo + wid; j < hi; j += 8) convert_item(a, first + j, scr, lane);
}
__device__ __forceinline__ void convert_in_tail(const Args& a, LAS unsigned char* lds, int first, int count, int tot_units, int G, int c) {
    const int rem = tot_units % G;
    if (rem == 0) convert_range(a, lds, first, count, c, G);
    else if (c >= rem) convert_range(a, lds, first, count, c - rem, G - rem);
}

__device__ __forceinline__ void phase_p0(const Args& a, LAS unsigned char* lds) {
    const int tid = tid_now(), lane = tid & 63, wid = __builtin_amdgcn_readfirstlane(tid >> 6);
    unsigned char* ws = a.ws;
    for (int job = blockIdx.x; job < 192; job += gridDim.x) {
        const int l = job / 96, n0 = (job % 96) * 64;
        LAS float* sv = (LAS float*)lds;
        LAS float* red = (LAS float*)(lds + 5 * 1024 * 4);
        for (int i = tid; i < 5 * 1024; i += 512) { const int r = i >> 10, k = i & 1023; const float v = r < 4 ? a.in[I_C][r * 1024 + k] : a.in[I_CCTX][k]; sv[i] = siluf_(v); }
        __syncthreads();
        const int ks = tid >> 6, col = tid & 63;
        const float* w = a.in[I_WMOD] + (size_t)l * 1024 * 6144 + (size_t)(ks * 128) * 6144 + n0 + col;
        float acc[5] = {0.f, 0.f, 0.f, 0.f, 0.f};
#pragma unroll 8
        for (int k = 0; k < 128; ++k) { const float wv = w[(size_t)k * 6144];
#pragma unroll
            for (int r = 0; r < 5; ++r) acc[r] += sv[r * 1024 + ks * 128 + k] * wv; }
#pragma unroll
        for (int r = 0; r < 5; ++r) red[(ks * 5 + r) * 64 + col] = acc[r];
        __syncthreads();
        if (tid < 320) { const int r = tid >> 6; float s = 0.f;
#pragma unroll
            for (int q = 0; q < 8; ++q) s += red[(q * 5 + r) * 64 + col];
            ((float*)(ws + WS_MOD))[(size_t)(l * 5 + r) * 6144 + n0 + col] = s + a.in[I_BMOD][l * 6144 + n0 + col]; }
        __syncthreads();
    }
    LAS float* scr = (LAS float*)(lds + wid * 16384);
    const int gw = blockIdx.x * 8 + wid, NGW = gridDim.x * 8;
    constexpr int P0_N0 = CV_E0 + CV_P0_E0, P0_N1 = P0_N0 + CV_P0_EI1, P0_N2 = P0_N1 + CV_P0_EO1;
    for (int j = gw; j < P0_N2; j += NGW) { const int idx = j < P0_N0 ? j : (j < P0_N1 ? CV_EI1 + (j - P0_N0) : CV_EO1 + (j - P0_N1)); convert_item(a, idx, scr, lane); }
    for (int i = blockIdx.x * 512 + tid; i < 2 * 4096; i += gridDim.x * 512) { const int l = i >> 12, g = (i >> 10) & 3, k = i & 1023; ((float*)(ws + WS_TAB))[i] = a.in[I_RWG][l * 4096 + k * 4 + g]; }
    for (int i = blockIdx.x * 512 + tid; i < 2 * 4 * 64 * 64; i += gridDim.x * 512) { const int lg = i >> 12, dd = (i >> 6) & 63, c = i & 63;
        ((bf16_t*)(ws + WS_PWT))[i] = (bf16_t)(pk2(a.in[I_POOLW][(size_t)lg * 4096 + c * 64 + dd], 0.f) & 0xffffu); }
    for (int i = blockIdx.x * 512 + tid; i < 4 * 8 * 64; i += gridDim.x * 512) { const int wi = i >> 9, f = (i >> 6) & 7, ln = i & 63, mt = f >> 2, nt = (f >> 1) & 1, sq = f & 1, rr = ln & 31, hh = ln >> 5, hw = 1 << wi;
        const int t = 32 * nt + rr; int lo = t - hw, hi = t + hw; lo = lo < 0 ? 0 : lo; hi = hi > 64 ? 64 : hi; const int cnt = hi - lo;
        unsigned w4[4];
#pragma unroll
        for (int jp = 0; jp < 4; ++jp) { unsigned wd = 0u;
#pragma unroll
            for (int e = 0; e < 2; ++e) { const int j = 2 * jp + e, tp = 32 * mt + 16 * sq + 8 * (j >> 2) + 4 * hh + (j & 3);
                const int val = ((tp >= lo && tp < hi) ? 1 : 0) - (tp == t ? cnt : 0);
                wd |= (__float_as_uint((float)val) >> 16) << (16 * e); }
            w4[jp] = wd; }
        ((u32x4*)(ws + WS_BAND))[i] = (u32x4){w4[0], w4[1], w4[2], w4[3]}; }
    for (int i = blockIdx.x * 512 + tid; i < 2 * 224 * 1024 / 8; i += gridDim.x * 512) { const int l = i / (224 * 128), q = i % (224 * 128);
        *(u32x4*)((bf16_t*)(ws + WS_WIN) + (size_t)l * NINP * 1024 + (size_t)NIN * 1024 + (size_t)q * 8) = (u32x4){0u, 0u, 0u, 0u}; }
}

__device__ __forceinline__ void load_row(const float* xrow, int lane, f32x4 (&v)[4]) {
    const f32x4* xr = (const f32x4*)xrow + lane;
#pragma unroll
    for (int j = 0; j < 4; ++j) v[j] = xr[64 * j];
}
__device__ __forceinline__ void load_row_bf(const bf16_t* xrow, int lane, f32x4 (&v)[4]) {
#pragma unroll
    for (int j = 0; j < 4; ++j) { const u32x2 w = *((const u32x2*)xrow + lane + 64 * j); v[j] = (f32x4){bflo(w.x), bfhi(w.x), bflo(w.y), bfhi(w.y)}; }
}
__device__ __forceinline__ void store_row_bf(bf16_t* xrow, int lane, const f32x4 (&v)[4]) {
#pragma unroll
    for (int j = 0; j < 4; ++j) { u32x2 w; w.x = pk2(v[j].x, v[j].y); w.y = pk2(v[j].z, v[j].w); *((u32x2*)xrow + lane + 64 * j) = w; }
}
__device__ __forceinline__ float row_rstd(const f32x4 (&v)[4]) {
    float s = 0.f;
#pragma unroll
    for (int j = 0; j < 4; ++j) s += (v[j].x * v[j].x + v[j].y * v[j].y) + (v[j].z * v[j].z + v[j].w * v[j].w);
    return rsqrtf(wave_sum(s) * (1.0f / D) + EPS);
}
__device__ __forceinline__ void norm_mod_store(f32x4 (&v)[4], float rstd, const float* g, const float* sc, const float* sh, bf16_t* hrow, int lane) {
#pragma unroll
    for (int j = 0; j < 4; ++j) { const f32x4 gv = *((const f32x4*)g + lane + 64 * j), scv = *((const f32x4*)sc + lane + 64 * j), shv = *((const f32x4*)sh + lane + 64 * j);
        v[j] = (v[j] * rstd * gv) * (1.0f + scv) + shv;
        u32x2 w; w.x = pk2(v[j].x, v[j].y); w.y = pk2(v[j].z, v[j].w);
        *((u32x2*)hrow + lane + 64 * j) = w; }
}

__device__ __forceinline__ void norm_store_cached(f32x4 (&v)[4], float rstd, const f32x4 (&GS)[4], const f32x4 (&SH)[4], bf16_t* hrow, int lane) {
#pragma unroll
    for (int j = 0; j < 4; ++j) { v[j] = (v[j] * rstd) * GS[j] + SH[j];
        u32x2 w; w.x = pk2(v[j].x, v[j].y); w.y = pk2(v[j].z, v[j].w);
        *((u32x2*)hrow + lane + 64 * j) = w; }
}
__device__ __forceinline__ void norm_store_cached8(f32x4 (&v)[4], float rstd, const f32x4 (&GS)[4], const f32x4 (&SH)[4], unsigned char* hrow, int lane) {
#pragma unroll
    for (int j = 0; j < 4; ++j) { v[j] = (v[j] * rstd) * GS[j] + SH[j];
        float q[4];
#pragma unroll
        for (int i = 0; i < 4; ++i) q[i] = fminf(fmaxf(v[j][i] * F8_HSC, -440.0f), 440.0f);
        int w = 0; w = __builtin_amdgcn_cvt_pk_fp8_f32(q[0], q[1], w, false); w = __builtin_amdgcn_cvt_pk_fp8_f32(q[2], q[3], w, true);
        *((unsigned*)hrow + lane + 64 * j) = (unsigned)w; }
}
__device__ __forceinline__ void load_mod_cached(const float* g, const float* sc, const float* sh, const float* ga, int lane, f32x4 (&GS)[4], f32x4 (&SH)[4], f32x4 (&GA)[4]) {
#pragma unroll
    for (int j = 0; j < 4; ++j) { const f32x4 gv = *((const f32x4*)g + lane + 64 * j), scv = *((const f32x4*)sc + lane + 64 * j);
        GS[j] = gv * (1.0f + scv); SH[j] = *((const f32x4*)sh + lane + 64 * j); GA[j] = *((const f32x4*)ga + lane + 64 * j); }
}

__device__ __forceinline__ void phase_norm1_l0(const Args& a) {
    const int lane = tid_now() & 63, wid = tid_now() >> 6, gw = blockIdx.x * 8 + wid, NGW = gridDim.x * 8;
    const float* MOD = (const float*)(a.ws + WS_MOD); bf16_t* H = (bf16_t*)(a.ws + WS_H);
    int cur_b = -1; f32x4 GS[4], SH[4], GA[4];
#pragma unroll 1
    for (int m = gw; m < MTOT; m += 2 * NGW) {
        const int m2 = m + NGW; const bool has2 = m2 < MTOT; const int m2c = has2 ? m2 : m;
        const float* src = m < NLAT ? a.in[I_X] + (size_t)m * D : a.in[I_CTX] + (size_t)(m - NLAT) * D;
        const float* src2 = m2c < NLAT ? a.in[I_X] + (size_t)m2c * D : a.in[I_CTX] + (size_t)(m2c - NLAT) * D;
        const int b = m < NLAT ? (m >> 13) : 4, b2 = m2c < NLAT ? (m2c >> 13) : 4;
        f32x4 v[4], v2[4]; load_row(src, lane, v); load_row(src2, lane, v2);
        const float rstd = row_rstd(v), rstd2 = row_rstd(v2);
        if (b != cur_b) { const float* mod = MOD + (size_t)b * 6144; load_mod_cached(a.in[I_G1], mod + 1024, mod, mod, lane, GS, SH, GA); cur_b = b; }
        norm_store_cached(v, rstd, GS, SH, H + (size_t)m * D, lane);
        if (has2) { if (b2 != cur_b) { const float* mod = MOD + (size_t)b2 * 6144; load_mod_cached(a.in[I_G1], mod + 1024, mod, mod, lane, GS, SH, GA); cur_b = b2; }
            norm_store_cached(v2, rstd2, GS, SH, H + (size_t)m2 * D, lane); }
    }
}

struct ChunkPos { int b, sf, sb; };
__device__ __forceinline__ ChunkPos chunk_pos(int chunk) {
    ChunkPos p;
    if (chunk < 512) { p.b = chunk >> 7; const int n = chunk & 127; p.sf = 4 + n; p.sb = 4 + 127 - n; }
    else { const int cc = chunk - 512; p.b = cc >> 2; const int n = cc & 3; p.sf = n; p.sb = 3 - n; }
    return p;
}

constexpr int VS = 72;
__device__ __forceinline__ void gla_prep_dir(int dir, int lane, const float (&w)[8], float bias, const bf16x8 (&Az)[2], f32x16 (&BT)[2]) {
    asm volatile("" : "+v"(lane));
    const int r = lane & 31, hf = lane >> 5;
    const f32x16 zero16 = {0.f, 0.f, 0.f, 0.f, 0.f, 0.f, 0.f, 0.f, 0.f, 0.f, 0.f, 0.f, 0.f, 0.f, 0.f, 0.f};
    u32x4 mk[2];
#pragma unroll
    for (int s = 0; s < 2; ++s) { unsigned w4[4];
#pragma unroll
        for (int jp = 0; jp < 4; ++jp) { const int j0 = 2 * jp, j1 = 2 * jp + 1;
            const int t0 = 16 * s + 8 * (j0 >> 2) + 4 * hf + (j0 & 3), t1 = 16 * s + 8 * (j1 >> 2) + 4 * hf + (j1 & 3);
            const bool c0 = dir ? (t0 >= r) : (t0 <= r), c1 = dir ? (t1 >= r) : (t1 <= r);
            w4[jp] = (c0 ? 0x3F80u : 0u) | (c1 ? 0x3F800000u : 0u); }
        mk[s].x = w4[0]; mk[s].y = w4[1]; mk[s].z = w4[2]; mk[s].w = w4[3]; }
    bf16x8 Bhi, Blo; split8(w, Bhi, Blo);
    BT[0] = zero16; BT[1] = zero16;
#pragma unroll 1
    for (int mt = 0; mt < 2; ++mt) {
        const bf16x8 A = mt ? Az[1] : Az[0];
        f32x16 x = MFMA32(A, Bhi, zero16); x = MFMA32(A, Blo, x);
        float la[16];
#pragma unroll
        for (int i = 0; i < 16; ++i) { const float v = x[i] + bias; la[i] = (fminf(v, 0.f) - __logf(1.0f + __expf(-fabsf(v)))) * (1.0f / 16.0f); }
#pragma unroll
        for (int s = 0; s < 2; ++s) {
            const float t8[8] = {la[8 * s], la[8 * s + 1], la[8 * s + 2], la[8 * s + 3], la[8 * s + 4], la[8 * s + 5], la[8 * s + 6], la[8 * s + 7]};
            bf16x8 Lh, Ll; split8(t8, Lh, Ll);
#pragma unroll
            for (int nt = 0; nt < 2; ++nt) {
                const bool full = dir ? (mt > nt) : (mt < nt);
                u32x4 bm; const unsigned fv = full ? 0x3F803F80u : 0u;
                bm.x = (mt == nt) ? mk[s].x : fv; bm.y = (mt == nt) ? mk[s].y : fv; bm.z = (mt == nt) ? mk[s].z : fv; bm.w = (mt == nt) ? mk[s].w : fv;
                const bf16x8 Bm = __builtin_bit_cast(bf16x8, bm);
                BT[nt] = MFMA32(Lh, Bm, BT[nt]); BT[nt] = MFMA32(Ll, Bm, BT[nt]); }
        }
    }
}
__device__ __forceinline__ void gla_gate_loads(const Args& a, int l, int h, int dir, const bf16_t* cols0, int lane, float (&w)[8], float& bias, bf16x8 (&Az)[2]) {
    const int r = lane & 31, hf = lane >> 5;
    const float* wp = a.in[dir ? I_GWB : I_GWF] + (size_t)(l * 16 + 8 * hf) * 128 + 32 * h + r;
#pragma unroll
    for (int j = 0; j < 8; ++j) w[j] = wp[j * 128];
    bias = a.in[dir ? I_GBB : I_GBF][l * 128 + 32 * h + r];
#pragma unroll
    for (int mt = 0; mt < 2; ++mt) Az[mt] = *(const bf16x8*)(cols0 + (size_t)(32 * mt + r) * NINP + C_ZF + 16 * dir + 8 * hf);
}
__device__ __forceinline__ void stage_vT(const bf16_t* cols0, int h, int lane, LAS bf16_t* vT) {
    u32x4 w[8];
#pragma unroll
    for (int q = 0; q < 8; ++q) { const int chunk = lane + 64 * q, t = chunk >> 3, cg = chunk & 7; w[q] = *(const u32x4*)(cols0 + (size_t)t * NINP + C_V + 64 * h + 8 * cg); }
#pragma unroll
    for (int q = 0; q < 8; ++q) PIN(w[q]);
#pragma unroll
    for (int q = 0; q < 8; ++q) { const int chunk = lane + 64 * q, t = chunk >> 3, cg = chunk & 7;
        LAS bf16_t* p = vT + (8 * cg) * VS + t;
        p[0 * VS] = (bf16_t)(w[q].x & 0xffffu); p[1 * VS] = (bf16_t)(w[q].x >> 16); p[2 * VS] = (bf16_t)(w[q].y & 0xffffu); p[3 * VS] = (bf16_t)(w[q].y >> 16);
        p[4 * VS] = (bf16_t)(w[q].z & 0xffffu); p[5 * VS] = (bf16_t)(w[q].z >> 16); p[6 * VS] = (bf16_t)(w[q].w & 0xffffu); p[7 * VS] = (bf16_t)(w[q].w >> 16); }
}
__device__ __forceinline__ void chunk_gla_item(const Args& a, int l, int tile, int h, int lane, LAS bf16_t* vT, LAS bf16_t* kdT) {
    const int r = lane & 31, hf = lane >> 5;
    const bf16_t* cols0 = (const bf16_t*)(a.ws + WS_COLS) + (size_t)tile * 64 * NINP;
    float* KV = (float*)(a.ws + WS_KV); float* DEC = (float*)(a.ws + WS_DEC);
    const ChunkPos cp = chunk_pos(tile);
    const f32x16 zero16 = {0.f, 0.f, 0.f, 0.f, 0.f, 0.f, 0.f, 0.f, 0.f, 0.f, 0.f, 0.f, 0.f, 0.f, 0.f, 0.f};
    stage_vT(cols0, h, lane, vT);
#pragma unroll 1
    for (int dir = 0; dir < 2; ++dir) {
        float gw8[8], gbias; bf16x8 Az[2]; u32x2 kraw[2][4];
        gla_gate_loads(a, l, h, dir, cols0, lane, gw8, gbias, Az);
#pragma unroll
        for (int nt = 0; nt < 2; ++nt)
#pragma unroll
            for (int g = 0; g < 4; ++g) kraw[nt][g] = *(const u32x2*)(cols0 + (size_t)(32 * nt + r) * NINP + C_K + 32 * h + 4 * hf + 8 * g);
#pragma unroll
        for (int j = 0; j < 8; ++j) PIN(gw8[j]);
        PIN(gbias); PIN(Az[0]); PIN(Az[1]);
#pragma unroll
        for (int nt = 0; nt < 2; ++nt)
#pragma unroll
            for (int g = 0; g < 4; ++g) PIN(kraw[nt][g]);
        f32x16 BT[2]; gla_prep_dir(dir, lane, gw8, gbias, Az, BT);
        const size_t e = (size_t)((dir * 4 + cp.b) * 4 + h) * NSEQ + (dir ? cp.sb : cp.sf);
        const int srcl = (dir ? 0 : 31) + 32 * hf;
        float tot[16];
#pragma unroll
        for (int i = 0; i < 16; ++i) tot[i] = __shfl(dir ? BT[0][i] : BT[1][i], srcl);
        if (r == (dir ? 0 : 31)) {
#pragma unroll
            for (int i = 0; i < 16; ++i) DEC[e * 32 + (i & 3) + 8 * (i >> 2) + 4 * hf] = __expf(tot[i]);
        }
#pragma unroll
        for (int nt = 0; nt < 2; ++nt) {
#pragma unroll
            for (int g = 0; g < 4; ++g) { const u32x2 kw = kraw[nt][g];
                const float kf[4] = {bflo(kw.x), bfhi(kw.x), bflo(kw.y), bfhi(kw.y)};
#pragma unroll
                for (int q = 0; q < 4; ++q) { const int i = 4 * g + q; const float kd = kf[q] * __expf(tot[i] - BT[nt][i]);
                    kdT[(8 * g + 4 * hf + q) * VS + 32 * nt + r] = (bf16_t)(pk2c(kd, 0.f) & 0xffffu); } }
        }
        LDS_WAIT(); asm volatile("" ::: "memory");
#pragma unroll 1
        for (int ct = 0; ct < 2; ++ct) {
            f32x16 acc = zero16;
#pragma unroll
            for (int ks = 0; ks < 4; ++ks) {
                const bf16x8 A = *(const LAS bf16x8*)(vT + (32 * ct + r) * VS + 16 * ks + 8 * hf);
                const bf16x8 B = *(const LAS bf16x8*)(kdT + r * VS + 16 * ks + 8 * hf);
                acc = MFMA32(A, B, acc); }
            float* dst = KV + e * 2048 + (size_t)(32 * ct + 4 * hf) * 32 + r;
#pragma unroll
            for (int i = 0; i < 16; ++i) dst[((i & 3) + 8 * (i >> 2)) * 32] = acc[i];
        }
        LDS_WAIT(); asm volatile("" ::: "memory");
    }
}
__device__ __forceinline__ void chunk_agv_item(const Args& a, int row0, int lane) {
    const bf16_t* COLS = (const bf16_t*)(a.ws + WS_COLS); float* AGV = (float*)(a.ws + WS_AGV); float* CXV = (float*)(a.ws + WS_CXV);
    const int t = lane >> 3;
#pragma unroll
    for (int rep = 0; rep < 2; ++rep) { const int c8 = ((lane & 7) + 8 * rep) * 8; const bf16_t* rp = COLS + (size_t)(row0 + t) * NINP;
        float fa[8], fg[8], fc[8], fx[8];
        unpack8(*(const u32x4*)(rp + C_CA + 128 + c8), fa); unpack8(*(const u32x4*)(rp + C_CG + 128 + c8), fg);
        unpack8(*(const u32x4*)(rp + C_SC + 128 + c8), fc); unpack8(*(const u32x4*)(rp + C_SX + 128 + c8), fx);
        f32x4 o0, o1, p0, p1;
#pragma unroll
        for (int i = 0; i < 4; ++i) { o0[i] = fa[i] * sigmoidf_(fg[i]); o1[i] = fa[4 + i] * sigmoidf_(fg[4 + i]); p0[i] = fc[i] * fx[i]; p1[i] = fc[4 + i] * fx[4 + i]; }
        float* ao = AGV + (size_t)(row0 + t) * 128 + c8; float* co = CXV + (size_t)(row0 + t) * 128 + c8;
        *(f32x4*)ao = o0; *(f32x4*)(ao + 4) = o1; *(f32x4*)co = p0; *(f32x4*)(co + 4) = p1; }
}
__device__ __forceinline__ int next_item(LAS int* ctr, int lane) {
    int j = 0; if (lane == 0) j = __hip_atomic_fetch_add(ctr, 1, __ATOMIC_RELAXED, __HIP_MEMORY_SCOPE_WORKGROUP);
    return __builtin_amdgcn_readfirstlane(j);
}
__device__ __forceinline__ void phase_chunk(const Args& a, int l, LAS unsigned char* lds) {
    const int tid = tid_now(), lane = tid & 63, wid = __builtin_amdgcn_readfirstlane(tid >> 6);
    LAS bf16_t* vT = (LAS bf16_t*)(lds + wid * 16384); LAS bf16_t* kdT = vT + 64 * VS;
    LAS int* ctr = (LAS int*)(lds + MISC_OFF + 16);
    if (tid == 0) *ctr = 0;
    __syncthreads();
    const int b = blockIdx.x, G = gridDim.x, nL = b < 512 ? (511 - b) / G + 1 : 0, cx = (G >= 48 ? (b >= 32 && b < 48) : (b < 16)) ? 1 : 0, cxt = 512 + (G >= 48 ? b - 32 : b);
    for (;;) { int j = next_item(ctr, lane);
        if (j < 4 * nL) { chunk_gla_item(a, l, b + G * (j >> 2), j & 3, lane, vT, kdT); continue; }
        j -= 4 * nL;
        if (j < 4 * cx) { chunk_gla_item(a, l, cxt, j & 3, lane, vT, kdT); continue; }
        j -= 4 * cx; if (j >= 8 * nL) break;
        chunk_agv_item(a, (b + G * (j >> 3)) * 64 + (j & 7) * 8, lane);
    }
}
__device__ __forceinline__ void mixer_gla_item(const Args& a, int l, int tile, int h, int lane, LAS bf16_t* vT) {
    const bf16_t* cols0 = (const bf16_t*)(a.ws + WS_COLS) + (size_t)tile * 64 * NINP;
    const bf16_t* SIN = (const bf16_t*)(a.ws + WS_SIN); bf16_t* MIX = (bf16_t*)(a.ws + WS_MIX);
    const ChunkPos cp = chunk_pos(tile);
    const f32x16 zero16 = {0.f, 0.f, 0.f, 0.f, 0.f, 0.f, 0.f, 0.f, 0.f, 0.f, 0.f, 0.f, 0.f, 0.f, 0.f, 0.f};
    stage_vT(cols0, h, lane, vT);
    LDS_WAIT(); asm volatile("" ::: "memory");
    f32x16 OT[2][2] = {{zero16, zero16}, {zero16, zero16}};
#pragma unroll 1
    for (int dir = 0; dir < 2; ++dir) {
        int ln = lane; asm volatile("" : "+v"(ln)); const int r = ln & 31, hf = ln >> 5;
        bf16x8 QD[2][2], KI[2][2];
        const bf16_t* st = SIN + ((size_t)((dir * 4 + cp.b) * 4 + h) * NSEQ + (dir ? cp.sb : cp.sf)) * 2048;
        u32x2 sraw[2][2][2];
        { float gw8[8], gbias; bf16x8 Az[2]; u32x2 qraw[2][4], kraw[2][4];
            gla_gate_loads(a, l, h, dir, cols0, ln, gw8, gbias, Az);
#pragma unroll
            for (int nt = 0; nt < 2; ++nt)
#pragma unroll
                for (int g = 0; g < 4; ++g) { const bf16_t* qp = cols0 + (size_t)(32 * nt + r) * NINP + C_Q + 32 * h + 4 * hf + 8 * g; qraw[nt][g] = *(const u32x2*)qp; kraw[nt][g] = *(const u32x2*)(qp + (C_K - C_Q)); }
#pragma unroll
            for (int ct = 0; ct < 2; ++ct)
#pragma unroll
                for (int s = 0; s < 2; ++s) { const size_t off = (size_t)(32 * ct + r) * 32 + 16 * s + 4 * hf; sraw[ct][s][0] = *(const u32x2*)(st + off); sraw[ct][s][1] = *(const u32x2*)(st + off + 8); }
#pragma unroll
            for (int j = 0; j < 8; ++j) PIN(gw8[j]);
            PIN(gbias); PIN(Az[0]); PIN(Az[1]);
#pragma unroll
            for (int nt = 0; nt < 2; ++nt)
#pragma unroll
                for (int g = 0; g < 4; ++g) { PIN(qraw[nt][g]); PIN(kraw[nt][g]); }
#pragma unroll
            for (int ct = 0; ct < 2; ++ct)
#pragma unroll
                for (int s = 0; s < 2; ++s) { PIN(sraw[ct][s][0]); PIN(sraw[ct][s][1]); }
            f32x16 BT[2]; gla_prep_dir(dir, ln, gw8, gbias, Az, BT);
#pragma unroll
            for (int nt = 0; nt < 2; ++nt) {
                float qd[16], ki[16];
#pragma unroll
                for (int g = 0; g < 4; ++g) { const u32x2 qw = qraw[nt][g], kw = kraw[nt][g];
                    const float qf[4] = {bflo(qw.x), bfhi(qw.x), bflo(qw.y), bfhi(qw.y)}, kf[4] = {bflo(kw.x), bfhi(kw.x), bflo(kw.y), bfhi(kw.y)};
#pragma unroll
                    for (int q = 0; q < 4; ++q) { const float bb = BT[nt][4 * g + q]; qd[4 * g + q] = qf[q] * 0.17677669529663687f * __expf(bb); ki[4 * g + q] = kf[q] * __expf(-bb); } }
#pragma unroll
                for (int s = 0; s < 2; ++s) { QD[nt][s] = pack8f(qd[8 * s], qd[8 * s + 1], qd[8 * s + 2], qd[8 * s + 3], qd[8 * s + 4], qd[8 * s + 5], qd[8 * s + 6], qd[8 * s + 7]);
                    KI[nt][s] = pack8f(ki[8 * s], ki[8 * s + 1], ki[8 * s + 2], ki[8 * s + 3], ki[8 * s + 4], ki[8 * s + 5], ki[8 * s + 6], ki[8 * s + 7]); }
            }
        }
#pragma unroll
        for (int jt = 0; jt < 2; ++jt)
#pragma unroll
            for (int it = 0; it < 2; ++it) {
                if (jt != it) { const bool keep = dir ? (jt > it) : (jt < it); if (!keep) continue; }
                f32x16 p = MFMA32(KI[jt][0], QD[it][0], zero16); p = MFMA32(KI[jt][1], QD[it][1], p);
                if (jt == it) {
#pragma unroll
                    for (int i = 0; i < 16; ++i) { const int jj = (i & 3) + 8 * (i >> 2) + 4 * hf; const bool kp_ = dir ? (jj >= r) : (jj <= r); p[i] = kp_ ? p[i] : 0.f; }
                }
                const bf16x8 P0 = pack_step(p, 0), P1 = pack_step(p, 1);
#pragma unroll
                for (int ct = 0; ct < 2; ++ct) {
                    const LAS bf16_t* vp = vT + (32 * ct + r) * VS + 32 * jt + 4 * hf;
                    const bf16x8 A0 = cat44(*(const LAS u32x2*)vp, *(const LAS u32x2*)(vp + 8)), A1 = cat44(*(const LAS u32x2*)(vp + 16), *(const LAS u32x2*)(vp + 24));
                    OT[ct][it] = MFMA32(A0, P0, OT[ct][it]); OT[ct][it] = MFMA32(A1, P1, OT[ct][it]); }
            }
#pragma unroll
        for (int ct = 0; ct < 2; ++ct)
#pragma unroll
            for (int s = 0; s < 2; ++s) {
                const bf16x8 As = cat44(sraw[ct][s][0], sraw[ct][s][1]);
                OT[ct][0] = MFMA32(As, QD[0][s], OT[ct][0]); OT[ct][1] = MFMA32(As, QD[1][s], OT[ct][1]); }
    }
    int ln2 = lane; asm volatile("" : "+v"(ln2)); const int r = ln2 & 31, hf = ln2 >> 5;
    u32x2 graw[2][2][4]; f32x4 gor[2][4];
#pragma unroll
    for (int ct = 0; ct < 2; ++ct)
#pragma unroll
        for (int g = 0; g < 4; ++g) { const int c0 = 32 * ct + 8 * g + 4 * hf; gor[ct][g] = *(const f32x4*)(a.in[I_GOUT] + l * 256 + 64 * h + c0);
#pragma unroll
            for (int it = 0; it < 2; ++it) graw[it][ct][g] = *(const u32x2*)(cols0 + (size_t)(32 * it + r) * NINP + C_G + 64 * h + c0); }
#pragma unroll
    for (int ct = 0; ct < 2; ++ct)
#pragma unroll
        for (int g = 0; g < 4; ++g) { PIN(gor[ct][g]); PIN(graw[0][ct][g]); PIN(graw[1][ct][g]); }
#pragma unroll
    for (int it = 0; it < 2; ++it) {
        float ss = 0.f;
#pragma unroll
        for (int ct = 0; ct < 2; ++ct)
#pragma unroll
            for (int i = 0; i < 16; ++i) ss += OT[ct][it][i] * OT[ct][it][i];
        ss = swap32_add(ss, ss);
        const float rs = rsqrtf(ss * (1.0f / 64.0f) + EPS);
        const int t = 32 * it + r;
#pragma unroll
        for (int ct = 0; ct < 2; ++ct)
#pragma unroll
            for (int g = 0; g < 4; ++g) { const int c0 = 32 * ct + 8 * g + 4 * hf;
                const u32x2 gw_ = graw[it][ct][g];
                const f32x4 go = gor[ct][g];
                const float o0 = OT[ct][it][4 * g] * rs * go[0] * siluf_(bflo(gw_.x)), o1 = OT[ct][it][4 * g + 1] * rs * go[1] * siluf_(bfhi(gw_.x));
                const float o2 = OT[ct][it][4 * g + 2] * rs * go[2] * siluf_(bflo(gw_.y)), o3 = OT[ct][it][4 * g + 3] * rs * go[3] * siluf_(bfhi(gw_.y));
                u32x2 w; w.x = pk2c(o0, o1); w.y = pk2c(o2, o3);
                *(u32x2*)(MIX + (size_t)(tile * 64 + t) * D + 64 * h + c0) = w; }
    }
    LDS_WAIT(); asm volatile("" ::: "memory");
}
template <int TAPS>
__device__ __forceinline__ void vconv_item(const float* SRC, float* DST, const float* w  , int b, int col, int chg, LAS float* buf, int lane) {
    const int ch = lane & 31, rh = lane >> 5;
    const size_t base = ((size_t)b * SEQ + col) * 128 + chg * 32 + ch;
#pragma unroll 8
    for (int r = 0; r < 128; r += 2) buf[(r + rh) * 32 + ch] = SRC[base + (size_t)(r + rh) * 64 * 128];
    float wt[TAPS];
#pragma unroll
    for (int j = 0; j < TAPS; ++j) wt[j] = w[j * 256 + chg * 32 + ch];
    LDS_WAIT(); asm volatile("" ::: "memory");
    constexpr int HW = TAPS / 2;
#pragma unroll 1
    for (int r0 = 0; r0 < 64; r0 += 8) {
        const int rb = rh * 64 + r0;
        float o[8] = {0.f, 0.f, 0.f, 0.f, 0.f, 0.f, 0.f, 0.f};
#pragma unroll
        for (int j = 0; j < TAPS + 7; ++j) { const int rin = rb - HW + j; const float x = (rin >= 0 && rin < 128) ? buf[rin * 32 + ch] : 0.f;
#pragma unroll
            for (int q = 0; q < 8; ++q) { if (j - q >= 0 && j - q < TAPS) o[q] += x * wt[j - q]; } }
#pragma unroll
        for (int q = 0; q < 8; ++q) DST[base + (size_t)(rb + q) * 64 * 128] = o[q];
    }
    LDS_WAIT(); asm volatile("" ::: "memory");
}
__device__ __forceinline__ void phase_scan(const Args& a, int l, LAS unsigned char* lds) {
    const int tid = tid_now(), lane = tid & 63, wid = __builtin_amdgcn_readfirstlane(tid >> 6);
    const float* KV = (const float*)(a.ws + WS_KV); const float* DEC = (const float*)(a.ws + WS_DEC); bf16_t* SIN = (bf16_t*)(a.ws + WS_SIN);
    if (tid < 256) {
        for (int rp = 0; rp < ((REP_SUB == 5 && l == 0) ? 2 : 1); ++rp)
        for (int gid = blockIdx.x * 256 + tid; gid < 65536; gid += gridDim.x * 256) {
            const int e = gid >> 11, idx = gid & 2047;
            const float* p = KV + (size_t)e * NSEQ * 2048 + idx; const float* dp = DEC + (size_t)e * NSEQ * 32 + (idx & 31); bf16_t* q = SIN + (size_t)e * NSEQ * 2048 + idx;
            float st = 0.f;
#pragma unroll 1
            for (int s0 = 0; s0 < NSEQ; s0 += 22) {
                float kv[22], dd[22];
#pragma unroll
                for (int u = 0; u < 22; ++u) { kv[u] = p[(size_t)(s0 + u) * 2048]; dd[u] = dp[(s0 + u) * 32]; }
#pragma unroll
                for (int u = 0; u < 22; ++u) { PIN(kv[u]); PIN(dd[u]); }
#pragma unroll
                for (int u = 0; u < 22; ++u) { q[(size_t)(s0 + u) * 2048] = (bf16_t)(pk2c(st, 0.f) & 0xffffu); st = dd[u] * st + kv[u]; }
            }
        }
    }
    LAS float* buf = (LAS float*)(lds + wid * 16384);
    const int gw = blockIdx.x * 8 + wid, NGW = gridDim.x * 8;
    for (int rp = 0; rp < ((REP_SUB == 6 && l == 0) ? 2 : 1); ++rp)
    for (int it = gw; it < 2048; it += NGW) {
        const int kind = it >> 10, q = it & 1023, b = q >> 8, col = (q >> 2) & 63, chg = q & 3;
        if (kind == 0) vconv_item<31>((const float*)(a.ws + WS_AGV), (float*)(a.ws + WS_UV), a.in[I_CONFW] + (size_t)l * 31 * 256 + 128, b, col, chg, buf, lane);
        else vconv_item<3>((const float*)(a.ws + WS_CXV), (float*)(a.ws + WS_SCV), a.in[I_SCW] + (size_t)l * 3 * 256 + 128, b, col, chg, buf, lane);
    }
}

__device__ __forceinline__ void mixer_conv_item(const Args& a, int l, int tile, int tg, int lane0, LAS float* U) {
    const bf16_t* COLS = (const bf16_t*)(a.ws + WS_COLS); bf16_t* MIX = (bf16_t*)(a.ws + WS_MIX);
    const int row0 = tile * 64, T0 = 16 * tg;
    const float* confw = a.in[I_CONFW] + (size_t)l * 31 * 256; const float* scw = a.in[I_SCW] + (size_t)l * 3 * 256;
#pragma unroll 1
    for (int p = 0; p < 2; ++p) {
        int lane = lane0; asm volatile("" : "+v"(lane));
        const int c = 64 * p + lane;
        float wv[31];
#pragma unroll
        for (int j = 0; j < 31; ++j) wv[j] = confw[j * 256 + c];
        float bias = a.in[I_CONFB][l * 256 + c];
        unsigned ra[46], rg[46];
#pragma unroll
        for (int i = 0; i < 46; ++i) { const int t = T0 - 15 + i, tc = t < 0 ? 0 : (t > 63 ? 63 : t); const bf16_t* rp = COLS + (size_t)(row0 + tc) * NINP + c; ra[i] = rp[C_CA]; rg[i] = rp[C_CG]; }
#pragma unroll
        for (int j = 0; j < 31; ++j) PIN(wv[j]);
        PIN(bias);
#pragma unroll
        for (int i = 0; i < 46; ++i) { PIN(ra[i]); PIN(rg[i]); }
        float ag[46];
#pragma unroll
        for (int i = 0; i < 46; ++i) { const int t = T0 - 15 + i; const float m = (t >= 0 && t < 64) ? 1.0f : 0.0f;
            ag[i] = m * __uint_as_float(ra[i] << 16) * __builtin_amdgcn_rcpf(1.0f + __expf(-__uint_as_float(rg[i] << 16))); }
#pragma unroll
        for (int q = 0; q < 16; ++q) { float o = bias;
#pragma unroll
            for (int j = 0; j < 31; ++j) o += ag[q + j] * wv[j];
            U[q * 256 + ((((c >> 2) ^ q) << 2) | (c & 3))] = o; }
        unsigned rc[18], rx[18], rsb[16];
        float w0 = scw[c], w1 = scw[256 + c], w2 = scw[512 + c];
#pragma unroll
        for (int i = 0; i < 18; ++i) { const int t = T0 - 1 + i, tc = t < 0 ? 0 : (t > 63 ? 63 : t); const bf16_t* rp = COLS + (size_t)(row0 + tc) * NINP + c; rc[i] = rp[C_SC]; rx[i] = rp[C_SX]; }
#pragma unroll
        for (int q = 0; q < 16; ++q) rsb[q] = COLS[(size_t)(row0 + T0 + q) * NINP + C_SB + c];
        PIN(w0); PIN(w1); PIN(w2);
#pragma unroll
        for (int i = 0; i < 18; ++i) { PIN(rc[i]); PIN(rx[i]); }
#pragma unroll
        for (int q = 0; q < 16; ++q) PIN(rsb[q]);
        float cx[18];
#pragma unroll
        for (int i = 0; i < 18; ++i) { const int t = T0 - 1 + i; const float m = (t >= 0 && t < 64) ? 1.0f : 0.0f; cx[i] = m * __uint_as_float(rc[i] << 16) * __uint_as_float(rx[i] << 16); }
#pragma unroll
        for (int q = 0; q < 16; ++q) { const float cv = cx[q] * w0 + cx[q + 1] * w1 + cx[q + 2] * w2;
            MIX[(size_t)(row0 + T0 + q) * D + 512 + c] = (bf16_t)(pk2c(__uint_as_float(rsb[q] << 16) * cv, 0.f) & 0xffffu); }
    }
    {
        int lane = lane0; asm volatile("" : "+v"(lane));
        const float* UV = (const float*)(a.ws + WS_UV); const float* SCV = (const float*)(a.ws + WS_SCV);
        f32x4 uu[8], svv[8], bzz[8]; u32x2 sbb[8];
#pragma unroll
        for (int k8 = 0; k8 < 8; ++k8) { const int idx = lane + 64 * k8, t = idx >> 5, c4 = (idx & 31) * 4; const size_t row = (size_t)(row0 + T0 + t);
            uu[k8] = *(const f32x4*)(UV + row * 128 + c4); bzz[k8] = *(const f32x4*)(a.in[I_CONFB] + l * 256 + 128 + c4);
            svv[k8] = *(const f32x4*)(SCV + row * 128 + c4); sbb[k8] = *(const u32x2*)(COLS + row * NINP + C_SB + 128 + c4); }
#pragma unroll
        for (int k8 = 0; k8 < 8; ++k8) { PIN(uu[k8]); PIN(bzz[k8]); PIN(svv[k8]); PIN(sbb[k8]); }
#pragma unroll
        for (int k8 = 0; k8 < 8; ++k8) { const int idx = lane + 64 * k8, t = idx >> 5, c4 = (idx & 31) * 4; const size_t row = (size_t)(row0 + T0 + t);
            *(LAS f32x4*)(U + t * 256 + ((((128 + c4) >> 2) ^ t) << 2)) = uu[k8] + bzz[k8];
            u32x2 w; w.x = pk2c(bflo(sbb[k8].x) * svv[k8][0], bfhi(sbb[k8].x) * svv[k8][1]); w.y = pk2c(bflo(sbb[k8].y) * svv[k8][2], bfhi(sbb[k8].y) * svv[k8][3]);
            *(u32x2*)(MIX + row * D + 512 + 128 + c4) = w; }
    }
    LDS_WAIT(); asm volatile("" ::: "memory");
    {
        int lane = lane0; asm volatile("" : "+v"(lane));
        const int t = lane >> 2, qd = lane & 3;
        f32x4 lgv[16], lbv[16];
        { const float* lg = a.in[I_CONFG] + l * 256 + 64 * qd; const float* lb = a.in[I_CONFBETA] + l * 256 + 64 * qd;
#pragma unroll
            for (int i = 0; i < 16; ++i) { lgv[i] = *(const f32x4*)(lg + 4 * i); lbv[i] = *(const f32x4*)(lb + 4 * i); }
#pragma unroll
            for (int i = 0; i < 16; ++i) { PIN(lgv[i]); PIN(lbv[i]); } }
        f32x4 v[16]; float s1 = 0.f;
#pragma unroll
        for (int i = 0; i < 16; ++i) { v[i] = *(const LAS f32x4*)(U + t * 256 + (((16 * qd + i) ^ t) << 2)); s1 += (v[i][0] + v[i][1]) + (v[i][2] + v[i][3]); }
        s1 = quad_sum(s1);
        const float mean = s1 * (1.0f / 256.0f); float s2 = 0.f;
#pragma unroll
        for (int i = 0; i < 16; ++i) { v[i] = v[i] - mean; s2 += (v[i][0] * v[i][0] + v[i][1] * v[i][1]) + (v[i][2] * v[i][2] + v[i][3] * v[i][3]); }
        s2 = quad_sum(s2);
        const float rstd = rsqrtf(s2 * (1.0f / 256.0f) + EPS);
        bf16_t* dst = MIX + (size_t)(row0 + T0 + t) * D + 256 + 64 * qd;
#pragma unroll
        for (int i = 0; i < 16; i += 2) { const f32x4 g0 = lgv[i], g1 = lgv[i + 1], b0 = lbv[i], b1 = lbv[i + 1];
            const f32x4 y0 = v[i] * rstd * g0 + b0, y1 = v[i + 1] * rstd * g1 + b1;
            u32x4 w; w.x = pk2c(siluf_(y0[0]), siluf_(y0[1])); w.y = pk2c(siluf_(y0[2]), siluf_(y0[3])); w.z = pk2c(siluf_(y1[0]), siluf_(y1[1])); w.w = pk2c(siluf_(y1[2]), siluf_(y1[3]));
            *(u32x4*)(dst + 4 * i) = w; }
    }
    LDS_WAIT(); asm volatile("" ::: "memory");
}
__device__ __forceinline__ void mixer_pool_item(const Args& a, int l, int tile, int g, int lane0) {
    const bf16_t* COLS = (const bf16_t*)(a.ws + WS_COLS); bf16_t* MIX = (bf16_t*)(a.ws + WS_MIX);
    const f32x16 zero16 = {0.f, 0.f, 0.f, 0.f, 0.f, 0.f, 0.f, 0.f, 0.f, 0.f, 0.f, 0.f, 0.f, 0.f, 0.f, 0.f};
    const int row0 = tile * 64;
    {
        int lane = lane0; asm volatile("" : "+v"(lane));
        const int r = lane & 31, hf = lane >> 5, hw = 1 << g;
        const bf16_t* pwt = (const bf16_t*)(a.ws + WS_PWT) + (size_t)(l * 4 + g) * 4096;
        const u32x4* band = (const u32x4*)(a.ws + WS_BAND) + (size_t)g * 512 + lane;
        f32x16 Y[2][2] = {{zero16, zero16}, {zero16, zero16}};
        bf16x8 Ax[2][4], Bw[2][4]; u32x4 Bb[8];
#pragma unroll
        for (int mt = 0; mt < 2; ++mt)
#pragma unroll
            for (int ks = 0; ks < 4; ++ks) { Ax[mt][ks] = *(const bf16x8*)(COLS + (size_t)(row0 + 32 * mt + r) * NINP + C_PL + 64 * g + 16 * ks + 8 * hf);
                Bw[mt][ks] = *(const bf16x8*)(pwt + (size_t)(32 * mt + r) * 64 + 16 * ks + 8 * hf); }
#pragma unroll
        for (int f = 0; f < 8; ++f) Bb[f] = band[f * 64];
        f32x4 psv[2][4];
#pragma unroll
        for (int ntd = 0; ntd < 2; ++ntd)
#pragma unroll
            for (int q = 0; q < 4; ++q) psv[ntd][q] = *(const f32x4*)(a.in[I_POOLS] + l * 256 + 64 * g + 32 * ntd + 8 * q + 4 * hf);
#pragma unroll
        for (int mt = 0; mt < 2; ++mt)
#pragma unroll
            for (int ks = 0; ks < 4; ++ks) { PIN(Ax[mt][ks]); PIN(Bw[mt][ks]); }
#pragma unroll
        for (int f = 0; f < 8; ++f) PIN(Bb[f]);
#pragma unroll
        for (int ntd = 0; ntd < 2; ++ntd)
#pragma unroll
            for (int q = 0; q < 4; ++q) PIN(psv[ntd][q]);
#pragma unroll
        for (int mt = 0; mt < 2; ++mt) {
#pragma unroll
            for (int ntd = 0; ntd < 2; ++ntd) {
                f32x16 z = zero16;
#pragma unroll
                for (int ks = 0; ks < 4; ++ks) z = MFMA32(Ax[mt][ks], Bw[ntd][ks], z);
#pragma unroll
                for (int sq = 0; sq < 2; ++sq) {
                    const float t8[8] = {z[8 * sq], z[8 * sq + 1], z[8 * sq + 2], z[8 * sq + 3], z[8 * sq + 4], z[8 * sq + 5], z[8 * sq + 6], z[8 * sq + 7]};
                    bf16x8 Zh, Zl; split8(t8, Zh, Zl);
#pragma unroll
                    for (int ntt = 0; ntt < 2; ++ntt) { const bf16x8 Bq = __builtin_bit_cast(bf16x8, Bb[(mt * 2 + ntt) * 2 + sq]);
                        Y[ntd][ntt] = MFMA32(Zh, Bq, Y[ntd][ntt]); Y[ntd][ntt] = MFMA32(Zl, Bq, Y[ntd][ntt]); }
                }
            }
        }
#pragma unroll
        for (int ntt = 0; ntt < 2; ++ntt) { const int t = 32 * ntt + r; int lo = t - hw, hi = t + hw; lo = lo < 0 ? 0 : lo; hi = hi > 64 ? 64 : hi; const float inv = 1.0f / (float)(hi - lo);
#pragma unroll
            for (int ntd = 0; ntd < 2; ++ntd)
#pragma unroll
                for (int q = 0; q < 4; ++q) { const int dd0 = 32 * ntd + 8 * q + 4 * hf; const f32x4 ps = psv[ntd][q];
                    u32x2 w; w.x = pk2c(Y[ntd][ntt][4 * q] * inv * ps[0], Y[ntd][ntt][4 * q + 1] * inv * ps[1]); w.y = pk2c(Y[ntd][ntt][4 * q + 2] * inv * ps[2], Y[ntd][ntt][4 * q + 3] * inv * ps[3]);
                    *(u32x2*)(MIX + (size_t)(row0 + t) * D + 768 + 64 * g + dd0) = w; } }
    }
}

__device__ __forceinline__ void mixer_local(const Args& a, int l, int tile, int half, LAS unsigned char* lds) {
    const int tid = tid_now();
    const bf16_t* COLS = (const bf16_t*)(a.ws + WS_COLS); bf16_t* MIX = (bf16_t*)(a.ws + WS_MIX);
    LAS float* AG = (LAS float*)lds;
    LAS float* U = AG + 7936;
    LAS float* CX = U + 8192;
    const bool lat = tile < 512; const int r0 = tile * 64 + half * 32;
    const int seq_lo = lat ? tile * 64 : (NLAT + ((tile - 512) >> 2) * CTXL), seq_hi = lat ? tile * 64 + 64 : seq_lo + CTXL;
    const float* confw = a.in[I_CONFW] + (size_t)l * 31 * 256; const float* scw = a.in[I_SCW] + (size_t)l * 3 * 256;
    const int npass = lat ? 1 : 2;
    for (int ps = 0; ps < npass; ++ps) {
        const int chb = ps * 128;
        for (int idx = tid; idx < 62 * 16; idx += 512) { const int tt = idx >> 4, c8 = (idx & 15) * 8, r = r0 - 15 + tt;
            float o[8] = {0.f, 0.f, 0.f, 0.f, 0.f, 0.f, 0.f, 0.f};
            if (r >= seq_lo && r < seq_hi) { const bf16_t* rp = COLS + (size_t)r * NINP; float fa[8], fg[8]; unpack8(*(const u32x4*)(rp + C_CA + chb + c8), fa); unpack8(*(const u32x4*)(rp + C_CG + chb + c8), fg);
#pragma unroll
                for (int i = 0; i < 8; ++i) o[i] = fa[i] * sigmoidf_(fg[i]); }
            *(LAS f32x4*)(AG + tt * 128 + c8) = (f32x4){o[0], o[1], o[2], o[3]}; *(LAS f32x4*)(AG + tt * 128 + c8 + 4) = (f32x4){o[4], o[5], o[6], o[7]}; }
        for (int idx = tid; idx < 34 * 16; idx += 512) { const int tt = idx >> 4, c8 = (idx & 15) * 8, r = r0 - 1 + tt;
            float o[8] = {0.f, 0.f, 0.f, 0.f, 0.f, 0.f, 0.f, 0.f};
            if (r >= seq_lo && r < seq_hi) { const bf16_t* rp = COLS + (size_t)r * NINP; float fc[8], fx[8]; unpack8(*(const u32x4*)(rp + C_SC + chb + c8), fc); unpack8(*(const u32x4*)(rp + C_SX + chb + c8), fx);
#pragma unroll
                for (int i = 0; i < 8; ++i) o[i] = fc[i] * fx[i]; }
            *(LAS f32x4*)(CX + tt * 128 + c8) = (f32x4){o[0], o[1], o[2], o[3]}; *(LAS f32x4*)(CX + tt * 128 + c8 + 4) = (f32x4){o[4], o[5], o[6], o[7]}; }
        __syncthreads();
        { const int c = tid & 127, t0 = (tid >> 7) * 8;
            float wv[31];
#pragma unroll
            for (int j = 0; j < 31; ++j) wv[j] = confw[j * 256 + chb + c];
            const float bias = a.in[I_CONFB][l * 256 + chb + c];
            const float w0 = scw[chb + c], w1 = scw[256 + chb + c], w2 = scw[512 + chb + c];
            float o[8];
#pragma unroll
            for (int q = 0; q < 8; ++q) o[q] = bias;
#pragma unroll
            for (int j = 0; j < 38; ++j) { const float x = AG[(t0 + j) * 128 + c];
#pragma unroll
                for (int q = 0; q < 8; ++q) { if (j - q >= 0 && j - q < 31) o[q] += x * wv[j - q]; } }
#pragma unroll
            for (int q = 0; q < 8; ++q) U[(t0 + q) * 256 + chb + c] = o[q];
            unsigned sbr[8];
#pragma unroll
            for (int q = 0; q < 8; ++q) sbr[q] = COLS[(size_t)(r0 + t0 + q) * NINP + C_SB + chb + c];
#pragma unroll
            for (int q = 0; q < 8; ++q) PIN(sbr[q]);
#pragma unroll
            for (int q = 0; q < 8; ++q) { const int t = t0 + q; const float cv = CX[t * 128 + c] * w0 + CX[(t + 1) * 128 + c] * w1 + CX[(t + 2) * 128 + c] * w2;
                const float sb = __uint_as_float(sbr[q] << 16);
                MIX[(size_t)(r0 + t) * D + 512 + chb + c] = (bf16_t)(pk2(sb * cv, 0.f) & 0xffffu); }
        }
        __syncthreads();
    }
    if (lat) {
        const float* UV = (const float*)(a.ws + WS_UV); const float* SCV = (const float*)(a.ws + WS_SCV);
        for (int idx = tid; idx < 32 * 32; idx += 512) { const int t = idx >> 5, c4 = (idx & 31) * 4;
            const f32x4 u = *(const f32x4*)(UV + (size_t)(r0 + t) * 128 + c4), bz = *(const f32x4*)(a.in[I_CONFB] + l * 256 + 128 + c4);
            *(LAS f32x4*)(U + t * 256 + 128 + c4) = u + bz;
            const f32x4 sv = *(const f32x4*)(SCV + (size_t)(r0 + t) * 128 + c4);
            const u32x2 sbw = *(const u32x2*)(COLS + (size_t)(r0 + t) * NINP + C_SB + 128 + c4);
            u32x2 w; w.x = pk2(bflo(sbw.x) * sv[0], bfhi(sbw.x) * sv[1]); w.y = pk2(bflo(sbw.y) * sv[2], bfhi(sbw.y) * sv[3]);
            *(u32x2*)(MIX + (size_t)(r0 + t) * D + 512 + 128 + c4) = w; }
        __syncthreads();
    }
    { const int t = tid >> 4, c0 = (tid & 15) * 16;
        float s = 0.f;
#pragma unroll
        for (int i = 0; i < 16; i += 4) { const f32x4 v = *(const LAS f32x4*)(U + t * 256 + c0 + i); s += (v[0] + v[1]) + (v[2] + v[3]); }
        s = row_sum16(s);
        const float mean = s * (1.0f / 256.0f); float q = 0.f;
#pragma unroll
        for (int i = 0; i < 16; i += 4) { const f32x4 v = *(const LAS f32x4*)(U + t * 256 + c0 + i) - mean; q += (v[0] * v[0] + v[1] * v[1]) + (v[2] * v[2] + v[3] * v[3]); }
        q = row_sum16(q);
        const float rstd = rsqrtf(q * (1.0f / 256.0f) + EPS);
        const float* lg = a.in[I_CONFG] + l * 256 + c0; const float* lb = a.in[I_CONFBETA] + l * 256 + c0;
#pragma unroll
        for (int i = 0; i < 16; i += 8) { float y[8];
#pragma unroll
            for (int k = 0; k < 8; ++k) y[k] = siluf_((U[t * 256 + c0 + i + k] - mean) * rstd * lg[i + k] + lb[i + k]);
            u32x4 w; w.x = pk2(y[0], y[1]); w.y = pk2(y[2], y[3]); w.z = pk2(y[4], y[5]); w.w = pk2(y[6], y[7]);
            *(u32x4*)(MIX + (size_t)(r0 + t) * D + 256 + c0 + i) = w; }
    }
    __syncthreads();
    for (int hf = 0; hf < 2; ++hf) {
        LAS float* PI = (LAS float*)lds;
        LAS float* DF = PI + 6144;
        LAS float* PW = DF + 4224;
        for (int idx = tid; idx < 48 * 16; idx += 512) { const int tt = idx >> 4, c8 = (idx & 15) * 8, r = r0 - 8 + tt;
            float o[8] = {0.f, 0.f, 0.f, 0.f, 0.f, 0.f, 0.f, 0.f};
            if (r >= seq_lo && r < seq_hi) unpack8(*(const u32x4*)(COLS + (size_t)r * NINP + C_PL + hf * 128 + c8), o);
            *(LAS f32x4*)(PI + tt * 128 + c8) = (f32x4){o[0], o[1], o[2], o[3]}; *(LAS f32x4*)(PI + tt * 128 + c8 + 4) = (f32x4){o[4], o[5], o[6], o[7]}; }
        for (int idx = tid; idx < 2 * 64 * 64 / 4; idx += 512) *(LAS f32x4*)(PW + idx * 4) = *(const f32x4*)(a.in[I_POOLW] + (size_t)l * 4 * 4096 + (size_t)hf * 2 * 4096 + idx * 4);
        __syncthreads();
        for (int idx = tid; idx < 32 * 128; idx += 512) { const int t = idx >> 7, c = idx & 127, g = hf * 2 + (c >> 6); const int hw = 1 << g;
            const int r = r0 + t; int lo = r - hw, hi = r + hw; lo = lo < seq_lo ? seq_lo : lo; hi = hi > seq_hi ? seq_hi : hi;
            float sm = 0.f; for (int rr = lo; rr < hi; ++rr) sm += PI[(rr - r0 + 8) * 128 + c];
            DF[t * 132 + c] = sm / (float)(hi - lo) - PI[(t + 8) * 128 + c]; }
        __syncthreads();
        { const int gl = tid >> 8, tp = (tid >> 4) & 15, dq = tid & 15; const int dd0 = dq * 4;
            f32x4 o[2] = {(f32x4){0.f, 0.f, 0.f, 0.f}, (f32x4){0.f, 0.f, 0.f, 0.f}};
#pragma unroll 2
            for (int c4 = 0; c4 < 64; c4 += 4) { f32x4 dv[2];
#pragma unroll
                for (int x = 0; x < 2; ++x) dv[x] = *(const LAS f32x4*)(DF + (tp * 2 + x) * 132 + gl * 64 + c4);
#pragma unroll
                for (int q = 0; q < 4; ++q) { const f32x4 wv = *(const LAS f32x4*)(PW + (gl * 64 + c4 + q) * 64 + dd0);
#pragma unroll
                    for (int x = 0; x < 2; ++x) o[x] += dv[x][q] * wv; } }
            const int ch = (hf * 2 + gl) * 64 + dd0; const f32x4 ps = *(const f32x4*)(a.in[I_POOLS] + l * 256 + ch);
#pragma unroll
            for (int x = 0; x < 2; ++x) { u32x2 w; w.x = pk2(o[x][0] * ps[0], o[x][1] * ps[1]); w.y = pk2(o[x][2] * ps[2], o[x][3] * ps[3]);
                *(u32x2*)(MIX + (size_t)(r0 + tp * 2 + x) * D + 768 + ch) = w; } }
        __syncthreads();
    }
}

__device__ __forceinline__ void phase_mixer(const Args& a, int l, LAS unsigned char* lds) {
    const int ntile = (l == 1) ? 512 : NCHUNK;
    { const int tid = tid_now(), lane = tid & 63, wid = __builtin_amdgcn_readfirstlane(tid >> 6);
        LAS bf16_t* vT = (LAS bf16_t*)(lds + wid * 16384);
        LAS int* ctr = (LAS int*)(lds + MISC_OFF + 16);
        if (tid == 0) *ctr = 0;
        __syncthreads();
        const int b = blockIdx.x, G = gridDim.x, nL = b < 512 ? (511 - b) / G + 1 : 0, cx = (l == 0 && (G >= 48 ? (b >= 32 && b < 48) : (b < 16))) ? 1 : 0, cxt = 512 + (G >= 48 ? b - 32 : b);
        for (;;) { int j = next_item(ctr, lane);
            if (j < 4 * nL) { mixer_gla_item(a, l, b + G * (j >> 2), j & 3, lane, vT); continue; }
            j -= 4 * nL;
            if (j < 4 * cx) { mixer_gla_item(a, l, cxt, j & 3, lane, vT); continue; }
            j -= 4 * cx;
            if (j < 4 * nL) { mixer_conv_item(a, l, b + G * (j >> 2), j & 3, lane, (LAS float*)vT); continue; }
            j -= 4 * nL; if (j >= 4 * nL) break;
            mixer_pool_item(a, l, b + G * (j >> 2), j & 3, lane); } }
    if (l == 0) {
        if ((int)gridDim.x > 32 && (int)blockIdx.x >= 32) convert_range(a, lds, CV_E0 + CV_P0_E0, CV_G, (int)blockIdx.x - 32, (int)gridDim.x - 32);
        else { if ((int)gridDim.x <= 32) convert_range(a, lds, CV_E0 + CV_P0_E0, CV_G, (int)blockIdx.x, (int)gridDim.x);
            __syncthreads();
            for (int it = blockIdx.x; it < 16 * 2; it += gridDim.x) mixer_local(a, l, 512 + (it >> 1), it & 1, lds); }
    }
}

__device__ __forceinline__ void phase_router(const Args& a, int l, LAS unsigned char* lds) {
    const int tid = tid_now(), lane = tid & 63, wid = tid >> 6;
    const int M = (l == 1) ? NLAT : MTOT;
    const float* MOD = (const float*)(a.ws + WS_MOD) + (size_t)l * 5 * 6144; unsigned char* H = a.ws + WS_H;
    LAS float* WRE = (LAS float*)lds;
    LAS int* INFO = (LAS int*)(lds + MISC_OFF + 4096);
    LAS int* HIST = (LAS int*)(lds + MISC_OFF + 2048);
    const float* wre = a.in[I_RWE] + (size_t)l * 1024 * 32; const float* wrgT = (const float*)(a.ws + WS_TAB) + (size_t)l * 4096;
    for (int i = tid; i < 1024 * 8; i += 512) { const int k = i >> 3, q = i & 7; const f32x4 w = *(const f32x4*)(wre + k * 32 + q * 4);
        WRE[(4 * q + 0) * 1024 + k] = w[0]; WRE[(4 * q + 1) * 1024 + k] = w[1]; WRE[(4 * q + 2) * 1024 + k] = w[2]; WRE[(4 * q + 3) * 1024 + k] = w[3]; }
    if (tid < 64) HIST[tid] = 0;
    __syncthreads();
    const int per = (M + gridDim.x - 1) / gridDim.x; const int r_lo = blockIdx.x * per; int r_hi = r_lo + per; if (r_hi > M) r_hi = M;
    const float rbg0 = a.in[I_RBG][l * 4 + 0], rbg1 = a.in[I_RBG][l * 4 + 1], rbg2 = a.in[I_RBG][l * 4 + 2], rbg3 = a.in[I_RBG][l * 4 + 3];
    bf16_t* XB = (bf16_t*)(a.ws + WS_XB); const bf16_t* Y1 = (const bf16_t*)(a.ws + WS_Y);
    int cur_b = -1; f32x4 GS[4], SH[4], GA[4], WGT[4][4];
#pragma unroll
    for (int g = 0; g < 4; ++g)
#pragma unroll
        for (int j = 0; j < 4; ++j) WGT[g][j] = *((const f32x4*)(wrgT + g * 1024) + lane + 64 * j);
    for (int rp = 0; rp < ((REP_SUB == 7 && l == 0) ? 2 : 1); ++rp)
#pragma unroll 1
    for (int mm = r_lo + wid; mm < r_hi; mm += 16) {
        f32x4 vv[2][4]; u32x2 yy[2][4]; int mrow[2]; bool has[2];
#pragma unroll
        for (int rr = 0; rr < 2; ++rr) { const int m = mm + 8 * rr; has[rr] = m < r_hi; const int mc = has[rr] ? m : mm; mrow[rr] = mc;
            if (l == 0) load_row(mc < NLAT ? a.in[I_X] + (size_t)mc * D : a.in[I_CTX] + (size_t)(mc - NLAT) * D, lane, vv[rr]);
            else load_row_bf(XB + (size_t)mc * D, lane, vv[rr]);
#pragma unroll
            for (int j = 0; j < 4; ++j) yy[rr][j] = *((const u32x2*)(Y1 + (size_t)mc * D) + lane + 64 * j); }
#pragma unroll
        for (int rr = 0; rr < 2; ++rr) {
            if (!has[rr]) continue;
            const int m = mrow[rr]; const int b = m < NLAT ? (m >> 13) : 4;
            if (b != cur_b) { const float* mod = MOD + (size_t)b * 6144; load_mod_cached(a.in[I_G2] + l * 1024, mod + 4 * 1024, mod + 3 * 1024, mod + 2 * 1024, lane, GS, SH, GA); cur_b = b; }
            f32x4 v[4];
#pragma unroll
            for (int j = 0; j < 4; ++j) { const u32x2 y = yy[rr][j]; v[j] = vv[rr][j] + GA[j] * (f32x4){bflo(y.x), bfhi(y.x), bflo(y.y), bfhi(y.y)}; }
            store_row_bf(XB + (size_t)m * D, lane, v);
            const float rstd = row_rstd(v);
            norm_store_cached8(v, rstd, GS, SH, H + (size_t)m * D, lane);
            f32x2 g2_[4] = {{0.f, 0.f}, {0.f, 0.f}, {0.f, 0.f}, {0.f, 0.f}};
#pragma unroll
            for (int g = 0; g < 4; ++g)
#pragma unroll
                for (int j = 0; j < 4; ++j) { const f32x4 w = WGT[g][j]; g2_[g] = fma2(LO2(v[j]), LO2(w), g2_[g]); g2_[g] = fma2(HI2(v[j]), HI2(w), g2_[g]); }
            float lg0, lg1, lg2, lg3;
            { float kk = swap16_add(swap32_add(g2_[0][0] + g2_[0][1], g2_[2][0] + g2_[2][1]), swap32_add(g2_[1][0] + g2_[1][1], g2_[3][0] + g2_[3][1]));
                kk = row_sum16(kk);
                lg0 = __int_as_float(__builtin_amdgcn_readlane(__float_as_int(kk), 0)) + rbg0; lg1 = __int_as_float(__builtin_amdgcn_readlane(__float_as_int(kk), 16)) + rbg1;
                lg2 = __int_as_float(__builtin_amdgcn_readlane(__float_as_int(kk), 32)) + rbg2; lg3 = __int_as_float(__builtin_amdgcn_readlane(__float_as_int(kk), 48)) + rbg3; }
            int grp = 0; float best = lg0; if (lg1 > best) { best = lg1; grp = 1; } if (lg2 > best) { best = lg2; grp = 2; } if (lg3 > best) { best = lg3; grp = 3; }
            const float pg = 1.0f / (__expf(lg0 - best) + __expf(lg1 - best) + __expf(lg2 - best) + __expf(lg3 - best));
            grp = __builtin_amdgcn_readfirstlane(grp);
            float ep[8];
            { const LAS float* wb = WRE + (size_t)(grp * 8) * 1024;
#pragma unroll
                for (int i = 0; i < 8; i += 2) { f32x4 w[2][4];
#pragma unroll
                    for (int u = 0; u < 2; ++u)
#pragma unroll
                        for (int j = 0; j < 4; ++j) w[u][j] = *((const LAS f32x4*)(wb + (i + u) * 1024) + lane + 64 * j);
#pragma unroll
                    for (int u = 0; u < 2; ++u)
#pragma unroll
                        for (int j = 0; j < 4; ++j) PIN(w[u][j]);
#pragma unroll
                    for (int u = 0; u < 2; ++u) { f32x2 acc_ = {0.f, 0.f};
#pragma unroll
                        for (int j = 0; j < 4; ++j) { acc_ = fma2(LO2(v[j]), LO2(w[u][j]), acc_); acc_ = fma2(HI2(v[j]), HI2(w[u][j]), acc_); }
                        ep[i + u] = acc_[0] + acc_[1]; } } }
            float le[8];
            { const bool h3 = (lane & 8) != 0;
                const float k20 = swap16_add(swap32_add(ep[0], ep[4]), swap32_add(ep[2], ep[6])), k21 = swap16_add(swap32_add(ep[1], ep[5]), swap32_add(ep[3], ep[7]));
                float kk = h3 ? k21 : k20; const float sk = h3 ? k20 : k21; kk += dppf<0x128>(sk);
                kk = oct_sum(kk);
#pragma unroll
                for (int i = 0; i < 8; ++i) le[i] = __int_as_float(__builtin_amdgcn_readlane(__float_as_int(kk), 8 * i)) + a.in[I_RBE][l * 32 + grp * 8 + i]; }
            int i0 = 0; float v0 = le[0];
#pragma unroll
            for (int i = 1; i < 8; ++i) if (le[i] > v0) { v0 = le[i]; i0 = i; }
            int i1 = -1; float v1 = -3.0e38f;
#pragma unroll
            for (int i = 0; i < 8; ++i) if (i != i0 && le[i] > v1) { v1 = le[i]; i1 = i; }
            const float w0 = 1.0f / (1.0f + __expf(v1 - v0)); const float w1 = 1.0f - w0;
            if (lane == 0) { const int lr = m - r_lo; INFO[lr * 4 + 0] = grp * 8 + i0; INFO[lr * 4 + 1] = grp * 8 + i1; INFO[lr * 4 + 2] = __float_as_int(w0 * pg); INFO[lr * 4 + 3] = __float_as_int(w1 * pg); }
        }
    }
    __syncthreads();
    const int nr = r_hi - r_lo; int lp0 = 0, lp1 = 0, ee0 = 0, ee1 = 0;
    if (tid < nr) { ee0 = INFO[tid * 4 + 0]; ee1 = INFO[tid * 4 + 1]; lp0 = atomicAdd((int*)(HIST + ee0), 1); lp1 = atomicAdd((int*)(HIST + ee1), 1); }
    __syncthreads();
    unsigned* cnt = (unsigned*)(a.ws + WS_CTL) + CW_CNT + l * 32 * 64;
    if (tid < 32) { const int c = HIST[tid]; HIST[32 + tid] = c ? (int)atomicAdd(cnt + tid * 64, (unsigned)c) : 0; }
    __syncthreads();
    if (tid < nr) { const int m = r_lo + tid; const int p0 = HIST[32 + ee0] + lp0, p1 = HIST[32 + ee1] + lp1;
        int* TL = (int*)(a.ws + WS_TOKLIST); TL[ee0 * MTOT + p0] = m; TL[ee1 * MTOT + p1] = m;
        *((i32x4*)(a.ws + WS_TOKINFO) + m) = (i32x4){(ee0 << 20) | p0, (ee1 << 20) | p1, INFO[tid * 4 + 2], INFO[tid * 4 + 3]}; }
    __syncthreads();
}

__device__ __forceinline__ int moe_tables(const Args& a, int l, LAS unsigned char* lds) {
    LAS int* TB = (LAS int*)(lds + MISC_OFF + 256); LAS int* CN = TB + 64; LAS int* TE = (LAS int*)(lds + MISC_OFF + 1024); LAS int* TM = TE + 320;
    const unsigned* cnt = (const unsigned*)(a.ws + WS_CTL) + CW_CNT + l * 32 * 64;
    { const int tq_ = tid_now(); if (tq_ < 32) CN[tq_] = (int)__hip_atomic_load(cnt + tq_ * 64, __ATOMIC_RELAXED, __HIP_MEMORY_SCOPE_AGENT); }
    __syncthreads();
    if (tid_now() == 0) { int t = 0;
#pragma unroll 1
        for (int e = 0; e < 32; ++e) { TB[e] = t; const int nt = (CN[e] + 255) >> 8;
#pragma unroll 1
            for (int q = 0; q < nt; ++q) { TE[t + q] = e; TM[t + q] = q; } t += nt; } TB[32] = t; }
    __syncthreads();
    return __builtin_amdgcn_readfirstlane(TB[32]);
}

__device__ __forceinline__ void phase_combine(const Args& a, int l, LAS unsigned char* lds) {
    const int lane = tid_now() & 63, wid = tid_now() >> 6, gw = blockIdx.x * 8 + wid, NGW = gridDim.x * 8;
    const int M = (l == 1) ? NLAT : MTOT;
    (void)moe_tables(a, l, lds);
    const LAS int* TB = (const LAS int*)(lds + MISC_OFF + 256);
    const float* MOD = (const float*)(a.ws + WS_MOD); const unsigned char* Y = (const unsigned char*)(a.ws + WS_Y); bf16_t* H = (bf16_t*)(a.ws + WS_H);
    bf16_t* XB = (bf16_t*)(a.ws + WS_XB);
    int cur_b = -1; f32x4 GS[4], SH[4], GA[4];
#pragma unroll 1
    for (int mm = gw; mm < M; mm += 2 * NGW) {
        f32x4 vv[2][4]; unsigned ya[2][4], yb[2][4]; i32x4 inf[2]; int mrow[2]; bool has[2];
#pragma unroll
        for (int rr = 0; rr < 2; ++rr) { const int m = mm + rr * NGW; has[rr] = m < M; const int mc = has[rr] ? m : mm; mrow[rr] = mc;
            inf[rr] = *((const i32x4*)(a.ws + WS_TOKINFO) + mc);
            load_row_bf(XB + (size_t)mc * D, lane, vv[rr]); }
#pragma unroll
        for (int rr = 0; rr < 2; ++rr) { const int e0 = inf[rr].x >> 20, p0 = inf[rr].x & 0xfffff, e1 = inf[rr].y >> 20, p1 = inf[rr].y & 0xfffff;
            const unsigned char* y0 = Y + (size_t)(TB[e0] * 256 + p0) * D; const unsigned char* y1 = Y + (size_t)(TB[e1] * 256 + p1) * D;
#pragma unroll
            for (int j = 0; j < 4; ++j) { ya[rr][j] = *((const unsigned*)y0 + lane + 64 * j); yb[rr][j] = *((const unsigned*)y1 + lane + 64 * j); } }
#pragma unroll
        for (int rr = 0; rr < 2; ++rr) {
            if (!has[rr]) continue;
            const int m = mrow[rr]; const int b = m < NLAT ? (m >> 13) : 4;
            const float w0s = __int_as_float(inf[rr].z) * (1.0f / 16.0f), w1s = __int_as_float(inf[rr].w) * (1.0f / 16.0f);
            if (b != cur_b) { const float* ga2 = MOD + (size_t)(l * 5 + b) * 6144 + 5 * 1024;
                if (l == 0) { const float* mod = MOD + (size_t)(5 + b) * 6144; load_mod_cached(a.in[I_G1] + 1024, mod + 1024, mod, ga2, lane, GS, SH, GA); }
                else {
#pragma unroll
                    for (int j = 0; j < 4; ++j) { GS[j] = *((const f32x4*)a.in[I_GFINAL] + lane + 64 * j); SH[j] = (f32x4){0.f, 0.f, 0.f, 0.f}; GA[j] = *((const f32x4*)ga2 + lane + 64 * j); } }
                cur_b = b; }
            f32x4 v[4];
#pragma unroll
            for (int j = 0; j < 4; ++j) { const int a0 = (int)ya[rr][j], a1 = (int)yb[rr][j];
                f32x4 y; y[0] = w0s * __builtin_amdgcn_cvt_f32_fp8(a0, 0) + w1s * __builtin_amdgcn_cvt_f32_fp8(a1, 0); y[1] = w0s * __builtin_amdgcn_cvt_f32_fp8(a0, 1) + w1s * __builtin_amdgcn_cvt_f32_fp8(a1, 1);
                y[2] = w0s * __builtin_amdgcn_cvt_f32_fp8(a0, 2) + w1s * __builtin_amdgcn_cvt_f32_fp8(a1, 2); y[3] = w0s * __builtin_amdgcn_cvt_f32_fp8(a0, 3) + w1s * __builtin_amdgcn_cvt_f32_fp8(a1, 3);
                v[j] = vv[rr][j] + GA[j] * y; }
            const float rstd = row_rstd(v);
            if (l == 0) {
                store_row_bf(XB + (size_t)m * D, lane, v);
                norm_store_cached(v, rstd, GS, SH, H + (size_t)m * D, lane);
            } else {
                float* xr = a.out + (size_t)m * D;
#pragma unroll
                for (int j = 0; j < 4; ++j) *((f32x4*)xr + lane + 64 * j) = (v[j] * rstd) * GS[j];
            }
        }
    }
}

#define XB_TMO      128
#define XB_XCNT(j)  (256  + 64 * (j))
#define XB_XSUB(j)  (1280 + 64 * (j))
#define XB_XGEN(j)  (2304 + 64 * (j))
#define XB_TOP      3328
#define XB_TOPGEN   3392
#define XCD_BAR_WORDS 3456
#define XB_SPIN_CAP (1u << 22)
__device__ __forceinline__ unsigned xb_ld(unsigned* p)              { return __hip_atomic_load(p, __ATOMIC_RELAXED, __HIP_MEMORY_SCOPE_AGENT); }
__device__ __forceinline__ unsigned xb_add(unsigned* p, unsigned v) { return __hip_atomic_fetch_add(p, v, __ATOMIC_RELAXED, __HIP_MEMORY_SCOPE_AGENT); }
__device__ __forceinline__ unsigned xb_xcc_id() { return (unsigned)__builtin_amdgcn_s_getreg((3 << 11) | 20) & 0xFu; }
#define XB_SPIN(cond, bar) do { unsigned _sp = 0; while (cond) { __builtin_amdgcn_s_sleep(1); \
    if ((++_sp & 255u) == 0u) { if (xb_ld(&(bar)[XB_TMO])) break; if (_sp > XB_SPIN_CAP) { atomicAdd(&(bar)[XB_TMO], 1u); break; } } } } while (0)
struct XcdBarrier { unsigned* bar; unsigned x; volatile LAS unsigned* st; };
__device__ __forceinline__ XcdBarrier xcd_barrier_post(unsigned* bar, volatile LAS unsigned* st) {
    XcdBarrier b; b.bar = bar; b.x = xb_xcc_id(); b.st = st;
    if (threadIdx.x == 0) (void)xb_add(&bar[XB_XCNT(b.x)], 1u);
    return b;
}
__device__ __forceinline__ void xcd_barrier_complete(unsigned* bar, unsigned x, unsigned& nloc, unsigned& nx) {
    const unsigned G = gridDim.x * gridDim.y * gridDim.z;
    unsigned sum, cnt, mine, sp = 0u;
    for (;;) {
        sum = 0u; cnt = 0u; mine = 0u;
#pragma unroll
        for (unsigned j = 0; j < 16; ++j) { const unsigned c = xb_ld(&bar[XB_XCNT(j)]); sum += c; cnt += (c > 0u) ? 1u : 0u; mine = (j == x) ? c : mine; }
        if (sum == G) break;
        __builtin_amdgcn_s_sleep(1);
        if ((++sp & 255u) == 0u) { if (xb_ld(&bar[XB_TMO])) break; if (sp > XB_SPIN_CAP) { atomicAdd(&bar[XB_TMO], 1u); break; } }
    }
    nloc = mine > 0u ? mine : 1u; nx = cnt > 0u ? cnt : 1u;
}
__device__ __forceinline__ void xcd_barrier(const XcdBarrier& b) {
    asm volatile("s_waitcnt vmcnt(0)" ::: "memory");
    __syncthreads();
    if (threadIdx.x == 0) {
        unsigned* bar = b.bar;
        __builtin_amdgcn_s_waitcnt(0);
        unsigned nloc = b.st[0], nx = b.st[1];
        if (nloc == 0u) { xcd_barrier_complete(bar, b.x, nloc, nx); b.st[0] = nloc; b.st[1] = nx; }
        const unsigned old = xb_add(&bar[XB_XSUB(b.x)], 1u);
        const unsigned gen = old / nloc;
        if (old + 1u == (gen + 1u) * nloc) {
            __builtin_amdgcn_fence(__ATOMIC_RELEASE, "agent");
            asm volatile("s_waitcnt vmcnt(0)" ::: "memory");
            const unsigned og = xb_add(&bar[XB_TOP], 1u);
            const unsigned tg = og / nx;
            if (og + 1u == (tg + 1u) * nx) xb_add(&bar[XB_TOPGEN], 1u);
            else XB_SPIN(xb_ld(&bar[XB_TOPGEN]) == tg, bar);
            __builtin_amdgcn_fence(__ATOMIC_ACQUIRE, "agent");
            xb_add(&bar[XB_XGEN(b.x)], 1u);
            asm volatile("s_waitcnt vmcnt(0)" ::: "memory");
        } else {
            XB_SPIN(xb_ld(&bar[XB_XGEN(b.x)]) == gen, bar);
            __builtin_amdgcn_fence(__ATOMIC_ACQUIRE, "agent");
            asm volatile("s_waitcnt vmcnt(0)" ::: "memory");
        }
    }
    __syncthreads();
}

constexpr int NPHASE = 20;
#ifndef DIAG_PH
#define DIAG_PH -1
#endif
#define PH_ON(x) (DIAG_PH < 0 || DIAG_PH == (x))
#ifndef REP_ID
#define REP_ID -1
#endif
__global__ void __launch_bounds__(512, 2) mega(Args a) {
    extern __shared__ __attribute__((aligned(16))) unsigned char lds_raw[];
    LAS unsigned char* lds = (LAS unsigned char*)lds_raw;
    unsigned char* ws = a.ws;
    volatile LAS unsigned* bst = (volatile LAS unsigned*)(lds + MISC_OFF);
    if (threadIdx.x < 2) bst[threadIdx.x] = 0u;
    __syncthreads();
    XcdBarrier xbar = xcd_barrier_post((unsigned*)(ws + WS_CTL) + CW_BAR, bst);
    unsigned long long tph_ = 0ull;
    for (int ph = a.ph_lo; ph < a.ph_hi; ++ph) {
      unsigned long long t0_ = 0ull; if (TIME_PH >= 0 && ph == TIME_PH) t0_ = __builtin_amdgcn_s_memrealtime();
      const int cls_ = ph < 2 ? ph : 2 + (ph - 2) % 9;
      const int nrep_ = (REP_ID >= 0 && cls_ == REP_ID) ? 2 : 1;
      for (int rep_ = 0; rep_ < nrep_; ++rep_) {
        if (rep_) xcd_barrier(xbar);
        if (PH_ON(0) && ph == 0) phase_p0(a, lds);
        else if (PH_ON(1) && ph == 1) phase_norm1_l0(a);
        else {
            const int l = (ph - 2) / 9, sp = (ph - 2) % 9;
            if (PH_ON(2) && sp == 0) {
                g8::DenseSched S; S.init(ws + WS_H, ws + WS_WIN + (size_t)l * NINP * 1024 * 2, MTOT, NINP, 1024, gridDim.x, blockIdx.x);
                g8::EpiBf16 E{(bf16_t*)(ws + WS_COLS), NINP};
                g8::gemm_phase<false>(lds, S, E);
                if (l == 0) convert_in_tail(a, lds, CV_E0 + CV_P0_E0 + CV_G, CV_A, S.nwg, S.G, S.c); else convert_in_tail(a, lds, CV_EI1 + CV_P0_EI1 + CV_C + CV_D, CV_E, S.nwg, S.G, S.c);
            } else if (PH_ON(3) && sp == 1) phase_chunk(a, l, lds);
            else if (PH_ON(4) && sp == 2) phase_scan(a, l, lds);
            else if (PH_ON(5) && sp == 3) phase_mixer(a, l, lds);
            else if (PH_ON(6) && sp == 4) {
                g8::DenseSched S; S.init(ws + WS_MIX, ws + WS_WOUT + (size_t)l * 1024 * 1024 * 2, l == 1 ? NLAT : MTOT, 1024, 1024, gridDim.x, blockIdx.x);
                g8::EpiBf16 E{(bf16_t*)(ws + WS_Y), 1024};
                g8::gemm_phase<false>(lds, S, E);
                if (l == 0) convert_in_tail(a, lds, CV_E0 + CV_P0_E0 + CV_G + CV_A, CV_B, S.nwg, S.G, S.c);
            } else if (PH_ON(7) && sp == 5) phase_router(a, l, lds);
            else if ((PH_ON(8) || PH_ON(9)) && (sp == 6 || sp == 7)) {
                const int T = moe_tables(a, l, lds);
                const int G = gridDim.x, bx = blockIdx.x, vcu = (G % 8 == 0) ? (bx % 8) * (G / 8) + bx / 8 : bx;
                const LAS int* TBp = (const LAS int*)(lds + MISC_OFF + 256);
                if (PH_ON(8) && sp == 6) {
                    g8::MoeSched<true> S; S.A = (const char*)(ws + WS_H); S.Bw = (const char*)(ws + WS_WEIN) + (size_t)l * 32 * 1024 * 1024; S.wstride = (size_t)1024 * 1024; S.K = 512;     S.T = T; S.G = G; S.c = vcu;
                    S.tile_e = (const LAS int*)(lds + MISC_OFF + 1024); S.tile_mt = S.tile_e + 320; S.cnt = TBp + 64; S.toklist = (const int*)(ws + WS_TOKLIST);
                    g8::EpiSwiGLU E{ws + WS_ACT};
                    g8::gemm_phase<true>(lds, S, E);
                    if (l == 0) convert_in_tail(a, lds, CV_EI1 + CV_P0_EI1, CV_C, 4 * T, G, vcu); else convert_in_tail(a, lds, CV_EO1 + CV_P0_EO1, CV_F, 4 * T, G, vcu);
                } else if (PH_ON(9) && sp == 7) {
                    g8::MoeSched<false> S; S.A = (const char*)(ws + WS_ACT); S.Bw = (const char*)(ws + WS_WEOUT) + (size_t)l * 32 * 1024 * 512; S.wstride = (size_t)1024 * 512; S.K = 256; S.T = T; S.G = G; S.c = vcu;
                    S.tile_e = (const LAS int*)(lds + MISC_OFF + 1024); S.tile_mt = S.tile_e + 320; S.cnt = TBp + 64; S.toklist = (const int*)(ws + WS_TOKLIST);
                    g8::EpiFp8 E{(unsigned char*)(ws + WS_Y)};
                    g8::gemm_phase<true>(lds, S, E);
                    if (l == 0) convert_in_tail(a, lds, CV_EI1 + CV_P0_EI1 + CV_C, CV_D, 4 * T, G, vcu);
                }
            } else if (PH_ON(10) && sp == 8) phase_combine(a, l, lds);
        }
      }
        if (ph + 1 < a.ph_hi) { if (a.ph_lo < 0) cg::this_grid().sync(); else xcd_barrier(xbar); }
        if (TIME_PH >= 0 && ph == TIME_PH) tph_ = __builtin_amdgcn_s_memrealtime() - t0_;
    }
    if (TIME_PH >= 0 && blockIdx.x == 0 && threadIdx.x == 0) { const unsigned long long te_ = __builtin_amdgcn_s_memrealtime(); while (__builtin_amdgcn_s_memrealtime() - te_ < 4ull * tph_) __builtin_amdgcn_s_sleep(8); }
}

extern "C" void kernel_launch(void* const* d_in, const int* in_sizes, int n_in, void* d_out, int out_size, void* d_ws, size_t ws_size, hipStream_t stream) {
    static int grid = 0;
    if (grid == 0) {
        if (n_in != 29 || out_size != NLAT * D || ws_size < WS_END) { fprintf(stderr, "kernel_launch: unexpected shapes (n_in %d out %d ws %zu)\n", n_in, out_size, ws_size); grid = -1; return; }
        int dev = 0, cus = 0, per_cu = 0;
        hipGetDevice(&dev); hipDeviceGetAttribute(&cus, hipDeviceAttributeMultiprocessorCount, dev);
        if (hipFuncSetAttribute((const void*)mega, hipFuncAttributeMaxDynamicSharedMemorySize, LDS_BYTES) != hipSuccess) { fprintf(stderr, "kernel_launch: hipFuncSetAttribute failed\n"); grid = -1; return; }
        if (hipOccupancyMaxActiveBlocksPerMultiprocessor(&per_cu, (const void*)mega, 512, LDS_BYTES) != hipSuccess || per_cu < 1) { fprintf(stderr, "kernel_launch: occupancy query says %d\n", per_cu); per_cu = 1; }
        (void)hipGetLastError();
        grid = cus;
    }
    if (grid < 0) return;
    hipMemsetAsync((char*)d_ws + WS_CTL, 0, CTL_BYTES, stream);
    Args a{};
    for (int i = 0; i < 29; ++i) a.in[i] = (const float*)d_in[i];
    a.out = (float*)d_out; a.ws = (unsigned char*)d_ws;
#if MK_MULTI
    for (int ph = 0; ph < NPHASE; ++ph) { a.ph_lo = ph; a.ph_hi = ph + 1; hipLaunchKernelGGL(mega, dim3(grid), dim3(512), LDS_BYTES, stream, a); }
#else
    a.ph_lo = 0; a.ph_hi = NPHASE;
    void* args[] = {&a};
    hipError_t e = hipLaunchCooperativeKernel((const void*)mega, dim3(grid), dim3(512), args, LDS_BYTES, stream);
    if (e != hipSuccess) fprintf(stderr, "cooperative launch failed: %s (grid %d)\n", hipGetErrorString(e), grid);
#endif
}
```

```cpp
#include <hip/hip_runtime.h>
#include <hip/hip_cooperative_groups.h>
#include <cstdio>
namespace cg = cooperative_groups;

#ifndef MK_MULTI
#define MK_MULTI 0
#endif

#ifndef TIME_PH
#define TIME_PH -1
#endif
#ifndef REP_SUB
#define REP_SUB 0
#endif

#define LAS __attribute__((address_space(3)))
typedef unsigned short bf16_t;
typedef short bf16x8 __attribute__((ext_vector_type(8)));
typedef float f32x4 __attribute__((ext_vector_type(4)));
typedef float f32x2 __attribute__((ext_vector_type(2)));
typedef unsigned u32x4 __attribute__((ext_vector_type(4)));
typedef unsigned u32x2 __attribute__((ext_vector_type(2)));
typedef int i32x4 __attribute__((ext_vector_type(4)));
typedef int i32x8 __attribute__((ext_vector_type(8)));

constexpr int D = 1024, NLAT = 32768, SEQ = 8192, NCTXT = 1024, CTXL = 256, MTOT = NLAT + NCTXT;
constexpr int NIN = 2336, NINP = 2560;
constexpr int NCHUNK = MTOT / 64, NSEQ = 132;
constexpr int NEXP = 32, DEXP = 512, SLOTS = 75776;
constexpr float EPS = 1e-6f;
constexpr float F8_YSC = 16.0f;
constexpr float F8_WSC = 256.0f, F8_HSC = 16.0f, F8_ASC = 8.0f;
constexpr int C_Q = 0, C_K = 128, C_V = 256, C_G = 512, C_ZF = 768, C_ZB = 784, C_CA = 800, C_CG = 1056, C_SB = 1312, C_SC = 1568, C_SX = 1824, C_PL = 2080;

constexpr size_t MiB = 1u << 20;
constexpr size_t WS_CTL = 0, CTL_BYTES = 1 * MiB;
constexpr size_t WS_MOD = 1 * MiB;
constexpr size_t WS_TAB = 1 * MiB + 512 * 1024;
constexpr size_t WS_PWT = WS_TAB + 64 * 1024;
constexpr size_t WS_WRET = WS_TAB + 256 * 1024;
constexpr size_t WS_BAND = WS_TAB + 192 * 1024;
constexpr size_t WS_WIN = 2 * MiB;
constexpr size_t WS_WOUT = 12 * MiB;
constexpr size_t WS_WEIN = 16 * MiB;
constexpr size_t WS_WEOUT = 144 * MiB;
constexpr size_t WS_XCTX = 208 * MiB;
constexpr size_t WS_H = 212 * MiB;
constexpr size_t WS_COLS = 278 * MiB;
constexpr size_t WS_MIX = 443 * MiB;
constexpr size_t WS_KV = 509 * MiB;
constexpr size_t WS_DEC = 542 * MiB;
constexpr size_t WS_AGV = 543 * MiB;
constexpr size_t WS_CXV = 559 * MiB;
constexpr size_t WS_UV = 575 * MiB;
constexpr size_t WS_SCV = 591 * MiB;
constexpr size_t WS_TOKINFO = 607 * MiB;
constexpr size_t WS_TOKLIST = 608 * MiB;
constexpr size_t WS_ACT = 613 * MiB;
constexpr size_t WS_Y = 687 * MiB;
constexpr size_t WS_SIN = 835 * MiB;
constexpr size_t WS_XB = 852 * MiB;
constexpr size_t WS_END = 918 * MiB;
constexpr int CW_CNT = 1024;
constexpr int CW_CHQ = 6144;
constexpr int CW_MXQ = 512;
constexpr int CW_BAR = 8192;

constexpr int LDS_BYTES = 147456;
constexpr int MISC_OFF = 131072;

__device__ __forceinline__ unsigned pk2(float lo, float hi) { unsigned r; asm("v_cvt_pk_bf16_f32 %0, %1, %2" : "=v"(r) : "v"(lo), "v"(hi)); return r; }
__device__ __forceinline__ float bflo(unsigned w) { return __uint_as_float(w << 16); }
__device__ __forceinline__ float bfhi(unsigned w) { return __uint_as_float(w & 0xffff0000u); }
__device__ __forceinline__ void unpack8(const u32x4 w, float (&f)[8]) { f[0] = bflo(w.x); f[1] = bfhi(w.x); f[2] = bflo(w.y); f[3] = bfhi(w.y); f[4] = bflo(w.z); f[5] = bfhi(w.z); f[6] = bflo(w.w); f[7] = bfhi(w.w); }
__device__ __forceinline__ float sigmoidf_(float x) { return __builtin_amdgcn_rcpf(1.0f + __expf(-x)); }
__device__ __forceinline__ float siluf_(float x) { return x * __builtin_amdgcn_rcpf(1.0f + __expf(-x)); }
__device__ __forceinline__ float logsigf_(float x) { return fminf(x, 0.0f) - log1pf(__expf(-fabsf(x))); }
template <int CTRL> __device__ __forceinline__ float dppf(float v) { return __int_as_float(__builtin_amdgcn_update_dpp(0, __float_as_int(v), CTRL, 0xF, 0xF, true)); }
__device__ __forceinline__ float quad_sum(float v) { v += dppf<0xB1>(v); v += dppf<0x4E>(v); return v; }
__device__ __forceinline__ float oct_sum(float v) { v = quad_sum(v); v += dppf<0x141>(v); return v; }
__device__ __forceinline__ float row_sum16(float v) { v = oct_sum(v); v += dppf<0x140>(v); return v; }
__device__ __forceinline__ float swap32_add(float a, float b) { const auto r = __builtin_amdgcn_permlane32_swap(__float_as_uint(a), __float_as_uint(b), false, false); return __uint_as_float(r[0]) + __uint_as_float(r[1]); }
__device__ __forceinline__ float swap16_add(float a, float b) { const auto r = __builtin_amdgcn_permlane16_swap(__float_as_uint(a), __float_as_uint(b), false, false); return __uint_as_float(r[0]) + __uint_as_float(r[1]); }
__device__ __forceinline__ float wave_sum(float v) { v = row_sum16(v); v = swap16_add(v, v); return swap32_add(v, v); }
__device__ __forceinline__ f32x2 fma2(f32x2 a, f32x2 b, f32x2 c) { return __builtin_elementwise_fma(a, b, c); }
#define LO2(x) __builtin_shufflevector((x), (x), 0, 1)
#define HI2(x) __builtin_shufflevector((x), (x), 2, 3)

typedef float f32x16 __attribute__((ext_vector_type(16)));
typedef __bf16 bf16x2_t __attribute__((ext_vector_type(2)));
#define MFMA32(a, b, c) __builtin_amdgcn_mfma_f32_32x32x16_bf16((a), (b), (c), 0, 0, 0)
__device__ __forceinline__ unsigned pk2c(float lo, float hi) { const f32x2 v = {lo, hi}; return __builtin_bit_cast(unsigned, __builtin_convertvector(v, bf16x2_t)); }
__device__ __forceinline__ bf16x8 pack8f(float x0, float x1, float x2, float x3, float x4, float x5, float x6, float x7) {
    u32x4 p; p.x = pk2c(x0, x1); p.y = pk2c(x2, x3); p.z = pk2c(x4, x5); p.w = pk2c(x6, x7); return __builtin_bit_cast(bf16x8, p); }
__device__ __forceinline__ bf16x8 pack_step(const f32x16& x, int s) { return s == 0 ? pack8f(x[0], x[1], x[2], x[3], x[4], x[5], x[6], x[7]) : pack8f(x[8], x[9], x[10], x[11], x[12], x[13], x[14], x[15]); }
__device__ __forceinline__ void split8(const float (&x)[8], bf16x8& hi, bf16x8& lo) {
    u32x4 p; p.x = pk2c(x[0], x[1]); p.y = pk2c(x[2], x[3]); p.z = pk2c(x[4], x[5]); p.w = pk2c(x[6], x[7]);
    hi = __builtin_bit_cast(bf16x8, p);
    lo = pack8f(x[0] - bflo(p.x), x[1] - bfhi(p.x), x[2] - bflo(p.y), x[3] - bfhi(p.y), x[4] - bflo(p.z), x[5] - bfhi(p.z), x[6] - bflo(p.w), x[7] - bfhi(p.w)); }
__device__ __forceinline__ bf16x8 cat44(u32x2 a, u32x2 b) { u32x4 p; p.x = a.x; p.y = a.y; p.z = b.x; p.w = b.y; return __builtin_bit_cast(bf16x8, p); }
#define LDS_WAIT() asm volatile("s_waitcnt lgkmcnt(0)" ::: "memory")
#define PIN(x) asm volatile("" : "+v"(x) :: "memory")
__device__ __forceinline__ int tid_now() { int t = threadIdx.x; asm volatile("" : "+v"(t)); return t; }

namespace g8 {
constexpr int BM = 256, BK = 64, HALF = 128, HTB = HALF * BK * 2, NXCD = 8, WGM = 8;
__device__ __forceinline__ int lds_byte(int r, int c) { const int st = (r >> 4) * 2 + (c >> 5), rr = r & 15, cc = c & 31, ob = rr * 64 + cc * 2; return st * 1024 + (ob ^ (((ob >> 9) & 1) << 5)); }
__device__ __forceinline__ void stage_rc(int b, int& R, int& C) { const int st = b / 1024, sb = b % 1024, swz = sb ^ (((sb >> 9) & 1) << 5); R = (st >> 1) * 16 + swz / 64; C = (st & 1) * 32 + (swz % 64) / 2; }
__device__ __forceinline__ int perm32(int rho) { const int n = rho >> 4, i = rho & 15; return 8 * (i >> 2) + 4 * n + (i & 3); }

__device__ __forceinline__ i32x8 cat8(bf16x8 lo, bf16x8 hi) { const i32x4 a = __builtin_bit_cast(i32x4, lo), b = __builtin_bit_cast(i32x4, hi); return __builtin_shufflevector(a, b, 0, 1, 2, 3, 4, 5, 6, 7); }
struct Unit { int pm, pn, e, mt; };

struct DenseSched {
    const char* A; const char* Bt; int K, nM, nN, nwg, G, c;
    __device__ __forceinline__ void init(const void* A_, const void* Bt_, int M, int N, int K_, int G_, int c_) { A = (const char*)A_; Bt = (const char*)Bt_; K = K_; nM = M / BM; nN = N / BM; nwg = nM * nN; G = G_; c = c_; }
    __device__ __forceinline__ bool next(int i, Unit& u) const {
        const long L = (long)i * G + c; if (L >= nwg) return false;
        int wgid = (int)L; { const int q = nwg / NXCD, r = nwg % NXCD, xcd = wgid % NXCD, off = wgid / NXCD; wgid = (xcd < r ? xcd * (q + 1) : r * (q + 1) + (xcd - r) * q) + off; }
        const int nig = WGM * nN, gid = wgid / nig, fm = gid * WGM, gsz = (nM - fm) < WGM ? (nM - fm) : WGM;
        u.pm = fm + ((wgid % nig) % gsz); u.pn = (wgid % nig) / gsz; u.e = 0; u.mt = 0; return true;
    }
    __device__ __forceinline__ unsigned a_off(const Unit& u, int h, int R, int C) const { return (unsigned)(((u.pm * BM + h * HALF + R) * K + C) * 2); }
    __device__ __forceinline__ const char* b_ptr(const Unit& u) const { return Bt + (size_t)u.pn * BM * K * 2; }
};
template <bool GATHER> struct MoeSched {
    const char* A; const char* Bw; size_t wstride; int K, T, G, c; const LAS int* tile_e; const LAS int* tile_mt; const LAS int* cnt; const int* toklist;
    __device__ __forceinline__ bool next(int i, Unit& u) const {
        const int L = i * G + c; if (L >= 4 * T) return false;
        u.pm = L >> 2; u.pn = L & 3; u.e = __builtin_amdgcn_readfirstlane(tile_e[u.pm]); u.mt = __builtin_amdgcn_readfirstlane(tile_mt[u.pm]); return true;
    }
    __device__ __forceinline__ unsigned a_off(const Unit& u, int h, int R, int C) const {
        if (GATHER) { const int pos = u.mt * BM + h * HALF + R; int tok = 0; if (pos < cnt[u.e]) tok = toklist[u.e * MTOT + pos]; return (unsigned)((tok * K + C) * 2); }
        return (unsigned)(((u.pm * BM + h * HALF + R) * K + C) * 2);
    }
    __device__ __forceinline__ const char* b_ptr(const Unit& u) const { return Bw + (size_t)u.e * wstride + (size_t)u.pn * BM * K * 2; }
};

struct EpiBf16 {
    static constexpr int PERM = 1; static constexpr int SC0 = 0x7F, SC1 = 0x7F;
    bf16_t* O; int ldc, ncols;
    __device__ __forceinline__ void operator()(const f32x4 (&acc)[2][2][4][2], const Unit& u, int wr, int wc, int fr, int fq) const {
        const int row0 = u.pm * BM + wr * 64 + fr, col0 = u.pn * BM + wc * 32 + 8 * fq;
#pragma unroll
        for (int ai = 0; ai < 2; ++ai)
#pragma unroll
            for (int m = 0; m < 4; ++m) { bf16_t* rowp = O + (size_t)(row0 + ai * HALF + m * 16) * ldc + col0;
#pragma unroll
                for (int bj = 0; bj < 2; ++bj) { const f32x4 v0 = acc[ai][bj][m][0], v1 = acc[ai][bj][m][1];
                    u32x4 w; w.x = pk2(v0[0], v0[1]); w.y = pk2(v0[2], v0[3]); w.z = pk2(v1[0], v1[1]); w.w = pk2(v1[2], v1[3]);
                    if (col0 + bj * HALF < ncols) *(u32x4*)(rowp + bj * HALF) = w; } }
    }
};
struct EpiFp8 {
    static constexpr int PERM = 2;
    static constexpr int SC0 = 0x78, SC1 = 0x78;
    unsigned char* O;
    __device__ __forceinline__ void operator()(const f32x4 (&acc)[2][2][4][2], const Unit& u, int wr, int wc, int fr, int fq) const {
        const int row0 = u.pm * BM + wr * 64 + fr, col0 = u.pn * BM + wc * 64 + 16 * fq;
        int W[4] = {0, 0, 0, 0};
#pragma unroll
        for (int ai = 0; ai < 2; ++ai)
#pragma unroll
            for (int m = 0; m < 4; ++m) { unsigned char* rowp = O + (size_t)(row0 + ai * HALF + m * 16) * 1024 + col0;
#pragma unroll
                for (int bj = 0; bj < 2; ++bj)
#pragma unroll
                    for (int n = 0; n < 2; ++n) { const f32x4 x = acc[ai][bj][m][n]; int w = W[bj * 2 + n];
                        w = __builtin_amdgcn_cvt_pk_fp8_f32(__builtin_amdgcn_fmed3f(x[0], -440.0f, 440.0f), __builtin_amdgcn_fmed3f(x[1], -440.0f, 440.0f), w, false);
                        w = __builtin_amdgcn_cvt_pk_fp8_f32(__builtin_amdgcn_fmed3f(x[2], -440.0f, 440.0f), __builtin_amdgcn_fmed3f(x[3], -440.0f, 440.0f), w, true); W[bj * 2 + n] = w; }
                *(u32x4*)rowp = (u32x4){(unsigned)W[0], (unsigned)W[1], (unsigned)W[2], (unsigned)W[3]}; }
    }
};
struct EpiFp8S {
    static constexpr int PERM = 2; static constexpr int SC0 = 0x7F, SC1 = 0x7F;
    unsigned char* O; float sc;
    __device__ __forceinline__ void operator()(const f32x4 (&acc)[2][2][4][2], const Unit& u, int wr, int wc, int fr, int fq) const {
        const int row0 = u.pm * BM + wr * 64 + fr, col0 = u.pn * BM + wc * 64 + 16 * fq;
        int W[4] = {0, 0, 0, 0};
#pragma unroll
        for (int ai = 0; ai < 2; ++ai)
#pragma unroll
            for (int m = 0; m < 4; ++m) { unsigned char* rowp = O + (size_t)(row0 + ai * HALF + m * 16) * 1024 + col0;
#pragma unroll
                for (int bj = 0; bj < 2; ++bj)
#pragma unroll
                    for (int n = 0; n < 2; ++n) { const f32x4 x = acc[ai][bj][m][n] * sc; int w = W[bj * 2 + n];
                        w = __builtin_amdgcn_cvt_pk_fp8_f32(__builtin_amdgcn_fmed3f(x[0], -440.0f, 440.0f), __builtin_amdgcn_fmed3f(x[1], -440.0f, 440.0f), w, false);
                        w = __builtin_amdgcn_cvt_pk_fp8_f32(__builtin_amdgcn_fmed3f(x[2], -440.0f, 440.0f), __builtin_amdgcn_fmed3f(x[3], -440.0f, 440.0f), w, true); W[bj * 2 + n] = w; }
                *(u32x4*)rowp = (u32x4){(unsigned)W[0], (unsigned)W[1], (unsigned)W[2], (unsigned)W[3]}; }
    }
};
struct EpiSwiGLU {
    static constexpr int PERM = 1;
    static constexpr int SC0 = 0x73, SC1 = 0x76;
    unsigned char* O;
    __device__ __forceinline__ void operator()(const f32x4 (&acc)[2][2][4][2], const Unit& u, int wr, int wc, int fr, int fq) const {
        const int row0 = u.pm * BM + wr * 64 + fr, col0 = u.pn * HALF + wc * 32 + 8 * fq;
        int W[2] = {0, 0};
#pragma unroll
        for (int ai = 0; ai < 2; ++ai)
#pragma unroll
            for (int m = 0; m < 4; ++m) { unsigned char* rowp = O + (size_t)(row0 + ai * HALF + m * 16) * DEXP + col0;
#pragma unroll
                for (int n = 0; n < 2; ++n) { const f32x4 g = acc[ai][0][m][n], up = acc[ai][1][m][n]; float v[4];
#pragma unroll
                    for (int i = 0; i < 4; ++i) v[i] = __builtin_amdgcn_fmed3f(siluf_(g[i]) * up[i], -440.0f, 440.0f);
                    int w = W[n]; w = __builtin_amdgcn_cvt_pk_fp8_f32(v[0], v[1], w, false); w = __builtin_amdgcn_cvt_pk_fp8_f32(v[2], v[3], w, true); W[n] = w; }
                *(u32x2*)rowp = (u32x2){(unsigned)W[0], (unsigned)W[1]}; }
    }
};
template <bool F8, class Epi, class Sched>
__device__ __forceinline__ void gemm_phase(LAS unsigned char* lds, const Sched& S, const Epi& E) {
    const int tid = tid_now(), wid = __builtin_amdgcn_readfirstlane(tid >> 6), lane = tid & 63, wr = wid >> 2, wc = wid & 3, fr = lane & 15, fq = lane >> 4;
    const int K = S.K, nt = K / BK;
    int mxsc = 0x7F7F7F7F, mxs0 = Epi::SC0 * 0x01010101, mxs1 = Epi::SC1 * 0x01010101; asm volatile("" : "+v"(mxsc)); asm volatile("" : "+v"(mxs0)); if (Epi::SC0 != Epi::SC1) asm volatile("" : "+v"(mxs1)); else mxs1 = mxs0;
    unsigned voffB[2];
#pragma unroll
    for (int i = 0; i < 2; ++i) { int R, C; stage_rc(tid * 16 + i * 8192, R, C); const int Rb = Epi::PERM == 2 ? (((R >> 5) & 3) * 64 + 16 * ((R & 15) >> 2) + 4 * ((R >> 4) & 1) + (R & 3)) : (Epi::PERM == 1 ? ((R & ~31) + perm32(R & 31)) : R); voffB[i] = (unsigned)(Rb * K + C) * 2u; }
    const size_t kstep = (size_t)(BK * 2);
    const size_t hstep = (size_t)(Epi::PERM == 2 ? 8 : HALF) * K * 2;
    const unsigned ldsw = (unsigned)wid * 1024u;
    const int aoff = lds_byte(wr * 64 + fr, fq * 8), boff = lds_byte(wc * 32 + fr, fq * 8);
#define G8_SA(b, h) (((b) * 2 + (h)) * HTB)
#define G8_SB(b, h) ((4 + (b) * 2 + (h)) * HTB)
#define G8_STAGE(bufoff, gbase, voff) do { const unsigned long long _g = (unsigned long long)(gbase); \
        const char* _gb = (const char*)(((unsigned long long)(unsigned)__builtin_amdgcn_readfirstlane((int)(unsigned)(_g >> 32)) << 32) | (unsigned long long)(unsigned)__builtin_amdgcn_readfirstlane((int)(unsigned)_g)); \
        _Pragma("unroll") for (int _i = 0; _i < 2; ++_i) \
        __builtin_amdgcn_global_load_lds((const unsigned*)(_gb + (voff)[_i]), (LAS unsigned*)(lds + (bufoff) + ldsw + _i * 8192), 16, 0, 0); } while (0)
#define G8_LDA(dst, b, h) do { _Pragma("unroll") for (int m = 0; m < 4; ++m) _Pragma("unroll") for (int k = 0; k < 2; ++k) dst[m][k] = *(const LAS bf16x8*)(lds + G8_SA(b, h) + aoff + m * 2048 + k * 1024); } while (0)
#define G8_LDB(dst, b, h) do { _Pragma("unroll") for (int n = 0; n < 2; ++n) _Pragma("unroll") for (int k = 0; k < 2; ++k) dst[n][k] = *(const LAS bf16x8*)(lds + G8_SB(b, h) + boff + n * 2048 + k * 1024); } while (0)
#define G8_MMA(ai, bj, At, Bt) do { __builtin_amdgcn_s_setprio(1); _Pragma("unroll") for (int m = 0; m < 4; ++m) _Pragma("unroll") for (int n = 0; n < 2; ++n) _Pragma("unroll") for (int k = 0; k < 2; ++k) \
        acc[ai][bj][m][n] = __builtin_amdgcn_mfma_f32_16x16x32_bf16(Bt[n][k], At[m][k], acc[ai][bj][m][n], 0, 0, 0); __builtin_amdgcn_s_setprio(0); } while (0)
#define G8_MMA8(ai, bj, At, Bt) do { __builtin_amdgcn_s_setprio(1); _Pragma("unroll") for (int m = 0; m < 4; ++m) _Pragma("unroll") for (int n = 0; n < 2; ++n) \
        acc[ai][bj][m][n] = __builtin_amdgcn_mfma_scale_f32_16x16x128_f8f6f4(cat8(Bt[n][0], Bt[n][1]), cat8(At[m][0], At[m][1]), acc[ai][bj][m][n], 0, 0, 0, (bj) ? mxs1 : mxs0, 0, mxsc); __builtin_amdgcn_s_setprio(0); } while (0)
#define G8_MM(ai, bj, At, Bt) do { if (F8) G8_MMA8(ai, bj, At, Bt); else G8_MMA(ai, bj, At, Bt); } while (0)
#define G8_WAIT_V(n) asm volatile("s_waitcnt vmcnt(" #n ")" ::: "memory")
#define G8_WAIT_L(n) asm volatile("s_waitcnt lgkmcnt(" #n ")" ::: "memory")
#define G8_BAR __builtin_amdgcn_s_barrier()
#define G8_SCHED __builtin_amdgcn_sched_barrier(0)
    Unit cur, nxt; int ui = 0;
    if (!S.next(0, cur)) return;
    f32x4 acc[2][2][4][2];
#pragma unroll
    for (int a = 0; a < 2; ++a)
#pragma unroll
        for (int b = 0; b < 2; ++b)
#pragma unroll
            for (int m = 0; m < 4; ++m)
#pragma unroll
                for (int n = 0; n < 2; ++n) acc[a][b][m][n] = (f32x4){0.f, 0.f, 0.f, 0.f};
    bf16x8 At[4][2], B0[2][2], B1[2][2];
    unsigned vA0[2], vA1[2];
#pragma unroll
    for (int i = 0; i < 2; ++i) { int R, C; stage_rc(tid * 16 + i * 8192, R, C); vA0[i] = S.a_off(cur, 0, R, C); vA1[i] = S.a_off(cur, 1, R, C); }
    const char* const Ab = S.A;
    const char* cB = S.b_ptr(cur);
    G8_STAGE(G8_SB(0, 0), cB, voffB); G8_STAGE(G8_SA(0, 0), Ab, vA0); G8_STAGE(G8_SB(0, 1), cB + hstep, voffB); G8_STAGE(G8_SA(0, 1), Ab, vA1);
    if (wr == 1) G8_BAR;
    G8_WAIT_V(4); G8_BAR;
    G8_STAGE(G8_SB(1, 0), cB + kstep, voffB); G8_STAGE(G8_SA(1, 0), Ab + kstep, vA0); G8_STAGE(G8_SB(1, 1), cB + hstep + kstep, voffB);
    G8_WAIT_V(6); G8_BAR;
    for (;;) {
        const bool has_next = S.next(ui + 1, nxt);
        const char* nB = has_next ? S.b_ptr(nxt) : cB;
        unsigned nA0[2] = {vA0[0], vA0[1]}, nA1[2] = {vA1[0], vA1[1]};
        if (has_next) {
#pragma unroll
            for (int i = 0; i < 2; ++i) { int R, C; stage_rc(tid * 16 + i * 8192, R, C); nA0[i] = S.a_off(nxt, 0, R, C); nA1[i] = S.a_off(nxt, 1, R, C); }
        }
#pragma unroll 1
        for (int t = 0; t < nt; t += 2) {
            const bool last = (t == nt - 2);
            const char* a1 = Ab + (size_t)(t + 1) * kstep;
            const char* a2 = last ? Ab : Ab + (size_t)(t + 2) * kstep; const char* b2 = last ? nB : cB + (size_t)(t + 2) * kstep;
            const char* a3 = a2 + kstep; const char* b3 = b2 + kstep;
            G8_LDB(B0, 0, 0); G8_SCHED; G8_LDA(At, 0, 0); G8_STAGE(G8_SA(1, 1), a1, vA1);
            G8_WAIT_L(8); G8_BAR; G8_WAIT_L(0); G8_MM(0, 0, At, B0); G8_BAR; G8_SCHED;
            if (last) {
#pragma unroll
                for (int i = 0; i < 2; ++i) { vA0[i] = nA0[i]; vA1[i] = nA1[i]; }
            }
            G8_LDB(B1, 0, 1); G8_STAGE(G8_SB(0, 0), b2, voffB);
            G8_BAR; G8_WAIT_L(0); G8_MM(0, 1, At, B1); G8_BAR;
            G8_LDA(At, 0, 1); G8_STAGE(G8_SA(0, 0), a2, vA0);
            G8_BAR; G8_WAIT_L(0); G8_MM(1, 0, At, B0); G8_BAR; G8_SCHED;
            G8_STAGE(G8_SB(0, 1), b2 + hstep, voffB);
            G8_WAIT_V(6); G8_BAR; G8_MM(1, 1, At, B1); G8_BAR;
            G8_LDB(B0, 1, 0); G8_SCHED; G8_LDA(At, 1, 0); G8_STAGE(G8_SA(0, 1), a2, vA1);
            G8_WAIT_L(8); G8_BAR; G8_WAIT_L(0); G8_MM(0, 0, At, B0); G8_BAR; G8_SCHED;
            G8_LDB(B1, 1, 1); G8_STAGE(G8_SB(1, 0), b3, voffB);
            G8_BAR; G8_WAIT_L(0); G8_MM(0, 1, At, B1); G8_BAR;
            G8_LDA(At, 1, 1); G8_STAGE(G8_SA(1, 0), a3, vA0);
            G8_BAR; G8_WAIT_L(0); G8_MM(1, 0, At, B0); G8_BAR; G8_SCHED;
            G8_STAGE(G8_SB(1, 1), b3 + hstep, voffB);
            G8_WAIT_V(6); G8_BAR; G8_MM(1, 1, At, B1); G8_BAR;
        }
        E(acc, cur, wr, wc, fr, fq);
        if (!has_next) break;
#pragma unroll
        for (int a = 0; a < 2; ++a)
#pragma unroll
            for (int b = 0; b < 2; ++b)
#pragma unroll
                for (int m = 0; m < 4; ++m)
#pragma unroll
                    for (int n = 0; n < 2; ++n) acc[a][b][m][n] = (f32x4){0.f, 0.f, 0.f, 0.f};
        cur = nxt; cB = nB; ++ui;
    }
    G8_WAIT_V(0);
    if (wr == 0) G8_BAR;
    G8_BAR;
#undef G8_SA
#undef G8_SB
#undef G8_STAGE
#undef G8_LDA
#undef G8_LDB
#undef G8_MMA
#undef G8_MMA8
#undef G8_MM
#undef G8_WAIT_V
#undef G8_WAIT_L
#undef G8_BAR
#undef G8_SCHED
}
}

struct Args { const float* in[29]; float* out; unsigned char* ws; int ph_lo, ph_hi; };
enum { I_X = 0, I_C, I_CTX, I_CCTX, I_WMOD, I_BMOD, I_G1, I_G2, I_WIN, I_GWF, I_GBF, I_GWB, I_GBB, I_GOUT, I_CONFW, I_CONFB, I_CONFG, I_CONFBETA, I_SCW, I_POOLW, I_POOLS, I_WOUT, I_RWG, I_RBG, I_RWE, I_RBE, I_EIN, I_EOUT, I_GFINAL };

constexpr int CV_SMALL = 3360, CV_E0 = 3360, CV_EI1 = 27936, CV_EO1 = 44320, CV_END = 52512;
constexpr int CV_G = 4480;
constexpr int CV_A = 10368, CV_B = 9728;
constexpr int CV_C = 4096, CV_D = 2048, CV_E = 10240;
constexpr int CV_F = 4096;
constexpr int CV_K = 0;
static_assert((CV_EI1 - CV_E0) - CV_G - CV_A - CV_B >= 0 && (CV_EO1 - CV_EI1) - CV_C - CV_D - CV_E >= 0, "conversion slots exceed their ranges");
constexpr int CV_P0_E0 = (CV_EI1 - CV_E0) - CV_G - CV_A - CV_B, CV_P0_EI1 = (CV_EO1 - CV_EI1) - CV_C - CV_D - CV_E, CV_P0_EO1 = (CV_END - CV_EO1) - CV_F;
struct CvD { const float* src; unsigned char* dst; int N; unsigned rstep; bool f8; };
__device__ __forceinline__ CvD cv_desc(const Args& a, int idx, int lane) {
    unsigned char* ws = a.ws; const float* W; unsigned char* WT; int K, N, kb, n0, dst0, esz;
    if (idx < CV_SMALL) { const int l = idx / 1680; int r = idx % 1680; esz = 2; K = 1024;
        if (r < 1168) { kb = r / 73; n0 = (r % 73) * 32; dst0 = n0; W = a.in[I_WIN] + (size_t)l * 1024 * NIN; N = NIN; WT = ws + WS_WIN + (size_t)l * NINP * 1024 * 2; }
        else { r -= 1168; kb = r / 32; n0 = (r % 32) * 32; dst0 = n0; W = a.in[I_WOUT] + (size_t)l * 1024 * 1024; N = 1024; WT = ws + WS_WOUT + (size_t)l * 1024 * 1024 * 2; } }
    else { int l, r; bool is_in; esz = 1; N = 1024;
        if (idx < CV_EI1) { l = 0; r = idx - CV_E0; is_in = r < 16384; if (!is_in) r -= 16384; }
        else if (idx < CV_EO1) { l = 1; r = idx - CV_EI1; is_in = true; }
        else { l = 1; r = idx - CV_EO1; is_in = false; }
        if (is_in) { const int le = l * 32 + r / 512, q = r % 512; kb = 2 * (q >> 6) + (q & 1); n0 = ((q >> 1) & 31) * 32; K = 1024;
            dst0 = n0 < 512 ? (256 * (n0 >> 7) + (n0 & 127)) : (256 * ((n0 - 512) >> 7) + 128 + ((n0 - 512) & 127));
            W = a.in[I_EIN] + (size_t)le * 1024 * 1024; WT = ws + WS_WEIN + (size_t)le * 1024 * 1024; }
        else { const int le = l * 32 + r / 256, q = r % 256; kb = 2 * (q >> 6) + (q & 1); n0 = ((q >> 1) & 31) * 32; dst0 = n0; K = 512;
            W = a.in[I_EOUT] + (size_t)le * 512 * 1024; WT = ws + WS_WEOUT + (size_t)le * 1024 * 512; } }
    CvD d; d.N = N; d.f8 = esz == 1; d.rstep = (unsigned)(8 * K * esz);
    d.src = W + (size_t)(64 * kb + (lane >> 5)) * N + n0 + (lane & 31);
    d.dst = WT + ((size_t)(dst0 + (lane >> 3)) * K + 64 * kb + 8 * (lane & 7)) * esz;
    return d;
}
__device__ __forceinline__ void cv_load(const CvD& d, float (&wv)[32]) {
#pragma unroll
    for (int i = 0; i < 32; ++i) wv[i] = d.src[(size_t)(2 * i) * d.N];
}
__device__ __forceinline__ void cv_finish(const CvD& d, float (&wv)[32], LAS float* scr, int lane) {
#pragma unroll
    for (int i = 0; i < 32; ++i) PIN(wv[i]);
#pragma unroll
    for (int i = 0; i < 32; ++i) { const int kk = 2 * i + (lane >> 5); scr[kk * 33 + (lane & 31)] = wv[i]; }
    LDS_WAIT(); asm volatile("" ::: "memory");
    const int c = lane & 7;
    if (d.f8) {
#pragma unroll
        for (int j = 0; j < 4; ++j) { const int n = (lane >> 3) + 8 * j; const LAS float* s = scr + (8 * c) * 33 + n;
            float v[8];
#pragma unroll
            for (int i = 0; i < 8; ++i) v[i] = __builtin_amdgcn_fmed3f(s[i * 33] * F8_WSC, -440.0f, 440.0f);
            int w0 = 0, w1 = 0;
            w0 = __builtin_amdgcn_cvt_pk_fp8_f32(v[0], v[1], w0, false); w0 = __builtin_amdgcn_cvt_pk_fp8_f32(v[2], v[3], w0, true);
            w1 = __builtin_amdgcn_cvt_pk_fp8_f32(v[4], v[5], w1, false); w1 = __builtin_amdgcn_cvt_pk_fp8_f32(v[6], v[7], w1, true);
            *(u32x2*)(d.dst + (size_t)j * d.rstep) = (u32x2){(unsigned)w0, (unsigned)w1}; }
    } else {
#pragma unroll
        for (int j = 0; j < 4; ++j) { const int n = (lane >> 3) + 8 * j; const LAS float* s = scr + (8 * c) * 33 + n;
            u32x4 o; o.x = pk2(s[0 * 33], s[1 * 33]); o.y = pk2(s[2 * 33], s[3 * 33]); o.z = pk2(s[4 * 33], s[5 * 33]); o.w = pk2(s[6 * 33], s[7 * 33]);
            *(u32x4*)(d.dst + (size_t)j * d.rstep) = o; }
    }
    LDS_WAIT(); asm volatile("" ::: "memory");
}
template <class Map>
__device__ __forceinline__ void convert_loop(const Args& a, LAS float* scr, int lane, int j0, int jend, int step, Map map) {
    if (j0 >= jend) return;
    CvD d = cv_desc(a, map(j0), lane); float wv[32]; cv_load(d, wv);
#pragma unroll 1
    for (int j = j0;;) {
        const int jn = j + step; const bool hn = jn < jend;
        const CvD dn = cv_desc(a, map(hn ? jn : j), lane); float wn[32];
        if (hn) cv_load(dn, wn);
        cv_finish(d, wv, scr, lane);
        if (!hn) break;
        d = dn; j = jn;
#pragma unroll
        for (int i = 0; i < 32; ++i) wv[i] = wn[i];
    }
}
__device__ __forceinline__ void convert_item(const Args& a, int idx, LAS float* scr, int lane) { const CvD d = cv_desc(a, idx, lane); float wv[32]; cv_load(d, wv); cv_finish(d, wv, scr, lane); }
__device__ __forceinline__ void convert_range(const Args& a, LAS unsigned char* lds, int first, int count, int rank, int nparts) {
    const int tid = tid_now(), lane = tid & 63, wid = __builtin_amdgcn_readfirstlane(tid >> 6);
    LAS float* scr = (LAS float*)(lds + wid * 16384);
    const int per = ((count + nparts - 1) / nparts + 1) & ~1, lo = rank * per, hi = (lo + per < count) ? lo + per : count;
    convert_loop(a, scr, lane, lo + wid, hi, 8, [first](int j) { return first + j; });
}
__device__ __forceinline__ void convert_in_tail(const Args& a, LAS unsigned char* lds, int first, int count, int tot_units, int G, int c) {
    const int rem = tot_units % G;
    if (rem == 0) convert_range(a, lds, first, count, c, G);
    else if (c >= rem) convert_range(a, lds, first, count, c - rem, G - rem);
}

__device__ __forceinline__ void phase_p0(const Args& a, LAS unsigned char* lds) {
    const int tid = tid_now(), lane = tid & 63, wid = __builtin_amdgcn_readfirstlane(tid >> 6);
    unsigned char* ws = a.ws;
    for (int job = blockIdx.x; job < 192; job += gridDim.x) {
        const int l = job / 96, n0 = (job % 96) * 64;
        LAS float* sv = (LAS float*)lds;
        LAS float* red = (LAS float*)(lds + 5 * 1024 * 4);
        for (int i = tid; i < 5 * 1024; i += 512) { const int r = i >> 10, k = i & 1023; const float v = r < 4 ? a.in[I_C][r * 1024 + k] : a.in[I_CCTX][k]; sv[i] = siluf_(v); }
        __syncthreads();
        const int ks = tid >> 6, col = tid & 63;
        const float* w = a.in[I_WMOD] + (size_t)l * 1024 * 6144 + (size_t)(ks * 128) * 6144 + n0 + col;
        float acc[5] = {0.f, 0.f, 0.f, 0.f, 0.f};
#pragma unroll 8
        for (int k = 0; k < 128; ++k) { const float wv = w[(size_t)k * 6144];
#pragma unroll
            for (int r = 0; r < 5; ++r) acc[r] += sv[r * 1024 + ks * 128 + k] * wv; }
#pragma unroll
        for (int r = 0; r < 5; ++r) red[(ks * 5 + r) * 64 + col] = acc[r];
        __syncthreads();
        if (tid < 320) { const int r = tid >> 6; float s = 0.f;
#pragma unroll
            for (int q = 0; q < 8; ++q) s += red[(q * 5 + r) * 64 + col];
            ((float*)(ws + WS_MOD))[(size_t)(l * 5 + r) * 6144 + n0 + col] = s + a.in[I_BMOD][l * 6144 + n0 + col]; }
        __syncthreads();
    }
    LAS float* scr = (LAS float*)(lds + wid * 16384);
    const int gw = blockIdx.x * 8 + wid, NGW = gridDim.x * 8;
    constexpr int P0_N0 = CV_E0 + CV_P0_E0, P0_N1 = P0_N0 + CV_P0_EI1, P0_N2 = P0_N1 + CV_P0_EO1;
    convert_loop(a, scr, lane, gw, P0_N2, NGW, [](int j) { return j < P0_N0 ? j : (j < P0_N1 ? CV_EI1 + (j - P0_N0) : CV_EO1 + (j - P0_N1)); });
    for (int i = blockIdx.x * 512 + tid; i < 2 * 4096; i += gridDim.x * 512) { const int l = i >> 12, g = (i >> 10) & 3, k = i & 1023; ((float*)(ws + WS_TAB))[i] = a.in[I_RWG][l * 4096 + k * 4 + g]; }
    for (int i = blockIdx.x * 512 + tid; i < 2 * 32768; i += gridDim.x * 512) { const int l = i >> 15, e = (i >> 10) & 31, k = i & 1023; ((float*)(ws + WS_WRET))[i] = a.in[I_RWE][l * 32768 + k * 32 + e]; }
    for (int i = blockIdx.x * 512 + tid; i < 2 * 4 * 64 * 64; i += gridDim.x * 512) { const int lg = i >> 12, dd = (i >> 6) & 63, c = i & 63;
        ((bf16_t*)(ws + WS_PWT))[i] = (bf16_t)(pk2(a.in[I_POOLW][(size_t)lg * 4096 + c * 64 + dd], 0.f) & 0xffffu); }
    for (int i = blockIdx.x * 512 + tid; i < 4 * 8 * 64; i += gridDim.x * 512) { const int wi = i >> 9, f = (i >> 6) & 7, ln = i & 63, mt = f >> 2, nt = (f >> 1) & 1, sq = f & 1, rr = ln & 31, hh = ln >> 5, hw = 1 << wi;
        const int t = 32 * nt + rr; int lo = t - hw, hi = t + hw; lo = lo < 0 ? 0 : lo; hi = hi > 64 ? 64 : hi; const int cnt = hi - lo;
        unsigned w4[4];
#pragma unroll
        for (int jp = 0; jp < 4; ++jp) { unsigned wd = 0u;
#pragma unroll
            for (int e = 0; e < 2; ++e) { const int j = 2 * jp + e, tp = 32 * mt + 16 * sq + 8 * (j >> 2) + 4 * hh + (j & 3);
                const int val = ((tp >= lo && tp < hi) ? 1 : 0) - (tp == t ? cnt : 0);
                wd |= (__float_as_uint((float)val) >> 16) << (16 * e); }
            w4[jp] = wd; }
        ((u32x4*)(ws + WS_BAND))[i] = (u32x4){w4[0], w4[1], w4[2], w4[3]}; }
    for (int i = blockIdx.x * 512 + tid; i < 2 * 224 * 1024 / 8; i += gridDim.x * 512) { const int l = i / (224 * 128), q = i % (224 * 128);
        *(u32x4*)((bf16_t*)(ws + WS_WIN) + (size_t)l * NINP * 1024 + (size_t)NIN * 1024 + (size_t)q * 8) = (u32x4){0u, 0u, 0u, 0u}; }
}

__device__ __forceinline__ void load_row(const float* xrow, int lane, f32x4 (&v)[4]) {
    const f32x4* xr = (const f32x4*)xrow + lane;
#pragma unroll
    for (int j = 0; j < 4; ++j) v[j] = xr[64 * j];
}
__device__ __forceinline__ void load_row_bf(const bf16_t* xrow, int lane, f32x4 (&v)[4]) {
#pragma unroll
    for (int j = 0; j < 4; ++j) { const u32x2 w = *((const u32x2*)xrow + lane + 64 * j); v[j] = (f32x4){bflo(w.x), bfhi(w.x), bflo(w.y), bfhi(w.y)}; }
}
__device__ __forceinline__ void store_row_bf(bf16_t* xrow, int lane, const f32x4 (&v)[4]) {
#pragma unroll
    for (int j = 0; j < 4; ++j) { u32x2 w; w.x = pk2(v[j].x, v[j].y); w.y = pk2(v[j].z, v[j].w); *((u32x2*)xrow + lane + 64 * j) = w; }
}
__device__ __forceinline__ float row_rstd(const f32x4 (&v)[4]) {
    float s = 0.f;
#pragma unroll
    for (int j = 0; j < 4; ++j) s += (v[j].x * v[j].x + v[j].y * v[j].y) + (v[j].z * v[j].z + v[j].w * v[j].w);
    return rsqrtf(wave_sum(s) * (1.0f / D) + EPS);
}
__device__ __forceinline__ void norm_mod_store(f32x4 (&v)[4], float rstd, const float* g, const float* sc, const float* sh, bf16_t* hrow, int lane) {
#pragma unroll
    for (int j = 0; j < 4; ++j) { const f32x4 gv = *((const f32x4*)g + lane + 64 * j), scv = *((const f32x4*)sc + lane + 64 * j), shv = *((const f32x4*)sh + lane + 64 * j);
        v[j] = (v[j] * rstd * gv) * (1.0f + scv) + shv;
        u32x2 w; w.x = pk2(v[j].x, v[j].y); w.y = pk2(v[j].z, v[j].w);
        *((u32x2*)hrow + lane + 64 * j) = w; }
}

__device__ __forceinline__ void norm_store_cached(f32x4 (&v)[4], float rstd, const f32x4 (&GS)[4], const f32x4 (&SH)[4], bf16_t* hrow, int lane) {
#pragma unroll
    for (int j = 0; j < 4; ++j) { v[j] = (v[j] * rstd) * GS[j] + SH[j];
        u32x2 w; w.x = pk2(v[j].x, v[j].y); w.y = pk2(v[j].z, v[j].w);
        *((u32x2*)hrow + lane + 64 * j) = w; }
}
__device__ __forceinline__ void norm_store_cached8(f32x4 (&v)[4], float rstd, const f32x4 (&GS)[4], const f32x4 (&SH)[4], unsigned char* hrow, int lane) {
#pragma unroll
    for (int j = 0; j < 4; ++j) { v[j] = (v[j] * rstd) * GS[j] + SH[j];
        float q[4];
#pragma unroll
        for (int i = 0; i < 4; ++i) q[i] = fminf(fmaxf(v[j][i] * F8_HSC, -440.0f), 440.0f);
        int w = 0; w = __builtin_amdgcn_cvt_pk_fp8_f32(q[0], q[1], w, false); w = __builtin_amdgcn_cvt_pk_fp8_f32(q[2], q[3], w, true);
        *((unsigned*)hrow + lane + 64 * j) = (unsigned)w; }
}
__device__ __forceinline__ void load_mod_cached(const float* g, const float* sc, const float* sh, const float* ga, int lane, f32x4 (&GS)[4], f32x4 (&SH)[4], f32x4 (&GA)[4]) {
#pragma unroll
    for (int j = 0; j < 4; ++j) { const f32x4 gv = *((const f32x4*)g + lane + 64 * j), scv = *((const f32x4*)sc + lane + 64 * j);
        GS[j] = gv * (1.0f + scv); SH[j] = *((const f32x4*)sh + lane + 64 * j); GA[j] = *((const f32x4*)ga + lane + 64 * j); }
}

__device__ __forceinline__ void phase_norm1_l0(const Args& a) {
    const int lane = tid_now() & 63, wid = tid_now() >> 6, gw = blockIdx.x * 8 + wid, NGW = gridDim.x * 8;
    const float* MOD = (const float*)(a.ws + WS_MOD); bf16_t* H = (bf16_t*)(a.ws + WS_H);
    int cur_b = -1; f32x4 GS[4], SH[4], GA[4];
#pragma unroll 1
    for (int m = gw; m < MTOT; m += 2 * NGW) {
        const int m2 = m + NGW; const bool has2 = m2 < MTOT; const int m2c = has2 ? m2 : m;
        const float* src = m < NLAT ? a.in[I_X] + (size_t)m * D : a.in[I_CTX] + (size_t)(m - NLAT) * D;
        const float* src2 = m2c < NLAT ? a.in[I_X] + (size_t)m2c * D : a.in[I_CTX] + (size_t)(m2c - NLAT) * D;
        const int b = m < NLAT ? (m >> 13) : 4, b2 = m2c < NLAT ? (m2c >> 13) : 4;
        f32x4 v[4], v2[4]; load_row(src, lane, v); load_row(src2, lane, v2);
        const float rstd = row_rstd(v), rstd2 = row_rstd(v2);
        if (b != cur_b) { const float* mod = MOD + (size_t)b * 6144; load_mod_cached(a.in[I_G1], mod + 1024, mod, mod, lane, GS, SH, GA); cur_b = b; }
        norm_store_cached(v, rstd, GS, SH, H + (size_t)m * D, lane);
        if (has2) { if (b2 != cur_b) { const float* mod = MOD + (size_t)b2 * 6144; load_mod_cached(a.in[I_G1], mod + 1024, mod, mod, lane, GS, SH, GA); cur_b = b2; }
            norm_store_cached(v2, rstd2, GS, SH, H + (size_t)m2 * D, lane); }
    }
}

struct ChunkPos { int b, sf, sb; };
__device__ __forceinline__ ChunkPos chunk_pos(int chunk) {
    ChunkPos p;
    if (chunk < 512) { p.b = chunk >> 7; const int n = chunk & 127; p.sf = 4 + n; p.sb = 4 + 127 - n; }
    else { const int cc = chunk - 512; p.b = cc >> 2; const int n = cc & 3; p.sf = n; p.sb = 3 - n; }
    return p;
}

constexpr int VS = 72;
__device__ __forceinline__ void gla_prep_dir(int dir, int lane, const float (&w)[8], float bias, const bf16x8 (&Az)[2], f32x16 (&BT)[2]) {
    asm volatile("" : "+v"(lane));
    const int r = lane & 31, hf = lane >> 5;
    const f32x16 zero16 = {0.f, 0.f, 0.f, 0.f, 0.f, 0.f, 0.f, 0.f, 0.f, 0.f, 0.f, 0.f, 0.f, 0.f, 0.f, 0.f};
    u32x4 mk[2];
#pragma unroll
    for (int s = 0; s < 2; ++s) { unsigned w4[4];
#pragma unroll
        for (int jp = 0; jp < 4; ++jp) { const int j0 = 2 * jp, j1 = 2 * jp + 1;
            const int t0 = 16 * s + 8 * (j0 >> 2) + 4 * hf + (j0 & 3), t1 = 16 * s + 8 * (j1 >> 2) + 4 * hf + (j1 & 3);
            const bool c0 = dir ? (t0 >= r) : (t0 <= r), c1 = dir ? (t1 >= r) : (t1 <= r);
            w4[jp] = (c0 ? 0x3F80u : 0u) | (c1 ? 0x3F800000u : 0u); }
        mk[s].x = w4[0]; mk[s].y = w4[1]; mk[s].z = w4[2]; mk[s].w = w4[3]; }
    bf16x8 Bhi, Blo; split8(w, Bhi, Blo);
    BT[0] = zero16; BT[1] = zero16;
#pragma unroll 1
    for (int mt = 0; mt < 2; ++mt) {
        const bf16x8 A = mt ? Az[1] : Az[0];
        f32x16 x = MFMA32(A, Bhi, zero16); x = MFMA32(A, Blo, x);
        float la[16];
#pragma unroll
        for (int i = 0; i < 16; ++i) { const float v = x[i] + bias; la[i] = (fminf(v, 0.f) - __logf(1.0f + __expf(-fabsf(v)))) * (1.0f / 16.0f); }
#pragma unroll
        for (int s = 0; s < 2; ++s) {
            const float t8[8] = {la[8 * s], la[8 * s + 1], la[8 * s + 2], la[8 * s + 3], la[8 * s + 4], la[8 * s + 5], la[8 * s + 6], la[8 * s + 7]};
            bf16x8 Lh, Ll; split8(t8, Lh, Ll);
#pragma unroll
            for (int nt = 0; nt < 2; ++nt) {
                const bool full = dir ? (mt > nt) : (mt < nt);
                u32x4 bm; const unsigned fv = full ? 0x3F803F80u : 0u;
                bm.x = (mt == nt) ? mk[s].x : fv; bm.y = (mt == nt) ? mk[s].y : fv; bm.z = (mt == nt) ? mk[s].z : fv; bm.w = (mt == nt) ? mk[s].w : fv;
                const bf16x8 Bm = __builtin_bit_cast(bf16x8, bm);
                BT[nt] = MFMA32(Lh, Bm, BT[nt]); BT[nt] = MFMA32(Ll, Bm, BT[nt]); }
        }
    }
}
__device__ __forceinline__ void gla_gate_loads(const Args& a, int l, int h, int dir, const bf16_t* cols0, int lane, float (&w)[8], float& bias, bf16x8 (&Az)[2]) {
    const int r = lane & 31, hf = lane >> 5;
    const float* wp = a.in[dir ? I_GWB : I_GWF] + (size_t)(l * 16 + 8 * hf) * 128 + 32 * h + r;
#pragma unroll
    for (int j = 0; j < 8; ++j) w[j] = wp[j * 128];
    bias = a.in[dir ? I_GBB : I_GBF][l * 128 + 32 * h + r];
#pragma unroll
    for (int mt = 0; mt < 2; ++mt) Az[mt] = *(const bf16x8*)(cols0 + (size_t)(32 * mt + r) * NINP + C_ZF + 16 * dir + 8 * hf);
}
__device__ __forceinline__ void stage_vT(const bf16_t* cols0, int h, int lane, LAS bf16_t* vT) {
    u32x4 w[8];
#pragma unroll
    for (int q = 0; q < 8; ++q) { const int chunk = lane + 64 * q, t = chunk >> 3, cg = chunk & 7; w[q] = *(const u32x4*)(cols0 + (size_t)t * NINP + C_V + 64 * h + 8 * cg); }
#pragma unroll
    for (int q = 0; q < 8; ++q) PIN(w[q]);
#pragma unroll
    for (int q = 0; q < 8; ++q) { const int chunk = lane + 64 * q, t = chunk >> 3, cg = chunk & 7;
        LAS bf16_t* p = vT + (8 * cg) * VS + t;
        p[0 * VS] = (bf16_t)(w[q].x & 0xffffu); p[1 * VS] = (bf16_t)(w[q].x >> 16); p[2 * VS] = (bf16_t)(w[q].y & 0xffffu); p[3 * VS] = (bf16_t)(w[q].y >> 16);
        p[4 * VS] = (bf16_t)(w[q].z & 0xffffu); p[5 * VS] = (bf16_t)(w[q].z >> 16); p[6 * VS] = (bf16_t)(w[q].w & 0xffffu); p[7 * VS] = (bf16_t)(w[q].w >> 16); }
}
__device__ __forceinline__ void chunk_gla_item(const Args& a, int l, int tile, int h, int d0, int d1, int lane, LAS bf16_t* vT, LAS bf16_t* kdT) {
    const int r = lane & 31, hf = lane >> 5;
    const bf16_t* cols0 = (const bf16_t*)(a.ws + WS_COLS) + (size_t)tile * 64 * NINP;
    float* KV = (float*)(a.ws + WS_KV); float* DEC = (float*)(a.ws + WS_DEC);
    const ChunkPos cp = chunk_pos(tile);
    const f32x16 zero16 = {0.f, 0.f, 0.f, 0.f, 0.f, 0.f, 0.f, 0.f, 0.f, 0.f, 0.f, 0.f, 0.f, 0.f, 0.f, 0.f};
    stage_vT(cols0, h, lane, vT);
#pragma unroll 1
    for (int dir = d0; dir < d1; ++dir) {
        float gw8[8], gbias; bf16x8 Az[2]; u32x2 kraw[2][4];
        gla_gate_loads(a, l, h, dir, cols0, lane, gw8, gbias, Az);
#pragma unroll
        for (int nt = 0; nt < 2; ++nt)
#pragma unroll
            for (int g = 0; g < 4; ++g) kraw[nt][g] = *(const u32x2*)(cols0 + (size_t)(32 * nt + r) * NINP + C_K + 32 * h + 4 * hf + 8 * g);
#pragma unroll
        for (int j = 0; j < 8; ++j) PIN(gw8[j]);
        PIN(gbias); PIN(Az[0]); PIN(Az[1]);
#pragma unroll
        for (int nt = 0; nt < 2; ++nt)
#pragma unroll
            for (int g = 0; g < 4; ++g) PIN(kraw[nt][g]);
        f32x16 BT[2]; gla_prep_dir(dir, lane, gw8, gbias, Az, BT);
        const size_t e = (size_t)((dir * 4 + cp.b) * 4 + h) * NSEQ + (dir ? cp.sb : cp.sf);
        const int srcl = (dir ? 0 : 31) + 32 * hf;
        float tot[16];
#pragma unroll
        for (int i = 0; i < 16; ++i) tot[i] = __shfl(dir ? BT[0][i] : BT[1][i], srcl);
        if (r == (dir ? 0 : 31)) {
#pragma unroll
            for (int i = 0; i < 16; ++i) DEC[e * 32 + (i & 3) + 8 * (i >> 2) + 4 * hf] = __expf(tot[i]);
        }
#pragma unroll
        for (int nt = 0; nt < 2; ++nt) {
#pragma unroll
            for (int g = 0; g < 4; ++g) { const u32x2 kw = kraw[nt][g];
                const float kf[4] = {bflo(kw.x), bfhi(kw.x), bflo(kw.y), bfhi(kw.y)};
#pragma unroll
                for (int q = 0; q < 4; ++q) { const int i = 4 * g + q; const float kd = kf[q] * __expf(tot[i] - BT[nt][i]);
                    kdT[(8 * g + 4 * hf + q) * VS + 32 * nt + r] = (bf16_t)(pk2c(kd, 0.f) & 0xffffu); } }
        }
        LDS_WAIT(); asm volatile("" ::: "memory");
#pragma unroll 1
        for (int ct = 0; ct < 2; ++ct) {
            f32x16 acc = zero16;
#pragma unroll
            for (int ks = 0; ks < 4; ++ks) {
                const bf16x8 A = *(const LAS bf16x8*)(vT + (32 * ct + r) * VS + 16 * ks + 8 * hf);
                const bf16x8 B = *(const LAS bf16x8*)(kdT + r * VS + 16 * ks + 8 * hf);
                acc = MFMA32(A, B, acc); }
            float* dst = KV + e * 2048 + (size_t)(32 * ct + 4 * hf) * 32 + r;
#pragma unroll
            for (int i = 0; i < 16; ++i) dst[((i & 3) + 8 * (i >> 2)) * 32] = acc[i];
        }
        LDS_WAIT(); asm volatile("" ::: "memory");
    }
}
__device__ __forceinline__ void chunk_agv_item(const Args& a, int row0, int lane) {
    const bf16_t* COLS = (const bf16_t*)(a.ws + WS_COLS); float* AGV = (float*)(a.ws + WS_AGV); float* CXV = (float*)(a.ws + WS_CXV);
    const int t = lane >> 3;
#pragma unroll
    for (int rep = 0; rep < 2; ++rep) { const int c8 = ((lane & 7) + 8 * rep) * 8; const bf16_t* rp = COLS + (size_t)(row0 + t) * NINP;
        float fa[8], fg[8], fc[8], fx[8];
        unpack8(*(const u32x4*)(rp + C_CA + 128 + c8), fa); unpack8(*(const u32x4*)(rp + C_CG + 128 + c8), fg);
        unpack8(*(const u32x4*)(rp + C_SC + 128 + c8), fc); unpack8(*(const u32x4*)(rp + C_SX + 128 + c8), fx);
        f32x4 o0, o1, p0, p1;
#pragma unroll
        for (int i = 0; i < 4; ++i) { o0[i] = fa[i] * sigmoidf_(fg[i]); o1[i] = fa[4 + i] * sigmoidf_(fg[4 + i]); p0[i] = fc[i] * fx[i]; p1[i] = fc[4 + i] * fx[4 + i]; }
        float* ao = AGV + (size_t)(row0 + t) * 128 + c8; float* co = CXV + (size_t)(row0 + t) * 128 + c8;
        *(f32x4*)ao = o0; *(f32x4*)(ao + 4) = o1; *(f32x4*)co = p0; *(f32x4*)(co + 4) = p1; }
}
__device__ __forceinline__ int next_item(LAS int* ctr, int lane) {
    int j = 0; if (lane == 0) j = __hip_atomic_fetch_add(ctr, 1, __ATOMIC_RELAXED, __HIP_MEMORY_SCOPE_WORKGROUP);
    return __builtin_amdgcn_readfirstlane(j);
}
__device__ __forceinline__ void phase_chunk(const Args& a, int l, LAS unsigned char* lds) {
    const int tid = tid_now(), lane = tid & 63, wid = __builtin_amdgcn_readfirstlane(tid >> 6);
    LAS bf16_t* vT = (LAS bf16_t*)(lds + wid * 16384); LAS bf16_t* kdT = vT + 64 * VS;
    LAS int* ctr = (LAS int*)(lds + MISC_OFF + 16);
    if (tid == 0) { int z_ = 0; asm volatile("" : "+v"(z_)); ctr[0] = z_; ctr[1] = z_; }
    __syncthreads();
    const int b = blockIdx.x, G = gridDim.x, nL = b < 512 ? (511 - b) / G + 1 : 0, cx = (b >= 96 && b < 224) ? 1 : 0;
    for (;;) { int j = next_item(ctr, lane);
        if (j < 4 * nL) { chunk_gla_item(a, l, b + G * (j >> 2), j & 3, 0, 2, lane, vT, kdT); continue; }
        j -= 4 * nL;
        if (j < cx) { const int k = b - 96; chunk_gla_item(a, l, 512 + (k >> 3), (k >> 1) & 3, k & 1, (k & 1) + 1, lane, vT, kdT); continue; }
        break;
    }
    if (b < 96 || b >= 224) {
        unsigned* q = (unsigned*)(a.ws + WS_CTL) + CW_CHQ + 512 * l + 64 * (b & 7); constexpr int per = CV_K / 8;
        const int first = (l == 0 ? CV_E0 + CV_P0_E0 + CV_G + CV_A - CV_K : CV_EI1 + CV_P0_EI1 + CV_C + CV_D + CV_E - CV_K) + (b & 7) * per;
        int t1 = 0; if (lane == 0) t1 = (int)atomicAdd(q, 1u);
#pragma unroll 1
        for (;;) { const int jj = __builtin_amdgcn_readfirstlane(t1); if (jj >= per) break;
            t1 = 0; if (lane == 0) t1 = (int)atomicAdd(q, 1u);
            convert_item(a, first + jj, (LAS float*)(lds + (tid_now() >> 6) * 16384), tid_now() & 63); }
    }
}
__device__ __forceinline__ void mixer_gla_item(const Args& a, int l, int tile, int h, int lane, LAS bf16_t* vT) {
    const bf16_t* cols0 = (const bf16_t*)(a.ws + WS_COLS) + (size_t)tile * 64 * NINP;
    const bf16_t* SIN = (const bf16_t*)(a.ws + WS_SIN); bf16_t* MIX = (bf16_t*)(a.ws + WS_MIX);
    const ChunkPos cp = chunk_pos(tile);
    const f32x16 zero16 = {0.f, 0.f, 0.f, 0.f, 0.f, 0.f, 0.f, 0.f, 0.f, 0.f, 0.f, 0.f, 0.f, 0.f, 0.f, 0.f};
    stage_vT(cols0, h, lane, vT);
    LDS_WAIT(); asm volatile("" ::: "memory");
    f32x16 OT[2][2] = {{zero16, zero16}, {zero16, zero16}};
#pragma unroll 1
    for (int dir = 0; dir < 2; ++dir) {
        int ln = lane; asm volatile("" : "+v"(ln)); const int r = ln & 31, hf = ln >> 5;
        bf16x8 QD[2][2], KI[2][2];
        const bf16_t* st = SIN + ((size_t)((dir * 4 + cp.b) * 4 + h) * NSEQ + (dir ? cp.sb : cp.sf)) * 2048;
        u32x2 sraw[2][2][2];
        { float gw8[8], gbias; bf16x8 Az[2]; u32x2 qraw[2][4], kraw[2][4];
            gla_gate_loads(a, l, h, dir, cols0, ln, gw8, gbias, Az);
#pragma unroll
            for (int nt = 0; nt < 2; ++nt)
#pragma unroll
                for (int g = 0; g < 4; ++g) { const bf16_t* qp = cols0 + (size_t)(32 * nt + r) * NINP + C_Q + 32 * h + 4 * hf + 8 * g; qraw[nt][g] = *(const u32x2*)qp; kraw[nt][g] = *(const u32x2*)(qp + (C_K - C_Q)); }
#pragma unroll
            for (int ct = 0; ct < 2; ++ct)
#pragma unroll
                for (int s = 0; s < 2; ++s) { const size_t off = (size_t)(32 * ct + r) * 32 + 16 * s + 4 * hf; sraw[ct][s][0] = *(const u32x2*)(st + off); sraw[ct][s][1] = *(const u32x2*)(st + off + 8); }
#pragma unroll
            for (int j = 0; j < 8; ++j) PIN(gw8[j]);
            PIN(gbias); PIN(Az[0]); PIN(Az[1]);
#pragma unroll
            for (int nt = 0; nt < 2; ++nt)
#pragma unroll
                for (int g = 0; g < 4; ++g) { PIN(qraw[nt][g]); PIN(kraw[nt][g]); }
#pragma unroll
            for (int ct = 0; ct < 2; ++ct)
#pragma unroll
                for (int s = 0; s < 2; ++s) { PIN(sraw[ct][s][0]); PIN(sraw[ct][s][1]); }
            f32x16 BT[2]; gla_prep_dir(dir, ln, gw8, gbias, Az, BT);
#pragma unroll
            for (int nt = 0; nt < 2; ++nt) {
                float qd[16], ki[16];
#pragma unroll
                for (int g = 0; g < 4; ++g) { const u32x2 qw = qraw[nt][g], kw = kraw[nt][g];
                    const float qf[4] = {bflo(qw.x), bfhi(qw.x), bflo(qw.y), bfhi(qw.y)}, kf[4] = {bflo(kw.x), bfhi(kw.x), bflo(kw.y), bfhi(kw.y)};
#pragma unroll
                    for (int q = 0; q < 4; ++q) { const float bb = BT[nt][4 * g + q]; qd[4 * g + q] = qf[q] * 0.17677669529663687f * __expf(bb); ki[4 * g + q] = kf[q] * __expf(-bb); } }
#pragma unroll
                for (int s = 0; s < 2; ++s) { QD[nt][s] = pack8f(qd[8 * s], qd[8 * s + 1], qd[8 * s + 2], qd[8 * s + 3], qd[8 * s + 4], qd[8 * s + 5], qd[8 * s + 6], qd[8 * s + 7]);
                    KI[nt][s] = pack8f(ki[8 * s], ki[8 * s + 1], ki[8 * s + 2], ki[8 * s + 3], ki[8 * s + 4], ki[8 * s + 5], ki[8 * s + 6], ki[8 * s + 7]); }
            }
        }
#pragma unroll
        for (int jt = 0; jt < 2; ++jt)
#pragma unroll
            for (int it = 0; it < 2; ++it) {
                if (jt != it) { const bool keep = dir ? (jt > it) : (jt < it); if (!keep) continue; }
                f32x16 p = MFMA32(KI[jt][0], QD[it][0], zero16); p = MFMA32(KI[jt][1], QD[it][1], p);
                if (jt == it) {
#pragma unroll
                    for (int i = 0; i < 16; ++i) { const int jj = (i & 3) + 8 * (i >> 2) + 4 * hf; const bool kp_ = dir ? (jj >= r) : (jj <= r); p[i] = kp_ ? p[i] : 0.f; }
                }
                const bf16x8 P0 = pack_step(p, 0), P1 = pack_step(p, 1);
#pragma unroll
                for (int ct = 0; ct < 2; ++ct) {
                    const LAS bf16_t* vp = vT + (32 * ct + r) * VS + 32 * jt + 4 * hf;
                    const bf16x8 A0 = cat44(*(const LAS u32x2*)vp, *(const LAS u32x2*)(vp + 8)), A1 = cat44(*(const LAS u32x2*)(vp + 16), *(const LAS u32x2*)(vp + 24));
                    OT[ct][it] = MFMA32(A0, P0, OT[ct][it]); OT[ct][it] = MFMA32(A1, P1, OT[ct][it]); }
            }
#pragma unroll
        for (int ct = 0; ct < 2; ++ct)
#pragma unroll
            for (int s = 0; s < 2; ++s) {
                const bf16x8 As = cat44(sraw[ct][s][0], sraw[ct][s][1]);
                OT[ct][0] = MFMA32(As, QD[0][s], OT[ct][0]); OT[ct][1] = MFMA32(As, QD[1][s], OT[ct][1]); }
    }
    int ln2 = lane; asm volatile("" : "+v"(ln2)); const int r = ln2 & 31, hf = ln2 >> 5;
    u32x2 graw[2][2][4]; f32x4 gor[2][4];
#pragma unroll
    for (int ct = 0; ct < 2; ++ct)
#pragma unroll
        for (int g = 0; g < 4; ++g) { const int c0 = 32 * ct + 8 * g + 4 * hf; gor[ct][g] = *(const f32x4*)(a.in[I_GOUT] + l * 256 + 64 * h + c0);
#pragma unroll
            for (int it = 0; it < 2; ++it) graw[it][ct][g] = *(const u32x2*)(cols0 + (size_t)(32 * it + r) * NINP + C_G + 64 * h + c0); }
#pragma unroll
    for (int ct = 0; ct < 2; ++ct)
#pragma unroll
        for (int g = 0; g < 4; ++g) { PIN(gor[ct][g]); PIN(graw[0][ct][g]); PIN(graw[1][ct][g]); }
#pragma unroll
    for (int it = 0; it < 2; ++it) {
        float ss = 0.f;
#pragma unroll
        for (int ct = 0; ct < 2; ++ct)
#pragma unroll
            for (int i = 0; i < 16; ++i) ss += OT[ct][it][i] * OT[ct][it][i];
        ss = swap32_add(ss, ss);
        const float rs = rsqrtf(ss * (1.0f / 64.0f) + EPS);
        const int t = 32 * it + r;
#pragma unroll
        for (int ct = 0; ct < 2; ++ct)
#pragma unroll
            for (int g = 0; g < 4; ++g) { const int c0 = 32 * ct + 8 * g + 4 * hf;
                const u32x2 gw_ = graw[it][ct][g];
                const f32x4 go = gor[ct][g];
                const float o0 = OT[ct][it][4 * g] * rs * go[0] * siluf_(bflo(gw_.x)), o1 = OT[ct][it][4 * g + 1] * rs * go[1] * siluf_(bfhi(gw_.x));
                const float o2 = OT[ct][it][4 * g + 2] * rs * go[2] * siluf_(bflo(gw_.y)), o3 = OT[ct][it][4 * g + 3] * rs * go[3] * siluf_(bfhi(gw_.y));
                u32x2 w; w.x = pk2c(o0, o1); w.y = pk2c(o2, o3);
                *(u32x2*)(MIX + (size_t)(tile * 64 + t) * D + 64 * h + c0) = w; }
    }
    LDS_WAIT(); asm volatile("" ::: "memory");
}
template <int TAPS>
__device__ __forceinline__ void vconv_item(const bf16_t* COLS, float* DST, const float* w  , int b, int col, int chg, LAS float* buf, int lane) {
    const int ch = lane & 31, rh = lane >> 5;
    const size_t base = ((size_t)b * SEQ + col) * 128 + chg * 32 + ch;
    constexpr int cA = (TAPS == 31 ? C_CA : C_SC) + 128, cB = (TAPS == 31 ? C_CG : C_SX) + 128;
    const bf16_t* src = COLS + ((size_t)b * SEQ + col) * NINP + chg * 32 + ch;
    float wt[TAPS];
    { unsigned xa[64], xb[64];
#pragma unroll
        for (int i = 0; i < 64; ++i) { const bf16_t* rp = src + (size_t)(2 * i + rh) * 64 * NINP; xa[i] = rp[cA]; xb[i] = rp[cB]; }
#pragma unroll
        for (int j = 0; j < TAPS; ++j) wt[j] = w[j * 256 + chg * 32 + ch];
#pragma unroll
        for (int i = 0; i < 64; ++i) { PIN(xa[i]); PIN(xb[i]); }
#pragma unroll
        for (int i = 0; i < 64; ++i) { const float fa = __uint_as_float(xa[i] << 16), fb = __uint_as_float(xb[i] << 16);
            buf[(2 * i + rh) * 32 + ch] = (TAPS == 31) ? fa * sigmoidf_(fb) : fa * fb; } }
    LDS_WAIT(); asm volatile("" ::: "memory");
    constexpr int HW = TAPS / 2;
#pragma unroll 1
    for (int r0 = 0; r0 < 64; r0 += 8) {
        const int rb = rh * 64 + r0;
        float o[8] = {0.f, 0.f, 0.f, 0.f, 0.f, 0.f, 0.f, 0.f};
#pragma unroll
        for (int j = 0; j < TAPS + 7; ++j) { const int rin = rb - HW + j; const float x = (rin >= 0 && rin < 128) ? buf[rin * 32 + ch] : 0.f;
#pragma unroll
            for (int q = 0; q < 8; ++q) { if (j - q >= 0 && j - q < TAPS) o[q] += x * wt[j - q]; } }
#pragma unroll
        for (int q = 0; q < 8; ++q) DST[base + (size_t)(rb + q) * 64 * 128] = o[q];
    }
    LDS_WAIT(); asm volatile("" ::: "memory");
}
__device__ __forceinline__ void phase_scan(const Args& a, int l, LAS unsigned char* lds) {
    const int tid = tid_now(), lane = tid & 63, wid = __builtin_amdgcn_readfirstlane(tid >> 6);
    LAS int* vctr = (LAS int*)(lds + MISC_OFF + 16);
    if (tid == 0) *vctr = 0;
    __syncthreads();
    const float* KV = (const float*)(a.ws + WS_KV); const float* DEC = (const float*)(a.ws + WS_DEC); bf16_t* SIN = (bf16_t*)(a.ws + WS_SIN);
    if (tid < 256) {
        for (int rp = 0; rp < ((REP_SUB == 5 && l == 0) ? 2 : 1); ++rp)
        for (int gid = blockIdx.x * 256 + tid; gid < 65536; gid += gridDim.x * 256) {
            const int e = gid >> 11, idx = gid & 2047;
            const float* p = KV + (size_t)e * NSEQ * 2048 + idx; const float* dp = DEC + (size_t)e * NSEQ * 32 + (idx & 31); bf16_t* q = SIN + (size_t)e * NSEQ * 2048 + idx;
            float st = 0.f;
#pragma unroll 1
            for (int s0 = 0; s0 < NSEQ; s0 += 22) {
                float kv[22], dd[22];
#pragma unroll
                for (int u = 0; u < 22; ++u) { kv[u] = p[(size_t)(s0 + u) * 2048]; dd[u] = dp[(s0 + u) * 32]; }
#pragma unroll
                for (int u = 0; u < 22; ++u) { PIN(kv[u]); PIN(dd[u]); }
#pragma unroll
                for (int u = 0; u < 22; ++u) { q[(size_t)(s0 + u) * 2048] = (bf16_t)(pk2c(st, 0.f) & 0xffffu); st = dd[u] * st + kv[u]; }
            }
        }
    }
    LAS float* buf = (LAS float*)(lds + wid * 16384);
    for (;;) { const int j = next_item(vctr, lane); const int it = (int)blockIdx.x + (int)gridDim.x * j; if (it >= 2048) break;
        const int kind = it >> 10, q = it & 1023, b = q >> 8, col = (q >> 2) & 63, chg = q & 3;
        if (kind == 0) vconv_item<31>((const bf16_t*)(a.ws + WS_COLS), (float*)(a.ws + WS_UV), a.in[I_CONFW] + (size_t)l * 31 * 256 + 128, b, col, chg, buf, lane);
        else vconv_item<3>((const bf16_t*)(a.ws + WS_COLS), (float*)(a.ws + WS_SCV), a.in[I_SCW] + (size_t)l * 3 * 256 + 128, b, col, chg, buf, lane);
    }
}

__device__ __forceinline__ void mixer_conv_item(const Args& a, int l, int tile, int tg, int lane0, LAS float* U) {
    const bf16_t* COLS = (const bf16_t*)(a.ws + WS_COLS); bf16_t* MIX = (bf16_t*)(a.ws + WS_MIX);
    const int row0 = tile * 64, T0 = 16 * tg;
    const float* confw = a.in[I_CONFW] + (size_t)l * 31 * 256; const float* scw = a.in[I_SCW] + (size_t)l * 3 * 256;
#pragma unroll 1
    for (int p = 0; p < 2; ++p) {
        int lane = lane0; asm volatile("" : "+v"(lane));
        const int c = 64 * p + lane;
        float wv[31];
#pragma unroll
        for (int j = 0; j < 31; ++j) wv[j] = confw[j * 256 + c];
        float bias = a.in[I_CONFB][l * 256 + c];
        unsigned ra[46], rg[46];
#pragma unroll
        for (int i = 0; i < 46; ++i) { const int t = T0 - 15 + i, tc = t < 0 ? 0 : (t > 63 ? 63 : t); const bf16_t* rp = COLS + (size_t)(row0 + tc) * NINP + c; ra[i] = rp[C_CA]; rg[i] = rp[C_CG]; }
#pragma unroll
        for (int j = 0; j < 31; ++j) PIN(wv[j]);
        PIN(bias);
#pragma unroll
        for (int i = 0; i < 46; ++i) { PIN(ra[i]); PIN(rg[i]); }
        float ag[46];
#pragma unroll
        for (int i = 0; i < 46; ++i) { const int t = T0 - 15 + i; const float m = (t >= 0 && t < 64) ? 1.0f : 0.0f;
            ag[i] = m * __uint_as_float(ra[i] << 16) * __builtin_amdgcn_rcpf(1.0f + __expf(-__uint_as_float(rg[i] << 16))); }
#pragma unroll
        for (int q = 0; q < 16; ++q) { float o = bias;
#pragma unroll
            for (int j = 0; j < 31; ++j) o += ag[q + j] * wv[j];
            U[q * 256 + ((((c >> 2) ^ q) << 2) | (c & 3))] = o; }
        unsigned rc[18], rx[18], rsb[16];
        float w0 = scw[c], w1 = scw[256 + c], w2 = scw[512 + c];
#pragma unroll
        for (int i = 0; i < 18; ++i) { const int t = T0 - 1 + i, tc = t < 0 ? 0 : (t > 63 ? 63 : t); const bf16_t* rp = COLS + (size_t)(row0 + tc) * NINP + c; rc[i] = rp[C_SC]; rx[i] = rp[C_SX]; }
#pragma unroll
        for (int q = 0; q < 16; ++q) rsb[q] = COLS[(size_t)(row0 + T0 + q) * NINP + C_SB + c];
        PIN(w0); PIN(w1); PIN(w2);
#pragma unroll
        for (int i = 0; i < 18; ++i) { PIN(rc[i]); PIN(rx[i]); }
#pragma unroll
        for (int q = 0; q < 16; ++q) PIN(rsb[q]);
        float cx[18];
#pragma unroll
        for (int i = 0; i < 18; ++i) { const int t = T0 - 1 + i; const float m = (t >= 0 && t < 64) ? 1.0f : 0.0f; cx[i] = m * __uint_as_float(rc[i] << 16) * __uint_as_float(rx[i] << 16); }
#pragma unroll
        for (int q = 0; q < 16; ++q) { const float cv = cx[q] * w0 + cx[q + 1] * w1 + cx[q + 2] * w2;
            MIX[(size_t)(row0 + T0 + q) * D + 512 + c] = (bf16_t)(pk2c(__uint_as_float(rsb[q] << 16) * cv, 0.f) & 0xffffu); }
    }
    {
        int lane = lane0; asm volatile("" : "+v"(lane));
        const float* UV = (const float*)(a.ws + WS_UV); const float* SCV = (const float*)(a.ws + WS_SCV);
        f32x4 uu[8], svv[8], bzz[8]; u32x2 sbb[8];
#pragma unroll
        for (int k8 = 0; k8 < 8; ++k8) { const int idx = lane + 64 * k8, t = idx >> 5, c4 = (idx & 31) * 4; const size_t row = (size_t)(row0 + T0 + t);
            uu[k8] = *(const f32x4*)(UV + row * 128 + c4); bzz[k8] = *(const f32x4*)(a.in[I_CONFB] + l * 256 + 128 + c4);
            svv[k8] = *(const f32x4*)(SCV + row * 128 + c4); sbb[k8] = *(const u32x2*)(COLS + row * NINP + C_SB + 128 + c4); }
#pragma unroll
        for (int k8 = 0; k8 < 8; ++k8) { PIN(uu[k8]); PIN(bzz[k8]); PIN(svv[k8]); PIN(sbb[k8]); }
#pragma unroll
        for (int k8 = 0; k8 < 8; ++k8) { const int idx = lane + 64 * k8, t = idx >> 5, c4 = (idx & 31) * 4; const size_t row = (size_t)(row0 + T0 + t);
            *(LAS f32x4*)(U + t * 256 + ((((128 + c4) >> 2) ^ t) << 2)) = uu[k8] + bzz[k8];
            u32x2 w; w.x = pk2c(bflo(sbb[k8].x) * svv[k8][0], bfhi(sbb[k8].x) * svv[k8][1]); w.y = pk2c(bflo(sbb[k8].y) * svv[k8][2], bfhi(sbb[k8].y) * svv[k8][3]);
            *(u32x2*)(MIX + row * D + 512 + 128 + c4) = w; }
    }
    LDS_WAIT(); asm volatile("" ::: "memory");
    {
        int lane = lane0; asm volatile("" : "+v"(lane));
        const int t = lane >> 2, qd = lane & 3;
        f32x4 lgv[16], lbv[16];
        { const float* lg = a.in[I_CONFG] + l * 256 + 64 * qd; const float* lb = a.in[I_CONFBETA] + l * 256 + 64 * qd;
#pragma unroll
            for (int i = 0; i < 16; ++i) { lgv[i] = *(const f32x4*)(lg + 4 * i); lbv[i] = *(const f32x4*)(lb + 4 * i); }
#pragma unroll
            for (int i = 0; i < 16; ++i) { PIN(lgv[i]); PIN(lbv[i]); } }
        f32x4 v[16]; float s1 = 0.f;
#pragma unroll
        for (int i = 0; i < 16; ++i) { v[i] = *(const LAS f32x4*)(U + t * 256 + (((16 * qd + i) ^ t) << 2)); s1 += (v[i][0] + v[i][1]) + (v[i][2] + v[i][3]); }
        s1 = quad_sum(s1);
        const float mean = s1 * (1.0f / 256.0f); float s2 = 0.f;
#pragma unroll
        for (int i = 0; i < 16; ++i) { v[i] = v[i] - mean; s2 += (v[i][0] * v[i][0] + v[i][1] * v[i][1]) + (v[i][2] * v[i][2] + v[i][3] * v[i][3]); }
        s2 = quad_sum(s2);
        const float rstd = rsqrtf(s2 * (1.0f / 256.0f) + EPS);
        bf16_t* dst = MIX + (size_t)(row0 + T0 + t) * D + 256 + 64 * qd;
#pragma unroll
        for (int i = 0; i < 16; i += 2) { const f32x4 g0 = lgv[i], g1 = lgv[i + 1], b0 = lbv[i], b1 = lbv[i + 1];
            const f32x4 y0 = v[i] * rstd * g0 + b0, y1 = v[i + 1] * rstd * g1 + b1;
            u32x4 w; w.x = pk2c(siluf_(y0[0]), siluf_(y0[1])); w.y = pk2c(siluf_(y0[2]), siluf_(y0[3])); w.z = pk2c(siluf_(y1[0]), siluf_(y1[1])); w.w = pk2c(siluf_(y1[2]), siluf_(y1[3]));
            *(u32x4*)(dst + 4 * i) = w; }
    }
    LDS_WAIT(); asm volatile("" ::: "memory");
}
__device__ __forceinline__ void mixer_pool_item(const Args& a, int l, int tile, int g, int lane0) {
    const bf16_t* COLS = (const bf16_t*)(a.ws + WS_COLS); bf16_t* MIX = (bf16_t*)(a.ws + WS_MIX);
    const f32x16 zero16 = {0.f, 0.f, 0.f, 0.f, 0.f, 0.f, 0.f, 0.f, 0.f, 0.f, 0.f, 0.f, 0.f, 0.f, 0.f, 0.f};
    const int row0 = tile * 64;
    {
        int lane = lane0; asm volatile("" : "+v"(lane));
        const int r = lane & 31, hf = lane >> 5, hw = 1 << g;
        const bf16_t* pwt = (const bf16_t*)(a.ws + WS_PWT) + (size_t)(l * 4 + g) * 4096;
        const u32x4* band = (const u32x4*)(a.ws + WS_BAND) + (size_t)g * 512 + lane;
        f32x16 Y[2][2] = {{zero16, zero16}, {zero16, zero16}};
        bf16x8 Ax[2][4], Bw[2][4]; u32x4 Bb[8];
#pragma unroll
        for (int mt = 0; mt < 2; ++mt)
#pragma unroll
            for (int ks = 0; ks < 4; ++ks) { Ax[mt][ks] = *(const bf16x8*)(COLS + (size_t)(row0 + 32 * mt + r) * NINP + C_PL + 64 * g + 16 * ks + 8 * hf);
                Bw[mt][ks] = *(const bf16x8*)(pwt + (size_t)(32 * mt + r) * 64 + 16 * ks + 8 * hf); }
#pragma unroll
        for (int f = 0; f < 8; ++f) Bb[f] = band[f * 64];
        f32x4 psv[2][4];
#pragma unroll
        for (int ntd = 0; ntd < 2; ++ntd)
#pragma unroll
            for (int q = 0; q < 4; ++q) psv[ntd][q] = *(const f32x4*)(a.in[I_POOLS] + l * 256 + 64 * g + 32 * ntd + 8 * q + 4 * hf);
#pragma unroll
        for (int mt = 0; mt < 2; ++mt)
#pragma unroll
            for (int ks = 0; ks < 4; ++ks) { PIN(Ax[mt][ks]); PIN(Bw[mt][ks]); }
#pragma unroll
        for (int f = 0; f < 8; ++f) PIN(Bb[f]);
#pragma unroll
        for (int ntd = 0; ntd < 2; ++ntd)
#pragma unroll
            for (int q = 0; q < 4; ++q) PIN(psv[ntd][q]);
#pragma unroll
        for (int mt = 0; mt < 2; ++mt) {
#pragma unroll
            for (int ntd = 0; ntd < 2; ++ntd) {
                f32x16 z = zero16;
#pragma unroll
                for (int ks = 0; ks < 4; ++ks) z = MFMA32(Ax[mt][ks], Bw[ntd][ks], z);
#pragma unroll
                for (int sq = 0; sq < 2; ++sq) {
                    const float t8[8] = {z[8 * sq], z[8 * sq + 1], z[8 * sq + 2], z[8 * sq + 3], z[8 * sq + 4], z[8 * sq + 5], z[8 * sq + 6], z[8 * sq + 7]};
                    bf16x8 Zh, Zl; split8(t8, Zh, Zl);
#pragma unroll
                    for (int ntt = 0; ntt < 2; ++ntt) { const bf16x8 Bq = __builtin_bit_cast(bf16x8, Bb[(mt * 2 + ntt) * 2 + sq]);
                        Y[ntd][ntt] = MFMA32(Zh, Bq, Y[ntd][ntt]); Y[ntd][ntt] = MFMA32(Zl, Bq, Y[ntd][ntt]); }
                }
            }
        }
#pragma unroll
        for (int ntt = 0; ntt < 2; ++ntt) { const int t = 32 * ntt + r; int lo = t - hw, hi = t + hw; lo = lo < 0 ? 0 : lo; hi = hi > 64 ? 64 : hi; const float inv = 1.0f / (float)(hi - lo);
#pragma unroll
            for (int ntd = 0; ntd < 2; ++ntd)
#pragma unroll
                for (int q = 0; q < 4; ++q) { const int dd0 = 32 * ntd + 8 * q + 4 * hf; const f32x4 ps = psv[ntd][q];
                    u32x2 w; w.x = pk2c(Y[ntd][ntt][4 * q] * inv * ps[0], Y[ntd][ntt][4 * q + 1] * inv * ps[1]); w.y = pk2c(Y[ntd][ntt][4 * q + 2] * inv * ps[2], Y[ntd][ntt][4 * q + 3] * inv * ps[3]);
                    *(u32x2*)(MIX + (size_t)(row0 + t) * D + 768 + 64 * g + dd0) = w; } }
    }
}

__device__ __forceinline__ void mixer_local(const Args& a, int l, int tile, int half, int part, LAS unsigned char* lds) {
    const int tid = tid_now();
    const bf16_t* COLS = (const bf16_t*)(a.ws + WS_COLS); bf16_t* MIX = (bf16_t*)(a.ws + WS_MIX);
    LAS float* AG = (LAS float*)lds;
    LAS float* U = AG + 7936;
    LAS float* CX = U + 8192;
    const bool lat = tile < 512; const int r0 = tile * 64 + half * 32;
    const int seq_lo = lat ? tile * 64 : (NLAT + ((tile - 512) >> 2) * CTXL), seq_hi = lat ? tile * 64 + 64 : seq_lo + CTXL;
    const float* confw = a.in[I_CONFW] + (size_t)l * 31 * 256; const float* scw = a.in[I_SCW] + (size_t)l * 3 * 256;
    const int npass = part > 0 ? 0 : (lat ? 1 : 2);
    for (int ps = 0; ps < npass; ++ps) {
        const int chb = ps * 128;
        for (int idx = tid; idx < 62 * 16; idx += 512) { const int tt = idx >> 4, c8 = (idx & 15) * 8, r = r0 - 15 + tt;
            float o[8] = {0.f, 0.f, 0.f, 0.f, 0.f, 0.f, 0.f, 0.f};
            if (r >= seq_lo && r < seq_hi) { const bf16_t* rp = COLS + (size_t)r * NINP; float fa[8], fg[8]; unpack8(*(const u32x4*)(rp + C_CA + chb + c8), fa); unpack8(*(const u32x4*)(rp + C_CG + chb + c8), fg);
#pragma unroll
                for (int i = 0; i < 8; ++i) o[i] = fa[i] * sigmoidf_(fg[i]); }
            *(LAS f32x4*)(AG + tt * 128 + c8) = (f32x4){o[0], o[1], o[2], o[3]}; *(LAS f32x4*)(AG + tt * 128 + c8 + 4) = (f32x4){o[4], o[5], o[6], o[7]}; }
        for (int idx = tid; idx < 34 * 16; idx += 512) { const int tt = idx >> 4, c8 = (idx & 15) * 8, r = r0 - 1 + tt;
            float o[8] = {0.f, 0.f, 0.f, 0.f, 0.f, 0.f, 0.f, 0.f};
            if (r >= seq_lo && r < seq_hi) { const bf16_t* rp = COLS + (size_t)r * NINP; float fc[8], fx[8]; unpack8(*(const u32x4*)(rp + C_SC + chb + c8), fc); unpack8(*(const u32x4*)(rp + C_SX + chb + c8), fx);
#pragma unroll
                for (int i = 0; i < 8; ++i) o[i] = fc[i] * fx[i]; }
            *(LAS f32x4*)(CX + tt * 128 + c8) = (f32x4){o[0], o[1], o[2], o[3]}; *(LAS f32x4*)(CX + tt * 128 + c8 + 4) = (f32x4){o[4], o[5], o[6], o[7]}; }
        __syncthreads();
        { const int c = tid & 127, t0 = (tid >> 7) * 8;
            float wv[31];
#pragma unroll
            for (int j = 0; j < 31; ++j) wv[j] = confw[j * 256 + chb + c];
            const float bias = a.in[I_CONFB][l * 256 + chb + c];
            const float w0 = scw[chb + c], w1 = scw[256 + chb + c], w2 = scw[512 + chb + c];
            float o[8];
#pragma unroll
            for (int q = 0; q < 8; ++q) o[q] = bias;
#pragma unroll
            for (int j = 0; j < 38; ++j) { const float x = AG[(t0 + j) * 128 + c];
#pragma unroll
                for (int q = 0; q < 8; ++q) { if (j - q >= 0 && j - q < 31) o[q] += x * wv[j - q]; } }
#pragma unroll
            for (int q = 0; q < 8; ++q) U[(t0 + q) * 256 + chb + c] = o[q];
            unsigned sbr[8];
#pragma unroll
            for (int q = 0; q < 8; ++q) sbr[q] = COLS[(size_t)(r0 + t0 + q) * NINP + C_SB + chb + c];
#pragma unroll
            for (int q = 0; q < 8; ++q) PIN(sbr[q]);
#pragma unroll
            for (int q = 0; q < 8; ++q) { const int t = t0 + q; const float cv = CX[t * 128 + c] * w0 + CX[(t + 1) * 128 + c] * w1 + CX[(t + 2) * 128 + c] * w2;
                const float sb = __uint_as_float(sbr[q] << 16);
                MIX[(size_t)(r0 + t) * D + 512 + chb + c] = (bf16_t)(pk2(sb * cv, 0.f) & 0xffffu); }
        }
        __syncthreads();
    }
    if (lat && part <= 0) {
        const float* UV = (const float*)(a.ws + WS_UV); const float* SCV = (const float*)(a.ws + WS_SCV);
        for (int idx = tid; idx < 32 * 32; idx += 512) { const int t = idx >> 5, c4 = (idx & 31) * 4;
            const f32x4 u = *(const f32x4*)(UV + (size_t)(r0 + t) * 128 + c4), bz = *(const f32x4*)(a.in[I_CONFB] + l * 256 + 128 + c4);
            *(LAS f32x4*)(U + t * 256 + 128 + c4) = u + bz;
            const f32x4 sv = *(const f32x4*)(SCV + (size_t)(r0 + t) * 128 + c4);
            const u32x2 sbw = *(const u32x2*)(COLS + (size_t)(r0 + t) * NINP + C_SB + 128 + c4);
            u32x2 w; w.x = pk2(bflo(sbw.x) * sv[0], bfhi(sbw.x) * sv[1]); w.y = pk2(bflo(sbw.y) * sv[2], bfhi(sbw.y) * sv[3]);
            *(u32x2*)(MIX + (size_t)(r0 + t) * D + 512 + 128 + c4) = w; }
        __syncthreads();
    }
    if (part <= 0) { const int t = tid >> 4, c0 = (tid & 15) * 16;
        float s = 0.f;
#pragma unroll
        for (int i = 0; i < 16; i += 4) { const f32x4 v = *(const LAS f32x4*)(U + t * 256 + c0 + i); s += (v[0] + v[1]) + (v[2] + v[3]); }
        s = row_sum16(s);
        const float mean = s * (1.0f / 256.0f); float q = 0.f;
#pragma unroll
        for (int i = 0; i < 16; i += 4) { const f32x4 v = *(const LAS f32x4*)(U + t * 256 + c0 + i) - mean; q += (v[0] * v[0] + v[1] * v[1]) + (v[2] * v[2] + v[3] * v[3]); }
        q = row_sum16(q);
        const float rstd = rsqrtf(q * (1.0f / 256.0f) + EPS);
        const float* lg = a.in[I_CONFG] + l * 256 + c0; const float* lb = a.in[I_CONFBETA] + l * 256 + c0;
#pragma unroll
        for (int i = 0; i < 16; i += 8) { float y[8];
#pragma unroll
            for (int k = 0; k < 8; ++k) y[k] = siluf_((U[t * 256 + c0 + i + k] - mean) * rstd * lg[i + k] + lb[i + k]);
            u32x4 w; w.x = pk2(y[0], y[1]); w.y = pk2(y[2], y[3]); w.z = pk2(y[4], y[5]); w.w = pk2(y[6], y[7]);
            *(u32x4*)(MIX + (size_t)(r0 + t) * D + 256 + c0 + i) = w; }
    }
    __syncthreads();
    if (part == 0) return;
    for (int hf = (part > 0 ? part - 1 : 0); hf < (part > 0 ? part : 2); ++hf) {
        LAS float* PI = (LAS float*)lds;
        LAS float* DF = PI + 6144;
        LAS float* PW = DF + 4224;
        for (int idx = tid; idx < 48 * 16; idx += 512) { const int tt = idx >> 4, c8 = (idx & 15) * 8, r = r0 - 8 + tt;
            float o[8] = {0.f, 0.f, 0.f, 0.f, 0.f, 0.f, 0.f, 0.f};
            if (r >= seq_lo && r < seq_hi) unpack8(*(const u32x4*)(COLS + (size_t)r * NINP + C_PL + hf * 128 + c8), o);
            *(LAS f32x4*)(PI + tt * 128 + c8) = (f32x4){o[0], o[1], o[2], o[3]}; *(LAS f32x4*)(PI + tt * 128 + c8 + 4) = (f32x4){o[4], o[5], o[6], o[7]}; }
        for (int idx = tid; idx < 2 * 64 * 64 / 4; idx += 512) *(LAS f32x4*)(PW + idx * 4) = *(const f32x4*)(a.in[I_POOLW] + (size_t)l * 4 * 4096 + (size_t)hf * 2 * 4096 + idx * 4);
        __syncthreads();
        for (int idx = tid; idx < 32 * 128; idx += 512) { const int t = idx >> 7, c = idx & 127, g = hf * 2 + (c >> 6); const int hw = 1 << g;
            const int r = r0 + t; int lo = r - hw, hi = r + hw; lo = lo < seq_lo ? seq_lo : lo; hi = hi > seq_hi ? seq_hi : hi;
            float sm = 0.f; for (int rr = lo; rr < hi; ++rr) sm += PI[(rr - r0 + 8) * 128 + c];
            DF[t * 132 + c] = sm / (float)(hi - lo) - PI[(t + 8) * 128 + c]; }
        __syncthreads();
        { const int gl = tid >> 8, tp = (tid >> 4) & 15, dq = tid & 15; const int dd0 = dq * 4;
            f32x4 o[2] = {(f32x4){0.f, 0.f, 0.f, 0.f}, (f32x4){0.f, 0.f, 0.f, 0.f}};
#pragma unroll 2
            for (int c4 = 0; c4 < 64; c4 += 4) { f32x4 dv[2];
#pragma unroll
                for (int x = 0; x < 2; ++x) dv[x] = *(const LAS f32x4*)(DF + (tp * 2 + x) * 132 + gl * 64 + c4);
#pragma unroll
                for (int q = 0; q < 4; ++q) { const f32x4 wv = *(const LAS f32x4*)(PW + (gl * 64 + c4 + q) * 64 + dd0);
#pragma unroll
                    for (int x = 0; x < 2; ++x) o[x] += dv[x][q] * wv; } }
            const int ch = (hf * 2 + gl) * 64 + dd0; const f32x4 ps = *(const f32x4*)(a.in[I_POOLS] + l * 256 + ch);
#pragma unroll
            for (int x = 0; x < 2; ++x) { u32x2 w; w.x = pk2(o[x][0] * ps[0], o[x][1] * ps[1]); w.y = pk2(o[x][2] * ps[2], o[x][3] * ps[3]);
                *(u32x2*)(MIX + (size_t)(r0 + tp * 2 + x) * D + 768 + ch) = w; } }
        __syncthreads();
    }
}

__device__ __forceinline__ void phase_pool(const Args& a, int l, LAS unsigned char* lds) {
    LAS int* ctr = (LAS int*)(lds + MISC_OFF + 20);
    const int b = blockIdx.x, G = gridDim.x, nL = b < 512 ? (511 - b) / G + 1 : 0;
#pragma unroll 1
    for (;;) { const int jp = next_item(ctr, tid_now() & 63); if (jp >= 4 * nL) break;
        mixer_pool_item(a, l, b + G * (jp >> 2), jp & 3, tid_now() & 63); }
}
__device__ __forceinline__ void phase_mixer(const Args& a, int l, LAS unsigned char* lds) {
    const int b = blockIdx.x, G = gridDim.x;
    const bool spread = (l == 0);
    if (spread && b < 96) mixer_local(a, l, 512 + b / 6, (b / 3) & 1, b % 3, lds);
    { const int tid = tid_now(), lane = tid & 63, wid = __builtin_amdgcn_readfirstlane(tid >> 6);
        LAS bf16_t* vT = (LAS bf16_t*)(lds + wid * 16384);
        LAS int* ctr = (LAS int*)(lds + MISC_OFF + 16);
        if (tid == 0) *ctr = 0;
        __syncthreads();
        const int nL = b < 512 ? (511 - b) / G + 1 : 0;
        int ncx = 0;
        if (spread && b >= 96 && b < 160) ncx = 1;
        for (;;) { int j = next_item(ctr, lane);
            if (j < 4 * nL) { mixer_gla_item(a, l, b + G * (j >> 2), j & 3, lane, vT); continue; }
            j -= 4 * nL;
            if (j < ncx) { const int bb = blockIdx.x; mixer_gla_item(a, l, 512 + ((bb - 96) >> 2), (bb - 96) & 3, lane, vT); continue; }
            j -= ncx;
            if (j < 4 * nL) { mixer_conv_item(a, l, b + G * (j >> 2), j & 3, lane, (LAS float*)vT); continue; }
            break; }
        if (spread) {
            unsigned* q = (unsigned*)(a.ws + WS_CTL) + CW_MXQ + 64 * (b & 7); constexpr int per = CV_G / 8;
            int t1 = 0; if (lane == 0) t1 = (int)atomicAdd(q, 1u);
#pragma unroll 1
            for (;;) { const int jj = __builtin_amdgcn_readfirstlane(t1); if (jj >= per) break;
                t1 = 0; if (lane == 0) t1 = (int)atomicAdd(q, 1u);
                convert_item(a, CV_E0 + CV_P0_E0 + ((int)blockIdx.x & 7) * per + jj, (LAS float*)(lds + (tid_now() >> 6) * 16384), tid_now() & 63); }
        }
    }
}

__device__ __forceinline__ void phase_router(const Args& a, int l, LAS unsigned char* lds) {
    const int tid = tid_now(), lane = tid & 63, wid = tid >> 6;
    const int M = (l == 1) ? NLAT : MTOT;
    const float* MOD = (const float*)(a.ws + WS_MOD) + (size_t)l * 5 * 6144; unsigned char* H = a.ws + WS_H;
    LAS float* WRE = (LAS float*)lds;
    LAS int* INFO = (LAS int*)(lds + MISC_OFF + 4096);
    LAS int* HIST = (LAS int*)(lds + MISC_OFF + 2048);
    const float* wre = (const float*)(a.ws + WS_WRET) + (size_t)l * 32768; const float* wrgT = (const float*)(a.ws + WS_TAB) + (size_t)l * 4096;
    { f32x4 wq[16];
#pragma unroll
        for (int i = 0; i < 16; ++i) wq[i] = *((const f32x4*)wre + tid + 512 * i);
#pragma unroll
        for (int i = 0; i < 16; ++i) PIN(wq[i]);
#pragma unroll
        for (int i = 0; i < 16; ++i) *((LAS f32x4*)WRE + tid + 512 * i) = wq[i]; }
    if (tid < 64) HIST[tid] = 0;
    __syncthreads();
    const int per = (M + gridDim.x - 1) / gridDim.x; const int r_lo = blockIdx.x * per; int r_hi = r_lo + per; if (r_hi > M) r_hi = M;
    const float rbg0 = a.in[I_RBG][l * 4 + 0], rbg1 = a.in[I_RBG][l * 4 + 1], rbg2 = a.in[I_RBG][l * 4 + 2], rbg3 = a.in[I_RBG][l * 4 + 3];
    bf16_t* XB = (bf16_t*)(a.ws + WS_XB); const unsigned char* Y1 = a.ws + WS_Y;
    int cur_b = -1; f32x4 GS[4], SH[4], GA[4], WGT[4][4];
#pragma unroll
    for (int g = 0; g < 4; ++g)
#pragma unroll
        for (int j = 0; j < 4; ++j) WGT[g][j] = *((const f32x4*)(wrgT + g * 1024) + lane + 64 * j);
    for (int rp = 0; rp < ((REP_SUB == 7 && l == 0) ? 2 : 1); ++rp)
#pragma unroll 1
    for (int mm = r_lo + wid; mm < r_hi; mm += 16) {
        f32x4 vv[2][4]; unsigned yy[2][4]; int mrow[2]; bool has[2];
#pragma unroll
        for (int rr = 0; rr < 2; ++rr) { const int m = mm + 8 * rr; has[rr] = m < r_hi; const int mc = has[rr] ? m : mm; mrow[rr] = mc;
            if (l == 0) load_row(mc < NLAT ? a.in[I_X] + (size_t)mc * D : a.in[I_CTX] + (size_t)(mc - NLAT) * D, lane, vv[rr]);
            else load_row_bf(XB + (size_t)mc * D, lane, vv[rr]);
#pragma unroll
            for (int j = 0; j < 4; ++j) yy[rr][j] = *((const unsigned*)(Y1 + (size_t)mc * D) + lane + 64 * j); }
#pragma unroll
        for (int rr = 0; rr < 2; ++rr) {
            if (!has[rr]) continue;
            const int m = mrow[rr]; const int b = m < NLAT ? (m >> 13) : 4;
            if (b != cur_b) { const float* mod = MOD + (size_t)b * 6144; load_mod_cached(a.in[I_G2] + l * 1024, mod + 4 * 1024, mod + 3 * 1024, mod + 2 * 1024, lane, GS, SH, GA);
#pragma unroll
                for (int j = 0; j < 4; ++j) GA[j] = GA[j] * (1.0f / F8_YSC);
                cur_b = b; }
            f32x4 v[4];
#pragma unroll
            for (int j = 0; j < 4; ++j) { const int y = (int)yy[rr][j]; const f32x2 ylo = __builtin_amdgcn_cvt_pk_f32_fp8(y, false), yhi = __builtin_amdgcn_cvt_pk_f32_fp8(y, true); v[j] = vv[rr][j] + GA[j] * (f32x4){ylo[0], ylo[1], yhi[0], yhi[1]}; }
            store_row_bf(XB + (size_t)m * D, lane, v);
            const float rstd = row_rstd(v);
            norm_store_cached8(v, rstd, GS, SH, H + (size_t)m * D, lane);
            f32x2 g2_[4] = {{0.f, 0.f}, {0.f, 0.f}, {0.f, 0.f}, {0.f, 0.f}};
#pragma unroll
            for (int g = 0; g < 4; ++g)
#pragma unroll
                for (int j = 0; j < 4; ++j) { const f32x4 w = WGT[g][j]; g2_[g] = fma2(LO2(v[j]), LO2(w), g2_[g]); g2_[g] = fma2(HI2(v[j]), HI2(w), g2_[g]); }
            float lg0, lg1, lg2, lg3;
            { float kk = swap16_add(swap32_add(g2_[0][0] + g2_[0][1], g2_[2][0] + g2_[2][1]), swap32_add(g2_[1][0] + g2_[1][1], g2_[3][0] + g2_[3][1]));
                kk = row_sum16(kk);
                lg0 = __int_as_float(__builtin_amdgcn_readlane(__float_as_int(kk), 0)) + rbg0; lg1 = __int_as_float(__builtin_amdgcn_readlane(__float_as_int(kk), 16)) + rbg1;
                lg2 = __int_as_float(__builtin_amdgcn_readlane(__float_as_int(kk), 32)) + rbg2; lg3 = __int_as_float(__builtin_amdgcn_readlane(__float_as_int(kk), 48)) + rbg3; }
            int grp = 0; float best = lg0; if (lg1 > best) { best = lg1; grp = 1; } if (lg2 > best) { best = lg2; grp = 2; } if (lg3 > best) { best = lg3; grp = 3; }
            const float pg = 1.0f / (__expf(lg0 - best) + __expf(lg1 - best) + __expf(lg2 - best) + __expf(lg3 - best));
            grp = __builtin_amdgcn_readfirstlane(grp);
            float ep[8];
            { const LAS float* wb = WRE + (size_t)(grp * 8) * 1024;
#pragma unroll
                for (int i = 0; i < 8; i += 2) { f32x4 w[2][4];
#pragma unroll
                    for (int u = 0; u < 2; ++u)
#pragma unroll
                        for (int j = 0; j < 4; ++j) w[u][j] = *((const LAS f32x4*)(wb + (i + u) * 1024) + lane + 64 * j);
#pragma unroll
                    for (int u = 0; u < 2; ++u)
#pragma unroll
                        for (int j = 0; j < 4; ++j) PIN(w[u][j]);
#pragma unroll
                    for (int u = 0; u < 2; ++u) { f32x2 acc_ = {0.f, 0.f};
#pragma unroll
                        for (int j = 0; j < 4; ++j) { acc_ = fma2(LO2(v[j]), LO2(w[u][j]), acc_); acc_ = fma2(HI2(v[j]), HI2(w[u][j]), acc_); }
                        ep[i + u] = acc_[0] + acc_[1]; } } }
            float le[8];
            { const bool h3 = (lane & 8) != 0;
                const float k20 = swap16_add(swap32_add(ep[0], ep[4]), swap32_add(ep[2], ep[6])), k21 = swap16_add(swap32_add(ep[1], ep[5]), swap32_add(ep[3], ep[7]));
                float kk = h3 ? k21 : k20; const float sk = h3 ? k20 : k21; kk += dppf<0x128>(sk);
                kk = oct_sum(kk);
#pragma unroll
                for (int i = 0; i < 8; ++i) le[i] = __int_as_float(__builtin_amdgcn_readlane(__float_as_int(kk), 8 * i)) + a.in[I_RBE][l * 32 + grp * 8 + i]; }
            int i0 = 0; float v0 = le[0];
#pragma unroll
            for (int i = 1; i < 8; ++i) if (le[i] > v0) { v0 = le[i]; i0 = i; }
            int i1 = -1; float v1 = -3.0e38f;
#pragma unroll
            for (int i = 0; i < 8; ++i) if (i != i0 && le[i] > v1) { v1 = le[i]; i1 = i; }
            const float w0 = 1.0f / (1.0f + __expf(v1 - v0)); const float w1 = 1.0f - w0;
            if (lane == 0) { const int lr = m - r_lo; INFO[lr * 4 + 0] = grp * 8 + i0; INFO[lr * 4 + 1] = grp * 8 + i1; INFO[lr * 4 + 2] = __float_as_int(w0 * pg); INFO[lr * 4 + 3] = __float_as_int(w1 * pg); }
        }
    }
    __syncthreads();
    const int nr = r_hi - r_lo; int lp0 = 0, lp1 = 0, ee0 = 0, ee1 = 0;
    if (tid < nr) { ee0 = INFO[tid * 4 + 0]; ee1 = INFO[tid * 4 + 1]; lp0 = atomicAdd((int*)(HIST + ee0), 1); lp1 = atomicAdd((int*)(HIST + ee1), 1); }
    __syncthreads();
    unsigned* cnt = (unsigned*)(a.ws + WS_CTL) + CW_CNT + l * 32 * 64;
    if (tid < 32) { const int c = HIST[tid]; HIST[32 + tid] = c ? (int)atomicAdd(cnt + tid * 64, (unsigned)c) : 0; }
    __syncthreads();
    if (tid < nr) { const int m = r_lo + tid; const int p0 = HIST[32 + ee0] + lp0, p1 = HIST[32 + ee1] + lp1;
        int* TL = (int*)(a.ws + WS_TOKLIST); TL[ee0 * MTOT + p0] = m; TL[ee1 * MTOT + p1] = m;
        *((i32x4*)(a.ws + WS_TOKINFO) + m) = (i32x4){(ee0 << 20) | p0, (ee1 << 20) | p1, INFO[tid * 4 + 2], INFO[tid * 4 + 3]}; }
    __syncthreads();
}

__device__ __forceinline__ int moe_tables(const Args& a, int l, LAS unsigned char* lds) {
    LAS int* TB = (LAS int*)(lds + MISC_OFF + 256); LAS int* CN = TB + 64; LAS int* TE = (LAS int*)(lds + MISC_OFF + 1024); LAS int* TM = TE + 320;
    const unsigned* cnt = (const unsigned*)(a.ws + WS_CTL) + CW_CNT + l * 32 * 64;
    const int t = tid_now();
    if (t < 64) {
        const int e = t & 31; int c = 0;
        if (t < 32) { c = (int)__hip_atomic_load(cnt + e * 64, __ATOMIC_RELAXED, __HIP_MEMORY_SCOPE_AGENT); CN[e] = c; }
        const int nt = (c + 255) >> 8; int incl = nt;
#pragma unroll
        for (int o = 1; o < 32; o <<= 1) { const int up = __shfl_up(incl, o); if (t >= o) incl += up; }
        const int start = incl - nt;
        if (t < 32) { TB[e] = start;
#pragma unroll 1
            for (int q = 0; q < nt; ++q) { TE[start + q] = e; TM[start + q] = q; } }
        if (t == 31) TB[32] = incl;
    }
    __syncthreads();
    return __builtin_amdgcn_readfirstlane(TB[32]);
}

__device__ __forceinline__ void phase_combine(const Args& a, int l, LAS unsigned char* lds) {
    const int lane = tid_now() & 63, wid = tid_now() >> 6, gw = blockIdx.x * 8 + wid, NGW = gridDim.x * 8;
    const int M = (l == 1) ? NLAT : MTOT;
    (void)moe_tables(a, l, lds);
    const LAS int* TB = (const LAS int*)(lds + MISC_OFF + 256);
    const float* MOD = (const float*)(a.ws + WS_MOD); const unsigned char* Y = (const unsigned char*)(a.ws + WS_Y); bf16_t* H = (bf16_t*)(a.ws + WS_H);
    bf16_t* XB = (bf16_t*)(a.ws + WS_XB);
    int cur_b = -1; f32x4 GS[4], SH[4], GA[4];
#pragma unroll 1
    for (int mm = gw; mm < M; mm += 2 * NGW) {
        f32x4 vv[2][4]; unsigned ya[2][4], yb[2][4]; i32x4 inf[2]; int mrow[2]; bool has[2];
#pragma unroll
        for (int rr = 0; rr < 2; ++rr) { const int m = mm + rr * NGW; has[rr] = m < M; const int mc = has[rr] ? m : mm; mrow[rr] = mc;
            inf[rr] = *((const i32x4*)(a.ws + WS_TOKINFO) + mc);
            load_row_bf(XB + (size_t)mc * D, lane, vv[rr]); }
#pragma unroll
        for (int rr = 0; rr < 2; ++rr) { const int e0 = inf[rr].x >> 20, p0 = inf[rr].x & 0xfffff, e1 = inf[rr].y >> 20, p1 = inf[rr].y & 0xfffff;
            const unsigned char* y0 = Y + (size_t)(TB[e0] * 256 + p0) * D; const unsigned char* y1 = Y + (size_t)(TB[e1] * 256 + p1) * D;
#pragma unroll
            for (int j = 0; j < 4; ++j) { ya[rr][j] = *((const unsigned*)y0 + lane + 64 * j); yb[rr][j] = *((const unsigned*)y1 + lane + 64 * j); } }
#pragma unroll
        for (int rr = 0; rr < 2; ++rr) {
            if (!has[rr]) continue;
            const int m = mrow[rr]; const int b = m < NLAT ? (m >> 13) : 4;
            const float w0s = __int_as_float(inf[rr].z) * (1.0f / 16.0f), w1s = __int_as_float(inf[rr].w) * (1.0f / 16.0f);
            if (b != cur_b) { const float* ga2 = MOD + (size_t)(l * 5 + b) * 6144 + 5 * 1024;
                if (l == 0) { const float* mod = MOD + (size_t)(5 + b) * 6144; load_mod_cached(a.in[I_G1] + 1024, mod + 1024, mod, ga2, lane, GS, SH, GA); }
                else {
#pragma unroll
                    for (int j = 0; j < 4; ++j) { GS[j] = *((const f32x4*)a.in[I_GFINAL] + lane + 64 * j); SH[j] = (f32x4){0.f, 0.f, 0.f, 0.f}; GA[j] = *((const f32x4*)ga2 + lane + 64 * j); } }
                cur_b = b; }
            f32x4 v[4];
#pragma unroll
            for (int j = 0; j < 4; ++j) { const int a0 = (int)ya[rr][j], a1 = (int)yb[rr][j];
                f32x4 y; y[0] = w0s * __builtin_amdgcn_cvt_f32_fp8(a0, 0) + w1s * __builtin_amdgcn_cvt_f32_fp8(a1, 0); y[1] = w0s * __builtin_amdgcn_cvt_f32_fp8(a0, 1) + w1s * __builtin_amdgcn_cvt_f32_fp8(a1, 1);
                y[2] = w0s * __builtin_amdgcn_cvt_f32_fp8(a0, 2) + w1s * __builtin_amdgcn_cvt_f32_fp8(a1, 2); y[3] = w0s * __builtin_amdgcn_cvt_f32_fp8(a0, 3) + w1s * __builtin_amdgcn_cvt_f32_fp8(a1, 3);
                v[j] = vv[rr][j] + GA[j] * y; }
            const float rstd = row_rstd(v);
            if (l == 0) {
                store_row_bf(XB + (size_t)m * D, lane, v);
                norm_store_cached(v, rstd, GS, SH, H + (size_t)m * D, lane);
            } else {
                float* xr = a.out + (size_t)m * D;
#pragma unroll
                for (int j = 0; j < 4; ++j) *((f32x4*)xr + lane + 64 * j) = (v[j] * rstd) * GS[j];
            }
        }
    }
}

#define XB_TMO      128
#define XB_XCNT(j)  (256  + 64 * (j))
#define XB_XSUB(j)  (1280 + 64 * (j))
#define XB_XGEN(j)  (2304 + 64 * (j))
#define XB_TOP      3328
#define XB_TOPGEN   3392
#define XCD_BAR_WORDS 3456
#define XB_SPIN_CAP (1u << 22)
__device__ __forceinline__ unsigned xb_ld(unsigned* p)              { return __hip_atomic_load(p, __ATOMIC_RELAXED, __HIP_MEMORY_SCOPE_AGENT); }
__device__ __forceinline__ unsigned xb_add(unsigned* p, unsigned v) { return __hip_atomic_fetch_add(p, v, __ATOMIC_RELAXED, __HIP_MEMORY_SCOPE_AGENT); }
__device__ __forceinline__ unsigned xb_xcc_id() { return (unsigned)__builtin_amdgcn_s_getreg((3 << 11) | 20) & 0xFu; }
#define XB_SPIN(cond, bar) do { unsigned _sp = 0; while (cond) { __builtin_amdgcn_s_sleep(1); \
    if ((++_sp & 255u) == 0u) { if (xb_ld(&(bar)[XB_TMO])) break; if (_sp > XB_SPIN_CAP) { atomicAdd(&(bar)[XB_TMO], 1u); break; } } } } while (0)
struct XcdBarrier { unsigned* bar; unsigned x; volatile LAS unsigned* st; };
__device__ __forceinline__ XcdBarrier xcd_barrier_post(unsigned* bar, volatile LAS unsigned* st) {
    XcdBarrier b; b.bar = bar; b.x = xb_xcc_id(); b.st = st;
    if (threadIdx.x == 0) (void)xb_add(&bar[XB_XCNT(b.x)], 1u);
    return b;
}
__device__ __forceinline__ void xcd_barrier_complete(unsigned* bar, unsigned x, unsigned& nloc, unsigned& nx) {
    const unsigned G = gridDim.x * gridDim.y * gridDim.z;
    unsigned sum, cnt, mine, sp = 0u;
    for (;;) {
        sum = 0u; cnt = 0u; mine = 0u;
#pragma unroll
        for (unsigned j = 0; j < 16; ++j) { const unsigned c = xb_ld(&bar[XB_XCNT(j)]); sum += c; cnt += (c > 0u) ? 1u : 0u; mine = (j == x) ? c : mine; }
        if (sum == G) break;
        __builtin_amdgcn_s_sleep(1);
        if ((++sp & 255u) == 0u) { if (xb_ld(&bar[XB_TMO])) break; if (sp > XB_SPIN_CAP) { atomicAdd(&bar[XB_TMO], 1u); break; } }
    }
    nloc = mine > 0u ? mine : 1u; nx = cnt > 0u ? cnt : 1u;
}
__device__ __forceinline__ void xcd_barrier(const XcdBarrier& b) {
    asm volatile("s_waitcnt vmcnt(0)" ::: "memory");
    __syncthreads();
    if (threadIdx.x == 0) {
        unsigned* bar = b.bar;
        __builtin_amdgcn_s_waitcnt(0);
        unsigned nloc = b.st[0], nx = b.st[1];
        if (nloc == 0u) { xcd_barrier_complete(bar, b.x, nloc, nx); b.st[0] = nloc; b.st[1] = nx; }
        const unsigned old = xb_add(&bar[XB_XSUB(b.x)], 1u);
        const unsigned gen = old / nloc;
        if (old + 1u == (gen + 1u) * nloc) {
            __builtin_amdgcn_fence(__ATOMIC_RELEASE, "agent");
            asm volatile("s_waitcnt vmcnt(0)" ::: "memory");
            const unsigned og = xb_add(&bar[XB_TOP], 1u);
            const unsigned tg = og / nx;
            if (og + 1u == (tg + 1u) * nx) xb_add(&bar[XB_TOPGEN], 1u);
            else XB_SPIN(xb_ld(&bar[XB_TOPGEN]) == tg, bar);
            __builtin_amdgcn_fence(__ATOMIC_ACQUIRE, "agent");
            xb_add(&bar[XB_XGEN(b.x)], 1u);
            asm volatile("s_waitcnt vmcnt(0)" ::: "memory");
        } else {
            XB_SPIN(xb_ld(&bar[XB_XGEN(b.x)]) == gen, bar);
            __builtin_amdgcn_fence(__ATOMIC_ACQUIRE, "agent");
            asm volatile("s_waitcnt vmcnt(0)" ::: "memory");
        }
    }
    __syncthreads();
}

constexpr int NPHASE = 20;
#ifndef DIAG_PH
#define DIAG_PH -1
#endif
#define PH_ON(x) (DIAG_PH < 0 || DIAG_PH == (x))
#ifndef REP_ID
#define REP_ID -1
#endif
__global__ void __launch_bounds__(512, 2) mega(Args a) {
    extern __shared__ __attribute__((aligned(16))) unsigned char lds_raw[];
    LAS unsigned char* lds = (LAS unsigned char*)lds_raw;
    unsigned char* ws = a.ws;
    volatile LAS unsigned* bst = (volatile LAS unsigned*)(lds + MISC_OFF);
    if (threadIdx.x < 2) bst[threadIdx.x] = 0u;
    __syncthreads();
    XcdBarrier xbar = xcd_barrier_post((unsigned*)(ws + WS_CTL) + CW_BAR, bst);
    unsigned long long tph_ = 0ull;
    for (int ph = a.ph_lo; ph < a.ph_hi; ++ph) {
      unsigned long long t0_ = 0ull; if (TIME_PH >= 0 && ph == TIME_PH) t0_ = __builtin_amdgcn_s_memrealtime();
      const int cls_ = ph < 2 ? ph : 2 + (ph - 2) % 9;
      const int nrep_ = (REP_ID >= 0 && cls_ == REP_ID) ? 2 : 1;
      for (int rep_ = 0; rep_ < nrep_; ++rep_) {
        if (rep_) xcd_barrier(xbar);
        if (PH_ON(0) && ph == 0) phase_p0(a, lds);
        else if (PH_ON(1) && ph == 1) phase_norm1_l0(a);
        else {
            const int l = (ph - 2) / 9, sp = (ph - 2) % 9;
            if (PH_ON(2) && sp == 0) {
                g8::DenseSched S; S.init(ws + WS_H, ws + WS_WIN + (size_t)l * NINP * 1024 * 2, MTOT, NINP, 1024, gridDim.x, blockIdx.x);
                g8::EpiBf16 E{(bf16_t*)(ws + WS_COLS), NINP, NIN};
                g8::gemm_phase<false>(lds, S, E);
                if (l == 0) convert_in_tail(a, lds, CV_E0 + CV_P0_E0 + CV_G, CV_A - CV_K, S.nwg, S.G, S.c); else convert_in_tail(a, lds, CV_EI1 + CV_P0_EI1 + CV_C + CV_D, CV_E - CV_K, S.nwg, S.G, S.c);
            } else if (PH_ON(3) && sp == 1) { phase_chunk(a, l, lds); phase_pool(a, l, lds); }
            else if (PH_ON(4) && sp == 2) phase_scan(a, l, lds);
            else if (PH_ON(5) && sp == 3) phase_mixer(a, l, lds);
            else if (PH_ON(6) && sp == 4) {
                g8::DenseSched S; S.init(ws + WS_MIX, ws + WS_WOUT + (size_t)l * 1024 * 1024 * 2, l == 1 ? NLAT : MTOT, 1024, 1024, gridDim.x, blockIdx.x);
                g8::EpiFp8S E{ws + WS_Y, F8_YSC};
                g8::gemm_phase<false>(lds, S, E);
                if (l == 0) convert_in_tail(a, lds, CV_E0 + CV_P0_E0 + CV_G + CV_A, CV_B, S.nwg, S.G, S.c);
            } else if (PH_ON(7) && sp == 5) phase_router(a, l, lds);
            else if ((PH_ON(8) || PH_ON(9)) && (sp == 6 || sp == 7)) {
                const int T = moe_tables(a, l, lds);
                const int G = gridDim.x, bx = blockIdx.x, vcu = (G % 8 == 0) ? (bx % 8) * (G / 8) + bx / 8 : bx;
                const LAS int* TBp = (const LAS int*)(lds + MISC_OFF + 256);
                if (PH_ON(8) && sp == 6) {
                    g8::MoeSched<true> S; S.A = (const char*)(ws + WS_H); S.Bw = (const char*)(ws + WS_WEIN) + (size_t)l * 32 * 1024 * 1024; S.wstride = (size_t)1024 * 1024; S.K = 512;     S.T = T; S.G = G; S.c = vcu;
                    S.tile_e = (const LAS int*)(lds + MISC_OFF + 1024); S.tile_mt = S.tile_e + 320; S.cnt = TBp + 64; S.toklist = (const int*)(ws + WS_TOKLIST);
                    g8::EpiSwiGLU E{ws + WS_ACT};
                    g8::gemm_phase<true>(lds, S, E);
                    if (l == 0) convert_in_tail(a, lds, CV_EI1 + CV_P0_EI1, CV_C, 4 * T, G, vcu); else convert_in_tail(a, lds, CV_EO1 + CV_P0_EO1, CV_F, 4 * T, G, vcu);
                } else if (PH_ON(9) && sp == 7) {
                    g8::MoeSched<false> S; S.A = (const char*)(ws + WS_ACT); S.Bw = (const char*)(ws + WS_WEOUT) + (size_t)l * 32 * 1024 * 512; S.wstride = (size_t)1024 * 512; S.K = 256; S.T = T; S.G = G; S.c = vcu;
                    S.tile_e = (const LAS int*)(lds + MISC_OFF + 1024); S.tile_mt = S.tile_e + 320; S.cnt = TBp + 64; S.toklist = (const int*)(ws + WS_TOKLIST);
                    g8::EpiFp8 E{(unsigned char*)(ws + WS_Y)};
                    g8::gemm_phase<true>(lds, S, E);
                    if (l == 0) convert_in_tail(a, lds, CV_EI1 + CV_P0_EI1 + CV_C, CV_D, 4 * T, G, vcu);
                }
            } else if (PH_ON(10) && sp == 8) phase_combine(a, l, lds);
        }
      }
        if (ph + 1 < a.ph_hi) { if (a.ph_lo < 0) cg::this_grid().sync(); else xcd_barrier(xbar); }
        if (TIME_PH >= 0 && ph == TIME_PH) tph_ = __builtin_amdgcn_s_memrealtime() - t0_;
    }
    if (TIME_PH >= 0 && blockIdx.x == 0 && threadIdx.x == 0) { const unsigned long long te_ = __builtin_amdgcn_s_memrealtime(); while (__builtin_amdgcn_s_memrealtime() - te_ < 4ull * tph_) __builtin_amdgcn_s_sleep(8); }
}

extern "C" void kernel_launch(void* const* d_in, const int* in_sizes, int n_in, void* d_out, int out_size, void* d_ws, size_t ws_size, hipStream_t stream) {
    static int grid = 0;
    if (grid == 0) {
        if (n_in != 29 || out_size != NLAT * D || ws_size < WS_END) { fprintf(stderr, "kernel_launch: unexpected shapes (n_in %d out %d ws %zu)\n", n_in, out_size, ws_size); grid = -1; return; }
        int dev = 0, cus = 0, per_cu = 0;
        hipGetDevice(&dev); hipDeviceGetAttribute(&cus, hipDeviceAttributeMultiprocessorCount, dev);
        if (hipFuncSetAttribute((const void*)mega, hipFuncAttributeMaxDynamicSharedMemorySize, LDS_BYTES) != hipSuccess) { fprintf(stderr, "kernel_launch: hipFuncSetAttribute failed\n"); grid = -1; return; }
        if (hipOccupancyMaxActiveBlocksPerMultiprocessor(&per_cu, (const void*)mega, 512, LDS_BYTES) != hipSuccess || per_cu < 1) { fprintf(stderr, "kernel_launch: occupancy query says %d\n", per_cu); per_cu = 1; }
        (void)hipGetLastError();
        if (cus < 224) { fprintf(stderr, "kernel_launch: this kernel needs at least 224 CUs (got %d)\n", cus); grid = -1; return; }
        grid = cus;
    }
    if (grid < 0) return;
    hipMemsetAsync((char*)d_ws + WS_CTL, 0, CTL_BYTES, stream);
    Args a{};
    for (int i = 0; i < 29; ++i) a.in[i] = (const float*)d_in[i];
    a.out = (float*)d_out; a.ws = (unsigned char*)d_ws;
#if MK_MULTI
    for (int ph = 0; ph < NPHASE; ++ph) { a.ph_lo = ph; a.ph_hi = ph + 1; hipLaunchKernelGGL(mega, dim3(grid), dim3(512), LDS_BYTES, stream, a); }
#else
    a.ph_lo = 0; a.ph_hi = NPHASE;
    void* args[] = {&a};
    hipError_t e = hipLaunchCooperativeKernel((const void*)mega, dim3(grid), dim3(512), args, LDS_BYTES, stream);
    if (e != hipSuccess) fprintf(stderr, "cooperative launch failed: %s (grid %d)\n", hipGetErrorString(e), grid);
#endif
}
```
